# Optimizing an MI355X kernel written in HIP

```python
import math
import jax
import jax.numpy as jnp
from jax import lax
import numpy as np

D_MODEL = 1024
BATCH = 4
SEQ = 4096
DEPTH = 1

GRID_W = 64
CTX_LEN = 256
H_RET = 4
RET_DK = 128
RET_DV = 128
RET_W = H_RET * RET_DV
H_GDN = 4
GDN_DK = 128
GDN_DV = 128
GDN_W = H_GDN * GDN_DV
SHORT_CONV = 3
CHUNK = 128
ROPE_BASE = 10000.0
N_STATE = 2 * RET_W + 2 * GDN_W + 4 * H_GDN
N_QUERY = 2 * RET_W + 2 * GDN_W + 2 * D_MODEL
N_IN = N_STATE + N_QUERY
N_EXPERTS = 64
TOP_K = 8
N_GROUPS = 8
TOPK_GROUPS = 4
D_EXPERT = 256
D_SHARED = 256
ROUTED_SCALE = 2.5
EXPERT_BLOCK = 128
EPS = 1e-6

kernel_name = 'hybrid_retention_gdn_moe_prefix_dit'


def _rmsnorm(t, g):
    tf = t.astype(jnp.float32)
    y = tf * lax.rsqrt(jnp.mean(tf * tf, axis=-1, keepdims=True) + EPS)
    return (y * g.astype(jnp.float32)).astype(t.dtype)


def _l2norm(t):
    return t * lax.rsqrt(jnp.sum(t * t, axis=-1, keepdims=True) + EPS)


def _group_norm(t):
    tc = t - jnp.mean(t, axis=-1, keepdims=True)
    return tc * lax.rsqrt(jnp.mean(tc * tc, axis=-1, keepdims=True) + EPS)


def _head_rms(t):
    return t * lax.rsqrt(jnp.mean(t * t, axis=-1, keepdims=True) + EPS)


def _split_heads(t, n_heads):
    b, l, w = t.shape
    return t.reshape(b, l, n_heads, w // n_heads).transpose(0, 2, 1, 3)


def _merge_heads(t):
    b, h, l, d = t.shape
    return t.transpose(0, 2, 1, 3).reshape(b, l, h * d)


def _dwconv(t, w):
    return lax.conv_general_dilated(t, w[:, None, :].astype(t.dtype), (1,), 'SAME',
                                    dimension_numbers=('NWC', 'WIO', 'NWC'),
                                    feature_group_count=t.shape[-1])


def _modulation(cvec, w, b, n):
    m = jax.nn.silu(cvec) @ w[:, : n * D_MODEL] + b[: n * D_MODEL]
    return jnp.split(m, n, axis=-1)


def _axial_rope(n):
    rows = n // GRID_W
    pos_r = jnp.repeat(jnp.arange(rows, dtype=jnp.float32), GRID_W)
    pos_c = jnp.tile(jnp.arange(GRID_W, dtype=jnp.float32), rows)
    n_freq = RET_DK // 4
    inv = ROPE_BASE ** (-jnp.arange(n_freq, dtype=jnp.float32) / n_freq)
    ang = jnp.concatenate([pos_r[:, None] * inv, pos_c[:, None] * inv], axis=-1)
    return jnp.cos(ang), jnp.sin(ang)


def _apply_rope(t, cos, sin):
    half = RET_DK // 2
    t1, t2 = t[..., :half], t[..., half:]
    return jnp.concatenate([t1 * cos - t2 * sin, t1 * sin + t2 * cos], axis=-1)


def _retention_scan(q, k, v, log_g, s0):
    b, h, l, dk = k.shape
    n = l // CHUNK
    kc = k.reshape(b, h, n, CHUNK, dk)
    vc = v.reshape(b, h, n, CHUNK, -1)
    lg = log_g.astype(jnp.float32)[:, None]
    idx = jnp.arange(CHUNK, dtype=jnp.float32)
    kv = jnp.einsum('bhncd,hc,bhnce->bhnde', kc, jnp.exp(lg * (CHUNK - 1 - idx)), vc)
    chunk_decay = jnp.exp(lg[:, 0] * CHUNK)[None, :, None, None]

    def step(s, kv_n):
        return chunk_decay * s + kv_n, (None if q is None else s)

    s_fin, s_prev = lax.scan(step, s0, jnp.moveaxis(kv, 2, 0))
    if q is None:
        return s_fin
    qc = q.reshape(b, h, n, CHUNK, dk)
    dist = idx[:, None] - idx[None, :]
    dmat = jnp.where(dist >= 0, jnp.exp(lg[:, :, None] * jnp.maximum(dist, 0.0)), 0.0)
    scores = jnp.einsum('bhnid,bhnjd->bhnij', qc, kc) * dmat[None, :, None]
    o = jnp.einsum('bhnij,bhnje->bhnie', scores, vc)
    o = o + jnp.einsum('bhnid,nbhde->bhnie', qc, s_prev) * jnp.exp(lg * (idx + 1.0))[None, :, None, :, None]
    return o.reshape(b, h, l, -1), s_fin


def _gdn_scan(q, k, v, log_a, beta, s0):
    b, h, l, dk = k.shape
    dv = v.shape[-1]
    n = l // CHUNK
    kc = k.reshape(b, h, n, CHUNK, dk)
    vc = v.reshape(b, h, n, CHUNK, dv)
    bc = beta.reshape(b, h, n, CHUNK, 1)
    g = jnp.cumsum(log_a.reshape(b, h, n, CHUNK), axis=-1)
    idx = jnp.arange(CHUNK)
    strict = idx[:, None] > idx[None, :]
    rel = g[..., :, None] - g[..., None, :]
    a = jnp.einsum('bhnid,bhnjd->bhnij', kc, kc) * bc * jnp.where(strict, jnp.exp(jnp.where(strict, rel, 0.0)), 0.0)
    rhs = jnp.concatenate([bc * vc, bc * jnp.exp(g)[..., None] * kc], axis=-1)
    sol = lax.linalg.triangular_solve(a + jnp.eye(CHUNK, dtype=a.dtype), rhs,
                                      left_side=True, lower=True, unit_diagonal=True)
    u, wk = sol[..., :dv], sol[..., dv:]
    g_last = g[..., -1]
    k_tail = kc * jnp.exp(g_last[..., None] - g)[..., None]

    def step(s, inp):
        u_n, w_n, kt_n, gl_n = inp
        v_new = u_n - jnp.einsum('bhck,bhkv->bhcv', w_n, s)
        s_next = jnp.exp(gl_n)[..., None, None] * s + jnp.einsum('bhck,bhcv->bhkv', kt_n, v_new)
        return s_next, (None if q is None else (v_new, s))

    xs = tuple(jnp.moveaxis(t, 2, 0) for t in (u, wk, k_tail, g_last))
    s_fin, ys = lax.scan(step, s0, xs)
    if q is None:
        return s_fin
    v_new, s_prev = ys
    qc = q.reshape(b, h, n, CHUNK, dk)
    incl = idx[:, None] >= idx[None, :]
    qk = jnp.einsum('bhnid,bhnjd->bhnij', qc, kc) * jnp.where(incl, jnp.exp(jnp.where(incl, rel, 0.0)), 0.0)
    o = jnp.einsum('bhnij,nbhjv->bhniv', qk, v_new)
    o = o + jnp.einsum('bhnik,nbhkv->bhniv', qc * jnp.exp(g)[..., None], s_prev)
    return o.reshape(b, h, l, -1), s_fin


def _state_features(h, w_in_l, conv_l, a_log_l, dt_bias_l):
    p = h @ w_in_l[:, :N_STATE]
    rk = _split_heads(p[..., :RET_W].astype(jnp.float32), H_RET) * RET_DK ** -0.5
    rv = _split_heads(p[..., RET_W:2 * RET_W].astype(jnp.float32), H_RET)
    gkv = jax.nn.silu(_dwconv(p[..., 2 * RET_W:2 * RET_W + 2 * GDN_W], conv_l[:, GDN_W:])).astype(jnp.float32)
    gk = _l2norm(_split_heads(gkv[..., :GDN_W], H_GDN))
    gv = _split_heads(gkv[..., GDN_W:], H_GDN)
    b, l = h.shape[:2]
    gab = p[..., 2 * RET_W + 2 * GDN_W:].astype(jnp.float32).reshape(b, l, 2, 2, H_GDN).transpose(2, 3, 0, 4, 1)
    log_a = -jnp.exp(a_log_l.astype(jnp.float32))[:, None, :, None] * jax.nn.softplus(
        gab[0] + dt_bias_l.astype(jnp.float32)[:, None, :, None])
    beta = jax.nn.sigmoid(gab[1])
    return rk, rv, gk, gv, log_a, beta


def _query_features(h, w_in_l, conv_l):
    p = h @ w_in_l[:, N_STATE:]
    rq = _split_heads(p[..., :RET_W].astype(jnp.float32), H_RET)
    rg = p[..., RET_W:2 * RET_W]
    gq = jax.nn.silu(_dwconv(p[..., 2 * RET_W:2 * RET_W + GDN_W], conv_l[:, :GDN_W])).astype(jnp.float32)
    gq = _l2norm(_split_heads(gq, H_GDN)) * GDN_DK ** -0.5
    gz = p[..., 2 * RET_W + GDN_W:2 * RET_W + 2 * GDN_W]
    gates = jax.nn.sigmoid(p[..., 2 * RET_W + 2 * GDN_W:].astype(jnp.float32))
    return rq, rg, gq, gz, gates


def _recurrent_mixers(sf, rq, gq, init, ret_log_decay_l):
    rk, rv, gk, gv, log_a, beta = sf
    flip = lambda t: jnp.flip(t, axis=2)
    r_f = _retention_scan(rq, rk, rv, ret_log_decay_l[0], init[0])
    r_b = _retention_scan(None if rq is None else flip(rq), flip(rk), flip(rv), ret_log_decay_l[1], init[1])
    g_f = _gdn_scan(gq, gk, gv, log_a[0], beta[0], init[2])
    g_b = _gdn_scan(None if gq is None else flip(gq), flip(gk), flip(gv), flip(log_a[1]), flip(beta[1]), init[3])
    if rq is None:
        return (r_f, r_b, g_f, g_b)
    return r_f[0] + flip(r_b[0]), g_f[0] + flip(g_b[0]), (r_f[1], r_b[1], g_f[1], g_b[1])


def _mixer_out(ret_o, gdn_o, rg, gz, gates, ret_gn_w_l, gdn_norm_w_l, w_ret_out_l, w_gdn_out_l, w_o_l):
    dt = w_o_l.dtype
    ret_y = _merge_heads(_group_norm(ret_o)) * ret_gn_w_l.astype(jnp.float32) * jax.nn.silu(rg.astype(jnp.float32))
    gdn_y = _merge_heads(_head_rms(gdn_o)) * gdn_norm_w_l.astype(jnp.float32) * jax.nn.silu(gz.astype(jnp.float32))
    merged = (gates[..., :D_MODEL] * (ret_y.astype(dt) @ w_ret_out_l)
              + gates[..., D_MODEL:] * (gdn_y.astype(dt) @ w_gdn_out_l))
    return merged.astype(dt) @ w_o_l


def _moe(h, w_router_l, bias_l, w_gate_l, w_up_l, w_down_l, w_sh_gate_l, w_sh_up_l, w_sh_down_l):
    b, l, d = h.shape
    t = b * l
    xt = h.reshape(t, d)
    scores = jax.nn.sigmoid((xt @ w_router_l).astype(jnp.float32))
    biased = scores + bias_l.astype(jnp.float32)
    per_group = N_EXPERTS // N_GROUPS
    grp_score = lax.top_k(biased.reshape(t, N_GROUPS, per_group), 2)[0].sum(-1)
    grp_keep = jax.nn.one_hot(lax.top_k(grp_score, TOPK_GROUPS)[1], N_GROUPS, dtype=jnp.float32).sum(1) > 0
    cand = jnp.where(jnp.repeat(grp_keep, per_group, axis=1), biased, -jnp.inf)
    sel = lax.top_k(cand, TOP_K)[1]
    wts = jnp.take_along_axis(scores, sel, axis=1)
    wts = wts / jnp.sum(wts, axis=-1, keepdims=True) * ROUTED_SCALE
    n_assign = t * TOP_K
    flat_e = sel.reshape(-1)
    order = jnp.argsort(flat_e)
    e_sorted = flat_e[order]
    sizes = jnp.bincount(flat_e, length=N_EXPERTS).astype(jnp.int32)
    padded = (sizes + EXPERT_BLOCK - 1) // EXPERT_BLOCK * EXPERT_BLOCK
    pad_end = jnp.cumsum(padded)
    slot = (pad_end - padded)[e_sorted] + jnp.arange(n_assign, dtype=jnp.int32) - (jnp.cumsum(sizes) - sizes)[e_sorted]
    n_blocks = -(-n_assign // EXPERT_BLOCK) + N_EXPERTS
    n_slots = n_blocks * EXPERT_BLOCK
    slot_tok = jnp.full((n_slots,), t, jnp.int32).at[slot].set((order // TOP_K).astype(jnp.int32))
    slot_w = jnp.zeros((n_slots,), jnp.float32).at[slot].set(wts.reshape(-1)[order])
    block_e = jnp.minimum(jnp.searchsorted(pad_end, jnp.arange(n_blocks, dtype=jnp.int32) * EXPERT_BLOCK, side='right'),
                          N_EXPERTS - 1)
    xb = jnp.concatenate([xt, jnp.zeros((1, d), xt.dtype)])[slot_tok].reshape(n_blocks, EXPERT_BLOCK, d)

    def expert_block(args):
        xe, e = args
        return (jax.nn.silu(xe @ w_gate_l[e]) * (xe @ w_up_l[e])) @ w_down_l[e]

    yb = lax.map(expert_block, (xb, block_e)).reshape(n_slots, d)
    routed = jax.ops.segment_sum(yb * slot_w[:, None].astype(yb.dtype), slot_tok, num_segments=t + 1)[:t]
    shared = (jax.nn.silu(xt @ w_sh_gate_l) * (xt @ w_sh_up_l)) @ w_sh_down_l
    return (routed + shared).reshape(b, l, d)


def setup_inputs(seed: int = 0) -> dict:
    key = jax.random.key(seed)
    ks = jax.random.split(key, 32)
    f32 = jnp.float32
    D = D_MODEL

    def nrm(k, shape, fan_in, scale=1.0):
        return jax.random.normal(k, shape, f32) * (scale * fan_in ** -0.5)

    def gain(k, shape):
        return 1.0 + 0.05 * jax.random.normal(k, shape, f32)

    base_decay = jnp.log1p(-jnp.power(2.0, -5.0 - jnp.arange(H_RET, dtype=f32)))
    dt = jnp.exp(jax.random.uniform(ks[12], (DEPTH, 2, H_GDN), f32, math.log(1e-3), math.log(1e-1)))
    return {
        'x': jax.random.normal(ks[0], (BATCH, SEQ, D), f32),
        'c': jax.random.normal(ks[1], (BATCH, D), f32),
        'ctx': jax.random.normal(ks[2], (BATCH, CTX_LEN, D), f32),
        'c_ctx': jax.random.normal(ks[3], (D,), f32),
        'w_mod': nrm(ks[4], (DEPTH, D, 6 * D), D, 0.3),
        'b_mod': 0.02 * jax.random.normal(ks[5], (DEPTH, 6 * D), f32),
        'norm_mix_pre': gain(ks[6], (DEPTH, D)),
        'norm_mix_post': gain(ks[7], (DEPTH, D)),
        'norm_ffn_pre': gain(ks[8], (DEPTH, D)),
        'norm_ffn_post': gain(ks[9], (DEPTH, D)),
        'w_in': nrm(ks[10], (DEPTH, D, N_IN), D),
        'gdn_conv': nrm(ks[11], (DEPTH, SHORT_CONV, 3 * GDN_W), SHORT_CONV),
        'ret_log_decay': base_decay * (1.0 + 0.05 * jax.random.normal(ks[13], (DEPTH, 2, H_RET), f32)),
        'gdn_a_log': jnp.log(jax.random.uniform(ks[14], (DEPTH, 2, H_GDN), f32, 1.0, 16.0)),
        'gdn_dt_bias': dt + jnp.log(-jnp.expm1(-dt)),
        'ret_gn_w': gain(ks[15], (DEPTH, RET_W)),
        'gdn_norm_w': gain(ks[16], (DEPTH, GDN_W)),
        'w_ret_out': nrm(ks[17], (DEPTH, RET_W, D), RET_W),
        'w_gdn_out': nrm(ks[18], (DEPTH, GDN_W, D), GDN_W),
        'w_o': nrm(ks[19], (DEPTH, D, D), D),
        'w_router': nrm(ks[20], (DEPTH, D, N_EXPERTS), D),
        'router_bias': 0.01 * jax.random.normal(ks[21], (DEPTH, N_EXPERTS), f32),
        'w_gate': nrm(ks[22], (DEPTH, N_EXPERTS, D, D_EXPERT), D),
        'w_up': nrm(ks[23], (DEPTH, N_EXPERTS, D, D_EXPERT), D),
        'w_down': nrm(ks[24], (DEPTH, N_EXPERTS, D_EXPERT, D), D_EXPERT),
        'w_sh_gate': nrm(ks[25], (DEPTH, D, D_SHARED), D),
        'w_sh_up': nrm(ks[26], (DEPTH, D, D_SHARED), D),
        'w_sh_down': nrm(ks[27], (DEPTH, D_SHARED, D), D_SHARED),
    }


def reference(x, c, ctx, c_ctx, w_mod, b_mod, norm_mix_pre, norm_mix_post, norm_ffn_pre, norm_ffn_post,
              w_in, gdn_conv, ret_log_decay, gdn_a_log, gdn_dt_bias, ret_gn_w, gdn_norm_w,
              w_ret_out, w_gdn_out, w_o, w_router, router_bias, w_gate, w_up, w_down,
              w_sh_gate, w_sh_up, w_sh_down):
    b, n, _ = x.shape
    cos, sin = _axial_rope(n)
    zr = jnp.zeros((b, H_RET, RET_DK, RET_DV), jnp.float32)
    zg = jnp.zeros((b, H_GDN, GDN_DK, GDN_DV), jnp.float32)
    zero_state = (zr, zr, zg, zg)
    for i in range(DEPTH):
        last = i == DEPTH - 1
        out_p = (ret_gn_w[i], gdn_norm_w[i], w_ret_out[i], w_gdn_out[i], w_o[i])
        moe_p = (w_router[i], router_bias[i], w_gate[i], w_up[i], w_down[i], w_sh_gate[i], w_sh_up[i], w_sh_down[i])
        sh1, sc1, g1, sh2, sc2, g2 = [m[:, None, :] for m in _modulation(c, w_mod[i], b_mod[i], 6)]
        cm = _modulation(c_ctx, w_mod[i], b_mod[i], 2 if last else 6)
        hc = _rmsnorm(ctx, norm_mix_pre[i]) * (1.0 + cm[1]) + cm[0]
        sf_c = _state_features(hc, w_in[i], gdn_conv[i], gdn_a_log[i], gdn_dt_bias[i])
        if last:
            init = _recurrent_mixers(sf_c, None, None, zero_state, ret_log_decay[i])
        else:
            rq_c, rg_c, gq_c, gz_c, gates_c = _query_features(hc, w_in[i], gdn_conv[i])
            ret_c, gdn_c, init = _recurrent_mixers(sf_c, rq_c, gq_c, zero_state, ret_log_decay[i])
            ctx = ctx + cm[2] * _rmsnorm(_mixer_out(ret_c, gdn_c, rg_c, gz_c, gates_c, *out_p), norm_mix_post[i])
            h2c = _rmsnorm(ctx, norm_ffn_pre[i]) * (1.0 + cm[4]) + cm[3]
            ctx = ctx + cm[5] * _rmsnorm(_moe(h2c, *moe_p), norm_ffn_post[i])
        hx = _rmsnorm(x, norm_mix_pre[i]) * (1.0 + sc1) + sh1
        rk, rv, gk, gv, log_a, beta = _state_features(hx, w_in[i], gdn_conv[i], gdn_a_log[i], gdn_dt_bias[i])
        rq, rg, gq, gz, gates = _query_features(hx, w_in[i], gdn_conv[i])
        sf_x = (_apply_rope(rk, cos, sin), rv, gk, gv, log_a, beta)
        ret_x, gdn_x, _ = _recurrent_mixers(sf_x, _apply_rope(rq, cos, sin), gq, init, ret_log_decay[i])
        x = x + g1 * _rmsnorm(_mixer_out(ret_x, gdn_x, rg, gz, gates, *out_p), norm_mix_post[i])
        h2 = _rmsnorm(x, norm_ffn_pre[i]) * (1.0 + sc2) + sh2
        x = x + g2 * _rmsnorm(_moe(h2, *moe_p), norm_ffn_post[i])
    return x
```

```cpp
#include <hip/hip_runtime.h>
#include <cstdio>
#include <cstdint>

#ifndef MK_ONE_LAUNCH
#define MK_ONE_LAUNCH 0
#endif
#ifndef MK_REF_GEMM
#define MK_REF_GEMM 0
#endif

constexpr int NB = 4, SEQ = 4096, DM = 1024, CTXL = 256, RPB = SEQ + CTXL  , NROW = NB * RPB  , NT = NB * SEQ  ;
constexpr int NH = 4, HD = 128, CH = 128, NCHUNK = RPB / CH  ;
constexpr int N_STATE = 2064, N_IN = 6160, NEXP = 64, TOPK = 8, DEXP = 256;
constexpr float EPS = 1e-6f;
constexpr int NPCOL = 4096;
constexpr int SLOT_SH = 147456;
constexpr int NSLOT = SLOT_SH + NT;

constexpr size_t MiB = 1u << 20;
constexpr size_t WS_CTL = 0, CTL_BYTES = 1 * MiB;
constexpr size_t WS_MOD = 1 * MiB;
constexpr size_t WS_ROPE = 2 * MiB;
constexpr size_t WS_LOGA = 4 * MiB;
constexpr size_t WS_BETA = 5 * MiB;
constexpr size_t WS_WRO = 6 * MiB, WS_WGO = 7 * MiB, WS_WO = 8 * MiB;
constexpr size_t WS_P = 10 * MiB;
constexpr size_t WS_HX = 146 * MiB;
constexpr size_t WS_GK = WS_HX, WS_GV = WS_HX + 17 * MiB;
constexpr size_t WS_CH = 180 * MiB;
constexpr size_t WS_WIN = WS_CH;
constexpr size_t WS_ORET = WS_CH, WS_OGDN = WS_CH + 32 * MiB, WS_GQ = WS_CH + 64 * MiB;
constexpr size_t WS_RETY = 282 * MiB, WS_GDNY = 298 * MiB;
constexpr size_t WS_YB = 10 * MiB;
constexpr size_t WS_WGU = 10 * MiB;
constexpr size_t WS_H2 = 75 * MiB;
constexpr size_t WS_WD = 138 * MiB;
constexpr size_t WS_HMID = 171 * MiB;
constexpr size_t WS_TMP = 171 * MiB, WS_MERGED = 203 * MiB;
constexpr size_t WS_MO = 251 * MiB;
constexpr size_t WS_LIST = 283 * MiB;
constexpr size_t WS_SELW = 287 * MiB;
constexpr size_t WS_END = 288 * MiB;
static_assert(WS_RETY + 32 * MiB <= 319 * MiB, "ws budget");
constexpr int CW_BAR = 1024;
constexpr int CW_CNT = 8192;

#define GAS __attribute__((address_space(1)))
#define LAS __attribute__((address_space(3)))
typedef unsigned short bf16;
typedef float f32x4 __attribute__((ext_vector_type(4)));
typedef float f32x2 __attribute__((ext_vector_type(2)));
typedef short bf16x8 __attribute__((ext_vector_type(8)));
typedef unsigned u32x4 __attribute__((ext_vector_type(4)));
typedef unsigned u32x2 __attribute__((ext_vector_type(2)));
__device__ __forceinline__ unsigned f2bf(float f) { unsigned u = __builtin_bit_cast(unsigned, f); return (u + 0x7fffu + ((u >> 16) & 1u)) >> 16; }
__device__ __forceinline__ unsigned pk2(float lo, float hi) { return f2bf(lo) | (f2bf(hi) << 16); }
__device__ __forceinline__ float bf2f(unsigned b) { return __builtin_bit_cast(float, b << 16); }
__device__ __forceinline__ float bflo(unsigned w) { return __builtin_bit_cast(float, w << 16); }
__device__ __forceinline__ float bfhi(unsigned w) { return __builtin_bit_cast(float, w & 0xffff0000u); }
__device__ __forceinline__ float sigmoidf_(float x) { return 1.f / (1.f + __expf(-x)); }
__device__ __forceinline__ float siluf_(float x) { return x / (1.f + __expf(-x)); }
__device__ __forceinline__ float wave_sum(float v) {
#pragma unroll
    for (int o = 1; o < 64; o <<= 1) v += __shfl_xor(v, o);
    return v;
}
__device__ __forceinline__ float sum16(float v) {
#pragma unroll
    for (int o = 1; o < 16; o <<= 1) v += __shfl_xor(v, o);
    return v;
}
__device__ __forceinline__ void unpack8(const u32x4 w, float (&o)[8]) {
    o[0] = bflo(w.x); o[1] = bfhi(w.x); o[2] = bflo(w.y); o[3] = bfhi(w.y); o[4] = bflo(w.z); o[5] = bfhi(w.z); o[6] = bflo(w.w); o[7] = bfhi(w.w);
}
__device__ __forceinline__ u32x4 pack8(const float (&v)[8]) { u32x4 w; w.x = pk2(v[0], v[1]); w.y = pk2(v[2], v[3]); w.z = pk2(v[4], v[5]); w.w = pk2(v[6], v[7]); return w; }

namespace pg8 {
constexpr int BM = 256, BK = 64, HALF = 128, HTB = HALF * BK * 2, STAGE_BYTES = 8 * HTB;
__host__ __device__ __forceinline__ int lds_byte(int r, int c) { const int st = (r >> 4) * 2 + (c >> 5), rr = r & 15, cc = c & 31, ob = rr * 64 + cc * 2; return st * 1024 + (ob ^ (((ob >> 9) & 1) << 5)); }
__host__ __device__ __forceinline__ void stage_rc(int b, int& R, int& C) { const int st = b / 1024, sb = b % 1024, swz = sb ^ (((sb >> 9) & 1) << 5); R = (st >> 1) * 16 + swz / 64; C = (st & 1) * 32 + (swz % 64) / 2; }
__host__ __device__ __forceinline__ int perm32(int rho) { const int n = rho >> 4, i = rho & 15; return 8 * (i >> 2) + 4 * n + (i & 3); }
__device__ __forceinline__ unsigned cvt_pk_bf16(float lo, float hi) { unsigned r; asm volatile("v_cvt_pk_bf16_f32 %0, %1, %2" : "=v"(r) : "v"(lo), "v"(hi)); return r; }

struct Unit { const char* A; const char* B; int pm, pn, e, base; };

template <class Epi, class Sched, bool GATHER, bool SP2>
__device__ __forceinline__ void gemm_phase(LAS unsigned char* lds, const int K, const Sched& S, const Epi& E) {
#if MK_REF_GEMM
    {
        const int tid = threadIdx.x, wid = tid >> 6, lane = tid & 63, wr = wid >> 2, wc = wid & 3, fr = lane & 15, fq = lane >> 4;
        Unit cur;
        for (int ui = 0; S.next(ui, cur); ++ui) {
            f32x4 acc[2][2][4][2];
            for (int ai = 0; ai < 2; ++ai) for (int m = 0; m < 4; ++m) {
                const int r = 128 * ai + 64 * wr + 16 * m + fr;
                const bf16* arow = GATHER ? (const bf16*)cur.A + (size_t)S.row_index(cur, r) * K : (const bf16*)cur.A + (size_t)r * K;
                for (int bj = 0; bj < 2; ++bj) for (int n = 0; n < 2; ++n) {
                    f32x4 a4 = {0.f, 0.f, 0.f, 0.f};
                    for (int i = 0; i < 4; ++i) { const int c = 128 * bj + 32 * wc + 8 * fq + 4 * n + i; const bf16* brow = (const bf16*)cur.B + (size_t)c * K;
                        float s = 0.f; for (int k = 0; k < K; ++k) s += bf2f(arow[k]) * bf2f(brow[k]); a4[i] = s; }
                    acc[ai][bj][m][n] = a4; } }
            E(acc, cur, wr, wc, fr, fq);
        }
        return;
    }
#else
    const int tid = threadIdx.x, wid = __builtin_amdgcn_readfirstlane(tid >> 6), lane = tid & 63, wr = wid >> 2, wc = wid & 3, fr = lane & 15, fq = lane >> 4;
    const int nt = K / BK;
    unsigned voffA[2], voffB[2]; int gR = 0, gC = 0;
#pragma unroll
    for (int i = 0; i < 2; ++i) { int R, C; stage_rc(tid * 16 + i * 8192, R, C); const int Rb = (R & ~31) + perm32(R & 31);
        voffA[i] = (unsigned)(R * K + C) * 2u; voffB[i] = (unsigned)(Rb * K + C) * 2u; if (i == 0) { gR = R; gC = C; } }
    const size_t kstep = (size_t)(BK * 2);
    const size_t hstep = (size_t)HALF * K * 2;
    const unsigned ldsw = (unsigned)wid * 1024u;
    const int aoff = lds_byte(wr * 64 + fr, fq * 8), boff = lds_byte(wc * 32 + fr, fq * 8);
#define PG8_SA(b, h) (((b) * 2 + (h)) * HTB)
#define PG8_SB(b, h) ((4 + (b) * 2 + (h)) * HTB)
#define PG8_STAGE(bufoff, gbase, voff) do { _Pragma("unroll") for (int _i = 0; _i < 2; ++_i) \
        __builtin_amdgcn_global_load_lds((const unsigned*)((const char*)(gbase) + (voff)[_i]), (LAS unsigned*)(lds + (bufoff) + ldsw + _i * 8192), 16, 0, 0); } while (0)
#define PG8_STAGE_A(bufoff, gbase, h, G) do { if constexpr (GATHER) { PG8_STAGE(bufoff, gbase, (G)[h]); } else { PG8_STAGE(bufoff, (gbase) + (h) * hstep, voffA); } } while (0)
#define PG8_LDA(dst, b, h) do { _Pragma("unroll") for (int m = 0; m < 4; ++m) _Pragma("unroll") for (int k = 0; k < 2; ++k) dst[m][k] = *(const LAS bf16x8*)(lds + PG8_SA(b, h) + aoff + m * 2048 + k * 1024); } while (0)
#define PG8_LDB(dst, b, h) do { _Pragma("unroll") for (int n = 0; n < 2; ++n) _Pragma("unroll") for (int k = 0; k < 2; ++k) dst[n][k] = *(const LAS bf16x8*)(lds + PG8_SB(b, h) + boff + n * 2048 + k * 1024); } while (0)
#define PG8_MMA(ai, bj, At, Bt) do { __builtin_amdgcn_s_setprio(1); _Pragma("unroll") for (int m = 0; m < 4; ++m) _Pragma("unroll") for (int n = 0; n < 2; ++n) _Pragma("unroll") for (int k = 0; k < 2; ++k) \
        acc[ai][bj][m][n] = __builtin_amdgcn_mfma_f32_16x16x32_bf16(Bt[n][k], At[m][k], acc[ai][bj][m][n], 0, 0, 0); __builtin_amdgcn_s_setprio(0); } while (0)
#define PG8_WAIT_V(n) asm volatile("s_waitcnt vmcnt(" #n ")" ::: "memory")
#define PG8_WAIT_L(n) asm volatile("s_waitcnt lgkmcnt(" #n ")" ::: "memory")
#define PG8_BAR __builtin_amdgcn_s_barrier()
#define PG8_SCHED __builtin_amdgcn_sched_barrier(0)
    Unit cur, nxt; int ui = 0;
    if (!S.next(0, cur)) return;
    f32x4 acc[2][2][4][2];
#pragma unroll
    for (int a = 0; a < 2; ++a)
#pragma unroll
        for (int b = 0; b < 2; ++b)
#pragma unroll
            for (int m = 0; m < 4; ++m)
#pragma unroll
                for (int n = 0; n < 2; ++n) acc[a][b][m][n] = (f32x4){0.f, 0.f, 0.f, 0.f};
    bf16x8 At[4][2], B0[2][2], B1[2][2];
    const char* cA = cur.A; const char* cB = cur.B;
    unsigned cG[2][2] = {{0u, 0u}, {0u, 0u}}, nG[2][2] = {{0u, 0u}, {0u, 0u}};
    if constexpr (GATHER) {
#pragma unroll
        for (int h = 0; h < 2; ++h)
#pragma unroll
            for (int i = 0; i < 2; ++i) cG[h][i] = ((unsigned)S.row_index(cur, 128 * h + gR + 64 * i) * (unsigned)K + (unsigned)gC) * 2u;
    }
    if constexpr (SP2) {
        PG8_STAGE(PG8_SB(0, 0), cB, voffB); PG8_STAGE(PG8_SB(0, 1), cB + hstep, voffB); PG8_STAGE_A(PG8_SA(0, 0), cA, 0, cG); PG8_STAGE_A(PG8_SA(0, 1), cA, 1, cG);
        if (wr == 1) PG8_BAR;
        PG8_WAIT_V(2); PG8_BAR;
        PG8_STAGE(PG8_SB(1, 0), cB + kstep, voffB); PG8_STAGE_A(PG8_SA(1, 0), cA + kstep, 0, cG); PG8_STAGE(PG8_SB(1, 1), cB + hstep + kstep, voffB);
        PG8_WAIT_V(6); PG8_BAR;
    } else {
        PG8_STAGE(PG8_SB(0, 0), cB, voffB); PG8_STAGE_A(PG8_SA(0, 0), cA, 0, cG); PG8_STAGE(PG8_SB(0, 1), cB + hstep, voffB); PG8_STAGE_A(PG8_SA(0, 1), cA, 1, cG);
        if (wr == 1) PG8_BAR;
        PG8_WAIT_V(4); PG8_BAR;
        PG8_STAGE(PG8_SB(1, 0), cB + kstep, voffB); PG8_STAGE_A(PG8_SA(1, 0), cA + kstep, 0, cG); PG8_STAGE(PG8_SB(1, 1), cB + hstep + kstep, voffB);
        PG8_WAIT_V(6); PG8_BAR;
    }
    for (;;) {
        const bool has_next = S.next(ui + 1, nxt);
        const char* nA = has_next ? nxt.A : cA; const char* nB = has_next ? nxt.B : cB;
        for (int t = 0; t < nt; t += 2) {
            const bool last = (t == nt - 2);
            const char* a1 = cA + (size_t)(t + 1) * kstep;
            const char* a2 = last ? nA : cA + (size_t)(t + 2) * kstep; const char* b2 = last ? nB : cB + (size_t)(t + 2) * kstep;
            const char* a3 = a2 + kstep; const char* b3 = b2 + kstep;
            unsigned g2[2][2] = {{0u, 0u}, {0u, 0u}};
            if constexpr (GATHER) {
                if (last) {
                    if (has_next) {
#pragma unroll
                        for (int h = 0; h < 2; ++h)
#pragma unroll
                            for (int i = 0; i < 2; ++i) nG[h][i] = ((unsigned)S.row_index(nxt, 128 * h + gR + 64 * i) * (unsigned)K + (unsigned)gC) * 2u;
                    } else {
#pragma unroll
                        for (int h = 0; h < 2; ++h)
#pragma unroll
                            for (int i = 0; i < 2; ++i) nG[h][i] = cG[h][i];
                    }
                }
#pragma unroll
                for (int h = 0; h < 2; ++h)
#pragma unroll
                    for (int i = 0; i < 2; ++i) g2[h][i] = last ? nG[h][i] : cG[h][i];
            }
            if constexpr (SP2) {
            PG8_LDB(B0, 0, 0); PG8_LDB(B1, 0, 1); PG8_SCHED; PG8_LDA(At, 0, 0); PG8_STAGE_A(PG8_SA(1, 1), a1, 1, cG);
            PG8_WAIT_V(8); PG8_WAIT_L(0); PG8_BAR; PG8_MMA(0, 0, At, B0); PG8_MMA(0, 1, At, B1); PG8_BAR; PG8_SCHED;
            PG8_LDA(At, 0, 1); PG8_STAGE(PG8_SB(0, 0), b2, voffB); PG8_STAGE(PG8_SB(0, 1), b2 + hstep, voffB); PG8_STAGE_A(PG8_SA(0, 0), a2, 0, g2);
            PG8_WAIT_V(8); PG8_WAIT_L(0); PG8_BAR; PG8_MMA(1, 0, At, B0); PG8_MMA(1, 1, At, B1); PG8_BAR; PG8_SCHED;
            PG8_LDB(B0, 1, 0); PG8_LDB(B1, 1, 1); PG8_SCHED; PG8_LDA(At, 1, 0); PG8_STAGE_A(PG8_SA(0, 1), a2, 1, g2);
            PG8_WAIT_V(8); PG8_WAIT_L(0); PG8_BAR; PG8_MMA(0, 0, At, B0); PG8_MMA(0, 1, At, B1); PG8_BAR; PG8_SCHED;
            PG8_LDA(At, 1, 1); PG8_STAGE(PG8_SB(1, 0), b3, voffB); PG8_STAGE(PG8_SB(1, 1), b3 + hstep, voffB); PG8_STAGE_A(PG8_SA(1, 0), a3, 0, g2);
            PG8_WAIT_V(8); PG8_WAIT_L(0); PG8_BAR; PG8_MMA(1, 0, At, B0); PG8_MMA(1, 1, At, B1); PG8_BAR; PG8_SCHED;
            } else {
            PG8_LDB(B0, 0, 0); PG8_SCHED; PG8_LDA(At, 0, 0); PG8_STAGE_A(PG8_SA(1, 1), a1, 1, cG);
            PG8_WAIT_L(8); PG8_BAR; PG8_WAIT_L(0); PG8_MMA(0, 0, At, B0); PG8_BAR; PG8_SCHED;
            PG8_LDB(B1, 0, 1); PG8_STAGE(PG8_SB(0, 0), b2, voffB);
            PG8_BAR; PG8_WAIT_L(0); PG8_MMA(0, 1, At, B1); PG8_BAR;
            PG8_LDA(At, 0, 1); PG8_STAGE_A(PG8_SA(0, 0), a2, 0, g2);
            PG8_BAR; PG8_WAIT_L(0); PG8_MMA(1, 0, At, B0); PG8_BAR; PG8_SCHED;
            PG8_STAGE(PG8_SB(0, 1), b2 + hstep, voffB);
            PG8_WAIT_V(6); PG8_BAR; PG8_MMA(1, 1, At, B1); PG8_BAR;
            PG8_LDB(B0, 1, 0); PG8_SCHED; PG8_LDA(At, 1, 0); PG8_STAGE_A(PG8_SA(0, 1), a2, 1, g2);
            PG8_WAIT_L(8); PG8_BAR; PG8_WAIT_L(0); PG8_MMA(0, 0, At, B0); PG8_BAR; PG8_SCHED;
            PG8_LDB(B1, 1, 1); PG8_STAGE(PG8_SB(1, 0), b3, voffB);
            PG8_BAR; PG8_WAIT_L(0); PG8_MMA(0, 1, At, B1); PG8_BAR;
            PG8_LDA(At, 1, 1); PG8_STAGE_A(PG8_SA(1, 0), a3, 0, g2);
            PG8_BAR; PG8_WAIT_L(0); PG8_MMA(1, 0, At, B0); PG8_BAR; PG8_SCHED;
            PG8_STAGE(PG8_SB(1, 1), b3 + hstep, voffB);
            PG8_WAIT_V(6); PG8_BAR; PG8_MMA(1, 1, At, B1); PG8_BAR;
            }
        }
        if (wr == 0) PG8_BAR;
        E(acc, cur, wr, wc, fr, fq);
        if (!has_next) break;
#pragma unroll
        for (int a = 0; a < 2; ++a)
#pragma unroll
            for (int b = 0; b < 2; ++b)
#pragma unroll
                for (int m = 0; m < 4; ++m)
#pragma unroll
                    for (int n = 0; n < 2; ++n) acc[a][b][m][n] = (f32x4){0.f, 0.f, 0.f, 0.f};
        cur = nxt; cA = nA; cB = nB; ++ui;
        if constexpr (GATHER) {
#pragma unroll
            for (int h = 0; h < 2; ++h)
#pragma unroll
                for (int i = 0; i < 2; ++i) cG[h][i] = nG[h][i];
        }
        if (wr == 1) PG8_BAR;
    }
    PG8_WAIT_V(0);
    PG8_BAR;
#undef PG8_SA
#undef PG8_SB
#undef PG8_STAGE
#undef PG8_STAGE_A
#undef PG8_LDA
#undef PG8_LDB
#undef PG8_MMA
#undef PG8_WAIT_V
#undef PG8_WAIT_L
#undef PG8_BAR
#undef PG8_SCHED
#endif
}
}
constexpr bool SP2 = true;

#define XB_TMO      128
#define XB_XCNT(j)  (256  + 64 * (j))
#define XB_XSUB(j)  (1280 + 64 * (j))
#define XB_XGEN(j)  (2304 + 64 * (j))
#define XB_TOP      3328
#define XB_TOPGEN   3392
#define XCD_BAR_WORDS 3456
#define XB_SPIN_CAP (1u << 18)
__device__ __forceinline__ unsigned xb_ld(unsigned* p)              { return __hip_atomic_load(p, __ATOMIC_RELAXED, __HIP_MEMORY_SCOPE_AGENT); }
__device__ __forceinline__ unsigned xb_add(unsigned* p, unsigned v) { return __hip_atomic_fetch_add(p, v, __ATOMIC_RELAXED, __HIP_MEMORY_SCOPE_AGENT); }
__device__ __forceinline__ unsigned xb_xcc_id() { return (unsigned)__builtin_amdgcn_s_getreg((3 << 11) | 20) & 0xFu; }
#define XB_SPIN(cond, bar) do { unsigned _sp = 0; while (cond) { __builtin_amdgcn_s_sleep(1); \
    if ((++_sp & 255u) == 0u) { if (xb_ld(&(bar)[XB_TMO])) break; if (_sp > XB_SPIN_CAP) { atomicAdd(&(bar)[XB_TMO], 1u); break; } } } } while (0)
struct XcdBarrier { unsigned* bar; unsigned x; volatile LAS unsigned* st; };
__device__ __forceinline__ XcdBarrier xcd_barrier_post(unsigned* bar, volatile LAS unsigned* st) {
    XcdBarrier b; b.bar = bar; b.x = xb_xcc_id(); b.st = st;
    if (threadIdx.x == 0) (void)xb_add(&bar[XB_XCNT(b.x)], 1u);
    return b;
}
__device__ __forceinline__ void xcd_barrier_complete(unsigned* bar, unsigned x, unsigned& nloc, unsigned& nx) {
    const unsigned G = gridDim.x * gridDim.y * gridDim.z;
    unsigned sum, cnt, mine, sp = 0u;
    for (;;) {
        sum = 0u; cnt = 0u; mine = 0u;
#pragma unroll
        for (unsigned j = 0; j < 16; ++j) { const unsigned c = xb_ld(&bar[XB_XCNT(j)]); sum += c; cnt += (c > 0u) ? 1u : 0u; mine = (j == x) ? c : mine; }
        if (sum == G) break;
        __builtin_amdgcn_s_sleep(1);
        if ((++sp & 255u) == 0u) { if (xb_ld(&bar[XB_TMO])) break; if (sp > XB_SPIN_CAP) { atomicAdd(&bar[XB_TMO], 1u); break; } }
    }
    nloc = mine > 0u ? mine : 1u; nx = cnt > 0u ? cnt : 1u;
}
__device__ __forceinline__ void xcd_barrier(const XcdBarrier& b) {
    asm volatile("s_waitcnt vmcnt(0)" ::: "memory");
    __syncthreads();
    if (threadIdx.x == 0) {
        unsigned* bar = b.bar;
        __builtin_amdgcn_s_waitcnt(0);
        unsigned nloc = b.st[0], nx = b.st[1];
        if (nloc == 0u) { xcd_barrier_complete(bar, b.x, nloc, nx); b.st[0] = nloc; b.st[1] = nx; }
        const unsigned old = xb_add(&bar[XB_XSUB(b.x)], 1u);
        const unsigned gen = old / nloc;
        if (old + 1u == (gen + 1u) * nloc) {
            __builtin_amdgcn_fence(__ATOMIC_RELEASE, "agent");
            asm volatile("s_waitcnt vmcnt(0)" ::: "memory");
            const unsigned og = xb_add(&bar[XB_TOP], 1u);
            const unsigned tg = og / nx;
            if (og + 1u == (tg + 1u) * nx) xb_add(&bar[XB_TOPGEN], 1u);
            else XB_SPIN(xb_ld(&bar[XB_TOPGEN]) == tg, bar);
            __builtin_amdgcn_fence(__ATOMIC_ACQUIRE, "agent");
            xb_add(&bar[XB_XGEN(b.x)], 1u);
            asm volatile("s_waitcnt vmcnt(0)" ::: "memory");
        } else {
            XB_SPIN(xb_ld(&bar[XB_XGEN(b.x)]) == gen, bar);
            __builtin_amdgcn_fence(__ATOMIC_ACQUIRE, "agent");
            asm volatile("s_waitcnt vmcnt(0)" ::: "memory");
        }
    }
    __syncthreads();
}

constexpr int NWAVES = 8, NTHR = 512;
constexpr int RING_BYTES = 131072, MISC_OFF = RING_BYTES, LDS_BYTES = 147456;
struct Args {
    const float* in[28]; float* out; unsigned char* ws; int ph_lo, ph_hi;
};
struct Frame {
    LAS unsigned char* lds; int tid, lane, wave, G, bid;
    const float *x, *c, *ctx, *c_ctx, *w_mod, *b_mod, *n_mix_pre, *n_mix_post, *n_ffn_pre, *n_ffn_post, *w_in, *gdn_conv, *ret_log_decay, *gdn_a_log, *gdn_dt_bias,
        *ret_gn_w, *gdn_norm_w, *w_ret_out, *w_gdn_out, *w_o, *w_router, *router_bias, *w_gate, *w_up, *w_down, *w_sh_gate, *w_sh_up, *w_sh_down;
    float* out; unsigned char* ws; unsigned* ctl;
};
#define WSP(T, off) ((T*)(F.ws + (off)))

template <class CM>
__device__ __forceinline__ void transpose_item(const float* W, int ld, int K, bf16* WT, LAS float* scr, int kb, int nb, int lane, const CM& cm) {
    const int k0 = 64 * kb, n0 = 32 * nb; const int sc = cm(n0 + (lane & 31));
#pragma unroll 8
    for (int i = 0; i < 32; ++i) { const int kk = 2 * i + (lane >> 5); scr[kk * 33 + (lane & 31)] = W[(size_t)(k0 + kk) * ld + sc]; }
    asm volatile("s_waitcnt lgkmcnt(0)" ::: "memory");
    const int c = lane & 7;
#pragma unroll
    for (int j = 0; j < 4; ++j) { const int n = (lane >> 3) + 8 * j; const LAS float* s = scr + (8 * c) * 33 + n;
        u32x4 o; o.x = pk2(s[0 * 33], s[1 * 33]); o.y = pk2(s[2 * 33], s[3 * 33]); o.z = pk2(s[4 * 33], s[5 * 33]); o.w = pk2(s[6 * 33], s[7 * 33]);
        *(u32x4*)(WT + (size_t)(n0 + n) * K + k0 + 8 * c) = o; }
    asm volatile("s_waitcnt lgkmcnt(0)" ::: "memory");
}
struct CmIdent { int off; __device__ __forceinline__ int operator()(int n) const { return n + off; } };
struct CmWin {
    __device__ __forceinline__ int operator()(int n) const {
        const int g = n >> 9; int src = n + (n >= 2048 ? 16 : 0);
        if (g == 0 || g == 4) { const int hb = n & ~127, cp = n & 127; const int wc = cp >> 5, fq = (cp >> 3) & 3, nn = (cp >> 2) & 1, i = cp & 3;
            const int d = 64 * nn + 16 * wc + 4 * fq + i; src = hb + d + (n >= 2048 ? 16 : 0); }
        return src; }
};
__device__ __forceinline__ void gu_decode(int cp, int& hid, int& isup) { const int pn = cp >> 8, r = cp & 255, bj = r >> 7, wc = (r >> 5) & 3, fq = (r >> 3) & 3, nn = (r >> 2) & 1, i = r & 3; hid = pn * 128 + bj * 64 + wc * 16 + fq * 4 + i; isup = nn; }

__device__ __forceinline__ void phase_prologue(Frame& F) {
    const int gw = F.bid * NWAVES + F.wave, NGW = F.G * NWAVES; const int gt = F.bid * NTHR + F.tid, NGT = F.G * NTHR;
    LAS float* scr = (LAS float*)(F.lds + F.wave * 16384);
    { float2* rt = WSP(float2, WS_ROPE);
      for (int idx = gt; idx < SEQ * 64; idx += NGT) { const int t = idx >> 6, j = idx & 63; const float pos = (float)(j < 32 ? (t >> 6) : (t & 63)); const int f = j & 31;
          const float inv = powf(10000.0f, -(float)f / 32.0f); const float ang = pos * inv; float sn, cs; sincosf(ang, &sn, &cs); rt[idx] = make_float2(cs, sn); } }
    {
        LAS float* red = (LAS float*)(F.lds);
        for (int it = F.bid; it < 96; it += F.G) {
            const int col = it * 64 + F.lane; float a[5] = {0.f, 0.f, 0.f, 0.f, 0.f};
            const int kb = F.wave * 128;
#pragma unroll 4
            for (int k = kb; k < kb + 128; ++k) { const float w = F.w_mod[(size_t)k * 6144 + col];
#pragma unroll
                for (int r = 0; r < 5; ++r) { const float cv = r < 4 ? F.c[r * DM + k] : F.c_ctx[k]; a[r] += siluf_(cv) * w; } }
#pragma unroll
            for (int r = 0; r < 5; ++r) red[(F.wave * 5 + r) * 64 + F.lane] = a[r];
            __syncthreads();
            if (F.wave < 5) { float s = F.b_mod[col];
#pragma unroll
                for (int w = 0; w < 8; ++w) s += red[(w * 5 + F.wave) * 64 + F.lane];
                WSP(float, WS_MOD)[F.wave * 6144 + col] = s; }
            __syncthreads();
        }
    }
    {
        constexpr int I_IN = 16 * 192, I_RO = 8 * 32, I_O = 16 * 32; constexpr int NIT = I_IN + 2 * I_RO + I_O;
        for (int it = gw; it < NIT; it += NGW) { int r = it;
            if (r < I_IN) { transpose_item(F.w_in, N_IN, DM, WSP(bf16, WS_WIN), scr, r / 192, r % 192, F.lane, CmWin{}); continue; } r -= I_IN;
            if (r < I_RO) { transpose_item(F.w_ret_out, DM, 512, WSP(bf16, WS_WRO), scr, r / 32, r % 32, F.lane, CmIdent{0}); continue; } r -= I_RO;
            if (r < I_RO) { transpose_item(F.w_gdn_out, DM, 512, WSP(bf16, WS_WGO), scr, r / 32, r % 32, F.lane, CmIdent{0}); continue; } r -= I_RO;
            transpose_item(F.w_o, DM, DM, WSP(bf16, WS_WO), scr, r / 32, r % 32, F.lane, CmIdent{0}); }
    }
}

__device__ __forceinline__ void phase_moe_weights(Frame& F) {
    const int gw = F.bid * NWAVES + F.wave, NGW = F.G * NWAVES;
    LAS float* scr = (LAS float*)(F.lds + F.wave * 16384);
    constexpr int I_GU = 16 * 16  , I_D = 4 * 32;
    for (int it = gw; it < 65 * (I_GU + I_D); it += NGW) {
        const int e = it / (I_GU + I_D); int r = it % (I_GU + I_D);
        if (r < I_GU) {
            const int kb = r / 16, nb = r % 16;
            const int k0 = 64 * kb, n0 = 32 * nb; int hid, isup; gu_decode(n0 + (F.lane & 31), hid, isup);
            const float* Wg = e < 64 ? F.w_gate + (size_t)e * DM * DEXP : F.w_sh_gate; const float* Wu = e < 64 ? F.w_up + (size_t)e * DM * DEXP : F.w_sh_up;
            const float* W = isup ? Wu : Wg;
#pragma unroll 8
            for (int i = 0; i < 32; ++i) { const int kk = 2 * i + (F.lane >> 5); scr[kk * 33 + (F.lane & 31)] = W[(size_t)(k0 + kk) * DEXP + hid]; }
            asm volatile("s_waitcnt lgkmcnt(0)" ::: "memory");
            const int c = F.lane & 7; bf16* WT = WSP(bf16, WS_WGU) + (size_t)e * 512 * DM;
#pragma unroll
            for (int j = 0; j < 4; ++j) { const int n = (F.lane >> 3) + 8 * j; const LAS float* s = scr + (8 * c) * 33 + n;
                u32x4 o; o.x = pk2(s[0 * 33], s[1 * 33]); o.y = pk2(s[2 * 33], s[3 * 33]); o.z = pk2(s[4 * 33], s[5 * 33]); o.w = pk2(s[6 * 33], s[7 * 33]);
                *(u32x4*)(WT + (size_t)(n0 + n) * DM + k0 + 8 * c) = o; }
            asm volatile("s_waitcnt lgkmcnt(0)" ::: "memory");
        } else { r -= I_GU;
            const float* W = e < 64 ? F.w_down + (size_t)e * DEXP * DM : F.w_sh_down;
            transpose_item(W, DM, DEXP, WSP(bf16, WS_WD) + (size_t)e * DM * DEXP, scr, r / 32, r % 32, F.lane, CmIdent{0}); }
    }
}

__device__ __forceinline__ void phase_norm1(Frame& F) {
    const int gw = F.bid * NWAVES + F.wave, NGW = F.G * NWAVES;
    const float* mod = WSP(float, WS_MOD);
    for (int row = gw; row < NROW; row += NGW) {
        const int b = row / RPB, pos = row % RPB; const bool isctx = pos < CTXL;
        const float* src = isctx ? F.ctx + ((size_t)b * CTXL + pos) * DM : F.x + ((size_t)b * SEQ + (pos - CTXL)) * DM;
        const float* sh = isctx ? mod + 4 * 6144 : mod + b * 6144; const float* sc = sh + DM;
        f32x4 v[4]; float ss = 0.f;
#pragma unroll
        for (int j = 0; j < 4; ++j) { v[j] = *(const f32x4*)(src + 4 * (F.lane + 64 * j)); ss += v[j].x * v[j].x + v[j].y * v[j].y + v[j].z * v[j].z + v[j].w * v[j].w; }
        const float rstd = 1.0f / sqrtf(wave_sum(ss) * (1.f / DM) + EPS);
        float gd[16];
#pragma unroll
        for (int jj = 0; jj < 16; ++jj) gd[jj] = 0.f;
#pragma unroll
        for (int j = 0; j < 4; ++j) { const int c0 = 4 * (F.lane + 64 * j);
            const f32x4 g = *(const f32x4*)(F.n_mix_pre + c0), s1 = *(const f32x4*)(sc + c0), s0 = *(const f32x4*)(sh + c0);
            f32x4 h; h.x = v[j].x * rstd * g.x * (1.f + s1.x) + s0.x; h.y = v[j].y * rstd * g.y * (1.f + s1.y) + s0.y; h.z = v[j].z * rstd * g.z * (1.f + s1.z) + s0.z; h.w = v[j].w * rstd * g.w * (1.f + s1.w) + s0.w;
            u32x2 o; o.x = pk2(h.x, h.y); o.y = pk2(h.z, h.w);
            *(u32x2*)(WSP(bf16, WS_HX) + (size_t)row * DM + c0) = o;
#pragma unroll
            for (int q = 0; q < 4; ++q) { const float hv = q == 0 ? h.x : q == 1 ? h.y : q == 2 ? h.z : h.w; const float* wr = F.w_in + (size_t)(c0 + q) * N_IN + 2048;
#pragma unroll
                for (int jj = 0; jj < 4; ++jj) { const f32x4 w4 = *(const f32x4*)(wr + 4 * jj); gd[4 * jj] += hv * w4.x; gd[4 * jj + 1] += hv * w4.y; gd[4 * jj + 2] += hv * w4.z; gd[4 * jj + 3] += hv * w4.w; } } }
        float mine = 0.f;
#pragma unroll
        for (int jj = 0; jj < 16; ++jj) { const float s = wave_sum(gd[jj]); mine = (F.lane == jj) ? s : mine; }
        if (F.lane < 16) { const int ab = F.lane >> 3, dir = (F.lane >> 2) & 1, h = F.lane & 3; const size_t o = ((size_t)(dir * NB + b) * NH + h) * RPB + pos;
            if (ab == 0) { const float z = mine + F.gdn_dt_bias[dir * 4 + h]; const float sp = z > 20.f ? z : log1pf(expf(z)); WSP(float, WS_LOGA)[o] = -expf(F.gdn_a_log[dir * 4 + h]) * sp; }
            else WSP(float, WS_BETA)[o] = 1.f / (1.f + expf(-mine)); }
    }
}

struct SchedIn {
    const char* A; const char* B; int G, c;
    __device__ __forceinline__ bool next(int i, pg8::Unit& u) const {
        const int L = i * G + c; if (L >= 1536 + 32) return false;
        int lt, pn;
        if (L < 1536) { int wgid = L; { const int q = 1536 / 8, xcd = wgid % 8, off = wgid / 8; wgid = xcd * q + off; }
            const int nig = 8 * 24, gid = wgid / nig, fm = gid * 8; lt = fm + ((wgid % nig) % 8); pn = (wgid % nig) / 8; u.pm = (lt >> 4) * 17 + 1 + (lt & 15); }
        else { const int q = L - 1536; u.pm = (q >> 3) * 17; pn = q & 7; }
        u.pn = pn; u.e = 0; u.base = 0; u.A = A + (size_t)u.pm * 256 * DM * 2; u.B = B + (size_t)pn * 256 * DM * 2; return true; }
    __device__ __forceinline__ int row_index(const pg8::Unit&, int r) const { return r; }
};
struct EpiIn {
    bf16* P; bf16* GATES; const float2* rope;
    __device__ __forceinline__ void operator()(const f32x4 (&acc)[2][2][4][2], const pg8::Unit& u, int wr, int wc, int fr, int fq) const {
        const int g = u.pn >> 1;
        const int b = u.pm / 17, tl = u.pm % 17;
#pragma unroll
        for (int ai = 0; ai < 2; ++ai)
#pragma unroll
            for (int m = 0; m < 4; ++m) {
                const int rt = ai * 128 + wr * 64 + m * 16 + fr; const size_t prow = (size_t)u.pm * 256 + rt;
#pragma unroll
                for (int bj = 0; bj < 2; ++bj) {
                    f32x4 v0 = acc[ai][bj][m][0], v1 = acc[ai][bj][m][1];
                    const int ct = bj * 128 + wc * 32 + 8 * fq;
                    if (g == 0 || g == 4) {
                        const float s = (g == 0) ? 0.08838834764831845f : 1.0f; v0 = v0 * s; v1 = v1 * s;
                        const int j = 16 * wc + 4 * fq;
                        f32x4 o1 = v0, o2 = v1;
                        if (tl != 0) { const int t = (tl - 1) * 256 + rt; const float2* cs = rope + (size_t)t * 64 + j;
#pragma unroll
                            for (int i = 0; i < 4; ++i) { const float2 c2 = cs[i]; o1[i] = v0[i] * c2.x - v1[i] * c2.y; o2[i] = v0[i] * c2.y + v1[i] * c2.x; } }
                        bf16* dst = P + prow * NPCOL + u.pn * 256 + bj * 128 + j;
                        u32x2 w1, w2; w1.x = pg8::cvt_pk_bf16(o1[0], o1[1]); w1.y = pg8::cvt_pk_bf16(o1[2], o1[3]); w2.x = pg8::cvt_pk_bf16(o2[0], o2[1]); w2.y = pg8::cvt_pk_bf16(o2[2], o2[3]);
                        *(u32x2*)dst = w1; *(u32x2*)(dst + 64) = w2;
                    } else if (g < 8) {
                        u32x4 w; w.x = pg8::cvt_pk_bf16(v0[0], v0[1]); w.y = pg8::cvt_pk_bf16(v0[2], v0[3]); w.z = pg8::cvt_pk_bf16(v1[0], v1[1]); w.w = pg8::cvt_pk_bf16(v1[2], v1[3]);
                        *(u32x4*)(P + prow * NPCOL + u.pn * 256 + ct) = w;
                    } else {
                        const size_t lrow = (size_t)b * SEQ + (size_t)(tl - 1) * 256 + rt;
#pragma unroll
                        for (int i = 0; i < 4; ++i) { v0[i] = sigmoidf_(v0[i]); v1[i] = sigmoidf_(v1[i]); }
                        u32x4 w; w.x = pg8::cvt_pk_bf16(v0[0], v0[1]); w.y = pg8::cvt_pk_bf16(v0[2], v0[3]); w.z = pg8::cvt_pk_bf16(v1[0], v1[1]); w.w = pg8::cvt_pk_bf16(v1[2], v1[3]);
                        *(u32x4*)(GATES + lrow * 2048 + (u.pn - 16) * 256 + ct) = w;
                    }
                }
            }
    }
};

__device__ __forceinline__ void phase_feat(Frame& F) {
    const int gw = F.bid * NWAVES + F.wave, NGW = F.G * NWAVES;
    { const int gt = F.bid * NTHR + F.tid, NGT = F.G * NTHR; f32x4* z = WSP(f32x4, WS_ORET); for (int i = gt; i < 2 * NT * 512 / 4; i += NGT) z[i] = (f32x4){0.f, 0.f, 0.f, 0.f}; }
    const bf16* P = WSP(bf16, WS_P);
    for (int row = gw; row < NROW; row += NGW) {
        const int pos = row % RPB; const bool isctx = pos < CTXL;
        const bool hp = isctx ? (pos > 0) : (pos > CTXL), hn = isctx ? (pos < CTXL - 1) : (pos < RPB - 1);
#pragma unroll
        for (int part = 0; part < 3; ++part) {
            if (part == 2 && isctx) continue;
            const int pc = (part == 0 ? 1024 : part == 1 ? 1536 : 3072) + 8 * F.lane; const int cc = (part == 0 ? 512 : part == 1 ? 1024 : 0) + 8 * F.lane;
            const u32x4 z4 = {0u, 0u, 0u, 0u};
            const u32x4 r0 = hp ? *(const u32x4*)(P + (size_t)(row - 1) * NPCOL + pc) : z4, r1 = *(const u32x4*)(P + (size_t)row * NPCOL + pc), r2 = hn ? *(const u32x4*)(P + (size_t)(row + 1) * NPCOL + pc) : z4;
            float a0[8], a1[8], a2[8], y[8]; unpack8(r0, a0); unpack8(r1, a1); unpack8(r2, a2); float ss = 0.f;
#pragma unroll
            for (int i = 0; i < 8; ++i) { const float cv = F.gdn_conv[cc + i] * a0[i] + F.gdn_conv[1536 + cc + i] * a1[i] + F.gdn_conv[3072 + cc + i] * a2[i]; y[i] = siluf_(cv); ss += y[i] * y[i]; }
            if (part != 1) { const float tot = sum16(ss); const float sc = (1.0f / sqrtf(tot + EPS)) * (part == 2 ? 0.08838834764831845f : 1.0f);
#pragma unroll
                for (int i = 0; i < 8; ++i) y[i] *= sc; }
            bf16* dst = part == 0 ? WSP(bf16, WS_GK) : part == 1 ? WSP(bf16, WS_GV) : WSP(bf16, WS_GQ);
            *(u32x4*)(dst + (size_t)row * 512 + 8 * F.lane) = pack8(y);
        }
    }
}
__device__ __forceinline__ void phase_seq(Frame& F) {
    LAS float* sk = (LAS float*)F.lds; LAS float* sq = sk + 128; LAS float* sv = sq + 128; LAS float* ps = sv + 128; LAS float* ps2 = ps + 512;
    const int r4 = F.tid >> 7, j = F.tid & 127;
    for (int chain = F.bid; chain < 64; chain += F.G) {
        const int mixer = chain >> 5, b = (chain >> 3) & 3, h = (chain >> 1) & 3, dir = chain & 1;
        const bf16* P = WSP(bf16, WS_P);
        const bf16* Kp = mixer ? WSP(bf16, WS_GK) + h * 128 : P + h * 128; const int kld = mixer ? 512 : NPCOL;
        const bf16* Vp = mixer ? WSP(bf16, WS_GV) + h * 128 : P + 512 + h * 128; const int vld = kld;
        const bf16* Qp = mixer ? WSP(bf16, WS_GQ) + h * 128 : P + 2048 + h * 128; const int qld = kld;
        float* O = (mixer ? WSP(float, WS_OGDN) : WSP(float, WS_ORET)) + h * 128;
        const float* la = WSP(float, WS_LOGA) + ((size_t)(dir * NB + b) * NH + h) * RPB; const float* be = WSP(float, WS_BETA) + ((size_t)(dir * NB + b) * NH + h) * RPB;
        const float gam = expf(F.ret_log_decay[dir * 4 + h]);
        float S[32];
#pragma unroll
        for (int i = 0; i < 32; ++i) S[i] = 0.f;
        for (int s = 0; s < RPB; ++s) {
            const bool isctx = s < CTXL; const int pos = isctx ? (dir ? CTXL - 1 - s : s) : CTXL + (dir ? SEQ - 1 - (s - CTXL) : (s - CTXL));
            const size_t row = (size_t)b * RPB + pos;
            if (r4 == 0) sk[j] = bf2f(Kp[row * kld + j]); else if (r4 == 1) sv[j] = bf2f(Vp[row * vld + j]); else if (r4 == 2) sq[j] = isctx ? 0.f : bf2f(Qp[row * qld + j]);
            const float a = mixer ? expf(la[pos]) : gam; const float bt = mixer ? be[pos] : 1.f;
            __syncthreads();
            float delta = sv[j];
            if (mixer) { float p = 0.f;
#pragma unroll
                for (int i = 0; i < 32; ++i) p += sk[r4 * 32 + i] * S[i];
                ps[r4 * 128 + j] = p; __syncthreads();
                const float kS = a * (ps[j] + ps[128 + j] + ps[256 + j] + ps[384 + j]); delta = bt * (sv[j] - kS); }
            float po = 0.f;
#pragma unroll
            for (int i = 0; i < 32; ++i) { S[i] = a * S[i] + sk[r4 * 32 + i] * delta; po += sq[r4 * 32 + i] * S[i]; }
            ps2[r4 * 128 + j] = po; __syncthreads();
            if (!isctx && r4 == 0) { const float o = ps2[j] + ps2[128 + j] + ps2[256 + j] + ps2[384 + j]; atomicAdd(O + ((size_t)b * SEQ + (pos - CTXL)) * 512 + j, o); }
        }
        __syncthreads();
    }
}
__device__ __forceinline__ void phase_mixnorm(Frame& F) {
    const int gw = F.bid * NWAVES + F.wave, NGW = F.G * NWAVES;
    const bf16* P = WSP(bf16, WS_P);
    for (int t = gw; t < NT; t += NGW) {
        const int b = t / SEQ, tt = t % SEQ; const size_t prow = (size_t)b * RPB + CTXL + tt; const int c0 = 8 * F.lane;
        { const float* o = WSP(float, WS_ORET) + (size_t)t * 512 + c0; const f32x4 a = *(const f32x4*)o, c = *(const f32x4*)(o + 4); float v[8] = {a.x, a.y, a.z, a.w, c.x, c.y, c.z, c.w};
          float s = 0.f;
#pragma unroll
          for (int i = 0; i < 8; ++i) s += v[i];
          const float mean = sum16(s) * (1.f / 128.f); float q = 0.f;
#pragma unroll
          for (int i = 0; i < 8; ++i) { v[i] -= mean; q += v[i] * v[i]; }
          const float rstd = 1.0f / sqrtf(sum16(q) * (1.f / 128.f) + EPS);
          float gz[8]; unpack8(*(const u32x4*)(P + prow * NPCOL + 2560 + c0), gz);
#pragma unroll
          for (int i = 0; i < 8; ++i) v[i] = v[i] * rstd * F.ret_gn_w[c0 + i] * siluf_(gz[i]);
          *(u32x4*)(WSP(bf16, WS_RETY) + (size_t)t * 512 + c0) = pack8(v); }
        { const float* o = WSP(float, WS_OGDN) + (size_t)t * 512 + c0; const f32x4 a = *(const f32x4*)o, c = *(const f32x4*)(o + 4); float v[8] = {a.x, a.y, a.z, a.w, c.x, c.y, c.z, c.w};
          float q = 0.f;
#pragma unroll
          for (int i = 0; i < 8; ++i) q += v[i] * v[i];
          const float rstd = 1.0f / sqrtf(sum16(q) * (1.f / 128.f) + EPS);
          float gz[8]; unpack8(*(const u32x4*)(P + prow * NPCOL + 3584 + c0), gz);
#pragma unroll
          for (int i = 0; i < 8; ++i) v[i] = v[i] * rstd * F.gdn_norm_w[c0 + i] * siluf_(gz[i]);
          *(u32x4*)(WSP(bf16, WS_GDNY) + (size_t)t * 512 + c0) = pack8(v); }
    }
}

struct SchedMerge {
    const char *A0, *A1, *B0, *B1; int G, c;
    __device__ __forceinline__ bool next(int i, pg8::Unit& u) const {
        const int L = (i >> 1) * G + c; if (L >= 256) return false; const int term = i & 1;
        const int xcd = L % 8, off = L / 8; const int w = xcd * 32 + off;
        u.pm = w >> 2; u.pn = w & 3; u.e = term; u.base = 0;
        u.A = (term ? A1 : A0) + (size_t)u.pm * 256 * 512 * 2; u.B = (term ? B1 : B0) + (size_t)u.pn * 256 * 512 * 2; return true; }
    __device__ __forceinline__ int row_index(const pg8::Unit&, int r) const { return r; }
};
struct EpiMerge {
    const bf16* GATES; bf16* TMP; bf16* MERGED;
    __device__ __forceinline__ void operator()(const f32x4 (&acc)[2][2][4][2], const pg8::Unit& u, int wr, int wc, int fr, int fq) const {
#pragma unroll
        for (int ai = 0; ai < 2; ++ai)
#pragma unroll
            for (int m = 0; m < 4; ++m) { const size_t row = (size_t)u.pm * 256 + ai * 128 + wr * 64 + m * 16 + fr;
#pragma unroll
                for (int bj = 0; bj < 2; ++bj) { const int col = u.pn * 256 + bj * 128 + wc * 32 + 8 * fq;
                    float g[8]; unpack8(*(const u32x4*)(GATES + row * 2048 + u.e * 1024 + col), g);
                    float v[8] = {acc[ai][bj][m][0][0], acc[ai][bj][m][0][1], acc[ai][bj][m][0][2], acc[ai][bj][m][0][3], acc[ai][bj][m][1][0], acc[ai][bj][m][1][1], acc[ai][bj][m][1][2], acc[ai][bj][m][1][3]};
                    if (u.e == 0) {
#pragma unroll
                        for (int i = 0; i < 8; ++i) v[i] *= g[i];
                        *(u32x4*)(TMP + row * DM + col) = pack8(v);
                    } else { float p[8]; unpack8(*(const u32x4*)(TMP + row * DM + col), p);
#pragma unroll
                        for (int i = 0; i < 8; ++i) v[i] = p[i] + v[i] * g[i];
                        *(u32x4*)(MERGED + row * DM + col) = pack8(v); } } }
    }
};
struct SchedDense {
    const char *A, *B; int nM, nN, K, G, c;
    __device__ __forceinline__ bool next(int i, pg8::Unit& u) const {
        const int L = i * G + c; const int nwg = nM * nN; if (L >= nwg) return false;
        int w = L; if (nwg % 8 == 0) { const int xcd = L % 8, off = L / 8; w = xcd * (nwg / 8) + off; }
        u.pm = w / nN; u.pn = w % nN; u.e = 0; u.base = 0; u.A = A + (size_t)u.pm * 256 * K * 2; u.B = B + (size_t)u.pn * 256 * K * 2; return true; }
    __device__ __forceinline__ int row_index(const pg8::Unit&, int r) const { return r; }
};
struct EpiBf16Store { bf16* O; int ldc;
    __device__ __forceinline__ void operator()(const f32x4 (&acc)[2][2][4][2], const pg8::Unit& u, int wr, int wc, int fr, int fq) const {
#pragma unroll
        for (int ai = 0; ai < 2; ++ai)
#pragma unroll
            for (int m = 0; m < 4; ++m) { const size_t row = (size_t)u.pm * 256 + ai * 128 + wr * 64 + m * 16 + fr;
#pragma unroll
                for (int bj = 0; bj < 2; ++bj) { const int col = u.pn * 256 + bj * 128 + wc * 32 + 8 * fq; const f32x4 v0 = acc[ai][bj][m][0], v1 = acc[ai][bj][m][1];
                    u32x4 w; w.x = pg8::cvt_pk_bf16(v0[0], v0[1]); w.y = pg8::cvt_pk_bf16(v0[2], v0[3]); w.z = pg8::cvt_pk_bf16(v1[0], v1[1]); w.w = pg8::cvt_pk_bf16(v1[2], v1[3]);
                    *(u32x4*)(O + row * ldc + col) = w; } }
    }
};

__device__ __forceinline__ void load_row_bf16(const bf16* p, int lane, float (&v)[16]) { float a[8], b[8]; unpack8(*(const u32x4*)(p + 8 * lane), a); unpack8(*(const u32x4*)(p + 512 + 8 * lane), b);
#pragma unroll
    for (int i = 0; i < 8; ++i) { v[i] = a[i]; v[8 + i] = b[i]; } }
__device__ __forceinline__ void load_row_f32(const float* p, int lane, float (&v)[16]) {
#pragma unroll
    for (int q = 0; q < 4; ++q) { const f32x4 a = *(const f32x4*)(p + (q >> 1) * 512 + 8 * lane + 4 * (q & 1)); v[4 * q] = a.x; v[4 * q + 1] = a.y; v[4 * q + 2] = a.z; v[4 * q + 3] = a.w; } }
__device__ __forceinline__ void store_row_f32(float* p, int lane, const float (&v)[16]) {
#pragma unroll
    for (int q = 0; q < 4; ++q) *(f32x4*)(p + (q >> 1) * 512 + 8 * lane + 4 * (q & 1)) = (f32x4){v[4 * q], v[4 * q + 1], v[4 * q + 2], v[4 * q + 3]}; }
__device__ __forceinline__ void compute_x1(Frame& F, int t, float (&x1)[16]) {
    const int b = t / SEQ; const float* mod = WSP(float, WS_MOD) + b * 6144;
    float mo[16], xv[16], wv[16], g1[16]; load_row_bf16(WSP(bf16, WS_MO) + (size_t)t * DM, F.lane, mo); load_row_f32(F.x + (size_t)t * DM, F.lane, xv);
    load_row_f32(F.n_mix_post, F.lane, wv); load_row_f32(mod + 2 * DM, F.lane, g1);
    float ss = 0.f;
#pragma unroll
    for (int i = 0; i < 16; ++i) ss += mo[i] * mo[i];
    const float rstd = 1.0f / sqrtf(wave_sum(ss) * (1.f / DM) + EPS);
#pragma unroll
    for (int i = 0; i < 16; ++i) x1[i] = xv[i] + g1[i] * (mo[i] * rstd * wv[i]);
}
__device__ __forceinline__ void phase_route(Frame& F) {
    const int gw = F.bid * NWAVES + F.wave, NGW = F.G * NWAVES;
    LAS float* hs = (LAS float*)(F.lds + F.wave * 4096);
    unsigned* cnt = F.ctl + CW_CNT; int* list = WSP(int, WS_LIST); float* selw = WSP(float, WS_SELW);
    for (int t = gw; t < NT; t += NGW) {
        const int b = t / SEQ; const float* mod = WSP(float, WS_MOD) + b * 6144;
        float x1[16]; compute_x1(F, t, x1);
        float ss = 0.f;
#pragma unroll
        for (int i = 0; i < 16; ++i) ss += x1[i] * x1[i];
        const float rstd = 1.0f / sqrtf(wave_sum(ss) * (1.f / DM) + EPS);
        float wv[16], sh[16], sc[16], h2[16]; load_row_f32(F.n_ffn_pre, F.lane, wv); load_row_f32(mod + 3 * DM, F.lane, sh); load_row_f32(mod + 4 * DM, F.lane, sc);
#pragma unroll
        for (int i = 0; i < 16; ++i) h2[i] = x1[i] * rstd * wv[i] * (1.f + sc[i]) + sh[i];
        { float a[8], c[8];
#pragma unroll
          for (int i = 0; i < 8; ++i) { a[i] = h2[i]; c[i] = h2[8 + i]; }
          bf16* d = WSP(bf16, WS_H2) + (size_t)t * DM; *(u32x4*)(d + 8 * F.lane) = pack8(a); *(u32x4*)(d + 512 + 8 * F.lane) = pack8(c); }
#pragma unroll
        for (int i = 0; i < 8; ++i) { hs[8 * F.lane + i] = h2[i]; hs[512 + 8 * F.lane + i] = h2[8 + i]; }
        asm volatile("s_waitcnt lgkmcnt(0)" ::: "memory");
        float lg0 = 0.f, lg1 = 0.f, lg2 = 0.f, lg3 = 0.f;
        for (int k = 0; k < DM; k += 4) { const f32x4 hv = *(const LAS f32x4*)(hs + k);
            lg0 += hv.x * F.w_router[(size_t)k * NEXP + F.lane]; lg1 += hv.y * F.w_router[(size_t)(k + 1) * NEXP + F.lane]; lg2 += hv.z * F.w_router[(size_t)(k + 2) * NEXP + F.lane]; lg3 += hv.w * F.w_router[(size_t)(k + 3) * NEXP + F.lane]; }
        const float logit = (lg0 + lg1) + (lg2 + lg3);
        const float score = 1.f / (1.f + expf(-logit)); const float biased = score + F.router_bias[F.lane];
        int rk = 0;
#pragma unroll
        for (int o = 0; o < 8; ++o) { const int src = (F.lane & ~7) | o; const float ov = __shfl(biased, src); rk += (ov > biased || (ov == biased && src < F.lane)) ? 1 : 0; }
        float gs = rk < 2 ? biased : 0.f; gs += __shfl_xor(gs, 1); gs += __shfl_xor(gs, 2); gs += __shfl_xor(gs, 4);
        int grk = 0; const int myg = F.lane >> 3;
#pragma unroll
        for (int o = 0; o < 8; ++o) { const float ov = __shfl(gs, o * 8); grk += (ov > gs || (ov == gs && o < myg)) ? 1 : 0; }
        const bool keep = grk < 4;
        const float cand = keep ? biased : -__builtin_inff();
        int erk = 0;
        for (int o = 0; o < 64; ++o) { const float ov = __shfl(cand, o); erk += (ov > cand || (ov == cand && o < F.lane)) ? 1 : 0; }
        const bool sel = keep && erk < TOPK;
        const float ssum = wave_sum(sel ? score : 0.f);
        if (sel) { const float w = score / ssum * 2.5f; const unsigned pos = atomicAdd(cnt + F.lane, 1u);
            list[(size_t)F.lane * NT + pos] = t * 8 + erk; selw[t * 8 + erk] = w; }
    }
}

__device__ __forceinline__ void build_tile_prefix(Frame& F, LAS int* tp) {
    __syncthreads();
    if (F.tid == 0) { int s = 0; const unsigned* cnt = F.ctl + CW_CNT; for (int e = 0; e < 64; ++e) { tp[e] = s; s += ((int)__hip_atomic_load(cnt + e, __ATOMIC_RELAXED, __HIP_MEMORY_SCOPE_AGENT) + 255) >> 8; } tp[64] = s; tp[65] = s + 64; }
    __syncthreads();
}
struct SchedMoe {
    const char* A; const char* B; const int* list; const unsigned* cnt; const LAS int* tp; int npn, K, G, c; size_t bstride  ; int bcol0  ; bool gather;
    __device__ __forceinline__ bool next(int i, pg8::Unit& u) const {
        const int L = i * G + c; const int ntile = __builtin_amdgcn_readfirstlane(tp[65]); if (L >= ntile * npn) return false;
        const int tile = L / npn; u.pn = L % npn; int e = 0;
        for (int q = 64; q >= 1; q >>= 1) if (e + q <= 64 && __builtin_amdgcn_readfirstlane(tp[e + q]) <= tile) e += q;
        e = __builtin_amdgcn_readfirstlane(e);
        u.e = e; u.pm = tile - __builtin_amdgcn_readfirstlane(tp[e]); u.base = (e < 64 ? tile * 256 : SLOT_SH + u.pm * 256);
        u.A = gather ? A : A + (size_t)u.base * K * 2; u.B = B + (size_t)e * bstride + (size_t)(bcol0 + u.pn * 256) * K * 2; return true; }
    __device__ __forceinline__ int row_index(const pg8::Unit& u, int r) const {
        if (u.e == 64) return u.pm * 256 + r;
        const int n = (int)cnt[u.e]; int idx = u.pm * 256 + r; if (idx >= n) idx = 0; return list[(size_t)u.e * NT + idx] >> 3; }
};
struct EpiUp { bf16* HMID;
    __device__ __forceinline__ void operator()(const f32x4 (&acc)[2][2][4][2], const pg8::Unit& u, int wr, int wc, int fr, int fq) const {
#pragma unroll
        for (int ai = 0; ai < 2; ++ai)
#pragma unroll
            for (int m = 0; m < 4; ++m) { const size_t slot = (size_t)u.base + ai * 128 + wr * 64 + m * 16 + fr;
#pragma unroll
                for (int bj = 0; bj < 2; ++bj) { const int hid = u.pn * 128 + bj * 64 + wc * 16 + fq * 4; const f32x4 g = acc[ai][bj][m][0], up = acc[ai][bj][m][1];
                    u32x2 w; w.x = pg8::cvt_pk_bf16(siluf_(g[0]) * up[0], siluf_(g[1]) * up[1]); w.y = pg8::cvt_pk_bf16(siluf_(g[2]) * up[2], siluf_(g[3]) * up[3]);
                    *(u32x2*)(HMID + slot * DEXP + hid) = w; } }
    }
};
struct EpiDown { bf16* YB; float* OUT; const int* list; const float* selw; const unsigned* cnt; int half;
    __device__ __forceinline__ void operator()(const f32x4 (&acc)[2][2][4][2], const pg8::Unit& u, int wr, int wc, int fr, int fq) const {
        const int n = u.e < 64 ? (int)cnt[u.e] : 0;
#pragma unroll
        for (int ai = 0; ai < 2; ++ai)
#pragma unroll
            for (int m = 0; m < 4; ++m) { const int r = ai * 128 + wr * 64 + m * 16 + fr; const int idx = u.pm * 256 + r;
                if (u.e == 64) { float* o = OUT + (size_t)idx * DM + half * 512 + u.pn * 256 + wc * 32 + 8 * fq;
#pragma unroll
                    for (int bj = 0; bj < 2; ++bj) { *(f32x4*)(o + bj * 128) = acc[ai][bj][m][0]; *(f32x4*)(o + bj * 128 + 4) = acc[ai][bj][m][1]; } }
                else if (idx < n) { const int dst = list[(size_t)u.e * NT + idx]; const float w = selw[dst]; bf16* o = YB + (size_t)dst * 512 + u.pn * 256 + wc * 32 + 8 * fq;
#pragma unroll
                    for (int bj = 0; bj < 2; ++bj) { const f32x4 v0 = acc[ai][bj][m][0] * w, v1 = acc[ai][bj][m][1] * w;
                        u32x4 q; q.x = pg8::cvt_pk_bf16(v0[0], v0[1]); q.y = pg8::cvt_pk_bf16(v0[2], v0[3]); q.z = pg8::cvt_pk_bf16(v1[0], v1[1]); q.w = pg8::cvt_pk_bf16(v1[2], v1[3]);
                        *(u32x4*)(o + bj * 128) = q; } } }
    }
};
__device__ __forceinline__ void phase_combine(Frame& F, int half) {
    const int gw = F.bid * NWAVES + F.wave, NGW = F.G * NWAVES; const bf16* YB = WSP(bf16, WS_YB);
    for (int t = gw; t < NT; t += NGW) {
        float* o = F.out + (size_t)t * DM + half * 512 + 8 * F.lane; f32x4 a = *(const f32x4*)o, c = *(const f32x4*)(o + 4);
#pragma unroll
        for (int k = 0; k < 8; ++k) { float v[8]; unpack8(*(const u32x4*)(YB + ((size_t)t * 8 + k) * 512 + 8 * F.lane), v); a.x += v[0]; a.y += v[1]; a.z += v[2]; a.w += v[3]; c.x += v[4]; c.y += v[5]; c.z += v[6]; c.w += v[7]; }
        *(f32x4*)o = a; *(f32x4*)(o + 4) = c;
    }
}
__device__ __forceinline__ void phase_final(Frame& F) {
    const int gw = F.bid * NWAVES + F.wave, NGW = F.G * NWAVES; const bf16* YB = WSP(bf16, WS_YB);
    for (int t = gw; t < NT; t += NGW) {
        const int b = t / SEQ; const float* mod = WSP(float, WS_MOD) + b * 6144;
        float mv[16]; load_row_f32(F.out + (size_t)t * DM, F.lane, mv);
#pragma unroll
        for (int k = 0; k < 8; ++k) { float v[8]; unpack8(*(const u32x4*)(YB + ((size_t)t * 8 + k) * 512 + 8 * F.lane), v);
#pragma unroll
            for (int i = 0; i < 8; ++i) mv[8 + i] += v[i]; }
        float ss = 0.f;
#pragma unroll
        for (int i = 0; i < 16; ++i) ss += mv[i] * mv[i];
        const float rstd = 1.0f / sqrtf(wave_sum(ss) * (1.f / DM) + EPS);
        float x1[16]; compute_x1(F, t, x1);
        float wv[16], g2[16]; load_row_f32(F.n_ffn_post, F.lane, wv); load_row_f32(mod + 5 * DM, F.lane, g2);
        float o[16];
#pragma unroll
        for (int i = 0; i < 16; ++i) o[i] = x1[i] + g2[i] * (mv[i] * rstd * wv[i]);
        store_row_f32(F.out + (size_t)t * DM, F.lane, o);
    }
}

constexpr int N_PHASES = 16;
__global__ void __launch_bounds__(NTHR, 2) fwd(Args args) {
    extern __shared__ __attribute__((aligned(16))) unsigned char lds_raw[];
    Frame F; F.lds = (LAS unsigned char*)lds_raw; F.tid = threadIdx.x; F.lane = F.tid & 63; F.wave = __builtin_amdgcn_readfirstlane(F.tid >> 6); F.G = gridDim.x; F.bid = blockIdx.x;
    F.x = args.in[0]; F.c = args.in[1]; F.ctx = args.in[2]; F.c_ctx = args.in[3]; F.w_mod = args.in[4]; F.b_mod = args.in[5]; F.n_mix_pre = args.in[6]; F.n_mix_post = args.in[7];
    F.n_ffn_pre = args.in[8]; F.n_ffn_post = args.in[9]; F.w_in = args.in[10]; F.gdn_conv = args.in[11]; F.ret_log_decay = args.in[12]; F.gdn_a_log = args.in[13]; F.gdn_dt_bias = args.in[14];
    F.ret_gn_w = args.in[15]; F.gdn_norm_w = args.in[16]; F.w_ret_out = args.in[17]; F.w_gdn_out = args.in[18]; F.w_o = args.in[19]; F.w_router = args.in[20]; F.router_bias = args.in[21];
    F.w_gate = args.in[22]; F.w_up = args.in[23]; F.w_down = args.in[24]; F.w_sh_gate = args.in[25]; F.w_sh_up = args.in[26]; F.w_sh_down = args.in[27];
    F.out = args.out; F.ws = args.ws; F.ctl = (unsigned*)(args.ws + WS_CTL);
    volatile LAS unsigned* MISC = (volatile LAS unsigned*)(F.lds + MISC_OFF);
    if (F.tid < 64) MISC[F.tid] = 0u;
    __syncthreads();
#if MK_ONE_LAUNCH
    XcdBarrier bar = xcd_barrier_post(F.ctl + CW_BAR, MISC + 8);
#define SEAM() xcd_barrier(bar)
#else
#define SEAM() do {} while (0)
#endif
    const int lo = args.ph_lo, hi = args.ph_hi;
#ifndef PHM
#define PHM 0xffff
#endif
#define IN(k) (((PHM >> (k)) & 1) && lo <= (k) && (k) < hi)
    LAS int* tp = (LAS int*)(F.lds + MISC_OFF + 256);

    if (IN(0)) { phase_prologue(F); SEAM(); }
    if (IN(1)) { phase_norm1(F); SEAM(); }
    if (IN(2)) {
        SchedIn S{(const char*)WSP(bf16, WS_HX), (const char*)WSP(bf16, WS_WIN), F.G, F.bid};
        EpiIn E{WSP(bf16, WS_P), (bf16*)F.out, WSP(float2, WS_ROPE)};
        pg8::gemm_phase<EpiIn, SchedIn, false, SP2>(F.lds, DM, S, E); SEAM();
    }
    if (IN(3)) { phase_feat(F); SEAM(); }
    if (IN(4)) { phase_seq(F); SEAM(); }
    if (IN(5)) { phase_mixnorm(F); SEAM(); }
    if (IN(6)) {
        SchedMerge S{(const char*)WSP(bf16, WS_RETY), (const char*)WSP(bf16, WS_GDNY), (const char*)WSP(bf16, WS_WRO), (const char*)WSP(bf16, WS_WGO), F.G, F.bid};
        EpiMerge E{(const bf16*)F.out, WSP(bf16, WS_TMP), WSP(bf16, WS_MERGED)};
        pg8::gemm_phase<EpiMerge, SchedMerge, false, SP2>(F.lds, 512, S, E);
        phase_moe_weights(F); SEAM();
    }
    if (IN(7)) {
        SchedDense S{(const char*)WSP(bf16, WS_MERGED), (const char*)WSP(bf16, WS_WO), 64, 4, DM, F.G, F.bid};
        EpiBf16Store E{WSP(bf16, WS_MO), DM};
        pg8::gemm_phase<EpiBf16Store, SchedDense, false, SP2>(F.lds, DM, S, E); SEAM();
    }
    if (IN(8)) { phase_route(F); SEAM(); }
    if (IN(9)) {
        build_tile_prefix(F, tp);
        SchedMoe S{(const char*)WSP(bf16, WS_H2), (const char*)WSP(bf16, WS_WGU), WSP(int, WS_LIST), F.ctl + CW_CNT, tp, 2, DM, F.G, F.bid, (size_t)512 * DM * 2, 0, true};
        EpiUp E{WSP(bf16, WS_HMID)};
        pg8::gemm_phase<EpiUp, SchedMoe, true, SP2>(F.lds, DM, S, E); SEAM();
    }
    if (IN(10)) {
        build_tile_prefix(F, tp);
        SchedMoe S{(const char*)WSP(bf16, WS_HMID), (const char*)WSP(bf16, WS_WD), WSP(int, WS_LIST), F.ctl + CW_CNT, tp, 2, DEXP, F.G, F.bid, (size_t)DM * DEXP * 2, 0, false};
        EpiDown E{WSP(bf16, WS_YB), F.out, WSP(int, WS_LIST), WSP(float, WS_SELW), F.ctl + CW_CNT, 0};
        pg8::gemm_phase<EpiDown, SchedMoe, false, SP2>(F.lds, DEXP, S, E); SEAM();
    }
    if (IN(11)) { phase_combine(F, 0); SEAM(); }
    if (IN(12)) {
        build_tile_prefix(F, tp);
        SchedMoe S{(const char*)WSP(bf16, WS_HMID), (const char*)WSP(bf16, WS_WD), WSP(int, WS_LIST), F.ctl + CW_CNT, tp, 2, DEXP, F.G, F.bid, (size_t)DM * DEXP * 2, 512, false};
        EpiDown E{WSP(bf16, WS_YB), F.out, WSP(int, WS_LIST), WSP(float, WS_SELW), F.ctl + CW_CNT, 1};
        pg8::gemm_phase<EpiDown, SchedMoe, false, SP2>(F.lds, DEXP, S, E); SEAM();
    }
    if (IN(13)) { phase_final(F); }
#undef IN
}

extern "C" void kernel_launch(void* const* d_in, const int* in_sizes, int n_in, void* d_out, int out_size, void* d_ws, size_t ws_size, hipStream_t stream) {
    static int grid = 0;
    if (grid == 0) {
        if (n_in != 28 || in_sizes[0] != NT * DM || out_size != NT * DM || ws_size < 314 * MiB) { fprintf(stderr, "kernel_launch: unexpected shapes / workspace (%d inputs, ws %zu)\n", n_in, ws_size); grid = -1; return; }
        int dev = 0, cus = 0;
        if (hipGetDevice(&dev) != hipSuccess || hipDeviceGetAttribute(&cus, hipDeviceAttributeMultiprocessorCount, dev) != hipSuccess) { grid = -1; return; }
        if (hipFuncSetAttribute((const void*)fwd, hipFuncAttributeMaxDynamicSharedMemorySize, LDS_BYTES) != hipSuccess) { fprintf(stderr, "kernel_launch: hipFuncSetAttribute failed\n"); grid = -1; return; }
        int per_cu = 0; (void)hipOccupancyMaxActiveBlocksPerMultiprocessor(&per_cu, (const void*)fwd, NTHR, LDS_BYTES); (void)hipGetLastError();
        if (per_cu < 1) fprintf(stderr, "kernel_launch: occupancy query says %d\n", per_cu);
        grid = cus;
    }
    if (grid < 0) return;
    (void)hipMemsetAsync((char*)d_ws + WS_CTL, 0, CTL_BYTES, stream);
    Args a{};
    for (int i = 0; i < 28; ++i) a.in[i] = (const float*)d_in[i];
    a.out = (float*)d_out; a.ws = (unsigned char*)d_ws;
#if MK_ONE_LAUNCH
    a.ph_lo = 0; a.ph_hi = N_PHASES;
    hipLaunchKernelGGL(fwd, dim3(grid), dim3(NTHR), LDS_BYTES, stream, a);
#else
    for (int p = 0; p < 14; ++p) { a.ph_lo = p; a.ph_hi = p + 1; hipLaunchKernelGGL(fwd, dim3(grid), dim3(NTHR), LDS_BYTES, stream, a); }
#endif
}
```

```cpp
#include <hip/hip_runtime.h>
#include <cstdio>
#include <cstdint>

#ifndef MK_ONE_LAUNCH
#define MK_ONE_LAUNCH 1
#endif
#ifndef MK_REF_GEMM
#define MK_REF_GEMM 0
#endif

constexpr int NB = 4, SEQ = 4096, DM = 1024, CTXL = 256, RPB = SEQ + CTXL  , NROW = NB * RPB  , NT = NB * SEQ  ;
constexpr int NH = 4, HD = 128, CH = 128, NCHUNK = RPB / CH  ;
constexpr int N_STATE = 2064, N_IN = 6160, NEXP = 64, TOPK = 8, DEXP = 256;
constexpr float EPS = 1e-6f;
constexpr int NPCOL = 4096;
constexpr int SLOT_SH = 147456;
constexpr int NSLOT = SLOT_SH + NT;

constexpr size_t MiB = 1u << 20;
constexpr size_t WS_CTL = 0, CTL_BYTES = 1 * MiB;
constexpr size_t WS_MOD = 1 * MiB;
constexpr size_t WS_ROPE = 2 * MiB;
constexpr size_t WS_LOGA = 4 * MiB;
constexpr size_t WS_BETA = 5 * MiB;
constexpr size_t WS_WRO = 6 * MiB, WS_WGO = 7 * MiB, WS_WO = 8 * MiB;
constexpr size_t WS_P = 10 * MiB;
constexpr size_t WS_HX = 146 * MiB;
constexpr size_t WS_GK = WS_HX, WS_GV = WS_HX + 17 * MiB;
constexpr size_t WS_CH = 180 * MiB;
constexpr size_t WS_WIN = WS_CH;
constexpr size_t WS_ORET = WS_CH, WS_OGDN = WS_CH + 32 * MiB, WS_GQ = WS_CH + 64 * MiB;
constexpr size_t WS_RETY = 282 * MiB, WS_GDNY = 298 * MiB;
constexpr size_t WS_YB = 10 * MiB;
constexpr size_t WS_WGU = 10 * MiB;
constexpr size_t WS_H2 = 75 * MiB;
constexpr size_t WS_WD = 138 * MiB;
constexpr size_t WS_HMID = 171 * MiB;
constexpr size_t WS_TMP = 171 * MiB, WS_MERGED = 203 * MiB;
constexpr size_t WS_MO = 251 * MiB;
constexpr size_t WS_LIST = 283 * MiB;
constexpr size_t WS_SELW = 287 * MiB;
constexpr size_t WS_END = 288 * MiB;
static_assert(WS_RETY + 32 * MiB <= 319 * MiB, "ws budget");
constexpr int CW_BAR = 1024;
constexpr int CW_CNT = 8192;

#define GAS __attribute__((address_space(1)))
#define LAS __attribute__((address_space(3)))
typedef unsigned short bf16;
typedef float f32x4 __attribute__((ext_vector_type(4)));
typedef float f32x2 __attribute__((ext_vector_type(2)));
typedef short bf16x8 __attribute__((ext_vector_type(8)));
typedef unsigned u32x4 __attribute__((ext_vector_type(4)));
typedef unsigned u32x2 __attribute__((ext_vector_type(2)));
__device__ __forceinline__ unsigned f2bf(float f) { unsigned u = __builtin_bit_cast(unsigned, f); return (u + 0x7fffu + ((u >> 16) & 1u)) >> 16; }
__device__ __forceinline__ unsigned pk2(float lo, float hi) { return f2bf(lo) | (f2bf(hi) << 16); }
__device__ __forceinline__ float bf2f(unsigned b) { return __builtin_bit_cast(float, b << 16); }
__device__ __forceinline__ float bflo(unsigned w) { return __builtin_bit_cast(float, w << 16); }
__device__ __forceinline__ float bfhi(unsigned w) { return __builtin_bit_cast(float, w & 0xffff0000u); }
__device__ __forceinline__ float sigmoidf_(float x) { return 1.f / (1.f + __expf(-x)); }
__device__ __forceinline__ float siluf_(float x) { return x / (1.f + __expf(-x)); }
__device__ __forceinline__ float wave_sum(float v) {
#pragma unroll
    for (int o = 1; o < 64; o <<= 1) v += __shfl_xor(v, o);
    return v;
}
__device__ __forceinline__ float sum16(float v) {
#pragma unroll
    for (int o = 1; o < 16; o <<= 1) v += __shfl_xor(v, o);
    return v;
}
__device__ __forceinline__ void unpack8(const u32x4 w, float (&o)[8]) {
    o[0] = bflo(w.x); o[1] = bfhi(w.x); o[2] = bflo(w.y); o[3] = bfhi(w.y); o[4] = bflo(w.z); o[5] = bfhi(w.z); o[6] = bflo(w.w); o[7] = bfhi(w.w);
}
__device__ __forceinline__ u32x4 pack8(const float (&v)[8]) { u32x4 w; w.x = pk2(v[0], v[1]); w.y = pk2(v[2], v[3]); w.z = pk2(v[4], v[5]); w.w = pk2(v[6], v[7]); return w; }

namespace pg8 {
constexpr int BM = 256, BK = 64, HALF = 128, HTB = HALF * BK * 2, STAGE_BYTES = 8 * HTB;
__host__ __device__ __forceinline__ int lds_byte(int r, int c) { const int st = (r >> 4) * 2 + (c >> 5), rr = r & 15, cc = c & 31, ob = rr * 64 + cc * 2; return st * 1024 + (ob ^ (((ob >> 9) & 1) << 5)); }
__host__ __device__ __forceinline__ void stage_rc(int b, int& R, int& C) { const int st = b / 1024, sb = b % 1024, swz = sb ^ (((sb >> 9) & 1) << 5); R = (st >> 1) * 16 + swz / 64; C = (st & 1) * 32 + (swz % 64) / 2; }
__host__ __device__ __forceinline__ int perm32(int rho) { const int n = rho >> 4, i = rho & 15; return 8 * (i >> 2) + 4 * n + (i & 3); }
__device__ __forceinline__ unsigned cvt_pk_bf16(float lo, float hi) { unsigned r; asm volatile("v_cvt_pk_bf16_f32 %0, %1, %2" : "=v"(r) : "v"(lo), "v"(hi)); return r; }

struct Unit { const char* A; const char* B; int pm, pn, e, base; };

template <class Epi, class Sched, bool GATHER, bool SP2>
__device__ __forceinline__ void gemm_phase(LAS unsigned char* lds, const int K, const Sched& S, const Epi& E) {
#if MK_REF_GEMM
    {
        const int tid = threadIdx.x, wid = tid >> 6, lane = tid & 63, wr = wid >> 2, wc = wid & 3, fr = lane & 15, fq = lane >> 4;
        Unit cur;
        for (int ui = 0; S.next(ui, cur); ++ui) {
            f32x4 acc[2][2][4][2];
            for (int ai = 0; ai < 2; ++ai) for (int m = 0; m < 4; ++m) {
                const int r = 128 * ai + 64 * wr + 16 * m + fr;
                const bf16* arow = GATHER ? (const bf16*)cur.A + (size_t)S.row_index(cur, r) * K : (const bf16*)cur.A + (size_t)r * K;
                for (int bj = 0; bj < 2; ++bj) for (int n = 0; n < 2; ++n) {
                    f32x4 a4 = {0.f, 0.f, 0.f, 0.f};
                    for (int i = 0; i < 4; ++i) { const int c = 128 * bj + 32 * wc + 8 * fq + 4 * n + i; const bf16* brow = (const bf16*)cur.B + (size_t)c * K;
                        float s = 0.f; for (int k = 0; k < K; ++k) s += bf2f(arow[k]) * bf2f(brow[k]); a4[i] = s; }
                    acc[ai][bj][m][n] = a4; } }
            E(acc, cur, wr, wc, fr, fq);
        }
        return;
    }
#else
    const int tid = threadIdx.x, wid = __builtin_amdgcn_readfirstlane(tid >> 6), lane = tid & 63, wr = wid >> 2, wc = wid & 3, fr = lane & 15, fq = lane >> 4;
    const int nt = K / BK;
    unsigned voffA[2], voffB[2]; int gR = 0, gC = 0;
#pragma unroll
    for (int i = 0; i < 2; ++i) { int R, C; stage_rc(tid * 16 + i * 8192, R, C); const int Rb = (R & ~31) + perm32(R & 31);
        voffA[i] = (unsigned)(R * K + C) * 2u; voffB[i] = (unsigned)(Rb * K + C) * 2u; if (i == 0) { gR = R; gC = C; } }
    const size_t kstep = (size_t)(BK * 2);
    const size_t hstep = (size_t)HALF * K * 2;
    const unsigned ldsw = (unsigned)wid * 1024u;
    const int aoff = lds_byte(wr * 64 + fr, fq * 8), boff = lds_byte(wc * 32 + fr, fq * 8);
#define PG8_SA(b, h) (((b) * 2 + (h)) * HTB)
#define PG8_SB(b, h) ((4 + (b) * 2 + (h)) * HTB)
#define PG8_STAGE(bufoff, gbase, voff) do { _Pragma("unroll") for (int _i = 0; _i < 2; ++_i) \
        __builtin_amdgcn_global_load_lds((const unsigned*)((const char*)(gbase) + (voff)[_i]), (LAS unsigned*)(lds + (bufoff) + ldsw + _i * 8192), 16, 0, 0); } while (0)
#define PG8_STAGE_A(bufoff, gbase, h, G) do { if constexpr (GATHER) { PG8_STAGE(bufoff, gbase, (G)[h]); } else { PG8_STAGE(bufoff, (gbase) + (h) * hstep, voffA); } } while (0)
#define PG8_LDA(dst, b, h) do { _Pragma("unroll") for (int m = 0; m < 4; ++m) _Pragma("unroll") for (int k = 0; k < 2; ++k) dst[m][k] = *(const LAS bf16x8*)(lds + PG8_SA(b, h) + aoff + m * 2048 + k * 1024); } while (0)
#define PG8_LDB(dst, b, h) do { _Pragma("unroll") for (int n = 0; n < 2; ++n) _Pragma("unroll") for (int k = 0; k < 2; ++k) dst[n][k] = *(const LAS bf16x8*)(lds + PG8_SB(b, h) + boff + n * 2048 + k * 1024); } while (0)
#define PG8_MMA(ai, bj, At, Bt) do { __builtin_amdgcn_s_setprio(1); _Pragma("unroll") for (int m = 0; m < 4; ++m) _Pragma("unroll") for (int n = 0; n < 2; ++n) _Pragma("unroll") for (int k = 0; k < 2; ++k) \
        acc[ai][bj][m][n] = __builtin_amdgcn_mfma_f32_16x16x32_bf16(Bt[n][k], At[m][k], acc[ai][bj][m][n], 0, 0, 0); __builtin_amdgcn_s_setprio(0); } while (0)
#define PG8_WAIT_V(n) asm volatile("s_waitcnt vmcnt(" #n ")" ::: "memory")
#define PG8_WAIT_L(n) asm volatile("s_waitcnt lgkmcnt(" #n ")" ::: "memory")
#define PG8_BAR __builtin_amdgcn_s_barrier()
#define PG8_SCHED __builtin_amdgcn_sched_barrier(0)
    Unit cur, nxt; int ui = 0;
    if (!S.next(0, cur)) return;
    f32x4 acc[2][2][4][2];
#pragma unroll
    for (int a = 0; a < 2; ++a)
#pragma unroll
        for (int b = 0; b < 2; ++b)
#pragma unroll
            for (int m = 0; m < 4; ++m)
#pragma unroll
                for (int n = 0; n < 2; ++n) acc[a][b][m][n] = (f32x4){0.f, 0.f, 0.f, 0.f};
    bf16x8 At[4][2], B0[2][2], B1[2][2];
    const char* cA = cur.A; const char* cB = cur.B;
    unsigned cG[2][2] = {{0u, 0u}, {0u, 0u}}, nG[2][2] = {{0u, 0u}, {0u, 0u}};
    if constexpr (GATHER) {
#pragma unroll
        for (int h = 0; h < 2; ++h)
#pragma unroll
            for (int i = 0; i < 2; ++i) cG[h][i] = ((unsigned)S.row_index(cur, 128 * h + gR + 64 * i) * (unsigned)K + (unsigned)gC) * 2u;
    }
    if constexpr (SP2) {
        PG8_STAGE(PG8_SB(0, 0), cB, voffB); PG8_STAGE(PG8_SB(0, 1), cB + hstep, voffB); PG8_STAGE_A(PG8_SA(0, 0), cA, 0, cG); PG8_STAGE_A(PG8_SA(0, 1), cA, 1, cG);
        if (wr == 1) PG8_BAR;
        PG8_WAIT_V(2); PG8_BAR;
        PG8_STAGE(PG8_SB(1, 0), cB + kstep, voffB); PG8_STAGE_A(PG8_SA(1, 0), cA + kstep, 0, cG); PG8_STAGE(PG8_SB(1, 1), cB + hstep + kstep, voffB);
        PG8_WAIT_V(6); PG8_BAR;
    } else {
        PG8_STAGE(PG8_SB(0, 0), cB, voffB); PG8_STAGE_A(PG8_SA(0, 0), cA, 0, cG); PG8_STAGE(PG8_SB(0, 1), cB + hstep, voffB); PG8_STAGE_A(PG8_SA(0, 1), cA, 1, cG);
        if (wr == 1) PG8_BAR;
        PG8_WAIT_V(4); PG8_BAR;
        PG8_STAGE(PG8_SB(1, 0), cB + kstep, voffB); PG8_STAGE_A(PG8_SA(1, 0), cA + kstep, 0, cG); PG8_STAGE(PG8_SB(1, 1), cB + hstep + kstep, voffB);
        PG8_WAIT_V(6); PG8_BAR;
    }
    for (;;) {
        const bool has_next = S.next(ui + 1, nxt);
        const char* nA = has_next ? nxt.A : cA; const char* nB = has_next ? nxt.B : cB;
        for (int t = 0; t < nt; t += 2) {
            const bool last = (t == nt - 2);
            const char* a1 = cA + (size_t)(t + 1) * kstep;
            const char* a2 = last ? nA : cA + (size_t)(t + 2) * kstep; const char* b2 = last ? nB : cB + (size_t)(t + 2) * kstep;
            const char* a3 = a2 + kstep; const char* b3 = b2 + kstep;
            unsigned g2[2][2] = {{0u, 0u}, {0u, 0u}};
            if constexpr (GATHER) {
                if (last) {
                    if (has_next) {
#pragma unroll
                        for (int h = 0; h < 2; ++h)
#pragma unroll
                            for (int i = 0; i < 2; ++i) nG[h][i] = ((unsigned)S.row_index(nxt, 128 * h + gR + 64 * i) * (unsigned)K + (unsigned)gC) * 2u;
                    } else {
#pragma unroll
                        for (int h = 0; h < 2; ++h)
#pragma unroll
                            for (int i = 0; i < 2; ++i) nG[h][i] = cG[h][i];
                    }
                }
#pragma unroll
                for (int h = 0; h < 2; ++h)
#pragma unroll
                    for (int i = 0; i < 2; ++i) g2[h][i] = last ? nG[h][i] : cG[h][i];
            }
            if constexpr (SP2) {
            PG8_LDB(B0, 0, 0); PG8_LDB(B1, 0, 1); PG8_SCHED; PG8_LDA(At, 0, 0); PG8_STAGE_A(PG8_SA(1, 1), a1, 1, cG);
            PG8_WAIT_V(8); PG8_WAIT_L(0); PG8_BAR; PG8_MMA(0, 0, At, B0); PG8_MMA(0, 1, At, B1); PG8_BAR; PG8_SCHED;
            PG8_LDA(At, 0, 1); PG8_STAGE(PG8_SB(0, 0), b2, voffB); PG8_STAGE(PG8_SB(0, 1), b2 + hstep, voffB); PG8_STAGE_A(PG8_SA(0, 0), a2, 0, g2);
            PG8_WAIT_V(8); PG8_WAIT_L(0); PG8_BAR; PG8_MMA(1, 0, At, B0); PG8_MMA(1, 1, At, B1); PG8_BAR; PG8_SCHED;
            PG8_LDB(B0, 1, 0); PG8_LDB(B1, 1, 1); PG8_SCHED; PG8_LDA(At, 1, 0); PG8_STAGE_A(PG8_SA(0, 1), a2, 1, g2);
            PG8_WAIT_V(8); PG8_WAIT_L(0); PG8_BAR; PG8_MMA(0, 0, At, B0); PG8_MMA(0, 1, At, B1); PG8_BAR; PG8_SCHED;
            PG8_LDA(At, 1, 1); PG8_STAGE(PG8_SB(1, 0), b3, voffB); PG8_STAGE(PG8_SB(1, 1), b3 + hstep, voffB); PG8_STAGE_A(PG8_SA(1, 0), a3, 0, g2);
            PG8_WAIT_V(8); PG8_WAIT_L(0); PG8_BAR; PG8_MMA(1, 0, At, B0); PG8_MMA(1, 1, At, B1); PG8_BAR; PG8_SCHED;
            } else {
            PG8_LDB(B0, 0, 0); PG8_SCHED; PG8_LDA(At, 0, 0); PG8_STAGE_A(PG8_SA(1, 1), a1, 1, cG);
            PG8_WAIT_L(8); PG8_BAR; PG8_WAIT_L(0); PG8_MMA(0, 0, At, B0); PG8_BAR; PG8_SCHED;
            PG8_LDB(B1, 0, 1); PG8_STAGE(PG8_SB(0, 0), b2, voffB);
            PG8_BAR; PG8_WAIT_L(0); PG8_MMA(0, 1, At, B1); PG8_BAR;
            PG8_LDA(At, 0, 1); PG8_STAGE_A(PG8_SA(0, 0), a2, 0, g2);
            PG8_BAR; PG8_WAIT_L(0); PG8_MMA(1, 0, At, B0); PG8_BAR; PG8_SCHED;
            PG8_STAGE(PG8_SB(0, 1), b2 + hstep, voffB);
            PG8_WAIT_V(6); PG8_BAR; PG8_MMA(1, 1, At, B1); PG8_BAR;
            PG8_LDB(B0, 1, 0); PG8_SCHED; PG8_LDA(At, 1, 0); PG8_STAGE_A(PG8_SA(0, 1), a2, 1, g2);
            PG8_WAIT_L(8); PG8_BAR; PG8_WAIT_L(0); PG8_MMA(0, 0, At, B0); PG8_BAR; PG8_SCHED;
            PG8_LDB(B1, 1, 1); PG8_STAGE(PG8_SB(1, 0), b3, voffB);
            PG8_BAR; PG8_WAIT_L(0); PG8_MMA(0, 1, At, B1); PG8_BAR;
            PG8_LDA(At, 1, 1); PG8_STAGE_A(PG8_SA(1, 0), a3, 0, g2);
            PG8_BAR; PG8_WAIT_L(0); PG8_MMA(1, 0, At, B0); PG8_BAR; PG8_SCHED;
            PG8_STAGE(PG8_SB(1, 1), b3 + hstep, voffB);
            PG8_WAIT_V(6); PG8_BAR; PG8_MMA(1, 1, At, B1); PG8_BAR;
            }
        }
        if (wr == 0) PG8_BAR;
        E(acc, cur, wr, wc, fr, fq);
        if (!has_next) break;
#pragma unroll
        for (int a = 0; a < 2; ++a)
#pragma unroll
            for (int b = 0; b < 2; ++b)
#pragma unroll
                for (int m = 0; m < 4; ++m)
#pragma unroll
                    for (int n = 0; n < 2; ++n) acc[a][b][m][n] = (f32x4){0.f, 0.f, 0.f, 0.f};
        cur = nxt; cA = nA; cB = nB; ++ui;
        if constexpr (GATHER) {
#pragma unroll
            for (int h = 0; h < 2; ++h)
#pragma unroll
                for (int i = 0; i < 2; ++i) cG[h][i] = nG[h][i];
        }
        if (wr == 1) PG8_BAR;
    }
    PG8_WAIT_V(0);
    PG8_BAR;
#undef PG8_SA
#undef PG8_SB
#undef PG8_STAGE
#undef PG8_STAGE_A
#undef PG8_LDA
#undef PG8_LDB
#undef PG8_MMA
#undef PG8_WAIT_V
#undef PG8_WAIT_L
#undef PG8_BAR
#undef PG8_SCHED
#endif
}
}
constexpr bool SP2 = true;

#define XB_TMO      128
#define XB_XCNT(j)  (256  + 64 * (j))
#define XB_XSUB(j)  (1280 + 64 * (j))
#define XB_XGEN(j)  (2304 + 64 * (j))
#define XB_TOP      3328
#define XB_TOPGEN   3392
#define XCD_BAR_WORDS 3456
#define XB_SPIN_CAP (1u << 18)
__device__ __forceinline__ unsigned xb_ld(unsigned* p)              { return __hip_atomic_load(p, __ATOMIC_RELAXED, __HIP_MEMORY_SCOPE_AGENT); }
__device__ __forceinline__ unsigned xb_add(unsigned* p, unsigned v) { return __hip_atomic_fetch_add(p, v, __ATOMIC_RELAXED, __HIP_MEMORY_SCOPE_AGENT); }
__device__ __forceinline__ unsigned xb_xcc_id() { return (unsigned)__builtin_amdgcn_s_getreg((3 << 11) | 20) & 0xFu; }
#define XB_SPIN(cond, bar) do { unsigned _sp = 0; while (cond) { __builtin_amdgcn_s_sleep(1); \
    if ((++_sp & 255u) == 0u) { if (xb_ld(&(bar)[XB_TMO])) break; if (_sp > XB_SPIN_CAP) { atomicAdd(&(bar)[XB_TMO], 1u); break; } } } } while (0)
struct XcdBarrier { unsigned* bar; unsigned x; volatile LAS unsigned* st; };
__device__ __forceinline__ XcdBarrier xcd_barrier_post(unsigned* bar, volatile LAS unsigned* st) {
    XcdBarrier b; b.bar = bar; b.x = xb_xcc_id(); b.st = st;
    if (threadIdx.x == 0) (void)xb_add(&bar[XB_XCNT(b.x)], 1u);
    return b;
}
__device__ __forceinline__ void xcd_barrier_complete(unsigned* bar, unsigned x, unsigned& nloc, unsigned& nx) {
    const unsigned G = gridDim.x * gridDim.y * gridDim.z;
    unsigned sum, cnt, mine, sp = 0u;
    for (;;) {
        sum = 0u; cnt = 0u; mine = 0u;
#pragma unroll
        for (unsigned j = 0; j < 16; ++j) { const unsigned c = xb_ld(&bar[XB_XCNT(j)]); sum += c; cnt += (c > 0u) ? 1u : 0u; mine = (j == x) ? c : mine; }
        if (sum == G) break;
        __builtin_amdgcn_s_sleep(1);
        if ((++sp & 255u) == 0u) { if (xb_ld(&bar[XB_TMO])) break; if (sp > XB_SPIN_CAP) { atomicAdd(&bar[XB_TMO], 1u); break; } }
    }
    nloc = mine > 0u ? mine : 1u; nx = cnt > 0u ? cnt : 1u;
}
__device__ __forceinline__ void xcd_barrier(const XcdBarrier& b) {
    asm volatile("s_waitcnt vmcnt(0)" ::: "memory");
    __syncthreads();
    if (threadIdx.x == 0) {
        unsigned* bar = b.bar;
        __builtin_amdgcn_s_waitcnt(0);
        unsigned nloc = b.st[0], nx = b.st[1];
        if (nloc == 0u) { xcd_barrier_complete(bar, b.x, nloc, nx); b.st[0] = nloc; b.st[1] = nx; }
        const unsigned old = xb_add(&bar[XB_XSUB(b.x)], 1u);
        const unsigned gen = old / nloc;
        if (old + 1u == (gen + 1u) * nloc) {
            __builtin_amdgcn_fence(__ATOMIC_RELEASE, "agent");
            asm volatile("s_waitcnt vmcnt(0)" ::: "memory");
            const unsigned og = xb_add(&bar[XB_TOP], 1u);
            const unsigned tg = og / nx;
            if (og + 1u == (tg + 1u) * nx) xb_add(&bar[XB_TOPGEN], 1u);
            else XB_SPIN(xb_ld(&bar[XB_TOPGEN]) == tg, bar);
            __builtin_amdgcn_fence(__ATOMIC_ACQUIRE, "agent");
            xb_add(&bar[XB_XGEN(b.x)], 1u);
            asm volatile("s_waitcnt vmcnt(0)" ::: "memory");
        } else {
            XB_SPIN(xb_ld(&bar[XB_XGEN(b.x)]) == gen, bar);
            __builtin_amdgcn_fence(__ATOMIC_ACQUIRE, "agent");
            asm volatile("s_waitcnt vmcnt(0)" ::: "memory");
        }
    }
    __syncthreads();
}

constexpr int NWAVES = 8, NTHR = 512;
constexpr int RING_BYTES = 131072, MISC_OFF = RING_BYTES, LDS_BYTES = 147456;
struct Args {
    const float* in[28]; float* out; unsigned char* ws; int ph_lo, ph_hi;
};
struct Frame {
    LAS unsigned char* lds; int tid, lane, wave, G, bid;
    const float *x, *c, *ctx, *c_ctx, *w_mod, *b_mod, *n_mix_pre, *n_mix_post, *n_ffn_pre, *n_ffn_post, *w_in, *gdn_conv, *ret_log_decay, *gdn_a_log, *gdn_dt_bias,
        *ret_gn_w, *gdn_norm_w, *w_ret_out, *w_gdn_out, *w_o, *w_router, *router_bias, *w_gate, *w_up, *w_down, *w_sh_gate, *w_sh_up, *w_sh_down;
    float* out; unsigned char* ws; unsigned* ctl;
};
#define WSP(T, off) ((T*)(F.ws + (off)))

template <class CM>
__device__ __forceinline__ void transpose_item(const float* W, int ld, int K, bf16* WT, LAS float* scr, int kb, int nb, int lane, const CM& cm) {
    const int k0 = 64 * kb, n0 = 32 * nb; const int sc = cm(n0 + (lane & 31));
#pragma unroll 8
    for (int i = 0; i < 32; ++i) { const int kk = 2 * i + (lane >> 5); scr[kk * 33 + (lane & 31)] = W[(size_t)(k0 + kk) * ld + sc]; }
    asm volatile("s_waitcnt lgkmcnt(0)" ::: "memory");
    const int c = lane & 7;
#pragma unroll
    for (int j = 0; j < 4; ++j) { const int n = (lane >> 3) + 8 * j; const LAS float* s = scr + (8 * c) * 33 + n;
        u32x4 o; o.x = pk2(s[0 * 33], s[1 * 33]); o.y = pk2(s[2 * 33], s[3 * 33]); o.z = pk2(s[4 * 33], s[5 * 33]); o.w = pk2(s[6 * 33], s[7 * 33]);
        *(u32x4*)(WT + (size_t)(n0 + n) * K + k0 + 8 * c) = o; }
    asm volatile("s_waitcnt lgkmcnt(0)" ::: "memory");
}
struct CmIdent { int off; __device__ __forceinline__ int operator()(int n) const { return n + off; } };
struct CmWin {
    __device__ __forceinline__ int operator()(int n) const {
        const int g = n >> 9; int src = n + (n >= 2048 ? 16 : 0);
        if (g == 0 || g == 4) { const int hb = n & ~127, cp = n & 127; const int wc = cp >> 5, fq = (cp >> 3) & 3, nn = (cp >> 2) & 1, i = cp & 3;
            const int d = 64 * nn + 16 * wc + 4 * fq + i; src = hb + d + (n >= 2048 ? 16 : 0); }
        return src; }
};
__device__ __forceinline__ void gu_decode(int cp, int& hid, int& isup) { const int pn = cp >> 8, r = cp & 255, bj = r >> 7, wc = (r >> 5) & 3, fq = (r >> 3) & 3, nn = (r >> 2) & 1, i = r & 3; hid = pn * 128 + bj * 64 + wc * 16 + fq * 4 + i; isup = nn; }

__device__ __forceinline__ void phase_prologue(Frame& F) {
    const int gw = F.bid * NWAVES + F.wave, NGW = F.G * NWAVES; const int gt = F.bid * NTHR + F.tid, NGT = F.G * NTHR;
    LAS float* scr = (LAS float*)(F.lds + F.wave * 16384);
    { float2* rt = WSP(float2, WS_ROPE);
      for (int idx = gt; idx < SEQ * 64; idx += NGT) { const int t = idx >> 6, j = idx & 63; const float pos = (float)(j < 32 ? (t >> 6) : (t & 63)); const int f = j & 31;
          const float inv = powf(10000.0f, -(float)f / 32.0f); const float ang = pos * inv; float sn, cs; sincosf(ang, &sn, &cs); rt[idx] = make_float2(cs, sn); } }
    {
        LAS float* red = (LAS float*)(F.lds);
        for (int it = F.bid; it < 96; it += F.G) {
            const int col = it * 64 + F.lane; float a[5] = {0.f, 0.f, 0.f, 0.f, 0.f};
            const int kb = F.wave * 128;
#pragma unroll 4
            for (int k = kb; k < kb + 128; ++k) { const float w = F.w_mod[(size_t)k * 6144 + col];
#pragma unroll
                for (int r = 0; r < 5; ++r) { const float cv = r < 4 ? F.c[r * DM + k] : F.c_ctx[k]; a[r] += siluf_(cv) * w; } }
#pragma unroll
            for (int r = 0; r < 5; ++r) red[(F.wave * 5 + r) * 64 + F.lane] = a[r];
            __syncthreads();
            if (F.wave < 5) { float s = F.b_mod[col];
#pragma unroll
                for (int w = 0; w < 8; ++w) s += red[(w * 5 + F.wave) * 64 + F.lane];
                WSP(float, WS_MOD)[F.wave * 6144 + col] = s; }
            __syncthreads();
        }
    }
    {
        constexpr int I_IN = 16 * 192, I_RO = 8 * 32, I_O = 16 * 32; constexpr int NIT = I_IN + 2 * I_RO + I_O;
        for (int it = gw; it < NIT; it += NGW) { int r = it;
            if (r < I_IN) { transpose_item(F.w_in, N_IN, DM, WSP(bf16, WS_WIN), scr, r / 192, r % 192, F.lane, CmWin{}); continue; } r -= I_IN;
            if (r < I_RO) { transpose_item(F.w_ret_out, DM, 512, WSP(bf16, WS_WRO), scr, r / 32, r % 32, F.lane, CmIdent{0}); continue; } r -= I_RO;
            if (r < I_RO) { transpose_item(F.w_gdn_out, DM, 512, WSP(bf16, WS_WGO), scr, r / 32, r % 32, F.lane, CmIdent{0}); continue; } r -= I_RO;
            transpose_item(F.w_o, DM, DM, WSP(bf16, WS_WO), scr, r / 32, r % 32, F.lane, CmIdent{0}); }
    }
}

__device__ __forceinline__ void phase_moe_weights(Frame& F) {
    const int gw = F.bid * NWAVES + F.wave, NGW = F.G * NWAVES;
    LAS float* scr = (LAS float*)(F.lds + F.wave * 16384);
    constexpr int I_GU = 16 * 16  , I_D = 4 * 32;
    for (int it = gw; it < 65 * (I_GU + I_D); it += NGW) {
        const int e = it / (I_GU + I_D); int r = it % (I_GU + I_D);
        if (r < I_GU) {
            const int kb = r / 16, nb = r % 16;
            const int k0 = 64 * kb, n0 = 32 * nb; int hid, isup; gu_decode(n0 + (F.lane & 31), hid, isup);
            const float* Wg = e < 64 ? F.w_gate + (size_t)e * DM * DEXP : F.w_sh_gate; const float* Wu = e < 64 ? F.w_up + (size_t)e * DM * DEXP : F.w_sh_up;
            const float* W = isup ? Wu : Wg;
#pragma unroll 8
            for (int i = 0; i < 32; ++i) { const int kk = 2 * i + (F.lane >> 5); scr[kk * 33 + (F.lane & 31)] = W[(size_t)(k0 + kk) * DEXP + hid]; }
            asm volatile("s_waitcnt lgkmcnt(0)" ::: "memory");
            const int c = F.lane & 7; bf16* WT = WSP(bf16, WS_WGU) + (size_t)e * 512 * DM;
#pragma unroll
            for (int j = 0; j < 4; ++j) { const int n = (F.lane >> 3) + 8 * j; const LAS float* s = scr + (8 * c) * 33 + n;
                u32x4 o; o.x = pk2(s[0 * 33], s[1 * 33]); o.y = pk2(s[2 * 33], s[3 * 33]); o.z = pk2(s[4 * 33], s[5 * 33]); o.w = pk2(s[6 * 33], s[7 * 33]);
                *(u32x4*)(WT + (size_t)(n0 + n) * DM + k0 + 8 * c) = o; }
            asm volatile("s_waitcnt lgkmcnt(0)" ::: "memory");
        } else { r -= I_GU;
            const float* W = e < 64 ? F.w_down + (size_t)e * DEXP * DM : F.w_sh_down;
            transpose_item(W, DM, DEXP, WSP(bf16, WS_WD) + (size_t)e * DM * DEXP, scr, r / 32, r % 32, F.lane, CmIdent{0}); }
    }
}

__device__ __forceinline__ void phase_norm1(Frame& F) {
    const int gw = F.bid * NWAVES + F.wave, NGW = F.G * NWAVES;
    const float* mod = WSP(float, WS_MOD);
    for (int row = gw; row < NROW; row += NGW) {
        const int b = row / RPB, pos = row % RPB; const bool isctx = pos < CTXL;
        const float* src = isctx ? F.ctx + ((size_t)b * CTXL + pos) * DM : F.x + ((size_t)b * SEQ + (pos - CTXL)) * DM;
        const float* sh = isctx ? mod + 4 * 6144 : mod + b * 6144; const float* sc = sh + DM;
        f32x4 v[4]; float ss = 0.f;
#pragma unroll
        for (int j = 0; j < 4; ++j) { v[j] = *(const f32x4*)(src + 4 * (F.lane + 64 * j)); ss += v[j].x * v[j].x + v[j].y * v[j].y + v[j].z * v[j].z + v[j].w * v[j].w; }
        const float rstd = 1.0f / sqrtf(wave_sum(ss) * (1.f / DM) + EPS);
        float gd[16];
#pragma unroll
        for (int jj = 0; jj < 16; ++jj) gd[jj] = 0.f;
#pragma unroll
        for (int j = 0; j < 4; ++j) { const int c0 = 4 * (F.lane + 64 * j);
            const f32x4 g = *(const f32x4*)(F.n_mix_pre + c0), s1 = *(const f32x4*)(sc + c0), s0 = *(const f32x4*)(sh + c0);
            f32x4 h; h.x = v[j].x * rstd * g.x * (1.f + s1.x) + s0.x; h.y = v[j].y * rstd * g.y * (1.f + s1.y) + s0.y; h.z = v[j].z * rstd * g.z * (1.f + s1.z) + s0.z; h.w = v[j].w * rstd * g.w * (1.f + s1.w) + s0.w;
            u32x2 o; o.x = pk2(h.x, h.y); o.y = pk2(h.z, h.w);
            *(u32x2*)(WSP(bf16, WS_HX) + (size_t)row * DM + c0) = o;
#pragma unroll
            for (int q = 0; q < 4; ++q) { const float hv = q == 0 ? h.x : q == 1 ? h.y : q == 2 ? h.z : h.w; const float* wr = F.w_in + (size_t)(c0 + q) * N_IN + 2048;
#pragma unroll
                for (int jj = 0; jj < 4; ++jj) { const f32x4 w4 = *(const f32x4*)(wr + 4 * jj); gd[4 * jj] += hv * w4.x; gd[4 * jj + 1] += hv * w4.y; gd[4 * jj + 2] += hv * w4.z; gd[4 * jj + 3] += hv * w4.w; } } }
        float mine = 0.f;
#pragma unroll
        for (int jj = 0; jj < 16; ++jj) { const float s = wave_sum(gd[jj]); mine = (F.lane == jj) ? s : mine; }
        if (F.lane < 16) { const int ab = F.lane >> 3, dir = (F.lane >> 2) & 1, h = F.lane & 3; const size_t o = ((size_t)(dir * NB + b) * NH + h) * RPB + pos;
            if (ab == 0) { const float z = mine + F.gdn_dt_bias[dir * 4 + h]; const float sp = z > 20.f ? z : log1pf(expf(z)); WSP(float, WS_LOGA)[o] = -expf(F.gdn_a_log[dir * 4 + h]) * sp; }
            else WSP(float, WS_BETA)[o] = 1.f / (1.f + expf(-mine)); }
    }
}

struct SchedIn {
    const char* A; const char* B; int G, c;
    __device__ __forceinline__ bool next(int i, pg8::Unit& u) const {
        const int L = i * G + c; if (L >= 1536 + 32) return false;
        int lt, pn;
        if (L < 1536) { int wgid = L; { const int q = 1536 / 8, xcd = wgid % 8, off = wgid / 8; wgid = xcd * q + off; }
            const int nig = 8 * 24, gid = wgid / nig, fm = gid * 8; lt = fm + ((wgid % nig) % 8); pn = (wgid % nig) / 8; u.pm = (lt >> 4) * 17 + 1 + (lt & 15); }
        else { const int q = L - 1536; u.pm = (q >> 3) * 17; pn = q & 7; }
        u.pn = pn; u.e = 0; u.base = 0; u.A = A + (size_t)u.pm * 256 * DM * 2; u.B = B + (size_t)pn * 256 * DM * 2; return true; }
    __device__ __forceinline__ int row_index(const pg8::Unit&, int r) const { return r; }
};
struct EpiIn {
    bf16* P; bf16* GATES; const float2* rope;
    __device__ __forceinline__ void operator()(const f32x4 (&acc)[2][2][4][2], const pg8::Unit& u, int wr, int wc, int fr, int fq) const {
        const int g = u.pn >> 1;
        const int b = u.pm / 17, tl = u.pm % 17;
#pragma unroll
        for (int ai = 0; ai < 2; ++ai)
#pragma unroll
            for (int m = 0; m < 4; ++m) {
                const int rt = ai * 128 + wr * 64 + m * 16 + fr; const size_t prow = (size_t)u.pm * 256 + rt;
#pragma unroll
                for (int bj = 0; bj < 2; ++bj) {
                    f32x4 v0 = acc[ai][bj][m][0], v1 = acc[ai][bj][m][1];
                    const int ct = bj * 128 + wc * 32 + 8 * fq;
                    if (g == 0 || g == 4) {
                        const float s = (g == 0) ? 0.08838834764831845f : 1.0f; v0 = v0 * s; v1 = v1 * s;
                        const int j = 16 * wc + 4 * fq;
                        f32x4 o1 = v0, o2 = v1;
                        if (tl != 0) { const int t = (tl - 1) * 256 + rt; const float2* cs = rope + (size_t)t * 64 + j;
#pragma unroll
                            for (int i = 0; i < 4; ++i) { const float2 c2 = cs[i]; o1[i] = v0[i] * c2.x - v1[i] * c2.y; o2[i] = v0[i] * c2.y + v1[i] * c2.x; } }
                        bf16* dst = P + prow * NPCOL + u.pn * 256 + bj * 128 + j;
                        u32x2 w1, w2; w1.x = pg8::cvt_pk_bf16(o1[0], o1[1]); w1.y = pg8::cvt_pk_bf16(o1[2], o1[3]); w2.x = pg8::cvt_pk_bf16(o2[0], o2[1]); w2.y = pg8::cvt_pk_bf16(o2[2], o2[3]);
                        *(u32x2*)dst = w1; *(u32x2*)(dst + 64) = w2;
                    } else if (g < 8) {
                        u32x4 w; w.x = pg8::cvt_pk_bf16(v0[0], v0[1]); w.y = pg8::cvt_pk_bf16(v0[2], v0[3]); w.z = pg8::cvt_pk_bf16(v1[0], v1[1]); w.w = pg8::cvt_pk_bf16(v1[2], v1[3]);
                        *(u32x4*)(P + prow * NPCOL + u.pn * 256 + ct) = w;
                    } else {
                        const size_t lrow = (size_t)b * SEQ + (size_t)(tl - 1) * 256 + rt;
#pragma unroll
                        for (int i = 0; i < 4; ++i) { v0[i] = sigmoidf_(v0[i]); v1[i] = sigmoidf_(v1[i]); }
                        u32x4 w; w.x = pg8::cvt_pk_bf16(v0[0], v0[1]); w.y = pg8::cvt_pk_bf16(v0[2], v0[3]); w.z = pg8::cvt_pk_bf16(v1[0], v1[1]); w.w = pg8::cvt_pk_bf16(v1[2], v1[3]);
                        *(u32x4*)(GATES + lrow * 2048 + (u.pn - 16) * 256 + ct) = w;
                    }
                }
            }
    }
};

__device__ __forceinline__ void phase_feat(Frame& F) {
    const int gw = F.bid * NWAVES + F.wave, NGW = F.G * NWAVES;
    { const int gt = F.bid * NTHR + F.tid, NGT = F.G * NTHR; f32x4* z = WSP(f32x4, WS_ORET); for (int i = gt; i < 2 * NT * 512 / 4; i += NGT) z[i] = (f32x4){0.f, 0.f, 0.f, 0.f}; }
    const bf16* P = WSP(bf16, WS_P);
    for (int row = gw; row < NROW; row += NGW) {
        const int pos = row % RPB; const bool isctx = pos < CTXL;
        const bool hp = isctx ? (pos > 0) : (pos > CTXL), hn = isctx ? (pos < CTXL - 1) : (pos < RPB - 1);
#pragma unroll
        for (int part = 0; part < 3; ++part) {
            if (part == 2 && isctx) continue;
            const int pc = (part == 0 ? 1024 : part == 1 ? 1536 : 3072) + 8 * F.lane; const int cc = (part == 0 ? 512 : part == 1 ? 1024 : 0) + 8 * F.lane;
            const u32x4 z4 = {0u, 0u, 0u, 0u};
            const u32x4 r0 = hp ? *(const u32x4*)(P + (size_t)(row - 1) * NPCOL + pc) : z4, r1 = *(const u32x4*)(P + (size_t)row * NPCOL + pc), r2 = hn ? *(const u32x4*)(P + (size_t)(row + 1) * NPCOL + pc) : z4;
            float a0[8], a1[8], a2[8], y[8]; unpack8(r0, a0); unpack8(r1, a1); unpack8(r2, a2); float ss = 0.f;
#pragma unroll
            for (int i = 0; i < 8; ++i) { const float cv = F.gdn_conv[cc + i] * a0[i] + F.gdn_conv[1536 + cc + i] * a1[i] + F.gdn_conv[3072 + cc + i] * a2[i]; y[i] = siluf_(cv); ss += y[i] * y[i]; }
            if (part != 1) { const float tot = sum16(ss); const float sc = (1.0f / sqrtf(tot + EPS)) * (part == 2 ? 0.08838834764831845f : 1.0f);
#pragma unroll
                for (int i = 0; i < 8; ++i) y[i] *= sc; }
            bf16* dst = part == 0 ? WSP(bf16, WS_GK) : part == 1 ? WSP(bf16, WS_GV) : WSP(bf16, WS_GQ);
            *(u32x4*)(dst + (size_t)row * 512 + 8 * F.lane) = pack8(y);
        }
    }
}
__device__ __forceinline__ void phase_seq(Frame& F) {
    LAS float* sk = (LAS float*)F.lds; LAS float* sq = sk + 128; LAS float* sv = sq + 128; LAS float* ps = sv + 128; LAS float* ps2 = ps + 512;
    const int r4 = F.tid >> 7, j = F.tid & 127;
    for (int chain = F.bid; chain < 64; chain += F.G) {
        const int mixer = chain >> 5, b = (chain >> 3) & 3, h = (chain >> 1) & 3, dir = chain & 1;
        const bf16* P = WSP(bf16, WS_P);
        const bf16* Kp = mixer ? WSP(bf16, WS_GK) + h * 128 : P + h * 128; const int kld = mixer ? 512 : NPCOL;
        const bf16* Vp = mixer ? WSP(bf16, WS_GV) + h * 128 : P + 512 + h * 128; const int vld = kld;
        const bf16* Qp = mixer ? WSP(bf16, WS_GQ) + h * 128 : P + 2048 + h * 128; const int qld = kld;
        float* O = (mixer ? WSP(float, WS_OGDN) : WSP(float, WS_ORET)) + h * 128;
        const float* la = WSP(float, WS_LOGA) + ((size_t)(dir * NB + b) * NH + h) * RPB; const float* be = WSP(float, WS_BETA) + ((size_t)(dir * NB + b) * NH + h) * RPB;
        const float gam = expf(F.ret_log_decay[dir * 4 + h]);
        float S[32];
#pragma unroll
        for (int i = 0; i < 32; ++i) S[i] = 0.f;
        for (int s = 0; s < RPB; ++s) {
            const bool isctx = s < CTXL; const int pos = isctx ? (dir ? CTXL - 1 - s : s) : CTXL + (dir ? SEQ - 1 - (s - CTXL) : (s - CTXL));
            const size_t row = (size_t)b * RPB + pos;
            if (r4 == 0) sk[j] = bf2f(Kp[row * kld + j]); else if (r4 == 1) sv[j] = bf2f(Vp[row * vld + j]); else if (r4 == 2) sq[j] = isctx ? 0.f : bf2f(Qp[row * qld + j]);
            const float a = mixer ? expf(la[pos]) : gam; const float bt = mixer ? be[pos] : 1.f;
            __syncthreads();
            float delta = sv[j];
            if (mixer) { float p = 0.f;
#pragma unroll
                for (int i = 0; i < 32; ++i) p += sk[r4 * 32 + i] * S[i];
                ps[r4 * 128 + j] = p; __syncthreads();
                const float kS = a * (ps[j] + ps[128 + j] + ps[256 + j] + ps[384 + j]); delta = bt * (sv[j] - kS); }
            float po = 0.f;
#pragma unroll
            for (int i = 0; i < 32; ++i) { S[i] = a * S[i] + sk[r4 * 32 + i] * delta; po += sq[r4 * 32 + i] * S[i]; }
            ps2[r4 * 128 + j] = po; __syncthreads();
            if (!isctx && r4 == 0) { const float o = ps2[j] + ps2[128 + j] + ps2[256 + j] + ps2[384 + j]; atomicAdd(O + ((size_t)b * SEQ + (pos - CTXL)) * 512 + j, o); }
        }
        __syncthreads();
    }
}
__device__ __forceinline__ void phase_mixnorm(Frame& F) {
    const int gw = F.bid * NWAVES + F.wave, NGW = F.G * NWAVES;
    const bf16* P = WSP(bf16, WS_P);
    for (int t = gw; t < NT; t += NGW) {
        const int b = t / SEQ, tt = t % SEQ; const size_t prow = (size_t)b * RPB + CTXL + tt; const int c0 = 8 * F.lane;
        { const float* o = WSP(float, WS_ORET) + (size_t)t * 512 + c0; const f32x4 a = *(const f32x4*)o, c = *(const f32x4*)(o + 4); float v[8] = {a.x, a.y, a.z, a.w, c.x, c.y, c.z, c.w};
          float s = 0.f;
#pragma unroll
          for (int i = 0; i < 8; ++i) s += v[i];
          const float mean = sum16(s) * (1.f / 128.f); float q = 0.f;
#pragma unroll
          for (int i = 0; i < 8; ++i) { v[i] -= mean; q += v[i] * v[i]; }
          const float rstd = 1.0f / sqrtf(sum16(q) * (1.f / 128.f) + EPS);
          float gz[8]; unpack8(*(const u32x4*)(P + prow * NPCOL + 2560 + c0), gz);
#pragma unroll
          for (int i = 0; i < 8; ++i) v[i] = v[i] * rstd * F.ret_gn_w[c0 + i] * siluf_(gz[i]);
          *(u32x4*)(WSP(bf16, WS_RETY) + (size_t)t * 512 + c0) = pack8(v); }
        { const float* o = WSP(float, WS_OGDN) + (size_t)t * 512 + c0; const f32x4 a = *(const f32x4*)o, c = *(const f32x4*)(o + 4); float v[8] = {a.x, a.y, a.z, a.w, c.x, c.y, c.z, c.w};
          float q = 0.f;
#pragma unroll
          for (int i = 0; i < 8; ++i) q += v[i] * v[i];
          const float rstd = 1.0f / sqrtf(sum16(q) * (1.f / 128.f) + EPS);
          float gz[8]; unpack8(*(const u32x4*)(P + prow * NPCOL + 3584 + c0), gz);
#pragma unroll
          for (int i = 0; i < 8; ++i) v[i] = v[i] * rstd * F.gdn_norm_w[c0 + i] * siluf_(gz[i]);
          *(u32x4*)(WSP(bf16, WS_GDNY) + (size_t)t * 512 + c0) = pack8(v); }
    }
}

struct SchedMerge {
    const char *A0, *A1, *B0, *B1; int G, c;
    __device__ __forceinline__ bool next(int i, pg8::Unit& u) const {
        const int L = (i >> 1) * G + c; if (L >= 256) return false; const int term = i & 1;
        const int xcd = L % 8, off = L / 8; const int w = xcd * 32 + off;
        u.pm = w >> 2; u.pn = w & 3; u.e = term; u.base = 0;
        u.A = (term ? A1 : A0) + (size_t)u.pm * 256 * 512 * 2; u.B = (term ? B1 : B0) + (size_t)u.pn * 256 * 512 * 2; return true; }
    __device__ __forceinline__ int row_index(const pg8::Unit&, int r) const { return r; }
};
struct EpiMerge {
    const bf16* GATES; bf16* TMP; bf16* MERGED;
    __device__ __forceinline__ void operator()(const f32x4 (&acc)[2][2][4][2], const pg8::Unit& u, int wr, int wc, int fr, int fq) const {
#pragma unroll
        for (int ai = 0; ai < 2; ++ai)
#pragma unroll
            for (int m = 0; m < 4; ++m) { const size_t row = (size_t)u.pm * 256 + ai * 128 + wr * 64 + m * 16 + fr;
#pragma unroll
                for (int bj = 0; bj < 2; ++bj) { const int col = u.pn * 256 + bj * 128 + wc * 32 + 8 * fq;
                    float g[8]; unpack8(*(const u32x4*)(GATES + row * 2048 + u.e * 1024 + col), g);
                    float v[8] = {acc[ai][bj][m][0][0], acc[ai][bj][m][0][1], acc[ai][bj][m][0][2], acc[ai][bj][m][0][3], acc[ai][bj][m][1][0], acc[ai][bj][m][1][1], acc[ai][bj][m][1][2], acc[ai][bj][m][1][3]};
                    if (u.e == 0) {
#pragma unroll
                        for (int i = 0; i < 8; ++i) v[i] *= g[i];
                        *(u32x4*)(TMP + row * DM + col) = pack8(v);
                    } else { float p[8]; unpack8(*(const u32x4*)(TMP + row * DM + col), p);
#pragma unroll
                        for (int i = 0; i < 8; ++i) v[i] = p[i] + v[i] * g[i];
                        *(u32x4*)(MERGED + row * DM + col) = pack8(v); } } }
    }
};
struct SchedDense {
    const char *A, *B; int nM, nN, K, G, c;
    __device__ __forceinline__ bool next(int i, pg8::Unit& u) const {
        const int L = i * G + c; const int nwg = nM * nN; if (L >= nwg) return false;
        int w = L; if (nwg % 8 == 0) { const int xcd = L % 8, off = L / 8; w = xcd * (nwg / 8) + off; }
        u.pm = w / nN; u.pn = w % nN; u.e = 0; u.base = 0; u.A = A + (size_t)u.pm * 256 * K * 2; u.B = B + (size_t)u.pn * 256 * K * 2; return true; }
    __device__ __forceinline__ int row_index(const pg8::Unit&, int r) const { return r; }
};
struct EpiBf16Store { bf16* O; int ldc;
    __device__ __forceinline__ void operator()(const f32x4 (&acc)[2][2][4][2], const pg8::Unit& u, int wr, int wc, int fr, int fq) const {
#pragma unroll
        for (int ai = 0; ai < 2; ++ai)
#pragma unroll
            for (int m = 0; m < 4; ++m) { const size_t row = (size_t)u.pm * 256 + ai * 128 + wr * 64 + m * 16 + fr;
#pragma unroll
                for (int bj = 0; bj < 2; ++bj) { const int col = u.pn * 256 + bj * 128 + wc * 32 + 8 * fq; const f32x4 v0 = acc[ai][bj][m][0], v1 = acc[ai][bj][m][1];
                    u32x4 w; w.x = pg8::cvt_pk_bf16(v0[0], v0[1]); w.y = pg8::cvt_pk_bf16(v0[2], v0[3]); w.z = pg8::cvt_pk_bf16(v1[0], v1[1]); w.w = pg8::cvt_pk_bf16(v1[2], v1[3]);
                    *(u32x4*)(O + row * ldc + col) = w; } }
    }
};

__device__ __forceinline__ void load_row_bf16(const bf16* p, int lane, float (&v)[16]) { float a[8], b[8]; unpack8(*(const u32x4*)(p + 8 * lane), a); unpack8(*(const u32x4*)(p + 512 + 8 * lane), b);
#pragma unroll
    for (int i = 0; i < 8; ++i) { v[i] = a[i]; v[8 + i] = b[i]; } }
__device__ __forceinline__ void load_row_f32(const float* p, int lane, float (&v)[16]) {
#pragma unroll
    for (int q = 0; q < 4; ++q) { const f32x4 a = *(const f32x4*)(p + (q >> 1) * 512 + 8 * lane + 4 * (q & 1)); v[4 * q] = a.x; v[4 * q + 1] = a.y; v[4 * q + 2] = a.z; v[4 * q + 3] = a.w; } }
__device__ __forceinline__ void store_row_f32(float* p, int lane, const float (&v)[16]) {
#pragma unroll
    for (int q = 0; q < 4; ++q) *(f32x4*)(p + (q >> 1) * 512 + 8 * lane + 4 * (q & 1)) = (f32x4){v[4 * q], v[4 * q + 1], v[4 * q + 2], v[4 * q + 3]}; }
__device__ __forceinline__ void compute_x1(Frame& F, int t, float (&x1)[16]) {
    const int b = t / SEQ; const float* mod = WSP(float, WS_MOD) + b * 6144;
    float mo[16], xv[16], wv[16], g1[16]; load_row_bf16(WSP(bf16, WS_MO) + (size_t)t * DM, F.lane, mo); load_row_f32(F.x + (size_t)t * DM, F.lane, xv);
    load_row_f32(F.n_mix_post, F.lane, wv); load_row_f32(mod + 2 * DM, F.lane, g1);
    float ss = 0.f;
#pragma unroll
    for (int i = 0; i < 16; ++i) ss += mo[i] * mo[i];
    const float rstd = 1.0f / sqrtf(wave_sum(ss) * (1.f / DM) + EPS);
#pragma unroll
    for (int i = 0; i < 16; ++i) x1[i] = xv[i] + g1[i] * (mo[i] * rstd * wv[i]);
}
__device__ __forceinline__ void phase_route(Frame& F) {
    const int gw = F.bid * NWAVES + F.wave, NGW = F.G * NWAVES;
    LAS float* hs = (LAS float*)(F.lds + F.wave * 4096);
    unsigned* cnt = F.ctl + CW_CNT; int* list = WSP(int, WS_LIST); float* selw = WSP(float, WS_SELW);
    for (int t = gw; t < NT; t += NGW) {
        const int b = t / SEQ; const float* mod = WSP(float, WS_MOD) + b * 6144;
        float x1[16]; compute_x1(F, t, x1);
        float ss = 0.f;
#pragma unroll
        for (int i = 0; i < 16; ++i) ss += x1[i] * x1[i];
        const float rstd = 1.0f / sqrtf(wave_sum(ss) * (1.f / DM) + EPS);
        float wv[16], sh[16], sc[16], h2[16]; load_row_f32(F.n_ffn_pre, F.lane, wv); load_row_f32(mod + 3 * DM, F.lane, sh); load_row_f32(mod + 4 * DM, F.lane, sc);
#pragma unroll
        for (int i = 0; i < 16; ++i) h2[i] = x1[i] * rstd * wv[i] * (1.f + sc[i]) + sh[i];
        { float a[8], c[8];
#pragma unroll
          for (int i = 0; i < 8; ++i) { a[i] = h2[i]; c[i] = h2[8 + i]; }
          bf16* d = WSP(bf16, WS_H2) + (size_t)t * DM; *(u32x4*)(d + 8 * F.lane) = pack8(a); *(u32x4*)(d + 512 + 8 * F.lane) = pack8(c); }
#pragma unroll
        for (int i = 0; i < 8; ++i) { hs[8 * F.lane + i] = h2[i]; hs[512 + 8 * F.lane + i] = h2[8 + i]; }
        asm volatile("s_waitcnt lgkmcnt(0)" ::: "memory");
        float lg0 = 0.f, lg1 = 0.f, lg2 = 0.f, lg3 = 0.f;
        for (int k = 0; k < DM; k += 4) { const f32x4 hv = *(const LAS f32x4*)(hs + k);
            lg0 += hv.x * F.w_router[(size_t)k * NEXP + F.lane]; lg1 += hv.y * F.w_router[(size_t)(k + 1) * NEXP + F.lane]; lg2 += hv.z * F.w_router[(size_t)(k + 2) * NEXP + F.lane]; lg3 += hv.w * F.w_router[(size_t)(k + 3) * NEXP + F.lane]; }
        const float logit = (lg0 + lg1) + (lg2 + lg3);
        const float score = 1.f / (1.f + expf(-logit)); const float biased = score + F.router_bias[F.lane];
        int rk = 0;
#pragma unroll
        for (int o = 0; o < 8; ++o) { const int src = (F.lane & ~7) | o; const float ov = __shfl(biased, src); rk += (ov > biased || (ov == biased && src < F.lane)) ? 1 : 0; }
        float gs = rk < 2 ? biased : 0.f; gs += __shfl_xor(gs, 1); gs += __shfl_xor(gs, 2); gs += __shfl_xor(gs, 4);
        int grk = 0; const int myg = F.lane >> 3;
#pragma unroll
        for (int o = 0; o < 8; ++o) { const float ov = __shfl(gs, o * 8); grk += (ov > gs || (ov == gs && o < myg)) ? 1 : 0; }
        const bool keep = grk < 4;
        const float cand = keep ? biased : -__builtin_inff();
        int erk = 0;
        for (int o = 0; o < 64; ++o) { const float ov = __shfl(cand, o); erk += (ov > cand || (ov == cand && o < F.lane)) ? 1 : 0; }
        const bool sel = keep && erk < TOPK;
        const float ssum = wave_sum(sel ? score : 0.f);
        if (sel) { const float w = score / ssum * 2.5f; const unsigned pos = atomicAdd(cnt + F.lane, 1u);
            list[(size_t)F.lane * NT + pos] = t * 8 + erk; selw[t * 8 + erk] = w; }
    }
}

__device__ __forceinline__ void build_tile_prefix(Frame& F, LAS int* tp) {
    __syncthreads();
    if (F.tid == 0) { int s = 0; const unsigned* cnt = F.ctl + CW_CNT; for (int e = 0; e < 64; ++e) { tp[e] = s; s += ((int)__hip_atomic_load(cnt + e, __ATOMIC_RELAXED, __HIP_MEMORY_SCOPE_AGENT) + 255) >> 8; } tp[64] = s; tp[65] = s + 64; }
    __syncthreads();
}
struct SchedMoe {
    const char* A; const char* B; const int* list; const unsigned* cnt; const LAS int* tp; int npn, K, G, c; size_t bstride  ; int bcol0  ; bool gather;
    __device__ __forceinline__ bool next(int i, pg8::Unit& u) const {
        const int L = i * G + c; const int ntile = __builtin_amdgcn_readfirstlane(tp[65]); if (L >= ntile * npn) return false;
        const int tile = L / npn; u.pn = L % npn; int e = 0;
        for (int q = 64; q >= 1; q >>= 1) if (e + q <= 64 && __builtin_amdgcn_readfirstlane(tp[e + q]) <= tile) e += q;
        e = __builtin_amdgcn_readfirstlane(e);
        u.e = e; u.pm = tile - __builtin_amdgcn_readfirstlane(tp[e]); u.base = (e < 64 ? tile * 256 : SLOT_SH + u.pm * 256);
        u.A = gather ? A : A + (size_t)u.base * K * 2; u.B = B + (size_t)e * bstride + (size_t)(bcol0 + u.pn * 256) * K * 2; return true; }
    __device__ __forceinline__ int row_index(const pg8::Unit& u, int r) const {
        if (u.e == 64) return u.pm * 256 + r;
        const int n = (int)cnt[u.e]; int idx = u.pm * 256 + r; if (idx >= n) idx = 0; return list[(size_t)u.e * NT + idx] >> 3; }
};
struct EpiUp { bf16* HMID;
    __device__ __forceinline__ void operator()(const f32x4 (&acc)[2][2][4][2], const pg8::Unit& u, int wr, int wc, int fr, int fq) const {
#pragma unroll
        for (int ai = 0; ai < 2; ++ai)
#pragma unroll
            for (int m = 0; m < 4; ++m) { const size_t slot = (size_t)u.base + ai * 128 + wr * 64 + m * 16 + fr;
#pragma unroll
                for (int bj = 0; bj < 2; ++bj) { const int hid = u.pn * 128 + bj * 64 + wc * 16 + fq * 4; const f32x4 g = acc[ai][bj][m][0], up = acc[ai][bj][m][1];
                    u32x2 w; w.x = pg8::cvt_pk_bf16(siluf_(g[0]) * up[0], siluf_(g[1]) * up[1]); w.y = pg8::cvt_pk_bf16(siluf_(g[2]) * up[2], siluf_(g[3]) * up[3]);
                    *(u32x2*)(HMID + slot * DEXP + hid) = w; } }
    }
};
struct EpiDown { bf16* YB; float* OUT; const int* list; const float* selw; const unsigned* cnt; int half;
    __device__ __forceinline__ void operator()(const f32x4 (&acc)[2][2][4][2], const pg8::Unit& u, int wr, int wc, int fr, int fq) const {
        const int n = u.e < 64 ? (int)cnt[u.e] : 0;
#pragma unroll
        for (int ai = 0; ai < 2; ++ai)
#pragma unroll
            for (int m = 0; m < 4; ++m) { const int r = ai * 128 + wr * 64 + m * 16 + fr; const int idx = u.pm * 256 + r;
                if (u.e == 64) { float* o = OUT + (size_t)idx * DM + half * 512 + u.pn * 256 + wc * 32 + 8 * fq;
#pragma unroll
                    for (int bj = 0; bj < 2; ++bj) { *(f32x4*)(o + bj * 128) = acc[ai][bj][m][0]; *(f32x4*)(o + bj * 128 + 4) = acc[ai][bj][m][1]; } }
                else if (idx < n) { const int dst = list[(size_t)u.e * NT + idx]; const float w = selw[dst]; bf16* o = YB + (size_t)dst * 512 + u.pn * 256 + wc * 32 + 8 * fq;
#pragma unroll
                    for (int bj = 0; bj < 2; ++bj) { const f32x4 v0 = acc[ai][bj][m][0] * w, v1 = acc[ai][bj][m][1] * w;
                        u32x4 q; q.x = pg8::cvt_pk_bf16(v0[0], v0[1]); q.y = pg8::cvt_pk_bf16(v0[2], v0[3]); q.z = pg8::cvt_pk_bf16(v1[0], v1[1]); q.w = pg8::cvt_pk_bf16(v1[2], v1[3]);
                        *(u32x4*)(o + bj * 128) = q; } } }
    }
};
__device__ __forceinline__ void phase_combine(Frame& F, int half) {
    const int gw = F.bid * NWAVES + F.wave, NGW = F.G * NWAVES; const bf16* YB = WSP(bf16, WS_YB);
    for (int t = gw; t < NT; t += NGW) {
        float* o = F.out + (size_t)t * DM + half * 512 + 8 * F.lane; f32x4 a = *(const f32x4*)o, c = *(const f32x4*)(o + 4);
#pragma unroll
        for (int k = 0; k < 8; ++k) { float v[8]; unpack8(*(const u32x4*)(YB + ((size_t)t * 8 + k) * 512 + 8 * F.lane), v); a.x += v[0]; a.y += v[1]; a.z += v[2]; a.w += v[3]; c.x += v[4]; c.y += v[5]; c.z += v[6]; c.w += v[7]; }
        *(f32x4*)o = a; *(f32x4*)(o + 4) = c;
    }
}
__device__ __forceinline__ void phase_final(Frame& F) {
    const int gw = F.bid * NWAVES + F.wave, NGW = F.G * NWAVES; const bf16* YB = WSP(bf16, WS_YB);
    for (int t = gw; t < NT; t += NGW) {
        const int b = t / SEQ; const float* mod = WSP(float, WS_MOD) + b * 6144;
        float mv[16]; load_row_f32(F.out + (size_t)t * DM, F.lane, mv);
#pragma unroll
        for (int k = 0; k < 8; ++k) { float v[8]; unpack8(*(const u32x4*)(YB + ((size_t)t * 8 + k) * 512 + 8 * F.lane), v);
#pragma unroll
            for (int i = 0; i < 8; ++i) mv[8 + i] += v[i]; }
        float ss = 0.f;
#pragma unroll
        for (int i = 0; i < 16; ++i) ss += mv[i] * mv[i];
        const float rstd = 1.0f / sqrtf(wave_sum(ss) * (1.f / DM) + EPS);
        float x1[16]; compute_x1(F, t, x1);
        float wv[16], g2[16]; load_row_f32(F.n_ffn_post, F.lane, wv); load_row_f32(mod + 5 * DM, F.lane, g2);
        float o[16];
#pragma unroll
        for (int i = 0; i < 16; ++i) o[i] = x1[i] + g2[i] * (mv[i] * rstd * wv[i]);
        store_row_f32(F.out + (size_t)t * DM, F.lane, o);
    }
}

constexpr int N_PHASES = 16;
__global__ void __launch_bounds__(NTHR, 2) fwd(Args args) {
    extern __shared__ __attribute__((aligned(16))) unsigned char lds_raw[];
    Frame F; F.lds = (LAS unsigned char*)lds_raw; F.tid = threadIdx.x; F.lane = F.tid & 63; F.wave = __builtin_amdgcn_readfirstlane(F.tid >> 6); F.G = gridDim.x; F.bid = blockIdx.x;
    F.x = args.in[0]; F.c = args.in[1]; F.ctx = args.in[2]; F.c_ctx = args.in[3]; F.w_mod = args.in[4]; F.b_mod = args.in[5]; F.n_mix_pre = args.in[6]; F.n_mix_post = args.in[7];
    F.n_ffn_pre = args.in[8]; F.n_ffn_post = args.in[9]; F.w_in = args.in[10]; F.gdn_conv = args.in[11]; F.ret_log_decay = args.in[12]; F.gdn_a_log = args.in[13]; F.gdn_dt_bias = args.in[14];
    F.ret_gn_w = args.in[15]; F.gdn_norm_w = args.in[16]; F.w_ret_out = args.in[17]; F.w_gdn_out = args.in[18]; F.w_o = args.in[19]; F.w_router = args.in[20]; F.router_bias = args.in[21];
    F.w_gate = args.in[22]; F.w_up = args.in[23]; F.w_down = args.in[24]; F.w_sh_gate = args.in[25]; F.w_sh_up = args.in[26]; F.w_sh_down = args.in[27];
    F.out = args.out; F.ws = args.ws; F.ctl = (unsigned*)(args.ws + WS_CTL);
    volatile LAS unsigned* MISC = (volatile LAS unsigned*)(F.lds + MISC_OFF);
    if (F.tid < 64) MISC[F.tid] = 0u;
    __syncthreads();
#if MK_ONE_LAUNCH
    XcdBarrier bar = xcd_barrier_post(F.ctl + CW_BAR, MISC + 8);
#define SEAM() xcd_barrier(bar)
#else
#define SEAM() do {} while (0)
#endif
    const int lo = args.ph_lo, hi = args.ph_hi;
#ifndef PHM
#define PHM 0xffff
#endif
#define IN(k) (((PHM >> (k)) & 1) && lo <= (k) && (k) < hi)
    LAS int* tp = (LAS int*)(F.lds + MISC_OFF + 256);

    if (IN(0)) { phase_prologue(F); SEAM(); }
    if (IN(1)) { phase_norm1(F); SEAM(); }
    if (IN(2)) {
        SchedIn S{(const char*)WSP(bf16, WS_HX), (const char*)WSP(bf16, WS_WIN), F.G, F.bid};
        EpiIn E{WSP(bf16, WS_P), (bf16*)F.out, WSP(float2, WS_ROPE)};
        pg8::gemm_phase<EpiIn, SchedIn, false, SP2>(F.lds, DM, S, E); SEAM();
    }
    if (IN(3)) { phase_feat(F); SEAM(); }
    if (IN(4)) { phase_seq(F); SEAM(); }
    if (IN(5)) { phase_mixnorm(F); SEAM(); }
    if (IN(6)) {
        SchedMerge S{(const char*)WSP(bf16, WS_RETY), (const char*)WSP(bf16, WS_GDNY), (const char*)WSP(bf16, WS_WRO), (const char*)WSP(bf16, WS_WGO), F.G, F.bid};
        EpiMerge E{(const bf16*)F.out, WSP(bf16, WS_TMP), WSP(bf16, WS_MERGED)};
        pg8::gemm_phase<EpiMerge, SchedMerge, false, SP2>(F.lds, 512, S, E);
        phase_moe_weights(F); SEAM();
    }
    if (IN(7)) {
        SchedDense S{(const char*)WSP(bf16, WS_MERGED), (const char*)WSP(bf16, WS_WO), 64, 4, DM, F.G, F.bid};
        EpiBf16Store E{WSP(bf16, WS_MO), DM};
        pg8::gemm_phase<EpiBf16Store, SchedDense, false, SP2>(F.lds, DM, S, E); SEAM();
    }
    if (IN(8)) { phase_route(F); SEAM(); }
    if (IN(9)) {
        build_tile_prefix(F, tp);
        SchedMoe S{(const char*)WSP(bf16, WS_H2), (const char*)WSP(bf16, WS_WGU), WSP(int, WS_LIST), F.ctl + CW_CNT, tp, 2, DM, F.G, F.bid, (size_t)512 * DM * 2, 0, true};
        EpiUp E{WSP(bf16, WS_HMID)};
        pg8::gemm_phase<EpiUp, SchedMoe, true, SP2>(F.lds, DM, S, E); SEAM();
    }
    if (IN(10)) {
        build_tile_prefix(F, tp);
        SchedMoe S{(const char*)WSP(bf16, WS_HMID), (const char*)WSP(bf16, WS_WD), WSP(int, WS_LIST), F.ctl + CW_CNT, tp, 2, DEXP, F.G, F.bid, (size_t)DM * DEXP * 2, 0, false};
        EpiDown E{WSP(bf16, WS_YB), F.out, WSP(int, WS_LIST), WSP(float, WS_SELW), F.ctl + CW_CNT, 0};
        pg8::gemm_phase<EpiDown, SchedMoe, false, SP2>(F.lds, DEXP, S, E); SEAM();
    }
    if (IN(11)) { phase_combine(F, 0); SEAM(); }
    if (IN(12)) {
        build_tile_prefix(F, tp);
        SchedMoe S{(const char*)WSP(bf16, WS_HMID), (const char*)WSP(bf16, WS_WD), WSP(int, WS_LIST), F.ctl + CW_CNT, tp, 2, DEXP, F.G, F.bid, (size_t)DM * DEXP * 2, 512, false};
        EpiDown E{WSP(bf16, WS_YB), F.out, WSP(int, WS_LIST), WSP(float, WS_SELW), F.ctl + CW_CNT, 1};
        pg8::gemm_phase<EpiDown, SchedMoe, false, SP2>(F.lds, DEXP, S, E); SEAM();
    }
    if (IN(13)) { phase_final(F); }
#undef IN
}

extern "C" void kernel_launch(void* const* d_in, const int* in_sizes, int n_in, void* d_out, int out_size, void* d_ws, size_t ws_size, hipStream_t stream) {
    static int grid = 0;
    if (grid == 0) {
        if (n_in != 28 || in_sizes[0] != NT * DM || out_size != NT * DM || ws_size < 314 * MiB) { fprintf(stderr, "kernel_launch: unexpected shapes / workspace (%d inputs, ws %zu)\n", n_in, ws_size); grid = -1; return; }
        int dev = 0, cus = 0;
        if (hipGetDevice(&dev) != hipSuccess || hipDeviceGetAttribute(&cus, hipDeviceAttributeMultiprocessorCount, dev) != hipSuccess) { grid = -1; return; }
        if (hipFuncSetAttribute((const void*)fwd, hipFuncAttributeMaxDynamicSharedMemorySize, LDS_BYTES) != hipSuccess) { fprintf(stderr, "kernel_launch: hipFuncSetAttribute failed\n"); grid = -1; return; }
        int per_cu = 0; (void)hipOccupancyMaxActiveBlocksPerMultiprocessor(&per_cu, (const void*)fwd, NTHR, LDS_BYTES); (void)hipGetLastError();
        if (per_cu < 1) fprintf(stderr, "kernel_launch: occupancy query says %d\n", per_cu);
        grid = cus;
    }
    if (grid < 0) return;
    (void)hipMemsetAsync((char*)d_ws + WS_CTL, 0, CTL_BYTES, stream);
    Args a{};
    for (int i = 0; i < 28; ++i) a.in[i] = (const float*)d_in[i];
    a.out = (float*)d_out; a.ws = (unsigned char*)d_ws;
#if MK_ONE_LAUNCH
    a.ph_lo = 0; a.ph_hi = N_PHASES;
    hipLaunchKernelGGL(fwd, dim3(grid), dim3(NTHR), LDS_BYTES, stream, a);
#else
    for (int p = 0; p < 14; ++p) { a.ph_lo = p; a.ph_hi = p + 1; hipLaunchKernelGGL(fwd, dim3(grid), dim3(NTHR), LDS_BYTES, stream, a); }
#endif
}
```

```cpp
#include <hip/hip_runtime.h>
#include <cstdio>
#include <cstdint>

#ifndef MK_ONE_LAUNCH
#define MK_ONE_LAUNCH 1
#endif
#ifndef MK_REF_GEMM
#define MK_REF_GEMM 0
#endif

constexpr int NB = 4, SEQ = 4096, DM = 1024, CTXL = 256, RPB = SEQ + CTXL  , NROW = NB * RPB  , NT = NB * SEQ  ;
constexpr int NH = 4, HD = 128, CH = 128, NCHUNK = RPB / CH  ;
constexpr int N_STATE = 2064, N_IN = 6160, NEXP = 64, TOPK = 8, DEXP = 256;
constexpr float EPS = 1e-6f;
constexpr int NPCOL = 4096;
constexpr int SLOT_SH = 147456;
constexpr int NSLOT = SLOT_SH + NT;

constexpr size_t MiB = 1u << 20;
constexpr size_t WS_CTL = 0, CTL_BYTES = 1 * MiB;
constexpr size_t WS_MOD = 1 * MiB;
constexpr size_t WS_ROPE = 2 * MiB;
constexpr size_t WS_LOGA = 4 * MiB;
constexpr size_t WS_BETA = 5 * MiB;
constexpr size_t WS_WRO = 6 * MiB, WS_WGO = 7 * MiB, WS_WO = 8 * MiB;
constexpr size_t WS_P = 10 * MiB;
constexpr size_t PGRP = (size_t)NROW * 512;
constexpr size_t WS_CH = 146 * MiB;
constexpr size_t WS_WIN = WS_CH;
constexpr size_t WS_HX = WS_CH + 12 * MiB;
constexpr size_t WS_GM = WS_CH;
constexpr size_t WS_GC = WS_CH + 34 * MiB;
constexpr size_t WS_GKV = WS_CH + 68 * MiB;
constexpr size_t WS_GQT = WS_CH + 102 * MiB;
constexpr size_t WS_OGDN = WS_CH + 134 * MiB;
constexpr size_t WS_ORET = WS_CH + 150 * MiB;
constexpr size_t WS_RETY = WS_P, WS_GDNY = WS_P + 17 * MiB;
constexpr size_t WS_H2 = 10 * MiB;
constexpr size_t WS_WGU = 73 * MiB;
constexpr size_t WS_YB = 10 * MiB;
constexpr size_t WS_WD = 138 * MiB;
constexpr size_t WS_HMID = 171 * MiB;
constexpr size_t WS_TMP = 171 * MiB, WS_MERGED = 203 * MiB;
constexpr size_t WS_MO = 251 * MiB;
constexpr size_t WS_LIST = 283 * MiB;
constexpr size_t WS_SELW = 287 * MiB;
constexpr size_t WS_END = 312 * MiB;

constexpr int CW_BAR = 1024;
constexpr int CW_CNT = 8192;

#define GAS __attribute__((address_space(1)))
#define LAS __attribute__((address_space(3)))
typedef unsigned short bf16;
typedef float f32x4 __attribute__((ext_vector_type(4)));
typedef float f32x2 __attribute__((ext_vector_type(2)));
typedef short bf16x8 __attribute__((ext_vector_type(8)));
typedef unsigned u32x4 __attribute__((ext_vector_type(4)));
typedef unsigned u32x2 __attribute__((ext_vector_type(2)));
__device__ __forceinline__ unsigned f2bf(float f) { unsigned u = __builtin_bit_cast(unsigned, f); return (u + 0x7fffu + ((u >> 16) & 1u)) >> 16; }
__device__ __forceinline__ unsigned pk2(float lo, float hi) { return f2bf(lo) | (f2bf(hi) << 16); }
__device__ __forceinline__ float bf2f(unsigned b) { return __builtin_bit_cast(float, b << 16); }
__device__ __forceinline__ float bflo(unsigned w) { return __builtin_bit_cast(float, w << 16); }
__device__ __forceinline__ float bfhi(unsigned w) { return __builtin_bit_cast(float, w & 0xffff0000u); }
__device__ __forceinline__ float sigmoidf_(float x) { return 1.f / (1.f + __expf(-x)); }
__device__ __forceinline__ float siluf_(float x) { return x / (1.f + __expf(-x)); }
__device__ __forceinline__ float wave_sum(float v) {
#pragma unroll
    for (int o = 1; o < 64; o <<= 1) v += __shfl_xor(v, o);
    return v;
}
__device__ __forceinline__ float sum16(float v) {
#pragma unroll
    for (int o = 1; o < 16; o <<= 1) v += __shfl_xor(v, o);
    return v;
}
__device__ __forceinline__ void unpack8(const u32x4 w, float (&o)[8]) {
    o[0] = bflo(w.x); o[1] = bfhi(w.x); o[2] = bflo(w.y); o[3] = bfhi(w.y); o[4] = bflo(w.z); o[5] = bfhi(w.z); o[6] = bflo(w.w); o[7] = bfhi(w.w);
}
__device__ __forceinline__ u32x4 pack8(const float (&v)[8]) { u32x4 w; w.x = pk2(v[0], v[1]); w.y = pk2(v[2], v[3]); w.z = pk2(v[4], v[5]); w.w = pk2(v[6], v[7]); return w; }

namespace pg8 {
constexpr int BM = 256, BK = 64, HALF = 128, HTB = HALF * BK * 2, STAGE_BYTES = 8 * HTB;
__host__ __device__ __forceinline__ int lds_byte(int r, int c) { const int st = (r >> 4) * 2 + (c >> 5), rr = r & 15, cc = c & 31, ob = rr * 64 + cc * 2; return st * 1024 + (ob ^ (((ob >> 9) & 1) << 5)); }
__host__ __device__ __forceinline__ void stage_rc(int b, int& R, int& C) { const int st = b / 1024, sb = b % 1024, swz = sb ^ (((sb >> 9) & 1) << 5); R = (st >> 1) * 16 + swz / 64; C = (st & 1) * 32 + (swz % 64) / 2; }
__host__ __device__ __forceinline__ int perm32(int rho) { const int n = rho >> 4, i = rho & 15; return 8 * (i >> 2) + 4 * n + (i & 3); }
__device__ __forceinline__ unsigned cvt_pk_bf16(float lo, float hi) { unsigned r; asm volatile("v_cvt_pk_bf16_f32 %0, %1, %2" : "=v"(r) : "v"(lo), "v"(hi)); return r; }

struct Unit { const char* A; const char* B; int pm, pn, e, base; };

template <class Epi, class Sched, bool GATHER, bool SP2>
__device__ __forceinline__ void gemm_phase(LAS unsigned char* lds, const int K, const Sched& S, const Epi& E) {
#if MK_REF_GEMM
    {
        const int tid = threadIdx.x, wid = tid >> 6, lane = tid & 63, wr = wid >> 2, wc = wid & 3, fr = lane & 15, fq = lane >> 4;
        Unit cur;
        for (int ui = 0; S.next(ui, cur); ++ui) {
            f32x4 acc[2][2][4][2];
            for (int ai = 0; ai < 2; ++ai) for (int m = 0; m < 4; ++m) {
                const int r = 128 * ai + 64 * wr + 16 * m + fr;
                const bf16* arow = GATHER ? (const bf16*)cur.A + (size_t)S.row_index(cur, r) * K : (const bf16*)cur.A + (size_t)r * K;
                for (int bj = 0; bj < 2; ++bj) for (int n = 0; n < 2; ++n) {
                    f32x4 a4 = {0.f, 0.f, 0.f, 0.f};
                    for (int i = 0; i < 4; ++i) { const int c = 128 * bj + 32 * wc + 8 * fq + 4 * n + i; const bf16* brow = (const bf16*)cur.B + (size_t)c * K;
                        float s = 0.f; for (int k = 0; k < K; ++k) s += bf2f(arow[k]) * bf2f(brow[k]); a4[i] = s; }
                    acc[ai][bj][m][n] = a4; } }
            E(acc, cur, wr, wc, fr, fq);
        }
        return;
    }
#else
    const int tid = threadIdx.x, wid = __builtin_amdgcn_readfirstlane(tid >> 6), lane = tid & 63, wr = wid >> 2, wc = wid & 3, fr = lane & 15, fq = lane >> 4;
    const int nt = K / BK;
    unsigned voffA[2], voffB[2]; int gR = 0, gC = 0;
#pragma unroll
    for (int i = 0; i < 2; ++i) { int R, C; stage_rc(tid * 16 + i * 8192, R, C); const int Rb = (R & ~31) + perm32(R & 31);
        voffA[i] = (unsigned)(R * K + C) * 2u; voffB[i] = (unsigned)(Rb * K + C) * 2u; if (i == 0) { gR = R; gC = C; } }
    const size_t kstep = (size_t)(BK * 2);
    const size_t hstep = (size_t)HALF * K * 2;
    const unsigned ldsw = (unsigned)wid * 1024u;
    const int aoff = lds_byte(wr * 64 + fr, fq * 8), boff = lds_byte(wc * 32 + fr, fq * 8);
#define PG8_SA(b, h) (((b) * 2 + (h)) * HTB)
#define PG8_SB(b, h) ((4 + (b) * 2 + (h)) * HTB)
#define PG8_STAGE(bufoff, gbase, voff) do { _Pragma("unroll") for (int _i = 0; _i < 2; ++_i) \
        __builtin_amdgcn_global_load_lds((const unsigned*)((const char*)(gbase) + (voff)[_i]), (LAS unsigned*)(lds + (bufoff) + ldsw + _i * 8192), 16, 0, 0); } while (0)
#define PG8_STAGE_A(bufoff, gbase, h, G) do { if constexpr (GATHER) { PG8_STAGE(bufoff, gbase, (G)[h]); } else { PG8_STAGE(bufoff, (gbase) + (h) * hstep, voffA); } } while (0)
#define PG8_LDA(dst, b, h) do { _Pragma("unroll") for (int m = 0; m < 4; ++m) _Pragma("unroll") for (int k = 0; k < 2; ++k) dst[m][k] = *(const LAS bf16x8*)(lds + PG8_SA(b, h) + aoff + m * 2048 + k * 1024); } while (0)
#define PG8_LDB(dst, b, h) do { _Pragma("unroll") for (int n = 0; n < 2; ++n) _Pragma("unroll") for (int k = 0; k < 2; ++k) dst[n][k] = *(const LAS bf16x8*)(lds + PG8_SB(b, h) + boff + n * 2048 + k * 1024); } while (0)
#define PG8_MMA(ai, bj, At, Bt) do { __builtin_amdgcn_s_setprio(1); _Pragma("unroll") for (int m = 0; m < 4; ++m) _Pragma("unroll") for (int n = 0; n < 2; ++n) _Pragma("unroll") for (int k = 0; k < 2; ++k) \
        acc[ai][bj][m][n] = __builtin_amdgcn_mfma_f32_16x16x32_bf16(Bt[n][k], At[m][k], acc[ai][bj][m][n], 0, 0, 0); __builtin_amdgcn_s_setprio(0); } while (0)
#define PG8_WAIT_V(n) asm volatile("s_waitcnt vmcnt(" #n ")" ::: "memory")
#define PG8_WAIT_L(n) asm volatile("s_waitcnt lgkmcnt(" #n ")" ::: "memory")
#define PG8_BAR __builtin_amdgcn_s_barrier()
#define PG8_SCHED __builtin_amdgcn_sched_barrier(0)
    Unit cur, nxt; int ui = 0;
    if (!S.next(0, cur)) return;
    f32x4 acc[2][2][4][2];
#pragma unroll
    for (int a = 0; a < 2; ++a)
#pragma unroll
        for (int b = 0; b < 2; ++b)
#pragma unroll
            for (int m = 0; m < 4; ++m)
#pragma unroll
                for (int n = 0; n < 2; ++n) acc[a][b][m][n] = (f32x4){0.f, 0.f, 0.f, 0.f};
    bf16x8 At[4][2], B0[2][2], B1[2][2];
    const char* cA = cur.A; const char* cB = cur.B;
    unsigned cG[2][2] = {{0u, 0u}, {0u, 0u}}, nG[2][2] = {{0u, 0u}, {0u, 0u}};
    if constexpr (GATHER) {
#pragma unroll
        for (int h = 0; h < 2; ++h)
#pragma unroll
            for (int i = 0; i < 2; ++i) cG[h][i] = ((unsigned)S.row_index(cur, 128 * h + gR + 64 * i) * (unsigned)K + (unsigned)gC) * 2u;
    }
    if constexpr (SP2) {
        PG8_STAGE(PG8_SB(0, 0), cB, voffB); PG8_STAGE(PG8_SB(0, 1), cB + hstep, voffB); PG8_STAGE_A(PG8_SA(0, 0), cA, 0, cG); PG8_STAGE_A(PG8_SA(0, 1), cA, 1, cG);
        if (wr == 1) PG8_BAR;
        PG8_WAIT_V(2); PG8_BAR;
        PG8_STAGE(PG8_SB(1, 0), cB + kstep, voffB); PG8_STAGE_A(PG8_SA(1, 0), cA + kstep, 0, cG); PG8_STAGE(PG8_SB(1, 1), cB + hstep + kstep, voffB);
        PG8_WAIT_V(6); PG8_BAR;
    } else {
        PG8_STAGE(PG8_SB(0, 0), cB, voffB); PG8_STAGE_A(PG8_SA(0, 0), cA, 0, cG); PG8_STAGE(PG8_SB(0, 1), cB + hstep, voffB); PG8_STAGE_A(PG8_SA(0, 1), cA, 1, cG);
        if (wr == 1) PG8_BAR;
        PG8_WAIT_V(4); PG8_BAR;
        PG8_STAGE(PG8_SB(1, 0), cB + kstep, voffB); PG8_STAGE_A(PG8_SA(1, 0), cA + kstep, 0, cG); PG8_STAGE(PG8_SB(1, 1), cB + hstep + kstep, voffB);
        PG8_WAIT_V(6); PG8_BAR;
    }
    for (;;) {
        const bool has_next = S.next(ui + 1, nxt);
        const char* nA = has_next ? nxt.A : cA; const char* nB = has_next ? nxt.B : cB;
        for (int t = 0; t < nt; t += 2) {
            const bool last = (t == nt - 2);
            const char* a1 = cA + (size_t)(t + 1) * kstep;
            const char* a2 = last ? nA : cA + (size_t)(t + 2) * kstep; const char* b2 = last ? nB : cB + (size_t)(t + 2) * kstep;
            const char* a3 = a2 + kstep; const char* b3 = b2 + kstep;
            unsigned g2[2][2] = {{0u, 0u}, {0u, 0u}};
            if constexpr (GATHER) {
                if (last) {
                    if (has_next) {
#pragma unroll
                        for (int h = 0; h < 2; ++h)
#pragma unroll
                            for (int i = 0; i < 2; ++i) nG[h][i] = ((unsigned)S.row_index(nxt, 128 * h + gR + 64 * i) * (unsigned)K + (unsigned)gC) * 2u;
                    } else {
#pragma unroll
                        for (int h = 0; h < 2; ++h)
#pragma unroll
                            for (int i = 0; i < 2; ++i) nG[h][i] = cG[h][i];
                    }
                }
#pragma unroll
                for (int h = 0; h < 2; ++h)
#pragma unroll
                    for (int i = 0; i < 2; ++i) g2[h][i] = last ? nG[h][i] : cG[h][i];
            }
            if constexpr (SP2) {
            PG8_LDB(B0, 0, 0); PG8_LDB(B1, 0, 1); PG8_SCHED; PG8_LDA(At, 0, 0); PG8_STAGE_A(PG8_SA(1, 1), a1, 1, cG);
            PG8_WAIT_V(8); PG8_WAIT_L(0); PG8_BAR; PG8_MMA(0, 0, At, B0); PG8_MMA(0, 1, At, B1); PG8_BAR; PG8_SCHED;
            PG8_LDA(At, 0, 1); PG8_STAGE(PG8_SB(0, 0), b2, voffB); PG8_STAGE(PG8_SB(0, 1), b2 + hstep, voffB); PG8_STAGE_A(PG8_SA(0, 0), a2, 0, g2);
            PG8_WAIT_V(8); PG8_WAIT_L(0); PG8_BAR; PG8_MMA(1, 0, At, B0); PG8_MMA(1, 1, At, B1); PG8_BAR; PG8_SCHED;
            PG8_LDB(B0, 1, 0); PG8_LDB(B1, 1, 1); PG8_SCHED; PG8_LDA(At, 1, 0); PG8_STAGE_A(PG8_SA(0, 1), a2, 1, g2);
            PG8_WAIT_V(8); PG8_WAIT_L(0); PG8_BAR; PG8_MMA(0, 0, At, B0); PG8_MMA(0, 1, At, B1); PG8_BAR; PG8_SCHED;
            PG8_LDA(At, 1, 1); PG8_STAGE(PG8_SB(1, 0), b3, voffB); PG8_STAGE(PG8_SB(1, 1), b3 + hstep, voffB); PG8_STAGE_A(PG8_SA(1, 0), a3, 0, g2);
            PG8_WAIT_V(8); PG8_WAIT_L(0); PG8_BAR; PG8_MMA(1, 0, At, B0); PG8_MMA(1, 1, At, B1); PG8_BAR; PG8_SCHED;
            } else {
            PG8_LDB(B0, 0, 0); PG8_SCHED; PG8_LDA(At, 0, 0); PG8_STAGE_A(PG8_SA(1, 1), a1, 1, cG);
            PG8_WAIT_L(8); PG8_BAR; PG8_WAIT_L(0); PG8_MMA(0, 0, At, B0); PG8_BAR; PG8_SCHED;
            PG8_LDB(B1, 0, 1); PG8_STAGE(PG8_SB(0, 0), b2, voffB);
            PG8_BAR; PG8_WAIT_L(0); PG8_MMA(0, 1, At, B1); PG8_BAR;
            PG8_LDA(At, 0, 1); PG8_STAGE_A(PG8_SA(0, 0), a2, 0, g2);
            PG8_BAR; PG8_WAIT_L(0); PG8_MMA(1, 0, At, B0); PG8_BAR; PG8_SCHED;
            PG8_STAGE(PG8_SB(0, 1), b2 + hstep, voffB);
            PG8_WAIT_V(6); PG8_BAR; PG8_MMA(1, 1, At, B1); PG8_BAR;
            PG8_LDB(B0, 1, 0); PG8_SCHED; PG8_LDA(At, 1, 0); PG8_STAGE_A(PG8_SA(0, 1), a2, 1, g2);
            PG8_WAIT_L(8); PG8_BAR; PG8_WAIT_L(0); PG8_MMA(0, 0, At, B0); PG8_BAR; PG8_SCHED;
            PG8_LDB(B1, 1, 1); PG8_STAGE(PG8_SB(1, 0), b3, voffB);
            PG8_BAR; PG8_WAIT_L(0); PG8_MMA(0, 1, At, B1); PG8_BAR;
            PG8_LDA(At, 1, 1); PG8_STAGE_A(PG8_SA(1, 0), a3, 0, g2);
            PG8_BAR; PG8_WAIT_L(0); PG8_MMA(1, 0, At, B0); PG8_BAR; PG8_SCHED;
            PG8_STAGE(PG8_SB(1, 1), b3 + hstep, voffB);
            PG8_WAIT_V(6); PG8_BAR; PG8_MMA(1, 1, At, B1); PG8_BAR;
            }
        }
        if (wr == 0) PG8_BAR;
        { int tz = threadIdx.x; asm volatile("" : "+v"(tz)); const int wid_ = __builtin_amdgcn_readfirstlane(tz >> 6), lane_ = tz & 63;
          E(acc, cur, wid_ >> 2, wid_ & 3, lane_ & 15, lane_ >> 4); }
        if (!has_next) break;
#pragma unroll
        for (int a = 0; a < 2; ++a)
#pragma unroll
            for (int b = 0; b < 2; ++b)
#pragma unroll
                for (int m = 0; m < 4; ++m)
#pragma unroll
                    for (int n = 0; n < 2; ++n) acc[a][b][m][n] = (f32x4){0.f, 0.f, 0.f, 0.f};
        cur = nxt; cA = nA; cB = nB; ++ui;
        if constexpr (GATHER) {
#pragma unroll
            for (int h = 0; h < 2; ++h)
#pragma unroll
                for (int i = 0; i < 2; ++i) cG[h][i] = nG[h][i];
        }
        if (wr == 1) PG8_BAR;
    }
    PG8_WAIT_V(0);
    PG8_BAR;
#undef PG8_SA
#undef PG8_SB
#undef PG8_STAGE
#undef PG8_STAGE_A
#undef PG8_LDA
#undef PG8_LDB
#undef PG8_MMA
#undef PG8_WAIT_V
#undef PG8_WAIT_L
#undef PG8_BAR
#undef PG8_SCHED
#endif
}
}
constexpr bool SP2 = true;

#define XB_TMO      128
#define XB_XCNT(j)  (256  + 64 * (j))
#define XB_XSUB(j)  (1280 + 64 * (j))
#define XB_XGEN(j)  (2304 + 64 * (j))
#define XB_TOP      3328
#define XB_TOPGEN   3392
#define XCD_BAR_WORDS 3456
#define XB_SPIN_CAP (1u << 18)
__device__ __forceinline__ unsigned xb_ld(unsigned* p)              { return __hip_atomic_load(p, __ATOMIC_RELAXED, __HIP_MEMORY_SCOPE_AGENT); }
__device__ __forceinline__ unsigned xb_add(unsigned* p, unsigned v) { return __hip_atomic_fetch_add(p, v, __ATOMIC_RELAXED, __HIP_MEMORY_SCOPE_AGENT); }
__device__ __forceinline__ unsigned xb_xcc_id() { return (unsigned)__builtin_amdgcn_s_getreg((3 << 11) | 20) & 0xFu; }
#define XB_SPIN(cond, bar) do { unsigned _sp = 0; while (cond) { __builtin_amdgcn_s_sleep(1); \
    if ((++_sp & 255u) == 0u) { if (xb_ld(&(bar)[XB_TMO])) break; if (_sp > XB_SPIN_CAP) { atomicAdd(&(bar)[XB_TMO], 1u); break; } } } } while (0)
struct XcdBarrier { unsigned* bar; unsigned x; volatile LAS unsigned* st; };
__device__ __forceinline__ XcdBarrier xcd_barrier_post(unsigned* bar, volatile LAS unsigned* st) {
    XcdBarrier b; b.bar = bar; b.x = xb_xcc_id(); b.st = st;
    if (threadIdx.x == 0) (void)xb_add(&bar[XB_XCNT(b.x)], 1u);
    return b;
}
__device__ __forceinline__ void xcd_barrier_complete(unsigned* bar, unsigned x, unsigned& nloc, unsigned& nx) {
    const unsigned G = gridDim.x * gridDim.y * gridDim.z;
    unsigned sum, cnt, mine, sp = 0u;
    for (;;) {
        sum = 0u; cnt = 0u; mine = 0u;
#pragma unroll
        for (unsigned j = 0; j < 16; ++j) { const unsigned c = xb_ld(&bar[XB_XCNT(j)]); sum += c; cnt += (c > 0u) ? 1u : 0u; mine = (j == x) ? c : mine; }
        if (sum == G) break;
        __builtin_amdgcn_s_sleep(1);
        if ((++sp & 255u) == 0u) { if (xb_ld(&bar[XB_TMO])) break; if (sp > XB_SPIN_CAP) { atomicAdd(&bar[XB_TMO], 1u); break; } }
    }
    nloc = mine > 0u ? mine : 1u; nx = cnt > 0u ? cnt : 1u;
}
__device__ __forceinline__ void xcd_barrier(const XcdBarrier& b) {
    asm volatile("s_waitcnt vmcnt(0)" ::: "memory");
    __syncthreads();
    if (threadIdx.x == 0) {
        unsigned* bar = b.bar;
        __builtin_amdgcn_s_waitcnt(0);
        unsigned nloc = b.st[0], nx = b.st[1];
        if (nloc == 0u) { xcd_barrier_complete(bar, b.x, nloc, nx); b.st[0] = nloc; b.st[1] = nx; }
        const unsigned old = xb_add(&bar[XB_XSUB(b.x)], 1u);
        const unsigned gen = old / nloc;
        if (old + 1u == (gen + 1u) * nloc) {
            __builtin_amdgcn_fence(__ATOMIC_RELEASE, "agent");
            asm volatile("s_waitcnt vmcnt(0)" ::: "memory");
            const unsigned og = xb_add(&bar[XB_TOP], 1u);
            const unsigned tg = og / nx;
            if (og + 1u == (tg + 1u) * nx) xb_add(&bar[XB_TOPGEN], 1u);
            else XB_SPIN(xb_ld(&bar[XB_TOPGEN]) == tg, bar);
            __builtin_amdgcn_fence(__ATOMIC_ACQUIRE, "agent");
            xb_add(&bar[XB_XGEN(b.x)], 1u);
            asm volatile("s_waitcnt vmcnt(0)" ::: "memory");
        } else {
            XB_SPIN(xb_ld(&bar[XB_XGEN(b.x)]) == gen, bar);
            __builtin_amdgcn_fence(__ATOMIC_ACQUIRE, "agent");
            asm volatile("s_waitcnt vmcnt(0)" ::: "memory");
        }
    }
    __syncthreads();
}

constexpr int NWAVES = 8, NTHR = 512;
constexpr int RING_BYTES = 131072, MISC_OFF = 139264, LDS_BYTES = 147456;
struct Args {
    const float* in[28]; float* out; unsigned char* ws; int ph_lo, ph_hi;
};
struct Frame {
    LAS unsigned char* lds; int tid, lane, wave, G, bid;
    const float *x, *c, *ctx, *c_ctx, *w_mod, *b_mod, *n_mix_pre, *n_mix_post, *n_ffn_pre, *n_ffn_post, *w_in, *gdn_conv, *ret_log_decay, *gdn_a_log, *gdn_dt_bias,
        *ret_gn_w, *gdn_norm_w, *w_ret_out, *w_gdn_out, *w_o, *w_router, *router_bias, *w_gate, *w_up, *w_down, *w_sh_gate, *w_sh_up, *w_sh_down;
    float* out; unsigned char* ws; unsigned* ctl;
};
#define WSP(T, off) ((T*)(F.ws + (off)))

template <class CM>
__device__ __forceinline__ void transpose_item(const float* W, int ld, int K, bf16* WT, LAS float* scr, int kb, int nb, int lane, const CM& cm) {
    const int k0 = 64 * kb, n0 = 32 * nb; const int sc = cm(n0 + (lane & 31));
#pragma unroll 8
    for (int i = 0; i < 32; ++i) { const int kk = 2 * i + (lane >> 5); scr[kk * 33 + (lane & 31)] = W[(size_t)(k0 + kk) * ld + sc]; }
    asm volatile("s_waitcnt lgkmcnt(0)" ::: "memory");
    const int c = lane & 7;
#pragma unroll
    for (int j = 0; j < 4; ++j) { const int n = (lane >> 3) + 8 * j; const LAS float* s = scr + (8 * c) * 33 + n;
        u32x4 o; o.x = pk2(s[0 * 33], s[1 * 33]); o.y = pk2(s[2 * 33], s[3 * 33]); o.z = pk2(s[4 * 33], s[5 * 33]); o.w = pk2(s[6 * 33], s[7 * 33]);
        *(u32x4*)(WT + (size_t)(n0 + n) * K + k0 + 8 * c) = o; }
    asm volatile("s_waitcnt lgkmcnt(0)" ::: "memory");
}
struct CmIdent { int off; __device__ __forceinline__ int operator()(int n) const { return n + off; } };
struct CmWin {
    __device__ __forceinline__ int operator()(int n) const {
        const int g = n >> 9; int src = n + (n >= 2048 ? 16 : 0);
        if (g == 0 || g == 4) { const int hb = n & ~127, cp = n & 127; const int wc = cp >> 5, fq = (cp >> 3) & 3, nn = (cp >> 2) & 1, i = cp & 3;
            const int d = 64 * nn + 16 * wc + 4 * fq + i; src = hb + d + (n >= 2048 ? 16 : 0); }
        return src; }
};
__device__ __forceinline__ void gu_decode(int cp, int& hid, int& isup) { const int pn = cp >> 8, r = cp & 255, bj = r >> 7, wc = (r >> 5) & 3, fq = (r >> 3) & 3, nn = (r >> 2) & 1, i = r & 3; hid = pn * 128 + bj * 64 + wc * 16 + fq * 4 + i; isup = nn; }

__device__ __forceinline__ void phase_prologue(Frame& F) {
    const int gw = F.bid * NWAVES + F.wave, NGW = F.G * NWAVES; const int gt = F.bid * NTHR + F.tid, NGT = F.G * NTHR;
    LAS float* scr = (LAS float*)(F.lds + F.wave * 16384);
    { float2* rt = WSP(float2, WS_ROPE);
      for (int idx = gt; idx < SEQ * 64; idx += NGT) { const int t = idx >> 6, j = idx & 63; const float pos = (float)(j < 32 ? (t >> 6) : (t & 63)); const int f = j & 31;
          const float inv = powf(10000.0f, -(float)f / 32.0f); const float ang = pos * inv; float sn, cs; sincosf(ang, &sn, &cs); rt[idx] = make_float2(cs, sn); } }
    {
        LAS float* red = (LAS float*)(F.lds);
        for (int it = F.bid; it < 96; it += F.G) {
            const int col = it * 64 + F.lane; float a[5] = {0.f, 0.f, 0.f, 0.f, 0.f};
            const int kb = F.wave * 128;
#pragma unroll 4
            for (int k = kb; k < kb + 128; ++k) { const float w = F.w_mod[(size_t)k * 6144 + col];
#pragma unroll
                for (int r = 0; r < 5; ++r) { const float cv = r < 4 ? F.c[r * DM + k] : F.c_ctx[k]; a[r] += siluf_(cv) * w; } }
#pragma unroll
            for (int r = 0; r < 5; ++r) red[(F.wave * 5 + r) * 64 + F.lane] = a[r];
            __syncthreads();
            if (F.wave < 5) { float s = F.b_mod[col];
#pragma unroll
                for (int w = 0; w < 8; ++w) s += red[(w * 5 + F.wave) * 64 + F.lane];
                WSP(float, WS_MOD)[F.wave * 6144 + col] = s; }
            __syncthreads();
        }
    }
    {
        constexpr int I_IN = 16 * 192, I_RO = 8 * 32, I_O = 16 * 32; constexpr int NIT = I_IN + 2 * I_RO + I_O;
        for (int it = gw; it < NIT; it += NGW) { int r = it;
            if (r < I_IN) { transpose_item(F.w_in, N_IN, DM, WSP(bf16, WS_WIN), scr, r / 192, r % 192, F.lane, CmWin{}); continue; } r -= I_IN;
            if (r < I_RO) { transpose_item(F.w_ret_out, DM, 512, WSP(bf16, WS_WRO), scr, r / 32, r % 32, F.lane, CmIdent{0}); continue; } r -= I_RO;
            if (r < I_RO) { transpose_item(F.w_gdn_out, DM, 512, WSP(bf16, WS_WGO), scr, r / 32, r % 32, F.lane, CmIdent{0}); continue; } r -= I_RO;
            transpose_item(F.w_o, DM, DM, WSP(bf16, WS_WO), scr, r / 32, r % 32, F.lane, CmIdent{0}); }
    }
}

__device__ __forceinline__ void phase_moe_weights(Frame& F) {
    const int gw = F.bid * NWAVES + F.wave, NGW = F.G * NWAVES;
    LAS float* scr = (LAS float*)(F.lds + F.wave * 16384);
    constexpr int I_GU = 16 * 16  , I_D = 4 * 32;
    for (int it = gw; it < 65 * (I_GU + I_D); it += NGW) {
        const int e = it / (I_GU + I_D); int r = it % (I_GU + I_D);
        if (r < I_GU) {
            const int kb = r / 16, nb = r % 16;
            const int k0 = 64 * kb, n0 = 32 * nb; int hid, isup; gu_decode(n0 + (F.lane & 31), hid, isup);
            const float* Wg = e < 64 ? F.w_gate + (size_t)e * DM * DEXP : F.w_sh_gate; const float* Wu = e < 64 ? F.w_up + (size_t)e * DM * DEXP : F.w_sh_up;
            const float* W = isup ? Wu : Wg;
#pragma unroll 8
            for (int i = 0; i < 32; ++i) { const int kk = 2 * i + (F.lane >> 5); scr[kk * 33 + (F.lane & 31)] = W[(size_t)(k0 + kk) * DEXP + hid]; }
            asm volatile("s_waitcnt lgkmcnt(0)" ::: "memory");
            const int c = F.lane & 7; bf16* WT = WSP(bf16, WS_WGU) + (size_t)e * 512 * DM;
#pragma unroll
            for (int j = 0; j < 4; ++j) { const int n = (F.lane >> 3) + 8 * j; const LAS float* s = scr + (8 * c) * 33 + n;
                u32x4 o; o.x = pk2(s[0 * 33], s[1 * 33]); o.y = pk2(s[2 * 33], s[3 * 33]); o.z = pk2(s[4 * 33], s[5 * 33]); o.w = pk2(s[6 * 33], s[7 * 33]);
                *(u32x4*)(WT + (size_t)(n0 + n) * DM + k0 + 8 * c) = o; }
            asm volatile("s_waitcnt lgkmcnt(0)" ::: "memory");
        } else { r -= I_GU;
            const float* W = e < 64 ? F.w_down + (size_t)e * DEXP * DM : F.w_sh_down;
            transpose_item(W, DM, DEXP, WSP(bf16, WS_WD) + (size_t)e * DM * DEXP, scr, r / 32, r % 32, F.lane, CmIdent{0}); }
    }
}

__device__ __forceinline__ void phase_norm1(Frame& F) {
    const int gw = F.bid * NWAVES + F.wave, NGW = F.G * NWAVES;
    const float* mod = WSP(float, WS_MOD);
    for (int row = gw; row < NROW; row += NGW) {
        const int b = row / RPB, pos = row % RPB; const bool isctx = pos < CTXL;
        const float* src = isctx ? F.ctx + ((size_t)b * CTXL + pos) * DM : F.x + ((size_t)b * SEQ + (pos - CTXL)) * DM;
        const float* sh = isctx ? mod + 4 * 6144 : mod + b * 6144; const float* sc = sh + DM;
        f32x4 v[4]; float ss = 0.f;
#pragma unroll
        for (int j = 0; j < 4; ++j) { v[j] = *(const f32x4*)(src + 4 * (F.lane + 64 * j)); ss += v[j].x * v[j].x + v[j].y * v[j].y + v[j].z * v[j].z + v[j].w * v[j].w; }
        const float rstd = 1.0f / sqrtf(wave_sum(ss) * (1.f / DM) + EPS);
        float gd[16];
#pragma unroll
        for (int jj = 0; jj < 16; ++jj) gd[jj] = 0.f;
#pragma unroll
        for (int j = 0; j < 4; ++j) { const int c0 = 4 * (F.lane + 64 * j);
            const f32x4 g = *(const f32x4*)(F.n_mix_pre + c0), s1 = *(const f32x4*)(sc + c0), s0 = *(const f32x4*)(sh + c0);
            f32x4 h; h.x = v[j].x * rstd * g.x * (1.f + s1.x) + s0.x; h.y = v[j].y * rstd * g.y * (1.f + s1.y) + s0.y; h.z = v[j].z * rstd * g.z * (1.f + s1.z) + s0.z; h.w = v[j].w * rstd * g.w * (1.f + s1.w) + s0.w;
            u32x2 o; o.x = pk2(h.x, h.y); o.y = pk2(h.z, h.w);
            *(u32x2*)(WSP(bf16, WS_HX) + (size_t)row * DM + c0) = o;
#pragma unroll
            for (int q = 0; q < 4; ++q) { const float hv = q == 0 ? h.x : q == 1 ? h.y : q == 2 ? h.z : h.w; const float* wr = F.w_in + (size_t)(c0 + q) * N_IN + 2048;
#pragma unroll
                for (int jj = 0; jj < 4; ++jj) { const f32x4 w4 = *(const f32x4*)(wr + 4 * jj); gd[4 * jj] += hv * w4.x; gd[4 * jj + 1] += hv * w4.y; gd[4 * jj + 2] += hv * w4.z; gd[4 * jj + 3] += hv * w4.w; } } }
        float mine = 0.f;
#pragma unroll
        for (int jj = 0; jj < 16; ++jj) { const float s = wave_sum(gd[jj]); mine = (F.lane == jj) ? s : mine; }
        if (F.lane < 16) { const int ab = F.lane >> 3, dir = (F.lane >> 2) & 1, h = F.lane & 3; const size_t o = ((size_t)(dir * NB + b) * NH + h) * RPB + pos;
            if (ab == 0) { const float z = mine + F.gdn_dt_bias[dir * 4 + h]; const float sp = z > 20.f ? z : log1pf(expf(z)); WSP(float, WS_LOGA)[o] = -expf(F.gdn_a_log[dir * 4 + h]) * sp; }
            else WSP(float, WS_BETA)[o] = 1.f / (1.f + expf(-mine)); }
    }
}

struct SchedIn {
    const char* A; const char* B; int G, c;
    __device__ __forceinline__ bool next(int i, pg8::Unit& u) const {
        const int L = i * G + c; if (L >= 1536 + 32) return false;
        int lt, pn;
        if (L < 1536) { int wgid = L; { const int q = 1536 / 8, xcd = wgid % 8, off = wgid / 8; wgid = xcd * q + off; }
            const int nig = 8 * 24, gid = wgid / nig, fm = gid * 8; lt = fm + ((wgid % nig) % 8); pn = (wgid % nig) / 8; u.pm = (lt >> 4) * 17 + 1 + (lt & 15); }
        else { const int q = L - 1536; u.pm = (q >> 3) * 17; pn = q & 7; }
        u.pn = pn; u.e = 0; u.base = 0; u.A = A + (size_t)u.pm * 256 * DM * 2; u.B = B + (size_t)pn * 256 * DM * 2; return true; }
    __device__ __forceinline__ int row_index(const pg8::Unit&, int r) const { return r; }
};
struct EpiIn {
    bf16* P; bf16* GATES; const float2* rope;
    __device__ __forceinline__ void operator()(const f32x4 (&acc)[2][2][4][2], const pg8::Unit& u, int wr, int wc, int fr, int fq) const {
        const int g = u.pn >> 1;
        const int b = u.pm / 17, tl = u.pm % 17;
#pragma unroll
        for (int ai = 0; ai < 2; ++ai)
#pragma unroll
            for (int m = 0; m < 4; ++m) {
                const int rt = ai * 128 + wr * 64 + m * 16 + fr; const size_t prow = (size_t)u.pm * 256 + rt;
#pragma unroll
                for (int bj = 0; bj < 2; ++bj) {
                    f32x4 v0 = acc[ai][bj][m][0], v1 = acc[ai][bj][m][1];
                    const int ct = bj * 128 + wc * 32 + 8 * fq;
                    if (g == 0 || g == 4) {
                        const float s = (g == 0) ? 0.08838834764831845f : 1.0f; v0 = v0 * s; v1 = v1 * s;
                        const int j = 16 * wc + 4 * fq;
                        f32x4 o1 = v0, o2 = v1;
                        if (tl != 0) { const int t = (tl - 1) * 256 + rt; const float2* cs = rope + (size_t)t * 64 + j;
#pragma unroll
                            for (int i = 0; i < 4; ++i) { const float2 c2 = cs[i]; o1[i] = v0[i] * c2.x - v1[i] * c2.y; o2[i] = v0[i] * c2.y + v1[i] * c2.x; } }
                        bf16* dst = P + (size_t)g * PGRP + prow * 512 + (u.pn & 1) * 256 + bj * 128 + j;
                        u32x2 w1, w2; w1.x = pg8::cvt_pk_bf16(o1[0], o1[1]); w1.y = pg8::cvt_pk_bf16(o1[2], o1[3]); w2.x = pg8::cvt_pk_bf16(o2[0], o2[1]); w2.y = pg8::cvt_pk_bf16(o2[2], o2[3]);
                        *(u32x2*)dst = w1; *(u32x2*)(dst + 64) = w2;
                    } else if (g < 8) {
                        u32x4 w; w.x = pg8::cvt_pk_bf16(v0[0], v0[1]); w.y = pg8::cvt_pk_bf16(v0[2], v0[3]); w.z = pg8::cvt_pk_bf16(v1[0], v1[1]); w.w = pg8::cvt_pk_bf16(v1[2], v1[3]);
                        *(u32x4*)(P + (size_t)g * PGRP + prow * 512 + (u.pn & 1) * 256 + ct) = w;
                    } else {
                        const size_t lrow = (size_t)b * SEQ + (size_t)(tl - 1) * 256 + rt;
#pragma unroll
                        for (int i = 0; i < 4; ++i) { v0[i] = sigmoidf_(v0[i]); v1[i] = sigmoidf_(v1[i]); }
                        u32x4 w; w.x = pg8::cvt_pk_bf16(v0[0], v0[1]); w.y = pg8::cvt_pk_bf16(v0[2], v0[3]); w.z = pg8::cvt_pk_bf16(v1[0], v1[1]); w.w = pg8::cvt_pk_bf16(v1[2], v1[3]);
                        *(u32x4*)(GATES + lrow * 2048 + (u.pn - 16) * 256 + ct) = w;
                    }
                }
            }
    }
};

constexpr int IMGB = 34816, IMGS = 272;
typedef short s16x4 __attribute__((ext_vector_type(4)));
__device__ __forceinline__ unsigned offb(unsigned row, unsigned ch) { return 272u * row + 16u * ch; }
__device__ __forceinline__ unsigned offe(unsigned row, unsigned col) { return 272u * row + 2u * col; }
__device__ __forceinline__ bf16x8 frag_row(LAS unsigned char* img, int tile, int s, int lane) { return *(const LAS bf16x8*)(img + offb(16 * tile + (lane & 15), 4 * s + (lane >> 4))); }
__device__ __forceinline__ bf16x8 frag_tr(LAS unsigned char* img, int tile, int s, int lane) {
    const unsigned g = lane >> 4, qq = (lane & 15) >> 2, p = lane & 3;
    const s16x4 lo = __builtin_amdgcn_ds_read_tr16_b64_v4i16((LAS s16x4*)(img + offe(32 * s + 8 * g + qq, 16 * tile + 4 * p)));
    const s16x4 hi = __builtin_amdgcn_ds_read_tr16_b64_v4i16((LAS s16x4*)(img + offe(32 * s + 8 * g + 4 + qq, 16 * tile + 4 * p)));
    return (bf16x8){lo[0], lo[1], lo[2], lo[3], hi[0], hi[1], hi[2], hi[3]};
}
#define MFMA16(a, b, c) __builtin_amdgcn_mfma_f32_16x16x32_bf16(a, b, c, 0, 0, 0)
template <bool SWAP>
__device__ __forceinline__ void mm128(LAS unsigned char* ia, bool atr, LAS unsigned char* ib, bool btr, int wr, int wc, int lane, f32x4 (&acc)[2][4]) {
#pragma unroll
    for (int s = 0; s < 4; ++s) {
        bf16x8 fa[2], fb[4];
#pragma unroll
        for (int i = 0; i < 2; ++i) fa[i] = atr ? frag_tr(ia, 2 * wr + i, s, lane) : frag_row(ia, 2 * wr + i, s, lane);
#pragma unroll
        for (int j = 0; j < 4; ++j) fb[j] = btr ? frag_tr(ib, 4 * wc + j, s, lane) : frag_row(ib, 4 * wc + j, s, lane);
#pragma unroll
        for (int i = 0; i < 2; ++i)
#pragma unroll
            for (int j = 0; j < 4; ++j) acc[i][j] = SWAP ? MFMA16(fb[j], fa[i], acc[i][j]) : MFMA16(fa[i], fb[j], acc[i][j]);
    }
}
__device__ __forceinline__ void zero_acc(f32x4 (&acc)[2][4]) {
#pragma unroll
    for (int i = 0; i < 2; ++i)
#pragma unroll
        for (int j = 0; j < 4; ++j) acc[i][j] = (f32x4){0.f, 0.f, 0.f, 0.f};
}
__device__ __forceinline__ void st_img(LAS unsigned char* img, const f32x4 (&acc)[2][4], int wr, int wc, int lane) {
    const int r = lane & 15, q = lane >> 4;
#pragma unroll
    for (int i = 0; i < 2; ++i)
#pragma unroll
        for (int j = 0; j < 4; ++j) { u32x2 w; w.x = pk2(acc[i][j][0], acc[i][j][1]); w.y = pk2(acc[i][j][2], acc[i][j][3]);
            *(LAS u32x2*)(img + offe(32 * wr + 16 * i + r, 64 * wc + 16 * j + 4 * q)) = w; }
}
__device__ __forceinline__ void load_plain_img(LAS unsigned char* img, const bf16* src, int ld, int tid) {
#pragma unroll
    for (int i = 0; i < 4; ++i) { const int cidx = tid + 512 * i, row = cidx >> 4, ch = cidx & 15;
        *(LAS u32x4*)(img + offb(row, ch)) = *(const u32x4*)(src + (size_t)row * ld + 8 * ch); }
}
__device__ __forceinline__ void load_conv_img(LAS unsigned char* img, const bf16* src, const float* cw  , bool has_prev, bool has_next, int mode  , int wave, int lane) {
    asm volatile("" ::: "memory");
    const int ch = lane & 15; float w0[8], w1[8], w2[8];
#pragma unroll
    for (int i = 0; i < 8; ++i) { w0[i] = cw[8 * ch + i]; w1[i] = cw[1536 + 8 * ch + i]; w2[i] = cw[3072 + 8 * ch + i]; }
#pragma unroll
    for (int it = 0; it < 4; ++it) {
        const int row = 32 * it + 4 * wave + (lane >> 4); const u32x4 z4 = {0u, 0u, 0u, 0u};
        const u32x4 r0 = (row > 0 || has_prev) ? *(const u32x4*)(src + ((ptrdiff_t)row - 1) * 512 + 8 * ch) : z4;
        const u32x4 r1 = *(const u32x4*)(src + (size_t)row * 512 + 8 * ch);
        const u32x4 r2 = (row < 127 || has_next) ? *(const u32x4*)(src + (size_t)(row + 1) * 512 + 8 * ch) : z4;
        float a0[8], a1[8], a2[8], y[8]; unpack8(r0, a0); unpack8(r1, a1); unpack8(r2, a2); float ss = 0.f;
#pragma unroll
        for (int i = 0; i < 8; ++i) { y[i] = siluf_(w0[i] * a0[i] + w1[i] * a1[i] + w2[i] * a2[i]); ss += y[i] * y[i]; }
        if (mode != 1) { const float sc = (1.0f / sqrtf(sum16(ss) + EPS)) * (mode == 2 ? 0.08838834764831845f : 1.0f);
#pragma unroll
            for (int i = 0; i < 8; ++i) y[i] *= sc; }
        *(LAS u32x4*)(img + offb(row, ch)) = pack8(y);
    }
}
__device__ __forceinline__ void scale_rows_img(LAS unsigned char* dst, LAS unsigned char* src, const LAS float* rs, int tid) {
#pragma unroll
    for (int i = 0; i < 4; ++i) { const int cidx = tid + 512 * i, row = cidx >> 4, ch = cidx & 15; float v[8]; unpack8(*(const LAS u32x4*)(src + offb(row, ch)), v); const float sc = rs[row];
#pragma unroll
        for (int e = 0; e < 8; ++e) v[e] *= sc;
        *(LAS u32x4*)(dst + offb(row, ch)) = pack8(v); }
}
__device__ __forceinline__ void tri_inverse(LAS unsigned char* img, int w, int lane) {
    const int r = lane & 15, q = lane >> 4;
    {
        const int b0 = 16 * w; float x[16];
#pragma unroll
        for (int i = 0; i < 16; ++i) { float v = (i == r) ? 1.f : 0.f;
#pragma unroll
            for (int j = 0; j < i; ++j) v -= bf2f(*(const LAS unsigned short*)(img + offe(b0 + i, b0 + j))) * x[j];
            x[i] = v; }
        if (q == 0) {
#pragma unroll
            for (int i = 0; i < 16; ++i) *(LAS unsigned short*)(img + offe(b0 + i, b0 + r)) = (unsigned short)f2bf(x[i]); }
    }
    __syncthreads();
    if (w < 4) {
        const int c0 = 32 * w, r1 = c0 + 16;
        const u32x2 av = *(const LAS u32x2*)(img + offe(r1 + r, c0 + 4 * q));
        const bf16x8 fa = __builtin_bit_cast(bf16x8, (u32x4){av.x, av.y, 0u, 0u});
        const s16x4 tb = __builtin_amdgcn_ds_read_tr16_b64_v4i16((LAS s16x4*)(img + offe(c0 + 4 * q + (r >> 2), c0 + 4 * (r & 3))));
        const bf16x8 fb = (bf16x8){tb[0], tb[1], tb[2], tb[3], 0, 0, 0, 0};
        const f32x4 y = MFMA16(fa, fb, ((f32x4){0.f, 0.f, 0.f, 0.f}));
        const bf16x8 fy = __builtin_bit_cast(bf16x8, (u32x4){pk2(y[0], y[1]), pk2(y[2], y[3]), 0u, 0u});
        const u32x2 tv = *(const LAS u32x2*)(img + offe(r1 + r, r1 + 4 * q));
        const bf16x8 ft = __builtin_bit_cast(bf16x8, (u32x4){tv.x, tv.y, 0u, 0u});
        const f32x4 d = MFMA16(fy, ft, ((f32x4){0.f, 0.f, 0.f, 0.f}));
        u32x2 o; o.x = pk2(-d[0], -d[1]); o.y = pk2(-d[2], -d[3]);
        *(LAS u32x2*)(img + offe(r1 + r, c0 + 4 * q)) = o;
    }
    __syncthreads();
    {
        const int p = w >> 2, ti = (w >> 1) & 1, tj = w & 1, base = 64 * p, rb = base + 32;
        f32x4 y[2];
        const unsigned g = lane >> 4, qq = (lane & 15) >> 2, pp = lane & 3;
        const s16x4 lo = __builtin_amdgcn_ds_read_tr16_b64_v4i16((LAS s16x4*)(img + offe(base + 8 * g + qq, base + 16 * tj + 4 * pp)));
        const s16x4 hi = __builtin_amdgcn_ds_read_tr16_b64_v4i16((LAS s16x4*)(img + offe(base + 8 * g + 4 + qq, base + 16 * tj + 4 * pp)));
        const bf16x8 fb = (bf16x8){lo[0], lo[1], lo[2], lo[3], hi[0], hi[1], hi[2], hi[3]};
#pragma unroll
        for (int kt = 0; kt < 2; ++kt) { const bf16x8 fa = *(const LAS bf16x8*)(img + offb(rb + 16 * kt + r, (base >> 3) + q)); y[kt] = MFMA16(fa, fb, ((f32x4){0.f, 0.f, 0.f, 0.f})); }
        const bf16x8 fy = __builtin_bit_cast(bf16x8, (u32x4){pk2(y[0][0], y[0][1]), pk2(y[0][2], y[0][3]), pk2(y[1][0], y[1][1]), pk2(y[1][2], y[1][3])});
        const u32x2 t0 = *(const LAS u32x2*)(img + offe(rb + 16 * ti + r, rb + 4 * q)), t1 = *(const LAS u32x2*)(img + offe(rb + 16 * ti + r, rb + 16 + 4 * q));
        const bf16x8 ft = __builtin_bit_cast(bf16x8, (u32x4){t0.x, t0.y, t1.x, t1.y});
        const f32x4 d = MFMA16(fy, ft, ((f32x4){0.f, 0.f, 0.f, 0.f}));
        __syncthreads();
        u32x2 o; o.x = pk2(-d[0], -d[1]); o.y = pk2(-d[2], -d[3]);
        *(LAS u32x2*)(img + offe(rb + 16 * ti + r, base + 16 * tj + 4 * q)) = o;
    }
    __syncthreads();
    {
        const int tj = w >> 1, ti0 = 2 * (w & 1);
        f32x4 y[4];
#pragma unroll
        for (int kt = 0; kt < 4; ++kt) y[kt] = (f32x4){0.f, 0.f, 0.f, 0.f};
#pragma unroll
        for (int s = 0; s < 2; ++s) { const bf16x8 fb = frag_tr(img, tj, s, lane);
#pragma unroll
            for (int kt = 0; kt < 4; ++kt) y[kt] = MFMA16(frag_row(img, 4 + kt, s, lane), fb, y[kt]); }
        f32x4 d[2];
#pragma unroll
        for (int i = 0; i < 2; ++i) { d[i] = (f32x4){0.f, 0.f, 0.f, 0.f};
#pragma unroll
            for (int ks = 0; ks < 2; ++ks) {
                const bf16x8 fy = __builtin_bit_cast(bf16x8, (u32x4){pk2(y[2 * ks][0], y[2 * ks][1]), pk2(y[2 * ks][2], y[2 * ks][3]), pk2(y[2 * ks + 1][0], y[2 * ks + 1][1]), pk2(y[2 * ks + 1][2], y[2 * ks + 1][3])});
                const int row = 64 + 16 * (ti0 + i) + r;
                const u32x2 t0 = *(const LAS u32x2*)(img + offe(row, 64 + 32 * ks + 4 * q)), t1 = *(const LAS u32x2*)(img + offe(row, 64 + 32 * ks + 16 + 4 * q));
                d[i] = MFMA16(fy, __builtin_bit_cast(bf16x8, (u32x4){t0.x, t0.y, t1.x, t1.y}), d[i]); } }
        __syncthreads();
#pragma unroll
        for (int i = 0; i < 2; ++i) { u32x2 o; o.x = pk2(-d[i][0], -d[i][1]); o.y = pk2(-d[i][2], -d[i][3]);
            *(LAS u32x2*)(img + offe(64 + 16 * (ti0 + i) + r, 16 * tj + 4 * q)) = o; }
    }
    __syncthreads();
}

__device__ __forceinline__ void phase_prep(Frame& F) {
    LAS unsigned char* I0 = F.lds; LAS unsigned char* I1 = F.lds + IMGB; LAS unsigned char* I2 = F.lds + 2 * IMGB; LAS unsigned char* I3 = F.lds + 3 * IMGB;
    LAS float* sm = (LAS float*)(F.lds + MISC_OFF + 1024);
    LAS float* s_la = sm; LAS float* s_bet = sm + 128; LAS float* s_gc = sm + 256; LAS float* s_eg = sm + 384; LAS float* s_s2 = sm + 512; LAS float* s_t1 = sm + 640; LAS float* s_t2 = sm + 768;
#define LAUNDER() int tz_ = threadIdx.x; asm volatile("" : "+v"(tz_)); const int tid = tz_, lane = tz_ & 63, w = __builtin_amdgcn_readfirstlane(tz_ >> 6), wr = w >> 1, wc = w & 1, r = lane & 15, q = lane >> 4; (void)tid; (void)lane; (void)w; (void)wr; (void)wc; (void)r; (void)q
    const bf16* P = WSP(bf16, WS_P);
    for (int it = F.bid; it < 544; it += F.G) {
        int b, h, m;
        if (it < 512) { b = it >> 7; h = (it >> 5) & 3; m = 2 + (it & 31); } else { const int c = it - 512; b = c >> 3; h = (c >> 1) & 3; m = c & 1; }
        const bool isctx = m < 2; const int pos0 = 128 * m; const size_t row0 = (size_t)b * RPB + pos0; const size_t trow0 = (size_t)b * SEQ + (pos0 - CTXL);
        const bool hprev = isctx ? (m > 0) : (m > 2), hnext = isctx ? (m < 1) : (m < NCHUNK - 1);
        const size_t hoff = row0 * 512 + h * 128;
        const float lgf = F.ret_log_decay[h] * 1.4426950408889634f, lgb = F.ret_log_decay[4 + h] * 1.4426950408889634f;
        { LAUNDER();
        load_plain_img(I0, P + 0 * PGRP + hoff, 512, tid); load_plain_img(I1, P + 1 * PGRP + hoff, 512, tid);
        if (!isctx) load_plain_img(I2, P + 4 * PGRP + hoff, 512, tid);
        if (tid < 128) { s_t1[tid] = exp2f(lgf * (float)(127 - tid)); s_t2[tid] = exp2f(lgb * (float)tid); } }
        __syncthreads();
        f32x4 acc[2][4];
        if (!isctx) {
            { LAUNDER();
            zero_acc(acc); mm128<true>(I2, false, I0, false, wr, wc, lane, acc);
#pragma unroll
            for (int i = 0; i < 2; ++i)
#pragma unroll
                for (int j = 0; j < 4; ++j)
#pragma unroll
                    for (int e = 0; e < 4; ++e) { const int ii = 32 * wr + 16 * i + r, jj = 64 * wc + 16 * j + 4 * q + e; const int d = ii - jj;
                        const float wg = (d >= 0 ? exp2f(lgf * (float)d) : 0.f) + (d <= 0 ? exp2f(lgb * (float)(-d)) : 0.f); acc[i][j][e] *= wg; }
            st_img(I3, acc, wr, wc, lane); }
            __syncthreads();
            { LAUNDER();
            zero_acc(acc); mm128<true>(I3, false, I1, true, wr, wc, lane, acc);
            bf16* og = WSP(bf16, WS_ORET) + (trow0 + 32 * wr + r) * 512 + h * 128 + 64 * wc + 4 * q;
#pragma unroll
            for (int i = 0; i < 2; ++i)
#pragma unroll
                for (int j = 0; j < 4; ++j) { u32x2 o; o.x = pk2(acc[i][j][0], acc[i][j][1]); o.y = pk2(acc[i][j][2], acc[i][j][3]); *(u32x2*)(og + (size_t)(16 * i) * 512 + 16 * j) = o; } }
        }
#pragma unroll 1
        for (int dir = 0; dir < 2; ++dir) {
            LAS unsigned char* kw = dir ? I3 : I2;
            { LAUNDER(); scale_rows_img(kw, I0, dir ? s_t2 : s_t1, tid); }
            __syncthreads();
            LAUNDER();
            zero_acc(acc); mm128<false>(kw, true, I1, true, wr, wc, lane, acc);
            const int chain = (b * NH + h) * 2 + dir, n = dir ? (isctx ? 1 - m : 35 - m) : m;
            unsigned char* kv = F.ws + WS_GKV + ((size_t)chain * NCHUNK + n) * 32768;
#pragma unroll
            for (int i = 0; i < 2; ++i)
#pragma unroll
                for (int j = 0; j < 4; ++j) { const int mt = 2 * wr + i, nt = 4 * wc + j; u32x2 o; o.x = pk2(acc[i][j][0], acc[i][j][1]); o.y = pk2(acc[i][j][2], acc[i][j][3]);
                    *(u32x2*)(kv + ((size_t)((nt * 4 + (mt >> 1)) * 64 + (2 * (mt & 1) + (q >> 1)) * 16 + r)) * 16 + 8 * (q & 1)) = o; }
        }
        __syncthreads();
#pragma unroll 1
        for (int dir = 0; dir < 2; ++dir) {
            const int chain = (b * NH + h) * 2 + dir, n = dir ? (isctx ? 1 - m : 35 - m) : m;
            { LAUNDER(); load_conv_img(I0, P + 2 * PGRP + hoff, F.gdn_conv + 512 + h * 128, hprev, hnext, 0, w, lane); }
            { LAUNDER(); load_conv_img(I1, P + 3 * PGRP + hoff, F.gdn_conv + 1024 + h * 128, hprev, hnext, 1, w, lane); }
            { LAUNDER(); if (tid < 128) { const size_t o = ((size_t)(dir * NB + b) * NH + h) * RPB + pos0 + tid; s_la[tid] = WSP(float, WS_LOGA)[o]; s_bet[tid] = WSP(float, WS_BETA)[o]; } }
            __syncthreads();
            { LAUNDER();
            if (w == 0) {
                const float a = s_la[2 * lane], c = s_la[2 * lane + 1]; const float pr = a + c; float inc = pr;
#pragma unroll
                for (int o = 1; o < 64; o <<= 1) { const float t = __shfl_up(inc, o); if (lane >= o) inc += t; }
                const float tot = __shfl(inc, 63); const float ex = inc - pr;
                float g0 = ex + a, g1 = ex + pr;
                if (dir) { g0 = tot - ex; g1 = tot - (ex + a); }
                s_gc[2 * lane] = g0; s_gc[2 * lane + 1] = g1; s_eg[2 * lane] = __expf(g0); s_eg[2 * lane + 1] = __expf(g1);
                s_s2[2 * lane] = __expf(tot - g0); s_s2[2 * lane + 1] = __expf(tot - g1);
                if (lane == 0) s_t1[0] = __expf(tot);
            } }
            __syncthreads();
            { LAUNDER();
            zero_acc(acc); mm128<true>(I0, false, I0, false, wr, wc, lane, acc);
#pragma unroll
            for (int i = 0; i < 2; ++i)
#pragma unroll
                for (int j = 0; j < 4; ++j) { const int ii = 32 * wr + 16 * i + r; const float gi = s_gc[ii], bi = s_bet[ii];
#pragma unroll
                    for (int e = 0; e < 4; ++e) { const int jj = 64 * wc + 16 * j + 4 * q + e;
                        const float f = dir ? s_bet[jj] * __expf(s_gc[jj] - gi) : bi * __expf(gi - s_gc[jj]); acc[i][j][e] = (ii > jj) ? acc[i][j][e] * f : 0.f; } }
            st_img(I2, acc, wr, wc, lane); }
            __syncthreads();
            { LAUNDER(); tri_inverse(I2, w, lane); }
            { LAUNDER();
#pragma unroll
            for (int i = 0; i < 4; ++i) { const int cidx = tid + 512 * i, row = cidx >> 4, ch = cidx & 15; float v[8], v2[8]; unpack8(*(const LAS u32x4*)(I2 + offb(row, ch)), v);
#pragma unroll
                for (int e = 0; e < 8; ++e) { const int k = dir ? row : 8 * ch + e; const float bb = s_bet[k]; v[e] *= bb; v2[e] = v[e] * s_eg[k]; }
                *(LAS u32x4*)(I2 + offb(row, ch)) = pack8(v); *(LAS u32x4*)(I3 + offb(row, ch)) = pack8(v2); } }
            __syncthreads();
            { LAUNDER();
            zero_acc(acc); mm128<true>(I3, dir != 0, I0, true, wr, wc, lane, acc);
            __syncthreads();
            st_img(I3, acc, wr, wc, lane); }
            { LAUNDER();
            zero_acc(acc); mm128<true>(I2, dir != 0, I1, true, wr, wc, lane, acc);
            __syncthreads();
            st_img(I2, acc, wr, wc, lane);
            scale_rows_img(I1, I0, s_s2, tid); }
            __syncthreads();
            {
                LAUNDER();
                const float dtot = s_t1[0];
                zero_acc(acc); mm128<false>(I1, true, I2, true, wr, wc, lane, acc);
                unsigned char* gc = F.ws + WS_GC + ((size_t)chain * NCHUNK + n) * 32768;
#pragma unroll
                for (int i = 0; i < 2; ++i)
#pragma unroll
                    for (int j = 0; j < 4; ++j) { const int mt = 2 * wr + i, nt = 4 * wc + j; u32x2 o; o.x = pk2(acc[i][j][0], acc[i][j][1]); o.y = pk2(acc[i][j][2], acc[i][j][3]);
                        *(u32x2*)(gc + ((size_t)((nt * 8 + mt) * 64 + lane)) * 8) = o; }
                }
                { LAUNDER(); const float dtot = s_t1[0];
                zero_acc(acc); mm128<true>(I1, true, I3, true, wr, wc, lane, acc);
                unsigned char* gm = F.ws + WS_GM + ((size_t)chain * NCHUNK + n) * 32768;
#pragma unroll
                for (int i = 0; i < 2; ++i)
#pragma unroll
                    for (int j = 0; j < 4; ++j) { const int mt = 2 * wr + i, ct = 4 * wc + j; const int rowi = 16 * mt + r; float v[4];
#pragma unroll
                        for (int e = 0; e < 4; ++e) v[e] = ((rowi == 16 * ct + 4 * q + e) ? dtot : 0.f) - acc[i][j][e];
                        u32x2 o; o.x = pk2(v[0], v[1]); o.y = pk2(v[2], v[3]);
                        *(u32x2*)(gm + ((size_t)((mt * 4 + (ct >> 1)) * 64 + q * 16 + r)) * 16 + 8 * (ct & 1)) = o; }
            }
            __syncthreads();
            if (!isctx) {
                { LAUNDER(); load_conv_img(I1, P + 6 * PGRP + hoff, F.gdn_conv + h * 128, hprev, hnext, 2, w, lane); }
                __syncthreads();
                { LAUNDER();
                zero_acc(acc); mm128<true>(I1, false, I0, false, wr, wc, lane, acc);
#pragma unroll
                for (int i = 0; i < 2; ++i) { const int ii = 32 * wr + 16 * i + r; const float gi = s_gc[ii];
#pragma unroll
                    for (int j = 0; j < 4; ++j)
#pragma unroll
                        for (int e = 0; e < 4; ++e) { const int jj = 64 * wc + 16 * j + 4 * q + e; const bool on = dir ? (jj >= ii) : (jj <= ii);
                            acc[i][j][e] = on ? acc[i][j][e] * __expf(gi - s_gc[jj]) : 0.f; } }
                __syncthreads();
                st_img(I0, acc, wr, wc, lane); }
                __syncthreads();
                { LAUNDER();
                zero_acc(acc); mm128<true>(I0, false, I2, true, wr, wc, lane, acc);
                { bf16* ogp = WSP(bf16, WS_OGDN) + (trow0 + 32 * wr + r) * 512 + h * 128 + 64 * wc + 4 * q;
#pragma unroll
                  for (int i = 0; i < 2; ++i)
#pragma unroll
                    for (int j = 0; j < 4; ++j) { bf16* pp = ogp + (size_t)(16 * i) * 512 + 16 * j; f32x4 v = acc[i][j];
                        if (dir) { const u32x2 pv = *(const u32x2*)pp; v[0] += bflo(pv.x); v[1] += bfhi(pv.x); v[2] += bflo(pv.y); v[3] += bfhi(pv.y); }
                        u32x2 o; o.x = pk2(v[0], v[1]); o.y = pk2(v[2], v[3]); *(u32x2*)pp = o; } } }
                { LAUNDER();
                zero_acc(acc); mm128<true>(I0, false, I3, true, wr, wc, lane, acc);
                unsigned char* qt = F.ws + WS_GQT + ((size_t)chain * 32 + (n - 2)) * 32768;
#pragma unroll
                for (int i = 0; i < 2; ++i) { const int ii = 32 * wr + 16 * i + r; const float egi = s_eg[ii];
#pragma unroll
                    for (int j = 0; j < 4; ++j) { const int mt = 2 * wr + i, ct = 4 * wc + j; const u32x2 qv = *(const LAS u32x2*)(I1 + offe(ii, 64 * wc + 16 * j + 4 * q));
                        u32x2 o; o.x = pk2(egi * bflo(qv.x) - acc[i][j][0], egi * bfhi(qv.x) - acc[i][j][1]); o.y = pk2(egi * bflo(qv.y) - acc[i][j][2], egi * bfhi(qv.y) - acc[i][j][3]);
                        *(u32x2*)(qt + ((size_t)((mt * 4 + (ct >> 1)) * 64 + q * 16 + r)) * 16 + 8 * (ct & 1)) = o; } } }
                __syncthreads();
            }
        }
    }
#undef LAUNDER
}

__device__ __forceinline__ void phase_scan(Frame& F) {
    const int lane = F.lane, w = F.wave, tid = F.tid;
    for (int it = F.bid; it < 256; it += F.G) {
        if (it < 128) {
            const int chain = it >> 2, dq = it & 3;
            const unsigned char* gm = F.ws + WS_GM + (size_t)chain * NCHUNK * 32768; unsigned char* gc = F.ws + WS_GC + (size_t)chain * NCHUNK * 32768;
            const int nt = 2 * dq + (w & 1);
            bf16x8 sf[4];
#pragma unroll
            for (int s = 0; s < 4; ++s) sf[s] = (bf16x8){0, 0, 0, 0, 0, 0, 0, 0};
            u32x4 stg[4];
#pragma unroll
            for (int i = 0; i < 4; ++i) stg[i] = *(const u32x4*)(gm + (size_t)(tid + 512 * i) * 16);
#pragma unroll 1
            for (int n = 0; n < NCHUNK; ++n) {
                LAS unsigned char* buf = F.lds + (n & 1) * 32768;
#pragma unroll
                for (int i = 0; i < 4; ++i) *(LAS u32x4*)(buf + (size_t)(tid + 512 * i) * 16) = stg[i];
                if (n + 1 < NCHUNK) {
#pragma unroll
                    for (int i = 0; i < 4; ++i) stg[i] = *(const u32x4*)(gm + (size_t)(n + 1) * 32768 + (size_t)(tid + 512 * i) * 16); }
                __syncthreads();
                if (w < 2) {
                    unsigned char* slot = gc + (size_t)n * 32768 + (size_t)nt * 4096;
                    f32x4 acc[8];
#pragma unroll
                    for (int mt = 0; mt < 8; ++mt) { const u32x2 cv = *(const u32x2*)(slot + (size_t)(mt * 64 + lane) * 8); acc[mt] = (f32x4){bflo(cv.x), bfhi(cv.x), bflo(cv.y), bfhi(cv.y)}; }
#pragma unroll
                    for (int s = 0; s < 4; ++s)
#pragma unroll
                        for (int mt = 0; mt < 8; ++mt) acc[mt] = MFMA16(*(const LAS bf16x8*)(buf + (size_t)((mt * 4 + s) * 64 + lane) * 16), sf[s], acc[mt]);
#pragma unroll
                    for (int s = 0; s < 4; ++s) { const u32x4 pk = {pk2(acc[2 * s][0], acc[2 * s][1]), pk2(acc[2 * s][2], acc[2 * s][3]), pk2(acc[2 * s + 1][0], acc[2 * s + 1][1]), pk2(acc[2 * s + 1][2], acc[2 * s + 1][3])};
                        sf[s] = __builtin_bit_cast(bf16x8, pk); *(u32x4*)(slot + (size_t)(s * 64 + lane) * 16) = pk; }
                }
            }
            __syncthreads();
        } else {
            const int gidx = (it - 128) * NTHR + tid; const int chain = gidx >> 11, piece = gidx & 2047; const int h = (chain >> 1) & 3, dir = chain & 1;
            const float dec = expf(F.ret_log_decay[dir * 4 + h] * 128.f);
            unsigned char* kv = F.ws + WS_GKV + (size_t)chain * NCHUNK * 32768 + (size_t)piece * 16;
            float st[8];
#pragma unroll
            for (int e = 0; e < 8; ++e) st[e] = 0.f;
#pragma unroll 2
            for (int n = 0; n < NCHUNK; ++n) { float v[8]; unpack8(*(const u32x4*)(kv + (size_t)n * 32768), v);
#pragma unroll
                for (int e = 0; e < 8; ++e) st[e] = dec * st[e] + v[e];
                *(u32x4*)(kv + (size_t)n * 32768) = pack8(st); }
        }
    }
}

__device__ __forceinline__ void phase_out(Frame& F) {
    const int lane = F.lane, w = F.wave, r = lane & 15, q = lane >> 4;
    const bf16* P = WSP(bf16, WS_P);
    for (int it = F.bid; it < 512; it += F.G) {
        const int b = it >> 7, h = (it >> 5) & 3, m = 2 + (it & 31);
        const size_t prow = (size_t)b * RPB + 128 * m + 16 * w + r; const size_t trow = (size_t)b * SEQ + 128 * (m - 2) + 16 * w + r;
        const int il = 16 * w + r;
        f32x4 og[8], orr[8];
        {
            const bf16* a = WSP(bf16, WS_OGDN) + trow * 512 + h * 128 + 4 * q; const bf16* c = WSP(bf16, WS_ORET) + trow * 512 + h * 128 + 4 * q;
#pragma unroll
            for (int nt = 0; nt < 8; ++nt) { const u32x2 x = *(const u32x2*)(a + 16 * nt), y = *(const u32x2*)(c + 16 * nt);
                og[nt] = (f32x4){bflo(x.x), bfhi(x.x), bflo(x.y), bfhi(x.y)}; orr[nt] = (f32x4){bflo(y.x), bfhi(y.x), bflo(y.y), bfhi(y.y)}; }
        }
#pragma unroll 1
        for (int dir = 0; dir < 2; ++dir) {
            const int chain = (b * NH + h) * 2 + dir, n = dir ? 35 - m : m;
            {
                const unsigned char* qt = F.ws + WS_GQT + ((size_t)chain * 32 + (n - 2)) * 32768; const unsigned char* sp = F.ws + WS_GC + ((size_t)chain * NCHUNK + (n - 1)) * 32768;
#pragma unroll
                for (int s = 0; s < 4; ++s) { const bf16x8 fq = *(const bf16x8*)(qt + (size_t)((w * 4 + s) * 64 + lane) * 16);
#pragma unroll
                    for (int nt = 0; nt < 8; ++nt) og[nt] = MFMA16(*(const bf16x8*)(sp + (size_t)((nt * 4 + s) * 64 + lane) * 16), fq, og[nt]); }
            }
            {
                const unsigned char* sp = F.ws + WS_GKV + ((size_t)chain * NCHUNK + (n - 1)) * 32768; const bf16* qp = P + 4 * PGRP + prow * 512 + h * 128;
                f32x4 t[8];
#pragma unroll
                for (int nt = 0; nt < 8; ++nt) t[nt] = (f32x4){0.f, 0.f, 0.f, 0.f};
#pragma unroll
                for (int s = 0; s < 4; ++s) { const bf16x8 fq = *(const bf16x8*)(qp + 32 * s + 8 * q);
#pragma unroll
                    for (int nt = 0; nt < 8; ++nt) t[nt] = MFMA16(*(const bf16x8*)(sp + (size_t)((nt * 4 + s) * 64 + lane) * 16), fq, t[nt]); }
                const float lg = F.ret_log_decay[dir * 4 + h]; const float dcy = expf(lg * (float)(dir ? 128 - il : il + 1));
#pragma unroll
                for (int nt = 0; nt < 8; ++nt) orr[nt] = orr[nt] + t[nt] * dcy;
            }
        }
        {
            float s1 = 0.f;
#pragma unroll
            for (int nt = 0; nt < 8; ++nt) s1 += (orr[nt][0] + orr[nt][1]) + (orr[nt][2] + orr[nt][3]);
            s1 += __shfl_xor(s1, 16); s1 += __shfl_xor(s1, 32); const float mean = s1 * (1.f / 128.f);
            float s2 = 0.f, s3 = 0.f;
#pragma unroll
            for (int nt = 0; nt < 8; ++nt)
#pragma unroll
                for (int e = 0; e < 4; ++e) { const float d = orr[nt][e] - mean; s2 += d * d; s3 += og[nt][e] * og[nt][e]; }
            s2 += __shfl_xor(s2, 16); s2 += __shfl_xor(s2, 32); s3 += __shfl_xor(s3, 16); s3 += __shfl_xor(s3, 32);
            const float rs_r = 1.0f / sqrtf(s2 * (1.f / 128.f) + EPS), rs_g = 1.0f / sqrtf(s3 * (1.f / 128.f) + EPS);
            const bf16* rg = P + 5 * PGRP + prow * 512 + h * 128 + 4 * q; const bf16* gz = P + 7 * PGRP + prow * 512 + h * 128 + 4 * q;
            bf16* ry = WSP(bf16, WS_RETY) + trow * 512 + h * 128 + 4 * q; bf16* gy = WSP(bf16, WS_GDNY) + trow * 512 + h * 128 + 4 * q;
#pragma unroll
            for (int nt = 0; nt < 8; ++nt) { const u32x2 a = *(const u32x2*)(rg + 16 * nt), c = *(const u32x2*)(gz + 16 * nt);
                const float ga[4] = {bflo(a.x), bfhi(a.x), bflo(a.y), bfhi(a.y)}, gc4[4] = {bflo(c.x), bfhi(c.x), bflo(c.y), bfhi(c.y)};
                const f32x4 wr4 = *(const f32x4*)(F.ret_gn_w + h * 128 + 16 * nt + 4 * q), wg4 = *(const f32x4*)(F.gdn_norm_w + h * 128 + 16 * nt + 4 * q);
                float yr[4], yg[4];
#pragma unroll
                for (int e = 0; e < 4; ++e) { yr[e] = (orr[nt][e] - mean) * rs_r * wr4[e] * siluf_(ga[e]); yg[e] = og[nt][e] * rs_g * wg4[e] * siluf_(gc4[e]); }
                u32x2 o1, o2; o1.x = pk2(yr[0], yr[1]); o1.y = pk2(yr[2], yr[3]); o2.x = pk2(yg[0], yg[1]); o2.y = pk2(yg[2], yg[3]);
                *(u32x2*)(ry + 16 * nt) = o1; *(u32x2*)(gy + 16 * nt) = o2; }
        }
    }
}

struct SchedMerge {
    const char *A0, *A1, *B0, *B1; int G, c;
    __device__ __forceinline__ bool next(int i, pg8::Unit& u) const {
        const int L = (i >> 1) * G + c; if (L >= 256) return false; const int term = i & 1;
        const int xcd = L % 8, off = L / 8; const int w = xcd * 32 + off;
        u.pm = w >> 2; u.pn = w & 3; u.e = term; u.base = 0;
        u.A = (term ? A1 : A0) + (size_t)u.pm * 256 * 512 * 2; u.B = (term ? B1 : B0) + (size_t)u.pn * 256 * 512 * 2; return true; }
    __device__ __forceinline__ int row_index(const pg8::Unit&, int r) const { return r; }
};
struct EpiMerge {
    const bf16* GATES; bf16* TMP; bf16* MERGED;
    __device__ __forceinline__ void operator()(const f32x4 (&acc)[2][2][4][2], const pg8::Unit& u, int wr, int wc, int fr, int fq) const {
#pragma unroll
        for (int ai = 0; ai < 2; ++ai)
#pragma unroll
            for (int m = 0; m < 4; ++m) { const size_t row = (size_t)u.pm * 256 + ai * 128 + wr * 64 + m * 16 + fr;
#pragma unroll
                for (int bj = 0; bj < 2; ++bj) { const int col = u.pn * 256 + bj * 128 + wc * 32 + 8 * fq;
                    float g[8]; unpack8(*(const u32x4*)(GATES + row * 2048 + u.e * 1024 + col), g);
                    float v[8] = {acc[ai][bj][m][0][0], acc[ai][bj][m][0][1], acc[ai][bj][m][0][2], acc[ai][bj][m][0][3], acc[ai][bj][m][1][0], acc[ai][bj][m][1][1], acc[ai][bj][m][1][2], acc[ai][bj][m][1][3]};
                    if (u.e == 0) {
#pragma unroll
                        for (int i = 0; i < 8; ++i) v[i] *= g[i];
                        *(u32x4*)(TMP + row * DM + col) = pack8(v);
                    } else { float p[8]; unpack8(*(const u32x4*)(TMP + row * DM + col), p);
#pragma unroll
                        for (int i = 0; i < 8; ++i) v[i] = p[i] + v[i] * g[i];
                        *(u32x4*)(MERGED + row * DM + col) = pack8(v); } } }
    }
};
struct SchedDense {
    const char *A, *B; int nM, nN, K, G, c;
    __device__ __forceinline__ bool next(int i, pg8::Unit& u) const {
        const int L = i * G + c; const int nwg = nM * nN; if (L >= nwg) return false;
        int w = L; if (nwg % 8 == 0) { const int xcd = L % 8, off = L / 8; w = xcd * (nwg / 8) + off; }
        u.pm = w / nN; u.pn = w % nN; u.e = 0; u.base = 0; u.A = A + (size_t)u.pm * 256 * K * 2; u.B = B + (size_t)u.pn * 256 * K * 2; return true; }
    __device__ __forceinline__ int row_index(const pg8::Unit&, int r) const { return r; }
};
struct EpiBf16Store { bf16* O; int ldc;
    __device__ __forceinline__ void operator()(const f32x4 (&acc)[2][2][4][2], const pg8::Unit& u, int wr, int wc, int fr, int fq) const {
#pragma unroll
        for (int ai = 0; ai < 2; ++ai)
#pragma unroll
            for (int m = 0; m < 4; ++m) { const size_t row = (size_t)u.pm * 256 + ai * 128 + wr * 64 + m * 16 + fr;
#pragma unroll
                for (int bj = 0; bj < 2; ++bj) { const int col = u.pn * 256 + bj * 128 + wc * 32 + 8 * fq; const f32x4 v0 = acc[ai][bj][m][0], v1 = acc[ai][bj][m][1];
                    u32x4 w; w.x = pg8::cvt_pk_bf16(v0[0], v0[1]); w.y = pg8::cvt_pk_bf16(v0[2], v0[3]); w.z = pg8::cvt_pk_bf16(v1[0], v1[1]); w.w = pg8::cvt_pk_bf16(v1[2], v1[3]);
                    *(u32x4*)(O + row * ldc + col) = w; } }
    }
};

__device__ __forceinline__ void load_row_bf16(const bf16* p, int lane, float (&v)[16]) { float a[8], b[8]; unpack8(*(const u32x4*)(p + 8 * lane), a); unpack8(*(const u32x4*)(p + 512 + 8 * lane), b);
#pragma unroll
    for (int i = 0; i < 8; ++i) { v[i] = a[i]; v[8 + i] = b[i]; } }
__device__ __forceinline__ void load_row_f32(const float* p, int lane, float (&v)[16]) {
#pragma unroll
    for (int q = 0; q < 4; ++q) { const f32x4 a = *(const f32x4*)(p + (q >> 1) * 512 + 8 * lane + 4 * (q & 1)); v[4 * q] = a.x; v[4 * q + 1] = a.y; v[4 * q + 2] = a.z; v[4 * q + 3] = a.w; } }
__device__ __forceinline__ void store_row_f32(float* p, int lane, const float (&v)[16]) {
#pragma unroll
    for (int q = 0; q < 4; ++q) *(f32x4*)(p + (q >> 1) * 512 + 8 * lane + 4 * (q & 1)) = (f32x4){v[4 * q], v[4 * q + 1], v[4 * q + 2], v[4 * q + 3]}; }
__device__ __forceinline__ void compute_x1(Frame& F, int t, float (&x1)[16]) {
    const int b = t / SEQ; const float* mod = WSP(float, WS_MOD) + b * 6144;
    float mo[16], xv[16], wv[16], g1[16]; load_row_bf16(WSP(bf16, WS_MO) + (size_t)t * DM, F.lane, mo); load_row_f32(F.x + (size_t)t * DM, F.lane, xv);
    load_row_f32(F.n_mix_post, F.lane, wv); load_row_f32(mod + 2 * DM, F.lane, g1);
    float ss = 0.f;
#pragma unroll
    for (int i = 0; i < 16; ++i) ss += mo[i] * mo[i];
    const float rstd = 1.0f / sqrtf(wave_sum(ss) * (1.f / DM) + EPS);
#pragma unroll
    for (int i = 0; i < 16; ++i) x1[i] = xv[i] + g1[i] * (mo[i] * rstd * wv[i]);
}
__device__ __forceinline__ void phase_route(Frame& F) {
    const int gw = F.bid * NWAVES + F.wave, NGW = F.G * NWAVES;
    LAS float* hs = (LAS float*)(F.lds + F.wave * 4096);
    unsigned* cnt = F.ctl + CW_CNT; int* list = WSP(int, WS_LIST); float* selw = WSP(float, WS_SELW);
    for (int t = gw; t < NT; t += NGW) {
        const int b = t / SEQ; const float* mod = WSP(float, WS_MOD) + b * 6144;
        float x1[16]; compute_x1(F, t, x1);
        float ss = 0.f;
#pragma unroll
        for (int i = 0; i < 16; ++i) ss += x1[i] * x1[i];
        const float rstd = 1.0f / sqrtf(wave_sum(ss) * (1.f / DM) + EPS);
        float wv[16], sh[16], sc[16], h2[16]; load_row_f32(F.n_ffn_pre, F.lane, wv); load_row_f32(mod + 3 * DM, F.lane, sh); load_row_f32(mod + 4 * DM, F.lane, sc);
#pragma unroll
        for (int i = 0; i < 16; ++i) h2[i] = x1[i] * rstd * wv[i] * (1.f + sc[i]) + sh[i];
        { float a[8], c[8];
#pragma unroll
          for (int i = 0; i < 8; ++i) { a[i] = h2[i]; c[i] = h2[8 + i]; }
          bf16* d = WSP(bf16, WS_H2) + (size_t)t * DM; *(u32x4*)(d + 8 * F.lane) = pack8(a); *(u32x4*)(d + 512 + 8 * F.lane) = pack8(c); }
#pragma unroll
        for (int i = 0; i < 8; ++i) { hs[8 * F.lane + i] = h2[i]; hs[512 + 8 * F.lane + i] = h2[8 + i]; }
        asm volatile("s_waitcnt lgkmcnt(0)" ::: "memory");
        float lg0 = 0.f, lg1 = 0.f, lg2 = 0.f, lg3 = 0.f;
        for (int k = 0; k < DM; k += 4) { const f32x4 hv = *(const LAS f32x4*)(hs + k);
            lg0 += hv.x * F.w_router[(size_t)k * NEXP + F.lane]; lg1 += hv.y * F.w_router[(size_t)(k + 1) * NEXP + F.lane]; lg2 += hv.z * F.w_router[(size_t)(k + 2) * NEXP + F.lane]; lg3 += hv.w * F.w_router[(size_t)(k + 3) * NEXP + F.lane]; }
        const float logit = (lg0 + lg1) + (lg2 + lg3);
        const float score = 1.f / (1.f + expf(-logit)); const float biased = score + F.router_bias[F.lane];
        int rk = 0;
#pragma unroll
        for (int o = 0; o < 8; ++o) { const int src = (F.lane & ~7) | o; const float ov = __shfl(biased, src); rk += (ov > biased || (ov == biased && src < F.lane)) ? 1 : 0; }
        float gs = rk < 2 ? biased : 0.f; gs += __shfl_xor(gs, 1); gs += __shfl_xor(gs, 2); gs += __shfl_xor(gs, 4);
        int grk = 0; const int myg = F.lane >> 3;
#pragma unroll
        for (int o = 0; o < 8; ++o) { const float ov = __shfl(gs, o * 8); grk += (ov > gs || (ov == gs && o < myg)) ? 1 : 0; }
        const bool keep = grk < 4;
        const float cand = keep ? biased : -__builtin_inff();
        int erk = 0;
        for (int o = 0; o < 64; ++o) { const float ov = __shfl(cand, o); erk += (ov > cand || (ov == cand && o < F.lane)) ? 1 : 0; }
        const bool sel = keep && erk < TOPK;
        const float ssum = wave_sum(sel ? score : 0.f);
        if (sel) { const float w = score / ssum * 2.5f; const unsigned pos = atomicAdd(cnt + F.lane, 1u);
            list[(size_t)F.lane * NT + pos] = t * 8 + erk; selw[t * 8 + erk] = w; }
    }
}

__device__ __forceinline__ void build_tile_prefix(Frame& F, LAS int* tp) {
    __syncthreads();
    if (F.tid == 0) { int s = 0; const unsigned* cnt = F.ctl + CW_CNT; for (int e = 0; e < 64; ++e) { tp[e] = s; s += ((int)__hip_atomic_load(cnt + e, __ATOMIC_RELAXED, __HIP_MEMORY_SCOPE_AGENT) + 255) >> 8; } tp[64] = s; tp[65] = s + 64; }
    __syncthreads();
}
struct SchedMoe {
    const char* A; const char* B; const int* list; const unsigned* cnt; const LAS int* tp; int npn, K, G, c; size_t bstride  ; int bcol0  ; bool gather;
    __device__ __forceinline__ bool next(int i, pg8::Unit& u) const {
        const int L = i * G + c; const int ntile = __builtin_amdgcn_readfirstlane(tp[65]); if (L >= ntile * npn) return false;
        const int tile = L / npn; u.pn = L % npn; int e = 0;
        for (int q = 64; q >= 1; q >>= 1) if (e + q <= 64 && __builtin_amdgcn_readfirstlane(tp[e + q]) <= tile) e += q;
        e = __builtin_amdgcn_readfirstlane(e);
        u.e = e; u.pm = tile - __builtin_amdgcn_readfirstlane(tp[e]); u.base = (e < 64 ? tile * 256 : SLOT_SH + u.pm * 256);
        u.A = gather ? A : A + (size_t)u.base * K * 2; u.B = B + (size_t)e * bstride + (size_t)(bcol0 + u.pn * 256) * K * 2; return true; }
    __device__ __forceinline__ int row_index(const pg8::Unit& u, int r) const {
        if (u.e == 64) return u.pm * 256 + r;
        const int n = (int)cnt[u.e]; int idx = u.pm * 256 + r; if (idx >= n) idx = 0; return list[(size_t)u.e * NT + idx] >> 3; }
};
struct EpiUp { bf16* HMID;
    __device__ __forceinline__ void operator()(const f32x4 (&acc)[2][2][4][2], const pg8::Unit& u, int wr, int wc, int fr, int fq) const {
#pragma unroll
        for (int ai = 0; ai < 2; ++ai)
#pragma unroll
            for (int m = 0; m < 4; ++m) { const size_t slot = (size_t)u.base + ai * 128 + wr * 64 + m * 16 + fr;
#pragma unroll
                for (int bj = 0; bj < 2; ++bj) { const int hid = u.pn * 128 + bj * 64 + wc * 16 + fq * 4; const f32x4 g = acc[ai][bj][m][0], up = acc[ai][bj][m][1];
                    u32x2 w; w.x = pg8::cvt_pk_bf16(siluf_(g[0]) * up[0], siluf_(g[1]) * up[1]); w.y = pg8::cvt_pk_bf16(siluf_(g[2]) * up[2], siluf_(g[3]) * up[3]);
                    *(u32x2*)(HMID + slot * DEXP + hid) = w; } }
    }
};
struct EpiDown { bf16* YB; float* OUT; const int* list; const float* selw; const unsigned* cnt; int half;
    __device__ __forceinline__ void operator()(const f32x4 (&acc)[2][2][4][2], const pg8::Unit& u, int wr, int wc, int fr, int fq) const {
        const int n = u.e < 64 ? (int)cnt[u.e] : 0;
#pragma unroll
        for (int ai = 0; ai < 2; ++ai)
#pragma unroll
            for (int m = 0; m < 4; ++m) { const int r = ai * 128 + wr * 64 + m * 16 + fr; const int idx = u.pm * 256 + r;
                if (u.e == 64) { float* o = OUT + (size_t)idx * DM + half * 512 + u.pn * 256 + wc * 32 + 8 * fq;
#pragma unroll
                    for (int bj = 0; bj < 2; ++bj) { *(f32x4*)(o + bj * 128) = acc[ai][bj][m][0]; *(f32x4*)(o + bj * 128 + 4) = acc[ai][bj][m][1]; } }
                else if (idx < n) { const int dst = list[(size_t)u.e * NT + idx]; const float w = selw[dst]; bf16* o = YB + (size_t)dst * 512 + u.pn * 256 + wc * 32 + 8 * fq;
#pragma unroll
                    for (int bj = 0; bj < 2; ++bj) { const f32x4 v0 = acc[ai][bj][m][0] * w, v1 = acc[ai][bj][m][1] * w;
                        u32x4 q; q.x = pg8::cvt_pk_bf16(v0[0], v0[1]); q.y = pg8::cvt_pk_bf16(v0[2], v0[3]); q.z = pg8::cvt_pk_bf16(v1[0], v1[1]); q.w = pg8::cvt_pk_bf16(v1[2], v1[3]);
                        *(u32x4*)(o + bj * 128) = q; } } }
    }
};
__device__ __forceinline__ void phase_combine(Frame& F, int half) {
    const int gw = F.bid * NWAVES + F.wave, NGW = F.G * NWAVES; const bf16* YB = WSP(bf16, WS_YB);
    for (int t = gw; t < NT; t += NGW) {
        float* o = F.out + (size_t)t * DM + half * 512 + 8 * F.lane; f32x4 a = *(const f32x4*)o, c = *(const f32x4*)(o + 4);
#pragma unroll
        for (int k = 0; k < 8; ++k) { float v[8]; unpack8(*(const u32x4*)(YB + ((size_t)t * 8 + k) * 512 + 8 * F.lane), v); a.x += v[0]; a.y += v[1]; a.z += v[2]; a.w += v[3]; c.x += v[4]; c.y += v[5]; c.z += v[6]; c.w += v[7]; }
        *(f32x4*)o = a; *(f32x4*)(o + 4) = c;
    }
}
__device__ __forceinline__ void phase_final(Frame& F) {
    const int gw = F.bid * NWAVES + F.wave, NGW = F.G * NWAVES; const bf16* YB = WSP(bf16, WS_YB);
    for (int t = gw; t < NT; t += NGW) {
        const int b = t / SEQ; const float* mod = WSP(float, WS_MOD) + b * 6144;
        float mv[16]; load_row_f32(F.out + (size_t)t * DM, F.lane, mv);
#pragma unroll
        for (int k = 0; k < 8; ++k) { float v[8]; unpack8(*(const u32x4*)(YB + ((size_t)t * 8 + k) * 512 + 8 * F.lane), v);
#pragma unroll
            for (int i = 0; i < 8; ++i) mv[8 + i] += v[i]; }
        float ss = 0.f;
#pragma unroll
        for (int i = 0; i < 16; ++i) ss += mv[i] * mv[i];
        const float rstd = 1.0f / sqrtf(wave_sum(ss) * (1.f / DM) + EPS);
        float x1[16]; compute_x1(F, t, x1);
        float wv[16], g2[16]; load_row_f32(F.n_ffn_post, F.lane, wv); load_row_f32(mod + 5 * DM, F.lane, g2);
        float o[16];
#pragma unroll
        for (int i = 0; i < 16; ++i) o[i] = x1[i] + g2[i] * (mv[i] * rstd * wv[i]);
        store_row_f32(F.out + (size_t)t * DM, F.lane, o);
    }
}

constexpr int N_PHASES = 16;
__global__ void __launch_bounds__(NTHR, 2) fwd(Args args) {
    extern __shared__ __attribute__((aligned(16))) unsigned char lds_raw[];
    Frame F; F.lds = (LAS unsigned char*)lds_raw; F.tid = threadIdx.x; F.lane = F.tid & 63; F.wave = __builtin_amdgcn_readfirstlane(F.tid >> 6); F.G = gridDim.x; F.bid = blockIdx.x;
    F.x = args.in[0]; F.c = args.in[1]; F.ctx = args.in[2]; F.c_ctx = args.in[3]; F.w_mod = args.in[4]; F.b_mod = args.in[5]; F.n_mix_pre = args.in[6]; F.n_mix_post = args.in[7];
    F.n_ffn_pre = args.in[8]; F.n_ffn_post = args.in[9]; F.w_in = args.in[10]; F.gdn_conv = args.in[11]; F.ret_log_decay = args.in[12]; F.gdn_a_log = args.in[13]; F.gdn_dt_bias = args.in[14];
    F.ret_gn_w = args.in[15]; F.gdn_norm_w = args.in[16]; F.w_ret_out = args.in[17]; F.w_gdn_out = args.in[18]; F.w_o = args.in[19]; F.w_router = args.in[20]; F.router_bias = args.in[21];
    F.w_gate = args.in[22]; F.w_up = args.in[23]; F.w_down = args.in[24]; F.w_sh_gate = args.in[25]; F.w_sh_up = args.in[26]; F.w_sh_down = args.in[27];
    F.out = args.out; F.ws = args.ws; F.ctl = (unsigned*)(args.ws + WS_CTL);
    volatile LAS unsigned* MISC = (volatile LAS unsigned*)(F.lds + MISC_OFF);
    if (F.tid < 64) MISC[F.tid] = 0u;
    __syncthreads();
#if MK_ONE_LAUNCH
    XcdBarrier bar = xcd_barrier_post(F.ctl + CW_BAR, MISC + 8);
#define SEAM() xcd_barrier(bar)
#else
#define SEAM() do {} while (0)
#endif
    const int lo = args.ph_lo, hi = args.ph_hi;
#ifndef PHM
#define PHM 0xffff
#endif
#define IN(k) (((PHM >> (k)) & 1) && lo <= (k) && (k) < hi)
    LAS int* tp = (LAS int*)(F.lds + MISC_OFF + 256);

    if (IN(0)) { phase_prologue(F); SEAM(); }
    if (IN(1)) { phase_norm1(F); SEAM(); }
    if (IN(2)) {
        SchedIn S{(const char*)WSP(bf16, WS_HX), (const char*)WSP(bf16, WS_WIN), F.G, F.bid};
        EpiIn E{WSP(bf16, WS_P), (bf16*)F.out, WSP(float2, WS_ROPE)};
        pg8::gemm_phase<EpiIn, SchedIn, false, SP2>(F.lds, DM, S, E); SEAM();
    }
    if (IN(3)) { phase_prep(F); SEAM(); }
    if (IN(4)) { phase_scan(F); SEAM(); }
    if (IN(5)) { phase_out(F); SEAM(); }
    if (IN(6)) {
        SchedMerge S{(const char*)WSP(bf16, WS_RETY), (const char*)WSP(bf16, WS_GDNY), (const char*)WSP(bf16, WS_WRO), (const char*)WSP(bf16, WS_WGO), F.G, F.bid};
        EpiMerge E{(const bf16*)F.out, WSP(bf16, WS_TMP), WSP(bf16, WS_MERGED)};
        pg8::gemm_phase<EpiMerge, SchedMerge, false, SP2>(F.lds, 512, S, E);
        phase_moe_weights(F); SEAM();
    }
    if (IN(7)) {
        SchedDense S{(const char*)WSP(bf16, WS_MERGED), (const char*)WSP(bf16, WS_WO), 64, 4, DM, F.G, F.bid};
        EpiBf16Store E{WSP(bf16, WS_MO), DM};
        pg8::gemm_phase<EpiBf16Store, SchedDense, false, SP2>(F.lds, DM, S, E); SEAM();
    }
    if (IN(8)) { phase_route(F); SEAM(); }
    if (IN(9)) {
        build_tile_prefix(F, tp);
        SchedMoe S{(const char*)WSP(bf16, WS_H2), (const char*)WSP(bf16, WS_WGU), WSP(int, WS_LIST), F.ctl + CW_CNT, tp, 2, DM, F.G, F.bid, (size_t)512 * DM * 2, 0, true};
        EpiUp E{WSP(bf16, WS_HMID)};
        pg8::gemm_phase<EpiUp, SchedMoe, true, SP2>(F.lds, DM, S, E); SEAM();
    }
    if (IN(10)) {
        build_tile_prefix(F, tp);
        SchedMoe S{(const char*)WSP(bf16, WS_HMID), (const char*)WSP(bf16, WS_WD), WSP(int, WS_LIST), F.ctl + CW_CNT, tp, 2, DEXP, F.G, F.bid, (size_t)DM * DEXP * 2, 0, false};
        EpiDown E{WSP(bf16, WS_YB), F.out, WSP(int, WS_LIST), WSP(float, WS_SELW), F.ctl + CW_CNT, 0};
        pg8::gemm_phase<EpiDown, SchedMoe, false, SP2>(F.lds, DEXP, S, E); SEAM();
    }
    if (IN(11)) { phase_combine(F, 0); SEAM(); }
    if (IN(12)) {
        build_tile_prefix(F, tp);
        SchedMoe S{(const char*)WSP(bf16, WS_HMID), (const char*)WSP(bf16, WS_WD), WSP(int, WS_LIST), F.ctl + CW_CNT, tp, 2, DEXP, F.G, F.bid, (size_t)DM * DEXP * 2, 512, false};
        EpiDown E{WSP(bf16, WS_YB), F.out, WSP(int, WS_LIST), WSP(float, WS_SELW), F.ctl + CW_CNT, 1};
        pg8::gemm_phase<EpiDown, SchedMoe, false, SP2>(F.lds, DEXP, S, E); SEAM();
    }
    if (IN(13)) { phase_final(F); }
#undef IN
}

extern "C" void kernel_launch(void* const* d_in, const int* in_sizes, int n_in, void* d_out, int out_size, void* d_ws, size_t ws_size, hipStream_t stream) {
    static int grid = 0;
    if (grid == 0) {
        if (n_in != 28 || in_sizes[0] != NT * DM || out_size != NT * DM || ws_size < WS_END) { fprintf(stderr, "kernel_launch: unexpected shapes / workspace (%d inputs, ws %zu)\n", n_in, ws_size); grid = -1; return; }
        int dev = 0, cus = 0;
        if (hipGetDevice(&dev) != hipSuccess || hipDeviceGetAttribute(&cus, hipDeviceAttributeMultiprocessorCount, dev) != hipSuccess) { grid = -1; return; }
        if (hipFuncSetAttribute((const void*)fwd, hipFuncAttributeMaxDynamicSharedMemorySize, LDS_BYTES) != hipSuccess) { fprintf(stderr, "kernel_launch: hipFuncSetAttribute failed\n"); grid = -1; return; }
        int per_cu = 0; (void)hipOccupancyMaxActiveBlocksPerMultiprocessor(&per_cu, (const void*)fwd, NTHR, LDS_BYTES); (void)hipGetLastError();
        if (per_cu < 1) fprintf(stderr, "kernel_launch: occupancy query says %d\n", per_cu);
        grid = cus;
    }
    if (grid < 0) return;
    (void)hipMemsetAsync((char*)d_ws + WS_CTL, 0, CTL_BYTES, stream);
    Args a{};
    for (int i = 0; i < 28; ++i) a.in[i] = (const float*)d_in[i];
    a.out = (float*)d_out; a.ws = (unsigned char*)d_ws;
#if MK_ONE_LAUNCH
    a.ph_lo = 0; a.ph_hi = N_PHASES;
    hipLaunchKernelGGL(fwd, dim3(grid), dim3(NTHR), LDS_BYTES, stream, a);
#else
    for (int p = 0; p < 14; ++p) { a.ph_lo = p; a.ph_hi = p + 1; hipLaunchKernelGGL(fwd, dim3(grid), dim3(NTHR), LDS_BYTES, stream, a); }
#endif
}
```

```cpp
#include <hip/hip_runtime.h>
#include <cstdio>
#include <cstdint>

#ifndef MK_ONE_LAUNCH
#define MK_ONE_LAUNCH 1
#endif
#ifndef MK_REF_GEMM
#define MK_REF_GEMM 0
#endif

constexpr int NB = 4, SEQ = 4096, DM = 1024, CTXL = 256, RPB = SEQ + CTXL  , NROW = NB * RPB  , NT = NB * SEQ  ;
constexpr int NH = 4, HD = 128, CH = 128, NCHUNK = RPB / CH  ;
constexpr int N_STATE = 2064, N_IN = 6160, NEXP = 64, TOPK = 8, DEXP = 256;
constexpr float EPS = 1e-6f;
constexpr int NPCOL = 4096;
constexpr int SLOT_SH = 147456;
constexpr int NSLOT = SLOT_SH + NT;

constexpr size_t MiB = 1u << 20;
constexpr size_t WS_CTL = 0, CTL_BYTES = 1 * MiB;
constexpr size_t WS_MOD = 1 * MiB;
constexpr size_t WS_ROPE = 2 * MiB;
constexpr size_t WS_LOGA = 4 * MiB;
constexpr size_t WS_BETA = 5 * MiB;
constexpr size_t WS_WRO = 6 * MiB, WS_WGO = 7 * MiB, WS_WO = 8 * MiB;
constexpr size_t WS_P = 10 * MiB;
constexpr size_t PGRP = (size_t)NROW * 512;
constexpr size_t WS_CH = 146 * MiB;
constexpr size_t WS_WIN = WS_CH;
constexpr size_t WS_HX = WS_CH + 12 * MiB;
constexpr size_t WS_GM = WS_CH;
constexpr size_t WS_GC = WS_CH + 34 * MiB;
constexpr size_t WS_GKV = WS_CH + 68 * MiB;
constexpr size_t WS_GQT = WS_CH + 102 * MiB;
constexpr size_t WS_OGDN = WS_CH + 134 * MiB;
constexpr size_t WS_ORET = WS_CH + 150 * MiB;
constexpr size_t WS_RETY = WS_P, WS_GDNY = WS_P + 17 * MiB;
constexpr size_t WS_H2 = 10 * MiB;
constexpr size_t WS_WGU = 73 * MiB;
constexpr size_t WS_YB = 10 * MiB;
constexpr size_t WS_WD = 138 * MiB;
constexpr size_t WS_HMID = 171 * MiB;
constexpr size_t WS_TMP = 171 * MiB, WS_MERGED = 203 * MiB;
constexpr size_t WS_MO = 251 * MiB;
constexpr size_t WS_LIST = 283 * MiB;
constexpr size_t WS_SELW = 287 * MiB;
constexpr size_t WS_END = 312 * MiB;

constexpr int CW_BAR = 1024;
constexpr int CW_CNT = 8192;

#define GAS __attribute__((address_space(1)))
#define LAS __attribute__((address_space(3)))
typedef unsigned short bf16;
typedef float f32x4 __attribute__((ext_vector_type(4)));
typedef float f32x2 __attribute__((ext_vector_type(2)));
typedef short bf16x8 __attribute__((ext_vector_type(8)));
typedef unsigned u32x4 __attribute__((ext_vector_type(4)));
typedef unsigned u32x2 __attribute__((ext_vector_type(2)));
__device__ __forceinline__ unsigned f2bf(float f) { unsigned u = __builtin_bit_cast(unsigned, f); return (u + 0x7fffu + ((u >> 16) & 1u)) >> 16; }
__device__ __forceinline__ unsigned pk2(float lo, float hi) { return f2bf(lo) | (f2bf(hi) << 16); }
__device__ __forceinline__ float bf2f(unsigned b) { return __builtin_bit_cast(float, b << 16); }
__device__ __forceinline__ float bflo(unsigned w) { return __builtin_bit_cast(float, w << 16); }
__device__ __forceinline__ float bfhi(unsigned w) { return __builtin_bit_cast(float, w & 0xffff0000u); }
__device__ __forceinline__ float sigmoidf_(float x) { return 1.f / (1.f + __expf(-x)); }
__device__ __forceinline__ float siluf_(float x) { return x / (1.f + __expf(-x)); }
__device__ __forceinline__ float wave_sum(float v) {
#pragma unroll
    for (int o = 1; o < 64; o <<= 1) v += __shfl_xor(v, o);
    return v;
}
__device__ __forceinline__ float sum16(float v) {
#pragma unroll
    for (int o = 1; o < 16; o <<= 1) v += __shfl_xor(v, o);
    return v;
}
__device__ __forceinline__ void unpack8(const u32x4 w, float (&o)[8]) {
    o[0] = bflo(w.x); o[1] = bfhi(w.x); o[2] = bflo(w.y); o[3] = bfhi(w.y); o[4] = bflo(w.z); o[5] = bfhi(w.z); o[6] = bflo(w.w); o[7] = bfhi(w.w);
}
__device__ __forceinline__ u32x4 pack8(const float (&v)[8]) { u32x4 w; w.x = pk2(v[0], v[1]); w.y = pk2(v[2], v[3]); w.z = pk2(v[4], v[5]); w.w = pk2(v[6], v[7]); return w; }

namespace pg8 {
constexpr int BM = 256, BK = 64, HALF = 128, HTB = HALF * BK * 2, STAGE_BYTES = 8 * HTB;
__host__ __device__ __forceinline__ int lds_byte(int r, int c) { const int st = (r >> 4) * 2 + (c >> 5), rr = r & 15, cc = c & 31, ob = rr * 64 + cc * 2; return st * 1024 + (ob ^ (((ob >> 9) & 1) << 5)); }
__host__ __device__ __forceinline__ void stage_rc(int b, int& R, int& C) { const int st = b / 1024, sb = b % 1024, swz = sb ^ (((sb >> 9) & 1) << 5); R = (st >> 1) * 16 + swz / 64; C = (st & 1) * 32 + (swz % 64) / 2; }
__host__ __device__ __forceinline__ int perm32(int rho) { const int n = rho >> 4, i = rho & 15; return 8 * (i >> 2) + 4 * n + (i & 3); }
__device__ __forceinline__ unsigned cvt_pk_bf16(float lo, float hi) { unsigned r; asm volatile("v_cvt_pk_bf16_f32 %0, %1, %2" : "=v"(r) : "v"(lo), "v"(hi)); return r; }

struct Unit { const char* A; const char* B; int pm, pn, e, base; };

template <class Epi, class Sched, bool GATHER, bool SP2>
__device__ __forceinline__ void gemm_phase(LAS unsigned char* lds, const int K, const Sched& S, const Epi& E) {
#if MK_REF_GEMM
    {
        const int tid = threadIdx.x, wid = tid >> 6, lane = tid & 63, wr = wid >> 2, wc = wid & 3, fr = lane & 15, fq = lane >> 4;
        Unit cur;
        for (int ui = 0; S.next(ui, cur); ++ui) {
            f32x4 acc[2][2][4][2];
            for (int ai = 0; ai < 2; ++ai) for (int m = 0; m < 4; ++m) {
                const int r = 128 * ai + 64 * wr + 16 * m + fr;
                const bf16* arow = GATHER ? (const bf16*)cur.A + (size_t)S.row_index(cur, r) * K : (const bf16*)cur.A + (size_t)r * K;
                for (int bj = 0; bj < 2; ++bj) for (int n = 0; n < 2; ++n) {
                    f32x4 a4 = {0.f, 0.f, 0.f, 0.f};
                    for (int i = 0; i < 4; ++i) { const int c = 128 * bj + 32 * wc + 8 * fq + 4 * n + i; const bf16* brow = (const bf16*)cur.B + (size_t)c * K;
                        float s = 0.f; for (int k = 0; k < K; ++k) s += bf2f(arow[k]) * bf2f(brow[k]); a4[i] = s; }
                    acc[ai][bj][m][n] = a4; } }
            E(acc, cur, wr, wc, fr, fq);
        }
        return;
    }
#else
    const int tid = threadIdx.x, wid = __builtin_amdgcn_readfirstlane(tid >> 6), lane = tid & 63, wr = wid >> 2, wc = wid & 3, fr = lane & 15, fq = lane >> 4;
    const int nt = K / BK;
    unsigned voffA[2], voffB[2]; int gR = 0, gC = 0;
#pragma unroll
    for (int i = 0; i < 2; ++i) { int R, C; stage_rc(tid * 16 + i * 8192, R, C); const int Rb = (R & ~31) + perm32(R & 31);
        voffA[i] = (unsigned)(R * K + C) * 2u; voffB[i] = (unsigned)(Rb * K + C) * 2u; if (i == 0) { gR = R; gC = C; } }
    const size_t kstep = (size_t)(BK * 2);
    const size_t hstep = (size_t)HALF * K * 2;
    const unsigned ldsw = (unsigned)wid * 1024u;
    const int aoff = lds_byte(wr * 64 + fr, fq * 8), boff = lds_byte(wc * 32 + fr, fq * 8);
#define PG8_SA(b, h) (((b) * 2 + (h)) * HTB)
#define PG8_SB(b, h) ((4 + (b) * 2 + (h)) * HTB)
#define PG8_STAGE(bufoff, gbase, voff) do { _Pragma("unroll") for (int _i = 0; _i < 2; ++_i) \
        __builtin_amdgcn_global_load_lds((const unsigned*)((const char*)(gbase) + (voff)[_i]), (LAS unsigned*)(lds + (bufoff) + ldsw + _i * 8192), 16, 0, 0); } while (0)
#define PG8_STAGE_A(bufoff, gbase, h, G) do { if constexpr (GATHER) { PG8_STAGE(bufoff, gbase, (G)[h]); } else { PG8_STAGE(bufoff, (gbase) + (h) * hstep, voffA); } } while (0)
#define PG8_LDA(dst, b, h) do { _Pragma("unroll") for (int m = 0; m < 4; ++m) _Pragma("unroll") for (int k = 0; k < 2; ++k) dst[m][k] = *(const LAS bf16x8*)(lds + PG8_SA(b, h) + aoff + m * 2048 + k * 1024); } while (0)
#define PG8_LDB(dst, b, h) do { _Pragma("unroll") for (int n = 0; n < 2; ++n) _Pragma("unroll") for (int k = 0; k < 2; ++k) dst[n][k] = *(const LAS bf16x8*)(lds + PG8_SB(b, h) + boff + n * 2048 + k * 1024); } while (0)
#define PG8_MMA(ai, bj, At, Bt) do { __builtin_amdgcn_s_setprio(1); _Pragma("unroll") for (int m = 0; m < 4; ++m) _Pragma("unroll") for (int n = 0; n < 2; ++n) _Pragma("unroll") for (int k = 0; k < 2; ++k) \
        acc[ai][bj][m][n] = __builtin_amdgcn_mfma_f32_16x16x32_bf16(Bt[n][k], At[m][k], acc[ai][bj][m][n], 0, 0, 0); __builtin_amdgcn_s_setprio(0); } while (0)
#define PG8_WAIT_V(n) asm volatile("s_waitcnt vmcnt(" #n ")" ::: "memory")
#define PG8_WAIT_L(n) asm volatile("s_waitcnt lgkmcnt(" #n ")" ::: "memory")
#define PG8_BAR __builtin_amdgcn_s_barrier()
#define PG8_SCHED __builtin_amdgcn_sched_barrier(0)
    Unit cur, nxt; int ui = 0;
    if (!S.next(0, cur)) return;
    f32x4 acc[2][2][4][2];
#pragma unroll
    for (int a = 0; a < 2; ++a)
#pragma unroll
        for (int b = 0; b < 2; ++b)
#pragma unroll
            for (int m = 0; m < 4; ++m)
#pragma unroll
                for (int n = 0; n < 2; ++n) acc[a][b][m][n] = (f32x4){0.f, 0.f, 0.f, 0.f};
    bf16x8 At[4][2], B0[2][2], B1[2][2];
    const char* cA = cur.A; const char* cB = cur.B;
    unsigned cG[2][2] = {{0u, 0u}, {0u, 0u}}, nG[2][2] = {{0u, 0u}, {0u, 0u}};
    if constexpr (GATHER) {
#pragma unroll
        for (int h = 0; h < 2; ++h)
#pragma unroll
            for (int i = 0; i < 2; ++i) cG[h][i] = ((unsigned)S.row_index(cur, 128 * h + gR + 64 * i) * (unsigned)K + (unsigned)gC) * 2u;
    }
    if constexpr (SP2) {
        PG8_STAGE(PG8_SB(0, 0), cB, voffB); PG8_STAGE(PG8_SB(0, 1), cB + hstep, voffB); PG8_STAGE_A(PG8_SA(0, 0), cA, 0, cG); PG8_STAGE_A(PG8_SA(0, 1), cA, 1, cG);
        if (wr == 1) PG8_BAR;
        PG8_WAIT_V(2); PG8_BAR;
        PG8_STAGE(PG8_SB(1, 0), cB + kstep, voffB); PG8_STAGE_A(PG8_SA(1, 0), cA + kstep, 0, cG); PG8_STAGE(PG8_SB(1, 1), cB + hstep + kstep, voffB);
        PG8_WAIT_V(6); PG8_BAR;
    } else {
        PG8_STAGE(PG8_SB(0, 0), cB, voffB); PG8_STAGE_A(PG8_SA(0, 0), cA, 0, cG); PG8_STAGE(PG8_SB(0, 1), cB + hstep, voffB); PG8_STAGE_A(PG8_SA(0, 1), cA, 1, cG);
        if (wr == 1) PG8_BAR;
        PG8_WAIT_V(4); PG8_BAR;
        PG8_STAGE(PG8_SB(1, 0), cB + kstep, voffB); PG8_STAGE_A(PG8_SA(1, 0), cA + kstep, 0, cG); PG8_STAGE(PG8_SB(1, 1), cB + hstep + kstep, voffB);
        PG8_WAIT_V(6); PG8_BAR;
    }
    for (;;) {
        const bool has_next = S.next(ui + 1, nxt);
        const char* nA = has_next ? nxt.A : cA; const char* nB = has_next ? nxt.B : cB;
        for (int t = 0; t < nt; t += 2) {
            const bool last = (t == nt - 2);
            const char* a1 = cA + (size_t)(t + 1) * kstep;
            const char* a2 = last ? nA : cA + (size_t)(t + 2) * kstep; const char* b2 = last ? nB : cB + (size_t)(t + 2) * kstep;
            const char* a3 = a2 + kstep; const char* b3 = b2 + kstep;
            unsigned g2[2][2] = {{0u, 0u}, {0u, 0u}};
            if constexpr (GATHER) {
                if (last) {
                    if (has_next) {
#pragma unroll
                        for (int h = 0; h < 2; ++h)
#pragma unroll
                            for (int i = 0; i < 2; ++i) nG[h][i] = ((unsigned)S.row_index(nxt, 128 * h + gR + 64 * i) * (unsigned)K + (unsigned)gC) * 2u;
                    } else {
#pragma unroll
                        for (int h = 0; h < 2; ++h)
#pragma unroll
                            for (int i = 0; i < 2; ++i) nG[h][i] = cG[h][i];
                    }
                }
#pragma unroll
                for (int h = 0; h < 2; ++h)
#pragma unroll
                    for (int i = 0; i < 2; ++i) g2[h][i] = last ? nG[h][i] : cG[h][i];
            }
            if constexpr (SP2) {
            PG8_LDB(B0, 0, 0); PG8_LDB(B1, 0, 1); PG8_SCHED; PG8_LDA(At, 0, 0); PG8_STAGE_A(PG8_SA(1, 1), a1, 1, cG);
            PG8_WAIT_V(8); PG8_WAIT_L(0); PG8_BAR; PG8_MMA(0, 0, At, B0); PG8_MMA(0, 1, At, B1); PG8_BAR; PG8_SCHED;
            PG8_LDA(At, 0, 1); PG8_STAGE(PG8_SB(0, 0), b2, voffB); PG8_STAGE(PG8_SB(0, 1), b2 + hstep, voffB); PG8_STAGE_A(PG8_SA(0, 0), a2, 0, g2);
            PG8_WAIT_V(8); PG8_WAIT_L(0); PG8_BAR; PG8_MMA(1, 0, At, B0); PG8_MMA(1, 1, At, B1); PG8_BAR; PG8_SCHED;
            PG8_LDB(B0, 1, 0); PG8_LDB(B1, 1, 1); PG8_SCHED; PG8_LDA(At, 1, 0); PG8_STAGE_A(PG8_SA(0, 1), a2, 1, g2);
            PG8_WAIT_V(8); PG8_WAIT_L(0); PG8_BAR; PG8_MMA(0, 0, At, B0); PG8_MMA(0, 1, At, B1); PG8_BAR; PG8_SCHED;
            PG8_LDA(At, 1, 1); PG8_STAGE(PG8_SB(1, 0), b3, voffB); PG8_STAGE(PG8_SB(1, 1), b3 + hstep, voffB); PG8_STAGE_A(PG8_SA(1, 0), a3, 0, g2);
            PG8_WAIT_V(8); PG8_WAIT_L(0); PG8_BAR; PG8_MMA(1, 0, At, B0); PG8_MMA(1, 1, At, B1); PG8_BAR; PG8_SCHED;
            } else {
            PG8_LDB(B0, 0, 0); PG8_SCHED; PG8_LDA(At, 0, 0); PG8_STAGE_A(PG8_SA(1, 1), a1, 1, cG);
            PG8_WAIT_L(8); PG8_BAR; PG8_WAIT_L(0); PG8_MMA(0, 0, At, B0); PG8_BAR; PG8_SCHED;
            PG8_LDB(B1, 0, 1); PG8_STAGE(PG8_SB(0, 0), b2, voffB);
            PG8_BAR; PG8_WAIT_L(0); PG8_MMA(0, 1, At, B1); PG8_BAR;
            PG8_LDA(At, 0, 1); PG8_STAGE_A(PG8_SA(0, 0), a2, 0, g2);
            PG8_BAR; PG8_WAIT_L(0); PG8_MMA(1, 0, At, B0); PG8_BAR; PG8_SCHED;
            PG8_STAGE(PG8_SB(0, 1), b2 + hstep, voffB);
            PG8_WAIT_V(6); PG8_BAR; PG8_MMA(1, 1, At, B1); PG8_BAR;
            PG8_LDB(B0, 1, 0); PG8_SCHED; PG8_LDA(At, 1, 0); PG8_STAGE_A(PG8_SA(0, 1), a2, 1, g2);
            PG8_WAIT_L(8); PG8_BAR; PG8_WAIT_L(0); PG8_MMA(0, 0, At, B0); PG8_BAR; PG8_SCHED;
            PG8_LDB(B1, 1, 1); PG8_STAGE(PG8_SB(1, 0), b3, voffB);
            PG8_BAR; PG8_WAIT_L(0); PG8_MMA(0, 1, At, B1); PG8_BAR;
            PG8_LDA(At, 1, 1); PG8_STAGE_A(PG8_SA(1, 0), a3, 0, g2);
            PG8_BAR; PG8_WAIT_L(0); PG8_MMA(1, 0, At, B0); PG8_BAR; PG8_SCHED;
            PG8_STAGE(PG8_SB(1, 1), b3 + hstep, voffB);
            PG8_WAIT_V(6); PG8_BAR; PG8_MMA(1, 1, At, B1); PG8_BAR;
            }
        }
        if (wr == 0) PG8_BAR;
        { int tz = threadIdx.x; asm volatile("" : "+v"(tz)); const int wid_ = __builtin_amdgcn_readfirstlane(tz >> 6), lane_ = tz & 63;
          E(acc, cur, wid_ >> 2, wid_ & 3, lane_ & 15, lane_ >> 4); }
        if (!has_next) break;
#pragma unroll
        for (int a = 0; a < 2; ++a)
#pragma unroll
            for (int b = 0; b < 2; ++b)
#pragma unroll
                for (int m = 0; m < 4; ++m)
#pragma unroll
                    for (int n = 0; n < 2; ++n) acc[a][b][m][n] = (f32x4){0.f, 0.f, 0.f, 0.f};
        cur = nxt; cA = nA; cB = nB; ++ui;
        if constexpr (GATHER) {
#pragma unroll
            for (int h = 0; h < 2; ++h)
#pragma unroll
                for (int i = 0; i < 2; ++i) cG[h][i] = nG[h][i];
        }
        if (wr == 1) PG8_BAR;
    }
    PG8_WAIT_V(0);
    PG8_BAR;
#undef PG8_SA
#undef PG8_SB
#undef PG8_STAGE
#undef PG8_STAGE_A
#undef PG8_LDA
#undef PG8_LDB
#undef PG8_MMA
#undef PG8_WAIT_V
#undef PG8_WAIT_L
#undef PG8_BAR
#undef PG8_SCHED
#endif
}
}
constexpr bool SP2 = true;

#define XB_TMO      128
#define XB_XCNT(j)  (256  + 64 * (j))
#define XB_XSUB(j)  (1280 + 64 * (j))
#define XB_XGEN(j)  (2304 + 64 * (j))
#define XB_TOP      3328
#define XB_TOPGEN   3392
#define XCD_BAR_WORDS 3456
#define XB_SPIN_CAP (1u << 18)
__device__ __forceinline__ unsigned xb_ld(unsigned* p)              { return __hip_atomic_load(p, __ATOMIC_RELAXED, __HIP_MEMORY_SCOPE_AGENT); }
__device__ __forceinline__ unsigned xb_add(unsigned* p, unsigned v) { return __hip_atomic_fetch_add(p, v, __ATOMIC_RELAXED, __HIP_MEMORY_SCOPE_AGENT); }
__device__ __forceinline__ unsigned xb_xcc_id() { return (unsigned)__builtin_amdgcn_s_getreg((3 << 11) | 20) & 0xFu; }
#define XB_SPIN(cond, bar) do { unsigned _sp = 0; while (cond) { __builtin_amdgcn_s_sleep(1); \
    if ((++_sp & 255u) == 0u) { if (xb_ld(&(bar)[XB_TMO])) break; if (_sp > XB_SPIN_CAP) { atomicAdd(&(bar)[XB_TMO], 1u); break; } } } } while (0)
struct XcdBarrier { unsigned* bar; unsigned x; volatile LAS unsigned* st; };
__device__ __forceinline__ XcdBarrier xcd_barrier_post(unsigned* bar, volatile LAS unsigned* st) {
    XcdBarrier b; b.bar = bar; b.x = xb_xcc_id(); b.st = st;
    if (threadIdx.x == 0) (void)xb_add(&bar[XB_XCNT(b.x)], 1u);
    return b;
}
__device__ __forceinline__ void xcd_barrier_complete(unsigned* bar, unsigned x, unsigned& nloc, unsigned& nx) {
    const unsigned G = gridDim.x * gridDim.y * gridDim.z;
    unsigned sum, cnt, mine, sp = 0u;
    for (;;) {
        sum = 0u; cnt = 0u; mine = 0u;
#pragma unroll
        for (unsigned j = 0; j < 16; ++j) { const unsigned c = xb_ld(&bar[XB_XCNT(j)]); sum += c; cnt += (c > 0u) ? 1u : 0u; mine = (j == x) ? c : mine; }
        if (sum == G) break;
        __builtin_amdgcn_s_sleep(1);
        if ((++sp & 255u) == 0u) { if (xb_ld(&bar[XB_TMO])) break; if (sp > XB_SPIN_CAP) { atomicAdd(&bar[XB_TMO], 1u); break; } }
    }
    nloc = mine > 0u ? mine : 1u; nx = cnt > 0u ? cnt : 1u;
}
__device__ __forceinline__ void xcd_barrier(const XcdBarrier& b) {
    asm volatile("s_waitcnt vmcnt(0)" ::: "memory");
    __syncthreads();
    if (threadIdx.x == 0) {
        unsigned* bar = b.bar;
        __builtin_amdgcn_s_waitcnt(0);
        unsigned nloc = b.st[0], nx = b.st[1];
        if (nloc == 0u) { xcd_barrier_complete(bar, b.x, nloc, nx); b.st[0] = nloc; b.st[1] = nx; }
        const unsigned old = xb_add(&bar[XB_XSUB(b.x)], 1u);
        const unsigned gen = old / nloc;
        if (old + 1u == (gen + 1u) * nloc) {
            __builtin_amdgcn_fence(__ATOMIC_RELEASE, "agent");
            asm volatile("s_waitcnt vmcnt(0)" ::: "memory");
            const unsigned og = xb_add(&bar[XB_TOP], 1u);
            const unsigned tg = og / nx;
            if (og + 1u == (tg + 1u) * nx) xb_add(&bar[XB_TOPGEN], 1u);
            else XB_SPIN(xb_ld(&bar[XB_TOPGEN]) == tg, bar);
            __builtin_amdgcn_fence(__ATOMIC_ACQUIRE, "agent");
            xb_add(&bar[XB_XGEN(b.x)], 1u);
            asm volatile("s_waitcnt vmcnt(0)" ::: "memory");
        } else {
            XB_SPIN(xb_ld(&bar[XB_XGEN(b.x)]) == gen, bar);
            __builtin_amdgcn_fence(__ATOMIC_ACQUIRE, "agent");
            asm volatile("s_waitcnt vmcnt(0)" ::: "memory");
        }
    }
    __syncthreads();
}

constexpr int NWAVES = 8, NTHR = 512;
constexpr int RING_BYTES = 131072, MISC_OFF = 139264, LDS_BYTES = 147456;
struct Args {
    const float* in[28]; float* out; unsigned char* ws; int ph_lo, ph_hi;
};
struct Frame {
    LAS unsigned char* lds; int tid, lane, wave, G, bid;
    const float *x, *c, *ctx, *c_ctx, *w_mod, *b_mod, *n_mix_pre, *n_mix_post, *n_ffn_pre, *n_ffn_post, *w_in, *gdn_conv, *ret_log_decay, *gdn_a_log, *gdn_dt_bias,
        *ret_gn_w, *gdn_norm_w, *w_ret_out, *w_gdn_out, *w_o, *w_router, *router_bias, *w_gate, *w_up, *w_down, *w_sh_gate, *w_sh_up, *w_sh_down;
    float* out; unsigned char* ws; unsigned* ctl;
};
#define WSP(T, off) ((T*)(F.ws + (off)))

template <class CM>
__device__ __forceinline__ void transpose_item(const float* W, int ld, int K, bf16* WT, LAS float* scr, int kb, int nb, int lane, const CM& cm) {
    const int k0 = 64 * kb, n0 = 32 * nb; const int sc = cm(n0 + (lane & 31));
#pragma unroll 8
    for (int i = 0; i < 32; ++i) { const int kk = 2 * i + (lane >> 5); scr[kk * 33 + (lane & 31)] = W[(size_t)(k0 + kk) * ld + sc]; }
    asm volatile("s_waitcnt lgkmcnt(0)" ::: "memory");
    const int c = lane & 7;
#pragma unroll
    for (int j = 0; j < 4; ++j) { const int n = (lane >> 3) + 8 * j; const LAS float* s = scr + (8 * c) * 33 + n;
        u32x4 o; o.x = pk2(s[0 * 33], s[1 * 33]); o.y = pk2(s[2 * 33], s[3 * 33]); o.z = pk2(s[4 * 33], s[5 * 33]); o.w = pk2(s[6 * 33], s[7 * 33]);
        *(u32x4*)(WT + (size_t)(n0 + n) * K + k0 + 8 * c) = o; }
    asm volatile("s_waitcnt lgkmcnt(0)" ::: "memory");
}
struct CmIdent { int off; __device__ __forceinline__ int operator()(int n) const { return n + off; } };
struct CmWin {
    __device__ __forceinline__ int operator()(int n) const {
        const int g = n >> 9; int src = n + (n >= 2048 ? 16 : 0);
        if (g == 0 || g == 4) { const int hb = n & ~127, cp = n & 127; const int wc = cp >> 5, fq = (cp >> 3) & 3, nn = (cp >> 2) & 1, i = cp & 3;
            const int d = 64 * nn + 16 * wc + 4 * fq + i; src = hb + d + (n >= 2048 ? 16 : 0); }
        return src; }
};
__device__ __forceinline__ void gu_decode(int cp, int& hid, int& isup) { const int pn = cp >> 8, r = cp & 255, bj = r >> 7, wc = (r >> 5) & 3, fq = (r >> 3) & 3, nn = (r >> 2) & 1, i = r & 3; hid = pn * 128 + bj * 64 + wc * 16 + fq * 4 + i; isup = nn; }

__device__ __forceinline__ void phase_prologue(Frame& F) {
    const int gw = F.bid * NWAVES + F.wave, NGW = F.G * NWAVES; const int gt = F.bid * NTHR + F.tid, NGT = F.G * NTHR;
    LAS float* scr = (LAS float*)(F.lds + F.wave * 16384);
    { float2* rt = WSP(float2, WS_ROPE);
      for (int idx = gt; idx < SEQ * 64; idx += NGT) { const int t = idx >> 6, j = idx & 63; const float pos = (float)(j < 32 ? (t >> 6) : (t & 63)); const int f = j & 31;
          const float inv = powf(10000.0f, -(float)f / 32.0f); const float ang = pos * inv; float sn, cs; sincosf(ang, &sn, &cs); rt[idx] = make_float2(cs, sn); } }
    {
        LAS float* red = (LAS float*)(F.lds);
        for (int it = F.bid; it < 96; it += F.G) {
            const int col = it * 64 + F.lane; float a[5] = {0.f, 0.f, 0.f, 0.f, 0.f};
            const int kb = F.wave * 128;
#pragma unroll 4
            for (int k = kb; k < kb + 128; ++k) { const float w = F.w_mod[(size_t)k * 6144 + col];
#pragma unroll
                for (int r = 0; r < 5; ++r) { const float cv = r < 4 ? F.c[r * DM + k] : F.c_ctx[k]; a[r] += siluf_(cv) * w; } }
#pragma unroll
            for (int r = 0; r < 5; ++r) red[(F.wave * 5 + r) * 64 + F.lane] = a[r];
            __syncthreads();
            if (F.wave < 5) { float s = F.b_mod[col];
#pragma unroll
                for (int w = 0; w < 8; ++w) s += red[(w * 5 + F.wave) * 64 + F.lane];
                WSP(float, WS_MOD)[F.wave * 6144 + col] = s; }
            __syncthreads();
        }
    }
    {
        constexpr int I_IN = 16 * 192, I_RO = 8 * 32, I_O = 16 * 32; constexpr int NIT = I_IN + 2 * I_RO + I_O;
        for (int it = gw; it < NIT; it += NGW) { int r = it;
            if (r < I_IN) { transpose_item(F.w_in, N_IN, DM, WSP(bf16, WS_WIN), scr, r / 192, r % 192, F.lane, CmWin{}); continue; } r -= I_IN;
            if (r < I_RO) { transpose_item(F.w_ret_out, DM, 512, WSP(bf16, WS_WRO), scr, r / 32, r % 32, F.lane, CmIdent{0}); continue; } r -= I_RO;
            if (r < I_RO) { transpose_item(F.w_gdn_out, DM, 512, WSP(bf16, WS_WGO), scr, r / 32, r % 32, F.lane, CmIdent{0}); continue; } r -= I_RO;
            transpose_item(F.w_o, DM, DM, WSP(bf16, WS_WO), scr, r / 32, r % 32, F.lane, CmIdent{0}); }
    }
}

__device__ __forceinline__ void phase_moe_weights(Frame& F) {
    const int gw = F.bid * NWAVES + F.wave, NGW = F.G * NWAVES;
    LAS float* scr = (LAS float*)(F.lds + F.wave * 16384);
    constexpr int I_GU = 16 * 16  , I_D = 4 * 32;
    for (int it = gw; it < 65 * (I_GU + I_D); it += NGW) {
        const int e = it / (I_GU + I_D); int r = it % (I_GU + I_D);
        if (r < I_GU) {
            const int kb = r / 16, nb = r % 16;
            const int k0 = 64 * kb, n0 = 32 * nb; int hid, isup; gu_decode(n0 + (F.lane & 31), hid, isup);
            const float* Wg = e < 64 ? F.w_gate + (size_t)e * DM * DEXP : F.w_sh_gate; const float* Wu = e < 64 ? F.w_up + (size_t)e * DM * DEXP : F.w_sh_up;
            const float* W = isup ? Wu : Wg;
#pragma unroll 8
            for (int i = 0; i < 32; ++i) { const int kk = 2 * i + (F.lane >> 5); scr[kk * 33 + (F.lane & 31)] = W[(size_t)(k0 + kk) * DEXP + hid]; }
            asm volatile("s_waitcnt lgkmcnt(0)" ::: "memory");
            const int c = F.lane & 7; bf16* WT = WSP(bf16, WS_WGU) + (size_t)e * 512 * DM;
#pragma unroll
            for (int j = 0; j < 4; ++j) { const int n = (F.lane >> 3) + 8 * j; const LAS float* s = scr + (8 * c) * 33 + n;
                u32x4 o; o.x = pk2(s[0 * 33], s[1 * 33]); o.y = pk2(s[2 * 33], s[3 * 33]); o.z = pk2(s[4 * 33], s[5 * 33]); o.w = pk2(s[6 * 33], s[7 * 33]);
                *(u32x4*)(WT + (size_t)(n0 + n) * DM + k0 + 8 * c) = o; }
            asm volatile("s_waitcnt lgkmcnt(0)" ::: "memory");
        } else { r -= I_GU;
            const float* W = e < 64 ? F.w_down + (size_t)e * DEXP * DM : F.w_sh_down;
            transpose_item(W, DM, DEXP, WSP(bf16, WS_WD) + (size_t)e * DM * DEXP, scr, r / 32, r % 32, F.lane, CmIdent{0}); }
    }
}

__device__ __forceinline__ void phase_norm1(Frame& F) {
    const int gw = F.bid * NWAVES + F.wave, NGW = F.G * NWAVES;
    const float* mod = WSP(float, WS_MOD);
    LAS float* wl = (LAS float*)F.lds;
    for (int k = F.tid; k < DM; k += NTHR) { const float* wr = F.w_in + (size_t)k * N_IN + 2048;
#pragma unroll
        for (int jj = 0; jj < 4; ++jj) { const f32x4 w4 = *(const f32x4*)(wr + 4 * jj); wl[(4 * jj) * DM + k] = w4.x; wl[(4 * jj + 1) * DM + k] = w4.y; wl[(4 * jj + 2) * DM + k] = w4.z; wl[(4 * jj + 3) * DM + k] = w4.w; } }
    __syncthreads();
    for (int row = gw; row < NROW; row += NGW) {
        const int b = row / RPB, pos = row % RPB; const bool isctx = pos < CTXL;
        const float* src = isctx ? F.ctx + ((size_t)b * CTXL + pos) * DM : F.x + ((size_t)b * SEQ + (pos - CTXL)) * DM;
        const float* sh = isctx ? mod + 4 * 6144 : mod + b * 6144; const float* sc = sh + DM;
        f32x4 v[4]; float ss = 0.f;
#pragma unroll
        for (int j = 0; j < 4; ++j) { v[j] = *(const f32x4*)(src + 4 * (F.lane + 64 * j)); ss += v[j].x * v[j].x + v[j].y * v[j].y + v[j].z * v[j].z + v[j].w * v[j].w; }
        const float rstd = 1.0f / sqrtf(wave_sum(ss) * (1.f / DM) + EPS);
        float gd[16];
#pragma unroll
        for (int jj = 0; jj < 16; ++jj) gd[jj] = 0.f;
#pragma unroll
        for (int j = 0; j < 4; ++j) { const int c0 = 4 * (F.lane + 64 * j);
            const f32x4 g = *(const f32x4*)(F.n_mix_pre + c0), s1 = *(const f32x4*)(sc + c0), s0 = *(const f32x4*)(sh + c0);
            f32x4 h; h.x = v[j].x * rstd * g.x * (1.f + s1.x) + s0.x; h.y = v[j].y * rstd * g.y * (1.f + s1.y) + s0.y; h.z = v[j].z * rstd * g.z * (1.f + s1.z) + s0.z; h.w = v[j].w * rstd * g.w * (1.f + s1.w) + s0.w;
            u32x2 o; o.x = pk2(h.x, h.y); o.y = pk2(h.z, h.w);
            *(u32x2*)(WSP(bf16, WS_HX) + (size_t)row * DM + c0) = o;
#pragma unroll
            for (int jh = 0; jh < 2; ++jh) {
                asm volatile("" ::: "memory");
#pragma unroll
                for (int jj = 8 * jh; jj < 8 * jh + 8; ++jj) { const f32x4 w4 = *(const LAS f32x4*)(wl + jj * DM + c0); gd[jj] += (h.x * w4.x + h.y * w4.y) + (h.z * w4.z + h.w * w4.w); } } }
        float mine = 0.f;
#pragma unroll
        for (int jj = 0; jj < 16; ++jj) { const float s = wave_sum(gd[jj]); mine = (F.lane == jj) ? s : mine; }
        if (F.lane < 16) { const int ab = F.lane >> 3, dir = (F.lane >> 2) & 1, h = F.lane & 3; const size_t o = ((size_t)(dir * NB + b) * NH + h) * RPB + pos;
            if (ab == 0) { const float z = mine + F.gdn_dt_bias[dir * 4 + h]; const float sp = z > 20.f ? z : log1pf(expf(z)); WSP(float, WS_LOGA)[o] = -expf(F.gdn_a_log[dir * 4 + h]) * sp; }
            else WSP(float, WS_BETA)[o] = 1.f / (1.f + expf(-mine)); }
    }
}

struct SchedIn {
    const char* A; const char* B; int G, c;
    __device__ __forceinline__ bool next(int i, pg8::Unit& u) const {
        const int L = i * G + c; if (L >= 1536 + 32) return false;
        int lt, pn;
        if (L < 1536) { int wgid = L; { const int q = 1536 / 8, xcd = wgid % 8, off = wgid / 8; wgid = xcd * q + off; }
            const int nig = 8 * 24, gid = wgid / nig, fm = gid * 8; lt = fm + ((wgid % nig) % 8); pn = (wgid % nig) / 8; u.pm = (lt >> 4) * 17 + 1 + (lt & 15); }
        else { const int q = L - 1536; u.pm = (q >> 3) * 17; pn = q & 7; }
        u.pn = pn; u.e = 0; u.base = 0; u.A = A + (size_t)u.pm * 256 * DM * 2; u.B = B + (size_t)pn * 256 * DM * 2; return true; }
    __device__ __forceinline__ int row_index(const pg8::Unit&, int r) const { return r; }
};
struct EpiIn {
    bf16* P; bf16* GATES; const float2* rope;
    __device__ __forceinline__ void operator()(const f32x4 (&acc)[2][2][4][2], const pg8::Unit& u, int wr, int wc, int fr, int fq) const {
        const int g = u.pn >> 1;
        const int b = u.pm / 17, tl = u.pm % 17;
#pragma unroll
        for (int ai = 0; ai < 2; ++ai)
#pragma unroll
            for (int m = 0; m < 4; ++m) {
                const int rt = ai * 128 + wr * 64 + m * 16 + fr; const size_t prow = (size_t)u.pm * 256 + rt;
#pragma unroll
                for (int bj = 0; bj < 2; ++bj) {
                    f32x4 v0 = acc[ai][bj][m][0], v1 = acc[ai][bj][m][1];
                    const int ct = bj * 128 + wc * 32 + 8 * fq;
                    if (g == 0 || g == 4) {
                        const float s = (g == 0) ? 0.08838834764831845f : 1.0f; v0 = v0 * s; v1 = v1 * s;
                        const int j = 16 * wc + 4 * fq;
                        f32x4 o1 = v0, o2 = v1;
                        if (tl != 0) { const int t = (tl - 1) * 256 + rt; const float2* cs = rope + (size_t)t * 64 + j;
#pragma unroll
                            for (int i = 0; i < 4; ++i) { const float2 c2 = cs[i]; o1[i] = v0[i] * c2.x - v1[i] * c2.y; o2[i] = v0[i] * c2.y + v1[i] * c2.x; } }
                        bf16* dst = P + (size_t)g * PGRP + prow * 512 + (u.pn & 1) * 256 + bj * 128 + j;
                        u32x2 w1, w2; w1.x = pg8::cvt_pk_bf16(o1[0], o1[1]); w1.y = pg8::cvt_pk_bf16(o1[2], o1[3]); w2.x = pg8::cvt_pk_bf16(o2[0], o2[1]); w2.y = pg8::cvt_pk_bf16(o2[2], o2[3]);
                        *(u32x2*)dst = w1; *(u32x2*)(dst + 64) = w2;
                    } else if (g < 8) {
                        u32x4 w; w.x = pg8::cvt_pk_bf16(v0[0], v0[1]); w.y = pg8::cvt_pk_bf16(v0[2], v0[3]); w.z = pg8::cvt_pk_bf16(v1[0], v1[1]); w.w = pg8::cvt_pk_bf16(v1[2], v1[3]);
                        *(u32x4*)(P + (size_t)g * PGRP + prow * 512 + (u.pn & 1) * 256 + ct) = w;
                    } else {
                        const size_t lrow = (size_t)b * SEQ + (size_t)(tl - 1) * 256 + rt;
#pragma unroll
                        for (int i = 0; i < 4; ++i) { v0[i] = sigmoidf_(v0[i]); v1[i] = sigmoidf_(v1[i]); }
                        u32x4 w; w.x = pg8::cvt_pk_bf16(v0[0], v0[1]); w.y = pg8::cvt_pk_bf16(v0[2], v0[3]); w.z = pg8::cvt_pk_bf16(v1[0], v1[1]); w.w = pg8::cvt_pk_bf16(v1[2], v1[3]);
                        *(u32x4*)(GATES + lrow * 2048 + (u.pn - 16) * 256 + ct) = w;
                    }
                }
            }
    }
};

constexpr int IMGB = 34816, IMGS = 272;
typedef short s16x4 __attribute__((ext_vector_type(4)));
__device__ __forceinline__ unsigned offb(unsigned row, unsigned ch) { return 272u * row + 16u * ch; }
__device__ __forceinline__ unsigned offe(unsigned row, unsigned col) { return 272u * row + 2u * col; }
__device__ __forceinline__ bf16x8 frag_row(LAS unsigned char* img, int tile, int s, int lane) { return *(const LAS bf16x8*)(img + offb(16 * tile + (lane & 15), 4 * s + (lane >> 4))); }
__device__ __forceinline__ bf16x8 frag_tr(LAS unsigned char* img, int tile, int s, int lane) {
    const unsigned g = lane >> 4, qq = (lane & 15) >> 2, p = lane & 3;
    const s16x4 lo = __builtin_amdgcn_ds_read_tr16_b64_v4i16((LAS s16x4*)(img + offe(32 * s + 8 * g + qq, 16 * tile + 4 * p)));
    const s16x4 hi = __builtin_amdgcn_ds_read_tr16_b64_v4i16((LAS s16x4*)(img + offe(32 * s + 8 * g + 4 + qq, 16 * tile + 4 * p)));
    return (bf16x8){lo[0], lo[1], lo[2], lo[3], hi[0], hi[1], hi[2], hi[3]};
}
#define MFMA16(a, b, c) __builtin_amdgcn_mfma_f32_16x16x32_bf16(a, b, c, 0, 0, 0)
#define LBAR() do { asm volatile("s_waitcnt lgkmcnt(0)" ::: "memory"); __builtin_amdgcn_s_barrier(); asm volatile("" ::: "memory"); } while (0)
template <bool SWAP>
__device__ __forceinline__ void mm128(LAS unsigned char* ia, bool atr, LAS unsigned char* ib, bool btr, int wr, int wc, int lane, f32x4 (&acc)[2][4]) {
#pragma unroll
    for (int s = 0; s < 4; ++s) {
        bf16x8 fa[2], fb[4];
#pragma unroll
        for (int i = 0; i < 2; ++i) fa[i] = atr ? frag_tr(ia, 2 * wr + i, s, lane) : frag_row(ia, 2 * wr + i, s, lane);
#pragma unroll
        for (int j = 0; j < 4; ++j) fb[j] = btr ? frag_tr(ib, 4 * wc + j, s, lane) : frag_row(ib, 4 * wc + j, s, lane);
#pragma unroll
        for (int i = 0; i < 2; ++i)
#pragma unroll
            for (int j = 0; j < 4; ++j) acc[i][j] = SWAP ? MFMA16(fb[j], fa[i], acc[i][j]) : MFMA16(fa[i], fb[j], acc[i][j]);
    }
}
__device__ __forceinline__ void zero_acc(f32x4 (&acc)[2][4]) {
#pragma unroll
    for (int i = 0; i < 2; ++i)
#pragma unroll
        for (int j = 0; j < 4; ++j) acc[i][j] = (f32x4){0.f, 0.f, 0.f, 0.f};
}
__device__ __forceinline__ void st_img(LAS unsigned char* img, const f32x4 (&acc)[2][4], int wr, int wc, int lane) {
    const int r = lane & 15, q = lane >> 4;
#pragma unroll
    for (int i = 0; i < 2; ++i)
#pragma unroll
        for (int j = 0; j < 4; ++j) { u32x2 w; w.x = pk2(acc[i][j][0], acc[i][j][1]); w.y = pk2(acc[i][j][2], acc[i][j][3]);
            *(LAS u32x2*)(img + offe(32 * wr + 16 * i + r, 64 * wc + 16 * j + 4 * q)) = w; }
}
__device__ __forceinline__ void load_plain_img(LAS unsigned char* img, const bf16* src, int ld, int tid) {
#pragma unroll
    for (int i = 0; i < 4; ++i) { const int cidx = tid + 512 * i, row = cidx >> 4, ch = cidx & 15;
        *(LAS u32x4*)(img + offb(row, ch)) = *(const u32x4*)(src + (size_t)row * ld + 8 * ch); }
}
__device__ __forceinline__ void load_conv_img(LAS unsigned char* img, const bf16* src, const float* cw  , bool has_prev, bool has_next, int mode  , int wave, int lane) {
    asm volatile("" ::: "memory");
    const int ch = lane & 15; float w0[8], w1[8], w2[8];
#pragma unroll
    for (int i = 0; i < 8; ++i) { w0[i] = cw[8 * ch + i]; w1[i] = cw[1536 + 8 * ch + i]; w2[i] = cw[3072 + 8 * ch + i]; }
#pragma unroll
    for (int it = 0; it < 4; ++it) {
        const int row = 32 * it + 4 * wave + (lane >> 4); const u32x4 z4 = {0u, 0u, 0u, 0u};
        const u32x4 r0 = (row > 0 || has_prev) ? *(const u32x4*)(src + ((ptrdiff_t)row - 1) * 512 + 8 * ch) : z4;
        const u32x4 r1 = *(const u32x4*)(src + (size_t)row * 512 + 8 * ch);
        const u32x4 r2 = (row < 127 || has_next) ? *(const u32x4*)(src + (size_t)(row + 1) * 512 + 8 * ch) : z4;
        float a0[8], a1[8], a2[8], y[8]; unpack8(r0, a0); unpack8(r1, a1); unpack8(r2, a2); float ss = 0.f;
#pragma unroll
        for (int i = 0; i < 8; ++i) { y[i] = siluf_(w0[i] * a0[i] + w1[i] * a1[i] + w2[i] * a2[i]); ss += y[i] * y[i]; }
        if (mode != 1) { const float sc = (1.0f / sqrtf(sum16(ss) + EPS)) * (mode == 2 ? 0.08838834764831845f : 1.0f);
#pragma unroll
            for (int i = 0; i < 8; ++i) y[i] *= sc; }
        *(LAS u32x4*)(img + offb(row, ch)) = pack8(y);
    }
}
__device__ __forceinline__ void scale_rows_img(LAS unsigned char* dst, LAS unsigned char* src, const LAS float* rs, int tid) {
#pragma unroll
    for (int i = 0; i < 4; ++i) { const int cidx = tid + 512 * i, row = cidx >> 4, ch = cidx & 15; float v[8]; unpack8(*(const LAS u32x4*)(src + offb(row, ch)), v); const float sc = rs[row];
#pragma unroll
        for (int e = 0; e < 8; ++e) v[e] *= sc;
        *(LAS u32x4*)(dst + offb(row, ch)) = pack8(v); }
}
__device__ __forceinline__ void tri_inverse(LAS unsigned char* img, int w, int lane) {
    const int r = lane & 15, q = lane >> 4;
    {
        const int b0 = 16 * w; float x[16];
#pragma unroll
        for (int i = 0; i < 16; ++i) { float v = (i == r) ? 1.f : 0.f;
#pragma unroll
            for (int j = 0; j < i; ++j) v -= bf2f(*(const LAS unsigned short*)(img + offe(b0 + i, b0 + j))) * x[j];
            x[i] = v; }
        if (q == 0) {
#pragma unroll
            for (int i = 0; i < 16; ++i) *(LAS unsigned short*)(img + offe(b0 + i, b0 + r)) = (unsigned short)f2bf(x[i]); }
    }
    LBAR();
    if (w < 4) {
        const int c0 = 32 * w, r1 = c0 + 16;
        const u32x2 av = *(const LAS u32x2*)(img + offe(r1 + r, c0 + 4 * q));
        const bf16x8 fa = __builtin_bit_cast(bf16x8, (u32x4){av.x, av.y, 0u, 0u});
        const s16x4 tb = __builtin_amdgcn_ds_read_tr16_b64_v4i16((LAS s16x4*)(img + offe(c0 + 4 * q + (r >> 2), c0 + 4 * (r & 3))));
        const bf16x8 fb = (bf16x8){tb[0], tb[1], tb[2], tb[3], 0, 0, 0, 0};
        const f32x4 y = MFMA16(fa, fb, ((f32x4){0.f, 0.f, 0.f, 0.f}));
        const bf16x8 fy = __builtin_bit_cast(bf16x8, (u32x4){pk2(y[0], y[1]), pk2(y[2], y[3]), 0u, 0u});
        const u32x2 tv = *(const LAS u32x2*)(img + offe(r1 + r, r1 + 4 * q));
        const bf16x8 ft = __builtin_bit_cast(bf16x8, (u32x4){tv.x, tv.y, 0u, 0u});
        const f32x4 d = MFMA16(fy, ft, ((f32x4){0.f, 0.f, 0.f, 0.f}));
        u32x2 o; o.x = pk2(-d[0], -d[1]); o.y = pk2(-d[2], -d[3]);
        *(LAS u32x2*)(img + offe(r1 + r, c0 + 4 * q)) = o;
    }
    LBAR();
    {
        const int p = w >> 2, ti = (w >> 1) & 1, tj = w & 1, base = 64 * p, rb = base + 32;
        f32x4 y[2];
        const unsigned g = lane >> 4, qq = (lane & 15) >> 2, pp = lane & 3;
        const s16x4 lo = __builtin_amdgcn_ds_read_tr16_b64_v4i16((LAS s16x4*)(img + offe(base + 8 * g + qq, base + 16 * tj + 4 * pp)));
        const s16x4 hi = __builtin_amdgcn_ds_read_tr16_b64_v4i16((LAS s16x4*)(img + offe(base + 8 * g + 4 + qq, base + 16 * tj + 4 * pp)));
        const bf16x8 fb = (bf16x8){lo[0], lo[1], lo[2], lo[3], hi[0], hi[1], hi[2], hi[3]};
#pragma unroll
        for (int kt = 0; kt < 2; ++kt) { const bf16x8 fa = *(const LAS bf16x8*)(img + offb(rb + 16 * kt + r, (base >> 3) + q)); y[kt] = MFMA16(fa, fb, ((f32x4){0.f, 0.f, 0.f, 0.f})); }
        const bf16x8 fy = __builtin_bit_cast(bf16x8, (u32x4){pk2(y[0][0], y[0][1]), pk2(y[0][2], y[0][3]), pk2(y[1][0], y[1][1]), pk2(y[1][2], y[1][3])});
        const u32x2 t0 = *(const LAS u32x2*)(img + offe(rb + 16 * ti + r, rb + 4 * q)), t1 = *(const LAS u32x2*)(img + offe(rb + 16 * ti + r, rb + 16 + 4 * q));
        const bf16x8 ft = __builtin_bit_cast(bf16x8, (u32x4){t0.x, t0.y, t1.x, t1.y});
        const f32x4 d = MFMA16(fy, ft, ((f32x4){0.f, 0.f, 0.f, 0.f}));
        LBAR();
        u32x2 o; o.x = pk2(-d[0], -d[1]); o.y = pk2(-d[2], -d[3]);
        *(LAS u32x2*)(img + offe(rb + 16 * ti + r, base + 16 * tj + 4 * q)) = o;
    }
    LBAR();
    {
        const int tj = w >> 1, ti0 = 2 * (w & 1);
        f32x4 y[4];
#pragma unroll
        for (int kt = 0; kt < 4; ++kt) y[kt] = (f32x4){0.f, 0.f, 0.f, 0.f};
#pragma unroll
        for (int s = 0; s < 2; ++s) { const bf16x8 fb = frag_tr(img, tj, s, lane);
#pragma unroll
            for (int kt = 0; kt < 4; ++kt) y[kt] = MFMA16(frag_row(img, 4 + kt, s, lane), fb, y[kt]); }
        f32x4 d[2];
#pragma unroll
        for (int i = 0; i < 2; ++i) { d[i] = (f32x4){0.f, 0.f, 0.f, 0.f};
#pragma unroll
            for (int ks = 0; ks < 2; ++ks) {
                const bf16x8 fy = __builtin_bit_cast(bf16x8, (u32x4){pk2(y[2 * ks][0], y[2 * ks][1]), pk2(y[2 * ks][2], y[2 * ks][3]), pk2(y[2 * ks + 1][0], y[2 * ks + 1][1]), pk2(y[2 * ks + 1][2], y[2 * ks + 1][3])});
                const int row = 64 + 16 * (ti0 + i) + r;
                const u32x2 t0 = *(const LAS u32x2*)(img + offe(row, 64 + 32 * ks + 4 * q)), t1 = *(const LAS u32x2*)(img + offe(row, 64 + 32 * ks + 16 + 4 * q));
                d[i] = MFMA16(fy, __builtin_bit_cast(bf16x8, (u32x4){t0.x, t0.y, t1.x, t1.y}), d[i]); } }
        LBAR();
#pragma unroll
        for (int i = 0; i < 2; ++i) { u32x2 o; o.x = pk2(-d[i][0], -d[i][1]); o.y = pk2(-d[i][2], -d[i][3]);
            *(LAS u32x2*)(img + offe(64 + 16 * (ti0 + i) + r, 16 * tj + 4 * q)) = o; }
    }
    LBAR();
}

__device__ __forceinline__ void phase_prep(Frame& F) {
    LAS unsigned char* I0 = F.lds; LAS unsigned char* I1 = F.lds + IMGB; LAS unsigned char* I2 = F.lds + 2 * IMGB; LAS unsigned char* I3 = F.lds + 3 * IMGB;
    LAS float* sm = (LAS float*)(F.lds + MISC_OFF + 1024);
    LAS float* s_la = sm; LAS float* s_bet = sm + 128; LAS float* s_gc = sm + 256; LAS float* s_eg = sm + 384; LAS float* s_s2 = sm + 512; LAS float* s_t1 = sm + 640; LAS float* s_t2 = sm + 768;
#define LAUNDER() int tz_ = threadIdx.x; asm volatile("" : "+v"(tz_)); const int tid = tz_, lane = tz_ & 63, w = __builtin_amdgcn_readfirstlane(tz_ >> 6), wr = w >> 1, wc = w & 1, r = lane & 15, q = lane >> 4; (void)tid; (void)lane; (void)w; (void)wr; (void)wc; (void)r; (void)q
    const bf16* P = WSP(bf16, WS_P);
    for (int it = F.bid; it < 544; it += F.G) {
        int b, h, m;
        if (it < 512) { b = it >> 7; h = (it >> 5) & 3; m = 2 + (it & 31); } else { const int c = it - 512; b = c >> 3; h = (c >> 1) & 3; m = c & 1; }
        const bool isctx = m < 2; const int pos0 = 128 * m; const size_t row0 = (size_t)b * RPB + pos0; const size_t trow0 = (size_t)b * SEQ + (pos0 - CTXL);
        const bool hprev = isctx ? (m > 0) : (m > 2), hnext = isctx ? (m < 1) : (m < NCHUNK - 1);
        const size_t hoff = row0 * 512 + h * 128;
        const float lgf = F.ret_log_decay[h] * 1.4426950408889634f, lgb = F.ret_log_decay[4 + h] * 1.4426950408889634f;
        { LAUNDER();
        load_plain_img(I0, P + 0 * PGRP + hoff, 512, tid); load_plain_img(I1, P + 1 * PGRP + hoff, 512, tid);
        if (!isctx) load_plain_img(I2, P + 4 * PGRP + hoff, 512, tid);
        if (tid < 128) { s_t1[tid] = exp2f(lgf * (float)(127 - tid)); s_t2[tid] = exp2f(lgb * (float)tid); } }
        LBAR();
        f32x4 acc[2][4];
        if (!isctx) {
            { LAUNDER();
            zero_acc(acc); mm128<true>(I2, false, I0, false, wr, wc, lane, acc);
#pragma unroll
            for (int i = 0; i < 2; ++i)
#pragma unroll
                for (int j = 0; j < 4; ++j)
#pragma unroll
                    for (int e = 0; e < 4; ++e) { const int ii = 32 * wr + 16 * i + r, jj = 64 * wc + 16 * j + 4 * q + e; const int d = ii - jj;
                        const float wg = (d >= 0 ? exp2f(lgf * (float)d) : 0.f) + (d <= 0 ? exp2f(lgb * (float)(-d)) : 0.f); acc[i][j][e] *= wg; }
            st_img(I3, acc, wr, wc, lane); }
            LBAR();
            { LAUNDER();
            zero_acc(acc); mm128<true>(I3, false, I1, true, wr, wc, lane, acc);
            bf16* og = WSP(bf16, WS_ORET) + (trow0 + 32 * wr + r) * 512 + h * 128 + 64 * wc + 4 * q;
#pragma unroll
            for (int i = 0; i < 2; ++i)
#pragma unroll
                for (int j = 0; j < 4; ++j) { u32x2 o; o.x = pk2(acc[i][j][0], acc[i][j][1]); o.y = pk2(acc[i][j][2], acc[i][j][3]); *(u32x2*)(og + (size_t)(16 * i) * 512 + 16 * j) = o; } }
        }
#pragma unroll 1
        for (int dir = 0; dir < 2; ++dir) {
            LAS unsigned char* kw = dir ? I3 : I2;
            { LAUNDER(); scale_rows_img(kw, I0, dir ? s_t2 : s_t1, tid); }
            LBAR();
            LAUNDER();
            zero_acc(acc); mm128<false>(kw, true, I1, true, wr, wc, lane, acc);
            const int chain = (b * NH + h) * 2 + dir, n = dir ? (isctx ? 1 - m : 35 - m) : m;
            unsigned char* kv = F.ws + WS_GKV + ((size_t)chain * NCHUNK + n) * 32768;
#pragma unroll
            for (int i = 0; i < 2; ++i)
#pragma unroll
                for (int j = 0; j < 4; ++j) { const int mt = 2 * wr + i, nt = 4 * wc + j; u32x2 o; o.x = pk2(acc[i][j][0], acc[i][j][1]); o.y = pk2(acc[i][j][2], acc[i][j][3]);
                    *(u32x2*)(kv + ((size_t)((nt * 4 + (mt >> 1)) * 64 + (2 * (mt & 1) + (q >> 1)) * 16 + r)) * 16 + 8 * (q & 1)) = o; }
        }
        LBAR();
#pragma unroll 1
        for (int dir = 0; dir < 2; ++dir) {
            const int chain = (b * NH + h) * 2 + dir, n = dir ? (isctx ? 1 - m : 35 - m) : m;
            { LAUNDER(); load_conv_img(I0, P + 2 * PGRP + hoff, F.gdn_conv + 512 + h * 128, hprev, hnext, 0, w, lane); }
            { LAUNDER(); load_conv_img(I1, P + 3 * PGRP + hoff, F.gdn_conv + 1024 + h * 128, hprev, hnext, 1, w, lane); }
            { LAUNDER(); if (tid < 128) { const size_t o = ((size_t)(dir * NB + b) * NH + h) * RPB + pos0 + tid; s_la[tid] = WSP(float, WS_LOGA)[o]; s_bet[tid] = WSP(float, WS_BETA)[o]; } }
            LBAR();
            { LAUNDER();
            if (w == 0) {
                const float a = s_la[2 * lane], c = s_la[2 * lane + 1]; const float pr = a + c; float inc = pr;
#pragma unroll
                for (int o = 1; o < 64; o <<= 1) { const float t = __shfl_up(inc, o); if (lane >= o) inc += t; }
                const float tot = __shfl(inc, 63); const float ex = inc - pr;
                float g0 = ex + a, g1 = ex + pr;
                if (dir) { g0 = tot - ex; g1 = tot - (ex + a); }
                s_gc[2 * lane] = g0; s_gc[2 * lane + 1] = g1; s_eg[2 * lane] = __expf(g0); s_eg[2 * lane + 1] = __expf(g1);
                s_s2[2 * lane] = __expf(tot - g0); s_s2[2 * lane + 1] = __expf(tot - g1);
                if (lane == 0) s_t1[0] = __expf(tot);
            } }
            LBAR();
            { LAUNDER();
            zero_acc(acc); mm128<true>(I0, false, I0, false, wr, wc, lane, acc);
#pragma unroll
            for (int i = 0; i < 2; ++i)
#pragma unroll
                for (int j = 0; j < 4; ++j) { const int ii = 32 * wr + 16 * i + r; const float gi = s_gc[ii], bi = s_bet[ii];
#pragma unroll
                    for (int e = 0; e < 4; ++e) { const int jj = 64 * wc + 16 * j + 4 * q + e;
                        const float f = dir ? s_bet[jj] * __expf(s_gc[jj] - gi) : bi * __expf(gi - s_gc[jj]); acc[i][j][e] = (ii > jj) ? acc[i][j][e] * f : 0.f; } }
            st_img(I2, acc, wr, wc, lane); }
            LBAR();
            { LAUNDER(); tri_inverse(I2, w, lane); }
            { LAUNDER();
#pragma unroll
            for (int i = 0; i < 4; ++i) { const int cidx = tid + 512 * i, row = cidx >> 4, ch = cidx & 15; float v[8], v2[8]; unpack8(*(const LAS u32x4*)(I2 + offb(row, ch)), v);
#pragma unroll
                for (int e = 0; e < 8; ++e) { const int k = dir ? row : 8 * ch + e; const float bb = s_bet[k]; v[e] *= bb; v2[e] = v[e] * s_eg[k]; }
                *(LAS u32x4*)(I2 + offb(row, ch)) = pack8(v); *(LAS u32x4*)(I3 + offb(row, ch)) = pack8(v2); } }
            LBAR();
            { LAUNDER();
            zero_acc(acc); mm128<true>(I3, dir != 0, I0, true, wr, wc, lane, acc);
            LBAR();
            st_img(I3, acc, wr, wc, lane); }
            { LAUNDER();
            zero_acc(acc); mm128<true>(I2, dir != 0, I1, true, wr, wc, lane, acc);
            LBAR();
            st_img(I2, acc, wr, wc, lane);
            scale_rows_img(I1, I0, s_s2, tid); }
            LBAR();
            {
                LAUNDER();
                const float dtot = s_t1[0];
                zero_acc(acc); mm128<false>(I1, true, I2, true, wr, wc, lane, acc);
                unsigned char* gc = F.ws + WS_GC + ((size_t)chain * NCHUNK + n) * 32768;
#pragma unroll
                for (int i = 0; i < 2; ++i)
#pragma unroll
                    for (int j = 0; j < 4; ++j) { const int mt = 2 * wr + i, nt = 4 * wc + j; u32x2 o; o.x = pk2(acc[i][j][0], acc[i][j][1]); o.y = pk2(acc[i][j][2], acc[i][j][3]);
                        *(u32x2*)(gc + ((size_t)((nt * 8 + mt) * 64 + lane)) * 8) = o; }
                }
                { LAUNDER(); const float dtot = s_t1[0];
                zero_acc(acc); mm128<true>(I1, true, I3, true, wr, wc, lane, acc);
                unsigned char* gm = F.ws + WS_GM + ((size_t)chain * NCHUNK + n) * 32768;
#pragma unroll
                for (int i = 0; i < 2; ++i)
#pragma unroll
                    for (int j = 0; j < 4; ++j) { const int mt = 2 * wr + i, ct = 4 * wc + j; const int rowi = 16 * mt + r; float v[4];
#pragma unroll
                        for (int e = 0; e < 4; ++e) v[e] = ((rowi == 16 * ct + 4 * q + e) ? dtot : 0.f) - acc[i][j][e];
                        u32x2 o; o.x = pk2(v[0], v[1]); o.y = pk2(v[2], v[3]);
                        *(u32x2*)(gm + ((size_t)((mt * 4 + (ct >> 1)) * 64 + q * 16 + r)) * 16 + 8 * (ct & 1)) = o; }
            }
            LBAR();
            if (!isctx) {
                { LAUNDER(); load_conv_img(I1, P + 6 * PGRP + hoff, F.gdn_conv + h * 128, hprev, hnext, 2, w, lane); }
                LBAR();
                { LAUNDER();
                zero_acc(acc); mm128<true>(I1, false, I0, false, wr, wc, lane, acc);
#pragma unroll
                for (int i = 0; i < 2; ++i) { const int ii = 32 * wr + 16 * i + r; const float gi = s_gc[ii];
#pragma unroll
                    for (int j = 0; j < 4; ++j)
#pragma unroll
                        for (int e = 0; e < 4; ++e) { const int jj = 64 * wc + 16 * j + 4 * q + e; const bool on = dir ? (jj >= ii) : (jj <= ii);
                            acc[i][j][e] = on ? acc[i][j][e] * __expf(gi - s_gc[jj]) : 0.f; } }
                LBAR();
                st_img(I0, acc, wr, wc, lane); }
                LBAR();
                { LAUNDER();
                zero_acc(acc); mm128<true>(I0, false, I2, true, wr, wc, lane, acc);
                { bf16* ogp = WSP(bf16, WS_OGDN) + (trow0 + 32 * wr + r) * 512 + h * 128 + 64 * wc + 4 * q;
#pragma unroll
                  for (int i = 0; i < 2; ++i)
#pragma unroll
                    for (int j = 0; j < 4; ++j) { bf16* pp = ogp + (size_t)(16 * i) * 512 + 16 * j; f32x4 v = acc[i][j];
                        if (dir) { const u32x2 pv = *(const u32x2*)pp; v[0] += bflo(pv.x); v[1] += bfhi(pv.x); v[2] += bflo(pv.y); v[3] += bfhi(pv.y); }
                        u32x2 o; o.x = pk2(v[0], v[1]); o.y = pk2(v[2], v[3]); *(u32x2*)pp = o; } } }
                { LAUNDER();
                zero_acc(acc); mm128<true>(I0, false, I3, true, wr, wc, lane, acc);
                unsigned char* qt = F.ws + WS_GQT + ((size_t)chain * 32 + (n - 2)) * 32768;
#pragma unroll
                for (int i = 0; i < 2; ++i) { const int ii = 32 * wr + 16 * i + r; const float egi = s_eg[ii];
#pragma unroll
                    for (int j = 0; j < 4; ++j) { const int mt = 2 * wr + i, ct = 4 * wc + j; const u32x2 qv = *(const LAS u32x2*)(I1 + offe(ii, 64 * wc + 16 * j + 4 * q));
                        u32x2 o; o.x = pk2(egi * bflo(qv.x) - acc[i][j][0], egi * bfhi(qv.x) - acc[i][j][1]); o.y = pk2(egi * bflo(qv.y) - acc[i][j][2], egi * bfhi(qv.y) - acc[i][j][3]);
                        *(u32x2*)(qt + ((size_t)((mt * 4 + (ct >> 1)) * 64 + q * 16 + r)) * 16 + 8 * (ct & 1)) = o; } } }
                LBAR();
            }
        }
    }
#undef LAUNDER
}

__device__ __forceinline__ void phase_scan(Frame& F) {
    const int lane = F.lane, w = F.wave, tid = F.tid;
    for (int it = F.bid; it < 256; it += F.G) {
        if (it < 128) {
            const int chain = it >> 2, dq = it & 3;
            const unsigned char* gm = F.ws + WS_GM + (size_t)chain * NCHUNK * 32768; unsigned char* gc = F.ws + WS_GC + (size_t)chain * NCHUNK * 32768;
            const int nt = 2 * dq + (w & 1);
            bf16x8 sf[4];
#pragma unroll
            for (int s = 0; s < 4; ++s) sf[s] = (bf16x8){0, 0, 0, 0, 0, 0, 0, 0};
            u32x4 stg[4];
#pragma unroll
            for (int i = 0; i < 4; ++i) stg[i] = *(const u32x4*)(gm + (size_t)(tid + 512 * i) * 16);
#pragma unroll 1
            for (int n = 0; n < NCHUNK; ++n) {
                LAS unsigned char* buf = F.lds + (n & 1) * 32768;
#pragma unroll
                for (int i = 0; i < 4; ++i) *(LAS u32x4*)(buf + (size_t)(tid + 512 * i) * 16) = stg[i];
                if (n + 1 < NCHUNK) {
#pragma unroll
                    for (int i = 0; i < 4; ++i) stg[i] = *(const u32x4*)(gm + (size_t)(n + 1) * 32768 + (size_t)(tid + 512 * i) * 16); }
                LBAR();
                if (w < 2) {
                    unsigned char* slot = gc + (size_t)n * 32768 + (size_t)nt * 4096;
                    f32x4 acc[8];
#pragma unroll
                    for (int mt = 0; mt < 8; ++mt) { const u32x2 cv = *(const u32x2*)(slot + (size_t)(mt * 64 + lane) * 8); acc[mt] = (f32x4){bflo(cv.x), bfhi(cv.x), bflo(cv.y), bfhi(cv.y)}; }
#pragma unroll
                    for (int s = 0; s < 4; ++s)
#pragma unroll
                        for (int mt = 0; mt < 8; ++mt) acc[mt] = MFMA16(*(const LAS bf16x8*)(buf + (size_t)((mt * 4 + s) * 64 + lane) * 16), sf[s], acc[mt]);
#pragma unroll
                    for (int s = 0; s < 4; ++s) { const u32x4 pk = {pk2(acc[2 * s][0], acc[2 * s][1]), pk2(acc[2 * s][2], acc[2 * s][3]), pk2(acc[2 * s + 1][0], acc[2 * s + 1][1]), pk2(acc[2 * s + 1][2], acc[2 * s + 1][3])};
                        sf[s] = __builtin_bit_cast(bf16x8, pk); *(u32x4*)(slot + (size_t)(s * 64 + lane) * 16) = pk; }
                }
            }
            LBAR();
        } else {
            const int gidx = (it - 128) * NTHR + tid; const int chain = gidx >> 11, piece = gidx & 2047; const int h = (chain >> 1) & 3, dir = chain & 1;
            const float dec = expf(F.ret_log_decay[dir * 4 + h] * 128.f);
            unsigned char* kv = F.ws + WS_GKV + (size_t)chain * NCHUNK * 32768 + (size_t)piece * 16;
            float st[8];
#pragma unroll
            for (int e = 0; e < 8; ++e) st[e] = 0.f;
#pragma unroll 2
            for (int n = 0; n < NCHUNK; ++n) { float v[8]; unpack8(*(const u32x4*)(kv + (size_t)n * 32768), v);
#pragma unroll
                for (int e = 0; e < 8; ++e) st[e] = dec * st[e] + v[e];
                *(u32x4*)(kv + (size_t)n * 32768) = pack8(st); }
        }
    }
}

__device__ __forceinline__ void phase_out(Frame& F) {
    const bf16* P = WSP(bf16, WS_P);
    for (int it = F.bid; it < 512; it += F.G) {
        int tz_ = threadIdx.x; asm volatile("" : "+v"(tz_)); const int tid = tz_, lane = tz_ & 63, w = __builtin_amdgcn_readfirstlane(tz_ >> 6), r = lane & 15, q = lane >> 4;
        const int b = it >> 7, h = (it >> 5) & 3, m = 2 + (it & 31);
        {
#pragma unroll
            for (int k = 0; k < 4; ++k) { const int dir = k & 1; const int chain = (b * NH + h) * 2 + dir, n = dir ? 35 - m : m;
                const unsigned char* sp = F.ws + (k < 2 ? WS_GC : WS_GKV) + ((size_t)chain * NCHUNK + (n - 1)) * 32768;
                u32x4 v[4];
#pragma unroll
                for (int i = 0; i < 4; ++i) v[i] = *(const u32x4*)(sp + (size_t)(tid + 512 * i) * 16);
#pragma unroll
                for (int i = 0; i < 4; ++i) *(LAS u32x4*)(F.lds + k * 32768 + (tid + 512 * i) * 16) = v[i]; }
        }
        const size_t prow = (size_t)b * RPB + 128 * m + 16 * w + r; const size_t trow = (size_t)b * SEQ + 128 * (m - 2) + 16 * w + r;
        const int il = 16 * w + r;
        f32x4 og[8], orr[8];
        {
            const bf16* a = WSP(bf16, WS_OGDN) + trow * 512 + h * 128 + 4 * q; const bf16* c = WSP(bf16, WS_ORET) + trow * 512 + h * 128 + 4 * q;
#pragma unroll
            for (int nt = 0; nt < 8; ++nt) { const u32x2 x = *(const u32x2*)(a + 16 * nt), y = *(const u32x2*)(c + 16 * nt);
                og[nt] = (f32x4){bflo(x.x), bfhi(x.x), bflo(x.y), bfhi(x.y)}; orr[nt] = (f32x4){bflo(y.x), bfhi(y.x), bflo(y.y), bfhi(y.y)}; }
        }
        bf16x8 fqg[2][4], fqr[4];
#pragma unroll
        for (int dir = 0; dir < 2; ++dir) { const int chain = (b * NH + h) * 2 + dir, n = dir ? 35 - m : m; const unsigned char* qt = F.ws + WS_GQT + ((size_t)chain * 32 + (n - 2)) * 32768;
#pragma unroll
            for (int s = 0; s < 4; ++s) fqg[dir][s] = *(const bf16x8*)(qt + (size_t)((w * 4 + s) * 64 + lane) * 16); }
        { const bf16* qp = P + 4 * PGRP + prow * 512 + h * 128;
#pragma unroll
          for (int s = 0; s < 4; ++s) fqr[s] = *(const bf16x8*)(qp + 32 * s + 8 * q); }
        LBAR();
#pragma unroll
        for (int dir = 0; dir < 2; ++dir) {
            {
                const LAS unsigned char* sp = F.lds + dir * 32768;
#pragma unroll
                for (int s = 0; s < 4; ++s)
#pragma unroll
                    for (int nt = 0; nt < 8; ++nt) og[nt] = MFMA16(*(const LAS bf16x8*)(sp + ((nt * 4 + s) * 64 + lane) * 16), fqg[dir][s], og[nt]);
            }
            {
                const LAS unsigned char* sp = F.lds + (2 + dir) * 32768;
                f32x4 t[8];
#pragma unroll
                for (int nt = 0; nt < 8; ++nt) t[nt] = (f32x4){0.f, 0.f, 0.f, 0.f};
#pragma unroll
                for (int s = 0; s < 4; ++s)
#pragma unroll
                    for (int nt = 0; nt < 8; ++nt) t[nt] = MFMA16(*(const LAS bf16x8*)(sp + ((nt * 4 + s) * 64 + lane) * 16), fqr[s], t[nt]);
                const float lg = F.ret_log_decay[dir * 4 + h]; const float dcy = expf(lg * (float)(dir ? 128 - il : il + 1));
#pragma unroll
                for (int nt = 0; nt < 8; ++nt) orr[nt] = orr[nt] + t[nt] * dcy;
            }
        }
        {
            float s1 = 0.f;
#pragma unroll
            for (int nt = 0; nt < 8; ++nt) s1 += (orr[nt][0] + orr[nt][1]) + (orr[nt][2] + orr[nt][3]);
            s1 += __shfl_xor(s1, 16); s1 += __shfl_xor(s1, 32); const float mean = s1 * (1.f / 128.f);
            float s2 = 0.f, s3 = 0.f;
#pragma unroll
            for (int nt = 0; nt < 8; ++nt)
#pragma unroll
                for (int e = 0; e < 4; ++e) { const float d = orr[nt][e] - mean; s2 += d * d; s3 += og[nt][e] * og[nt][e]; }
            s2 += __shfl_xor(s2, 16); s2 += __shfl_xor(s2, 32); s3 += __shfl_xor(s3, 16); s3 += __shfl_xor(s3, 32);
            const float rs_r = 1.0f / sqrtf(s2 * (1.f / 128.f) + EPS), rs_g = 1.0f / sqrtf(s3 * (1.f / 128.f) + EPS);
            const bf16* rg = P + 5 * PGRP + prow * 512 + h * 128 + 4 * q; const bf16* gz = P + 7 * PGRP + prow * 512 + h * 128 + 4 * q;
            bf16* ry = WSP(bf16, WS_RETY) + trow * 512 + h * 128 + 4 * q; bf16* gy = WSP(bf16, WS_GDNY) + trow * 512 + h * 128 + 4 * q;
#pragma unroll
            for (int nt = 0; nt < 8; ++nt) { const u32x2 a = *(const u32x2*)(rg + 16 * nt), c = *(const u32x2*)(gz + 16 * nt);
                const float ga[4] = {bflo(a.x), bfhi(a.x), bflo(a.y), bfhi(a.y)}, gc4[4] = {bflo(c.x), bfhi(c.x), bflo(c.y), bfhi(c.y)};
                const f32x4 wr4 = *(const f32x4*)(F.ret_gn_w + h * 128 + 16 * nt + 4 * q), wg4 = *(const f32x4*)(F.gdn_norm_w + h * 128 + 16 * nt + 4 * q);
                float yr[4], yg[4];
#pragma unroll
                for (int e = 0; e < 4; ++e) { yr[e] = (orr[nt][e] - mean) * rs_r * wr4[e] * siluf_(ga[e]); yg[e] = og[nt][e] * rs_g * wg4[e] * siluf_(gc4[e]); }
                u32x2 o1, o2; o1.x = pk2(yr[0], yr[1]); o1.y = pk2(yr[2], yr[3]); o2.x = pk2(yg[0], yg[1]); o2.y = pk2(yg[2], yg[3]);
                *(u32x2*)(ry + 16 * nt) = o1; *(u32x2*)(gy + 16 * nt) = o2; }
        }
        LBAR();
    }
}

struct SchedMerge {
    const char *A0, *A1, *B0, *B1; int G, c;
    __device__ __forceinline__ bool next(int i, pg8::Unit& u) const {
        const int L = (i >> 1) * G + c; if (L >= 256) return false; const int term = i & 1;
        const int xcd = L % 8, off = L / 8; const int w = xcd * 32 + off;
        u.pm = w >> 2; u.pn = w & 3; u.e = term; u.base = 0;
        u.A = (term ? A1 : A0) + (size_t)u.pm * 256 * 512 * 2; u.B = (term ? B1 : B0) + (size_t)u.pn * 256 * 512 * 2; return true; }
    __device__ __forceinline__ int row_index(const pg8::Unit&, int r) const { return r; }
};
struct EpiMerge {
    const bf16* GATES; bf16* TMP; bf16* MERGED;
    __device__ __forceinline__ void operator()(const f32x4 (&acc)[2][2][4][2], const pg8::Unit& u, int wr, int wc, int fr, int fq) const {
#pragma unroll
        for (int ai = 0; ai < 2; ++ai)
#pragma unroll
            for (int m = 0; m < 4; ++m) { const size_t row = (size_t)u.pm * 256 + ai * 128 + wr * 64 + m * 16 + fr;
#pragma unroll
                for (int bj = 0; bj < 2; ++bj) { const int col = u.pn * 256 + bj * 128 + wc * 32 + 8 * fq;
                    float g[8]; unpack8(*(const u32x4*)(GATES + row * 2048 + u.e * 1024 + col), g);
                    float v[8] = {acc[ai][bj][m][0][0], acc[ai][bj][m][0][1], acc[ai][bj][m][0][2], acc[ai][bj][m][0][3], acc[ai][bj][m][1][0], acc[ai][bj][m][1][1], acc[ai][bj][m][1][2], acc[ai][bj][m][1][3]};
                    if (u.e == 0) {
#pragma unroll
                        for (int i = 0; i < 8; ++i) v[i] *= g[i];
                        *(u32x4*)(TMP + row * DM + col) = pack8(v);
                    } else { float p[8]; unpack8(*(const u32x4*)(TMP + row * DM + col), p);
#pragma unroll
                        for (int i = 0; i < 8; ++i) v[i] = p[i] + v[i] * g[i];
                        *(u32x4*)(MERGED + row * DM + col) = pack8(v); } } }
    }
};
struct SchedDense {
    const char *A, *B; int nM, nN, K, G, c;
    __device__ __forceinline__ bool next(int i, pg8::Unit& u) const {
        const int L = i * G + c; const int nwg = nM * nN; if (L >= nwg) return false;
        int w = L; if (nwg % 8 == 0) { const int xcd = L % 8, off = L / 8; w = xcd * (nwg / 8) + off; }
        u.pm = w / nN; u.pn = w % nN; u.e = 0; u.base = 0; u.A = A + (size_t)u.pm * 256 * K * 2; u.B = B + (size_t)u.pn * 256 * K * 2; return true; }
    __device__ __forceinline__ int row_index(const pg8::Unit&, int r) const { return r; }
};
struct EpiBf16Store { bf16* O; int ldc;
    __device__ __forceinline__ void operator()(const f32x4 (&acc)[2][2][4][2], const pg8::Unit& u, int wr, int wc, int fr, int fq) const {
#pragma unroll
        for (int ai = 0; ai < 2; ++ai)
#pragma unroll
            for (int m = 0; m < 4; ++m) { const size_t row = (size_t)u.pm * 256 + ai * 128 + wr * 64 + m * 16 + fr;
#pragma unroll
                for (int bj = 0; bj < 2; ++bj) { const int col = u.pn * 256 + bj * 128 + wc * 32 + 8 * fq; const f32x4 v0 = acc[ai][bj][m][0], v1 = acc[ai][bj][m][1];
                    u32x4 w; w.x = pg8::cvt_pk_bf16(v0[0], v0[1]); w.y = pg8::cvt_pk_bf16(v0[2], v0[3]); w.z = pg8::cvt_pk_bf16(v1[0], v1[1]); w.w = pg8::cvt_pk_bf16(v1[2], v1[3]);
                    *(u32x4*)(O + row * ldc + col) = w; } }
    }
};

__device__ __forceinline__ void load_row_bf16(const bf16* p, int lane, float (&v)[16]) { float a[8], b[8]; unpack8(*(const u32x4*)(p + 8 * lane), a); unpack8(*(const u32x4*)(p + 512 + 8 * lane), b);
#pragma unroll
    for (int i = 0; i < 8; ++i) { v[i] = a[i]; v[8 + i] = b[i]; } }
__device__ __forceinline__ void load_row_f32(const float* p, int lane, float (&v)[16]) {
#pragma unroll
    for (int q = 0; q < 4; ++q) { const f32x4 a = *(const f32x4*)(p + (q >> 1) * 512 + 8 * lane + 4 * (q & 1)); v[4 * q] = a.x; v[4 * q + 1] = a.y; v[4 * q + 2] = a.z; v[4 * q + 3] = a.w; } }
__device__ __forceinline__ void store_row_f32(float* p, int lane, const float (&v)[16]) {
#pragma unroll
    for (int q = 0; q < 4; ++q) *(f32x4*)(p + (q >> 1) * 512 + 8 * lane + 4 * (q & 1)) = (f32x4){v[4 * q], v[4 * q + 1], v[4 * q + 2], v[4 * q + 3]}; }
__device__ __forceinline__ void compute_x1(Frame& F, int t, float (&x1)[16]) {
    const int b = t / SEQ; const float* mod = WSP(float, WS_MOD) + b * 6144;
    const bf16* mop = WSP(bf16, WS_MO) + (size_t)t * DM;
    const u32x4 m0 = *(const u32x4*)(mop + 8 * F.lane), m1 = *(const u32x4*)(mop + 512 + 8 * F.lane);
    float ss = 0.f;
    { float a[8], c[8]; unpack8(m0, a); unpack8(m1, c);
#pragma unroll
      for (int i = 0; i < 8; ++i) ss += a[i] * a[i] + c[i] * c[i]; }
    const float rstd = 1.0f / sqrtf(wave_sum(ss) * (1.f / DM) + EPS);
#pragma unroll
    for (int hf = 0; hf < 2; ++hf) {
        asm volatile("" ::: "memory");
        const int c0 = hf * 512 + 8 * F.lane; float mo[8]; unpack8(hf ? m1 : m0, mo);
        const float* xp = F.x + (size_t)t * DM + c0; const float* wp = F.n_mix_post + c0; const float* gp = mod + 2 * DM + c0;
#pragma unroll
        for (int q = 0; q < 2; ++q) { const f32x4 xv = *(const f32x4*)(xp + 4 * q), wv = *(const f32x4*)(wp + 4 * q), g1 = *(const f32x4*)(gp + 4 * q);
#pragma unroll
            for (int e = 0; e < 4; ++e) x1[hf * 8 + 4 * q + e] = xv[e] + g1[e] * (mo[4 * q + e] * rstd * wv[e]); }
    }
}
__device__ __forceinline__ void route_token(Frame& F, int t, float logit, unsigned* cnt, int* list, float* selw) {
    const float score = 1.f / (1.f + expf(-logit)); const float biased = score + F.router_bias[F.lane];
    int rk = 0;
#pragma unroll
    for (int o = 0; o < 8; ++o) { const int src = (F.lane & ~7) | o; const float ov = __shfl(biased, src); rk += (ov > biased || (ov == biased && src < F.lane)) ? 1 : 0; }
    float gs = rk < 2 ? biased : 0.f; gs += __shfl_xor(gs, 1); gs += __shfl_xor(gs, 2); gs += __shfl_xor(gs, 4);
    int grk = 0; const int myg = F.lane >> 3;
#pragma unroll
    for (int o = 0; o < 8; ++o) { const float ov = __shfl(gs, o * 8); grk += (ov > gs || (ov == gs && o < myg)) ? 1 : 0; }
    const bool keep = grk < 4;
    const float cand = keep ? biased : -__builtin_inff();
    int erk = 0;
#pragma unroll 8
    for (int o = 0; o < 64; ++o) { const float ov = __shfl(cand, o); erk += (ov > cand || (ov == cand && o < F.lane)) ? 1 : 0; }
    const bool sel = keep && erk < TOPK;
    const float ssum = wave_sum(sel ? score : 0.f);
    if (sel) { const float w = score / ssum * 2.5f; const unsigned pos = atomicAdd(cnt + F.lane, 1u);
        list[(size_t)F.lane * NT + pos] = t * 8 + erk; selw[t * 8 + erk] = w; }
}
__device__ __forceinline__ void phase_route(Frame& F) {
    LAS float* hrow = (LAS float*)F.lds;
    LAS float* part = (LAS float*)(F.lds + 32768);
    unsigned* cnt = F.ctl + CW_CNT; int* list = WSP(int, WS_LIST); float* selw = WSP(float, WS_SELW);
    LAS float* wlds = (LAS float*)(F.lds + 49152);
    float wreg[96];
#pragma unroll
    for (int kk = 0; kk < 96; ++kk) wreg[kk] = F.w_router[(size_t)(F.wave * 128 + kk) * NEXP + F.lane];
#pragma unroll
    for (int kk = 0; kk < 32; ++kk) wlds[(F.wave * 32 + kk) * 64 + F.lane] = F.w_router[(size_t)(F.wave * 128 + 96 + kk) * NEXP + F.lane];
    for (int g8 = F.bid; g8 < NT / 8; g8 += F.G) {
        const int t = g8 * 8 + F.wave; const int b = t / SEQ; const float* mod = WSP(float, WS_MOD) + b * 6144;
        {
            float x1[16]; compute_x1(F, t, x1);
            float ss = 0.f;
#pragma unroll
            for (int i = 0; i < 16; ++i) ss += x1[i] * x1[i];
            const float rstd = 1.0f / sqrtf(wave_sum(ss) * (1.f / DM) + EPS);
            LAS float* hr = hrow + F.wave * DM; bf16* d = WSP(bf16, WS_H2) + (size_t)t * DM;
#pragma unroll
            for (int hf = 0; hf < 2; ++hf) {
                asm volatile("" ::: "memory");
                const int c0 = hf * 512 + 8 * F.lane; float h2[8];
#pragma unroll
                for (int q = 0; q < 2; ++q) { const f32x4 wv = *(const f32x4*)(F.n_ffn_pre + c0 + 4 * q), sh = *(const f32x4*)(mod + 3 * DM + c0 + 4 * q), sc = *(const f32x4*)(mod + 4 * DM + c0 + 4 * q);
#pragma unroll
                    for (int e = 0; e < 4; ++e) h2[4 * q + e] = x1[hf * 8 + 4 * q + e] * rstd * wv[e] * (1.f + sc[e]) + sh[e]; }
                *(u32x4*)(d + c0) = pack8(h2);
                *(LAS f32x4*)(hr + c0) = (f32x4){h2[0], h2[1], h2[2], h2[3]}; *(LAS f32x4*)(hr + c0 + 4) = (f32x4){h2[4], h2[5], h2[6], h2[7]};
            }
        }
        LBAR();
#pragma unroll
        for (int tok = 0; tok < 8; ++tok) { float a0 = 0.f, a1 = 0.f, a2 = 0.f, a3 = 0.f; const LAS float* hp = hrow + tok * DM + F.wave * 128;
#pragma unroll
            for (int k4 = 0; k4 < 24; ++k4) { const f32x4 hv = *(const LAS f32x4*)(hp + 4 * k4); a0 += hv.x * wreg[4 * k4]; a1 += hv.y * wreg[4 * k4 + 1]; a2 += hv.z * wreg[4 * k4 + 2]; a3 += hv.w * wreg[4 * k4 + 3]; }
#pragma unroll
            for (int k4 = 0; k4 < 8; ++k4) { const f32x4 hv = *(const LAS f32x4*)(hp + 96 + 4 * k4); const LAS float* wp = wlds + (F.wave * 32 + 4 * k4) * 64 + F.lane;
                a0 += hv.x * wp[0]; a1 += hv.y * wp[64]; a2 += hv.z * wp[128]; a3 += hv.w * wp[192]; }
            part[(F.wave * 8 + tok) * 64 + F.lane] = (a0 + a1) + (a2 + a3); }
        LBAR();
        float logit = 0.f;
#pragma unroll
        for (int w = 0; w < 8; ++w) logit += part[(w * 8 + F.wave) * 64 + F.lane];
        route_token(F, t, logit, cnt, list, selw);
    }
}

__device__ __forceinline__ void build_tile_prefix(Frame& F, LAS int* tp) {
    __syncthreads();
    if (F.tid == 0) { int s = 0; const unsigned* cnt = F.ctl + CW_CNT; for (int e = 0; e < 64; ++e) { tp[e] = s; s += ((int)__hip_atomic_load(cnt + e, __ATOMIC_RELAXED, __HIP_MEMORY_SCOPE_AGENT) + 255) >> 8; } tp[64] = s; tp[65] = s + 64; }
    __syncthreads();
}
struct SchedMoe {
    const char* A; const char* B; const int* list; const unsigned* cnt; const LAS int* tp; int npn, K, G, c; size_t bstride  ; int bcol0  ; bool gather;
    __device__ __forceinline__ bool next(int i, pg8::Unit& u) const {
        const int L = i * G + c; const int ntile = __builtin_amdgcn_readfirstlane(tp[65]); if (L >= ntile * npn) return false;
        const int tile = L / npn; u.pn = L % npn; int e = 0;
        for (int q = 64; q >= 1; q >>= 1) if (e + q <= 64 && __builtin_amdgcn_readfirstlane(tp[e + q]) <= tile) e += q;
        e = __builtin_amdgcn_readfirstlane(e);
        u.e = e; u.pm = tile - __builtin_amdgcn_readfirstlane(tp[e]); u.base = (e < 64 ? tile * 256 : SLOT_SH + u.pm * 256);
        u.A = gather ? A : A + (size_t)u.base * K * 2; u.B = B + (size_t)e * bstride + (size_t)(bcol0 + u.pn * 256) * K * 2; return true; }
    __device__ __forceinline__ int row_index(const pg8::Unit& u, int r) const {
        if (u.e == 64) return u.pm * 256 + r;
        const int n = (int)cnt[u.e]; int idx = u.pm * 256 + r; if (idx >= n) idx = 0; return list[(size_t)u.e * NT + idx] >> 3; }
};
struct EpiUp { bf16* HMID;
    __device__ __forceinline__ void operator()(const f32x4 (&acc)[2][2][4][2], const pg8::Unit& u, int wr, int wc, int fr, int fq) const {
#pragma unroll
        for (int ai = 0; ai < 2; ++ai)
#pragma unroll
            for (int m = 0; m < 4; ++m) { const size_t slot = (size_t)u.base + ai * 128 + wr * 64 + m * 16 + fr;
#pragma unroll
                for (int bj = 0; bj < 2; ++bj) { const int hid = u.pn * 128 + bj * 64 + wc * 16 + fq * 4; const f32x4 g = acc[ai][bj][m][0], up = acc[ai][bj][m][1];
                    u32x2 w; w.x = pg8::cvt_pk_bf16(siluf_(g[0]) * up[0], siluf_(g[1]) * up[1]); w.y = pg8::cvt_pk_bf16(siluf_(g[2]) * up[2], siluf_(g[3]) * up[3]);
                    *(u32x2*)(HMID + slot * DEXP + hid) = w; } }
    }
};
struct EpiDown { bf16* YB; float* OUT; const int* list; const float* selw; const unsigned* cnt; int half;
    __device__ __forceinline__ void operator()(const f32x4 (&acc)[2][2][4][2], const pg8::Unit& u, int wr, int wc, int fr, int fq) const {
        const int n = u.e < 64 ? (int)cnt[u.e] : 0;
#pragma unroll
        for (int ai = 0; ai < 2; ++ai)
#pragma unroll
            for (int m = 0; m < 4; ++m) { const int r = ai * 128 + wr * 64 + m * 16 + fr; const int idx = u.pm * 256 + r;
                if (u.e == 64) { float* o = OUT + (size_t)idx * DM + half * 512 + u.pn * 256 + wc * 32 + 8 * fq;
#pragma unroll
                    for (int bj = 0; bj < 2; ++bj) { *(f32x4*)(o + bj * 128) = acc[ai][bj][m][0]; *(f32x4*)(o + bj * 128 + 4) = acc[ai][bj][m][1]; } }
                else if (idx < n) { const int dst = list[(size_t)u.e * NT + idx]; const float w = selw[dst]; bf16* o = YB + (size_t)dst * 512 + u.pn * 256 + wc * 32 + 8 * fq;
#pragma unroll
                    for (int bj = 0; bj < 2; ++bj) { const f32x4 v0 = acc[ai][bj][m][0] * w, v1 = acc[ai][bj][m][1] * w;
                        u32x4 q; q.x = pg8::cvt_pk_bf16(v0[0], v0[1]); q.y = pg8::cvt_pk_bf16(v0[2], v0[3]); q.z = pg8::cvt_pk_bf16(v1[0], v1[1]); q.w = pg8::cvt_pk_bf16(v1[2], v1[3]);
                        *(u32x4*)(o + bj * 128) = q; } } }
    }
};
__device__ __forceinline__ void phase_combine(Frame& F, int half) {
    const int gw = F.bid * NWAVES + F.wave, NGW = F.G * NWAVES; const bf16* YB = WSP(bf16, WS_YB);
    for (int t = gw; t < NT; t += NGW) {
        float* o = F.out + (size_t)t * DM + half * 512 + 8 * F.lane; f32x4 a = *(const f32x4*)o, c = *(const f32x4*)(o + 4);
#pragma unroll
        for (int k = 0; k < 8; ++k) { float v[8]; unpack8(*(const u32x4*)(YB + ((size_t)t * 8 + k) * 512 + 8 * F.lane), v); a.x += v[0]; a.y += v[1]; a.z += v[2]; a.w += v[3]; c.x += v[4]; c.y += v[5]; c.z += v[6]; c.w += v[7]; }
        *(f32x4*)o = a; *(f32x4*)(o + 4) = c;
    }
}
__device__ __forceinline__ void phase_final(Frame& F) {
    const int gw = F.bid * NWAVES + F.wave, NGW = F.G * NWAVES; const bf16* YB = WSP(bf16, WS_YB);
    for (int t = gw; t < NT; t += NGW) {
        const int b = t / SEQ; const float* mod = WSP(float, WS_MOD) + b * 6144;
        float mv[16]; load_row_f32(F.out + (size_t)t * DM, F.lane, mv);
#pragma unroll
        for (int k = 0; k < 8; ++k) { float v[8]; unpack8(*(const u32x4*)(YB + ((size_t)t * 8 + k) * 512 + 8 * F.lane), v);
#pragma unroll
            for (int i = 0; i < 8; ++i) mv[8 + i] += v[i]; }
        float ss = 0.f;
#pragma unroll
        for (int i = 0; i < 16; ++i) ss += mv[i] * mv[i];
        const float rstd = 1.0f / sqrtf(wave_sum(ss) * (1.f / DM) + EPS);
        float x1[16]; compute_x1(F, t, x1);
        float wv[16], g2[16]; load_row_f32(F.n_ffn_post, F.lane, wv); load_row_f32(mod + 5 * DM, F.lane, g2);
        float o[16];
#pragma unroll
        for (int i = 0; i < 16; ++i) o[i] = x1[i] + g2[i] * (mv[i] * rstd * wv[i]);
        store_row_f32(F.out + (size_t)t * DM, F.lane, o);
    }
}

constexpr int N_PHASES = 16;
__global__ void __launch_bounds__(NTHR, 2) fwd(Args args) {
    extern __shared__ __attribute__((aligned(16))) unsigned char lds_raw[];
    Frame F; F.lds = (LAS unsigned char*)lds_raw; F.tid = threadIdx.x; F.lane = F.tid & 63; F.wave = __builtin_amdgcn_readfirstlane(F.tid >> 6); F.G = gridDim.x; F.bid = blockIdx.x;
    F.x = args.in[0]; F.c = args.in[1]; F.ctx = args.in[2]; F.c_ctx = args.in[3]; F.w_mod = args.in[4]; F.b_mod = args.in[5]; F.n_mix_pre = args.in[6]; F.n_mix_post = args.in[7];
    F.n_ffn_pre = args.in[8]; F.n_ffn_post = args.in[9]; F.w_in = args.in[10]; F.gdn_conv = args.in[11]; F.ret_log_decay = args.in[12]; F.gdn_a_log = args.in[13]; F.gdn_dt_bias = args.in[14];
    F.ret_gn_w = args.in[15]; F.gdn_norm_w = args.in[16]; F.w_ret_out = args.in[17]; F.w_gdn_out = args.in[18]; F.w_o = args.in[19]; F.w_router = args.in[20]; F.router_bias = args.in[21];
    F.w_gate = args.in[22]; F.w_up = args.in[23]; F.w_down = args.in[24]; F.w_sh_gate = args.in[25]; F.w_sh_up = args.in[26]; F.w_sh_down = args.in[27];
    F.out = args.out; F.ws = args.ws; F.ctl = (unsigned*)(args.ws + WS_CTL);
    volatile LAS unsigned* MISC = (volatile LAS unsigned*)(F.lds + MISC_OFF);
    if (F.tid < 64) MISC[F.tid] = 0u;
    __syncthreads();
#if MK_ONE_LAUNCH
    XcdBarrier bar = xcd_barrier_post(F.ctl + CW_BAR, MISC + 8);
#define SEAM() xcd_barrier(bar)
#else
#define SEAM() do {} while (0)
#endif
    const int lo = args.ph_lo, hi = args.ph_hi;
#ifndef PHM
#define PHM 0xffff
#endif
#ifndef DUP
#define DUP -1
#endif
#define IN(k) (((PHM >> (k)) & 1) && lo <= (k) && (k) < hi)
    LAS int* tp = (LAS int*)(F.lds + MISC_OFF + 256);

    if (IN(0)) _Pragma("unroll") for (int rep_ = 0; rep_ < ((DUP == 0) ? 2 : 1); ++rep_) { phase_prologue(F); SEAM(); }
    if (IN(1)) _Pragma("unroll") for (int rep_ = 0; rep_ < ((DUP == 1) ? 2 : 1); ++rep_) { phase_norm1(F); SEAM(); }
    if (IN(2)) _Pragma("unroll") for (int rep_ = 0; rep_ < ((DUP == 2) ? 2 : 1); ++rep_) {
        SchedIn S{(const char*)WSP(bf16, WS_HX), (const char*)WSP(bf16, WS_WIN), F.G, F.bid};
        EpiIn E{WSP(bf16, WS_P), (bf16*)F.out, WSP(float2, WS_ROPE)};
        pg8::gemm_phase<EpiIn, SchedIn, false, SP2>(F.lds, DM, S, E); SEAM();
    }
    if (IN(3)) _Pragma("unroll") for (int rep_ = 0; rep_ < ((DUP == 3) ? 2 : 1); ++rep_) { phase_prep(F); SEAM(); }
    if (IN(4)) _Pragma("unroll") for (int rep_ = 0; rep_ < ((DUP == 4) ? 2 : 1); ++rep_) { phase_scan(F); SEAM(); }
    if (IN(5)) _Pragma("unroll") for (int rep_ = 0; rep_ < ((DUP == 5) ? 2 : 1); ++rep_) { phase_out(F); SEAM(); }
    if (IN(6)) _Pragma("unroll") for (int rep_ = 0; rep_ < ((DUP == 6) ? 2 : 1); ++rep_) {
        SchedMerge S{(const char*)WSP(bf16, WS_RETY), (const char*)WSP(bf16, WS_GDNY), (const char*)WSP(bf16, WS_WRO), (const char*)WSP(bf16, WS_WGO), F.G, F.bid};
        EpiMerge E{(const bf16*)F.out, WSP(bf16, WS_TMP), WSP(bf16, WS_MERGED)};
        pg8::gemm_phase<EpiMerge, SchedMerge, false, SP2>(F.lds, 512, S, E);
        if (rep_ == 0) { _Pragma("unroll") for (int r2_ = 0; r2_ < ((DUP == 16) ? 2 : 1); ++r2_) phase_moe_weights(F); }
        SEAM();
    }
    if (IN(7)) _Pragma("unroll") for (int rep_ = 0; rep_ < ((DUP == 7) ? 2 : 1); ++rep_) {
        SchedDense S{(const char*)WSP(bf16, WS_MERGED), (const char*)WSP(bf16, WS_WO), 64, 4, DM, F.G, F.bid};
        EpiBf16Store E{WSP(bf16, WS_MO), DM};
        pg8::gemm_phase<EpiBf16Store, SchedDense, false, SP2>(F.lds, DM, S, E); SEAM();
    }
    if (IN(8)) _Pragma("unroll") for (int rep_ = 0; rep_ < ((DUP == 8) ? 2 : 1); ++rep_) { if (rep_ == 1) { if (F.bid == 0 && F.tid < 64) F.ctl[CW_CNT + F.tid] = 0u; SEAM(); } phase_route(F); SEAM(); }
    if (IN(9)) _Pragma("unroll") for (int rep_ = 0; rep_ < ((DUP == 9) ? 2 : 1); ++rep_) {
        build_tile_prefix(F, tp);
        SchedMoe S{(const char*)WSP(bf16, WS_H2), (const char*)WSP(bf16, WS_WGU), WSP(int, WS_LIST), F.ctl + CW_CNT, tp, 2, DM, F.G, F.bid, (size_t)512 * DM * 2, 0, true};
        EpiUp E{WSP(bf16, WS_HMID)};
        pg8::gemm_phase<EpiUp, SchedMoe, true, SP2>(F.lds, DM, S, E); SEAM();
    }
    if (IN(10)) _Pragma("unroll") for (int rep_ = 0; rep_ < ((DUP == 10) ? 2 : 1); ++rep_) {
        build_tile_prefix(F, tp);
        SchedMoe S{(const char*)WSP(bf16, WS_HMID), (const char*)WSP(bf16, WS_WD), WSP(int, WS_LIST), F.ctl + CW_CNT, tp, 2, DEXP, F.G, F.bid, (size_t)DM * DEXP * 2, 0, false};
        EpiDown E{WSP(bf16, WS_YB), F.out, WSP(int, WS_LIST), WSP(float, WS_SELW), F.ctl + CW_CNT, 0};
        pg8::gemm_phase<EpiDown, SchedMoe, false, SP2>(F.lds, DEXP, S, E); SEAM();
    }
    if (IN(11)) _Pragma("unroll") for (int rep_ = 0; rep_ < ((DUP == 11) ? 2 : 1); ++rep_) { phase_combine(F, 0); SEAM(); }
    if (IN(12)) _Pragma("unroll") for (int rep_ = 0; rep_ < ((DUP == 12) ? 2 : 1); ++rep_) {
        build_tile_prefix(F, tp);
        SchedMoe S{(const char*)WSP(bf16, WS_HMID), (const char*)WSP(bf16, WS_WD), WSP(int, WS_LIST), F.ctl + CW_CNT, tp, 2, DEXP, F.G, F.bid, (size_t)DM * DEXP * 2, 512, false};
        EpiDown E{WSP(bf16, WS_YB), F.out, WSP(int, WS_LIST), WSP(float, WS_SELW), F.ctl + CW_CNT, 1};
        pg8::gemm_phase<EpiDown, SchedMoe, false, SP2>(F.lds, DEXP, S, E); SEAM();
    }
    if (IN(13)) _Pragma("unroll") for (int rep_ = 0; rep_ < ((DUP == 13) ? 2 : 1); ++rep_) { phase_final(F); }
#undef IN
}

extern "C" void kernel_launch(void* const* d_in, const int* in_sizes, int n_in, void* d_out, int out_size, void* d_ws, size_t ws_size, hipStream_t stream) {
    static int grid = 0;
    if (grid == 0) {
        if (n_in != 28 || in_sizes[0] != NT * DM || out_size != NT * DM || ws_size < WS_END) { fprintf(stderr, "kernel_launch: unexpected shapes / workspace (%d inputs, ws %zu)\n", n_in, ws_size); grid = -1; return; }
        int dev = 0, cus = 0;
        if (hipGetDevice(&dev) != hipSuccess || hipDeviceGetAttribute(&cus, hipDeviceAttributeMultiprocessorCount, dev) != hipSuccess) { grid = -1; return; }
        if (hipFuncSetAttribute((const void*)fwd, hipFuncAttributeMaxDynamicSharedMemorySize, LDS_BYTES) != hipSuccess) { fprintf(stderr, "kernel_launch: hipFuncSetAttribute failed\n"); grid = -1; return; }
        int per_cu = 0; (void)hipOccupancyMaxActiveBlocksPerMultiprocessor(&per_cu, (const void*)fwd, NTHR, LDS_BYTES); (void)hipGetLastError();
        if (per_cu < 1) fprintf(stderr, "kernel_launch: occupancy query says %d\n", per_cu);
        grid = cus;
    }
    if (grid < 0) return;
    (void)hipMemsetAsync((char*)d_ws + WS_CTL, 0, CTL_BYTES, stream);
    Args a{};
    for (int i = 0; i < 28; ++i) a.in[i] = (const float*)d_in[i];
    a.out = (float*)d_out; a.ws = (unsigned char*)d_ws;
#if MK_ONE_LAUNCH
    a.ph_lo = 0; a.ph_hi = N_PHASES;
    hipLaunchKernelGGL(fwd, dim3(grid), dim3(NTHR), LDS_BYTES, stream, a);
#else
    for (int p = 0; p < 14; ++p) { a.ph_lo = p; a.ph_hi = p + 1; hipLaunchKernelGGL(fwd, dim3(grid), dim3(NTHR), LDS_BYTES, stream, a); }
#endif
}
```

```cpp
#include <hip/hip_runtime.h>
#include <cstdio>
#include <cstdint>

#ifndef MK_ONE_LAUNCH
#define MK_ONE_LAUNCH 1
#endif
#ifndef MK_REF_GEMM
#define MK_REF_GEMM 0
#endif

constexpr int NB = 4, SEQ = 4096, DM = 1024, CTXL = 256, RPB = SEQ + CTXL  , NROW = NB * RPB  , NT = NB * SEQ  ;
constexpr int NH = 4, HD = 128, CH = 128, NCHUNK = RPB / CH  ;
constexpr int N_STATE = 2064, N_IN = 6160, NEXP = 64, TOPK = 8, DEXP = 256;
constexpr float EPS = 1e-6f;
constexpr int NPCOL = 4096;
constexpr int SLOT_SH = 147456;
constexpr int NSLOT = SLOT_SH + NT;

constexpr size_t MiB = 1u << 20;
constexpr size_t WS_CTL = 0, CTL_BYTES = 1 * MiB;
constexpr size_t WS_MOD = 1 * MiB;
constexpr size_t WS_ROPE = 2 * MiB;
constexpr size_t WS_LOGA = 4 * MiB;
constexpr size_t WS_BETA = 5 * MiB;
constexpr size_t WS_WRO = 6 * MiB, WS_WGO = 7 * MiB, WS_WO = 8 * MiB;
constexpr size_t WS_P = 10 * MiB;
constexpr size_t PGRP = (size_t)NROW * 512;
constexpr size_t WS_CH = 146 * MiB;
constexpr size_t WS_WIN = WS_CH;
constexpr size_t WS_HX = WS_CH + 12 * MiB;
constexpr size_t WS_GM = WS_CH;
constexpr size_t WS_GC = WS_CH + 34 * MiB;
constexpr size_t WS_GKV = WS_CH + 68 * MiB;
constexpr size_t WS_GQT = WS_CH + 102 * MiB;
constexpr size_t WS_OGDN = WS_CH + 134 * MiB;
constexpr size_t WS_ORET = WS_CH + 150 * MiB;
constexpr size_t WS_RETY = WS_P, WS_GDNY = WS_P + 17 * MiB;
constexpr size_t WS_H2 = 10 * MiB;
constexpr size_t WS_WGU = 73 * MiB;
constexpr size_t WS_YB = 10 * MiB;
constexpr size_t WS_WD = 138 * MiB;
constexpr size_t WS_HMID = 171 * MiB;
constexpr size_t WS_TMP = 171 * MiB, WS_MERGED = 203 * MiB;
constexpr size_t WS_MO = 251 * MiB;
constexpr size_t WS_LIST = 283 * MiB;
constexpr size_t WS_END = 312 * MiB;

constexpr int CW_BAR = 1024;
constexpr int CW_CNT = 8192;

#define GAS __attribute__((address_space(1)))
#define LAS __attribute__((address_space(3)))
typedef unsigned short bf16;
typedef float f32x4 __attribute__((ext_vector_type(4)));
typedef float f32x2 __attribute__((ext_vector_type(2)));
typedef short bf16x8 __attribute__((ext_vector_type(8)));
typedef unsigned u32x4 __attribute__((ext_vector_type(4)));
typedef unsigned u32x2 __attribute__((ext_vector_type(2)));
__device__ __forceinline__ unsigned f2bf(float f) { unsigned u = __builtin_bit_cast(unsigned, f); return (u + 0x7fffu + ((u >> 16) & 1u)) >> 16; }
__device__ __forceinline__ unsigned pk2(float lo, float hi) { return f2bf(lo) | (f2bf(hi) << 16); }
__device__ __forceinline__ float bf2f(unsigned b) { return __builtin_bit_cast(float, b << 16); }
__device__ __forceinline__ float bflo(unsigned w) { return __builtin_bit_cast(float, w << 16); }
__device__ __forceinline__ float bfhi(unsigned w) { return __builtin_bit_cast(float, w & 0xffff0000u); }
__device__ __forceinline__ float sigmoidf_(float x) { return 1.f / (1.f + __expf(-x)); }
__device__ __forceinline__ float siluf_(float x) { return x / (1.f + __expf(-x)); }
__device__ __forceinline__ float wave_sum(float v) {
#pragma unroll
    for (int o = 1; o < 64; o <<= 1) v += __shfl_xor(v, o);
    return v;
}
__device__ __forceinline__ float sum16(float v) {
#pragma unroll
    for (int o = 1; o < 16; o <<= 1) v += __shfl_xor(v, o);
    return v;
}
__device__ __forceinline__ void unpack8(const u32x4 w, float (&o)[8]) {
    o[0] = bflo(w.x); o[1] = bfhi(w.x); o[2] = bflo(w.y); o[3] = bfhi(w.y); o[4] = bflo(w.z); o[5] = bfhi(w.z); o[6] = bflo(w.w); o[7] = bfhi(w.w);
}
__device__ __forceinline__ u32x4 pack8(const float (&v)[8]) { u32x4 w; w.x = pk2(v[0], v[1]); w.y = pk2(v[2], v[3]); w.z = pk2(v[4], v[5]); w.w = pk2(v[6], v[7]); return w; }

namespace pg8 {
constexpr int BM = 256, BK = 64, HALF = 128, HTB = HALF * BK * 2, STAGE_BYTES = 8 * HTB;
__host__ __device__ __forceinline__ int lds_byte(int r, int c) { const int st = (r >> 4) * 2 + (c >> 5), rr = r & 15, cc = c & 31, ob = rr * 64 + cc * 2; return st * 1024 + (ob ^ (((ob >> 9) & 1) << 5)); }
__host__ __device__ __forceinline__ void stage_rc(int b, int& R, int& C) { const int st = b / 1024, sb = b % 1024, swz = sb ^ (((sb >> 9) & 1) << 5); R = (st >> 1) * 16 + swz / 64; C = (st & 1) * 32 + (swz % 64) / 2; }
__host__ __device__ __forceinline__ int perm32(int rho) { const int n = rho >> 4, i = rho & 15; return 8 * (i >> 2) + 4 * n + (i & 3); }
__device__ __forceinline__ unsigned cvt_pk_bf16(float lo, float hi) { unsigned r; asm volatile("v_cvt_pk_bf16_f32 %0, %1, %2" : "=v"(r) : "v"(lo), "v"(hi)); return r; }

struct Unit { const char* A; const char* B; int pm, pn, e, base; };

template <class Epi, class Sched, bool GATHER, bool SP2>
__device__ __forceinline__ void gemm_phase(LAS unsigned char* lds, const int K, const Sched& S, const Epi& E) {
#if MK_REF_GEMM
    {
        const int tid = threadIdx.x, wid = tid >> 6, lane = tid & 63, wr = wid >> 2, wc = wid & 3, fr = lane & 15, fq = lane >> 4;
        Unit cur;
        for (int ui = 0; S.next(ui, cur); ++ui) {
            f32x4 acc[2][2][4][2];
            for (int ai = 0; ai < 2; ++ai) for (int m = 0; m < 4; ++m) {
                const int r = 128 * ai + 64 * wr + 16 * m + fr;
                const bf16* arow = GATHER ? (const bf16*)cur.A + (size_t)S.row_index(cur, r) * K : (const bf16*)cur.A + (size_t)r * K;
                for (int bj = 0; bj < 2; ++bj) for (int n = 0; n < 2; ++n) {
                    f32x4 a4 = {0.f, 0.f, 0.f, 0.f};
                    for (int i = 0; i < 4; ++i) { const int c = 128 * bj + 32 * wc + 8 * fq + 4 * n + i; const bf16* brow = (const bf16*)cur.B + (size_t)c * K;
                        float s = 0.f; for (int k = 0; k < K; ++k) s += bf2f(arow[k]) * bf2f(brow[k]); a4[i] = s; }
                    acc[ai][bj][m][n] = a4; } }
            E(acc, cur, wr, wc, fr, fq);
        }
        return;
    }
#else
    const int tid = threadIdx.x, wid = __builtin_amdgcn_readfirstlane(tid >> 6), lane = tid & 63, wr = wid >> 2, wc = wid & 3, fr = lane & 15, fq = lane >> 4;
    const int nt = K / BK;
    unsigned voffA[2], voffB[2]; int gR = 0, gC = 0;
#pragma unroll
    for (int i = 0; i < 2; ++i) { int R, C; stage_rc(tid * 16 + i * 8192, R, C); const int Rb = (R & ~31) + perm32(R & 31);
        voffA[i] = (unsigned)(R * K + C) * 2u; voffB[i] = (unsigned)(Rb * K + C) * 2u; if (i == 0) { gR = R; gC = C; } }
    const size_t kstep = (size_t)(BK * 2);
    const size_t hstep = (size_t)HALF * K * 2;
    const unsigned ldsw = (unsigned)wid * 1024u;
    const int aoff = lds_byte(wr * 64 + fr, fq * 8), boff = lds_byte(wc * 32 + fr, fq * 8);
#define PG8_SA(b, h) (((b) * 2 + (h)) * HTB)
#define PG8_SB(b, h) ((4 + (b) * 2 + (h)) * HTB)
#define PG8_STAGE(bufoff, gbase, voff) do { _Pragma("unroll") for (int _i = 0; _i < 2; ++_i) \
        __builtin_amdgcn_global_load_lds((const unsigned*)((const char*)(gbase) + (voff)[_i]), (LAS unsigned*)(lds + (bufoff) + ldsw + _i * 8192), 16, 0, 0); } while (0)
#define PG8_STAGE_A(bufoff, gbase, h, G) do { if constexpr (GATHER) { PG8_STAGE(bufoff, gbase, (G)[h]); } else { PG8_STAGE(bufoff, (gbase) + (h) * hstep, voffA); } } while (0)
#define PG8_LDA(dst, b, h) do { _Pragma("unroll") for (int m = 0; m < 4; ++m) _Pragma("unroll") for (int k = 0; k < 2; ++k) dst[m][k] = *(const LAS bf16x8*)(lds + PG8_SA(b, h) + aoff + m * 2048 + k * 1024); } while (0)
#define PG8_LDB(dst, b, h) do { _Pragma("unroll") for (int n = 0; n < 2; ++n) _Pragma("unroll") for (int k = 0; k < 2; ++k) dst[n][k] = *(const LAS bf16x8*)(lds + PG8_SB(b, h) + boff + n * 2048 + k * 1024); } while (0)
#define PG8_MMA(ai, bj, At, Bt) do { __builtin_amdgcn_s_setprio(1); _Pragma("unroll") for (int m = 0; m < 4; ++m) _Pragma("unroll") for (int n = 0; n < 2; ++n) _Pragma("unroll") for (int k = 0; k < 2; ++k) \
        acc[ai][bj][m][n] = __builtin_amdgcn_mfma_f32_16x16x32_bf16(Bt[n][k], At[m][k], acc[ai][bj][m][n], 0, 0, 0); __builtin_amdgcn_s_setprio(0); } while (0)
#define PG8_WAIT_V(n) asm volatile("s_waitcnt vmcnt(" #n ")" ::: "memory")
#define PG8_WAIT_L(n) asm volatile("s_waitcnt lgkmcnt(" #n ")" ::: "memory")
#define PG8_BAR __builtin_amdgcn_s_barrier()
#define PG8_SCHED __builtin_amdgcn_sched_barrier(0)
    Unit cur, nxt; int ui = 0;
    if (!S.next(0, cur)) return;
    f32x4 acc[2][2][4][2];
#pragma unroll
    for (int a = 0; a < 2; ++a)
#pragma unroll
        for (int b = 0; b < 2; ++b)
#pragma unroll
            for (int m = 0; m < 4; ++m)
#pragma unroll
                for (int n = 0; n < 2; ++n) acc[a][b][m][n] = (f32x4){0.f, 0.f, 0.f, 0.f};
    bf16x8 At[4][2], B0[2][2], B1[2][2];
    const char* cA = cur.A; const char* cB = cur.B;
    unsigned cG[2][2] = {{0u, 0u}, {0u, 0u}}, nG[2][2] = {{0u, 0u}, {0u, 0u}};
    if constexpr (GATHER) {
#pragma unroll
        for (int h = 0; h < 2; ++h)
#pragma unroll
            for (int i = 0; i < 2; ++i) cG[h][i] = ((unsigned)S.row_index(cur, 128 * h + gR + 64 * i) * (unsigned)K + (unsigned)gC) * 2u;
    }
    if constexpr (SP2) {
        PG8_STAGE(PG8_SB(0, 0), cB, voffB); PG8_STAGE(PG8_SB(0, 1), cB + hstep, voffB); PG8_STAGE_A(PG8_SA(0, 0), cA, 0, cG); PG8_STAGE_A(PG8_SA(0, 1), cA, 1, cG);
        if (wr == 1) PG8_BAR;
        PG8_WAIT_V(2); PG8_BAR;
        PG8_STAGE(PG8_SB(1, 0), cB + kstep, voffB); PG8_STAGE_A(PG8_SA(1, 0), cA + kstep, 0, cG); PG8_STAGE(PG8_SB(1, 1), cB + hstep + kstep, voffB);
        PG8_WAIT_V(6); PG8_BAR;
    } else {
        PG8_STAGE(PG8_SB(0, 0), cB, voffB); PG8_STAGE_A(PG8_SA(0, 0), cA, 0, cG); PG8_STAGE(PG8_SB(0, 1), cB + hstep, voffB); PG8_STAGE_A(PG8_SA(0, 1), cA, 1, cG);
        if (wr == 1) PG8_BAR;
        PG8_WAIT_V(4); PG8_BAR;
        PG8_STAGE(PG8_SB(1, 0), cB + kstep, voffB); PG8_STAGE_A(PG8_SA(1, 0), cA + kstep, 0, cG); PG8_STAGE(PG8_SB(1, 1), cB + hstep + kstep, voffB);
        PG8_WAIT_V(6); PG8_BAR;
    }
    for (;;) {
        const bool has_next = S.next(ui + 1, nxt);
        const char* nA = has_next ? nxt.A : cA; const char* nB = has_next ? nxt.B : cB;
        for (int t = 0; t < nt; t += 2) {
            const bool last = (t == nt - 2);
            const char* a1 = cA + (size_t)(t + 1) * kstep;
            const char* a2 = last ? nA : cA + (size_t)(t + 2) * kstep; const char* b2 = last ? nB : cB + (size_t)(t + 2) * kstep;
            const char* a3 = a2 + kstep; const char* b3 = b2 + kstep;
            unsigned g2[2][2] = {{0u, 0u}, {0u, 0u}};
            if constexpr (GATHER) {
                if (last) {
                    if (has_next) {
#pragma unroll
                        for (int h = 0; h < 2; ++h)
#pragma unroll
                            for (int i = 0; i < 2; ++i) nG[h][i] = ((unsigned)S.row_index(nxt, 128 * h + gR + 64 * i) * (unsigned)K + (unsigned)gC) * 2u;
                    } else {
#pragma unroll
                        for (int h = 0; h < 2; ++h)
#pragma unroll
                            for (int i = 0; i < 2; ++i) nG[h][i] = cG[h][i];
                    }
                }
#pragma unroll
                for (int h = 0; h < 2; ++h)
#pragma unroll
                    for (int i = 0; i < 2; ++i) g2[h][i] = last ? nG[h][i] : cG[h][i];
            }
            if constexpr (SP2) {
            PG8_LDB(B0, 0, 0); PG8_LDB(B1, 0, 1); PG8_SCHED; PG8_LDA(At, 0, 0); PG8_STAGE_A(PG8_SA(1, 1), a1, 1, cG);
            PG8_WAIT_V(8); PG8_WAIT_L(0); PG8_BAR; PG8_MMA(0, 0, At, B0); PG8_MMA(0, 1, At, B1); PG8_BAR; PG8_SCHED;
            PG8_LDA(At, 0, 1); PG8_STAGE(PG8_SB(0, 0), b2, voffB); PG8_STAGE(PG8_SB(0, 1), b2 + hstep, voffB); PG8_STAGE_A(PG8_SA(0, 0), a2, 0, g2);
            PG8_WAIT_V(8); PG8_WAIT_L(0); PG8_BAR; PG8_MMA(1, 0, At, B0); PG8_MMA(1, 1, At, B1); PG8_BAR; PG8_SCHED;
            PG8_LDB(B0, 1, 0); PG8_LDB(B1, 1, 1); PG8_SCHED; PG8_LDA(At, 1, 0); PG8_STAGE_A(PG8_SA(0, 1), a2, 1, g2);
            PG8_WAIT_V(8); PG8_WAIT_L(0); PG8_BAR; PG8_MMA(0, 0, At, B0); PG8_MMA(0, 1, At, B1); PG8_BAR; PG8_SCHED;
            PG8_LDA(At, 1, 1); PG8_STAGE(PG8_SB(1, 0), b3, voffB); PG8_STAGE(PG8_SB(1, 1), b3 + hstep, voffB); PG8_STAGE_A(PG8_SA(1, 0), a3, 0, g2);
            PG8_WAIT_V(8); PG8_WAIT_L(0); PG8_BAR; PG8_MMA(1, 0, At, B0); PG8_MMA(1, 1, At, B1); PG8_BAR; PG8_SCHED;
            } else {
            PG8_LDB(B0, 0, 0); PG8_SCHED; PG8_LDA(At, 0, 0); PG8_STAGE_A(PG8_SA(1, 1), a1, 1, cG);
            PG8_WAIT_L(8); PG8_BAR; PG8_WAIT_L(0); PG8_MMA(0, 0, At, B0); PG8_BAR; PG8_SCHED;
            PG8_LDB(B1, 0, 1); PG8_STAGE(PG8_SB(0, 0), b2, voffB);
            PG8_BAR; PG8_WAIT_L(0); PG8_MMA(0, 1, At, B1); PG8_BAR;
            PG8_LDA(At, 0, 1); PG8_STAGE_A(PG8_SA(0, 0), a2, 0, g2);
            PG8_BAR; PG8_WAIT_L(0); PG8_MMA(1, 0, At, B0); PG8_BAR; PG8_SCHED;
            PG8_STAGE(PG8_SB(0, 1), b2 + hstep, voffB);
            PG8_WAIT_V(6); PG8_BAR; PG8_MMA(1, 1, At, B1); PG8_BAR;
            PG8_LDB(B0, 1, 0); PG8_SCHED; PG8_LDA(At, 1, 0); PG8_STAGE_A(PG8_SA(0, 1), a2, 1, g2);
            PG8_WAIT_L(8); PG8_BAR; PG8_WAIT_L(0); PG8_MMA(0, 0, At, B0); PG8_BAR; PG8_SCHED;
            PG8_LDB(B1, 1, 1); PG8_STAGE(PG8_SB(1, 0), b3, voffB);
            PG8_BAR; PG8_WAIT_L(0); PG8_MMA(0, 1, At, B1); PG8_BAR;
            PG8_LDA(At, 1, 1); PG8_STAGE_A(PG8_SA(1, 0), a3, 0, g2);
            PG8_BAR; PG8_WAIT_L(0); PG8_MMA(1, 0, At, B0); PG8_BAR; PG8_SCHED;
            PG8_STAGE(PG8_SB(1, 1), b3 + hstep, voffB);
            PG8_WAIT_V(6); PG8_BAR; PG8_MMA(1, 1, At, B1); PG8_BAR;
            }
        }
        if (wr == 0) PG8_BAR;
        { int tz = threadIdx.x; asm volatile("" : "+v"(tz)); const int wid_ = __builtin_amdgcn_readfirstlane(tz >> 6), lane_ = tz & 63;
          E(acc, cur, wid_ >> 2, wid_ & 3, lane_ & 15, lane_ >> 4); }
        if (!has_next) break;
#pragma unroll
        for (int a = 0; a < 2; ++a)
#pragma unroll
            for (int b = 0; b < 2; ++b)
#pragma unroll
                for (int m = 0; m < 4; ++m)
#pragma unroll
                    for (int n = 0; n < 2; ++n) acc[a][b][m][n] = (f32x4){0.f, 0.f, 0.f, 0.f};
        cur = nxt; cA = nA; cB = nB; ++ui;
        if constexpr (GATHER) {
#pragma unroll
            for (int h = 0; h < 2; ++h)
#pragma unroll
                for (int i = 0; i < 2; ++i) cG[h][i] = nG[h][i];
        }
        if (wr == 1) PG8_BAR;
    }
    PG8_WAIT_V(0);
    PG8_BAR;
#undef PG8_SA
#undef PG8_SB
#undef PG8_STAGE
#undef PG8_STAGE_A
#undef PG8_LDA
#undef PG8_LDB
#undef PG8_MMA
#undef PG8_WAIT_V
#undef PG8_WAIT_L
#undef PG8_BAR
#undef PG8_SCHED
#endif
}
}
constexpr bool SP2 = true;

#define XB_TMO      128
#define XB_XCNT(j)  (256  + 64 * (j))
#define XB_XSUB(j)  (1280 + 64 * (j))
#define XB_XGEN(j)  (2304 + 64 * (j))
#define XB_TOP      3328
#define XB_TOPGEN   3392
#define XCD_BAR_WORDS 3456
#define XB_SPIN_CAP (1u << 18)
__device__ __forceinline__ unsigned xb_ld(unsigned* p)              { return __hip_atomic_load(p, __ATOMIC_RELAXED, __HIP_MEMORY_SCOPE_AGENT); }
__device__ __forceinline__ unsigned xb_add(unsigned* p, unsigned v) { return __hip_atomic_fetch_add(p, v, __ATOMIC_RELAXED, __HIP_MEMORY_SCOPE_AGENT); }
__device__ __forceinline__ unsigned xb_xcc_id() { return (unsigned)__builtin_amdgcn_s_getreg((3 << 11) | 20) & 0xFu; }
#define XB_SPIN(cond, bar) do { unsigned _sp = 0; while (cond) { __builtin_amdgcn_s_sleep(1); \
    if ((++_sp & 255u) == 0u) { if (xb_ld(&(bar)[XB_TMO])) break; if (_sp > XB_SPIN_CAP) { atomicAdd(&(bar)[XB_TMO], 1u); break; } } } } while (0)
struct XcdBarrier { unsigned* bar; unsigned x; volatile LAS unsigned* st; };
__device__ __forceinline__ XcdBarrier xcd_barrier_post(unsigned* bar, volatile LAS unsigned* st) {
    XcdBarrier b; b.bar = bar; b.x = xb_xcc_id(); b.st = st;
    if (threadIdx.x == 0) (void)xb_add(&bar[XB_XCNT(b.x)], 1u);
    return b;
}
__device__ __forceinline__ void xcd_barrier_complete(unsigned* bar, unsigned x, unsigned& nloc, unsigned& nx) {
    const unsigned G = gridDim.x * gridDim.y * gridDim.z;
    unsigned sum, cnt, mine, sp = 0u;
    for (;;) {
        sum = 0u; cnt = 0u; mine = 0u;
#pragma unroll
        for (unsigned j = 0; j < 16; ++j) { const unsigned c = xb_ld(&bar[XB_XCNT(j)]); sum += c; cnt += (c > 0u) ? 1u : 0u; mine = (j == x) ? c : mine; }
        if (sum == G) break;
        __builtin_amdgcn_s_sleep(1);
        if ((++sp & 255u) == 0u) { if (xb_ld(&bar[XB_TMO])) break; if (sp > XB_SPIN_CAP) { atomicAdd(&bar[XB_TMO], 1u); break; } }
    }
    nloc = mine > 0u ? mine : 1u; nx = cnt > 0u ? cnt : 1u;
}
__device__ __forceinline__ void xcd_barrier(const XcdBarrier& b) {
    asm volatile("s_waitcnt vmcnt(0)" ::: "memory");
    __syncthreads();
    if (threadIdx.x == 0) {
        unsigned* bar = b.bar;
        __builtin_amdgcn_s_waitcnt(0);
        unsigned nloc = b.st[0], nx = b.st[1];
        if (nloc == 0u) { xcd_barrier_complete(bar, b.x, nloc, nx); b.st[0] = nloc; b.st[1] = nx; }
        const unsigned old = xb_add(&bar[XB_XSUB(b.x)], 1u);
        const unsigned gen = old / nloc;
        if (old + 1u == (gen + 1u) * nloc) {
            __builtin_amdgcn_fence(__ATOMIC_RELEASE, "agent");
            asm volatile("s_waitcnt vmcnt(0)" ::: "memory");
            const unsigned og = xb_add(&bar[XB_TOP], 1u);
            const unsigned tg = og / nx;
            if (og + 1u == (tg + 1u) * nx) xb_add(&bar[XB_TOPGEN], 1u);
            else XB_SPIN(xb_ld(&bar[XB_TOPGEN]) == tg, bar);
            __builtin_amdgcn_fence(__ATOMIC_ACQUIRE, "agent");
            xb_add(&bar[XB_XGEN(b.x)], 1u);
            asm volatile("s_waitcnt vmcnt(0)" ::: "memory");
        } else {
            XB_SPIN(xb_ld(&bar[XB_XGEN(b.x)]) == gen, bar);
            __builtin_amdgcn_fence(__ATOMIC_ACQUIRE, "agent");
            asm volatile("s_waitcnt vmcnt(0)" ::: "memory");
        }
    }
    __syncthreads();
}

constexpr int NWAVES = 8, NTHR = 512;
constexpr int RING_BYTES = 131072, MISC_OFF = 139264, LDS_BYTES = 147456;
struct Args {
    const float* in[28]; float* out; unsigned char* ws; int ph_lo, ph_hi;
};
struct Frame {
    LAS unsigned char* lds; int tid, lane, wave, G, bid;
    const float *x, *c, *ctx, *c_ctx, *w_mod, *b_mod, *n_mix_pre, *n_mix_post, *n_ffn_pre, *n_ffn_post, *w_in, *gdn_conv, *ret_log_decay, *gdn_a_log, *gdn_dt_bias,
        *ret_gn_w, *gdn_norm_w, *w_ret_out, *w_gdn_out, *w_o, *w_router, *router_bias, *w_gate, *w_up, *w_down, *w_sh_gate, *w_sh_up, *w_sh_down;
    float* out; unsigned char* ws; unsigned* ctl;
};
#define WSP(T, off) ((T*)(F.ws + (off)))

template <class CM>
__device__ __forceinline__ void transpose_item(const float* W, int ld, int K, bf16* WT, LAS float* scr, int kb, int nb, int lane, const CM& cm) {
    const int k0 = 64 * kb, n0 = 32 * nb; const int sc = cm(n0 + (lane & 31));
#pragma unroll 8
    for (int i = 0; i < 32; ++i) { const int kk = 2 * i + (lane >> 5); scr[kk * 33 + (lane & 31)] = W[(size_t)(k0 + kk) * ld + sc]; }
    asm volatile("s_waitcnt lgkmcnt(0)" ::: "memory");
    const int c = lane & 7;
#pragma unroll
    for (int j = 0; j < 4; ++j) { const int n = (lane >> 3) + 8 * j; const LAS float* s = scr + (8 * c) * 33 + n;
        u32x4 o; o.x = pk2(s[0 * 33], s[1 * 33]); o.y = pk2(s[2 * 33], s[3 * 33]); o.z = pk2(s[4 * 33], s[5 * 33]); o.w = pk2(s[6 * 33], s[7 * 33]);
        *(u32x4*)(WT + (size_t)(n0 + n) * K + k0 + 8 * c) = o; }
    asm volatile("s_waitcnt lgkmcnt(0)" ::: "memory");
}
struct CmIdent { int off; __device__ __forceinline__ int operator()(int n) const { return n + off; } };
struct CmWin {
    __device__ __forceinline__ int operator()(int n) const {
        const int g = n >> 9; int src = n + (n >= 2048 ? 16 : 0);
        if (g == 0 || g == 4) { const int hb = n & ~127, cp = n & 127; const int wc = cp >> 5, fq = (cp >> 3) & 3, nn = (cp >> 2) & 1, i = cp & 3;
            const int d = 64 * nn + 16 * wc + 4 * fq + i; src = hb + d + (n >= 2048 ? 16 : 0); }
        return src; }
};
__device__ __forceinline__ void gu_decode(int cp, int& hid, int& isup) { const int pn = cp >> 8, r = cp & 255, bj = r >> 7, wc = (r >> 5) & 3, fq = (r >> 3) & 3, nn = (r >> 2) & 1, i = r & 3; hid = pn * 128 + bj * 64 + wc * 16 + fq * 4 + i; isup = nn; }

__device__ __forceinline__ void phase_prologue(Frame& F) {
    const int gw = F.bid * NWAVES + F.wave, NGW = F.G * NWAVES; const int gt = F.bid * NTHR + F.tid, NGT = F.G * NTHR;
    LAS float* scr = (LAS float*)(F.lds + F.wave * 16384);
    { float2* rt = WSP(float2, WS_ROPE);
      for (int idx = gt; idx < SEQ * 64; idx += NGT) { const int t = idx >> 6, j = idx & 63; const float pos = (float)(j < 32 ? (t >> 6) : (t & 63)); const int f = j & 31;
          const float inv = powf(10000.0f, -(float)f / 32.0f); const float ang = pos * inv; float sn, cs; sincosf(ang, &sn, &cs); rt[idx] = make_float2(cs, sn); } }
    {
        LAS float* red = (LAS float*)(F.lds);
        for (int it = F.bid; it < 96; it += F.G) {
            const int col = it * 64 + F.lane; float a[5] = {0.f, 0.f, 0.f, 0.f, 0.f};
            const int kb = F.wave * 128;
#pragma unroll 4
            for (int k = kb; k < kb + 128; ++k) { const float w = F.w_mod[(size_t)k * 6144 + col];
#pragma unroll
                for (int r = 0; r < 5; ++r) { const float cv = r < 4 ? F.c[r * DM + k] : F.c_ctx[k]; a[r] += siluf_(cv) * w; } }
#pragma unroll
            for (int r = 0; r < 5; ++r) red[(F.wave * 5 + r) * 64 + F.lane] = a[r];
            __syncthreads();
            if (F.wave < 5) { float s = F.b_mod[col];
#pragma unroll
                for (int w = 0; w < 8; ++w) s += red[(w * 5 + F.wave) * 64 + F.lane];
                WSP(float, WS_MOD)[F.wave * 6144 + col] = s; }
            __syncthreads();
        }
    }
    {
        constexpr int I_IN = 16 * 192, I_RO = 8 * 32, I_O = 16 * 32; constexpr int NIT = I_IN + 2 * I_RO + I_O;
        for (int it = gw; it < NIT; it += NGW) { int r = it;
            if (r < I_IN) { transpose_item(F.w_in, N_IN, DM, WSP(bf16, WS_WIN), scr, r / 192, r % 192, F.lane, CmWin{}); continue; } r -= I_IN;
            if (r < I_RO) { transpose_item(F.w_ret_out, DM, 512, WSP(bf16, WS_WRO), scr, r / 32, r % 32, F.lane, CmIdent{0}); continue; } r -= I_RO;
            if (r < I_RO) { transpose_item(F.w_gdn_out, DM, 512, WSP(bf16, WS_WGO), scr, r / 32, r % 32, F.lane, CmIdent{0}); continue; } r -= I_RO;
            transpose_item(F.w_o, DM, DM, WSP(bf16, WS_WO), scr, r / 32, r % 32, F.lane, CmIdent{0}); }
    }
}

__device__ __forceinline__ void phase_moe_weights(Frame& F) {
    const int gw = F.bid * NWAVES + F.wave, NGW = F.G * NWAVES;
    LAS float* scr = (LAS float*)(F.lds + F.wave * 16384);
    constexpr int I_GU = 16 * 16  , I_D = 4 * 32;
    for (int it = gw; it < 65 * (I_GU + I_D); it += NGW) {
        const int e = it / (I_GU + I_D); int r = it % (I_GU + I_D);
        if (r < I_GU) {
            const int kb = r / 16, nb = r % 16;
            const int k0 = 64 * kb, n0 = 32 * nb; int hid, isup; gu_decode(n0 + (F.lane & 31), hid, isup);
            const float* Wg = e < 64 ? F.w_gate + (size_t)e * DM * DEXP : F.w_sh_gate; const float* Wu = e < 64 ? F.w_up + (size_t)e * DM * DEXP : F.w_sh_up;
            const float* W = isup ? Wu : Wg;
#pragma unroll 8
            for (int i = 0; i < 32; ++i) { const int kk = 2 * i + (F.lane >> 5); scr[kk * 33 + (F.lane & 31)] = W[(size_t)(k0 + kk) * DEXP + hid]; }
            asm volatile("s_waitcnt lgkmcnt(0)" ::: "memory");
            const int c = F.lane & 7; bf16* WT = WSP(bf16, WS_WGU) + (size_t)e * 512 * DM;
#pragma unroll
            for (int j = 0; j < 4; ++j) { const int n = (F.lane >> 3) + 8 * j; const LAS float* s = scr + (8 * c) * 33 + n;
                u32x4 o; o.x = pk2(s[0 * 33], s[1 * 33]); o.y = pk2(s[2 * 33], s[3 * 33]); o.z = pk2(s[4 * 33], s[5 * 33]); o.w = pk2(s[6 * 33], s[7 * 33]);
                *(u32x4*)(WT + (size_t)(n0 + n) * DM + k0 + 8 * c) = o; }
            asm volatile("s_waitcnt lgkmcnt(0)" ::: "memory");
        } else { r -= I_GU;
            const float* W = e < 64 ? F.w_down + (size_t)e * DEXP * DM : F.w_sh_down;
            transpose_item(W, DM, DEXP, WSP(bf16, WS_WD) + (size_t)e * DM * DEXP, scr, r / 32, r % 32, F.lane, CmIdent{0}); }
    }
}

__device__ __forceinline__ void phase_norm1(Frame& F) {
    const int gw = F.bid * NWAVES + F.wave, NGW = F.G * NWAVES;
    const float* mod = WSP(float, WS_MOD);
    LAS float* wl = (LAS float*)F.lds;
    for (int k = F.tid; k < DM; k += NTHR) { const float* wr = F.w_in + (size_t)k * N_IN + 2048;
#pragma unroll
        for (int jj = 0; jj < 4; ++jj) { const f32x4 w4 = *(const f32x4*)(wr + 4 * jj); wl[(4 * jj) * DM + k] = w4.x; wl[(4 * jj + 1) * DM + k] = w4.y; wl[(4 * jj + 2) * DM + k] = w4.z; wl[(4 * jj + 3) * DM + k] = w4.w; } }
    __syncthreads();
    for (int row = gw; row < NROW; row += NGW) {
        const int b = row / RPB, pos = row % RPB; const bool isctx = pos < CTXL;
        const float* src = isctx ? F.ctx + ((size_t)b * CTXL + pos) * DM : F.x + ((size_t)b * SEQ + (pos - CTXL)) * DM;
        const float* sh = isctx ? mod + 4 * 6144 : mod + b * 6144; const float* sc = sh + DM;
        f32x4 v[4]; float ss = 0.f;
#pragma unroll
        for (int j = 0; j < 4; ++j) { v[j] = *(const f32x4*)(src + 4 * (F.lane + 64 * j)); ss += v[j].x * v[j].x + v[j].y * v[j].y + v[j].z * v[j].z + v[j].w * v[j].w; }
        const float rstd = 1.0f / sqrtf(wave_sum(ss) * (1.f / DM) + EPS);
        float gd[16];
#pragma unroll
        for (int jj = 0; jj < 16; ++jj) gd[jj] = 0.f;
#pragma unroll
        for (int j = 0; j < 4; ++j) { const int c0 = 4 * (F.lane + 64 * j);
            const f32x4 g = *(const f32x4*)(F.n_mix_pre + c0), s1 = *(const f32x4*)(sc + c0), s0 = *(const f32x4*)(sh + c0);
            f32x4 h; h.x = v[j].x * rstd * g.x * (1.f + s1.x) + s0.x; h.y = v[j].y * rstd * g.y * (1.f + s1.y) + s0.y; h.z = v[j].z * rstd * g.z * (1.f + s1.z) + s0.z; h.w = v[j].w * rstd * g.w * (1.f + s1.w) + s0.w;
            u32x2 o; o.x = pk2(h.x, h.y); o.y = pk2(h.z, h.w);
            *(u32x2*)(WSP(bf16, WS_HX) + (size_t)row * DM + c0) = o;
#pragma unroll
            for (int jh = 0; jh < 2; ++jh) {
                asm volatile("" ::: "memory");
#pragma unroll
                for (int jj = 8 * jh; jj < 8 * jh + 8; ++jj) { const f32x4 w4 = *(const LAS f32x4*)(wl + jj * DM + c0); gd[jj] += (h.x * w4.x + h.y * w4.y) + (h.z * w4.z + h.w * w4.w); } } }
        float mine = 0.f;
#pragma unroll
        for (int jj = 0; jj < 16; ++jj) { const float s = wave_sum(gd[jj]); mine = (F.lane == jj) ? s : mine; }
        if (F.lane < 16) { const int ab = F.lane >> 3, dir = (F.lane >> 2) & 1, h = F.lane & 3; const size_t o = ((size_t)(dir * NB + b) * NH + h) * RPB + pos;
            if (ab == 0) { const float z = mine + F.gdn_dt_bias[dir * 4 + h]; const float sp = z > 20.f ? z : log1pf(expf(z)); WSP(float, WS_LOGA)[o] = -expf(F.gdn_a_log[dir * 4 + h]) * sp; }
            else WSP(float, WS_BETA)[o] = 1.f / (1.f + expf(-mine)); }
    }
}

struct SchedIn {
    const char* A; const char* B; int G, c;
    __device__ __forceinline__ bool next(int i, pg8::Unit& u) const {
        const int L = i * G + c; if (L >= 1536 + 32) return false;
        int lt, pn;
        if (L < 1536) { int wgid = L; { const int q = 1536 / 8, xcd = wgid % 8, off = wgid / 8; wgid = xcd * q + off; }
            const int nig = 8 * 24, gid = wgid / nig, fm = gid * 8; lt = fm + ((wgid % nig) % 8); pn = (wgid % nig) / 8; u.pm = (lt >> 4) * 17 + 1 + (lt & 15); }
        else { const int q = L - 1536; u.pm = (q >> 3) * 17; pn = q & 7; }
        u.pn = pn; u.e = 0; u.base = 0; u.A = A + (size_t)u.pm * 256 * DM * 2; u.B = B + (size_t)pn * 256 * DM * 2; return true; }
    __device__ __forceinline__ int row_index(const pg8::Unit&, int r) const { return r; }
};
struct EpiIn {
    bf16* P; bf16* GATES; const float2* rope;
    __device__ __forceinline__ void operator()(const f32x4 (&acc)[2][2][4][2], const pg8::Unit& u, int wr, int wc, int fr, int fq) const {
        const int g = u.pn >> 1;
        const int b = u.pm / 17, tl = u.pm % 17;
#pragma unroll
        for (int ai = 0; ai < 2; ++ai)
#pragma unroll
            for (int m = 0; m < 4; ++m) {
                const int rt = ai * 128 + wr * 64 + m * 16 + fr; const size_t prow = (size_t)u.pm * 256 + rt;
#pragma unroll
                for (int bj = 0; bj < 2; ++bj) {
                    f32x4 v0 = acc[ai][bj][m][0], v1 = acc[ai][bj][m][1];
                    const int ct = bj * 128 + wc * 32 + 8 * fq;
                    if (g == 0 || g == 4) {
                        const float s = (g == 0) ? 0.08838834764831845f : 1.0f; v0 = v0 * s; v1 = v1 * s;
                        const int j = 16 * wc + 4 * fq;
                        f32x4 o1 = v0, o2 = v1;
                        if (tl != 0) { const int t = (tl - 1) * 256 + rt; const float2* cs = rope + (size_t)t * 64 + j;
#pragma unroll
                            for (int i = 0; i < 4; ++i) { const float2 c2 = cs[i]; o1[i] = v0[i] * c2.x - v1[i] * c2.y; o2[i] = v0[i] * c2.y + v1[i] * c2.x; } }
                        bf16* dst = P + (size_t)g * PGRP + prow * 512 + (u.pn & 1) * 256 + bj * 128 + j;
                        u32x2 w1, w2; w1.x = pg8::cvt_pk_bf16(o1[0], o1[1]); w1.y = pg8::cvt_pk_bf16(o1[2], o1[3]); w2.x = pg8::cvt_pk_bf16(o2[0], o2[1]); w2.y = pg8::cvt_pk_bf16(o2[2], o2[3]);
                        *(u32x2*)dst = w1; *(u32x2*)(dst + 64) = w2;
                    } else if (g < 8) {
                        u32x4 w; w.x = pg8::cvt_pk_bf16(v0[0], v0[1]); w.y = pg8::cvt_pk_bf16(v0[2], v0[3]); w.z = pg8::cvt_pk_bf16(v1[0], v1[1]); w.w = pg8::cvt_pk_bf16(v1[2], v1[3]);
                        *(u32x4*)(P + (size_t)g * PGRP + prow * 512 + (u.pn & 1) * 256 + ct) = w;
                    } else {
                        const size_t lrow = (size_t)b * SEQ + (size_t)(tl - 1) * 256 + rt;
#pragma unroll
                        for (int i = 0; i < 4; ++i) { v0[i] = sigmoidf_(v0[i]); v1[i] = sigmoidf_(v1[i]); }
                        u32x4 w; w.x = pg8::cvt_pk_bf16(v0[0], v0[1]); w.y = pg8::cvt_pk_bf16(v0[2], v0[3]); w.z = pg8::cvt_pk_bf16(v1[0], v1[1]); w.w = pg8::cvt_pk_bf16(v1[2], v1[3]);
                        *(u32x4*)(GATES + lrow * 2048 + (u.pn - 16) * 256 + ct) = w;
                    }
                }
            }
    }
};

constexpr int IMGB = 34816, IMGS = 272;
typedef short s16x4 __attribute__((ext_vector_type(4)));
__device__ __forceinline__ unsigned offb(unsigned row, unsigned ch) { return 272u * row + 16u * ch; }
__device__ __forceinline__ unsigned offe(unsigned row, unsigned col) { return 272u * row + 2u * col; }
__device__ __forceinline__ bf16x8 frag_row(LAS unsigned char* img, int tile, int s, int lane) { return *(const LAS bf16x8*)(img + offb(16 * tile + (lane & 15), 4 * s + (lane >> 4))); }
__device__ __forceinline__ bf16x8 frag_tr(LAS unsigned char* img, int tile, int s, int lane) {
    const unsigned g = lane >> 4, qq = (lane & 15) >> 2, p = lane & 3;
    const s16x4 lo = __builtin_amdgcn_ds_read_tr16_b64_v4i16((LAS s16x4*)(img + offe(32 * s + 8 * g + qq, 16 * tile + 4 * p)));
    const s16x4 hi = __builtin_amdgcn_ds_read_tr16_b64_v4i16((LAS s16x4*)(img + offe(32 * s + 8 * g + 4 + qq, 16 * tile + 4 * p)));
    return (bf16x8){lo[0], lo[1], lo[2], lo[3], hi[0], hi[1], hi[2], hi[3]};
}
#define MFMA16(a, b, c) __builtin_amdgcn_mfma_f32_16x16x32_bf16(a, b, c, 0, 0, 0)
#define LBAR() do { asm volatile("s_waitcnt lgkmcnt(0)" ::: "memory"); __builtin_amdgcn_s_barrier(); asm volatile("" ::: "memory"); } while (0)
template <bool SWAP>
__device__ __forceinline__ void mm128(LAS unsigned char* ia, bool atr, LAS unsigned char* ib, bool btr, int wr, int wc, int lane, f32x4 (&acc)[2][4]) {
#pragma unroll
    for (int s = 0; s < 4; ++s) {
        bf16x8 fa[2], fb[4];
#pragma unroll
        for (int i = 0; i < 2; ++i) fa[i] = atr ? frag_tr(ia, 2 * wr + i, s, lane) : frag_row(ia, 2 * wr + i, s, lane);
#pragma unroll
        for (int j = 0; j < 4; ++j) fb[j] = btr ? frag_tr(ib, 4 * wc + j, s, lane) : frag_row(ib, 4 * wc + j, s, lane);
#pragma unroll
        for (int i = 0; i < 2; ++i)
#pragma unroll
            for (int j = 0; j < 4; ++j) acc[i][j] = SWAP ? MFMA16(fb[j], fa[i], acc[i][j]) : MFMA16(fa[i], fb[j], acc[i][j]);
    }
}
__device__ __forceinline__ void zero_acc(f32x4 (&acc)[2][4]) {
#pragma unroll
    for (int i = 0; i < 2; ++i)
#pragma unroll
        for (int j = 0; j < 4; ++j) acc[i][j] = (f32x4){0.f, 0.f, 0.f, 0.f};
}
__device__ __forceinline__ void st_img(LAS unsigned char* img, const f32x4 (&acc)[2][4], int wr, int wc, int lane) {
    const int r = lane & 15, q = lane >> 4;
#pragma unroll
    for (int i = 0; i < 2; ++i)
#pragma unroll
        for (int j = 0; j < 4; ++j) { u32x2 w; w.x = pk2(acc[i][j][0], acc[i][j][1]); w.y = pk2(acc[i][j][2], acc[i][j][3]);
            *(LAS u32x2*)(img + offe(32 * wr + 16 * i + r, 64 * wc + 16 * j + 4 * q)) = w; }
}
__device__ __forceinline__ void load_plain_img(LAS unsigned char* img, const bf16* src, int ld, int tid) {
#pragma unroll
    for (int i = 0; i < 4; ++i) { const int cidx = tid + 512 * i, row = cidx >> 4, ch = cidx & 15;
        *(LAS u32x4*)(img + offb(row, ch)) = *(const u32x4*)(src + (size_t)row * ld + 8 * ch); }
}
__device__ __forceinline__ void load_conv_img(LAS unsigned char* img, const bf16* src, const float* cw  , bool has_prev, bool has_next, int mode  , int wave, int lane) {
    asm volatile("" ::: "memory");
    const int ch = lane & 15; float w0[8], w1[8], w2[8];
#pragma unroll
    for (int i = 0; i < 8; ++i) { w0[i] = cw[8 * ch + i]; w1[i] = cw[1536 + 8 * ch + i]; w2[i] = cw[3072 + 8 * ch + i]; }
#pragma unroll
    for (int it = 0; it < 4; ++it) {
        const int row = 32 * it + 4 * wave + (lane >> 4); const u32x4 z4 = {0u, 0u, 0u, 0u};
        const u32x4 r0 = (row > 0 || has_prev) ? *(const u32x4*)(src + ((ptrdiff_t)row - 1) * 512 + 8 * ch) : z4;
        const u32x4 r1 = *(const u32x4*)(src + (size_t)row * 512 + 8 * ch);
        const u32x4 r2 = (row < 127 || has_next) ? *(const u32x4*)(src + (size_t)(row + 1) * 512 + 8 * ch) : z4;
        float a0[8], a1[8], a2[8], y[8]; unpack8(r0, a0); unpack8(r1, a1); unpack8(r2, a2); float ss = 0.f;
#pragma unroll
        for (int i = 0; i < 8; ++i) { y[i] = siluf_(w0[i] * a0[i] + w1[i] * a1[i] + w2[i] * a2[i]); ss += y[i] * y[i]; }
        if (mode != 1) { const float sc = (1.0f / sqrtf(sum16(ss) + EPS)) * (mode == 2 ? 0.08838834764831845f : 1.0f);
#pragma unroll
            for (int i = 0; i < 8; ++i) y[i] *= sc; }
        *(LAS u32x4*)(img + offb(row, ch)) = pack8(y);
    }
}
__device__ __forceinline__ void scale_rows_img(LAS unsigned char* dst, LAS unsigned char* src, const LAS float* rs, int tid) {
#pragma unroll
    for (int i = 0; i < 4; ++i) { const int cidx = tid + 512 * i, row = cidx >> 4, ch = cidx & 15; float v[8]; unpack8(*(const LAS u32x4*)(src + offb(row, ch)), v); const float sc = rs[row];
#pragma unroll
        for (int e = 0; e < 8; ++e) v[e] *= sc;
        *(LAS u32x4*)(dst + offb(row, ch)) = pack8(v); }
}
__device__ __forceinline__ void tri_inverse(LAS unsigned char* img, int w, int lane) {
    const int r = lane & 15, q = lane >> 4;
    {
        const int b0 = 16 * w; float x[16];
#pragma unroll
        for (int i = 0; i < 16; ++i) { float v = (i == r) ? 1.f : 0.f;
#pragma unroll
            for (int j = 0; j < i; ++j) v -= bf2f(*(const LAS unsigned short*)(img + offe(b0 + i, b0 + j))) * x[j];
            x[i] = v; }
        if (q == 0) {
#pragma unroll
            for (int i = 0; i < 16; ++i) *(LAS unsigned short*)(img + offe(b0 + i, b0 + r)) = (unsigned short)f2bf(x[i]); }
    }
    LBAR();
    if (w < 4) {
        const int c0 = 32 * w, r1 = c0 + 16;
        const u32x2 av = *(const LAS u32x2*)(img + offe(r1 + r, c0 + 4 * q));
        const bf16x8 fa = __builtin_bit_cast(bf16x8, (u32x4){av.x, av.y, 0u, 0u});
        const s16x4 tb = __builtin_amdgcn_ds_read_tr16_b64_v4i16((LAS s16x4*)(img + offe(c0 + 4 * q + (r >> 2), c0 + 4 * (r & 3))));
        const bf16x8 fb = (bf16x8){tb[0], tb[1], tb[2], tb[3], 0, 0, 0, 0};
        const f32x4 y = MFMA16(fa, fb, ((f32x4){0.f, 0.f, 0.f, 0.f}));
        const bf16x8 fy = __builtin_bit_cast(bf16x8, (u32x4){pk2(y[0], y[1]), pk2(y[2], y[3]), 0u, 0u});
        const u32x2 tv = *(const LAS u32x2*)(img + offe(r1 + r, r1 + 4 * q));
        const bf16x8 ft = __builtin_bit_cast(bf16x8, (u32x4){tv.x, tv.y, 0u, 0u});
        const f32x4 d = MFMA16(fy, ft, ((f32x4){0.f, 0.f, 0.f, 0.f}));
        u32x2 o; o.x = pk2(-d[0], -d[1]); o.y = pk2(-d[2], -d[3]);
        *(LAS u32x2*)(img + offe(r1 + r, c0 + 4 * q)) = o;
    }
    LBAR();
    {
        const int p = w >> 2, ti = (w >> 1) & 1, tj = w & 1, base = 64 * p, rb = base + 32;
        f32x4 y[2];
        const unsigned g = lane >> 4, qq = (lane & 15) >> 2, pp = lane & 3;
        const s16x4 lo = __builtin_amdgcn_ds_read_tr16_b64_v4i16((LAS s16x4*)(img + offe(base + 8 * g + qq, base + 16 * tj + 4 * pp)));
        const s16x4 hi = __builtin_amdgcn_ds_read_tr16_b64_v4i16((LAS s16x4*)(img + offe(base + 8 * g + 4 + qq, base + 16 * tj + 4 * pp)));
        const bf16x8 fb = (bf16x8){lo[0], lo[1], lo[2], lo[3], hi[0], hi[1], hi[2], hi[3]};
#pragma unroll
        for (int kt = 0; kt < 2; ++kt) { const bf16x8 fa = *(const LAS bf16x8*)(img + offb(rb + 16 * kt + r, (base >> 3) + q)); y[kt] = MFMA16(fa, fb, ((f32x4){0.f, 0.f, 0.f, 0.f})); }
        const bf16x8 fy = __builtin_bit_cast(bf16x8, (u32x4){pk2(y[0][0], y[0][1]), pk2(y[0][2], y[0][3]), pk2(y[1][0], y[1][1]), pk2(y[1][2], y[1][3])});
        const u32x2 t0 = *(const LAS u32x2*)(img + offe(rb + 16 * ti + r, rb + 4 * q)), t1 = *(const LAS u32x2*)(img + offe(rb + 16 * ti + r, rb + 16 + 4 * q));
        const bf16x8 ft = __builtin_bit_cast(bf16x8, (u32x4){t0.x, t0.y, t1.x, t1.y});
        const f32x4 d = MFMA16(fy, ft, ((f32x4){0.f, 0.f, 0.f, 0.f}));
        LBAR();
        u32x2 o; o.x = pk2(-d[0], -d[1]); o.y = pk2(-d[2], -d[3]);
        *(LAS u32x2*)(img + offe(rb + 16 * ti + r, base + 16 * tj + 4 * q)) = o;
    }
    LBAR();
    {
        const int tj = w >> 1, ti0 = 2 * (w & 1);
        f32x4 y[4];
#pragma unroll
        for (int kt = 0; kt < 4; ++kt) y[kt] = (f32x4){0.f, 0.f, 0.f, 0.f};
#pragma unroll
        for (int s = 0; s < 2; ++s) { const bf16x8 fb = frag_tr(img, tj, s, lane);
#pragma unroll
            for (int kt = 0; kt < 4; ++kt) y[kt] = MFMA16(frag_row(img, 4 + kt, s, lane), fb, y[kt]); }
        f32x4 d[2];
#pragma unroll
        for (int i = 0; i < 2; ++i) { d[i] = (f32x4){0.f, 0.f, 0.f, 0.f};
#pragma unroll
            for (int ks = 0; ks < 2; ++ks) {
                const bf16x8 fy = __builtin_bit_cast(bf16x8, (u32x4){pk2(y[2 * ks][0], y[2 * ks][1]), pk2(y[2 * ks][2], y[2 * ks][3]), pk2(y[2 * ks + 1][0], y[2 * ks + 1][1]), pk2(y[2 * ks + 1][2], y[2 * ks + 1][3])});
                const int row = 64 + 16 * (ti0 + i) + r;
                const u32x2 t0 = *(const LAS u32x2*)(img + offe(row, 64 + 32 * ks + 4 * q)), t1 = *(const LAS u32x2*)(img + offe(row, 64 + 32 * ks + 16 + 4 * q));
                d[i] = MFMA16(fy, __builtin_bit_cast(bf16x8, (u32x4){t0.x, t0.y, t1.x, t1.y}), d[i]); } }
        LBAR();
#pragma unroll
        for (int i = 0; i < 2; ++i) { u32x2 o; o.x = pk2(-d[i][0], -d[i][1]); o.y = pk2(-d[i][2], -d[i][3]);
            *(LAS u32x2*)(img + offe(64 + 16 * (ti0 + i) + r, 16 * tj + 4 * q)) = o; }
    }
    LBAR();
}

__device__ __forceinline__ void phase_prep(Frame& F) {
    LAS unsigned char* I0 = F.lds; LAS unsigned char* I1 = F.lds + IMGB; LAS unsigned char* I2 = F.lds + 2 * IMGB; LAS unsigned char* I3 = F.lds + 3 * IMGB;
    LAS float* sm = (LAS float*)(F.lds + MISC_OFF + 1024);
    LAS float* s_la = sm; LAS float* s_bet = sm + 128; LAS float* s_gc = sm + 256; LAS float* s_eg = sm + 384; LAS float* s_s2 = sm + 512; LAS float* s_t1 = sm + 640; LAS float* s_t2 = sm + 768;
#define LAUNDER() int tz_ = threadIdx.x; asm volatile("" : "+v"(tz_)); const int tid = tz_, lane = tz_ & 63, w = __builtin_amdgcn_readfirstlane(tz_ >> 6), wr = w >> 1, wc = w & 1, r = lane & 15, q = lane >> 4; (void)tid; (void)lane; (void)w; (void)wr; (void)wc; (void)r; (void)q
    const bf16* P = WSP(bf16, WS_P);
    for (int it = F.bid; it < 512 + 96; it += F.G) {
        int b, h, m, part = 3;
        if (it < 512) { b = it >> 7; h = (it >> 5) & 3; m = 2 + (it & 31); } else { const int c3 = it - 512; const int c = c3 / 3; part = c3 - 3 * c; b = c >> 3; h = (c >> 1) & 3; m = c & 1; }
        const bool isctx = m < 2; const int pos0 = 128 * m; const size_t row0 = (size_t)b * RPB + pos0; const size_t trow0 = (size_t)b * SEQ + (pos0 - CTXL);
        const bool hprev = isctx ? (m > 0) : (m > 2), hnext = isctx ? (m < 1) : (m < NCHUNK - 1);
        const size_t hoff = row0 * 512 + h * 128;
        f32x4 acc[2][4];
        if (part == 3 || part == 0) {
        const float lgf = F.ret_log_decay[h] * 1.4426950408889634f, lgb = F.ret_log_decay[4 + h] * 1.4426950408889634f;
        { LAUNDER();
        load_plain_img(I0, P + 0 * PGRP + hoff, 512, tid); load_plain_img(I1, P + 1 * PGRP + hoff, 512, tid);
        if (!isctx) load_plain_img(I2, P + 4 * PGRP + hoff, 512, tid);
        if (tid < 128) { s_t1[tid] = exp2f(lgf * (float)(127 - tid)); s_t2[tid] = exp2f(lgb * (float)tid); } }
        LBAR();
        if (!isctx) {
            { LAUNDER();
            zero_acc(acc); mm128<true>(I2, false, I0, false, wr, wc, lane, acc);
#pragma unroll
            for (int i = 0; i < 2; ++i)
#pragma unroll
                for (int j = 0; j < 4; ++j)
#pragma unroll
                    for (int e = 0; e < 4; ++e) { const int ii = 32 * wr + 16 * i + r, jj = 64 * wc + 16 * j + 4 * q + e; const int d = ii - jj;
                        const float wg = (d >= 0 ? exp2f(lgf * (float)d) : 0.f) + (d <= 0 ? exp2f(lgb * (float)(-d)) : 0.f); acc[i][j][e] *= wg; }
            st_img(I3, acc, wr, wc, lane); }
            LBAR();
            { LAUNDER();
            zero_acc(acc); mm128<true>(I3, false, I1, true, wr, wc, lane, acc);
            bf16* og = WSP(bf16, WS_ORET) + (trow0 + 32 * wr + r) * 512 + h * 128 + 64 * wc + 4 * q;
#pragma unroll
            for (int i = 0; i < 2; ++i)
#pragma unroll
                for (int j = 0; j < 4; ++j) { u32x2 o; o.x = pk2(acc[i][j][0], acc[i][j][1]); o.y = pk2(acc[i][j][2], acc[i][j][3]); *(u32x2*)(og + (size_t)(16 * i) * 512 + 16 * j) = o; } }
        }
#pragma unroll 1
        for (int dir = 0; dir < 2; ++dir) {
            LAS unsigned char* kw = dir ? I3 : I2;
            { LAUNDER(); scale_rows_img(kw, I0, dir ? s_t2 : s_t1, tid); }
            LBAR();
            LAUNDER();
            zero_acc(acc); mm128<false>(kw, true, I1, true, wr, wc, lane, acc);
            const int chain = (b * NH + h) * 2 + dir, n = dir ? (isctx ? 1 - m : 35 - m) : m;
            unsigned char* kv = F.ws + WS_GKV + ((size_t)chain * NCHUNK + n) * 32768;
#pragma unroll
            for (int i = 0; i < 2; ++i)
#pragma unroll
                for (int j = 0; j < 4; ++j) { const int mt = 2 * wr + i, nt = 4 * wc + j; u32x2 o; o.x = pk2(acc[i][j][0], acc[i][j][1]); o.y = pk2(acc[i][j][2], acc[i][j][3]);
                    *(u32x2*)(kv + ((size_t)((nt * 4 + (mt >> 1)) * 64 + (2 * (mt & 1) + (q >> 1)) * 16 + r)) * 16 + 8 * (q & 1)) = o; }
        }
        LBAR();
        }
#pragma unroll 1
        for (int dir = (part == 2 ? 1 : 0); dir < (part == 3 ? 2 : part == 0 ? 0 : part); ++dir) {
            const int chain = (b * NH + h) * 2 + dir, n = dir ? (isctx ? 1 - m : 35 - m) : m;
            { LAUNDER(); load_conv_img(I0, P + 2 * PGRP + hoff, F.gdn_conv + 512 + h * 128, hprev, hnext, 0, w, lane); }
            { LAUNDER(); load_conv_img(I1, P + 3 * PGRP + hoff, F.gdn_conv + 1024 + h * 128, hprev, hnext, 1, w, lane); }
            { LAUNDER(); if (tid < 128) { const size_t o = ((size_t)(dir * NB + b) * NH + h) * RPB + pos0 + tid; s_la[tid] = WSP(float, WS_LOGA)[o]; s_bet[tid] = WSP(float, WS_BETA)[o]; } }
            LBAR();
            { LAUNDER();
            if (w == 0) {
                const float a = s_la[2 * lane], c = s_la[2 * lane + 1]; const float pr = a + c; float inc = pr;
#pragma unroll
                for (int o = 1; o < 64; o <<= 1) { const float t = __shfl_up(inc, o); if (lane >= o) inc += t; }
                const float tot = __shfl(inc, 63); const float ex = inc - pr;
                float g0 = ex + a, g1 = ex + pr;
                if (dir) { g0 = tot - ex; g1 = tot - (ex + a); }
                s_gc[2 * lane] = g0; s_gc[2 * lane + 1] = g1; s_eg[2 * lane] = __expf(g0); s_eg[2 * lane + 1] = __expf(g1);
                s_s2[2 * lane] = __expf(tot - g0); s_s2[2 * lane + 1] = __expf(tot - g1);
                if (lane == 0) s_t1[0] = __expf(tot);
            } }
            LBAR();
            { LAUNDER();
            zero_acc(acc); mm128<true>(I0, false, I0, false, wr, wc, lane, acc);
#pragma unroll
            for (int i = 0; i < 2; ++i)
#pragma unroll
                for (int j = 0; j < 4; ++j) { const int ii = 32 * wr + 16 * i + r; const float gi = s_gc[ii], bi = s_bet[ii];
#pragma unroll
                    for (int e = 0; e < 4; ++e) { const int jj = 64 * wc + 16 * j + 4 * q + e;
                        const float f = dir ? s_bet[jj] * __expf(s_gc[jj] - gi) : bi * __expf(gi - s_gc[jj]); acc[i][j][e] = (ii > jj) ? acc[i][j][e] * f : 0.f; } }
            st_img(I2, acc, wr, wc, lane); }
            LBAR();
            { LAUNDER(); tri_inverse(I2, w, lane); }
            { LAUNDER();
#pragma unroll
            for (int i = 0; i < 4; ++i) { const int cidx = tid + 512 * i, row = cidx >> 4, ch = cidx & 15; float v[8], v2[8]; unpack8(*(const LAS u32x4*)(I2 + offb(row, ch)), v);
#pragma unroll
                for (int e = 0; e < 8; ++e) { const int k = dir ? row : 8 * ch + e; const float bb = s_bet[k]; v[e] *= bb; v2[e] = v[e] * s_eg[k]; }
                *(LAS u32x4*)(I2 + offb(row, ch)) = pack8(v); *(LAS u32x4*)(I3 + offb(row, ch)) = pack8(v2); } }
            LBAR();
            { LAUNDER();
            zero_acc(acc); mm128<true>(I3, dir != 0, I0, true, wr, wc, lane, acc);
            LBAR();
            st_img(I3, acc, wr, wc, lane); }
            { LAUNDER();
            zero_acc(acc); mm128<true>(I2, dir != 0, I1, true, wr, wc, lane, acc);
            LBAR();
            st_img(I2, acc, wr, wc, lane);
            scale_rows_img(I1, I0, s_s2, tid); }
            LBAR();
            {
                LAUNDER();
                const float dtot = s_t1[0];
                zero_acc(acc); mm128<false>(I1, true, I2, true, wr, wc, lane, acc);
                unsigned char* gc = F.ws + WS_GC + ((size_t)chain * NCHUNK + n) * 32768;
#pragma unroll
                for (int i = 0; i < 2; ++i)
#pragma unroll
                    for (int j = 0; j < 4; ++j) { const int mt = 2 * wr + i, nt = 4 * wc + j; u32x2 o; o.x = pk2(acc[i][j][0], acc[i][j][1]); o.y = pk2(acc[i][j][2], acc[i][j][3]);
                        *(u32x2*)(gc + ((size_t)((nt * 8 + mt) * 64 + lane)) * 8) = o; }
                }
                { LAUNDER(); const float dtot = s_t1[0];
                zero_acc(acc); mm128<true>(I1, true, I3, true, wr, wc, lane, acc);
                unsigned char* gm = F.ws + WS_GM + ((size_t)chain * NCHUNK + n) * 32768;
#pragma unroll
                for (int i = 0; i < 2; ++i)
#pragma unroll
                    for (int j = 0; j < 4; ++j) { const int mt = 2 * wr + i, ct = 4 * wc + j; const int rowi = 16 * mt + r; float v[4];
#pragma unroll
                        for (int e = 0; e < 4; ++e) v[e] = ((rowi == 16 * ct + 4 * q + e) ? dtot : 0.f) - acc[i][j][e];
                        u32x2 o; o.x = pk2(v[0], v[1]); o.y = pk2(v[2], v[3]);
                        *(u32x2*)(gm + ((size_t)((mt * 4 + (ct >> 1)) * 64 + q * 16 + r)) * 16 + 8 * (ct & 1)) = o; }
            }
            LBAR();
            if (!isctx) {
                { LAUNDER(); load_conv_img(I1, P + 6 * PGRP + hoff, F.gdn_conv + h * 128, hprev, hnext, 2, w, lane); }
                LBAR();
                { LAUNDER();
                zero_acc(acc); mm128<true>(I1, false, I0, false, wr, wc, lane, acc);
#pragma unroll
                for (int i = 0; i < 2; ++i) { const int ii = 32 * wr + 16 * i + r; const float gi = s_gc[ii];
#pragma unroll
                    for (int j = 0; j < 4; ++j)
#pragma unroll
                        for (int e = 0; e < 4; ++e) { const int jj = 64 * wc + 16 * j + 4 * q + e; const bool on = dir ? (jj >= ii) : (jj <= ii);
                            acc[i][j][e] = on ? acc[i][j][e] * __expf(gi - s_gc[jj]) : 0.f; } }
                LBAR();
                st_img(I0, acc, wr, wc, lane); }
                LBAR();
                { LAUNDER();
                zero_acc(acc); mm128<true>(I0, false, I2, true, wr, wc, lane, acc);
                { bf16* ogp = WSP(bf16, WS_OGDN) + (trow0 + 32 * wr + r) * 512 + h * 128 + 64 * wc + 4 * q;
#pragma unroll
                  for (int i = 0; i < 2; ++i)
#pragma unroll
                    for (int j = 0; j < 4; ++j) { bf16* pp = ogp + (size_t)(16 * i) * 512 + 16 * j; f32x4 v = acc[i][j];
                        if (dir) { const u32x2 pv = *(const u32x2*)pp; v[0] += bflo(pv.x); v[1] += bfhi(pv.x); v[2] += bflo(pv.y); v[3] += bfhi(pv.y); }
                        u32x2 o; o.x = pk2(v[0], v[1]); o.y = pk2(v[2], v[3]); *(u32x2*)pp = o; } } }
                { LAUNDER();
                zero_acc(acc); mm128<true>(I0, false, I3, true, wr, wc, lane, acc);
                unsigned char* qt = F.ws + WS_GQT + ((size_t)chain * 32 + (n - 2)) * 32768;
#pragma unroll
                for (int i = 0; i < 2; ++i) { const int ii = 32 * wr + 16 * i + r; const float egi = s_eg[ii];
#pragma unroll
                    for (int j = 0; j < 4; ++j) { const int mt = 2 * wr + i, ct = 4 * wc + j; const u32x2 qv = *(const LAS u32x2*)(I1 + offe(ii, 64 * wc + 16 * j + 4 * q));
                        u32x2 o; o.x = pk2(egi * bflo(qv.x) - acc[i][j][0], egi * bfhi(qv.x) - acc[i][j][1]); o.y = pk2(egi * bflo(qv.y) - acc[i][j][2], egi * bfhi(qv.y) - acc[i][j][3]);
                        *(u32x2*)(qt + ((size_t)((mt * 4 + (ct >> 1)) * 64 + q * 16 + r)) * 16 + 8 * (ct & 1)) = o; } } }
                LBAR();
            }
        }
    }
#undef LAUNDER
}

__device__ __forceinline__ void phase_scan(Frame& F) {
    const int lane = F.lane, w = F.wave, tid = F.tid;
    for (int it = F.bid; it < 256; it += F.G) {
        if (it < 128) {
            const int chain = it >> 2, dq = it & 3;
            const unsigned char* gm = F.ws + WS_GM + (size_t)chain * NCHUNK * 32768; unsigned char* gc = F.ws + WS_GC + (size_t)chain * NCHUNK * 32768;
            const int nt = 2 * dq + (w & 1);
            bf16x8 sf[4];
#pragma unroll
            for (int s = 0; s < 4; ++s) sf[s] = (bf16x8){0, 0, 0, 0, 0, 0, 0, 0};
            u32x4 stg[4];
#pragma unroll
            for (int i = 0; i < 4; ++i) stg[i] = *(const u32x4*)(gm + (size_t)(tid + 512 * i) * 16);
#pragma unroll 1
            for (int n = 0; n < NCHUNK; ++n) {
                LAS unsigned char* buf = F.lds + (n & 1) * 32768;
#pragma unroll
                for (int i = 0; i < 4; ++i) *(LAS u32x4*)(buf + (size_t)(tid + 512 * i) * 16) = stg[i];
                if (n + 1 < NCHUNK) {
#pragma unroll
                    for (int i = 0; i < 4; ++i) stg[i] = *(const u32x4*)(gm + (size_t)(n + 1) * 32768 + (size_t)(tid + 512 * i) * 16); }
                LBAR();
                if (w < 2) {
                    unsigned char* slot = gc + (size_t)n * 32768 + (size_t)nt * 4096;
                    f32x4 acc[8];
#pragma unroll
                    for (int mt = 0; mt < 8; ++mt) { const u32x2 cv = *(const u32x2*)(slot + (size_t)(mt * 64 + lane) * 8); acc[mt] = (f32x4){bflo(cv.x), bfhi(cv.x), bflo(cv.y), bfhi(cv.y)}; }
#pragma unroll
                    for (int s = 0; s < 4; ++s)
#pragma unroll
                        for (int mt = 0; mt < 8; ++mt) acc[mt] = MFMA16(*(const LAS bf16x8*)(buf + (size_t)((mt * 4 + s) * 64 + lane) * 16), sf[s], acc[mt]);
#pragma unroll
                    for (int s = 0; s < 4; ++s) { const u32x4 pk = {pk2(acc[2 * s][0], acc[2 * s][1]), pk2(acc[2 * s][2], acc[2 * s][3]), pk2(acc[2 * s + 1][0], acc[2 * s + 1][1]), pk2(acc[2 * s + 1][2], acc[2 * s + 1][3])};
                        sf[s] = __builtin_bit_cast(bf16x8, pk); *(u32x4*)(slot + (size_t)(s * 64 + lane) * 16) = pk; }
                }
            }
            LBAR();
        } else {
            const int gidx = (it - 128) * NTHR + tid; const int chain = gidx >> 11, piece = gidx & 2047; const int h = (chain >> 1) & 3, dir = chain & 1;
            const float dec = expf(F.ret_log_decay[dir * 4 + h] * 128.f);
            unsigned char* kv = F.ws + WS_GKV + (size_t)chain * NCHUNK * 32768 + (size_t)piece * 16;
            float st[8];
#pragma unroll
            for (int e = 0; e < 8; ++e) st[e] = 0.f;
#pragma unroll 2
            for (int n = 0; n < NCHUNK; ++n) { float v[8]; unpack8(*(const u32x4*)(kv + (size_t)n * 32768), v);
#pragma unroll
                for (int e = 0; e < 8; ++e) st[e] = dec * st[e] + v[e];
                *(u32x4*)(kv + (size_t)n * 32768) = pack8(st); }
        }
    }
}

__device__ __forceinline__ void phase_out(Frame& F) {
    const bf16* P = WSP(bf16, WS_P);
    for (int it = F.bid; it < 512; it += F.G) {
        int tz_ = threadIdx.x; asm volatile("" : "+v"(tz_)); const int tid = tz_, lane = tz_ & 63, w = __builtin_amdgcn_readfirstlane(tz_ >> 6), r = lane & 15, q = lane >> 4;
        const int b = it >> 7, h = (it >> 5) & 3, m = 2 + (it & 31);
        {
#pragma unroll
            for (int k = 0; k < 4; ++k) { const int dir = k & 1; const int chain = (b * NH + h) * 2 + dir, n = dir ? 35 - m : m;
                const unsigned char* sp = F.ws + (k < 2 ? WS_GC : WS_GKV) + ((size_t)chain * NCHUNK + (n - 1)) * 32768;
                u32x4 v[4];
#pragma unroll
                for (int i = 0; i < 4; ++i) v[i] = *(const u32x4*)(sp + (size_t)(tid + 512 * i) * 16);
#pragma unroll
                for (int i = 0; i < 4; ++i) *(LAS u32x4*)(F.lds + k * 32768 + (tid + 512 * i) * 16) = v[i]; }
        }
        const size_t prow = (size_t)b * RPB + 128 * m + 16 * w + r; const size_t trow = (size_t)b * SEQ + 128 * (m - 2) + 16 * w + r;
        const int il = 16 * w + r;
        f32x4 og[8], orr[8];
        {
            const bf16* a = WSP(bf16, WS_OGDN) + trow * 512 + h * 128 + 4 * q; const bf16* c = WSP(bf16, WS_ORET) + trow * 512 + h * 128 + 4 * q;
#pragma unroll
            for (int nt = 0; nt < 8; ++nt) { const u32x2 x = *(const u32x2*)(a + 16 * nt), y = *(const u32x2*)(c + 16 * nt);
                og[nt] = (f32x4){bflo(x.x), bfhi(x.x), bflo(x.y), bfhi(x.y)}; orr[nt] = (f32x4){bflo(y.x), bfhi(y.x), bflo(y.y), bfhi(y.y)}; }
        }
        bf16x8 fqg[2][4], fqr[4];
#pragma unroll
        for (int dir = 0; dir < 2; ++dir) { const int chain = (b * NH + h) * 2 + dir, n = dir ? 35 - m : m; const unsigned char* qt = F.ws + WS_GQT + ((size_t)chain * 32 + (n - 2)) * 32768;
#pragma unroll
            for (int s = 0; s < 4; ++s) fqg[dir][s] = *(const bf16x8*)(qt + (size_t)((w * 4 + s) * 64 + lane) * 16); }
        { const bf16* qp = P + 4 * PGRP + prow * 512 + h * 128;
#pragma unroll
          for (int s = 0; s < 4; ++s) fqr[s] = *(const bf16x8*)(qp + 32 * s + 8 * q); }
        LBAR();
#pragma unroll
        for (int dir = 0; dir < 2; ++dir) {
            {
                const LAS unsigned char* sp = F.lds + dir * 32768;
#pragma unroll
                for (int s = 0; s < 4; ++s)
#pragma unroll
                    for (int nt = 0; nt < 8; ++nt) og[nt] = MFMA16(*(const LAS bf16x8*)(sp + ((nt * 4 + s) * 64 + lane) * 16), fqg[dir][s], og[nt]);
            }
            {
                const LAS unsigned char* sp = F.lds + (2 + dir) * 32768;
                f32x4 t[8];
#pragma unroll
                for (int nt = 0; nt < 8; ++nt) t[nt] = (f32x4){0.f, 0.f, 0.f, 0.f};
#pragma unroll
                for (int s = 0; s < 4; ++s)
#pragma unroll
                    for (int nt = 0; nt < 8; ++nt) t[nt] = MFMA16(*(const LAS bf16x8*)(sp + ((nt * 4 + s) * 64 + lane) * 16), fqr[s], t[nt]);
                const float lg = F.ret_log_decay[dir * 4 + h]; const float dcy = expf(lg * (float)(dir ? 128 - il : il + 1));
#pragma unroll
                for (int nt = 0; nt < 8; ++nt) orr[nt] = orr[nt] + t[nt] * dcy;
            }
        }
        {
            float s1 = 0.f;
#pragma unroll
            for (int nt = 0; nt < 8; ++nt) s1 += (orr[nt][0] + orr[nt][1]) + (orr[nt][2] + orr[nt][3]);
            s1 += __shfl_xor(s1, 16); s1 += __shfl_xor(s1, 32); const float mean = s1 * (1.f / 128.f);
            float s2 = 0.f, s3 = 0.f;
#pragma unroll
            for (int nt = 0; nt < 8; ++nt)
#pragma unroll
                for (int e = 0; e < 4; ++e) { const float d = orr[nt][e] - mean; s2 += d * d; s3 += og[nt][e] * og[nt][e]; }
            s2 += __shfl_xor(s2, 16); s2 += __shfl_xor(s2, 32); s3 += __shfl_xor(s3, 16); s3 += __shfl_xor(s3, 32);
            const float rs_r = 1.0f / sqrtf(s2 * (1.f / 128.f) + EPS), rs_g = 1.0f / sqrtf(s3 * (1.f / 128.f) + EPS);
            const bf16* rg = P + 5 * PGRP + prow * 512 + h * 128 + 4 * q; const bf16* gz = P + 7 * PGRP + prow * 512 + h * 128 + 4 * q;
            bf16* ry = WSP(bf16, WS_RETY) + trow * 512 + h * 128 + 4 * q; bf16* gy = WSP(bf16, WS_GDNY) + trow * 512 + h * 128 + 4 * q;
#pragma unroll
            for (int nt = 0; nt < 8; ++nt) { const u32x2 a = *(const u32x2*)(rg + 16 * nt), c = *(const u32x2*)(gz + 16 * nt);
                const float ga[4] = {bflo(a.x), bfhi(a.x), bflo(a.y), bfhi(a.y)}, gc4[4] = {bflo(c.x), bfhi(c.x), bflo(c.y), bfhi(c.y)};
                const f32x4 wr4 = *(const f32x4*)(F.ret_gn_w + h * 128 + 16 * nt + 4 * q), wg4 = *(const f32x4*)(F.gdn_norm_w + h * 128 + 16 * nt + 4 * q);
                float yr[4], yg[4];
#pragma unroll
                for (int e = 0; e < 4; ++e) { yr[e] = (orr[nt][e] - mean) * rs_r * wr4[e] * siluf_(ga[e]); yg[e] = og[nt][e] * rs_g * wg4[e] * siluf_(gc4[e]); }
                u32x2 o1, o2; o1.x = pk2(yr[0], yr[1]); o1.y = pk2(yr[2], yr[3]); o2.x = pk2(yg[0], yg[1]); o2.y = pk2(yg[2], yg[3]);
                *(u32x2*)(ry + 16 * nt) = o1; *(u32x2*)(gy + 16 * nt) = o2; }
        }
        LBAR();
    }
}

struct SchedMerge {
    const char *A0, *A1, *B0, *B1; int G, c;
    __device__ __forceinline__ bool next(int i, pg8::Unit& u) const {
        const int L = (i >> 1) * G + c; if (L >= 256) return false; const int term = i & 1;
        const int xcd = L % 8, off = L / 8; const int w = xcd * 32 + off;
        u.pm = w >> 2; u.pn = w & 3; u.e = term; u.base = 0;
        u.A = (term ? A1 : A0) + (size_t)u.pm * 256 * 512 * 2; u.B = (term ? B1 : B0) + (size_t)u.pn * 256 * 512 * 2; return true; }
    __device__ __forceinline__ int row_index(const pg8::Unit&, int r) const { return r; }
};
struct EpiMerge {
    const bf16* GATES; bf16* TMP; bf16* MERGED;
    __device__ __forceinline__ void operator()(const f32x4 (&acc)[2][2][4][2], const pg8::Unit& u, int wr, int wc, int fr, int fq) const {
#pragma unroll
        for (int ai = 0; ai < 2; ++ai)
#pragma unroll
            for (int m = 0; m < 4; ++m) { const size_t row = (size_t)u.pm * 256 + ai * 128 + wr * 64 + m * 16 + fr;
#pragma unroll
                for (int bj = 0; bj < 2; ++bj) { const int col = u.pn * 256 + bj * 128 + wc * 32 + 8 * fq;
                    float g[8]; unpack8(*(const u32x4*)(GATES + row * 2048 + u.e * 1024 + col), g);
                    float v[8] = {acc[ai][bj][m][0][0], acc[ai][bj][m][0][1], acc[ai][bj][m][0][2], acc[ai][bj][m][0][3], acc[ai][bj][m][1][0], acc[ai][bj][m][1][1], acc[ai][bj][m][1][2], acc[ai][bj][m][1][3]};
                    if (u.e == 0) {
#pragma unroll
                        for (int i = 0; i < 8; ++i) v[i] *= g[i];
                        *(u32x4*)(TMP + row * DM + col) = pack8(v);
                    } else { float p[8]; unpack8(*(const u32x4*)(TMP + row * DM + col), p);
#pragma unroll
                        for (int i = 0; i < 8; ++i) v[i] = p[i] + v[i] * g[i];
                        *(u32x4*)(MERGED + row * DM + col) = pack8(v); } } }
    }
};
struct SchedDense {
    const char *A, *B; int nM, nN, K, G, c;
    __device__ __forceinline__ bool next(int i, pg8::Unit& u) const {
        const int L = i * G + c; const int nwg = nM * nN; if (L >= nwg) return false;
        int w = L; if (nwg % 8 == 0) { const int xcd = L % 8, off = L / 8; w = xcd * (nwg / 8) + off; }
        u.pm = w / nN; u.pn = w % nN; u.e = 0; u.base = 0; u.A = A + (size_t)u.pm * 256 * K * 2; u.B = B + (size_t)u.pn * 256 * K * 2; return true; }
    __device__ __forceinline__ int row_index(const pg8::Unit&, int r) const { return r; }
};
struct EpiBf16Store { bf16* O; int ldc;
    __device__ __forceinline__ void operator()(const f32x4 (&acc)[2][2][4][2], const pg8::Unit& u, int wr, int wc, int fr, int fq) const {
#pragma unroll
        for (int ai = 0; ai < 2; ++ai)
#pragma unroll
            for (int m = 0; m < 4; ++m) { const size_t row = (size_t)u.pm * 256 + ai * 128 + wr * 64 + m * 16 + fr;
#pragma unroll
                for (int bj = 0; bj < 2; ++bj) { const int col = u.pn * 256 + bj * 128 + wc * 32 + 8 * fq; const f32x4 v0 = acc[ai][bj][m][0], v1 = acc[ai][bj][m][1];
                    u32x4 w; w.x = pg8::cvt_pk_bf16(v0[0], v0[1]); w.y = pg8::cvt_pk_bf16(v0[2], v0[3]); w.z = pg8::cvt_pk_bf16(v1[0], v1[1]); w.w = pg8::cvt_pk_bf16(v1[2], v1[3]);
                    *(u32x4*)(O + row * ldc + col) = w; } }
    }
};

__device__ __forceinline__ void load_row_bf16(const bf16* p, int lane, float (&v)[16]) { float a[8], b[8]; unpack8(*(const u32x4*)(p + 8 * lane), a); unpack8(*(const u32x4*)(p + 512 + 8 * lane), b);
#pragma unroll
    for (int i = 0; i < 8; ++i) { v[i] = a[i]; v[8 + i] = b[i]; } }
__device__ __forceinline__ void load_row_f32(const float* p, int lane, float (&v)[16]) {
#pragma unroll
    for (int q = 0; q < 4; ++q) { const f32x4 a = *(const f32x4*)(p + (q >> 1) * 512 + 8 * lane + 4 * (q & 1)); v[4 * q] = a.x; v[4 * q + 1] = a.y; v[4 * q + 2] = a.z; v[4 * q + 3] = a.w; } }
__device__ __forceinline__ void store_row_f32(float* p, int lane, const float (&v)[16]) {
#pragma unroll
    for (int q = 0; q < 4; ++q) *(f32x4*)(p + (q >> 1) * 512 + 8 * lane + 4 * (q & 1)) = (f32x4){v[4 * q], v[4 * q + 1], v[4 * q + 2], v[4 * q + 3]}; }
__device__ __forceinline__ void compute_x1(Frame& F, int t, float (&x1)[16]) {
    const int b = t / SEQ; const float* mod = WSP(float, WS_MOD) + b * 6144;
    const bf16* mop = WSP(bf16, WS_MO) + (size_t)t * DM;
    const u32x4 m0 = *(const u32x4*)(mop + 8 * F.lane), m1 = *(const u32x4*)(mop + 512 + 8 * F.lane);
    float ss = 0.f;
    { float a[8], c[8]; unpack8(m0, a); unpack8(m1, c);
#pragma unroll
      for (int i = 0; i < 8; ++i) ss += a[i] * a[i] + c[i] * c[i]; }
    const float rstd = 1.0f / sqrtf(wave_sum(ss) * (1.f / DM) + EPS);
#pragma unroll
    for (int hf = 0; hf < 2; ++hf) {
        const int c0 = hf * 512 + 8 * F.lane; float mo[8]; unpack8(hf ? m1 : m0, mo);
        const float* xp = F.x + (size_t)t * DM + c0; const float* wp = F.n_mix_post + c0; const float* gp = mod + 2 * DM + c0;
#pragma unroll
        for (int q = 0; q < 2; ++q) { const f32x4 xv = *(const f32x4*)(xp + 4 * q), wv = *(const f32x4*)(wp + 4 * q), g1 = *(const f32x4*)(gp + 4 * q);
#pragma unroll
            for (int e = 0; e < 4; ++e) x1[hf * 8 + 4 * q + e] = xv[e] + g1[e] * (mo[4 * q + e] * rstd * wv[e]); }
    }
}
__device__ __forceinline__ void route_token(Frame& F, int t, float logit, LAS unsigned* lcnt, LAS u32x2* stage, unsigned* cnt, int2* list) {
    const float score = 1.f / (1.f + expf(-logit)); const float biased = score + F.router_bias[F.lane];
    int rk = 0;
#pragma unroll
    for (int o = 0; o < 8; ++o) { const int src = (F.lane & ~7) | o; const float ov = __shfl(biased, src); rk += ((ov > biased) | ((ov == biased) & (src < F.lane))) ? 1 : 0; }
    float gs = rk < 2 ? biased : 0.f; gs += __shfl_xor(gs, 1); gs += __shfl_xor(gs, 2); gs += __shfl_xor(gs, 4);
    int grk = 0; const int myg = F.lane >> 3;
#pragma unroll
    for (int o = 0; o < 8; ++o) { const float ov = __shfl(gs, o * 8); grk += ((ov > gs) | ((ov == gs) & (o < myg))) ? 1 : 0; }
    const bool keep = grk < 4;
    const float cand = keep ? biased : -__builtin_inff();
    int erk = 0;
#pragma unroll
    for (int o = 0; o < 64; ++o) { const float ov = __builtin_bit_cast(float, __builtin_amdgcn_readlane(__builtin_bit_cast(int, cand), o)); erk += ((ov > cand) | ((ov == cand) & (o < F.lane))) ? 1 : 0; }
    const bool sel = keep && erk < TOPK;
    const float ssum = wave_sum(sel ? score : 0.f);
    if (sel) { const float w = score / ssum * 2.5f; const unsigned pos = __hip_atomic_fetch_add(lcnt + F.lane, 1u, __ATOMIC_RELAXED, __HIP_MEMORY_SCOPE_WORKGROUP);
        if (pos < 48u) stage[F.lane * 48 + pos] = (u32x2){(unsigned)(t * 8 + erk), __float_as_uint(w)};
        else { const unsigned gp = atomicAdd(cnt + 64 * F.lane, 1u); list[(size_t)F.lane * NT + gp] = make_int2(t * 8 + erk, __float_as_int(w)); } }
}
__device__ __forceinline__ void phase_route(Frame& F) {
    LAS float* hrow = (LAS float*)F.lds;
    LAS float* part = (LAS float*)(F.lds + 32768);
    LAS float* wlds = (LAS float*)(F.lds + 49152);
    LAS u32x2* stage = (LAS u32x2*)(F.lds + 114688);
    LAS unsigned* lcnt = (LAS unsigned*)(F.lds + MISC_OFF + 1024);
    unsigned* cnt = F.ctl + CW_CNT; int2* list = WSP(int2, WS_LIST);
    float wreg[96];
#pragma unroll
    for (int kk = 0; kk < 96; ++kk) wreg[kk] = F.w_router[(size_t)(F.wave * 128 + kk) * NEXP + F.lane];
#pragma unroll
    for (int kk = 0; kk < 32; ++kk) wlds[(F.wave * 32 + kk) * 64 + F.lane] = F.w_router[(size_t)(F.wave * 128 + 96 + kk) * NEXP + F.lane];
    for (int g64 = F.bid; g64 < NT / 64; g64 += F.G) {
        if (F.tid < 64) lcnt[F.tid] = 0u;
        __syncthreads();
#pragma unroll 1
        for (int grp = 0; grp < 8; ++grp) {
            const int t = g64 * 64 + grp * 8 + F.wave; const int b = t / SEQ; const float* mod = WSP(float, WS_MOD) + b * 6144;
            {
                float x1[16]; compute_x1(F, t, x1);
                float ss = 0.f;
#pragma unroll
                for (int i = 0; i < 16; ++i) ss += x1[i] * x1[i];
                const float rstd = 1.0f / sqrtf(wave_sum(ss) * (1.f / DM) + EPS);
                LAS float* hr = hrow + F.wave * DM; bf16* d = WSP(bf16, WS_H2) + (size_t)t * DM;
#pragma unroll
                for (int hf = 0; hf < 2; ++hf) {
                    const int c0 = hf * 512 + 8 * F.lane; float h2[8];
#pragma unroll
                    for (int q = 0; q < 2; ++q) { const f32x4 wv = *(const f32x4*)(F.n_ffn_pre + c0 + 4 * q), sh = *(const f32x4*)(mod + 3 * DM + c0 + 4 * q), sc = *(const f32x4*)(mod + 4 * DM + c0 + 4 * q);
#pragma unroll
                        for (int e = 0; e < 4; ++e) h2[4 * q + e] = x1[hf * 8 + 4 * q + e] * rstd * wv[e] * (1.f + sc[e]) + sh[e]; }
                    *(u32x4*)(d + c0) = pack8(h2);
                    *(LAS f32x4*)(hr + c0) = (f32x4){h2[0], h2[1], h2[2], h2[3]}; *(LAS f32x4*)(hr + c0 + 4) = (f32x4){h2[4], h2[5], h2[6], h2[7]};
                }
            }
            LBAR();
#pragma unroll 1
            for (int tok = 0; tok < 8; ++tok) { float a0 = 0.f, a1 = 0.f, a2 = 0.f, a3 = 0.f; const LAS float* hp = hrow + tok * DM + F.wave * 128;
#pragma unroll
                for (int k4 = 0; k4 < 24; ++k4) { const f32x4 hv = *(const LAS f32x4*)(hp + 4 * k4); a0 += hv.x * wreg[4 * k4]; a1 += hv.y * wreg[4 * k4 + 1]; a2 += hv.z * wreg[4 * k4 + 2]; a3 += hv.w * wreg[4 * k4 + 3]; }
#pragma unroll
                for (int k4 = 0; k4 < 8; ++k4) { const f32x4 hv = *(const LAS f32x4*)(hp + 96 + 4 * k4); const LAS float* wp = wlds + (F.wave * 32 + 4 * k4) * 64 + F.lane;
                    a0 += hv.x * wp[0]; a1 += hv.y * wp[64]; a2 += hv.z * wp[128]; a3 += hv.w * wp[192]; }
                part[(F.wave * 8 + tok) * 64 + F.lane] = (a0 + a1) + (a2 + a3); }
            LBAR();
            float logit = 0.f;
#pragma unroll
            for (int w = 0; w < 8; ++w) logit += part[(w * 8 + F.wave) * 64 + F.lane];
            route_token(F, t, logit, lcnt, stage, cnt, list);
        }
        __syncthreads();
        if (F.tid < 64) { const unsigned n = lcnt[F.tid] < 48u ? lcnt[F.tid] : 48u; lcnt[F.tid] = n; lcnt[64 + F.tid] = atomicAdd(cnt + 64 * F.tid, n); }
        __syncthreads();
        { const int e = F.tid >> 3; const unsigned n = lcnt[e], base = lcnt[64 + e];
          for (unsigned j = F.tid & 7; j < n; j += 8) { const u32x2 v = stage[e * 48 + j]; list[(size_t)e * NT + base + j] = make_int2((int)v.x, (int)v.y); } }
        __syncthreads();
    }
}

__device__ __forceinline__ void build_tile_prefix(Frame& F, LAS int* tp) {
    __syncthreads();
    if (F.tid == 0) { int s = 0; const unsigned* cnt = F.ctl + CW_CNT; for (int e = 0; e < 64; ++e) { tp[e] = s; s += ((int)__hip_atomic_load(cnt + 64 * e, __ATOMIC_RELAXED, __HIP_MEMORY_SCOPE_AGENT) + 255) >> 8; } tp[64] = s; tp[65] = s + 64;
        const int x = F.bid & 7; int l = 0; for (int k = 0; k < 8; ++k) { tp[80 + k] = l; l += tp[x + 8 * k + 1] - tp[x + 8 * k]; } tp[88] = l; tp[89] = l + 8; }
    __syncthreads();
}
struct SchedMoe {
    const char* A; const char* B; const int2* list; const unsigned* cnt; const LAS int* tp; int npn, K, G, c; size_t bstride  ; int bcol0  ; bool gather;
    __device__ __forceinline__ bool next(int i, pg8::Unit& u) const {
        int e, pm;
        if ((G & 7) == 0) {
            const int x = c & 7, W = G >> 3, L = i * W + (c >> 3); const int nt = __builtin_amdgcn_readfirstlane(tp[89]); if (L >= nt * npn) return false;
            const int tl = L / npn; u.pn = L % npn; int k = 0;
            for (int q = 8; q >= 1; q >>= 1) if (k + q <= 8 && __builtin_amdgcn_readfirstlane(tp[80 + k + q]) <= tl) k += q;
            k = __builtin_amdgcn_readfirstlane(k); const int off = tl - __builtin_amdgcn_readfirstlane(tp[80 + k]);
            if (k < 8) { e = x + 8 * k; pm = off; } else { e = 64; pm = x + 8 * off; }
        } else {
            const int L = i * G + c; const int ntile = __builtin_amdgcn_readfirstlane(tp[65]); if (L >= ntile * npn) return false;
            const int tile = L / npn; u.pn = L % npn; e = 0;
            for (int q = 64; q >= 1; q >>= 1) if (e + q <= 64 && __builtin_amdgcn_readfirstlane(tp[e + q]) <= tile) e += q;
            e = __builtin_amdgcn_readfirstlane(e); pm = tile - __builtin_amdgcn_readfirstlane(tp[e]);
        }
        u.e = e; u.pm = pm; u.base = (e < 64 ? (__builtin_amdgcn_readfirstlane(tp[e < 64 ? e : 0]) + pm) * 256 : SLOT_SH + pm * 256);
        u.A = gather ? A : A + (size_t)u.base * K * 2; u.B = B + (size_t)e * bstride + (size_t)(bcol0 + u.pn * 256) * K * 2; return true; }
    __device__ __forceinline__ int row_index(const pg8::Unit& u, int r) const {
        if (u.e == 64) return u.pm * 256 + r;
        const unsigned tok = (unsigned)list[(size_t)u.e * NT + u.pm * 256 + r].x >> 3; return (int)(tok < (unsigned)NT ? tok : 0u); }
};
struct EpiUp { bf16* HMID;
    __device__ __forceinline__ void operator()(const f32x4 (&acc)[2][2][4][2], const pg8::Unit& u, int wr, int wc, int fr, int fq) const {
#pragma unroll
        for (int ai = 0; ai < 2; ++ai)
#pragma unroll
            for (int m = 0; m < 4; ++m) { const size_t slot = (size_t)u.base + ai * 128 + wr * 64 + m * 16 + fr;
#pragma unroll
                for (int bj = 0; bj < 2; ++bj) { const int hid = u.pn * 128 + bj * 64 + wc * 16 + fq * 4; const f32x4 g = acc[ai][bj][m][0], up = acc[ai][bj][m][1];
                    u32x2 w; w.x = pg8::cvt_pk_bf16(siluf_(g[0]) * up[0], siluf_(g[1]) * up[1]); w.y = pg8::cvt_pk_bf16(siluf_(g[2]) * up[2], siluf_(g[3]) * up[3]);
                    *(u32x2*)(HMID + slot * DEXP + hid) = w; } }
    }
};
struct EpiDown { bf16* YB; float* OUT; const int2* list; const unsigned* cnt; int half;
    __device__ __forceinline__ void operator()(const f32x4 (&acc)[2][2][4][2], const pg8::Unit& u, int wr, int wc, int fr, int fq) const {
        if (u.e == 64) {
#pragma unroll
            for (int ai = 0; ai < 2; ++ai)
#pragma unroll
                for (int m = 0; m < 4; ++m) { const int idx = u.pm * 256 + ai * 128 + wr * 64 + m * 16 + fr; float* o = OUT + (size_t)idx * DM + half * 512 + u.pn * 256 + wc * 32 + 8 * fq;
#pragma unroll
                    for (int bj = 0; bj < 2; ++bj) { *(f32x4*)(o + bj * 128) = acc[ai][bj][m][0]; *(f32x4*)(o + bj * 128 + 4) = acc[ai][bj][m][1]; } }
        } else {
            const int n = (int)cnt[64 * u.e]; int2 dw[2][4];
#pragma unroll
            for (int ai = 0; ai < 2; ++ai)
#pragma unroll
                for (int m = 0; m < 4; ++m) { int idx = u.pm * 256 + ai * 128 + wr * 64 + m * 16 + fr; idx = idx < n ? idx : n - 1; dw[ai][m] = list[(size_t)u.e * NT + idx]; }
#pragma unroll
            for (int ai = 0; ai < 2; ++ai)
#pragma unroll
                for (int m = 0; m < 4; ++m) { const int idx = u.pm * 256 + ai * 128 + wr * 64 + m * 16 + fr;
                    if (idx < n) { const float w = __int_as_float(dw[ai][m].y); bf16* o = YB + (size_t)dw[ai][m].x * 512 + u.pn * 256 + wc * 32 + 8 * fq;
#pragma unroll
                        for (int bj = 0; bj < 2; ++bj) { const f32x4 v0 = acc[ai][bj][m][0] * w, v1 = acc[ai][bj][m][1] * w;
                            u32x4 q; q.x = pg8::cvt_pk_bf16(v0[0], v0[1]); q.y = pg8::cvt_pk_bf16(v0[2], v0[3]); q.z = pg8::cvt_pk_bf16(v1[0], v1[1]); q.w = pg8::cvt_pk_bf16(v1[2], v1[3]);
                            *(u32x4*)(o + bj * 128) = q; } } }
        }
    }
};
__device__ __forceinline__ void phase_combine(Frame& F, int half) {
    const int gw = F.bid * NWAVES + F.wave, NGW = F.G * NWAVES; const bf16* YB = WSP(bf16, WS_YB);
    for (int t = gw; t < NT; t += NGW) {
        float* o = F.out + (size_t)t * DM + half * 512 + 8 * F.lane; f32x4 a = *(const f32x4*)o, c = *(const f32x4*)(o + 4);
#pragma unroll
        for (int k = 0; k < 8; ++k) { float v[8]; unpack8(*(const u32x4*)(YB + ((size_t)t * 8 + k) * 512 + 8 * F.lane), v); a.x += v[0]; a.y += v[1]; a.z += v[2]; a.w += v[3]; c.x += v[4]; c.y += v[5]; c.z += v[6]; c.w += v[7]; }
        *(f32x4*)o = a; *(f32x4*)(o + 4) = c;
    }
}
__device__ __forceinline__ void phase_final(Frame& F) {
    const int gw = F.bid * NWAVES + F.wave, NGW = F.G * NWAVES; const bf16* YB = WSP(bf16, WS_YB);
    for (int t = gw; t < NT; t += NGW) {
        const int b = t / SEQ; const float* mod = WSP(float, WS_MOD) + b * 6144;
        float mv[16]; load_row_f32(F.out + (size_t)t * DM, F.lane, mv);
#pragma unroll
        for (int k = 0; k < 8; ++k) { float v[8]; unpack8(*(const u32x4*)(YB + ((size_t)t * 8 + k) * 512 + 8 * F.lane), v);
#pragma unroll
            for (int i = 0; i < 8; ++i) mv[8 + i] += v[i]; }
        float ss = 0.f;
#pragma unroll
        for (int i = 0; i < 16; ++i) ss += mv[i] * mv[i];
        const float rstd = 1.0f / sqrtf(wave_sum(ss) * (1.f / DM) + EPS);
        float x1[16]; compute_x1(F, t, x1);
        float wv[16], g2[16]; load_row_f32(F.n_ffn_post, F.lane, wv); load_row_f32(mod + 5 * DM, F.lane, g2);
        float o[16];
#pragma unroll
        for (int i = 0; i < 16; ++i) o[i] = x1[i] + g2[i] * (mv[i] * rstd * wv[i]);
        store_row_f32(F.out + (size_t)t * DM, F.lane, o);
    }
}

constexpr int N_PHASES = 16;
__global__ void __launch_bounds__(NTHR, 2) fwd(Args args) {
    extern __shared__ __attribute__((aligned(16))) unsigned char lds_raw[];
    Frame F; F.lds = (LAS unsigned char*)lds_raw; F.tid = threadIdx.x; F.lane = F.tid & 63; F.wave = __builtin_amdgcn_readfirstlane(F.tid >> 6); F.G = gridDim.x; F.bid = blockIdx.x;
    F.x = args.in[0]; F.c = args.in[1]; F.ctx = args.in[2]; F.c_ctx = args.in[3]; F.w_mod = args.in[4]; F.b_mod = args.in[5]; F.n_mix_pre = args.in[6]; F.n_mix_post = args.in[7];
    F.n_ffn_pre = args.in[8]; F.n_ffn_post = args.in[9]; F.w_in = args.in[10]; F.gdn_conv = args.in[11]; F.ret_log_decay = args.in[12]; F.gdn_a_log = args.in[13]; F.gdn_dt_bias = args.in[14];
    F.ret_gn_w = args.in[15]; F.gdn_norm_w = args.in[16]; F.w_ret_out = args.in[17]; F.w_gdn_out = args.in[18]; F.w_o = args.in[19]; F.w_router = args.in[20]; F.router_bias = args.in[21];
    F.w_gate = args.in[22]; F.w_up = args.in[23]; F.w_down = args.in[24]; F.w_sh_gate = args.in[25]; F.w_sh_up = args.in[26]; F.w_sh_down = args.in[27];
    F.out = args.out; F.ws = args.ws; F.ctl = (unsigned*)(args.ws + WS_CTL);
    volatile LAS unsigned* MISC = (volatile LAS unsigned*)(F.lds + MISC_OFF);
    if (F.tid < 64) MISC[F.tid] = 0u;
    __syncthreads();
#if MK_ONE_LAUNCH
    XcdBarrier bar = xcd_barrier_post(F.ctl + CW_BAR, MISC + 8);
#define SEAM() xcd_barrier(bar)
#else
#define SEAM() do {} while (0)
#endif
    const int lo = args.ph_lo, hi = args.ph_hi;
#ifndef PHM
#define PHM 0xffff
#endif
#ifndef DUP
#define DUP -1
#endif
#define IN(k) (((PHM >> (k)) & 1) && lo <= (k) && (k) < hi)
    LAS int* tp = (LAS int*)(F.lds + MISC_OFF + 256);
#ifndef PROBE_PH
#define PROBE_PH -1
#endif
    volatile LAS unsigned long long* tsl = (volatile LAS unsigned long long*)(F.lds + MISC_OFF + 640);
#define STAMP(k) do { if (PROBE_PH >= 0 && F.bid == 0 && F.tid == 0) tsl[k] = __builtin_amdgcn_s_memrealtime(); } while (0)

    STAMP(0);
    if (IN(0)) _Pragma("unroll") for (int rep_ = 0; rep_ < ((DUP == 0) ? 2 : 1); ++rep_) { phase_prologue(F); SEAM(); }
    STAMP(1);
    if (IN(1)) _Pragma("unroll") for (int rep_ = 0; rep_ < ((DUP == 1) ? 2 : 1); ++rep_) { phase_norm1(F); SEAM(); }
    STAMP(2);
    if (IN(2)) _Pragma("unroll") for (int rep_ = 0; rep_ < ((DUP == 2) ? 2 : 1); ++rep_) {
        SchedIn S{(const char*)WSP(bf16, WS_HX), (const char*)WSP(bf16, WS_WIN), F.G, F.bid};
        EpiIn E{WSP(bf16, WS_P), (bf16*)F.out, WSP(float2, WS_ROPE)};
        pg8::gemm_phase<EpiIn, SchedIn, false, SP2>(F.lds, DM, S, E); SEAM();
    }
    STAMP(3);
    if (IN(3)) _Pragma("unroll") for (int rep_ = 0; rep_ < ((DUP == 3) ? 2 : 1); ++rep_) { phase_prep(F); SEAM(); }
    STAMP(4);
    if (IN(4)) _Pragma("unroll") for (int rep_ = 0; rep_ < ((DUP == 4) ? 2 : 1); ++rep_) { phase_scan(F); SEAM(); }
    STAMP(5);
    if (IN(5)) _Pragma("unroll") for (int rep_ = 0; rep_ < ((DUP == 5) ? 2 : 1); ++rep_) { phase_out(F); SEAM(); }
    STAMP(6);
    if (IN(6)) _Pragma("unroll") for (int rep_ = 0; rep_ < ((DUP == 6) ? 2 : 1); ++rep_) {
        SchedMerge S{(const char*)WSP(bf16, WS_RETY), (const char*)WSP(bf16, WS_GDNY), (const char*)WSP(bf16, WS_WRO), (const char*)WSP(bf16, WS_WGO), F.G, F.bid};
        EpiMerge E{(const bf16*)F.out, WSP(bf16, WS_TMP), WSP(bf16, WS_MERGED)};
        pg8::gemm_phase<EpiMerge, SchedMerge, false, SP2>(F.lds, 512, S, E);
        if (rep_ == 0) { _Pragma("unroll") for (int r2_ = 0; r2_ < ((DUP == 16) ? 2 : 1); ++r2_) phase_moe_weights(F); }
        SEAM();
    }
    STAMP(7);
    if (IN(7)) _Pragma("unroll") for (int rep_ = 0; rep_ < ((DUP == 7) ? 2 : 1); ++rep_) {
        SchedDense S{(const char*)WSP(bf16, WS_MERGED), (const char*)WSP(bf16, WS_WO), 64, 4, DM, F.G, F.bid};
        EpiBf16Store E{WSP(bf16, WS_MO), DM};
        pg8::gemm_phase<EpiBf16Store, SchedDense, false, SP2>(F.lds, DM, S, E); SEAM();
    }
    STAMP(8);
    if (IN(8)) _Pragma("unroll") for (int rep_ = 0; rep_ < ((DUP == 8) ? 2 : 1); ++rep_) { if (rep_ == 1) { if (F.bid == 0 && F.tid < 64) F.ctl[CW_CNT + 64 * F.tid] = 0u; SEAM(); } phase_route(F); SEAM(); }
    STAMP(9);
    if (IN(9)) _Pragma("unroll") for (int rep_ = 0; rep_ < ((DUP == 9) ? 2 : 1); ++rep_) {
        build_tile_prefix(F, tp);
        SchedMoe S{(const char*)WSP(bf16, WS_H2), (const char*)WSP(bf16, WS_WGU), WSP(int2, WS_LIST), F.ctl + CW_CNT, tp, 2, DM, F.G, F.bid, (size_t)512 * DM * 2, 0, true};
        EpiUp E{WSP(bf16, WS_HMID)};
        pg8::gemm_phase<EpiUp, SchedMoe, true, SP2>(F.lds, DM, S, E); SEAM();
    }
    STAMP(10);
    if (IN(10)) _Pragma("unroll") for (int rep_ = 0; rep_ < ((DUP == 10) ? 2 : 1); ++rep_) {
        build_tile_prefix(F, tp);
        SchedMoe S{(const char*)WSP(bf16, WS_HMID), (const char*)WSP(bf16, WS_WD), WSP(int2, WS_LIST), F.ctl + CW_CNT, tp, 2, DEXP, F.G, F.bid, (size_t)DM * DEXP * 2, 0, false};
        EpiDown E{WSP(bf16, WS_YB), F.out, WSP(int2, WS_LIST), F.ctl + CW_CNT, 0};
        pg8::gemm_phase<EpiDown, SchedMoe, false, SP2>(F.lds, DEXP, S, E); SEAM();
    }
    STAMP(11);
    if (IN(11)) _Pragma("unroll") for (int rep_ = 0; rep_ < ((DUP == 11) ? 2 : 1); ++rep_) { phase_combine(F, 0); SEAM(); }
    STAMP(12);
    if (IN(12)) _Pragma("unroll") for (int rep_ = 0; rep_ < ((DUP == 12) ? 2 : 1); ++rep_) {
        build_tile_prefix(F, tp);
        SchedMoe S{(const char*)WSP(bf16, WS_HMID), (const char*)WSP(bf16, WS_WD), WSP(int2, WS_LIST), F.ctl + CW_CNT, tp, 2, DEXP, F.G, F.bid, (size_t)DM * DEXP * 2, 512, false};
        EpiDown E{WSP(bf16, WS_YB), F.out, WSP(int2, WS_LIST), F.ctl + CW_CNT, 1};
        pg8::gemm_phase<EpiDown, SchedMoe, false, SP2>(F.lds, DEXP, S, E); SEAM();
    }
    STAMP(13);
    if (IN(13)) _Pragma("unroll") for (int rep_ = 0; rep_ < ((DUP == 13) ? 2 : 1); ++rep_) { phase_final(F); }
    STAMP(14);
    if (PROBE_PH >= 0 && F.bid == 0) { __syncthreads(); if (F.tid == 0) { const unsigned long long d = tsl[PROBE_PH + 1] - tsl[PROBE_PH]; float a = 1.0f + 0.2f * floorf((float)d * 0.001f); a = a > 30.f ? 30.f : a;
            asm volatile("s_waitcnt vmcnt(0)" ::: "memory"); F.out[0] += a; } }
#undef IN
}

extern "C" void kernel_launch(void* const* d_in, const int* in_sizes, int n_in, void* d_out, int out_size, void* d_ws, size_t ws_size, hipStream_t stream) {
    static int grid = 0;
    if (grid == 0) {
        if (n_in != 28 || in_sizes[0] != NT * DM || out_size != NT * DM || ws_size < WS_END) { fprintf(stderr, "kernel_launch: unexpected shapes / workspace (%d inputs, ws %zu)\n", n_in, ws_size); grid = -1; return; }
        int dev = 0, cus = 0;
        if (hipGetDevice(&dev) != hipSuccess || hipDeviceGetAttribute(&cus, hipDeviceAttributeMultiprocessorCount, dev) != hipSuccess) { grid = -1; return; }
        if (hipFuncSetAttribute((const void*)fwd, hipFuncAttributeMaxDynamicSharedMemorySize, LDS_BYTES) != hipSuccess) { fprintf(stderr, "kernel_launch: hipFuncSetAttribute failed\n"); grid = -1; return; }
        int per_cu = 0; (void)hipOccupancyMaxActiveBlocksPerMultiprocessor(&per_cu, (const void*)fwd, NTHR, LDS_BYTES); (void)hipGetLastError();
        if (per_cu < 1) fprintf(stderr, "kernel_launch: occupancy query says %d\n", per_cu);
        grid = cus;
    }
    if (grid < 0) return;
    (void)hipMemsetAsync((char*)d_ws + WS_CTL, 0, CTL_BYTES, stream);
    Args a{};
    for (int i = 0; i < 28; ++i) a.in[i] = (const float*)d_in[i];
    a.out = (float*)d_out; a.ws = (unsigned char*)d_ws;
#if MK_ONE_LAUNCH
    a.ph_lo = 0; a.ph_hi = N_PHASES;
    hipLaunchKernelGGL(fwd, dim3(grid), dim3(NTHR), LDS_BYTES, stream, a);
#else
    for (int p = 0; p < 14; ++p) { a.ph_lo = p; a.ph_hi = p + 1; hipLaunchKernelGGL(fwd, dim3(grid), dim3(NTHR), LDS_BYTES, stream, a); }
#endif
}
```

```cpp
#include <hip/hip_runtime.h>
#include <cstdio>
#include <cstdint>

#ifndef MK_ONE_LAUNCH
#define MK_ONE_LAUNCH 1
#endif
#ifndef MK_REF_GEMM
#define MK_REF_GEMM 0
#endif

constexpr int NB = 4, SEQ = 4096, DM = 1024, CTXL = 256, RPB = SEQ + CTXL  , NROW = NB * RPB  , NT = NB * SEQ  ;
constexpr int NH = 4, HD = 128, CH = 128, NCHUNK = RPB / CH  ;
constexpr int N_STATE = 2064, N_IN = 6160, NEXP = 64, TOPK = 8, DEXP = 256;
constexpr float EPS = 1e-6f;
constexpr int NPCOL = 4096;
constexpr int SLOT_SH = 147456;
constexpr int NSLOT = SLOT_SH + NT;

constexpr size_t MiB = 1u << 20;
constexpr size_t WS_CTL = 0, CTL_BYTES = 1 * MiB;
constexpr size_t WS_MOD = 1 * MiB;
constexpr size_t WS_ROPE = 2 * MiB;
constexpr size_t WS_LOGA = 4 * MiB;
constexpr size_t WS_BETA = 5 * MiB;
constexpr size_t WS_WRO = 6 * MiB, WS_WGO = 7 * MiB, WS_WO = 8 * MiB;
constexpr size_t WS_P = 10 * MiB;
constexpr size_t PGRP = (size_t)NROW * 512;
constexpr size_t WS_CH = 146 * MiB;
constexpr size_t WS_WIN = WS_CH;
constexpr size_t WS_HX = WS_CH + 12 * MiB;
constexpr size_t WS_GM = WS_CH;
constexpr size_t WS_GC = WS_CH + 34 * MiB;
constexpr size_t WS_GKV = WS_CH + 68 * MiB;
constexpr size_t WS_GQT = WS_CH + 102 * MiB;
constexpr size_t WS_OGDN = WS_CH + 134 * MiB;
constexpr size_t WS_ORET = WS_CH + 150 * MiB;
constexpr size_t WS_RETY = WS_P, WS_GDNY = WS_P + 17 * MiB;
constexpr size_t WS_H2 = 10 * MiB;
constexpr size_t WS_WGU = 73 * MiB;
constexpr size_t WS_YB = 10 * MiB;
constexpr size_t WS_WD = 138 * MiB;
constexpr size_t WS_HMID = 171 * MiB;
constexpr size_t WS_TMP = 171 * MiB, WS_MERGED = 203 * MiB;
constexpr size_t WS_MO = 251 * MiB;
constexpr size_t WS_LIST = 283 * MiB;
constexpr size_t WS_END = 312 * MiB;

constexpr int CW_BAR = 1024;
constexpr int CW_CNT = 8192;
constexpr int CW_FLAG = 12288;

#define GAS __attribute__((address_space(1)))
#define LAS __attribute__((address_space(3)))
typedef unsigned short bf16;
typedef float f32x4 __attribute__((ext_vector_type(4)));
typedef float f32x2 __attribute__((ext_vector_type(2)));
typedef short bf16x8 __attribute__((ext_vector_type(8)));
typedef unsigned u32x4 __attribute__((ext_vector_type(4)));
typedef unsigned u32x2 __attribute__((ext_vector_type(2)));
__device__ __forceinline__ unsigned f2bf(float f) { unsigned u = __builtin_bit_cast(unsigned, f); return (u + 0x7fffu + ((u >> 16) & 1u)) >> 16; }
__device__ __forceinline__ unsigned pk2(float lo, float hi) { return f2bf(lo) | (f2bf(hi) << 16); }
__device__ __forceinline__ float bf2f(unsigned b) { return __builtin_bit_cast(float, b << 16); }
__device__ __forceinline__ float bflo(unsigned w) { return __builtin_bit_cast(float, w << 16); }
__device__ __forceinline__ float bfhi(unsigned w) { return __builtin_bit_cast(float, w & 0xffff0000u); }
__device__ __forceinline__ float sigmoidf_(float x) { return 1.f / (1.f + __expf(-x)); }
__device__ __forceinline__ float siluf_(float x) { return x / (1.f + __expf(-x)); }
__device__ __forceinline__ float wave_sum(float v) {
#pragma unroll
    for (int o = 1; o < 64; o <<= 1) v += __shfl_xor(v, o);
    return v;
}
__device__ __forceinline__ float sum16(float v) {
#pragma unroll
    for (int o = 1; o < 16; o <<= 1) v += __shfl_xor(v, o);
    return v;
}
__device__ __forceinline__ void unpack8(const u32x4 w, float (&o)[8]) {
    o[0] = bflo(w.x); o[1] = bfhi(w.x); o[2] = bflo(w.y); o[3] = bfhi(w.y); o[4] = bflo(w.z); o[5] = bfhi(w.z); o[6] = bflo(w.w); o[7] = bfhi(w.w);
}
__device__ __forceinline__ u32x4 pack8(const float (&v)[8]) { u32x4 w; w.x = pk2(v[0], v[1]); w.y = pk2(v[2], v[3]); w.z = pk2(v[4], v[5]); w.w = pk2(v[6], v[7]); return w; }

namespace pg8 {
constexpr int BM = 256, BK = 64, HALF = 128, HTB = HALF * BK * 2, STAGE_BYTES = 8 * HTB;
__host__ __device__ __forceinline__ int lds_byte(int r, int c) { const int st = (r >> 4) * 2 + (c >> 5), rr = r & 15, cc = c & 31, ob = rr * 64 + cc * 2; return st * 1024 + (ob ^ (((ob >> 9) & 1) << 5)); }
__host__ __device__ __forceinline__ void stage_rc(int b, int& R, int& C) { const int st = b / 1024, sb = b % 1024, swz = sb ^ (((sb >> 9) & 1) << 5); R = (st >> 1) * 16 + swz / 64; C = (st & 1) * 32 + (swz % 64) / 2; }
__host__ __device__ __forceinline__ int perm32(int rho) { const int n = rho >> 4, i = rho & 15; return 8 * (i >> 2) + 4 * n + (i & 3); }
__device__ __forceinline__ unsigned cvt_pk_bf16(float lo, float hi) { unsigned r; asm volatile("v_cvt_pk_bf16_f32 %0, %1, %2" : "=v"(r) : "v"(lo), "v"(hi)); return r; }

struct Unit { const char* A; const char* B; int pm, pn, e, base; };

template <class Epi, class Sched, bool GATHER, bool SP2>
__device__ __forceinline__ void gemm_phase(LAS unsigned char* lds, const int K, const Sched& S, const Epi& E) {
#if MK_REF_GEMM
    {
        const int tid = threadIdx.x, wid = tid >> 6, lane = tid & 63, wr = wid >> 2, wc = wid & 3, fr = lane & 15, fq = lane >> 4;
        Unit cur;
        for (int ui = 0; S.next(ui, cur); ++ui) {
            f32x4 acc[2][2][4][2];
            for (int ai = 0; ai < 2; ++ai) for (int m = 0; m < 4; ++m) {
                const int r = 128 * ai + 64 * wr + 16 * m + fr;
                const bf16* arow = GATHER ? (const bf16*)cur.A + (size_t)S.row_index(cur, r) * K : (const bf16*)cur.A + (size_t)r * K;
                for (int bj = 0; bj < 2; ++bj) for (int n = 0; n < 2; ++n) {
                    f32x4 a4 = {0.f, 0.f, 0.f, 0.f};
                    for (int i = 0; i < 4; ++i) { const int c = 128 * bj + 32 * wc + 8 * fq + 4 * n + i; const bf16* brow = (const bf16*)cur.B + (size_t)c * K;
                        float s = 0.f; for (int k = 0; k < K; ++k) s += bf2f(arow[k]) * bf2f(brow[k]); a4[i] = s; }
                    acc[ai][bj][m][n] = a4; } }
            E(acc, cur, wr, wc, fr, fq);
        }
        return;
    }
#else
    const int tid = threadIdx.x, wid = __builtin_amdgcn_readfirstlane(tid >> 6), lane = tid & 63, wr = wid >> 2, wc = wid & 3, fr = lane & 15, fq = lane >> 4;
    const int nt = K / BK;
    unsigned voffA[2], voffB[2]; int gR = 0, gC = 0;
#pragma unroll
    for (int i = 0; i < 2; ++i) { int R, C; stage_rc(tid * 16 + i * 8192, R, C); const int Rb = (R & ~31) + perm32(R & 31);
        voffA[i] = (unsigned)(R * K + C) * 2u; voffB[i] = (unsigned)(Rb * K + C) * 2u; if (i == 0) { gR = R; gC = C; } }
    const size_t kstep = (size_t)(BK * 2);
    const size_t hstep = (size_t)HALF * K * 2;
    const unsigned ldsw = (unsigned)wid * 1024u;
    const int aoff = lds_byte(wr * 64 + fr, fq * 8), boff = lds_byte(wc * 32 + fr, fq * 8);
#define PG8_SA(b, h) (((b) * 2 + (h)) * HTB)
#define PG8_SB(b, h) ((4 + (b) * 2 + (h)) * HTB)
#define PG8_STAGE(bufoff, gbase, voff) do { _Pragma("unroll") for (int _i = 0; _i < 2; ++_i) \
        __builtin_amdgcn_global_load_lds((const unsigned*)((const char*)(gbase) + (voff)[_i]), (LAS unsigned*)(lds + (bufoff) + ldsw + _i * 8192), 16, 0, 0); } while (0)
#define PG8_STAGE_A(bufoff, gbase, h, G) do { if constexpr (GATHER) { PG8_STAGE(bufoff, gbase, (G)[h]); } else { PG8_STAGE(bufoff, (gbase) + (h) * hstep, voffA); } } while (0)
#define PG8_LDA(dst, b, h) do { _Pragma("unroll") for (int m = 0; m < 4; ++m) _Pragma("unroll") for (int k = 0; k < 2; ++k) dst[m][k] = *(const LAS bf16x8*)(lds + PG8_SA(b, h) + aoff + m * 2048 + k * 1024); } while (0)
#define PG8_LDB(dst, b, h) do { _Pragma("unroll") for (int n = 0; n < 2; ++n) _Pragma("unroll") for (int k = 0; k < 2; ++k) dst[n][k] = *(const LAS bf16x8*)(lds + PG8_SB(b, h) + boff + n * 2048 + k * 1024); } while (0)
#define PG8_MMA(ai, bj, At, Bt) do { __builtin_amdgcn_s_setprio(1); _Pragma("unroll") for (int m = 0; m < 4; ++m) _Pragma("unroll") for (int n = 0; n < 2; ++n) _Pragma("unroll") for (int k = 0; k < 2; ++k) \
        acc[ai][bj][m][n] = __builtin_amdgcn_mfma_f32_16x16x32_bf16(Bt[n][k], At[m][k], acc[ai][bj][m][n], 0, 0, 0); __builtin_amdgcn_s_setprio(0); } while (0)
#define PG8_WAIT_V(n) asm volatile("s_waitcnt vmcnt(" #n ")" ::: "memory")
#define PG8_WAIT_L(n) asm volatile("s_waitcnt lgkmcnt(" #n ")" ::: "memory")
#define PG8_BAR __builtin_amdgcn_s_barrier()
#define PG8_SCHED __builtin_amdgcn_sched_barrier(0)
    Unit cur, nxt; int ui = 0;
    if (!S.next(0, cur)) return;
    f32x4 acc[2][2][4][2];
#pragma unroll
    for (int a = 0; a < 2; ++a)
#pragma unroll
        for (int b = 0; b < 2; ++b)
#pragma unroll
            for (int m = 0; m < 4; ++m)
#pragma unroll
                for (int n = 0; n < 2; ++n) acc[a][b][m][n] = (f32x4){0.f, 0.f, 0.f, 0.f};
    bf16x8 At[4][2], B0[2][2], B1[2][2];
    const char* cA = cur.A; const char* cB = cur.B;
    unsigned cG[2][2] = {{0u, 0u}, {0u, 0u}}, nG[2][2] = {{0u, 0u}, {0u, 0u}};
    if constexpr (GATHER) {
#pragma unroll
        for (int h = 0; h < 2; ++h)
#pragma unroll
            for (int i = 0; i < 2; ++i) cG[h][i] = ((unsigned)S.row_index(cur, 128 * h + gR + 64 * i) * (unsigned)K + (unsigned)gC) * 2u;
    }
    if constexpr (SP2) {
        PG8_STAGE(PG8_SB(0, 0), cB, voffB); PG8_STAGE(PG8_SB(0, 1), cB + hstep, voffB); PG8_STAGE_A(PG8_SA(0, 0), cA, 0, cG); PG8_STAGE_A(PG8_SA(0, 1), cA, 1, cG);
        if (wr == 1) PG8_BAR;
        PG8_WAIT_V(2); PG8_BAR;
        PG8_STAGE(PG8_SB(1, 0), cB + kstep, voffB); PG8_STAGE_A(PG8_SA(1, 0), cA + kstep, 0, cG); PG8_STAGE(PG8_SB(1, 1), cB + hstep + kstep, voffB);
        PG8_WAIT_V(6); PG8_BAR;
    } else {
        PG8_STAGE(PG8_SB(0, 0), cB, voffB); PG8_STAGE_A(PG8_SA(0, 0), cA, 0, cG); PG8_STAGE(PG8_SB(0, 1), cB + hstep, voffB); PG8_STAGE_A(PG8_SA(0, 1), cA, 1, cG);
        if (wr == 1) PG8_BAR;
        PG8_WAIT_V(4); PG8_BAR;
        PG8_STAGE(PG8_SB(1, 0), cB + kstep, voffB); PG8_STAGE_A(PG8_SA(1, 0), cA + kstep, 0, cG); PG8_STAGE(PG8_SB(1, 1), cB + hstep + kstep, voffB);
        PG8_WAIT_V(6); PG8_BAR;
    }
    for (;;) {
        const bool has_next = S.next(ui + 1, nxt);
        const char* nA = has_next ? nxt.A : cA; const char* nB = has_next ? nxt.B : cB;
        for (int t = 0; t < nt; t += 2) {
            const bool last = (t == nt - 2);
            const char* a1 = cA + (size_t)(t + 1) * kstep;
            const char* a2 = last ? nA : cA + (size_t)(t + 2) * kstep; const char* b2 = last ? nB : cB + (size_t)(t + 2) * kstep;
            const char* a3 = a2 + kstep; const char* b3 = b2 + kstep;
            unsigned g2[2][2] = {{0u, 0u}, {0u, 0u}};
            if constexpr (GATHER) {
                if (last) {
                    if (has_next) {
#pragma unroll
                        for (int h = 0; h < 2; ++h)
#pragma unroll
                            for (int i = 0; i < 2; ++i) nG[h][i] = ((unsigned)S.row_index(nxt, 128 * h + gR + 64 * i) * (unsigned)K + (unsigned)gC) * 2u;
                    } else {
#pragma unroll
                        for (int h = 0; h < 2; ++h)
#pragma unroll
                            for (int i = 0; i < 2; ++i) nG[h][i] = cG[h][i];
                    }
                }
#pragma unroll
                for (int h = 0; h < 2; ++h)
#pragma unroll
                    for (int i = 0; i < 2; ++i) g2[h][i] = last ? nG[h][i] : cG[h][i];
            }
            if constexpr (SP2) {
            PG8_LDB(B0, 0, 0); PG8_LDB(B1, 0, 1); PG8_SCHED; PG8_LDA(At, 0, 0); PG8_STAGE_A(PG8_SA(1, 1), a1, 1, cG);
            PG8_WAIT_V(8); PG8_WAIT_L(0); PG8_BAR; PG8_MMA(0, 0, At, B0); PG8_MMA(0, 1, At, B1); PG8_BAR; PG8_SCHED;
            PG8_LDA(At, 0, 1); PG8_STAGE(PG8_SB(0, 0), b2, voffB); PG8_STAGE(PG8_SB(0, 1), b2 + hstep, voffB); PG8_STAGE_A(PG8_SA(0, 0), a2, 0, g2);
            PG8_WAIT_V(8); PG8_WAIT_L(0); PG8_BAR; PG8_MMA(1, 0, At, B0); PG8_MMA(1, 1, At, B1); PG8_BAR; PG8_SCHED;
            PG8_LDB(B0, 1, 0); PG8_LDB(B1, 1, 1); PG8_SCHED; PG8_LDA(At, 1, 0); PG8_STAGE_A(PG8_SA(0, 1), a2, 1, g2);
            PG8_WAIT_V(8); PG8_WAIT_L(0); PG8_BAR; PG8_MMA(0, 0, At, B0); PG8_MMA(0, 1, At, B1); PG8_BAR; PG8_SCHED;
            PG8_LDA(At, 1, 1); PG8_STAGE(PG8_SB(1, 0), b3, voffB); PG8_STAGE(PG8_SB(1, 1), b3 + hstep, voffB); PG8_STAGE_A(PG8_SA(1, 0), a3, 0, g2);
            PG8_WAIT_V(8); PG8_WAIT_L(0); PG8_BAR; PG8_MMA(1, 0, At, B0); PG8_MMA(1, 1, At, B1); PG8_BAR; PG8_SCHED;
            } else {
            PG8_LDB(B0, 0, 0); PG8_SCHED; PG8_LDA(At, 0, 0); PG8_STAGE_A(PG8_SA(1, 1), a1, 1, cG);
            PG8_WAIT_L(8); PG8_BAR; PG8_WAIT_L(0); PG8_MMA(0, 0, At, B0); PG8_BAR; PG8_SCHED;
            PG8_LDB(B1, 0, 1); PG8_STAGE(PG8_SB(0, 0), b2, voffB);
            PG8_BAR; PG8_WAIT_L(0); PG8_MMA(0, 1, At, B1); PG8_BAR;
            PG8_LDA(At, 0, 1); PG8_STAGE_A(PG8_SA(0, 0), a2, 0, g2);
            PG8_BAR; PG8_WAIT_L(0); PG8_MMA(1, 0, At, B0); PG8_BAR; PG8_SCHED;
            PG8_STAGE(PG8_SB(0, 1), b2 + hstep, voffB);
            PG8_WAIT_V(6); PG8_BAR; PG8_MMA(1, 1, At, B1); PG8_BAR;
            PG8_LDB(B0, 1, 0); PG8_SCHED; PG8_LDA(At, 1, 0); PG8_STAGE_A(PG8_SA(0, 1), a2, 1, g2);
            PG8_WAIT_L(8); PG8_BAR; PG8_WAIT_L(0); PG8_MMA(0, 0, At, B0); PG8_BAR; PG8_SCHED;
            PG8_LDB(B1, 1, 1); PG8_STAGE(PG8_SB(1, 0), b3, voffB);
            PG8_BAR; PG8_WAIT_L(0); PG8_MMA(0, 1, At, B1); PG8_BAR;
            PG8_LDA(At, 1, 1); PG8_STAGE_A(PG8_SA(1, 0), a3, 0, g2);
            PG8_BAR; PG8_WAIT_L(0); PG8_MMA(1, 0, At, B0); PG8_BAR; PG8_SCHED;
            PG8_STAGE(PG8_SB(1, 1), b3 + hstep, voffB);
            PG8_WAIT_V(6); PG8_BAR; PG8_MMA(1, 1, At, B1); PG8_BAR;
            }
        }
        if (wr == 0) PG8_BAR;
        { int tz = threadIdx.x; asm volatile("" : "+v"(tz)); const int wid_ = __builtin_amdgcn_readfirstlane(tz >> 6), lane_ = tz & 63;
          E(acc, cur, wid_ >> 2, wid_ & 3, lane_ & 15, lane_ >> 4); }
        if (!has_next) break;
#pragma unroll
        for (int a = 0; a < 2; ++a)
#pragma unroll
            for (int b = 0; b < 2; ++b)
#pragma unroll
                for (int m = 0; m < 4; ++m)
#pragma unroll
                    for (int n = 0; n < 2; ++n) acc[a][b][m][n] = (f32x4){0.f, 0.f, 0.f, 0.f};
        cur = nxt; cA = nA; cB = nB; ++ui;
        if constexpr (GATHER) {
#pragma unroll
            for (int h = 0; h < 2; ++h)
#pragma unroll
                for (int i = 0; i < 2; ++i) cG[h][i] = nG[h][i];
        }
        if (wr == 1) PG8_BAR;
    }
    PG8_WAIT_V(0);
    PG8_BAR;
#undef PG8_SA
#undef PG8_SB
#undef PG8_STAGE
#undef PG8_STAGE_A
#undef PG8_LDA
#undef PG8_LDB
#undef PG8_MMA
#undef PG8_WAIT_V
#undef PG8_WAIT_L
#undef PG8_BAR
#undef PG8_SCHED
#endif
}
}
constexpr bool SP2 = true;

#define XB_TMO      128
#define XB_XCNT(j)  (256  + 64 * (j))
#define XB_XSUB(j)  (1280 + 64 * (j))
#define XB_XGEN(j)  (2304 + 64 * (j))
#define XB_TOP      3328
#define XB_TOPGEN   3392
#define XCD_BAR_WORDS 3456
#define XB_SPIN_CAP (1u << 18)
__device__ __forceinline__ unsigned xb_ld(unsigned* p)              { return __hip_atomic_load(p, __ATOMIC_RELAXED, __HIP_MEMORY_SCOPE_AGENT); }
__device__ __forceinline__ unsigned xb_add(unsigned* p, unsigned v) { return __hip_atomic_fetch_add(p, v, __ATOMIC_RELAXED, __HIP_MEMORY_SCOPE_AGENT); }
__device__ __forceinline__ unsigned xb_xcc_id() { return (unsigned)__builtin_amdgcn_s_getreg((3 << 11) | 20) & 0xFu; }
#define XB_SPIN(cond, bar) do { unsigned _sp = 0; while (cond) { __builtin_amdgcn_s_sleep(1); \
    if ((++_sp & 255u) == 0u) { if (xb_ld(&(bar)[XB_TMO])) break; if (_sp > XB_SPIN_CAP) { atomicAdd(&(bar)[XB_TMO], 1u); break; } } } } while (0)
struct XcdBarrier { unsigned* bar; unsigned x; volatile LAS unsigned* st; };
__device__ __forceinline__ XcdBarrier xcd_barrier_post(unsigned* bar, volatile LAS unsigned* st) {
    XcdBarrier b; b.bar = bar; b.x = xb_xcc_id(); b.st = st;
    if (threadIdx.x == 0) (void)xb_add(&bar[XB_XCNT(b.x)], 1u);
    return b;
}
__device__ __forceinline__ void xcd_barrier_complete(unsigned* bar, unsigned x, unsigned& nloc, unsigned& nx) {
    const unsigned G = gridDim.x * gridDim.y * gridDim.z;
    unsigned sum, cnt, mine, sp = 0u;
    for (;;) {
        sum = 0u; cnt = 0u; mine = 0u;
#pragma unroll
        for (unsigned j = 0; j < 16; ++j) { const unsigned c = xb_ld(&bar[XB_XCNT(j)]); sum += c; cnt += (c > 0u) ? 1u : 0u; mine = (j == x) ? c : mine; }
        if (sum == G) break;
        __builtin_amdgcn_s_sleep(1);
        if ((++sp & 255u) == 0u) { if (xb_ld(&bar[XB_TMO])) break; if (sp > XB_SPIN_CAP) { atomicAdd(&bar[XB_TMO], 1u); break; } }
    }
    nloc = mine > 0u ? mine : 1u; nx = cnt > 0u ? cnt : 1u;
}
__device__ __forceinline__ void xcd_barrier(const XcdBarrier& b) {
    asm volatile("s_waitcnt vmcnt(0)" ::: "memory");
    __syncthreads();
    if (threadIdx.x == 0) {
        unsigned* bar = b.bar;
        __builtin_amdgcn_s_waitcnt(0);
        unsigned nloc = b.st[0], nx = b.st[1];
        if (nloc == 0u) { xcd_barrier_complete(bar, b.x, nloc, nx); b.st[0] = nloc; b.st[1] = nx; }
        const unsigned old = xb_add(&bar[XB_XSUB(b.x)], 1u);
        const unsigned gen = old / nloc;
        if (old + 1u == (gen + 1u) * nloc) {
            __builtin_amdgcn_fence(__ATOMIC_RELEASE, "agent");
            asm volatile("s_waitcnt vmcnt(0)" ::: "memory");
            const unsigned og = xb_add(&bar[XB_TOP], 1u);
            const unsigned tg = og / nx;
            if (og + 1u == (tg + 1u) * nx) xb_add(&bar[XB_TOPGEN], 1u);
            else XB_SPIN(xb_ld(&bar[XB_TOPGEN]) == tg, bar);
            __builtin_amdgcn_fence(__ATOMIC_ACQUIRE, "agent");
            xb_add(&bar[XB_XGEN(b.x)], 1u);
            asm volatile("s_waitcnt vmcnt(0)" ::: "memory");
        } else {
            XB_SPIN(xb_ld(&bar[XB_XGEN(b.x)]) == gen, bar);
            __builtin_amdgcn_fence(__ATOMIC_ACQUIRE, "agent");
            asm volatile("s_waitcnt vmcnt(0)" ::: "memory");
        }
    }
    __syncthreads();
}

constexpr int NWAVES = 8, NTHR = 512;
constexpr int RING_BYTES = 131072, MISC_OFF = 139264, LDS_BYTES = 147456;
struct Args {
    const float* in[28]; float* out; unsigned char* ws; int ph_lo, ph_hi;
};
struct Frame {
    LAS unsigned char* lds; int tid, lane, wave, G, bid;
    const float *x, *c, *ctx, *c_ctx, *w_mod, *b_mod, *n_mix_pre, *n_mix_post, *n_ffn_pre, *n_ffn_post, *w_in, *gdn_conv, *ret_log_decay, *gdn_a_log, *gdn_dt_bias,
        *ret_gn_w, *gdn_norm_w, *w_ret_out, *w_gdn_out, *w_o, *w_router, *router_bias, *w_gate, *w_up, *w_down, *w_sh_gate, *w_sh_up, *w_sh_down;
    float* out; unsigned char* ws; unsigned* ctl;
};
#define WSP(T, off) ((T*)(F.ws + (off)))

template <class CM>
__device__ __forceinline__ void transpose_item(const float* W, int ld, int K, bf16* WT, LAS float* scr, int kb, int nb, int lane, const CM& cm) {
    const int k0 = 64 * kb, n0 = 32 * nb; const int sc = cm(n0 + (lane & 31));
    float tv[32];
#pragma unroll
    for (int i = 0; i < 32; ++i) tv[i] = W[(size_t)(k0 + 2 * i + (lane >> 5)) * ld + sc];
#pragma unroll
    for (int i = 0; i < 32; ++i) scr[(2 * i + (lane >> 5)) * 33 + (lane & 31)] = tv[i];
    asm volatile("s_waitcnt lgkmcnt(0)" ::: "memory");
    const int c = lane & 7;
#pragma unroll
    for (int j = 0; j < 4; ++j) { const int n = (lane >> 3) + 8 * j; const LAS float* s = scr + (8 * c) * 33 + n;
        u32x4 o; o.x = pk2(s[0 * 33], s[1 * 33]); o.y = pk2(s[2 * 33], s[3 * 33]); o.z = pk2(s[4 * 33], s[5 * 33]); o.w = pk2(s[6 * 33], s[7 * 33]);
        *(u32x4*)(WT + (size_t)(n0 + n) * K + k0 + 8 * c) = o; }
    asm volatile("s_waitcnt lgkmcnt(0)" ::: "memory");
}
struct CmIdent { int off; __device__ __forceinline__ int operator()(int n) const { return n + off; } };
struct CmWin {
    __device__ __forceinline__ int operator()(int n) const {
        const int g = n >> 9; int src = n + (n >= 2048 ? 16 : 0);
        if (g == 0 || g == 4) { const int hb = n & ~127, cp = n & 127; const int wc = cp >> 5, fq = (cp >> 3) & 3, nn = (cp >> 2) & 1, i = cp & 3;
            const int d = 64 * nn + 16 * wc + 4 * fq + i; src = hb + d + (n >= 2048 ? 16 : 0); }
        return src; }
};
__device__ __forceinline__ void gu_decode(int cp, int& hid, int& isup) { const int pn = cp >> 8, r = cp & 255, bj = r >> 7, wc = (r >> 5) & 3, fq = (r >> 3) & 3, nn = (r >> 2) & 1, i = r & 3; hid = pn * 128 + bj * 64 + wc * 16 + fq * 4 + i; isup = nn; }

__device__ __forceinline__ void phase_prologue(Frame& F) {
    const int gw = F.bid * NWAVES + F.wave, NGW = F.G * NWAVES; const int gt = F.bid * NTHR + F.tid, NGT = F.G * NTHR;
    LAS float* scr = (LAS float*)(F.lds + F.wave * 16384);
    { float2* rt = WSP(float2, WS_ROPE);
      for (int idx = gt; idx < SEQ * 64; idx += NGT) { const int t = idx >> 6, j = idx & 63; const float pos = (float)(j < 32 ? (t >> 6) : (t & 63)); const int f = j & 31;
          const float inv = powf(10000.0f, -(float)f / 32.0f); const float ang = pos * inv; float sn, cs; sincosf(ang, &sn, &cs); rt[idx] = make_float2(cs, sn); } }
    {
        LAS float* red = (LAS float*)(F.lds);
        for (int it = F.bid; it < 96; it += F.G) {
            const int col = it * 64 + F.lane; float a[5] = {0.f, 0.f, 0.f, 0.f, 0.f};
            const int kb = F.wave * 128;
#pragma unroll 4
            for (int k = kb; k < kb + 128; ++k) { const float w = F.w_mod[(size_t)k * 6144 + col];
#pragma unroll
                for (int r = 0; r < 5; ++r) { const float cv = r < 4 ? F.c[r * DM + k] : F.c_ctx[k]; a[r] += siluf_(cv) * w; } }
#pragma unroll
            for (int r = 0; r < 5; ++r) red[(F.wave * 5 + r) * 64 + F.lane] = a[r];
            __syncthreads();
            if (F.wave < 5) { float s = F.b_mod[col];
#pragma unroll
                for (int w = 0; w < 8; ++w) s += red[(w * 5 + F.wave) * 64 + F.lane];
                WSP(float, WS_MOD)[F.wave * 6144 + col] = s; }
            __syncthreads();
        }
    }
    {
        constexpr int I_IN = 16 * 192, I_RO = 8 * 32, I_O = 16 * 32; constexpr int NIT = I_IN + 2 * I_RO + I_O;
        for (int it = gw; it < NIT; it += NGW) { int r = it;
            if (r < I_IN) { transpose_item(F.w_in, N_IN, DM, WSP(bf16, WS_WIN), scr, r / 192, r % 192, F.lane, CmWin{}); continue; } r -= I_IN;
            if (r < I_RO) { transpose_item(F.w_ret_out, DM, 512, WSP(bf16, WS_WRO), scr, r / 32, r % 32, F.lane, CmIdent{0}); continue; } r -= I_RO;
            if (r < I_RO) { transpose_item(F.w_gdn_out, DM, 512, WSP(bf16, WS_WGO), scr, r / 32, r % 32, F.lane, CmIdent{0}); continue; } r -= I_RO;
            transpose_item(F.w_o, DM, DM, WSP(bf16, WS_WO), scr, r / 32, r % 32, F.lane, CmIdent{0}); }
    }
}

__device__ __forceinline__ void phase_moe_weights(Frame& F) {
    const int gw = F.bid * NWAVES + F.wave, NGW = F.G * NWAVES;
    LAS float* scr = (LAS float*)(F.lds + F.wave * 16384);
    constexpr int I_GU = 16 * 16  , I_D = 4 * 32;
    for (int it = gw; it < 65 * (I_GU + I_D); it += NGW) {
        const int e = it / (I_GU + I_D); int r = it % (I_GU + I_D);
        if (r < I_GU) {
            const int kb = r / 16, nb = r % 16;
            const int k0 = 64 * kb, n0 = 32 * nb; int hid, isup; gu_decode(n0 + (F.lane & 31), hid, isup);
            const float* Wg = e < 64 ? F.w_gate + (size_t)e * DM * DEXP : F.w_sh_gate; const float* Wu = e < 64 ? F.w_up + (size_t)e * DM * DEXP : F.w_sh_up;
            const float* W = isup ? Wu : Wg;
            float tv[32];
#pragma unroll
            for (int i = 0; i < 32; ++i) tv[i] = W[(size_t)(k0 + 2 * i + (F.lane >> 5)) * DEXP + hid];
#pragma unroll
            for (int i = 0; i < 32; ++i) scr[(2 * i + (F.lane >> 5)) * 33 + (F.lane & 31)] = tv[i];
            asm volatile("s_waitcnt lgkmcnt(0)" ::: "memory");
            const int c = F.lane & 7; bf16* WT = WSP(bf16, WS_WGU) + (size_t)e * 512 * DM;
#pragma unroll
            for (int j = 0; j < 4; ++j) { const int n = (F.lane >> 3) + 8 * j; const LAS float* s = scr + (8 * c) * 33 + n;
                u32x4 o; o.x = pk2(s[0 * 33], s[1 * 33]); o.y = pk2(s[2 * 33], s[3 * 33]); o.z = pk2(s[4 * 33], s[5 * 33]); o.w = pk2(s[6 * 33], s[7 * 33]);
                *(u32x4*)(WT + (size_t)(n0 + n) * DM + k0 + 8 * c) = o; }
            asm volatile("s_waitcnt lgkmcnt(0)" ::: "memory");
        } else { r -= I_GU;
            const float* W = e < 64 ? F.w_down + (size_t)e * DEXP * DM : F.w_sh_down;
            transpose_item(W, DM, DEXP, WSP(bf16, WS_WD) + (size_t)e * DM * DEXP, scr, r / 32, r % 32, F.lane, CmIdent{0}); }
    }
}

template <bool LAT> __device__ __forceinline__ int norm1_row_of(int i) { return LAT ? (i >> 12) * RPB + CTXL + (i & 4095) : i; }
template <bool LAT>
__device__ __forceinline__ void norm1_rows(Frame& F, LAS float* wl, int w0, int nw, int r_lo, int r_hi) {
    const float* mod = WSP(float, WS_MOD);
    int ri = r_lo + w0; if (ri >= r_hi) return;
    f32x4 vn[4];
    { const int row = norm1_row_of<LAT>(ri); const int b = row / RPB, pos = row % RPB; const float* src = pos < CTXL ? F.ctx + ((size_t)b * CTXL + pos) * DM : F.x + ((size_t)b * SEQ + (pos - CTXL)) * DM;
#pragma unroll
      for (int j = 0; j < 4; ++j) vn[j] = *(const f32x4*)(src + 4 * (F.lane + 64 * j)); }
    for (; ri < r_hi; ri += nw) {
        const int row = norm1_row_of<LAT>(ri); const int b = row / RPB, pos = row % RPB; const bool isctx = pos < CTXL;
        const float* sh = isctx ? mod + 4 * 6144 : mod + b * 6144; const float* sc = sh + DM;
        f32x4 v[4]; float ss = 0.f;
#pragma unroll
        for (int j = 0; j < 4; ++j) { v[j] = vn[j]; ss += v[j].x * v[j].x + v[j].y * v[j].y + v[j].z * v[j].z + v[j].w * v[j].w; }
        { const int nri = ri + nw; if (nri < r_hi) { const int nr = norm1_row_of<LAT>(nri); const int nb = nr / RPB, np = nr % RPB; const float* src = np < CTXL ? F.ctx + ((size_t)nb * CTXL + np) * DM : F.x + ((size_t)nb * SEQ + (np - CTXL)) * DM;
#pragma unroll
            for (int j = 0; j < 4; ++j) vn[j] = *(const f32x4*)(src + 4 * (F.lane + 64 * j)); } }
        const float rstd = 1.0f / sqrtf(wave_sum(ss) * (1.f / DM) + EPS);
        float gd[16];
#pragma unroll
        for (int jj = 0; jj < 16; ++jj) gd[jj] = 0.f;
#pragma unroll
        for (int j = 0; j < 4; ++j) { const int c0 = 4 * (F.lane + 64 * j);
            const f32x4 g = *(const f32x4*)(F.n_mix_pre + c0), s1 = *(const f32x4*)(sc + c0), s0 = *(const f32x4*)(sh + c0);
            f32x4 h; h.x = v[j].x * rstd * g.x * (1.f + s1.x) + s0.x; h.y = v[j].y * rstd * g.y * (1.f + s1.y) + s0.y; h.z = v[j].z * rstd * g.z * (1.f + s1.z) + s0.z; h.w = v[j].w * rstd * g.w * (1.f + s1.w) + s0.w;
            u32x2 o; o.x = pk2(h.x, h.y); o.y = pk2(h.z, h.w);
            *(u32x2*)(WSP(bf16, WS_HX) + (size_t)row * DM + c0) = o;
#pragma unroll
            for (int jh = 0; jh < 2; ++jh) {
                asm volatile("" ::: "memory");
#pragma unroll
                for (int jj = 8 * jh; jj < 8 * jh + 8; ++jj) { const f32x4 w4 = *(const LAS f32x4*)(wl + jj * DM + c0); gd[jj] += (h.x * w4.x + h.y * w4.y) + (h.z * w4.z + h.w * w4.w); } } }
        float g8[8], g4[4], g2[2], mine;
        { const bool b0 = F.lane & 1, b1 = F.lane & 2, b2 = F.lane & 4, b3 = F.lane & 8;
#pragma unroll
          for (int i = 0; i < 8; ++i) { const float snd = b0 ? gd[2 * i] : gd[2 * i + 1], kp = b0 ? gd[2 * i + 1] : gd[2 * i]; g8[i] = kp + __shfl_xor(snd, 1); }
#pragma unroll
          for (int i = 0; i < 4; ++i) { const float snd = b1 ? g8[2 * i] : g8[2 * i + 1], kp = b1 ? g8[2 * i + 1] : g8[2 * i]; g4[i] = kp + __shfl_xor(snd, 2); }
#pragma unroll
          for (int i = 0; i < 2; ++i) { const float snd = b2 ? g4[2 * i] : g4[2 * i + 1], kp = b2 ? g4[2 * i + 1] : g4[2 * i]; g2[i] = kp + __shfl_xor(snd, 4); }
          { const float snd = b3 ? g2[0] : g2[1], kp = b3 ? g2[1] : g2[0]; mine = kp + __shfl_xor(snd, 8); }
          mine += __shfl_xor(mine, 16); mine += __shfl_xor(mine, 32); }
        if (F.lane < 16) { const int ab = F.lane >> 3, dir = (F.lane >> 2) & 1, h = F.lane & 3; const size_t o = ((size_t)(dir * NB + b) * NH + h) * RPB + pos;
            if (ab == 0) { const float z = mine + F.gdn_dt_bias[dir * 4 + h]; const float sp = z > 20.f ? z : log1pf(expf(z)); WSP(float, WS_LOGA)[o] = -expf(F.gdn_a_log[dir * 4 + h]) * sp; }
            else WSP(float, WS_BETA)[o] = 1.f / (1.f + expf(-mine)); }
    }
}
__device__ __forceinline__ void phase_norm1(Frame& F) {
    const int gw = F.bid * NWAVES + F.wave, NGW = F.G * NWAVES;
    LAS float* wl = (LAS float*)F.lds;
    for (int k = F.tid; k < DM; k += NTHR) { const float* wr = F.w_in + (size_t)k * N_IN + 2048;
#pragma unroll
        for (int jj = 0; jj < 4; ++jj) { const f32x4 w4 = *(const f32x4*)(wr + 4 * jj); wl[(4 * jj) * DM + k] = w4.x; wl[(4 * jj + 1) * DM + k] = w4.y; wl[(4 * jj + 2) * DM + k] = w4.z; wl[(4 * jj + 3) * DM + k] = w4.w; } }
    __syncthreads();
    if (F.G < 64) { norm1_rows<false>(F, wl, gw, NGW, 0, NROW); return; }
    if (F.bid < 32) {
        const int b = F.bid >> 3, sub = F.bid & 7; const int r0 = b * RPB + 32 * sub;
        norm1_rows<false>(F, wl, F.wave, NWAVES, r0, r0 + 32);
        asm volatile("s_waitcnt vmcnt(0)" ::: "memory");
        __syncthreads();
        if (F.tid == 0) {
            unsigned* flag = F.ctl + CW_FLAG + 64 * b;
            __builtin_amdgcn_fence(__ATOMIC_RELEASE, "agent"); asm volatile("s_waitcnt vmcnt(0)" ::: "memory");
            __hip_atomic_fetch_add(flag, 1u, __ATOMIC_RELAXED, __HIP_MEMORY_SCOPE_AGENT);
            unsigned sp = 0; while (__hip_atomic_load(flag, __ATOMIC_RELAXED, __HIP_MEMORY_SCOPE_AGENT) < 8u) { __builtin_amdgcn_s_sleep(1); if (++sp > (1u << 22)) break; }
            __builtin_amdgcn_fence(__ATOMIC_ACQUIRE, "agent"); asm volatile("s_waitcnt vmcnt(0)" ::: "memory");
        }
        __syncthreads();
    } else {
        norm1_rows<true>(F, wl, (F.bid - 32) * NWAVES + F.wave, (F.G - 32) * NWAVES, 0, NT);
    }
}

struct SchedIn {
    const char* A; const char* B; int G, c;
    __device__ __forceinline__ bool next(int i, pg8::Unit& u) const {
        const int L = i * G + c; if (L >= (G < 64 ? 1536 + 32 : 1536)) return false;
        int lt, pn;
        if (L < 1536) { int wgid = L; { const int q = 1536 / 8, xcd = wgid % 8, off = wgid / 8; wgid = xcd * q + off; }
            const int nig = 8 * 24, gid = wgid / nig, fm = gid * 8; lt = fm + ((wgid % nig) % 8); pn = (wgid % nig) / 8; u.pm = (lt >> 4) * 17 + 1 + (lt & 15); }
        else { const int q = L - 1536; u.pm = (q >> 3) * 17; pn = q & 7; }
        u.pn = pn; u.e = 0; u.base = 0; u.A = A + (size_t)u.pm * 256 * DM * 2; u.B = B + (size_t)pn * 256 * DM * 2; return true; }
    __device__ __forceinline__ int row_index(const pg8::Unit&, int r) const { return r; }
};
struct SchedCtx {
    const char* A; const char* B; int b, pn;
    __device__ __forceinline__ bool next(int i, pg8::Unit& u) const { if (i > 0) return false; u.pm = b * 17; u.pn = pn; u.e = 0; u.base = 0; u.A = A + (size_t)u.pm * 256 * DM * 2; u.B = B + (size_t)pn * 256 * DM * 2; return true; }
    __device__ __forceinline__ int row_index(const pg8::Unit&, int r) const { return r; }
};
struct EpiIn {
    bf16* P; bf16* GATES; const float2* rope;
    __device__ __forceinline__ void operator()(const f32x4 (&acc)[2][2][4][2], const pg8::Unit& u, int wr, int wc, int fr, int fq) const {
        const int g = u.pn >> 1;
        const int b = u.pm / 17, tl = u.pm % 17;
#pragma unroll
        for (int ai = 0; ai < 2; ++ai)
#pragma unroll
            for (int m = 0; m < 4; ++m) {
                const int rt = ai * 128 + wr * 64 + m * 16 + fr; const size_t prow = (size_t)u.pm * 256 + rt;
#pragma unroll
                for (int bj = 0; bj < 2; ++bj) {
                    f32x4 v0 = acc[ai][bj][m][0], v1 = acc[ai][bj][m][1];
                    const int ct = bj * 128 + wc * 32 + 8 * fq;
                    if (g == 0 || g == 4) {
                        const float s = (g == 0) ? 0.08838834764831845f : 1.0f; v0 = v0 * s; v1 = v1 * s;
                        const int j = 16 * wc + 4 * fq;
                        f32x4 o1 = v0, o2 = v1;
                        if (tl != 0) { const int t = (tl - 1) * 256 + rt; const float2* cs = rope + (size_t)t * 64 + j;
#pragma unroll
                            for (int i = 0; i < 4; ++i) { const float2 c2 = cs[i]; o1[i] = v0[i] * c2.x - v1[i] * c2.y; o2[i] = v0[i] * c2.y + v1[i] * c2.x; } }
                        bf16* dst = P + (size_t)g * PGRP + prow * 512 + (u.pn & 1) * 256 + bj * 128 + j;
                        u32x2 w1, w2; w1.x = pg8::cvt_pk_bf16(o1[0], o1[1]); w1.y = pg8::cvt_pk_bf16(o1[2], o1[3]); w2.x = pg8::cvt_pk_bf16(o2[0], o2[1]); w2.y = pg8::cvt_pk_bf16(o2[2], o2[3]);
                        *(u32x2*)dst = w1; *(u32x2*)(dst + 64) = w2;
                    } else if (g < 8) {
                        u32x4 w; w.x = pg8::cvt_pk_bf16(v0[0], v0[1]); w.y = pg8::cvt_pk_bf16(v0[2], v0[3]); w.z = pg8::cvt_pk_bf16(v1[0], v1[1]); w.w = pg8::cvt_pk_bf16(v1[2], v1[3]);
                        *(u32x4*)(P + (size_t)g * PGRP + prow * 512 + (u.pn & 1) * 256 + ct) = w;
                    } else {
                        const size_t lrow = (size_t)b * SEQ + (size_t)(tl - 1) * 256 + rt;
#pragma unroll
                        for (int i = 0; i < 4; ++i) { v0[i] = sigmoidf_(v0[i]); v1[i] = sigmoidf_(v1[i]); }
                        u32x4 w; w.x = pg8::cvt_pk_bf16(v0[0], v0[1]); w.y = pg8::cvt_pk_bf16(v0[2], v0[3]); w.z = pg8::cvt_pk_bf16(v1[0], v1[1]); w.w = pg8::cvt_pk_bf16(v1[2], v1[3]);
                        *(u32x4*)(GATES + lrow * 2048 + (u.pn - 16) * 256 + ct) = w;
                    }
                }
            }
    }
};

constexpr int IMGB = 34816, IMGS = 272;
typedef short s16x4 __attribute__((ext_vector_type(4)));
__device__ __forceinline__ unsigned offb(unsigned row, unsigned ch) { return 272u * row + 16u * ch; }
__device__ __forceinline__ unsigned offe(unsigned row, unsigned col) { return 272u * row + 2u * col; }
__device__ __forceinline__ bf16x8 frag_row(LAS unsigned char* img, int tile, int s, int lane) { return *(const LAS bf16x8*)(img + offb(16 * tile + (lane & 15), 4 * s + (lane >> 4))); }
__device__ __forceinline__ bf16x8 frag_tr(LAS unsigned char* img, int tile, int s, int lane) {
    const unsigned g = lane >> 4, qq = (lane & 15) >> 2, p = lane & 3;
    const s16x4 lo = __builtin_amdgcn_ds_read_tr16_b64_v4i16((LAS s16x4*)(img + offe(32 * s + 8 * g + qq, 16 * tile + 4 * p)));
    const s16x4 hi = __builtin_amdgcn_ds_read_tr16_b64_v4i16((LAS s16x4*)(img + offe(32 * s + 8 * g + 4 + qq, 16 * tile + 4 * p)));
    return (bf16x8){lo[0], lo[1], lo[2], lo[3], hi[0], hi[1], hi[2], hi[3]};
}
#define MFMA16(a, b, c) __builtin_amdgcn_mfma_f32_16x16x32_bf16(a, b, c, 0, 0, 0)
#define LBAR() do { asm volatile("s_waitcnt lgkmcnt(0)" ::: "memory"); __builtin_amdgcn_s_barrier(); asm volatile("" ::: "memory"); } while (0)
template <bool SWAP>
__device__ __forceinline__ void mm128(LAS unsigned char* ia, bool atr, LAS unsigned char* ib, bool btr, int wr, int wc, int lane, f32x4 (&acc)[2][4]) {
#pragma unroll
    for (int s = 0; s < 4; ++s) {
        bf16x8 fa[2], fb[4];
#pragma unroll
        for (int i = 0; i < 2; ++i) fa[i] = atr ? frag_tr(ia, 2 * wr + i, s, lane) : frag_row(ia, 2 * wr + i, s, lane);
#pragma unroll
        for (int j = 0; j < 4; ++j) fb[j] = btr ? frag_tr(ib, 4 * wc + j, s, lane) : frag_row(ib, 4 * wc + j, s, lane);
#pragma unroll
        for (int i = 0; i < 2; ++i)
#pragma unroll
            for (int j = 0; j < 4; ++j) acc[i][j] = SWAP ? MFMA16(fb[j], fa[i], acc[i][j]) : MFMA16(fa[i], fb[j], acc[i][j]);
    }
}
__device__ __forceinline__ void zero_acc(f32x4 (&acc)[2][4]) {
#pragma unroll
    for (int i = 0; i < 2; ++i)
#pragma unroll
        for (int j = 0; j < 4; ++j) acc[i][j] = (f32x4){0.f, 0.f, 0.f, 0.f};
}
__device__ __forceinline__ void st_img(LAS unsigned char* img, const f32x4 (&acc)[2][4], int wr, int wc, int lane) {
    const int r = lane & 15, q = lane >> 4;
#pragma unroll
    for (int i = 0; i < 2; ++i)
#pragma unroll
        for (int j = 0; j < 4; ++j) { u32x2 w; w.x = pk2(acc[i][j][0], acc[i][j][1]); w.y = pk2(acc[i][j][2], acc[i][j][3]);
            *(LAS u32x2*)(img + offe(32 * wr + 16 * i + r, 64 * wc + 16 * j + 4 * q)) = w; }
}
__device__ __forceinline__ void load_plain_img(LAS unsigned char* img, const bf16* src, int ld, int tid) {
#pragma unroll
    for (int i = 0; i < 4; ++i) { const int cidx = tid + 512 * i, row = cidx >> 4, ch = cidx & 15;
        *(LAS u32x4*)(img + offb(row, ch)) = *(const u32x4*)(src + (size_t)row * ld + 8 * ch); }
}
__device__ __forceinline__ void load_conv_img(LAS unsigned char* img, const bf16* src, const float* cw  , bool has_prev, bool has_next, int mode  , int wave, int lane) {
    asm volatile("" ::: "memory");
    const int ch = lane & 15; float w0[8], w1[8], w2[8];
#pragma unroll
    for (int i = 0; i < 8; ++i) { w0[i] = cw[8 * ch + i]; w1[i] = cw[1536 + 8 * ch + i]; w2[i] = cw[3072 + 8 * ch + i]; }
#pragma unroll
    for (int it = 0; it < 4; ++it) {
        const int row = 32 * it + 4 * wave + (lane >> 4); const u32x4 z4 = {0u, 0u, 0u, 0u};
        const u32x4 r0 = (row > 0 || has_prev) ? *(const u32x4*)(src + ((ptrdiff_t)row - 1) * 512 + 8 * ch) : z4;
        const u32x4 r1 = *(const u32x4*)(src + (size_t)row * 512 + 8 * ch);
        const u32x4 r2 = (row < 127 || has_next) ? *(const u32x4*)(src + (size_t)(row + 1) * 512 + 8 * ch) : z4;
        float a0[8], a1[8], a2[8], y[8]; unpack8(r0, a0); unpack8(r1, a1); unpack8(r2, a2); float ss = 0.f;
#pragma unroll
        for (int i = 0; i < 8; ++i) { y[i] = siluf_(w0[i] * a0[i] + w1[i] * a1[i] + w2[i] * a2[i]); ss += y[i] * y[i]; }
        if (mode != 1) { const float sc = (1.0f / sqrtf(sum16(ss) + EPS)) * (mode == 2 ? 0.08838834764831845f : 1.0f);
#pragma unroll
            for (int i = 0; i < 8; ++i) y[i] *= sc; }
        *(LAS u32x4*)(img + offb(row, ch)) = pack8(y);
    }
}
__device__ __forceinline__ void scale_rows_img(LAS unsigned char* dst, LAS unsigned char* src, const LAS float* rs, int tid) {
#pragma unroll
    for (int i = 0; i < 4; ++i) { const int cidx = tid + 512 * i, row = cidx >> 4, ch = cidx & 15; float v[8]; unpack8(*(const LAS u32x4*)(src + offb(row, ch)), v); const float sc = rs[row];
#pragma unroll
        for (int e = 0; e < 8; ++e) v[e] *= sc;
        *(LAS u32x4*)(dst + offb(row, ch)) = pack8(v); }
}
__device__ __forceinline__ void tri_inverse(LAS unsigned char* img, int w, int lane) {
    const int r = lane & 15, q = lane >> 4;
    {
        const int b0 = 16 * w; float x[16];
#pragma unroll
        for (int i = 0; i < 16; ++i) { float v = (i == r) ? 1.f : 0.f;
#pragma unroll
            for (int j = 0; j < i; ++j) v -= bf2f(*(const LAS unsigned short*)(img + offe(b0 + i, b0 + j))) * x[j];
            x[i] = v; }
        if (q == 0) {
#pragma unroll
            for (int i = 0; i < 16; ++i) *(LAS unsigned short*)(img + offe(b0 + i, b0 + r)) = (unsigned short)f2bf(x[i]); }
    }
    LBAR();
    if (w < 4) {
        const int c0 = 32 * w, r1 = c0 + 16;
        const u32x2 av = *(const LAS u32x2*)(img + offe(r1 + r, c0 + 4 * q));
        const bf16x8 fa = __builtin_bit_cast(bf16x8, (u32x4){av.x, av.y, 0u, 0u});
        const s16x4 tb = __builtin_amdgcn_ds_read_tr16_b64_v4i16((LAS s16x4*)(img + offe(c0 + 4 * q + (r >> 2), c0 + 4 * (r & 3))));
        const bf16x8 fb = (bf16x8){tb[0], tb[1], tb[2], tb[3], 0, 0, 0, 0};
        const f32x4 y = MFMA16(fa, fb, ((f32x4){0.f, 0.f, 0.f, 0.f}));
        const bf16x8 fy = __builtin_bit_cast(bf16x8, (u32x4){pk2(y[0], y[1]), pk2(y[2], y[3]), 0u, 0u});
        const u32x2 tv = *(const LAS u32x2*)(img + offe(r1 + r, r1 + 4 * q));
        const bf16x8 ft = __builtin_bit_cast(bf16x8, (u32x4){tv.x, tv.y, 0u, 0u});
        const f32x4 d = MFMA16(fy, ft, ((f32x4){0.f, 0.f, 0.f, 0.f}));
        u32x2 o; o.x = pk2(-d[0], -d[1]); o.y = pk2(-d[2], -d[3]);
        *(LAS u32x2*)(img + offe(r1 + r, c0 + 4 * q)) = o;
    }
    LBAR();
    {
        const int p = w >> 2, ti = (w >> 1) & 1, tj = w & 1, base = 64 * p, rb = base + 32;
        f32x4 y[2];
        const unsigned g = lane >> 4, qq = (lane & 15) >> 2, pp = lane & 3;
        const s16x4 lo = __builtin_amdgcn_ds_read_tr16_b64_v4i16((LAS s16x4*)(img + offe(base + 8 * g + qq, base + 16 * tj + 4 * pp)));
        const s16x4 hi = __builtin_amdgcn_ds_read_tr16_b64_v4i16((LAS s16x4*)(img + offe(base + 8 * g + 4 + qq, base + 16 * tj + 4 * pp)));
        const bf16x8 fb = (bf16x8){lo[0], lo[1], lo[2], lo[3], hi[0], hi[1], hi[2], hi[3]};
#pragma unroll
        for (int kt = 0; kt < 2; ++kt) { const bf16x8 fa = *(const LAS bf16x8*)(img + offb(rb + 16 * kt + r, (base >> 3) + q)); y[kt] = MFMA16(fa, fb, ((f32x4){0.f, 0.f, 0.f, 0.f})); }
        const bf16x8 fy = __builtin_bit_cast(bf16x8, (u32x4){pk2(y[0][0], y[0][1]), pk2(y[0][2], y[0][3]), pk2(y[1][0], y[1][1]), pk2(y[1][2], y[1][3])});
        const u32x2 t0 = *(const LAS u32x2*)(img + offe(rb + 16 * ti + r, rb + 4 * q)), t1 = *(const LAS u32x2*)(img + offe(rb + 16 * ti + r, rb + 16 + 4 * q));
        const bf16x8 ft = __builtin_bit_cast(bf16x8, (u32x4){t0.x, t0.y, t1.x, t1.y});
        const f32x4 d = MFMA16(fy, ft, ((f32x4){0.f, 0.f, 0.f, 0.f}));
        LBAR();
        u32x2 o; o.x = pk2(-d[0], -d[1]); o.y = pk2(-d[2], -d[3]);
        *(LAS u32x2*)(img + offe(rb + 16 * ti + r, base + 16 * tj + 4 * q)) = o;
    }
    LBAR();
    {
        const int tj = w >> 1, ti0 = 2 * (w & 1);
        f32x4 y[4];
#pragma unroll
        for (int kt = 0; kt < 4; ++kt) y[kt] = (f32x4){0.f, 0.f, 0.f, 0.f};
#pragma unroll
        for (int s = 0; s < 2; ++s) { const bf16x8 fb = frag_tr(img, tj, s, lane);
#pragma unroll
            for (int kt = 0; kt < 4; ++kt) y[kt] = MFMA16(frag_row(img, 4 + kt, s, lane), fb, y[kt]); }
        f32x4 d[2];
#pragma unroll
        for (int i = 0; i < 2; ++i) { d[i] = (f32x4){0.f, 0.f, 0.f, 0.f};
#pragma unroll
            for (int ks = 0; ks < 2; ++ks) {
                const bf16x8 fy = __builtin_bit_cast(bf16x8, (u32x4){pk2(y[2 * ks][0], y[2 * ks][1]), pk2(y[2 * ks][2], y[2 * ks][3]), pk2(y[2 * ks + 1][0], y[2 * ks + 1][1]), pk2(y[2 * ks + 1][2], y[2 * ks + 1][3])});
                const int row = 64 + 16 * (ti0 + i) + r;
                const u32x2 t0 = *(const LAS u32x2*)(img + offe(row, 64 + 32 * ks + 4 * q)), t1 = *(const LAS u32x2*)(img + offe(row, 64 + 32 * ks + 16 + 4 * q));
                d[i] = MFMA16(fy, __builtin_bit_cast(bf16x8, (u32x4){t0.x, t0.y, t1.x, t1.y}), d[i]); } }
        LBAR();
#pragma unroll
        for (int i = 0; i < 2; ++i) { u32x2 o; o.x = pk2(-d[i][0], -d[i][1]); o.y = pk2(-d[i][2], -d[i][3]);
            *(LAS u32x2*)(img + offe(64 + 16 * (ti0 + i) + r, 16 * tj + 4 * q)) = o; }
    }
    LBAR();
}

__device__ __forceinline__ void phase_prep(Frame& F) {
    LAS unsigned char* I0 = F.lds; LAS unsigned char* I1 = F.lds + IMGB; LAS unsigned char* I2 = F.lds + 2 * IMGB; LAS unsigned char* I3 = F.lds + 3 * IMGB;
    LAS float* sm = (LAS float*)(F.lds + MISC_OFF + 1024);
    LAS float* s_la = sm; LAS float* s_bet = sm + 128; LAS float* s_gc = sm + 256; LAS float* s_eg = sm + 384; LAS float* s_s2 = sm + 512; LAS float* s_t1 = sm + 640; LAS float* s_t2 = sm + 768;
#define LAUNDER() int tz_ = threadIdx.x; asm volatile("" : "+v"(tz_)); const int tid = tz_, lane = tz_ & 63, w = __builtin_amdgcn_readfirstlane(tz_ >> 6), wr = w >> 1, wc = w & 1, r = lane & 15, q = lane >> 4; (void)tid; (void)lane; (void)w; (void)wr; (void)wc; (void)r; (void)q
    const bf16* P = WSP(bf16, WS_P);
    for (int it = F.bid; it < 512 + 96; it += F.G) {
        int b, h, m, part = 3;
        if (it < 512) { b = it >> 7; h = (it >> 5) & 3; m = 2 + (it & 31); } else { const int c3 = it - 512; const int c = c3 / 3; part = c3 - 3 * c; b = c >> 3; h = (c >> 1) & 3; m = c & 1; }
        const bool isctx = m < 2; const int pos0 = 128 * m; const size_t row0 = (size_t)b * RPB + pos0; const size_t trow0 = (size_t)b * SEQ + (pos0 - CTXL);
        const bool hprev = isctx ? (m > 0) : (m > 2), hnext = isctx ? (m < 1) : (m < NCHUNK - 1);
        const size_t hoff = row0 * 512 + h * 128;
        f32x4 acc[2][4];
        if (part == 3 || part == 0) {
        const float lgf = F.ret_log_decay[h] * 1.4426950408889634f, lgb = F.ret_log_decay[4 + h] * 1.4426950408889634f;
        { LAUNDER();
        load_plain_img(I0, P + 0 * PGRP + hoff, 512, tid); load_plain_img(I1, P + 1 * PGRP + hoff, 512, tid);
        if (!isctx) load_plain_img(I2, P + 4 * PGRP + hoff, 512, tid);
        if (tid < 128) { s_t1[tid] = exp2f(lgf * (float)(127 - tid)); s_t2[tid] = exp2f(lgb * (float)tid); } }
        LBAR();
        if (!isctx) {
            { LAUNDER();
            zero_acc(acc); mm128<true>(I2, false, I0, false, wr, wc, lane, acc);
#pragma unroll
            for (int i = 0; i < 2; ++i)
#pragma unroll
                for (int j = 0; j < 4; ++j)
#pragma unroll
                    for (int e = 0; e < 4; ++e) { const int ii = 32 * wr + 16 * i + r, jj = 64 * wc + 16 * j + 4 * q + e; const int d = ii - jj;
                        const float wg = (d >= 0 ? exp2f(lgf * (float)d) : 0.f) + (d <= 0 ? exp2f(lgb * (float)(-d)) : 0.f); acc[i][j][e] *= wg; }
            st_img(I3, acc, wr, wc, lane); }
            LBAR();
            { LAUNDER();
            zero_acc(acc); mm128<true>(I3, false, I1, true, wr, wc, lane, acc);
            bf16* og = WSP(bf16, WS_ORET) + (trow0 + 32 * wr + r) * 512 + h * 128 + 64 * wc + 4 * q;
#pragma unroll
            for (int i = 0; i < 2; ++i)
#pragma unroll
                for (int j = 0; j < 4; ++j) { u32x2 o; o.x = pk2(acc[i][j][0], acc[i][j][1]); o.y = pk2(acc[i][j][2], acc[i][j][3]); *(u32x2*)(og + (size_t)(16 * i) * 512 + 16 * j) = o; } }
        }
#pragma unroll 1
        for (int dir = 0; dir < 2; ++dir) {
            LAS unsigned char* kw = dir ? I3 : I2;
            { LAUNDER(); scale_rows_img(kw, I0, dir ? s_t2 : s_t1, tid); }
            LBAR();
            LAUNDER();
            zero_acc(acc); mm128<false>(kw, true, I1, true, wr, wc, lane, acc);
            const int chain = (b * NH + h) * 2 + dir, n = dir ? (isctx ? 1 - m : 35 - m) : m;
            unsigned char* kv = F.ws + WS_GKV + ((size_t)chain * NCHUNK + n) * 32768;
#pragma unroll
            for (int i = 0; i < 2; ++i)
#pragma unroll
                for (int j = 0; j < 4; ++j) { const int mt = 2 * wr + i, nt = 4 * wc + j; u32x2 o; o.x = pk2(acc[i][j][0], acc[i][j][1]); o.y = pk2(acc[i][j][2], acc[i][j][3]);
                    *(u32x2*)(kv + ((size_t)((nt * 4 + (mt >> 1)) * 64 + (2 * (mt & 1) + (q >> 1)) * 16 + r)) * 16 + 8 * (q & 1)) = o; }
        }
        LBAR();
        }
#pragma unroll 1
        for (int dir = (part == 2 ? 1 : 0); dir < (part == 3 ? 2 : part == 0 ? 0 : part); ++dir) {
            const int chain = (b * NH + h) * 2 + dir, n = dir ? (isctx ? 1 - m : 35 - m) : m;
            { LAUNDER(); load_conv_img(I0, P + 2 * PGRP + hoff, F.gdn_conv + 512 + h * 128, hprev, hnext, 0, w, lane); }
            { LAUNDER(); load_conv_img(I1, P + 3 * PGRP + hoff, F.gdn_conv + 1024 + h * 128, hprev, hnext, 1, w, lane); }
            { LAUNDER(); if (tid < 128) { const size_t o = ((size_t)(dir * NB + b) * NH + h) * RPB + pos0 + tid; s_la[tid] = WSP(float, WS_LOGA)[o]; s_bet[tid] = WSP(float, WS_BETA)[o]; } }
            LBAR();
            { LAUNDER();
            if (w == 0) {
                const float a = s_la[2 * lane], c = s_la[2 * lane + 1]; const float pr = a + c; float inc = pr;
#pragma unroll
                for (int o = 1; o < 64; o <<= 1) { const float t = __shfl_up(inc, o); if (lane >= o) inc += t; }
                const float tot = __shfl(inc, 63); const float ex = inc - pr;
                float g0 = ex + a, g1 = ex + pr;
                if (dir) { g0 = tot - ex; g1 = tot - (ex + a); }
                s_gc[2 * lane] = g0; s_gc[2 * lane + 1] = g1; s_eg[2 * lane] = __expf(g0); s_eg[2 * lane + 1] = __expf(g1);
                s_s2[2 * lane] = __expf(tot - g0); s_s2[2 * lane + 1] = __expf(tot - g1);
                if (lane == 0) s_t1[0] = __expf(tot);
            } }
            LBAR();
            { LAUNDER();
            zero_acc(acc); mm128<true>(I0, false, I0, false, wr, wc, lane, acc);
#pragma unroll
            for (int i = 0; i < 2; ++i)
#pragma unroll
                for (int j = 0; j < 4; ++j) { const int ii = 32 * wr + 16 * i + r; const float gi = s_gc[ii], bi = s_bet[ii];
#pragma unroll
                    for (int e = 0; e < 4; ++e) { const int jj = 64 * wc + 16 * j + 4 * q + e;
                        const float f = dir ? s_bet[jj] * __expf(s_gc[jj] - gi) : bi * __expf(gi - s_gc[jj]); acc[i][j][e] = (ii > jj) ? acc[i][j][e] * f : 0.f; } }
            st_img(I2, acc, wr, wc, lane); }
            LBAR();
            { LAUNDER(); tri_inverse(I2, w, lane); }
            { LAUNDER();
#pragma unroll
            for (int i = 0; i < 4; ++i) { const int cidx = tid + 512 * i, row = cidx >> 4, ch = cidx & 15; float v[8], v2[8]; unpack8(*(const LAS u32x4*)(I2 + offb(row, ch)), v);
#pragma unroll
                for (int e = 0; e < 8; ++e) { const int k = dir ? row : 8 * ch + e; const float bb = s_bet[k]; v[e] *= bb; v2[e] = v[e] * s_eg[k]; }
                *(LAS u32x4*)(I2 + offb(row, ch)) = pack8(v); *(LAS u32x4*)(I3 + offb(row, ch)) = pack8(v2); } }
            LBAR();
            { LAUNDER();
            zero_acc(acc); mm128<true>(I3, dir != 0, I0, true, wr, wc, lane, acc);
            LBAR();
            st_img(I3, acc, wr, wc, lane); }
            { LAUNDER();
            zero_acc(acc); mm128<true>(I2, dir != 0, I1, true, wr, wc, lane, acc);
            LBAR();
            st_img(I2, acc, wr, wc, lane);
            scale_rows_img(I1, I0, s_s2, tid); }
            LBAR();
            {
                LAUNDER();
                const float dtot = s_t1[0];
                zero_acc(acc); mm128<false>(I1, true, I2, true, wr, wc, lane, acc);
                unsigned char* gc = F.ws + WS_GC + ((size_t)chain * NCHUNK + n) * 32768;
#pragma unroll
                for (int i = 0; i < 2; ++i)
#pragma unroll
                    for (int j = 0; j < 4; ++j) { const int mt = 2 * wr + i, nt = 4 * wc + j; u32x2 o; o.x = pk2(acc[i][j][0], acc[i][j][1]); o.y = pk2(acc[i][j][2], acc[i][j][3]);
                        *(u32x2*)(gc + ((size_t)((nt * 8 + mt) * 64 + lane)) * 8) = o; }
                }
                { LAUNDER(); const float dtot = s_t1[0];
                zero_acc(acc); mm128<true>(I1, true, I3, true, wr, wc, lane, acc);
                unsigned char* gm = F.ws + WS_GM + ((size_t)chain * NCHUNK + n) * 32768;
#pragma unroll
                for (int i = 0; i < 2; ++i)
#pragma unroll
                    for (int j = 0; j < 4; ++j) { const int mt = 2 * wr + i, ct = 4 * wc + j; const int rowi = 16 * mt + r; float v[4];
#pragma unroll
                        for (int e = 0; e < 4; ++e) v[e] = ((rowi == 16 * ct + 4 * q + e) ? dtot : 0.f) - acc[i][j][e];
                        u32x2 o; o.x = pk2(v[0], v[1]); o.y = pk2(v[2], v[3]);
                        *(u32x2*)(gm + ((size_t)((mt * 4 + (ct >> 1)) * 64 + q * 16 + r)) * 16 + 8 * (ct & 1)) = o; }
            }
            LBAR();
            if (!isctx) {
                { LAUNDER(); load_conv_img(I1, P + 6 * PGRP + hoff, F.gdn_conv + h * 128, hprev, hnext, 2, w, lane); }
                LBAR();
                { LAUNDER();
                zero_acc(acc); mm128<true>(I1, false, I0, false, wr, wc, lane, acc);
#pragma unroll
                for (int i = 0; i < 2; ++i) { const int ii = 32 * wr + 16 * i + r; const float gi = s_gc[ii];
#pragma unroll
                    for (int j = 0; j < 4; ++j)
#pragma unroll
                        for (int e = 0; e < 4; ++e) { const int jj = 64 * wc + 16 * j + 4 * q + e; const bool on = dir ? (jj >= ii) : (jj <= ii);
                            acc[i][j][e] = on ? acc[i][j][e] * __expf(gi - s_gc[jj]) : 0.f; } }
                LBAR();
                st_img(I0, acc, wr, wc, lane); }
                LBAR();
                { LAUNDER();
                zero_acc(acc); mm128<true>(I0, false, I2, true, wr, wc, lane, acc);
                { bf16* ogp = WSP(bf16, WS_OGDN) + (trow0 + 32 * wr + r) * 512 + h * 128 + 64 * wc + 4 * q;
#pragma unroll
                  for (int i = 0; i < 2; ++i)
#pragma unroll
                    for (int j = 0; j < 4; ++j) { bf16* pp = ogp + (size_t)(16 * i) * 512 + 16 * j; f32x4 v = acc[i][j];
                        if (dir) { const u32x2 pv = *(const u32x2*)pp; v[0] += bflo(pv.x); v[1] += bfhi(pv.x); v[2] += bflo(pv.y); v[3] += bfhi(pv.y); }
                        u32x2 o; o.x = pk2(v[0], v[1]); o.y = pk2(v[2], v[3]); *(u32x2*)pp = o; } } }
                { LAUNDER();
                zero_acc(acc); mm128<true>(I0, false, I3, true, wr, wc, lane, acc);
                unsigned char* qt = F.ws + WS_GQT + ((size_t)chain * 32 + (n - 2)) * 32768;
#pragma unroll
                for (int i = 0; i < 2; ++i) { const int ii = 32 * wr + 16 * i + r; const float egi = s_eg[ii];
#pragma unroll
                    for (int j = 0; j < 4; ++j) { const int mt = 2 * wr + i, ct = 4 * wc + j; const u32x2 qv = *(const LAS u32x2*)(I1 + offe(ii, 64 * wc + 16 * j + 4 * q));
                        u32x2 o; o.x = pk2(egi * bflo(qv.x) - acc[i][j][0], egi * bfhi(qv.x) - acc[i][j][1]); o.y = pk2(egi * bflo(qv.y) - acc[i][j][2], egi * bfhi(qv.y) - acc[i][j][3]);
                        *(u32x2*)(qt + ((size_t)((mt * 4 + (ct >> 1)) * 64 + q * 16 + r)) * 16 + 8 * (ct & 1)) = o; } } }
                LBAR();
            }
        }
    }
#undef LAUNDER
}

__device__ __forceinline__ void phase_scan(Frame& F) {
    const int lane = F.lane, w = F.wave, tid = F.tid;
    for (int it = F.bid; it < 256; it += F.G) {
        if (it < 128) {
            const int chain = (it & 7) * 4 + (it >> 5), dq = (it >> 3) & 3;
            const unsigned char* gm = F.ws + WS_GM + (size_t)chain * NCHUNK * 32768; unsigned char* gc = F.ws + WS_GC + (size_t)chain * NCHUNK * 32768;
            const unsigned char* gcs = gc + (size_t)(2 * dq) * 4096;
            if (w >= 4) {
                const int j = tid - 256; u32x4 sA[10], sB[10], sC[10], sD[10];
#define SCAN_LD(dst, n_) do { _Pragma("unroll") for (int i_ = 0; i_ < 8; ++i_) dst[i_] = *(const u32x4*)(gm + (size_t)(n_) * 32768 + (size_t)(j + 256 * i_) * 16); \
                              _Pragma("unroll") for (int i_ = 0; i_ < 2; ++i_) dst[8 + i_] = *(const u32x4*)(gcs + (size_t)(n_) * 32768 + (size_t)(j + 256 * i_) * 16); } while (0)
#define SCAN_ST(n_, src) do { LAS unsigned char* buf_ = F.lds + ((n_) % 3) * 40960; \
                              _Pragma("unroll") for (int i_ = 0; i_ < 8; ++i_) *(LAS u32x4*)(buf_ + (size_t)(j + 256 * i_) * 16) = src[i_]; \
                              _Pragma("unroll") for (int i_ = 0; i_ < 2; ++i_) *(LAS u32x4*)(buf_ + 32768 + (size_t)(j + 256 * i_) * 16) = src[8 + i_]; \
                              if ((n_) + 4 < NCHUNK) SCAN_LD(src, (n_) + 4); LBAR(); } while (0)
                SCAN_LD(sA, 0); SCAN_LD(sB, 1); SCAN_LD(sC, 2); SCAN_LD(sD, 3);
#pragma unroll 1
                for (int n = 0; n < 32; n += 4) { SCAN_ST(n, sA); SCAN_ST(n + 1, sB); SCAN_ST(n + 2, sC); SCAN_ST(n + 3, sD); }
                SCAN_ST(32, sA); SCAN_ST(33, sB);
#undef SCAN_LD
#undef SCAN_ST
            } else if (w < 2) {
                const int nt = 2 * dq + w;
                bf16x8 sf[4];
#pragma unroll
                for (int s = 0; s < 4; ++s) sf[s] = (bf16x8){0, 0, 0, 0, 0, 0, 0, 0};
#pragma unroll 1
                for (int n = 0; n < NCHUNK; ++n) {
                    LBAR();
                    const LAS unsigned char* buf = F.lds + (n % 3) * 40960; const LAS unsigned char* cb = buf + 32768 + w * 4096;
                    unsigned char* slot = gc + (size_t)n * 32768 + (size_t)nt * 4096; f32x4 acc[8];
#pragma unroll
                    for (int mt = 0; mt < 8; ++mt) { const u32x2 cv = *(const LAS u32x2*)(cb + (mt * 64 + lane) * 8); acc[mt] = (f32x4){bflo(cv.x), bfhi(cv.x), bflo(cv.y), bfhi(cv.y)}; }
#pragma unroll
                    for (int s = 0; s < 4; ++s)
#pragma unroll
                        for (int mt = 0; mt < 8; ++mt) acc[mt] = MFMA16(*(const LAS bf16x8*)(buf + ((mt * 4 + s) * 64 + lane) * 16), sf[s], acc[mt]);
#pragma unroll
                    for (int s = 0; s < 4; ++s) { const u32x4 pk = {pk2(acc[2 * s][0], acc[2 * s][1]), pk2(acc[2 * s][2], acc[2 * s][3]), pk2(acc[2 * s + 1][0], acc[2 * s + 1][1]), pk2(acc[2 * s + 1][2], acc[2 * s + 1][3])};
                        sf[s] = __builtin_bit_cast(bf16x8, pk); *(u32x4*)(slot + (size_t)(s * 64 + lane) * 16) = pk; }
                }
            } else {
#pragma unroll 1
                for (int n = 0; n < NCHUNK; ++n) LBAR();
            }
            LBAR();
#if defined(PROBE_PH) && PROBE_PH == 204
            if (F.bid == 0 && tid == 0) ((volatile LAS unsigned long long*)(F.lds + MISC_OFF + 4608))[5] = __builtin_amdgcn_s_memrealtime();
#endif
        } else {
            const int gidx = (it - 128) * NTHR + tid; const int chain = gidx >> 11, piece = gidx & 2047; const int h = (chain >> 1) & 3, dir = chain & 1;
            const float dec = expf(F.ret_log_decay[dir * 4 + h] * 128.f);
            unsigned char* kv = F.ws + WS_GKV + (size_t)chain * NCHUNK * 32768 + (size_t)piece * 16;
            float st[8];
#pragma unroll
            for (int e = 0; e < 8; ++e) st[e] = 0.f;
#pragma unroll 1
            for (int n0 = 0; n0 < NCHUNK; n0 += 17) { u32x4 v8[17];
#pragma unroll
                for (int j = 0; j < 17; ++j) v8[j] = *(const u32x4*)(kv + (size_t)(n0 + j) * 32768);
#pragma unroll
                for (int j = 0; j < 17; ++j) { float v[8]; unpack8(v8[j], v);
#pragma unroll
                    for (int e = 0; e < 8; ++e) st[e] = dec * st[e] + v[e];
                    *(u32x4*)(kv + (size_t)(n0 + j) * 32768) = pack8(st); } }
        }
    }
}

__device__ __forceinline__ void phase_out(Frame& F) {
    const bf16* P = WSP(bf16, WS_P);
    for (int it = F.bid; it < 512; it += F.G) {
        int tz_ = threadIdx.x; asm volatile("" : "+v"(tz_)); const int tid = tz_, lane = tz_ & 63, w = __builtin_amdgcn_readfirstlane(tz_ >> 6), r = lane & 15, q = lane >> 4;
        const int b = it >> 7, h = (it >> 5) & 3, m = 2 + (it & 31);
        const size_t prow = (size_t)b * RPB + 128 * m + 16 * w + r; const size_t trow = (size_t)b * SEQ + 128 * (m - 2) + 16 * w + r;
        const int il = 16 * w + r;
        bf16x8 fqg[2][4], fqr[4];
#pragma unroll
        for (int dir = 0; dir < 2; ++dir) { const int chain = (b * NH + h) * 2 + dir, n = dir ? 35 - m : m; const unsigned char* qt = F.ws + WS_GQT + ((size_t)chain * 32 + (n - 2)) * 32768;
#pragma unroll
            for (int s = 0; s < 4; ++s) fqg[dir][s] = *(const bf16x8*)(qt + (size_t)((w * 4 + s) * 64 + lane) * 16); }
        { const bf16* qp = P + 4 * PGRP + prow * 512 + h * 128;
#pragma unroll
          for (int s = 0; s < 4; ++s) fqr[s] = *(const bf16x8*)(qp + 32 * s + 8 * q); }
        u32x2 rog[8], ror[8];
        { const bf16* a = WSP(bf16, WS_OGDN) + trow * 512 + h * 128 + 4 * q; const bf16* c = WSP(bf16, WS_ORET) + trow * 512 + h * 128 + 4 * q;
#pragma unroll
          for (int nt = 0; nt < 8; ++nt) { rog[nt] = *(const u32x2*)(a + 16 * nt); ror[nt] = *(const u32x2*)(c + 16 * nt); } }
        {
            u32x4 v[4][4];
#pragma unroll
            for (int k = 0; k < 4; ++k) { const int dir = k & 1; const int chain = (b * NH + h) * 2 + dir, n = dir ? 35 - m : m;
                const unsigned char* sp = F.ws + (k < 2 ? WS_GC : WS_GKV) + ((size_t)chain * NCHUNK + (n - 1)) * 32768;
#pragma unroll
                for (int i = 0; i < 4; ++i) v[k][i] = *(const u32x4*)(sp + (size_t)(tid + 512 * i) * 16); }
#pragma unroll
            for (int k = 0; k < 4; ++k)
#pragma unroll
                for (int i = 0; i < 4; ++i) *(LAS u32x4*)(F.lds + k * 32768 + (tid + 512 * i) * 16) = v[k][i];
        }
        f32x4 og[8], orr[8];
#pragma unroll
        for (int nt = 0; nt < 8; ++nt) { og[nt] = (f32x4){bflo(rog[nt].x), bfhi(rog[nt].x), bflo(rog[nt].y), bfhi(rog[nt].y)}; orr[nt] = (f32x4){bflo(ror[nt].x), bfhi(ror[nt].x), bflo(ror[nt].y), bfhi(ror[nt].y)}; }
        LBAR();
#pragma unroll
        for (int dir = 0; dir < 2; ++dir) {
            {
                const LAS unsigned char* sp = F.lds + dir * 32768;
#pragma unroll
                for (int s = 0; s < 4; ++s)
#pragma unroll
                    for (int nt = 0; nt < 8; ++nt) og[nt] = MFMA16(*(const LAS bf16x8*)(sp + ((nt * 4 + s) * 64 + lane) * 16), fqg[dir][s], og[nt]);
            }
            {
                const LAS unsigned char* sp = F.lds + (2 + dir) * 32768;
                f32x4 t[8];
#pragma unroll
                for (int nt = 0; nt < 8; ++nt) t[nt] = (f32x4){0.f, 0.f, 0.f, 0.f};
#pragma unroll
                for (int s = 0; s < 4; ++s)
#pragma unroll
                    for (int nt = 0; nt < 8; ++nt) t[nt] = MFMA16(*(const LAS bf16x8*)(sp + ((nt * 4 + s) * 64 + lane) * 16), fqr[s], t[nt]);
                const float lg = F.ret_log_decay[dir * 4 + h]; const float dcy = expf(lg * (float)(dir ? 128 - il : il + 1));
#pragma unroll
                for (int nt = 0; nt < 8; ++nt) orr[nt] = orr[nt] + t[nt] * dcy;
            }
        }
        {
            float s1 = 0.f;
#pragma unroll
            for (int nt = 0; nt < 8; ++nt) s1 += (orr[nt][0] + orr[nt][1]) + (orr[nt][2] + orr[nt][3]);
            s1 += __shfl_xor(s1, 16); s1 += __shfl_xor(s1, 32); const float mean = s1 * (1.f / 128.f);
            float s2 = 0.f, s3 = 0.f;
#pragma unroll
            for (int nt = 0; nt < 8; ++nt)
#pragma unroll
                for (int e = 0; e < 4; ++e) { const float d = orr[nt][e] - mean; s2 += d * d; s3 += og[nt][e] * og[nt][e]; }
            s2 += __shfl_xor(s2, 16); s2 += __shfl_xor(s2, 32); s3 += __shfl_xor(s3, 16); s3 += __shfl_xor(s3, 32);
            const float rs_r = 1.0f / sqrtf(s2 * (1.f / 128.f) + EPS), rs_g = 1.0f / sqrtf(s3 * (1.f / 128.f) + EPS);
            const bf16* rg = P + 5 * PGRP + prow * 512 + h * 128 + 4 * q; const bf16* gz = P + 7 * PGRP + prow * 512 + h * 128 + 4 * q;
            bf16* ry = WSP(bf16, WS_RETY) + trow * 512 + h * 128 + 4 * q; bf16* gy = WSP(bf16, WS_GDNY) + trow * 512 + h * 128 + 4 * q;
#pragma unroll
            for (int nt = 0; nt < 8; ++nt) { const u32x2 a = *(const u32x2*)(rg + 16 * nt), c = *(const u32x2*)(gz + 16 * nt);
                const float ga[4] = {bflo(a.x), bfhi(a.x), bflo(a.y), bfhi(a.y)}, gc4[4] = {bflo(c.x), bfhi(c.x), bflo(c.y), bfhi(c.y)};
                const f32x4 wr4 = *(const f32x4*)(F.ret_gn_w + h * 128 + 16 * nt + 4 * q), wg4 = *(const f32x4*)(F.gdn_norm_w + h * 128 + 16 * nt + 4 * q);
                float yr[4], yg[4];
#pragma unroll
                for (int e = 0; e < 4; ++e) { yr[e] = (orr[nt][e] - mean) * rs_r * wr4[e] * siluf_(ga[e]); yg[e] = og[nt][e] * rs_g * wg4[e] * siluf_(gc4[e]); }
                u32x2 o1, o2; o1.x = pk2(yr[0], yr[1]); o1.y = pk2(yr[2], yr[3]); o2.x = pk2(yg[0], yg[1]); o2.y = pk2(yg[2], yg[3]);
                *(u32x2*)(ry + 16 * nt) = o1; *(u32x2*)(gy + 16 * nt) = o2; }
        }
        LBAR();
    }
}

struct SchedMerge {
    const char *A0, *A1, *B0, *B1; int G, c;
    __device__ __forceinline__ bool next(int i, pg8::Unit& u) const {
        const int L = (i >> 1) * G + c; if (L >= 256) return false; const int term = i & 1;
        const int xcd = L % 8, off = L / 8; const int w = xcd * 32 + off;
        u.pm = w >> 2; u.pn = w & 3; u.e = term; u.base = 0;
        u.A = (term ? A1 : A0) + (size_t)u.pm * 256 * 512 * 2; u.B = (term ? B1 : B0) + (size_t)u.pn * 256 * 512 * 2; return true; }
    __device__ __forceinline__ int row_index(const pg8::Unit&, int r) const { return r; }
};
struct EpiMerge {
    const bf16* GATES; bf16* TMP; bf16* MERGED;
    __device__ __forceinline__ void operator()(const f32x4 (&acc)[2][2][4][2], const pg8::Unit& u, int wr, int wc, int fr, int fq) const {
#pragma unroll
        for (int ai = 0; ai < 2; ++ai) {
            u32x4 gv[4][2], pv[4][2];
#pragma unroll
            for (int m = 0; m < 4; ++m) { const size_t row = (size_t)u.pm * 256 + ai * 128 + wr * 64 + m * 16 + fr;
#pragma unroll
                for (int bj = 0; bj < 2; ++bj) { const int col = u.pn * 256 + bj * 128 + wc * 32 + 8 * fq;
                    gv[m][bj] = *(const u32x4*)(GATES + row * 2048 + u.e * 1024 + col);
                    if (u.e != 0) pv[m][bj] = *(const u32x4*)(TMP + row * DM + col); } }
#pragma unroll
            for (int m = 0; m < 4; ++m) { const size_t row = (size_t)u.pm * 256 + ai * 128 + wr * 64 + m * 16 + fr;
#pragma unroll
                for (int bj = 0; bj < 2; ++bj) { const int col = u.pn * 256 + bj * 128 + wc * 32 + 8 * fq;
                    float g[8]; unpack8(gv[m][bj], g);
                    float v[8] = {acc[ai][bj][m][0][0], acc[ai][bj][m][0][1], acc[ai][bj][m][0][2], acc[ai][bj][m][0][3], acc[ai][bj][m][1][0], acc[ai][bj][m][1][1], acc[ai][bj][m][1][2], acc[ai][bj][m][1][3]};
                    if (u.e == 0) {
#pragma unroll
                        for (int i = 0; i < 8; ++i) v[i] *= g[i];
                        *(u32x4*)(TMP + row * DM + col) = pack8(v);
                    } else { float p[8]; unpack8(pv[m][bj], p);
#pragma unroll
                        for (int i = 0; i < 8; ++i) v[i] = p[i] + v[i] * g[i];
                        *(u32x4*)(MERGED + row * DM + col) = pack8(v); } } }
        }
    }
};
struct SchedDense {
    const char *A, *B; int nM, nN, K, G, c;
    __device__ __forceinline__ bool next(int i, pg8::Unit& u) const {
        const int L = i * G + c; const int nwg = nM * nN; if (L >= nwg) return false;
        int w = L; if (nwg % 8 == 0) { const int xcd = L % 8, off = L / 8; w = xcd * (nwg / 8) + off; }
        u.pm = w / nN; u.pn = w % nN; u.e = 0; u.base = 0; u.A = A + (size_t)u.pm * 256 * K * 2; u.B = B + (size_t)u.pn * 256 * K * 2; return true; }
    __device__ __forceinline__ int row_index(const pg8::Unit&, int r) const { return r; }
};
struct EpiBf16Store { bf16* O; int ldc;
    __device__ __forceinline__ void operator()(const f32x4 (&acc)[2][2][4][2], const pg8::Unit& u, int wr, int wc, int fr, int fq) const {
#pragma unroll
        for (int ai = 0; ai < 2; ++ai)
#pragma unroll
            for (int m = 0; m < 4; ++m) { const size_t row = (size_t)u.pm * 256 + ai * 128 + wr * 64 + m * 16 + fr;
#pragma unroll
                for (int bj = 0; bj < 2; ++bj) { const int col = u.pn * 256 + bj * 128 + wc * 32 + 8 * fq; const f32x4 v0 = acc[ai][bj][m][0], v1 = acc[ai][bj][m][1];
                    u32x4 w; w.x = pg8::cvt_pk_bf16(v0[0], v0[1]); w.y = pg8::cvt_pk_bf16(v0[2], v0[3]); w.z = pg8::cvt_pk_bf16(v1[0], v1[1]); w.w = pg8::cvt_pk_bf16(v1[2], v1[3]);
                    *(u32x4*)(O + row * ldc + col) = w; } }
    }
};

__device__ __forceinline__ void load_row_bf16(const bf16* p, int lane, float (&v)[16]) { float a[8], b[8]; unpack8(*(const u32x4*)(p + 8 * lane), a); unpack8(*(const u32x4*)(p + 512 + 8 * lane), b);
#pragma unroll
    for (int i = 0; i < 8; ++i) { v[i] = a[i]; v[8 + i] = b[i]; } }
__device__ __forceinline__ void load_row_f32(const float* p, int lane, float (&v)[16]) {
#pragma unroll
    for (int q = 0; q < 4; ++q) { const f32x4 a = *(const f32x4*)(p + (q >> 1) * 512 + 8 * lane + 4 * (q & 1)); v[4 * q] = a.x; v[4 * q + 1] = a.y; v[4 * q + 2] = a.z; v[4 * q + 3] = a.w; } }
__device__ __forceinline__ void store_row_f32(float* p, int lane, const float (&v)[16]) {
#pragma unroll
    for (int q = 0; q < 4; ++q) *(f32x4*)(p + (q >> 1) * 512 + 8 * lane + 4 * (q & 1)) = (f32x4){v[4 * q], v[4 * q + 1], v[4 * q + 2], v[4 * q + 3]}; }
__device__ __forceinline__ void compute_x1(Frame& F, int t, float (&x1)[16]) {
    const int b = t / SEQ; const float* mod = WSP(float, WS_MOD) + b * 6144;
    const bf16* mop = WSP(bf16, WS_MO) + (size_t)t * DM;
    const u32x4 m0 = *(const u32x4*)(mop + 8 * F.lane), m1 = *(const u32x4*)(mop + 512 + 8 * F.lane);
    float ss = 0.f;
    { float a[8], c[8]; unpack8(m0, a); unpack8(m1, c);
#pragma unroll
      for (int i = 0; i < 8; ++i) ss += a[i] * a[i] + c[i] * c[i]; }
    const float rstd = 1.0f / sqrtf(wave_sum(ss) * (1.f / DM) + EPS);
#pragma unroll
    for (int hf = 0; hf < 2; ++hf) {
        const int c0 = hf * 512 + 8 * F.lane; float mo[8]; unpack8(hf ? m1 : m0, mo);
        const float* xp = F.x + (size_t)t * DM + c0; const float* wp = F.n_mix_post + c0; const float* gp = mod + 2 * DM + c0;
#pragma unroll
        for (int q = 0; q < 2; ++q) { const f32x4 xv = *(const f32x4*)(xp + 4 * q), wv = *(const f32x4*)(wp + 4 * q), g1 = *(const f32x4*)(gp + 4 * q);
#pragma unroll
            for (int e = 0; e < 4; ++e) x1[hf * 8 + 4 * q + e] = xv[e] + g1[e] * (mo[4 * q + e] * rstd * wv[e]); }
    }
}
__device__ __forceinline__ void route_token(Frame& F, int t, float logit, LAS unsigned* lcnt, LAS u32x2* stage, unsigned* cnt, int2* list) {
    const float score = 1.f / (1.f + expf(-logit)); const float biased = score + F.router_bias[F.lane];
    int rk = 0;
#pragma unroll
    for (int o = 0; o < 8; ++o) { const int src = (F.lane & ~7) | o; const float ov = __shfl(biased, src); rk += ((ov > biased) | ((ov == biased) & (src < F.lane))) ? 1 : 0; }
    float gs = rk < 2 ? biased : 0.f; gs += __shfl_xor(gs, 1); gs += __shfl_xor(gs, 2); gs += __shfl_xor(gs, 4);
    int grk = 0; const int myg = F.lane >> 3;
#pragma unroll
    for (int o = 0; o < 8; ++o) { const float ov = __shfl(gs, o * 8); grk += ((ov > gs) | ((ov == gs) & (o < myg))) ? 1 : 0; }
    const bool keep = grk < 4;
    const float cand = keep ? biased : -__builtin_inff();
    int erk = 0;
#pragma unroll
    for (int o = 0; o < 64; ++o) { const float ov = __builtin_bit_cast(float, __builtin_amdgcn_readlane(__builtin_bit_cast(int, cand), o)); erk += ((ov > cand) | ((ov == cand) & (o < F.lane))) ? 1 : 0; }
    const bool sel = keep && erk < TOPK;
    const float ssum = wave_sum(sel ? score : 0.f);
    if (sel) { const float w = score / ssum * 2.5f; const unsigned pos = __hip_atomic_fetch_add(lcnt + F.lane, 1u, __ATOMIC_RELAXED, __HIP_MEMORY_SCOPE_WORKGROUP);
        if (pos < 48u) stage[F.lane * 48 + pos] = (u32x2){(unsigned)(t * 8 + erk), __float_as_uint(w)};
        else { const unsigned gp = atomicAdd(cnt + 64 * F.lane, 1u); list[(size_t)F.lane * NT + gp] = make_int2(t * 8 + erk, __float_as_int(w)); } }
}
__device__ __forceinline__ void phase_route(Frame& F) {
    constexpr int HST = 2064;
    LAS unsigned char* hhi = F.lds;
    LAS unsigned char* hlo = F.lds + 16 * HST;
    LAS float* part = (LAS float*)(F.lds + 2 * 16 * HST);
    LAS u32x2* stage = (LAS u32x2*)(F.lds + 2 * 16 * HST + 32768);
    LAS unsigned* lcnt = (LAS unsigned*)(F.lds + MISC_OFF + 1024);
    unsigned* cnt = F.ctl + CW_CNT; int2* list = WSP(int2, WS_LIST);
    const int r = F.lane & 15, q = F.lane >> 4, kbase = F.wave * 128;
    bf16x8 wh[4][4]; u32x2 wl8[4][4];
#pragma unroll
    for (int ft = 0; ft < 4; ++ft) {
        asm volatile("" ::: "memory");
#pragma unroll
        for (int s = 0; s < 4; ++s) { float wv[8];
#pragma unroll
            for (int j = 0; j < 8; ++j) wv[j] = F.w_router[(size_t)(kbase + 32 * s + 8 * q + j) * NEXP + 16 * ft + r];
            unsigned hi[8];
#pragma unroll
            for (int j = 0; j < 8; ++j) hi[j] = f2bf(wv[j]);
            wh[ft][s] = __builtin_bit_cast(bf16x8, (u32x4){hi[0] | (hi[1] << 16), hi[2] | (hi[3] << 16), hi[4] | (hi[5] << 16), hi[6] | (hi[7] << 16)});
            float lf[8];
#pragma unroll
            for (int j = 0; j < 8; ++j) lf[j] = (wv[j] - bf2f(hi[j])) * 4096.0f;
            unsigned p0 = __builtin_amdgcn_cvt_pk_bf8_f32(lf[0], lf[1], 0u, false); p0 = __builtin_amdgcn_cvt_pk_bf8_f32(lf[2], lf[3], p0, true);
            unsigned p1 = __builtin_amdgcn_cvt_pk_bf8_f32(lf[4], lf[5], 0u, false); p1 = __builtin_amdgcn_cvt_pk_bf8_f32(lf[6], lf[7], p1, true);
            wl8[ft][s] = (u32x2){p0, p1}; } }
    for (int g64 = F.bid; g64 < NT / 64; g64 += F.G) {
        if (F.tid < 64) lcnt[F.tid] = 0u;
        __syncthreads();
#pragma unroll 1
        for (int grp = 0; grp < 4; ++grp) {
#pragma unroll 1
            for (int tw = 0; tw < 2; ++tw) {
                const int slot = 2 * F.wave + tw; const int t = g64 * 64 + grp * 16 + slot; const int b = t / SEQ; const float* mod = WSP(float, WS_MOD) + b * 6144;
                float x1[16]; compute_x1(F, t, x1);
                float ss = 0.f;
#pragma unroll
                for (int i = 0; i < 16; ++i) ss += x1[i] * x1[i];
                const float rstd = 1.0f / sqrtf(wave_sum(ss) * (1.f / DM) + EPS);
                bf16* d = WSP(bf16, WS_H2) + (size_t)t * DM;
#pragma unroll
                for (int hf = 0; hf < 2; ++hf) {
                    asm volatile("" ::: "memory");
                    const int c0 = hf * 512 + 8 * F.lane; float h2[8];
#pragma unroll
                    for (int qq = 0; qq < 2; ++qq) { const f32x4 wv = *(const f32x4*)(F.n_ffn_pre + c0 + 4 * qq), sh = *(const f32x4*)(mod + 3 * DM + c0 + 4 * qq), sc = *(const f32x4*)(mod + 4 * DM + c0 + 4 * qq);
#pragma unroll
                        for (int e = 0; e < 4; ++e) h2[4 * qq + e] = x1[hf * 8 + 4 * qq + e] * rstd * wv[e] * (1.f + sc[e]) + sh[e]; }
                    const u32x4 hp = pack8(h2); *(u32x4*)(d + c0) = hp;
                    float lo8[8]; { float hb[8]; unpack8(hp, hb);
#pragma unroll
                        for (int e = 0; e < 8; ++e) lo8[e] = h2[e] - hb[e]; }
                    *(LAS u32x4*)(hhi + slot * HST + c0 * 2) = hp; *(LAS u32x4*)(hlo + slot * HST + c0 * 2) = pack8(lo8);
                }
            }
            LBAR();
            {
                typedef float f32x2v __attribute__((ext_vector_type(2)));
                f32x4 acc[4], acc2[4];
#pragma unroll
                for (int ft = 0; ft < 4; ++ft) { acc[ft] = (f32x4){0.f, 0.f, 0.f, 0.f}; acc2[ft] = (f32x4){0.f, 0.f, 0.f, 0.f}; }
#pragma unroll
                for (int s = 0; s < 4; ++s) { const int off = r * HST + (kbase + 32 * s + 8 * q) * 2;
                    const bf16x8 bh = *(const LAS bf16x8*)(hhi + off), bl = *(const LAS bf16x8*)(hlo + off);
#pragma unroll
                    for (int ft = 0; ft < 4; ++ft) {
                        const f32x2v l0 = __builtin_amdgcn_cvt_pk_f32_bf8(wl8[ft][s].x, false), l1 = __builtin_amdgcn_cvt_pk_f32_bf8(wl8[ft][s].x, true), l2 = __builtin_amdgcn_cvt_pk_f32_bf8(wl8[ft][s].y, false), l3 = __builtin_amdgcn_cvt_pk_f32_bf8(wl8[ft][s].y, true);
                        const bf16x8 wlo = __builtin_bit_cast(bf16x8, (u32x4){pk2(l0.x, l0.y), pk2(l1.x, l1.y), pk2(l2.x, l2.y), pk2(l3.x, l3.y)});
                        acc[ft] = MFMA16(wh[ft][s], bh, acc[ft]); acc[ft] = MFMA16(wh[ft][s], bl, acc[ft]); acc2[ft] = MFMA16(wlo, bh, acc2[ft]); } }
#pragma unroll
                for (int ft = 0; ft < 4; ++ft)
#pragma unroll
                    for (int e = 0; e < 4; ++e) part[(F.wave * 64 + 16 * ft + 4 * q + e) * 16 + r] = acc[ft][e] + acc2[ft][e] * (1.0f / 4096.0f);
            }
            LBAR();
#pragma unroll 1
            for (int tw = 0; tw < 2; ++tw) { const int slot = 2 * F.wave + tw; float logit = 0.f;
#pragma unroll
                for (int w = 0; w < 8; ++w) logit += part[(w * 64 + F.lane) * 16 + slot];
                route_token(F, g64 * 64 + grp * 16 + slot, logit, lcnt, stage, cnt, list); }
        }
        __syncthreads();
        if (F.tid < 64) { const unsigned n = lcnt[F.tid] < 48u ? lcnt[F.tid] : 48u; lcnt[F.tid] = n; lcnt[64 + F.tid] = atomicAdd(cnt + 64 * F.tid, n); }
        __syncthreads();
        { const int e = F.tid >> 3; const unsigned n = lcnt[e], base = lcnt[64 + e];
          for (unsigned j = F.tid & 7; j < n; j += 8) { const u32x2 v = stage[e * 48 + j]; list[(size_t)e * NT + base + j] = make_int2((int)v.x, (int)v.y); } }
        __syncthreads();
    }
}

__device__ __forceinline__ void build_tile_prefix(Frame& F, LAS int* tp) {
    __syncthreads();
    if (F.tid == 0) { int s = 0; const unsigned* cnt = F.ctl + CW_CNT; for (int e = 0; e < 64; ++e) { const int ce = (int)__hip_atomic_load(cnt + 64 * e, __ATOMIC_RELAXED, __HIP_MEMORY_SCOPE_AGENT); tp[96 + e] = ce; tp[e] = s; s += (ce + 255) >> 8; } tp[64] = s; tp[65] = s + 64;
        const int x = F.bid & 7; int l = 0; for (int k = 0; k < 8; ++k) { tp[80 + k] = l; l += tp[x + 8 * k + 1] - tp[x + 8 * k]; } tp[88] = l; tp[89] = l + 8; }
    __syncthreads();
}
struct SchedMoe {
    const char* A; const char* B; const int2* list; const unsigned* cnt; const LAS int* tp; int npn, K, G, c; size_t bstride  ; int bcol0  ; bool gather;
    __device__ __forceinline__ bool next(int i, pg8::Unit& u) const {
        int e, pm;
        if ((G & 7) == 0) {
            const int x = c & 7, W = G >> 3, L = i * W + (c >> 3); const int nt = __builtin_amdgcn_readfirstlane(tp[89]); if (L >= nt * npn) return false;
            const int tl = L / npn; u.pn = L % npn; int k = 0;
            for (int q = 8; q >= 1; q >>= 1) if (k + q <= 8 && __builtin_amdgcn_readfirstlane(tp[80 + k + q]) <= tl) k += q;
            k = __builtin_amdgcn_readfirstlane(k); const int off = tl - __builtin_amdgcn_readfirstlane(tp[80 + k]);
            if (k < 8) { e = x + 8 * k; pm = off; } else { e = 64; pm = x + 8 * off; }
        } else {
            const int L = i * G + c; const int ntile = __builtin_amdgcn_readfirstlane(tp[65]); if (L >= ntile * npn) return false;
            const int tile = L / npn; u.pn = L % npn; e = 0;
            for (int q = 64; q >= 1; q >>= 1) if (e + q <= 64 && __builtin_amdgcn_readfirstlane(tp[e + q]) <= tile) e += q;
            e = __builtin_amdgcn_readfirstlane(e); pm = tile - __builtin_amdgcn_readfirstlane(tp[e]);
        }
        u.e = e; u.pm = pm; u.base = (e < 64 ? (__builtin_amdgcn_readfirstlane(tp[e < 64 ? e : 0]) + pm) * 256 : SLOT_SH + pm * 256);
        u.A = gather ? A : A + (size_t)u.base * K * 2; u.B = B + (size_t)e * bstride + (size_t)(bcol0 + u.pn * 256) * K * 2; return true; }
    __device__ __forceinline__ int row_index(const pg8::Unit& u, int r) const {
        if (u.e == 64) return u.pm * 256 + r;
        const unsigned tok = (unsigned)list[(size_t)u.e * NT + u.pm * 256 + r].x >> 3; return (int)(tok < (unsigned)NT ? tok : 0u); }
};
struct EpiUp { bf16* HMID;
    __device__ __forceinline__ void operator()(const f32x4 (&acc)[2][2][4][2], const pg8::Unit& u, int wr, int wc, int fr, int fq) const {
#pragma unroll
        for (int ai = 0; ai < 2; ++ai)
#pragma unroll
            for (int m = 0; m < 4; ++m) { const size_t slot = (size_t)u.base + ai * 128 + wr * 64 + m * 16 + fr;
#pragma unroll
                for (int bj = 0; bj < 2; ++bj) { const int hid = u.pn * 128 + bj * 64 + wc * 16 + fq * 4; const f32x4 g = acc[ai][bj][m][0], up = acc[ai][bj][m][1];
                    u32x2 w; w.x = pg8::cvt_pk_bf16(siluf_(g[0]) * up[0], siluf_(g[1]) * up[1]); w.y = pg8::cvt_pk_bf16(siluf_(g[2]) * up[2], siluf_(g[3]) * up[3]);
                    *(u32x2*)(HMID + slot * DEXP + hid) = w; } }
    }
};
struct EpiDown { bf16* YB; float* OUT; const int2* list; const LAS int* tp; int half;
    __device__ __forceinline__ void operator()(const f32x4 (&acc)[2][2][4][2], const pg8::Unit& u, int wr, int wc, int fr, int fq) const {
        if (u.e == 64) {
#pragma unroll
            for (int ai = 0; ai < 2; ++ai)
#pragma unroll
                for (int m = 0; m < 4; ++m) { const int idx = u.pm * 256 + ai * 128 + wr * 64 + m * 16 + fr; float* o = OUT + (size_t)idx * DM + half * 512 + u.pn * 256 + wc * 32 + 8 * fq;
#pragma unroll
                    for (int bj = 0; bj < 2; ++bj) { *(f32x4*)(o + bj * 128) = acc[ai][bj][m][0]; *(f32x4*)(o + bj * 128 + 4) = acc[ai][bj][m][1]; } }
        } else {
#ifdef EXP_NO_EPI
            return;
#endif
            const int n = __builtin_amdgcn_readfirstlane(tp[96 + u.e]); int2 dw[2][4];
#pragma unroll
            for (int ai = 0; ai < 2; ++ai)
#pragma unroll
                for (int m = 0; m < 4; ++m) { int idx = u.pm * 256 + ai * 128 + wr * 64 + m * 16 + fr; idx = idx < n ? idx : n - 1; dw[ai][m] = list[(size_t)u.e * NT + idx]; }
#pragma unroll
            for (int ai = 0; ai < 2; ++ai)
#pragma unroll
                for (int m = 0; m < 4; ++m) { const int idx = u.pm * 256 + ai * 128 + wr * 64 + m * 16 + fr;
#ifdef EXP_NO_YB
                    if (false) {
#else
                    if (idx < n) {
#endif
                        const float w = __int_as_float(dw[ai][m].y); bf16* o = YB + (size_t)dw[ai][m].x * 512 + u.pn * 256 + wc * 32 + 8 * fq;
#pragma unroll
                        for (int bj = 0; bj < 2; ++bj) { const f32x4 v0 = acc[ai][bj][m][0] * w, v1 = acc[ai][bj][m][1] * w;
                            u32x4 q; q.x = pg8::cvt_pk_bf16(v0[0], v0[1]); q.y = pg8::cvt_pk_bf16(v0[2], v0[3]); q.z = pg8::cvt_pk_bf16(v1[0], v1[1]); q.w = pg8::cvt_pk_bf16(v1[2], v1[3]);
                            *(u32x4*)(o + bj * 128) = q; } } }
        }
    }
};
__device__ __forceinline__ void phase_combine(Frame& F, int half) {
    const int gw = F.bid * NWAVES + F.wave, NGW = F.G * NWAVES; const bf16* YB = WSP(bf16, WS_YB);
    for (int t = gw; t < NT; t += NGW) {
        float* o = F.out + (size_t)t * DM + half * 512 + 8 * F.lane; f32x4 a = *(const f32x4*)o, c = *(const f32x4*)(o + 4);
#pragma unroll
        for (int k = 0; k < 8; ++k) { float v[8]; unpack8(*(const u32x4*)(YB + ((size_t)t * 8 + k) * 512 + 8 * F.lane), v); a.x += v[0]; a.y += v[1]; a.z += v[2]; a.w += v[3]; c.x += v[4]; c.y += v[5]; c.z += v[6]; c.w += v[7]; }
        *(f32x4*)o = a; *(f32x4*)(o + 4) = c;
    }
}
__device__ __forceinline__ void phase_final(Frame& F) {
    const int gw = F.bid * NWAVES + F.wave, NGW = F.G * NWAVES; const bf16* YB = WSP(bf16, WS_YB);
    for (int t = gw; t < NT; t += NGW) {
        const int b = t / SEQ; const float* mod = WSP(float, WS_MOD) + b * 6144;
        float mv[16]; load_row_f32(F.out + (size_t)t * DM, F.lane, mv);
#pragma unroll
        for (int k = 0; k < 8; ++k) { float v[8]; unpack8(*(const u32x4*)(YB + ((size_t)t * 8 + k) * 512 + 8 * F.lane), v);
#pragma unroll
            for (int i = 0; i < 8; ++i) mv[8 + i] += v[i]; }
        float ss = 0.f;
#pragma unroll
        for (int i = 0; i < 16; ++i) ss += mv[i] * mv[i];
        const float rstd = 1.0f / sqrtf(wave_sum(ss) * (1.f / DM) + EPS);
        float x1[16]; compute_x1(F, t, x1);
        float wv[16], g2[16]; load_row_f32(F.n_ffn_post, F.lane, wv); load_row_f32(mod + 5 * DM, F.lane, g2);
        float o[16];
#pragma unroll
        for (int i = 0; i < 16; ++i) o[i] = x1[i] + g2[i] * (mv[i] * rstd * wv[i]);
        store_row_f32(F.out + (size_t)t * DM, F.lane, o);
    }
}

constexpr int N_PHASES = 16;
__global__ void __launch_bounds__(NTHR, 2) fwd(Args args) {
    extern __shared__ __attribute__((aligned(16))) unsigned char lds_raw[];
    Frame F; F.lds = (LAS unsigned char*)lds_raw; F.tid = threadIdx.x; F.lane = F.tid & 63; F.wave = __builtin_amdgcn_readfirstlane(F.tid >> 6); F.G = gridDim.x; F.bid = blockIdx.x;
    F.x = args.in[0]; F.c = args.in[1]; F.ctx = args.in[2]; F.c_ctx = args.in[3]; F.w_mod = args.in[4]; F.b_mod = args.in[5]; F.n_mix_pre = args.in[6]; F.n_mix_post = args.in[7];
    F.n_ffn_pre = args.in[8]; F.n_ffn_post = args.in[9]; F.w_in = args.in[10]; F.gdn_conv = args.in[11]; F.ret_log_decay = args.in[12]; F.gdn_a_log = args.in[13]; F.gdn_dt_bias = args.in[14];
    F.ret_gn_w = args.in[15]; F.gdn_norm_w = args.in[16]; F.w_ret_out = args.in[17]; F.w_gdn_out = args.in[18]; F.w_o = args.in[19]; F.w_router = args.in[20]; F.router_bias = args.in[21];
    F.w_gate = args.in[22]; F.w_up = args.in[23]; F.w_down = args.in[24]; F.w_sh_gate = args.in[25]; F.w_sh_up = args.in[26]; F.w_sh_down = args.in[27];
    F.out = args.out; F.ws = args.ws; F.ctl = (unsigned*)(args.ws + WS_CTL);
    volatile LAS unsigned* MISC = (volatile LAS unsigned*)(F.lds + MISC_OFF);
    if (F.tid < 64) MISC[F.tid] = 0u;
    __syncthreads();
#if MK_ONE_LAUNCH
    XcdBarrier bar = xcd_barrier_post(F.ctl + CW_BAR, MISC + 8);
#define SEAM() xcd_barrier(bar)
#else
#define SEAM() do {} while (0)
#endif
    const int lo = args.ph_lo, hi = args.ph_hi;
#ifndef PHM
#define PHM 0xffff
#endif
#ifndef DUP
#define DUP -1
#endif
#define IN(k) (((PHM >> (k)) & 1) && lo <= (k) && (k) < hi)
    LAS int* tp = (LAS int*)(F.lds + MISC_OFF + 256);
#ifndef PROBE_PH
#define PROBE_PH -1
#endif
#ifdef PROBE_A
#define PROBE_IA PROBE_A
#define PROBE_IB PROBE_B
#else
#define PROBE_IA (PROBE_PH % 100)
#define PROBE_IB ((PROBE_PH % 100) + 1)
#endif
    volatile LAS unsigned long long* tsl = (volatile LAS unsigned long long*)(F.lds + MISC_OFF + 4608);
#define STAMP(k) do { if (PROBE_PH >= 0 && F.bid == 0 && F.tid == 0 && !(PROBE_PH == 204 && (k) == 5)) tsl[k] = __builtin_amdgcn_s_memrealtime(); } while (0)

    STAMP(0);
    if (IN(0)) _Pragma("unroll") for (int rep_ = 0; rep_ < ((DUP == 0) ? 2 : 1); ++rep_) { phase_prologue(F); SEAM(); }
    STAMP(1);
    if (IN(1)) _Pragma("unroll") for (int rep_ = 0; rep_ < ((DUP == 1) ? 2 : 1); ++rep_) { phase_norm1(F);
        if (F.G >= 64 && F.bid < 32) { SchedCtx S{(const char*)WSP(bf16, WS_HX), (const char*)WSP(bf16, WS_WIN), F.bid >> 3, F.bid & 7}; EpiIn E{WSP(bf16, WS_P), (bf16*)F.out, WSP(float2, WS_ROPE)};
            pg8::gemm_phase<EpiIn, SchedCtx, false, SP2>(F.lds, DM, S, E); }
        SEAM(); }
    STAMP(2);
    if (IN(2)) _Pragma("unroll") for (int rep_ = 0; rep_ < ((DUP == 2) ? 2 : 1); ++rep_) {
        SchedIn S{(const char*)WSP(bf16, WS_HX), (const char*)WSP(bf16, WS_WIN), F.G, F.bid};
        EpiIn E{WSP(bf16, WS_P), (bf16*)F.out, WSP(float2, WS_ROPE)};
        pg8::gemm_phase<EpiIn, SchedIn, false, SP2>(F.lds, DM, S, E); SEAM();
    }
    STAMP(3);
    if (IN(3)) _Pragma("unroll") for (int rep_ = 0; rep_ < ((DUP == 3) ? 2 : 1); ++rep_) { phase_prep(F); SEAM(); }
    STAMP(4);
    if (IN(4)) _Pragma("unroll") for (int rep_ = 0; rep_ < ((DUP == 4) ? 2 : 1); ++rep_) { phase_scan(F); SEAM(); }
    STAMP(5);
    if (IN(5)) _Pragma("unroll") for (int rep_ = 0; rep_ < ((DUP == 5) ? 2 : 1); ++rep_) { phase_out(F); SEAM(); }
    STAMP(6);
    if (IN(6)) _Pragma("unroll") for (int rep_ = 0; rep_ < ((DUP == 6) ? 2 : 1); ++rep_) {
        SchedMerge S{(const char*)WSP(bf16, WS_RETY), (const char*)WSP(bf16, WS_GDNY), (const char*)WSP(bf16, WS_WRO), (const char*)WSP(bf16, WS_WGO), F.G, F.bid};
        EpiMerge E{(const bf16*)F.out, WSP(bf16, WS_TMP), WSP(bf16, WS_MERGED)};
        pg8::gemm_phase<EpiMerge, SchedMerge, false, SP2>(F.lds, 512, S, E);
        STAMP(15);
        if (rep_ == 0) { _Pragma("unroll") for (int r2_ = 0; r2_ < ((DUP == 16) ? 2 : 1); ++r2_) phase_moe_weights(F); }
        SEAM();
    }
    STAMP(7);
    if (IN(7)) _Pragma("unroll") for (int rep_ = 0; rep_ < ((DUP == 7) ? 2 : 1); ++rep_) {
        SchedDense S{(const char*)WSP(bf16, WS_MERGED), (const char*)WSP(bf16, WS_WO), 64, 4, DM, F.G, F.bid};
        EpiBf16Store E{WSP(bf16, WS_MO), DM};
        pg8::gemm_phase<EpiBf16Store, SchedDense, false, SP2>(F.lds, DM, S, E); SEAM();
    }
    STAMP(8);
    if (IN(8)) _Pragma("unroll") for (int rep_ = 0; rep_ < ((DUP == 8) ? 2 : 1); ++rep_) { if (rep_ == 1) { if (F.bid == 0 && F.tid < 64) F.ctl[CW_CNT + 64 * F.tid] = 0u; SEAM(); } phase_route(F); SEAM(); }
    STAMP(9);
    if (IN(9)) _Pragma("unroll") for (int rep_ = 0; rep_ < ((DUP == 9) ? 2 : 1); ++rep_) {
        build_tile_prefix(F, tp);
        SchedMoe S{(const char*)WSP(bf16, WS_H2), (const char*)WSP(bf16, WS_WGU), WSP(int2, WS_LIST), F.ctl + CW_CNT, tp, 2, DM, F.G, F.bid, (size_t)512 * DM * 2, 0, true};
        EpiUp E{WSP(bf16, WS_HMID)};
        pg8::gemm_phase<EpiUp, SchedMoe, true, SP2>(F.lds, DM, S, E); SEAM();
    }
    STAMP(10);
    if (IN(10)) _Pragma("unroll") for (int rep_ = 0; rep_ < ((DUP == 10) ? 2 : 1); ++rep_) {
        build_tile_prefix(F, tp);
        SchedMoe S{(const char*)WSP(bf16, WS_HMID), (const char*)WSP(bf16, WS_WD), WSP(int2, WS_LIST), F.ctl + CW_CNT, tp, 2, DEXP, F.G, F.bid, (size_t)DM * DEXP * 2, 0, false};
        EpiDown E{WSP(bf16, WS_YB), F.out, WSP(int2, WS_LIST), tp, 0};
        pg8::gemm_phase<EpiDown, SchedMoe, false, SP2>(F.lds, DEXP, S, E); SEAM();
    }
    STAMP(11);
    if (IN(11)) _Pragma("unroll") for (int rep_ = 0; rep_ < ((DUP == 11) ? 2 : 1); ++rep_) { phase_combine(F, 0); SEAM(); }
    STAMP(12);
    if (IN(12)) _Pragma("unroll") for (int rep_ = 0; rep_ < ((DUP == 12) ? 2 : 1); ++rep_) {
        build_tile_prefix(F, tp);
        SchedMoe S{(const char*)WSP(bf16, WS_HMID), (const char*)WSP(bf16, WS_WD), WSP(int2, WS_LIST), F.ctl + CW_CNT, tp, 2, DEXP, F.G, F.bid, (size_t)DM * DEXP * 2, 512, false};
        EpiDown E{WSP(bf16, WS_YB), F.out, WSP(int2, WS_LIST), tp, 1};
        pg8::gemm_phase<EpiDown, SchedMoe, false, SP2>(F.lds, DEXP, S, E); SEAM();
    }
    STAMP(13);
    if (IN(13)) _Pragma("unroll") for (int rep_ = 0; rep_ < ((DUP == 13) ? 2 : 1); ++rep_) { phase_final(F); }
    STAMP(14);
    if (PROBE_PH >= 0 && F.bid == 0) { __syncthreads(); if (F.tid == 0) { const unsigned long long d = tsl[PROBE_IB] - tsl[PROBE_IA]; float a = 1.0f + 0.2f * floorf((float)d * 0.001f); a = a > 30.f ? 30.f : a;
#ifdef PROBE_BIG
            a = 20.0f + (float)d * 0.005f;
#endif
            asm volatile("s_waitcnt vmcnt(0)" ::: "memory"); F.out[0] += a; } }
#undef IN
}

extern "C" void kernel_launch(void* const* d_in, const int* in_sizes, int n_in, void* d_out, int out_size, void* d_ws, size_t ws_size, hipStream_t stream) {
    static int grid = 0;
    if (grid == 0) {
        if (n_in != 28 || in_sizes[0] != NT * DM || out_size != NT * DM || ws_size < WS_END) { fprintf(stderr, "kernel_launch: unexpected shapes / workspace (%d inputs, ws %zu)\n", n_in, ws_size); grid = -1; return; }
        int dev = 0, cus = 0;
        if (hipGetDevice(&dev) != hipSuccess || hipDeviceGetAttribute(&cus, hipDeviceAttributeMultiprocessorCount, dev) != hipSuccess) { grid = -1; return; }
        if (hipFuncSetAttribute((const void*)fwd, hipFuncAttributeMaxDynamicSharedMemorySize, LDS_BYTES) != hipSuccess) { fprintf(stderr, "kernel_launch: hipFuncSetAttribute failed\n"); grid = -1; return; }
        int per_cu = 0; (void)hipOccupancyMaxActiveBlocksPerMultiprocessor(&per_cu, (const void*)fwd, NTHR, LDS_BYTES); (void)hipGetLastError();
        if (per_cu < 1) fprintf(stderr, "kernel_launch: occupancy query says %d\n", per_cu);
        grid = cus;
    }
    if (grid < 0) return;
    (void)hipMemsetAsync((char*)d_ws + WS_CTL, 0, CTL_BYTES, stream);
    Args a{};
    for (int i = 0; i < 28; ++i) a.in[i] = (const float*)d_in[i];
    a.out = (float*)d_out; a.ws = (unsigned char*)d_ws;
#if MK_ONE_LAUNCH
    a.ph_lo = 0; a.ph_hi = N_PHASES;
    hipLaunchKernelGGL(fwd, dim3(grid), dim3(NTHR), LDS_BYTES, stream, a);
#else
    for (int p = 0; p < 14; ++p) { a.ph_lo = p; a.ph_hi = p + 1; hipLaunchKernelGGL(fwd, dim3(grid), dim3(NTHR), LDS_BYTES, stream, a); }
#endif
}
```

```cpp
#include <hip/hip_runtime.h>
#include <cstdio>
#include <cstdint>

#ifndef MK_ONE_LAUNCH
#define MK_ONE_LAUNCH 1
#endif
#ifndef MK_REF_GEMM
#define MK_REF_GEMM 0
#endif

constexpr int NB = 4, SEQ = 4096, DM = 1024, CTXL = 256, RPB = SEQ + CTXL  , NROW = NB * RPB  , NT = NB * SEQ  ;
constexpr int NH = 4, HD = 128, CH = 128, NCHUNK = RPB / CH  ;
constexpr int N_STATE = 2064, N_IN = 6160, NEXP = 64, TOPK = 8, DEXP = 256;
constexpr float EPS = 1e-6f;
constexpr int NPCOL = 4096;
constexpr int SLOT_SH = 147456;
constexpr int NSLOT = SLOT_SH + NT;

constexpr size_t MiB = 1u << 20;
constexpr size_t WS_CTL = 0, CTL_BYTES = 1 * MiB;
constexpr size_t WS_MOD = 1 * MiB;
constexpr size_t WS_ROPE = 2 * MiB;
constexpr size_t WS_LOGA = 4 * MiB;
constexpr size_t WS_BETA = 5 * MiB;
constexpr size_t WS_WRO = 6 * MiB, WS_WGO = 7 * MiB, WS_WO = 8 * MiB;
constexpr size_t WS_P = 10 * MiB;
constexpr size_t PGRP = (size_t)NROW * 512;
constexpr size_t WS_CH = 146 * MiB;
constexpr size_t WS_WIN = WS_CH;
constexpr size_t WS_HX = WS_CH + 12 * MiB;
constexpr size_t WS_GM = WS_CH;
constexpr size_t WS_GC = WS_CH + 34 * MiB;
constexpr size_t WS_GKV = WS_CH + 68 * MiB;
constexpr size_t WS_GQT = WS_CH + 102 * MiB;
constexpr size_t WS_OGDN = WS_CH + 134 * MiB;
constexpr size_t WS_ORET = WS_CH + 150 * MiB;
constexpr size_t WS_RETY = WS_P, WS_GDNY = WS_P + 17 * MiB;
constexpr size_t WS_H2 = 10 * MiB;
constexpr size_t WS_WGU = 73 * MiB;
constexpr size_t WS_YB = 10 * MiB;
constexpr size_t WS_WD = 138 * MiB;
constexpr size_t WS_HMID = 171 * MiB;
constexpr size_t WS_TMP = 171 * MiB, WS_MERGED = 203 * MiB;
constexpr size_t WS_MO = 251 * MiB;
constexpr size_t WS_LIST = 283 * MiB;
constexpr size_t WS_END = 312 * MiB;

constexpr int CW_BAR = 1024;
constexpr int CW_CNT = 8192;
constexpr int CW_FLAG = 12288;

#define GAS __attribute__((address_space(1)))
#define LAS __attribute__((address_space(3)))
typedef unsigned short bf16;
typedef float f32x4 __attribute__((ext_vector_type(4)));
typedef float f32x2 __attribute__((ext_vector_type(2)));
typedef short bf16x8 __attribute__((ext_vector_type(8)));
typedef unsigned u32x4 __attribute__((ext_vector_type(4)));
typedef unsigned u32x2 __attribute__((ext_vector_type(2)));
__device__ __forceinline__ unsigned f2bf(float f) { unsigned u = __builtin_bit_cast(unsigned, f); return (u + 0x7fffu + ((u >> 16) & 1u)) >> 16; }
__device__ __forceinline__ unsigned pk2(float lo, float hi) { return f2bf(lo) | (f2bf(hi) << 16); }
__device__ __forceinline__ float bf2f(unsigned b) { return __builtin_bit_cast(float, b << 16); }
__device__ __forceinline__ float bflo(unsigned w) { return __builtin_bit_cast(float, w << 16); }
__device__ __forceinline__ float bfhi(unsigned w) { return __builtin_bit_cast(float, w & 0xffff0000u); }
__device__ __forceinline__ float sigmoidf_(float x) { return 1.f / (1.f + __expf(-x)); }
__device__ __forceinline__ float siluf_(float x) { return x / (1.f + __expf(-x)); }
__device__ __forceinline__ float wave_sum(float v) {
#pragma unroll
    for (int o = 1; o < 64; o <<= 1) v += __shfl_xor(v, o);
    return v;
}
__device__ __forceinline__ float sum16(float v) {
#pragma unroll
    for (int o = 1; o < 16; o <<= 1) v += __shfl_xor(v, o);
    return v;
}
__device__ __forceinline__ void unpack8(const u32x4 w, float (&o)[8]) {
    o[0] = bflo(w.x); o[1] = bfhi(w.x); o[2] = bflo(w.y); o[3] = bfhi(w.y); o[4] = bflo(w.z); o[5] = bfhi(w.z); o[6] = bflo(w.w); o[7] = bfhi(w.w);
}
__device__ __forceinline__ u32x4 pack8(const float (&v)[8]) { u32x4 w; w.x = pk2(v[0], v[1]); w.y = pk2(v[2], v[3]); w.z = pk2(v[4], v[5]); w.w = pk2(v[6], v[7]); return w; }

namespace pg8 {
constexpr int BM = 256, BK = 64, HALF = 128, HTB = HALF * BK * 2, STAGE_BYTES = 8 * HTB;
__host__ __device__ __forceinline__ int lds_byte(int r, int c) { const int st = (r >> 4) * 2 + (c >> 5), rr = r & 15, cc = c & 31, ob = rr * 64 + cc * 2; return st * 1024 + (ob ^ (((ob >> 9) & 1) << 5)); }
__host__ __device__ __forceinline__ void stage_rc(int b, int& R, int& C) { const int st = b / 1024, sb = b % 1024, swz = sb ^ (((sb >> 9) & 1) << 5); R = (st >> 1) * 16 + swz / 64; C = (st & 1) * 32 + (swz % 64) / 2; }
__host__ __device__ __forceinline__ int perm32(int rho) { const int n = rho >> 4, i = rho & 15; return 8 * (i >> 2) + 4 * n + (i & 3); }
__device__ __forceinline__ unsigned cvt_pk_bf16(float lo, float hi) { unsigned r; asm volatile("v_cvt_pk_bf16_f32 %0, %1, %2" : "=v"(r) : "v"(lo), "v"(hi)); return r; }

struct Unit { const char* A; const char* B; int pm, pn, e, base; };

template <class Epi, class Sched, bool GATHER, bool SP2>
__device__ __forceinline__ void gemm_phase(LAS unsigned char* lds, const int K, const Sched& S, const Epi& E) {
#if MK_REF_GEMM
    {
        const int tid = threadIdx.x, wid = tid >> 6, lane = tid & 63, wr = wid >> 2, wc = wid & 3, fr = lane & 15, fq = lane >> 4;
        Unit cur;
        for (int ui = 0; S.next(ui, cur); ++ui) {
            f32x4 acc[2][2][4][2];
            for (int ai = 0; ai < 2; ++ai) for (int m = 0; m < 4; ++m) {
                const int r = 128 * ai + 64 * wr + 16 * m + fr;
                const bf16* arow = GATHER ? (const bf16*)cur.A + (size_t)S.row_index(cur, r) * K : (const bf16*)cur.A + (size_t)r * K;
                for (int bj = 0; bj < 2; ++bj) for (int n = 0; n < 2; ++n) {
                    f32x4 a4 = {0.f, 0.f, 0.f, 0.f};
                    for (int i = 0; i < 4; ++i) { const int c = 128 * bj + 32 * wc + 8 * fq + 4 * n + i; const bf16* brow = (const bf16*)cur.B + (size_t)c * K;
                        float s = 0.f; for (int k = 0; k < K; ++k) s += bf2f(arow[k]) * bf2f(brow[k]); a4[i] = s; }
                    acc[ai][bj][m][n] = a4; } }
            E(acc, cur, wr, wc, fr, fq);
        }
        return;
    }
#else
    const int tid = threadIdx.x, wid = __builtin_amdgcn_readfirstlane(tid >> 6), lane = tid & 63, wr = wid >> 2, wc = wid & 3, fr = lane & 15, fq = lane >> 4;
    const int nt = K / BK;
    unsigned voffA[2], voffB[2]; int gR = 0, gC = 0;
#pragma unroll
    for (int i = 0; i < 2; ++i) { int R, C; stage_rc(tid * 16 + i * 8192, R, C); const int Rb = (R & ~31) + perm32(R & 31);
        voffA[i] = (unsigned)(R * K + C) * 2u; voffB[i] = (unsigned)(Rb * K + C) * 2u; if (i == 0) { gR = R; gC = C; } }
    const size_t kstep = (size_t)(BK * 2);
    const size_t hstep = (size_t)HALF * K * 2;
    const unsigned ldsw = (unsigned)wid * 1024u;
    const int aoff = lds_byte(wr * 64 + fr, fq * 8), boff = lds_byte(wc * 32 + fr, fq * 8);
#define PG8_SA(b, h) (((b) * 2 + (h)) * HTB)
#define PG8_SB(b, h) ((4 + (b) * 2 + (h)) * HTB)
#define PG8_STAGE(bufoff, gbase, voff) do { _Pragma("unroll") for (int _i = 0; _i < 2; ++_i) \
        __builtin_amdgcn_global_load_lds((const unsigned*)((const char*)(gbase) + (voff)[_i]), (LAS unsigned*)(lds + (bufoff) + ldsw + _i * 8192), 16, 0, 0); } while (0)
#define PG8_STAGE_A(bufoff, gbase, h, G) do { if constexpr (GATHER) { PG8_STAGE(bufoff, gbase, (G)[h]); } else { PG8_STAGE(bufoff, (gbase) + (h) * hstep, voffA); } } while (0)
#define PG8_LDA(dst, b, h) do { _Pragma("unroll") for (int m = 0; m < 4; ++m) _Pragma("unroll") for (int k = 0; k < 2; ++k) dst[m][k] = *(const LAS bf16x8*)(lds + PG8_SA(b, h) + aoff + m * 2048 + k * 1024); } while (0)
#define PG8_LDB(dst, b, h) do { _Pragma("unroll") for (int n = 0; n < 2; ++n) _Pragma("unroll") for (int k = 0; k < 2; ++k) dst[n][k] = *(const LAS bf16x8*)(lds + PG8_SB(b, h) + boff + n * 2048 + k * 1024); } while (0)
#define PG8_MMA(ai, bj, At, Bt) do { __builtin_amdgcn_s_setprio(1); _Pragma("unroll") for (int m = 0; m < 4; ++m) _Pragma("unroll") for (int n = 0; n < 2; ++n) _Pragma("unroll") for (int k = 0; k < 2; ++k) \
        acc[ai][bj][m][n] = __builtin_amdgcn_mfma_f32_16x16x32_bf16(Bt[n][k], At[m][k], acc[ai][bj][m][n], 0, 0, 0); __builtin_amdgcn_s_setprio(0); } while (0)
#define PG8_WAIT_V(n) asm volatile("s_waitcnt vmcnt(" #n ")" ::: "memory")
#define PG8_WAIT_L(n) asm volatile("s_waitcnt lgkmcnt(" #n ")" ::: "memory")
#define PG8_BAR __builtin_amdgcn_s_barrier()
#define PG8_SCHED __builtin_amdgcn_sched_barrier(0)
    Unit cur, nxt; int ui = 0;
    if (!S.next(0, cur)) return;
    f32x4 acc[2][2][4][2];
#pragma unroll
    for (int a = 0; a < 2; ++a)
#pragma unroll
        for (int b = 0; b < 2; ++b)
#pragma unroll
            for (int m = 0; m < 4; ++m)
#pragma unroll
                for (int n = 0; n < 2; ++n) acc[a][b][m][n] = (f32x4){0.f, 0.f, 0.f, 0.f};
    bf16x8 At[4][2], B0[2][2], B1[2][2];
    const char* cA = cur.A; const char* cB = cur.B;
    unsigned cG[2][2] = {{0u, 0u}, {0u, 0u}}, nG[2][2] = {{0u, 0u}, {0u, 0u}};
    if constexpr (GATHER) {
#pragma unroll
        for (int h = 0; h < 2; ++h)
#pragma unroll
            for (int i = 0; i < 2; ++i) cG[h][i] = ((unsigned)S.row_index(cur, 128 * h + gR + 64 * i) * (unsigned)K + (unsigned)gC) * 2u;
    }
    if constexpr (SP2) {
        PG8_STAGE(PG8_SB(0, 0), cB, voffB); PG8_STAGE(PG8_SB(0, 1), cB + hstep, voffB); PG8_STAGE_A(PG8_SA(0, 0), cA, 0, cG); PG8_STAGE_A(PG8_SA(0, 1), cA, 1, cG);
        if (wr == 1) PG8_BAR;
        PG8_WAIT_V(2); PG8_BAR;
        PG8_STAGE(PG8_SB(1, 0), cB + kstep, voffB); PG8_STAGE_A(PG8_SA(1, 0), cA + kstep, 0, cG); PG8_STAGE(PG8_SB(1, 1), cB + hstep + kstep, voffB);
        PG8_WAIT_V(6); PG8_BAR;
    } else {
        PG8_STAGE(PG8_SB(0, 0), cB, voffB); PG8_STAGE_A(PG8_SA(0, 0), cA, 0, cG); PG8_STAGE(PG8_SB(0, 1), cB + hstep, voffB); PG8_STAGE_A(PG8_SA(0, 1), cA, 1, cG);
        if (wr == 1) PG8_BAR;
        PG8_WAIT_V(4); PG8_BAR;
        PG8_STAGE(PG8_SB(1, 0), cB + kstep, voffB); PG8_STAGE_A(PG8_SA(1, 0), cA + kstep, 0, cG); PG8_STAGE(PG8_SB(1, 1), cB + hstep + kstep, voffB);
        PG8_WAIT_V(6); PG8_BAR;
    }
    for (;;) {
        const bool has_next = S.next(ui + 1, nxt);
        const char* nA = has_next ? nxt.A : cA; const char* nB = has_next ? nxt.B : cB;
        for (int t = 0; t < nt; t += 2) {
            const bool last = (t == nt - 2);
            const char* a1 = cA + (size_t)(t + 1) * kstep;
            const char* a2 = last ? nA : cA + (size_t)(t + 2) * kstep; const char* b2 = last ? nB : cB + (size_t)(t + 2) * kstep;
            const char* a3 = a2 + kstep; const char* b3 = b2 + kstep;
            unsigned g2[2][2] = {{0u, 0u}, {0u, 0u}};
            if constexpr (GATHER) {
                if (last) {
                    if (has_next) {
#pragma unroll
                        for (int h = 0; h < 2; ++h)
#pragma unroll
                            for (int i = 0; i < 2; ++i) nG[h][i] = ((unsigned)S.row_index(nxt, 128 * h + gR + 64 * i) * (unsigned)K + (unsigned)gC) * 2u;
                    } else {
#pragma unroll
                        for (int h = 0; h < 2; ++h)
#pragma unroll
                            for (int i = 0; i < 2; ++i) nG[h][i] = cG[h][i];
                    }
                }
#pragma unroll
                for (int h = 0; h < 2; ++h)
#pragma unroll
                    for (int i = 0; i < 2; ++i) g2[h][i] = last ? nG[h][i] : cG[h][i];
            }
            if constexpr (SP2) {
            PG8_LDB(B0, 0, 0); PG8_LDB(B1, 0, 1); PG8_SCHED; PG8_LDA(At, 0, 0); PG8_STAGE_A(PG8_SA(1, 1), a1, 1, cG);
            PG8_WAIT_V(8); PG8_WAIT_L(0); PG8_BAR; PG8_MMA(0, 0, At, B0); PG8_MMA(0, 1, At, B1); PG8_BAR; PG8_SCHED;
            PG8_LDA(At, 0, 1); PG8_STAGE(PG8_SB(0, 0), b2, voffB); PG8_STAGE(PG8_SB(0, 1), b2 + hstep, voffB); PG8_STAGE_A(PG8_SA(0, 0), a2, 0, g2);
            PG8_WAIT_V(8); PG8_WAIT_L(0); PG8_BAR; PG8_MMA(1, 0, At, B0); PG8_MMA(1, 1, At, B1); PG8_BAR; PG8_SCHED;
            PG8_LDB(B0, 1, 0); PG8_LDB(B1, 1, 1); PG8_SCHED; PG8_LDA(At, 1, 0); PG8_STAGE_A(PG8_SA(0, 1), a2, 1, g2);
            PG8_WAIT_V(8); PG8_WAIT_L(0); PG8_BAR; PG8_MMA(0, 0, At, B0); PG8_MMA(0, 1, At, B1); PG8_BAR; PG8_SCHED;
            PG8_LDA(At, 1, 1); PG8_STAGE(PG8_SB(1, 0), b3, voffB); PG8_STAGE(PG8_SB(1, 1), b3 + hstep, voffB); PG8_STAGE_A(PG8_SA(1, 0), a3, 0, g2);
            PG8_WAIT_V(8); PG8_WAIT_L(0); PG8_BAR; PG8_MMA(1, 0, At, B0); PG8_MMA(1, 1, At, B1); PG8_BAR; PG8_SCHED;
            } else {
            PG8_LDB(B0, 0, 0); PG8_SCHED; PG8_LDA(At, 0, 0); PG8_STAGE_A(PG8_SA(1, 1), a1, 1, cG);
            PG8_WAIT_L(8); PG8_BAR; PG8_WAIT_L(0); PG8_MMA(0, 0, At, B0); PG8_BAR; PG8_SCHED;
            PG8_LDB(B1, 0, 1); PG8_STAGE(PG8_SB(0, 0), b2, voffB);
            PG8_BAR; PG8_WAIT_L(0); PG8_MMA(0, 1, At, B1); PG8_BAR;
            PG8_LDA(At, 0, 1); PG8_STAGE_A(PG8_SA(0, 0), a2, 0, g2);
            PG8_BAR; PG8_WAIT_L(0); PG8_MMA(1, 0, At, B0); PG8_BAR; PG8_SCHED;
            PG8_STAGE(PG8_SB(0, 1), b2 + hstep, voffB);
            PG8_WAIT_V(6); PG8_BAR; PG8_MMA(1, 1, At, B1); PG8_BAR;
            PG8_LDB(B0, 1, 0); PG8_SCHED; PG8_LDA(At, 1, 0); PG8_STAGE_A(PG8_SA(0, 1), a2, 1, g2);
            PG8_WAIT_L(8); PG8_BAR; PG8_WAIT_L(0); PG8_MMA(0, 0, At, B0); PG8_BAR; PG8_SCHED;
            PG8_LDB(B1, 1, 1); PG8_STAGE(PG8_SB(1, 0), b3, voffB);
            PG8_BAR; PG8_WAIT_L(0); PG8_MMA(0, 1, At, B1); PG8_BAR;
            PG8_LDA(At, 1, 1); PG8_STAGE_A(PG8_SA(1, 0), a3, 0, g2);
            PG8_BAR; PG8_WAIT_L(0); PG8_MMA(1, 0, At, B0); PG8_BAR; PG8_SCHED;
            PG8_STAGE(PG8_SB(1, 1), b3 + hstep, voffB);
            PG8_WAIT_V(6); PG8_BAR; PG8_MMA(1, 1, At, B1); PG8_BAR;
            }
        }
        if (wr == 0) PG8_BAR;
        { int tz = threadIdx.x; asm volatile("" : "+v"(tz)); const int wid_ = __builtin_amdgcn_readfirstlane(tz >> 6), lane_ = tz & 63;
          E(acc, cur, wid_ >> 2, wid_ & 3, lane_ & 15, lane_ >> 4); }
        if (!has_next) break;
#pragma unroll
        for (int a = 0; a < 2; ++a)
#pragma unroll
            for (int b = 0; b < 2; ++b)
#pragma unroll
                for (int m = 0; m < 4; ++m)
#pragma unroll
                    for (int n = 0; n < 2; ++n) acc[a][b][m][n] = (f32x4){0.f, 0.f, 0.f, 0.f};
        cur = nxt; cA = nA; cB = nB; ++ui;
        if constexpr (GATHER) {
#pragma unroll
            for (int h = 0; h < 2; ++h)
#pragma unroll
                for (int i = 0; i < 2; ++i) cG[h][i] = nG[h][i];
        }
        if (wr == 1) PG8_BAR;
    }
    PG8_WAIT_V(0);
    PG8_BAR;
#undef PG8_SA
#undef PG8_SB
#undef PG8_STAGE
#undef PG8_STAGE_A
#undef PG8_LDA
#undef PG8_LDB
#undef PG8_MMA
#undef PG8_WAIT_V
#undef PG8_WAIT_L
#undef PG8_BAR
#undef PG8_SCHED
#endif
}
}
constexpr bool SP2 = true;

#define XB_TMO      128
#define XB_XCNT(j)  (256  + 64 * (j))
#define XB_XSUB(j)  (1280 + 64 * (j))
#define XB_XGEN(j)  (2304 + 64 * (j))
#define XB_TOP      3328
#define XB_TOPGEN   3392
#define XCD_BAR_WORDS 3456
#define XB_SPIN_CAP (1u << 18)
__device__ __forceinline__ unsigned xb_ld(unsigned* p)              { return __hip_atomic_load(p, __ATOMIC_RELAXED, __HIP_MEMORY_SCOPE_AGENT); }
__device__ __forceinline__ unsigned xb_add(unsigned* p, unsigned v) { return __hip_atomic_fetch_add(p, v, __ATOMIC_RELAXED, __HIP_MEMORY_SCOPE_AGENT); }
__device__ __forceinline__ unsigned xb_xcc_id() { return (unsigned)__builtin_amdgcn_s_getreg((3 << 11) | 20) & 0xFu; }
#define XB_SPIN(cond, bar) do { unsigned _sp = 0; while (cond) { __builtin_amdgcn_s_sleep(1); \
    if ((++_sp & 255u) == 0u) { if (xb_ld(&(bar)[XB_TMO])) break; if (_sp > XB_SPIN_CAP) { atomicAdd(&(bar)[XB_TMO], 1u); break; } } } } while (0)
struct XcdBarrier { unsigned* bar; unsigned x; volatile LAS unsigned* st; };
__device__ __forceinline__ XcdBarrier xcd_barrier_post(unsigned* bar, volatile LAS unsigned* st) {
    XcdBarrier b; b.bar = bar; b.x = xb_xcc_id(); b.st = st;
    if (threadIdx.x == 0) (void)xb_add(&bar[XB_XCNT(b.x)], 1u);
    return b;
}
__device__ __forceinline__ void xcd_barrier_complete(unsigned* bar, unsigned x, unsigned& nloc, unsigned& nx) {
    const unsigned G = gridDim.x * gridDim.y * gridDim.z;
    unsigned sum, cnt, mine, sp = 0u;
    for (;;) {
        sum = 0u; cnt = 0u; mine = 0u;
#pragma unroll
        for (unsigned j = 0; j < 16; ++j) { const unsigned c = xb_ld(&bar[XB_XCNT(j)]); sum += c; cnt += (c > 0u) ? 1u : 0u; mine = (j == x) ? c : mine; }
        if (sum == G) break;
        __builtin_amdgcn_s_sleep(1);
        if ((++sp & 255u) == 0u) { if (xb_ld(&bar[XB_TMO])) break; if (sp > XB_SPIN_CAP) { atomicAdd(&bar[XB_TMO], 1u); break; } }
    }
    nloc = mine > 0u ? mine : 1u; nx = cnt > 0u ? cnt : 1u;
}
__device__ __forceinline__ void xcd_barrier(const XcdBarrier& b) {
    asm volatile("s_waitcnt vmcnt(0)" ::: "memory");
    __syncthreads();
    if (threadIdx.x == 0) {
        unsigned* bar = b.bar;
        __builtin_amdgcn_s_waitcnt(0);
        unsigned nloc = b.st[0], nx = b.st[1];
        if (nloc == 0u) { xcd_barrier_complete(bar, b.x, nloc, nx); b.st[0] = nloc; b.st[1] = nx; }
        const unsigned old = xb_add(&bar[XB_XSUB(b.x)], 1u);
        const unsigned gen = old / nloc;
        if (old + 1u == (gen + 1u) * nloc) {
            __builtin_amdgcn_fence(__ATOMIC_RELEASE, "agent");
            asm volatile("s_waitcnt vmcnt(0)" ::: "memory");
            const unsigned og = xb_add(&bar[XB_TOP], 1u);
            const unsigned tg = og / nx;
            if (og + 1u == (tg + 1u) * nx) xb_add(&bar[XB_TOPGEN], 1u);
            else XB_SPIN(xb_ld(&bar[XB_TOPGEN]) == tg, bar);
            __builtin_amdgcn_fence(__ATOMIC_ACQUIRE, "agent");
            xb_add(&bar[XB_XGEN(b.x)], 1u);
            asm volatile("s_waitcnt vmcnt(0)" ::: "memory");
        } else {
            XB_SPIN(xb_ld(&bar[XB_XGEN(b.x)]) == gen, bar);
            __builtin_amdgcn_fence(__ATOMIC_ACQUIRE, "agent");
            asm volatile("s_waitcnt vmcnt(0)" ::: "memory");
        }
    }
    __syncthreads();
}

constexpr int NWAVES = 8, NTHR = 512;
constexpr int RING_BYTES = 131072, MISC_OFF = 139264, LDS_BYTES = 147456;
struct Args {
    const float* in[28]; float* out; unsigned char* ws; int ph_lo, ph_hi;
};
struct Frame {
    LAS unsigned char* lds; int tid, lane, wave, G, bid;
    const float *x, *c, *ctx, *c_ctx, *w_mod, *b_mod, *n_mix_pre, *n_mix_post, *n_ffn_pre, *n_ffn_post, *w_in, *gdn_conv, *ret_log_decay, *gdn_a_log, *gdn_dt_bias,
        *ret_gn_w, *gdn_norm_w, *w_ret_out, *w_gdn_out, *w_o, *w_router, *router_bias, *w_gate, *w_up, *w_down, *w_sh_gate, *w_sh_up, *w_sh_down;
    float* out; unsigned char* ws; unsigned* ctl;
};
#define WSP(T, off) ((T*)(F.ws + (off)))

template <class CM>
__device__ __forceinline__ void transpose_item(const float* W, int ld, int K, bf16* WT, LAS float* scr, int kb, int nb, int lane, const CM& cm) {
    const int k0 = 64 * kb, n0 = 32 * nb; const int sc = cm(n0 + (lane & 31));
    float tv[32];
#pragma unroll
    for (int i = 0; i < 32; ++i) tv[i] = W[(size_t)(k0 + 2 * i + (lane >> 5)) * ld + sc];
#pragma unroll
    for (int i = 0; i < 32; ++i) scr[(2 * i + (lane >> 5)) * 33 + (lane & 31)] = tv[i];
    asm volatile("s_waitcnt lgkmcnt(0)" ::: "memory");
    const int c = lane & 7;
#pragma unroll
    for (int j = 0; j < 4; ++j) { const int n = (lane >> 3) + 8 * j; const LAS float* s = scr + (8 * c) * 33 + n;
        u32x4 o; o.x = pk2(s[0 * 33], s[1 * 33]); o.y = pk2(s[2 * 33], s[3 * 33]); o.z = pk2(s[4 * 33], s[5 * 33]); o.w = pk2(s[6 * 33], s[7 * 33]);
        *(u32x4*)(WT + (size_t)(n0 + n) * K + k0 + 8 * c) = o; }
    asm volatile("s_waitcnt lgkmcnt(0)" ::: "memory");
}
struct CmIdent { int off; __device__ __forceinline__ int operator()(int n) const { return n + off; } };
struct CmWin {
    __device__ __forceinline__ int operator()(int n) const {
        const int g = n >> 9; int src = n + (n >= 2048 ? 16 : 0);
        if (g == 0 || g == 4) { const int hb = n & ~127, cp = n & 127; const int wc = cp >> 5, fq = (cp >> 3) & 3, nn = (cp >> 2) & 1, i = cp & 3;
            const int d = 64 * nn + 16 * wc + 4 * fq + i; src = hb + d + (n >= 2048 ? 16 : 0); }
        return src; }
};
__device__ __forceinline__ void gu_decode(int cp, int& hid, int& isup) { const int pn = cp >> 8, r = cp & 255, bj = r >> 7, wc = (r >> 5) & 3, fq = (r >> 3) & 3, nn = (r >> 2) & 1, i = r & 3; hid = pn * 128 + bj * 64 + wc * 16 + fq * 4 + i; isup = nn; }

__device__ __forceinline__ void phase_prologue(Frame& F) {
    const int gw = F.bid * NWAVES + F.wave, NGW = F.G * NWAVES; const int gt = F.bid * NTHR + F.tid, NGT = F.G * NTHR;
    LAS float* scr = (LAS float*)(F.lds + F.wave * 16384);
    { float2* rt = WSP(float2, WS_ROPE);
      for (int idx = gt; idx < SEQ * 64; idx += NGT) { const int t = idx >> 6, j = idx & 63; const float pos = (float)(j < 32 ? (t >> 6) : (t & 63)); const int f = j & 31;
          const float inv = powf(10000.0f, -(float)f / 32.0f); const float ang = pos * inv; float sn, cs; sincosf(ang, &sn, &cs); rt[idx] = make_float2(cs, sn); } }
    {
        LAS float* red = (LAS float*)(F.lds);
        for (int it = F.bid; it < 96; it += F.G) {
            const int col = it * 64 + F.lane; float a[5] = {0.f, 0.f, 0.f, 0.f, 0.f};
            const int kb = F.wave * 128;
#pragma unroll 4
            for (int k = kb; k < kb + 128; ++k) { const float w = F.w_mod[(size_t)k * 6144 + col];
#pragma unroll
                for (int r = 0; r < 5; ++r) { const float cv = r < 4 ? F.c[r * DM + k] : F.c_ctx[k]; a[r] += siluf_(cv) * w; } }
#pragma unroll
            for (int r = 0; r < 5; ++r) red[(F.wave * 5 + r) * 64 + F.lane] = a[r];
            __syncthreads();
            if (F.wave < 5) { float s = F.b_mod[col];
#pragma unroll
                for (int w = 0; w < 8; ++w) s += red[(w * 5 + F.wave) * 64 + F.lane];
                WSP(float, WS_MOD)[F.wave * 6144 + col] = s; }
            __syncthreads();
        }
    }
    {
        constexpr int I_IN = 16 * 192, I_RO = 8 * 32, I_O = 16 * 32; constexpr int NIT = I_IN + 2 * I_RO + I_O;
        for (int it = gw; it < NIT; it += NGW) { int r = it;
            if (r < I_IN) { transpose_item(F.w_in, N_IN, DM, WSP(bf16, WS_WIN), scr, r / 192, r % 192, F.lane, CmWin{}); continue; } r -= I_IN;
            if (r < I_RO) { transpose_item(F.w_ret_out, DM, 512, WSP(bf16, WS_WRO), scr, r / 32, r % 32, F.lane, CmIdent{0}); continue; } r -= I_RO;
            if (r < I_RO) { transpose_item(F.w_gdn_out, DM, 512, WSP(bf16, WS_WGO), scr, r / 32, r % 32, F.lane, CmIdent{0}); continue; } r -= I_RO;
            transpose_item(F.w_o, DM, DM, WSP(bf16, WS_WO), scr, r / 32, r % 32, F.lane, CmIdent{0}); }
    }
}

__device__ __forceinline__ void phase_moe_weights(Frame& F) {
    const int gw = F.bid * NWAVES + F.wave, NGW = F.G * NWAVES;
    LAS float* scr = (LAS float*)(F.lds + F.wave * 16384);
    constexpr int I_GU = 16 * 16  , I_D = 4 * 32;
    for (int it = gw; it < 65 * (I_GU + I_D); it += NGW) {
        const int e = it / (I_GU + I_D); int r = it % (I_GU + I_D);
        if (r < I_GU) {
            const int kb = r / 16, nb = r % 16;
            const int k0 = 64 * kb, n0 = 32 * nb; int hid, isup; gu_decode(n0 + (F.lane & 31), hid, isup);
            const float* Wg = e < 64 ? F.w_gate + (size_t)e * DM * DEXP : F.w_sh_gate; const float* Wu = e < 64 ? F.w_up + (size_t)e * DM * DEXP : F.w_sh_up;
            const float* W = isup ? Wu : Wg;
            float tv[32];
#pragma unroll
            for (int i = 0; i < 32; ++i) tv[i] = W[(size_t)(k0 + 2 * i + (F.lane >> 5)) * DEXP + hid];
#pragma unroll
            for (int i = 0; i < 32; ++i) scr[(2 * i + (F.lane >> 5)) * 33 + (F.lane & 31)] = tv[i];
            asm volatile("s_waitcnt lgkmcnt(0)" ::: "memory");
            const int c = F.lane & 7; bf16* WT = WSP(bf16, WS_WGU) + (size_t)e * 512 * DM;
#pragma unroll
            for (int j = 0; j < 4; ++j) { const int n = (F.lane >> 3) + 8 * j; const LAS float* s = scr + (8 * c) * 33 + n;
                u32x4 o; o.x = pk2(s[0 * 33], s[1 * 33]); o.y = pk2(s[2 * 33], s[3 * 33]); o.z = pk2(s[4 * 33], s[5 * 33]); o.w = pk2(s[6 * 33], s[7 * 33]);
                *(u32x4*)(WT + (size_t)(n0 + n) * DM + k0 + 8 * c) = o; }
            asm volatile("s_waitcnt lgkmcnt(0)" ::: "memory");
        } else { r -= I_GU;
            const float* W = e < 64 ? F.w_down + (size_t)e * DEXP * DM : F.w_sh_down;
            transpose_item(W, DM, DEXP, WSP(bf16, WS_WD) + (size_t)e * DM * DEXP, scr, r / 32, r % 32, F.lane, CmIdent{0}); }
    }
}

template <bool LAT> __device__ __forceinline__ int norm1_row_of(int i) { return LAT ? (i >> 12) * RPB + CTXL + (i & 4095) : i; }
template <bool LAT>
__device__ __forceinline__ void norm1_rows(Frame& F, LAS float* wl, int w0, int nw, int r_lo, int r_hi) {
    const float* mod = WSP(float, WS_MOD);
    int ri = r_lo + w0; if (ri >= r_hi) return;
    f32x4 vn[4];
    { const int row = norm1_row_of<LAT>(ri); const int b = row / RPB, pos = row % RPB; const float* src = pos < CTXL ? F.ctx + ((size_t)b * CTXL + pos) * DM : F.x + ((size_t)b * SEQ + (pos - CTXL)) * DM;
#pragma unroll
      for (int j = 0; j < 4; ++j) vn[j] = *(const f32x4*)(src + 4 * (F.lane + 64 * j)); }
    for (; ri < r_hi; ri += nw) {
        const int row = norm1_row_of<LAT>(ri); const int b = row / RPB, pos = row % RPB; const bool isctx = pos < CTXL;
        const float* sh = isctx ? mod + 4 * 6144 : mod + b * 6144; const float* sc = sh + DM;
        f32x4 v[4]; float ss = 0.f;
#pragma unroll
        for (int j = 0; j < 4; ++j) { v[j] = vn[j]; ss += v[j].x * v[j].x + v[j].y * v[j].y + v[j].z * v[j].z + v[j].w * v[j].w; }
        { const int nri = ri + nw; if (nri < r_hi) { const int nr = norm1_row_of<LAT>(nri); const int nb = nr / RPB, np = nr % RPB; const float* src = np < CTXL ? F.ctx + ((size_t)nb * CTXL + np) * DM : F.x + ((size_t)nb * SEQ + (np - CTXL)) * DM;
#pragma unroll
            for (int j = 0; j < 4; ++j) vn[j] = *(const f32x4*)(src + 4 * (F.lane + 64 * j)); } }
        const float rstd = 1.0f / sqrtf(wave_sum(ss) * (1.f / DM) + EPS);
        float gd[16];
#pragma unroll
        for (int jj = 0; jj < 16; ++jj) gd[jj] = 0.f;
#pragma unroll
        for (int j = 0; j < 4; ++j) { const int c0 = 4 * (F.lane + 64 * j);
            const f32x4 g = *(const f32x4*)(F.n_mix_pre + c0), s1 = *(const f32x4*)(sc + c0), s0 = *(const f32x4*)(sh + c0);
            f32x4 h; h.x = v[j].x * rstd * g.x * (1.f + s1.x) + s0.x; h.y = v[j].y * rstd * g.y * (1.f + s1.y) + s0.y; h.z = v[j].z * rstd * g.z * (1.f + s1.z) + s0.z; h.w = v[j].w * rstd * g.w * (1.f + s1.w) + s0.w;
            u32x2 o; o.x = pk2(h.x, h.y); o.y = pk2(h.z, h.w);
            *(u32x2*)(WSP(bf16, WS_HX) + (size_t)row * DM + c0) = o;
#pragma unroll
            for (int jh = 0; jh < 2; ++jh) {
                asm volatile("" ::: "memory");
#pragma unroll
                for (int jj = 8 * jh; jj < 8 * jh + 8; ++jj) { const f32x4 w4 = *(const LAS f32x4*)(wl + jj * DM + c0); gd[jj] += (h.x * w4.x + h.y * w4.y) + (h.z * w4.z + h.w * w4.w); } } }
        float g8[8], g4[4], g2[2], mine;
        { const bool b0 = F.lane & 1, b1 = F.lane & 2, b2 = F.lane & 4, b3 = F.lane & 8;
#pragma unroll
          for (int i = 0; i < 8; ++i) { const float snd = b0 ? gd[2 * i] : gd[2 * i + 1], kp = b0 ? gd[2 * i + 1] : gd[2 * i]; g8[i] = kp + __shfl_xor(snd, 1); }
#pragma unroll
          for (int i = 0; i < 4; ++i) { const float snd = b1 ? g8[2 * i] : g8[2 * i + 1], kp = b1 ? g8[2 * i + 1] : g8[2 * i]; g4[i] = kp + __shfl_xor(snd, 2); }
#pragma unroll
          for (int i = 0; i < 2; ++i) { const float snd = b2 ? g4[2 * i] : g4[2 * i + 1], kp = b2 ? g4[2 * i + 1] : g4[2 * i]; g2[i] = kp + __shfl_xor(snd, 4); }
          { const float snd = b3 ? g2[0] : g2[1], kp = b3 ? g2[1] : g2[0]; mine = kp + __shfl_xor(snd, 8); }
          mine += __shfl_xor(mine, 16); mine += __shfl_xor(mine, 32); }
        if (F.lane < 16) { const int ab = F.lane >> 3, dir = (F.lane >> 2) & 1, h = F.lane & 3; const size_t o = ((size_t)(dir * NB + b) * NH + h) * RPB + pos;
            if (ab == 0) { const float z = mine + F.gdn_dt_bias[dir * 4 + h]; const float sp = z > 20.f ? z : log1pf(expf(z)); WSP(float, WS_LOGA)[o] = -expf(F.gdn_a_log[dir * 4 + h]) * sp; }
            else WSP(float, WS_BETA)[o] = 1.f / (1.f + expf(-mine)); }
    }
}
__device__ __forceinline__ void phase_norm1(Frame& F) {
    const int gw = F.bid * NWAVES + F.wave, NGW = F.G * NWAVES;
    LAS float* wl = (LAS float*)F.lds;
    for (int k = F.tid; k < DM; k += NTHR) { const float* wr = F.w_in + (size_t)k * N_IN + 2048;
#pragma unroll
        for (int jj = 0; jj < 4; ++jj) { const f32x4 w4 = *(const f32x4*)(wr + 4 * jj); wl[(4 * jj) * DM + k] = w4.x; wl[(4 * jj + 1) * DM + k] = w4.y; wl[(4 * jj + 2) * DM + k] = w4.z; wl[(4 * jj + 3) * DM + k] = w4.w; } }
    __syncthreads();
    if (F.G < 64) { norm1_rows<false>(F, wl, gw, NGW, 0, NROW); return; }
    if (F.bid < 32) {
        const int b = F.bid >> 3, sub = F.bid & 7; const int r0 = b * RPB + 32 * sub;
        norm1_rows<false>(F, wl, F.wave, NWAVES, r0, r0 + 32);
        asm volatile("s_waitcnt vmcnt(0)" ::: "memory");
        __syncthreads();
        if (F.tid == 0) {
            unsigned* flag = F.ctl + CW_FLAG + 64 * b;
            __builtin_amdgcn_fence(__ATOMIC_RELEASE, "agent"); asm volatile("s_waitcnt vmcnt(0)" ::: "memory");
            __hip_atomic_fetch_add(flag, 1u, __ATOMIC_RELAXED, __HIP_MEMORY_SCOPE_AGENT);
            unsigned sp = 0; while (__hip_atomic_load(flag, __ATOMIC_RELAXED, __HIP_MEMORY_SCOPE_AGENT) < 8u) { __builtin_amdgcn_s_sleep(1); if (++sp > (1u << 22)) break; }
            __builtin_amdgcn_fence(__ATOMIC_ACQUIRE, "agent"); asm volatile("s_waitcnt vmcnt(0)" ::: "memory");
        }
        __syncthreads();
    } else {
        norm1_rows<true>(F, wl, (F.bid - 32) * NWAVES + F.wave, (F.G - 32) * NWAVES, 0, NT);
    }
}

struct SchedIn {
    const char* A; const char* B; int G, c;
    __device__ __forceinline__ bool next(int i, pg8::Unit& u) const {
        const int L = i * G + c; if (L >= (G < 64 ? 1536 + 32 : 1536)) return false;
        int lt, pn;
        if (L < 1536) { int wgid = L; { const int q = 1536 / 8, xcd = wgid % 8, off = wgid / 8; wgid = xcd * q + off; }
            const int nig = 8 * 24, gid = wgid / nig, fm = gid * 8; lt = fm + ((wgid % nig) % 8); pn = (wgid % nig) / 8; u.pm = (lt >> 4) * 17 + 1 + (lt & 15); }
        else { const int q = L - 1536; u.pm = (q >> 3) * 17; pn = q & 7; }
        u.pn = pn; u.e = 0; u.base = 0; u.A = A + (size_t)u.pm * 256 * DM * 2; u.B = B + (size_t)pn * 256 * DM * 2; return true; }
    __device__ __forceinline__ int row_index(const pg8::Unit&, int r) const { return r; }
};
struct SchedCtx {
    const char* A; const char* B; int b, pn;
    __device__ __forceinline__ bool next(int i, pg8::Unit& u) const { if (i > 0) return false; u.pm = b * 17; u.pn = pn; u.e = 0; u.base = 0; u.A = A + (size_t)u.pm * 256 * DM * 2; u.B = B + (size_t)pn * 256 * DM * 2; return true; }
    __device__ __forceinline__ int row_index(const pg8::Unit&, int r) const { return r; }
};
struct EpiIn {
    bf16* P; bf16* GATES; const float2* rope;
    __device__ __forceinline__ void operator()(const f32x4 (&acc)[2][2][4][2], const pg8::Unit& u, int wr, int wc, int fr, int fq) const {
        const int g = u.pn >> 1;
        const int b = u.pm / 17, tl = u.pm % 17;
#pragma unroll
        for (int ai = 0; ai < 2; ++ai)
#pragma unroll
            for (int m = 0; m < 4; ++m) {
                const int rt = ai * 128 + wr * 64 + m * 16 + fr; const size_t prow = (size_t)u.pm * 256 + rt;
#pragma unroll
                for (int bj = 0; bj < 2; ++bj) {
                    f32x4 v0 = acc[ai][bj][m][0], v1 = acc[ai][bj][m][1];
                    const int ct = bj * 128 + wc * 32 + 8 * fq;
                    if (g == 0 || g == 4) {
                        const float s = (g == 0) ? 0.08838834764831845f : 1.0f; v0 = v0 * s; v1 = v1 * s;
                        const int j = 16 * wc + 4 * fq;
                        f32x4 o1 = v0, o2 = v1;
                        if (tl != 0) { const int t = (tl - 1) * 256 + rt; const float2* cs = rope + (size_t)t * 64 + j;
#pragma unroll
                            for (int i = 0; i < 4; ++i) { const float2 c2 = cs[i]; o1[i] = v0[i] * c2.x - v1[i] * c2.y; o2[i] = v0[i] * c2.y + v1[i] * c2.x; } }
                        bf16* dst = P + (size_t)g * PGRP + prow * 512 + (u.pn & 1) * 256 + bj * 128 + j;
                        u32x2 w1, w2; w1.x = pg8::cvt_pk_bf16(o1[0], o1[1]); w1.y = pg8::cvt_pk_bf16(o1[2], o1[3]); w2.x = pg8::cvt_pk_bf16(o2[0], o2[1]); w2.y = pg8::cvt_pk_bf16(o2[2], o2[3]);
                        *(u32x2*)dst = w1; *(u32x2*)(dst + 64) = w2;
                    } else if (g < 8) {
                        u32x4 w; w.x = pg8::cvt_pk_bf16(v0[0], v0[1]); w.y = pg8::cvt_pk_bf16(v0[2], v0[3]); w.z = pg8::cvt_pk_bf16(v1[0], v1[1]); w.w = pg8::cvt_pk_bf16(v1[2], v1[3]);
                        *(u32x4*)(P + (size_t)g * PGRP + prow * 512 + (u.pn & 1) * 256 + ct) = w;
                    } else {
                        const size_t lrow = (size_t)b * SEQ + (size_t)(tl - 1) * 256 + rt;
#pragma unroll
                        for (int i = 0; i < 4; ++i) { v0[i] = sigmoidf_(v0[i]); v1[i] = sigmoidf_(v1[i]); }
                        u32x4 w; w.x = pg8::cvt_pk_bf16(v0[0], v0[1]); w.y = pg8::cvt_pk_bf16(v0[2], v0[3]); w.z = pg8::cvt_pk_bf16(v1[0], v1[1]); w.w = pg8::cvt_pk_bf16(v1[2], v1[3]);
                        *(u32x4*)(GATES + lrow * 2048 + (u.pn - 16) * 256 + ct) = w;
                    }
                }
            }
    }
};

constexpr int IMGB = 34816, IMGS = 272;
typedef short s16x4 __attribute__((ext_vector_type(4)));
__device__ __forceinline__ unsigned offb(unsigned row, unsigned ch) { return 272u * row + 16u * ch; }
__device__ __forceinline__ unsigned offe(unsigned row, unsigned col) { return 272u * row + 2u * col; }
__device__ __forceinline__ bf16x8 frag_row(LAS unsigned char* img, int tile, int s, int lane) { return *(const LAS bf16x8*)(img + offb(16 * tile + (lane & 15), 4 * s + (lane >> 4))); }
__device__ __forceinline__ bf16x8 frag_tr(LAS unsigned char* img, int tile, int s, int lane) {
    const unsigned g = lane >> 4, qq = (lane & 15) >> 2, p = lane & 3;
    const s16x4 lo = __builtin_amdgcn_ds_read_tr16_b64_v4i16((LAS s16x4*)(img + offe(32 * s + 8 * g + qq, 16 * tile + 4 * p)));
    const s16x4 hi = __builtin_amdgcn_ds_read_tr16_b64_v4i16((LAS s16x4*)(img + offe(32 * s + 8 * g + 4 + qq, 16 * tile + 4 * p)));
    return (bf16x8){lo[0], lo[1], lo[2], lo[3], hi[0], hi[1], hi[2], hi[3]};
}
#define MFMA16(a, b, c) __builtin_amdgcn_mfma_f32_16x16x32_bf16(a, b, c, 0, 0, 0)
#define LBAR() do { asm volatile("s_waitcnt lgkmcnt(0)" ::: "memory"); __builtin_amdgcn_s_barrier(); asm volatile("" ::: "memory"); } while (0)
template <bool SWAP>
__device__ __forceinline__ void mm128(LAS unsigned char* ia, bool atr, LAS unsigned char* ib, bool btr, int wr, int wc, int lane, f32x4 (&acc)[2][4]) {
#pragma unroll
    for (int s = 0; s < 4; ++s) {
        bf16x8 fa[2], fb[4];
#pragma unroll
        for (int i = 0; i < 2; ++i) fa[i] = atr ? frag_tr(ia, 2 * wr + i, s, lane) : frag_row(ia, 2 * wr + i, s, lane);
#pragma unroll
        for (int j = 0; j < 4; ++j) fb[j] = btr ? frag_tr(ib, 4 * wc + j, s, lane) : frag_row(ib, 4 * wc + j, s, lane);
#pragma unroll
        for (int i = 0; i < 2; ++i)
#pragma unroll
            for (int j = 0; j < 4; ++j) acc[i][j] = SWAP ? MFMA16(fb[j], fa[i], acc[i][j]) : MFMA16(fa[i], fb[j], acc[i][j]);
    }
}
__device__ __forceinline__ void zero_acc(f32x4 (&acc)[2][4]) {
#pragma unroll
    for (int i = 0; i < 2; ++i)
#pragma unroll
        for (int j = 0; j < 4; ++j) acc[i][j] = (f32x4){0.f, 0.f, 0.f, 0.f};
}
__device__ __forceinline__ void st_img(LAS unsigned char* img, const f32x4 (&acc)[2][4], int wr, int wc, int lane) {
    const int r = lane & 15, q = lane >> 4;
#pragma unroll
    for (int i = 0; i < 2; ++i)
#pragma unroll
        for (int j = 0; j < 4; ++j) { u32x2 w; w.x = pk2(acc[i][j][0], acc[i][j][1]); w.y = pk2(acc[i][j][2], acc[i][j][3]);
            *(LAS u32x2*)(img + offe(32 * wr + 16 * i + r, 64 * wc + 16 * j + 4 * q)) = w; }
}
__device__ __forceinline__ void load_plain_img(LAS unsigned char* img, const bf16* src, int ld, int tid) {
#pragma unroll
    for (int i = 0; i < 4; ++i) { const int cidx = tid + 512 * i, row = cidx >> 4, ch = cidx & 15;
        *(LAS u32x4*)(img + offb(row, ch)) = *(const u32x4*)(src + (size_t)row * ld + 8 * ch); }
}
__device__ __forceinline__ void load_conv_img(LAS unsigned char* img, const bf16* src, const float* cw  , bool has_prev, bool has_next, int mode  , int wave, int lane) {
    asm volatile("" ::: "memory");
    const int ch = lane & 15; float w0[8], w1[8], w2[8];
#pragma unroll
    for (int i = 0; i < 8; ++i) { w0[i] = cw[8 * ch + i]; w1[i] = cw[1536 + 8 * ch + i]; w2[i] = cw[3072 + 8 * ch + i]; }
#pragma unroll
    for (int it = 0; it < 4; ++it) {
        const int row = 32 * it + 4 * wave + (lane >> 4); const u32x4 z4 = {0u, 0u, 0u, 0u};
        const u32x4 r0 = (row > 0 || has_prev) ? *(const u32x4*)(src + ((ptrdiff_t)row - 1) * 512 + 8 * ch) : z4;
        const u32x4 r1 = *(const u32x4*)(src + (size_t)row * 512 + 8 * ch);
        const u32x4 r2 = (row < 127 || has_next) ? *(const u32x4*)(src + (size_t)(row + 1) * 512 + 8 * ch) : z4;
        float a0[8], a1[8], a2[8], y[8]; unpack8(r0, a0); unpack8(r1, a1); unpack8(r2, a2); float ss = 0.f;
#pragma unroll
        for (int i = 0; i < 8; ++i) { y[i] = siluf_(w0[i] * a0[i] + w1[i] * a1[i] + w2[i] * a2[i]); ss += y[i] * y[i]; }
        if (mode != 1) { const float sc = (1.0f / sqrtf(sum16(ss) + EPS)) * (mode == 2 ? 0.08838834764831845f : 1.0f);
#pragma unroll
            for (int i = 0; i < 8; ++i) y[i] *= sc; }
        *(LAS u32x4*)(img + offb(row, ch)) = pack8(y);
    }
}
__device__ __forceinline__ void scale_rows_img(LAS unsigned char* dst, LAS unsigned char* src, const LAS float* rs, int tid) {
#pragma unroll
    for (int i = 0; i < 4; ++i) { const int cidx = tid + 512 * i, row = cidx >> 4, ch = cidx & 15; float v[8]; unpack8(*(const LAS u32x4*)(src + offb(row, ch)), v); const float sc = rs[row];
#pragma unroll
        for (int e = 0; e < 8; ++e) v[e] *= sc;
        *(LAS u32x4*)(dst + offb(row, ch)) = pack8(v); }
}
__device__ __forceinline__ void tri_inverse(LAS unsigned char* img, int w, int lane) {
    const int r = lane & 15, q = lane >> 4;
    {
        const int b0 = 16 * w; float x[16];
#pragma unroll
        for (int i = 0; i < 16; ++i) { float v = (i == r) ? 1.f : 0.f;
#pragma unroll
            for (int j = 0; j < i; ++j) v -= bf2f(*(const LAS unsigned short*)(img + offe(b0 + i, b0 + j))) * x[j];
            x[i] = v; }
        if (q == 0) {
#pragma unroll
            for (int i = 0; i < 16; ++i) *(LAS unsigned short*)(img + offe(b0 + i, b0 + r)) = (unsigned short)f2bf(x[i]); }
    }
    LBAR();
    if (w < 4) {
        const int c0 = 32 * w, r1 = c0 + 16;
        const u32x2 av = *(const LAS u32x2*)(img + offe(r1 + r, c0 + 4 * q));
        const bf16x8 fa = __builtin_bit_cast(bf16x8, (u32x4){av.x, av.y, 0u, 0u});
        const s16x4 tb = __builtin_amdgcn_ds_read_tr16_b64_v4i16((LAS s16x4*)(img + offe(c0 + 4 * q + (r >> 2), c0 + 4 * (r & 3))));
        const bf16x8 fb = (bf16x8){tb[0], tb[1], tb[2], tb[3], 0, 0, 0, 0};
        const f32x4 y = MFMA16(fa, fb, ((f32x4){0.f, 0.f, 0.f, 0.f}));
        const bf16x8 fy = __builtin_bit_cast(bf16x8, (u32x4){pk2(y[0], y[1]), pk2(y[2], y[3]), 0u, 0u});
        const u32x2 tv = *(const LAS u32x2*)(img + offe(r1 + r, r1 + 4 * q));
        const bf16x8 ft = __builtin_bit_cast(bf16x8, (u32x4){tv.x, tv.y, 0u, 0u});
        const f32x4 d = MFMA16(fy, ft, ((f32x4){0.f, 0.f, 0.f, 0.f}));
        u32x2 o; o.x = pk2(-d[0], -d[1]); o.y = pk2(-d[2], -d[3]);
        *(LAS u32x2*)(img + offe(r1 + r, c0 + 4 * q)) = o;
    }
    LBAR();
    {
        const int p = w >> 2, ti = (w >> 1) & 1, tj = w & 1, base = 64 * p, rb = base + 32;
        f32x4 y[2];
        const unsigned g = lane >> 4, qq = (lane & 15) >> 2, pp = lane & 3;
        const s16x4 lo = __builtin_amdgcn_ds_read_tr16_b64_v4i16((LAS s16x4*)(img + offe(base + 8 * g + qq, base + 16 * tj + 4 * pp)));
        const s16x4 hi = __builtin_amdgcn_ds_read_tr16_b64_v4i16((LAS s16x4*)(img + offe(base + 8 * g + 4 + qq, base + 16 * tj + 4 * pp)));
        const bf16x8 fb = (bf16x8){lo[0], lo[1], lo[2], lo[3], hi[0], hi[1], hi[2], hi[3]};
#pragma unroll
        for (int kt = 0; kt < 2; ++kt) { const bf16x8 fa = *(const LAS bf16x8*)(img + offb(rb + 16 * kt + r, (base >> 3) + q)); y[kt] = MFMA16(fa, fb, ((f32x4){0.f, 0.f, 0.f, 0.f})); }
        const bf16x8 fy = __builtin_bit_cast(bf16x8, (u32x4){pk2(y[0][0], y[0][1]), pk2(y[0][2], y[0][3]), pk2(y[1][0], y[1][1]), pk2(y[1][2], y[1][3])});
        const u32x2 t0 = *(const LAS u32x2*)(img + offe(rb + 16 * ti + r, rb + 4 * q)), t1 = *(const LAS u32x2*)(img + offe(rb + 16 * ti + r, rb + 16 + 4 * q));
        const bf16x8 ft = __builtin_bit_cast(bf16x8, (u32x4){t0.x, t0.y, t1.x, t1.y});
        const f32x4 d = MFMA16(fy, ft, ((f32x4){0.f, 0.f, 0.f, 0.f}));
        LBAR();
        u32x2 o; o.x = pk2(-d[0], -d[1]); o.y = pk2(-d[2], -d[3]);
        *(LAS u32x2*)(img + offe(rb + 16 * ti + r, base + 16 * tj + 4 * q)) = o;
    }
    LBAR();
    {
        const int tj = w >> 1, ti0 = 2 * (w & 1);
        f32x4 y[4];
#pragma unroll
        for (int kt = 0; kt < 4; ++kt) y[kt] = (f32x4){0.f, 0.f, 0.f, 0.f};
#pragma unroll
        for (int s = 0; s < 2; ++s) { const bf16x8 fb = frag_tr(img, tj, s, lane);
#pragma unroll
            for (int kt = 0; kt < 4; ++kt) y[kt] = MFMA16(frag_row(img, 4 + kt, s, lane), fb, y[kt]); }
        f32x4 d[2];
#pragma unroll
        for (int i = 0; i < 2; ++i) { d[i] = (f32x4){0.f, 0.f, 0.f, 0.f};
#pragma unroll
            for (int ks = 0; ks < 2; ++ks) {
                const bf16x8 fy = __builtin_bit_cast(bf16x8, (u32x4){pk2(y[2 * ks][0], y[2 * ks][1]), pk2(y[2 * ks][2], y[2 * ks][3]), pk2(y[2 * ks + 1][0], y[2 * ks + 1][1]), pk2(y[2 * ks + 1][2], y[2 * ks + 1][3])});
                const int row = 64 + 16 * (ti0 + i) + r;
                const u32x2 t0 = *(const LAS u32x2*)(img + offe(row, 64 + 32 * ks + 4 * q)), t1 = *(const LAS u32x2*)(img + offe(row, 64 + 32 * ks + 16 + 4 * q));
                d[i] = MFMA16(fy, __builtin_bit_cast(bf16x8, (u32x4){t0.x, t0.y, t1.x, t1.y}), d[i]); } }
        LBAR();
#pragma unroll
        for (int i = 0; i < 2; ++i) { u32x2 o; o.x = pk2(-d[i][0], -d[i][1]); o.y = pk2(-d[i][2], -d[i][3]);
            *(LAS u32x2*)(img + offe(64 + 16 * (ti0 + i) + r, 16 * tj + 4 * q)) = o; }
    }
    LBAR();
}

__device__ __forceinline__ void phase_prep(Frame& F) {
    LAS unsigned char* I0 = F.lds; LAS unsigned char* I1 = F.lds + IMGB; LAS unsigned char* I2 = F.lds + 2 * IMGB; LAS unsigned char* I3 = F.lds + 3 * IMGB;
    LAS float* sm = (LAS float*)(F.lds + MISC_OFF + 1024);
    LAS float* s_la = sm; LAS float* s_bet = sm + 128; LAS float* s_gc = sm + 256; LAS float* s_eg = sm + 384; LAS float* s_s2 = sm + 512; LAS float* s_t1 = sm + 640; LAS float* s_t2 = sm + 768;
#define LAUNDER() int tz_ = threadIdx.x; asm volatile("" : "+v"(tz_)); const int tid = tz_, lane = tz_ & 63, w = __builtin_amdgcn_readfirstlane(tz_ >> 6), wr = w >> 1, wc = w & 1, r = lane & 15, q = lane >> 4; (void)tid; (void)lane; (void)w; (void)wr; (void)wc; (void)r; (void)q
    const bf16* P = WSP(bf16, WS_P);
    for (int it = F.bid; it < 512 + 96; it += F.G) {
        int b, h, m, part = 3;
        if (it < 512) { b = it >> 7; h = (it >> 5) & 3; m = 2 + (it & 31); } else { const int c3 = it - 512; const int c = c3 / 3; part = c3 - 3 * c; b = c >> 3; h = (c >> 1) & 3; m = c & 1; }
        const bool isctx = m < 2; const int pos0 = 128 * m; const size_t row0 = (size_t)b * RPB + pos0; const size_t trow0 = (size_t)b * SEQ + (pos0 - CTXL);
        const bool hprev = isctx ? (m > 0) : (m > 2), hnext = isctx ? (m < 1) : (m < NCHUNK - 1);
        const size_t hoff = row0 * 512 + h * 128;
        f32x4 acc[2][4];
        if (part == 3 || part == 0) {
        const float lgf = F.ret_log_decay[h] * 1.4426950408889634f, lgb = F.ret_log_decay[4 + h] * 1.4426950408889634f;
        { LAUNDER();
        load_plain_img(I0, P + 0 * PGRP + hoff, 512, tid); load_plain_img(I1, P + 1 * PGRP + hoff, 512, tid);
        if (!isctx) load_plain_img(I2, P + 4 * PGRP + hoff, 512, tid);
        if (tid < 128) { s_t1[tid] = exp2f(lgf * (float)(127 - tid)); s_t2[tid] = exp2f(lgb * (float)tid); } }
        LBAR();
        if (!isctx) {
            { LAUNDER();
            zero_acc(acc); mm128<true>(I2, false, I0, false, wr, wc, lane, acc);
#pragma unroll
            for (int i = 0; i < 2; ++i)
#pragma unroll
                for (int j = 0; j < 4; ++j)
#pragma unroll
                    for (int e = 0; e < 4; ++e) { const int ii = 32 * wr + 16 * i + r, jj = 64 * wc + 16 * j + 4 * q + e; const int d = ii - jj;
                        const float wg = (d >= 0 ? exp2f(lgf * (float)d) : 0.f) + (d <= 0 ? exp2f(lgb * (float)(-d)) : 0.f); acc[i][j][e] *= wg; }
            st_img(I3, acc, wr, wc, lane); }
            LBAR();
            { LAUNDER();
            zero_acc(acc); mm128<true>(I3, false, I1, true, wr, wc, lane, acc);
            bf16* og = WSP(bf16, WS_ORET) + (trow0 + 32 * wr + r) * 512 + h * 128 + 64 * wc + 4 * q;
#pragma unroll
            for (int i = 0; i < 2; ++i)
#pragma unroll
                for (int j = 0; j < 4; ++j) { u32x2 o; o.x = pk2(acc[i][j][0], acc[i][j][1]); o.y = pk2(acc[i][j][2], acc[i][j][3]); *(u32x2*)(og + (size_t)(16 * i) * 512 + 16 * j) = o; } }
        }
#pragma unroll 1
        for (int dir = 0; dir < 2; ++dir) {
            LAS unsigned char* kw = dir ? I3 : I2;
            { LAUNDER(); scale_rows_img(kw, I0, dir ? s_t2 : s_t1, tid); }
            LBAR();
            LAUNDER();
            zero_acc(acc); mm128<false>(kw, true, I1, true, wr, wc, lane, acc);
            const int chain = (b * NH + h) * 2 + dir, n = dir ? (isctx ? 1 - m : 35 - m) : m;
            unsigned char* kv = F.ws + WS_GKV + ((size_t)chain * NCHUNK + n) * 32768;
#pragma unroll
            for (int i = 0; i < 2; ++i)
#pragma unroll
                for (int j = 0; j < 4; ++j) { const int mt = 2 * wr + i, nt = 4 * wc + j; u32x2 o; o.x = pk2(acc[i][j][0], acc[i][j][1]); o.y = pk2(acc[i][j][2], acc[i][j][3]);
                    *(u32x2*)(kv + ((size_t)((nt * 4 + (mt >> 1)) * 64 + (2 * (mt & 1) + (q >> 1)) * 16 + r)) * 16 + 8 * (q & 1)) = o; }
        }
        LBAR();
        }
#pragma unroll 1
        for (int dir = (part == 2 ? 1 : 0); dir < (part == 3 ? 2 : part == 0 ? 0 : part); ++dir) {
            const int chain = (b * NH + h) * 2 + dir, n = dir ? (isctx ? 1 - m : 35 - m) : m;
            { LAUNDER(); load_conv_img(I0, P + 2 * PGRP + hoff, F.gdn_conv + 512 + h * 128, hprev, hnext, 0, w, lane); }
            { LAUNDER(); load_conv_img(I1, P + 3 * PGRP + hoff, F.gdn_conv + 1024 + h * 128, hprev, hnext, 1, w, lane); }
            { LAUNDER(); if (tid < 128) { const size_t o = ((size_t)(dir * NB + b) * NH + h) * RPB + pos0 + tid; s_la[tid] = WSP(float, WS_LOGA)[o]; s_bet[tid] = WSP(float, WS_BETA)[o]; } }
            LBAR();
            { LAUNDER();
            if (w == 0) {
                const float a = s_la[2 * lane], c = s_la[2 * lane + 1]; const float pr = a + c; float inc = pr;
#pragma unroll
                for (int o = 1; o < 64; o <<= 1) { const float t = __shfl_up(inc, o); if (lane >= o) inc += t; }
                const float tot = __shfl(inc, 63); const float ex = inc - pr;
                float g0 = ex + a, g1 = ex + pr;
                if (dir) { g0 = tot - ex; g1 = tot - (ex + a); }
                s_gc[2 * lane] = g0; s_gc[2 * lane + 1] = g1; s_eg[2 * lane] = __expf(g0); s_eg[2 * lane + 1] = __expf(g1);
                s_s2[2 * lane] = __expf(tot - g0); s_s2[2 * lane + 1] = __expf(tot - g1);
                if (lane == 0) s_t1[0] = __expf(tot);
            } }
            LBAR();
            { LAUNDER();
            zero_acc(acc); mm128<true>(I0, false, I0, false, wr, wc, lane, acc);
#pragma unroll
            for (int i = 0; i < 2; ++i)
#pragma unroll
                for (int j = 0; j < 4; ++j) { const int ii = 32 * wr + 16 * i + r; const float gi = s_gc[ii], bi = s_bet[ii];
#pragma unroll
                    for (int e = 0; e < 4; ++e) { const int jj = 64 * wc + 16 * j + 4 * q + e;
                        const float f = dir ? s_bet[jj] * __expf(s_gc[jj] - gi) : bi * __expf(gi - s_gc[jj]); acc[i][j][e] = (ii > jj) ? acc[i][j][e] * f : 0.f; } }
            st_img(I2, acc, wr, wc, lane); }
            LBAR();
            { LAUNDER(); tri_inverse(I2, w, lane); }
            { LAUNDER();
#pragma unroll
            for (int i = 0; i < 4; ++i) { const int cidx = tid + 512 * i, row = cidx >> 4, ch = cidx & 15; float v[8], v2[8]; unpack8(*(const LAS u32x4*)(I2 + offb(row, ch)), v);
#pragma unroll
                for (int e = 0; e < 8; ++e) { const int k = dir ? row : 8 * ch + e; const float bb = s_bet[k]; v[e] *= bb; v2[e] = v[e] * s_eg[k]; }
                *(LAS u32x4*)(I2 + offb(row, ch)) = pack8(v); *(LAS u32x4*)(I3 + offb(row, ch)) = pack8(v2); } }
            LBAR();
            { LAUNDER();
            zero_acc(acc); mm128<true>(I3, dir != 0, I0, true, wr, wc, lane, acc);
            LBAR();
            st_img(I3, acc, wr, wc, lane); }
            { LAUNDER();
            zero_acc(acc); mm128<true>(I2, dir != 0, I1, true, wr, wc, lane, acc);
            LBAR();
            st_img(I2, acc, wr, wc, lane);
            scale_rows_img(I1, I0, s_s2, tid); }
            LBAR();
            {
                LAUNDER();
                const float dtot = s_t1[0];
                zero_acc(acc); mm128<false>(I1, true, I2, true, wr, wc, lane, acc);
                unsigned char* gc = F.ws + WS_GC + ((size_t)chain * NCHUNK + n) * 32768;
#pragma unroll
                for (int i = 0; i < 2; ++i)
#pragma unroll
                    for (int j = 0; j < 4; ++j) { const int mt = 2 * wr + i, nt = 4 * wc + j; u32x2 o; o.x = pk2(acc[i][j][0], acc[i][j][1]); o.y = pk2(acc[i][j][2], acc[i][j][3]);
                        *(u32x2*)(gc + ((size_t)((nt * 8 + mt) * 64 + lane)) * 8) = o; }
                }
                { LAUNDER(); const float dtot = s_t1[0];
                zero_acc(acc); mm128<true>(I1, true, I3, true, wr, wc, lane, acc);
                unsigned char* gm = F.ws + WS_GM + ((size_t)chain * NCHUNK + n) * 32768;
#pragma unroll
                for (int i = 0; i < 2; ++i)
#pragma unroll
                    for (int j = 0; j < 4; ++j) { const int mt = 2 * wr + i, ct = 4 * wc + j; const int rowi = 16 * mt + r; float v[4];
#pragma unroll
                        for (int e = 0; e < 4; ++e) v[e] = ((rowi == 16 * ct + 4 * q + e) ? dtot : 0.f) - acc[i][j][e];
                        u32x2 o; o.x = pk2(v[0], v[1]); o.y = pk2(v[2], v[3]);
                        *(u32x2*)(gm + ((size_t)((mt * 4 + (ct >> 1)) * 64 + q * 16 + r)) * 16 + 8 * (ct & 1)) = o; }
            }
            LBAR();
            if (!isctx) {
                { LAUNDER(); load_conv_img(I1, P + 6 * PGRP + hoff, F.gdn_conv + h * 128, hprev, hnext, 2, w, lane); }
                LBAR();
                { LAUNDER();
                zero_acc(acc); mm128<true>(I1, false, I0, false, wr, wc, lane, acc);
#pragma unroll
                for (int i = 0; i < 2; ++i) { const int ii = 32 * wr + 16 * i + r; const float gi = s_gc[ii];
#pragma unroll
                    for (int j = 0; j < 4; ++j)
#pragma unroll
                        for (int e = 0; e < 4; ++e) { const int jj = 64 * wc + 16 * j + 4 * q + e; const bool on = dir ? (jj >= ii) : (jj <= ii);
                            acc[i][j][e] = on ? acc[i][j][e] * __expf(gi - s_gc[jj]) : 0.f; } }
                LBAR();
                st_img(I0, acc, wr, wc, lane); }
                LBAR();
                { LAUNDER();
                zero_acc(acc); mm128<true>(I0, false, I2, true, wr, wc, lane, acc);
                { bf16* ogp = WSP(bf16, WS_OGDN) + (trow0 + 32 * wr + r) * 512 + h * 128 + 64 * wc + 4 * q;
#pragma unroll
                  for (int i = 0; i < 2; ++i)
#pragma unroll
                    for (int j = 0; j < 4; ++j) { bf16* pp = ogp + (size_t)(16 * i) * 512 + 16 * j; f32x4 v = acc[i][j];
                        if (dir) { const u32x2 pv = *(const u32x2*)pp; v[0] += bflo(pv.x); v[1] += bfhi(pv.x); v[2] += bflo(pv.y); v[3] += bfhi(pv.y); }
                        u32x2 o; o.x = pk2(v[0], v[1]); o.y = pk2(v[2], v[3]); *(u32x2*)pp = o; } } }
                { LAUNDER();
                zero_acc(acc); mm128<true>(I0, false, I3, true, wr, wc, lane, acc);
                unsigned char* qt = F.ws + WS_GQT + ((size_t)chain * 32 + (n - 2)) * 32768;
#pragma unroll
                for (int i = 0; i < 2; ++i) { const int ii = 32 * wr + 16 * i + r; const float egi = s_eg[ii];
#pragma unroll
                    for (int j = 0; j < 4; ++j) { const int mt = 2 * wr + i, ct = 4 * wc + j; const u32x2 qv = *(const LAS u32x2*)(I1 + offe(ii, 64 * wc + 16 * j + 4 * q));
                        u32x2 o; o.x = pk2(egi * bflo(qv.x) - acc[i][j][0], egi * bfhi(qv.x) - acc[i][j][1]); o.y = pk2(egi * bflo(qv.y) - acc[i][j][2], egi * bfhi(qv.y) - acc[i][j][3]);
                        *(u32x2*)(qt + ((size_t)((mt * 4 + (ct >> 1)) * 64 + q * 16 + r)) * 16 + 8 * (ct & 1)) = o; } } }
                LBAR();
            }
        }
    }
#undef LAUNDER
}

__device__ __forceinline__ void phase_scan(Frame& F) {
    const int lane = F.lane, w = F.wave, tid = F.tid;
    for (int it = F.bid; it < 256; it += F.G) {
        if (it < 128) {
            const int chain = (it & 7) * 4 + (it >> 5), dq = (it >> 3) & 3;
            const unsigned char* gm = F.ws + WS_GM + (size_t)chain * NCHUNK * 32768; unsigned char* gc = F.ws + WS_GC + (size_t)chain * NCHUNK * 32768;
            const unsigned char* gcs = gc + (size_t)(2 * dq) * 4096;
            if (w >= 4) {
                const int j = tid - 256; u32x4 sA[10], sB[10], sC[10], sD[10];
#define SCAN_LD(dst, n_) do { _Pragma("unroll") for (int i_ = 0; i_ < 8; ++i_) dst[i_] = *(const u32x4*)(gm + (size_t)(n_) * 32768 + (size_t)(j + 256 * i_) * 16); \
                              _Pragma("unroll") for (int i_ = 0; i_ < 2; ++i_) dst[8 + i_] = *(const u32x4*)(gcs + (size_t)(n_) * 32768 + (size_t)(j + 256 * i_) * 16); } while (0)
#define SCAN_ST(n_, src) do { LAS unsigned char* buf_ = F.lds + ((n_) % 3) * 40960; \
                              _Pragma("unroll") for (int i_ = 0; i_ < 8; ++i_) *(LAS u32x4*)(buf_ + (size_t)(j + 256 * i_) * 16) = src[i_]; \
                              _Pragma("unroll") for (int i_ = 0; i_ < 2; ++i_) *(LAS u32x4*)(buf_ + 32768 + (size_t)(j + 256 * i_) * 16) = src[8 + i_]; \
                              if ((n_) + 4 < NCHUNK) SCAN_LD(src, (n_) + 4); LBAR(); } while (0)
                SCAN_LD(sA, 0); SCAN_LD(sB, 1); SCAN_LD(sC, 2); SCAN_LD(sD, 3);
#pragma unroll 1
                for (int n = 0; n < 32; n += 4) { SCAN_ST(n, sA); SCAN_ST(n + 1, sB); SCAN_ST(n + 2, sC); SCAN_ST(n + 3, sD); }
                SCAN_ST(32, sA); SCAN_ST(33, sB);
#undef SCAN_LD
#undef SCAN_ST
            } else if (w < 2) {
                const int nt = 2 * dq + w;
                bf16x8 sf[4];
#pragma unroll
                for (int s = 0; s < 4; ++s) sf[s] = (bf16x8){0, 0, 0, 0, 0, 0, 0, 0};
#pragma unroll 1
                for (int n = 0; n < NCHUNK; ++n) {
                    LBAR();
                    const LAS unsigned char* buf = F.lds + (n % 3) * 40960; const LAS unsigned char* cb = buf + 32768 + w * 4096;
                    unsigned char* slot = gc + (size_t)n * 32768 + (size_t)nt * 4096; f32x4 acc[8];
#pragma unroll
                    for (int mt = 0; mt < 8; ++mt) { const u32x2 cv = *(const LAS u32x2*)(cb + (mt * 64 + lane) * 8); acc[mt] = (f32x4){bflo(cv.x), bfhi(cv.x), bflo(cv.y), bfhi(cv.y)}; }
#pragma unroll
                    for (int s = 0; s < 4; ++s)
#pragma unroll
                        for (int mt = 0; mt < 8; ++mt) acc[mt] = MFMA16(*(const LAS bf16x8*)(buf + ((mt * 4 + s) * 64 + lane) * 16), sf[s], acc[mt]);
#pragma unroll
                    for (int s = 0; s < 4; ++s) { const u32x4 pk = {pk2(acc[2 * s][0], acc[2 * s][1]), pk2(acc[2 * s][2], acc[2 * s][3]), pk2(acc[2 * s + 1][0], acc[2 * s + 1][1]), pk2(acc[2 * s + 1][2], acc[2 * s + 1][3])};
                        sf[s] = __builtin_bit_cast(bf16x8, pk); *(u32x4*)(slot + (size_t)(s * 64 + lane) * 16) = pk; }
                }
            } else {
#pragma unroll 1
                for (int n = 0; n < NCHUNK; ++n) LBAR();
            }
            LBAR();
#if defined(PROBE_PH) && PROBE_PH == 204
            if (F.bid == 0 && tid == 0) ((volatile LAS unsigned long long*)(F.lds + MISC_OFF + 4608))[5] = __builtin_amdgcn_s_memrealtime();
#endif
        } else {
            const int gidx = (it - 128) * NTHR + tid; const int chain = gidx >> 11, piece = gidx & 2047; const int h = (chain >> 1) & 3, dir = chain & 1;
            const float dec = expf(F.ret_log_decay[dir * 4 + h] * 128.f);
            unsigned char* kv = F.ws + WS_GKV + (size_t)chain * NCHUNK * 32768 + (size_t)piece * 16;
            float st[8];
#pragma unroll
            for (int e = 0; e < 8; ++e) st[e] = 0.f;
#pragma unroll 1
            for (int n0 = 0; n0 < NCHUNK; n0 += 17) { u32x4 v8[17];
#pragma unroll
                for (int j = 0; j < 17; ++j) v8[j] = *(const u32x4*)(kv + (size_t)(n0 + j) * 32768);
#pragma unroll
                for (int j = 0; j < 17; ++j) { float v[8]; unpack8(v8[j], v);
#pragma unroll
                    for (int e = 0; e < 8; ++e) st[e] = dec * st[e] + v[e];
                    *(u32x4*)(kv + (size_t)(n0 + j) * 32768) = pack8(st); } }
        }
    }
}

__device__ __forceinline__ void phase_out(Frame& F) {
    const bf16* P = WSP(bf16, WS_P);
    for (int it = F.bid; it < 512; it += F.G) {
        int tz_ = threadIdx.x; asm volatile("" : "+v"(tz_)); const int tid = tz_, lane = tz_ & 63, w = __builtin_amdgcn_readfirstlane(tz_ >> 6), r = lane & 15, q = lane >> 4;
        const int b = it >> 7, h = (it >> 5) & 3, m = 2 + (it & 31);
        const size_t prow = (size_t)b * RPB + 128 * m + 16 * w + r; const size_t trow = (size_t)b * SEQ + 128 * (m - 2) + 16 * w + r;
        const int il = 16 * w + r;
        bf16x8 fqg[2][4], fqr[4];
#pragma unroll
        for (int dir = 0; dir < 2; ++dir) { const int chain = (b * NH + h) * 2 + dir, n = dir ? 35 - m : m; const unsigned char* qt = F.ws + WS_GQT + ((size_t)chain * 32 + (n - 2)) * 32768;
#pragma unroll
            for (int s = 0; s < 4; ++s) fqg[dir][s] = *(const bf16x8*)(qt + (size_t)((w * 4 + s) * 64 + lane) * 16); }
        { const bf16* qp = P + 4 * PGRP + prow * 512 + h * 128;
#pragma unroll
          for (int s = 0; s < 4; ++s) fqr[s] = *(const bf16x8*)(qp + 32 * s + 8 * q); }
        u32x2 rog[8], ror[8];
        { const bf16* a = WSP(bf16, WS_OGDN) + trow * 512 + h * 128 + 4 * q; const bf16* c = WSP(bf16, WS_ORET) + trow * 512 + h * 128 + 4 * q;
#pragma unroll
          for (int nt = 0; nt < 8; ++nt) { rog[nt] = *(const u32x2*)(a + 16 * nt); ror[nt] = *(const u32x2*)(c + 16 * nt); } }
        {
            u32x4 v[4][4];
#pragma unroll
            for (int k = 0; k < 4; ++k) { const int dir = k & 1; const int chain = (b * NH + h) * 2 + dir, n = dir ? 35 - m : m;
                const unsigned char* sp = F.ws + (k < 2 ? WS_GC : WS_GKV) + ((size_t)chain * NCHUNK + (n - 1)) * 32768;
#pragma unroll
                for (int i = 0; i < 4; ++i) v[k][i] = *(const u32x4*)(sp + (size_t)(tid + 512 * i) * 16); }
#pragma unroll
            for (int k = 0; k < 4; ++k)
#pragma unroll
                for (int i = 0; i < 4; ++i) *(LAS u32x4*)(F.lds + k * 32768 + (tid + 512 * i) * 16) = v[k][i];
        }
        f32x4 og[8], orr[8];
#pragma unroll
        for (int nt = 0; nt < 8; ++nt) { og[nt] = (f32x4){bflo(rog[nt].x), bfhi(rog[nt].x), bflo(rog[nt].y), bfhi(rog[nt].y)}; orr[nt] = (f32x4){bflo(ror[nt].x), bfhi(ror[nt].x), bflo(ror[nt].y), bfhi(ror[nt].y)}; }
        LBAR();
#pragma unroll
        for (int dir = 0; dir < 2; ++dir) {
            {
                const LAS unsigned char* sp = F.lds + dir * 32768;
#pragma unroll
                for (int s = 0; s < 4; ++s)
#pragma unroll
                    for (int nt = 0; nt < 8; ++nt) og[nt] = MFMA16(*(const LAS bf16x8*)(sp + ((nt * 4 + s) * 64 + lane) * 16), fqg[dir][s], og[nt]);
            }
            {
                const LAS unsigned char* sp = F.lds + (2 + dir) * 32768;
                f32x4 t[8];
#pragma unroll
                for (int nt = 0; nt < 8; ++nt) t[nt] = (f32x4){0.f, 0.f, 0.f, 0.f};
#pragma unroll
                for (int s = 0; s < 4; ++s)
#pragma unroll
                    for (int nt = 0; nt < 8; ++nt) t[nt] = MFMA16(*(const LAS bf16x8*)(sp + ((nt * 4 + s) * 64 + lane) * 16), fqr[s], t[nt]);
                const float lg = F.ret_log_decay[dir * 4 + h]; const float dcy = expf(lg * (float)(dir ? 128 - il : il + 1));
#pragma unroll
                for (int nt = 0; nt < 8; ++nt) orr[nt] = orr[nt] + t[nt] * dcy;
            }
        }
        {
            float s1 = 0.f;
#pragma unroll
            for (int nt = 0; nt < 8; ++nt) s1 += (orr[nt][0] + orr[nt][1]) + (orr[nt][2] + orr[nt][3]);
            s1 += __shfl_xor(s1, 16); s1 += __shfl_xor(s1, 32); const float mean = s1 * (1.f / 128.f);
            float s2 = 0.f, s3 = 0.f;
#pragma unroll
            for (int nt = 0; nt < 8; ++nt)
#pragma unroll
                for (int e = 0; e < 4; ++e) { const float d = orr[nt][e] - mean; s2 += d * d; s3 += og[nt][e] * og[nt][e]; }
            s2 += __shfl_xor(s2, 16); s2 += __shfl_xor(s2, 32); s3 += __shfl_xor(s3, 16); s3 += __shfl_xor(s3, 32);
            const float rs_r = 1.0f / sqrtf(s2 * (1.f / 128.f) + EPS), rs_g = 1.0f / sqrtf(s3 * (1.f / 128.f) + EPS);
            const bf16* rg = P + 5 * PGRP + prow * 512 + h * 128 + 4 * q; const bf16* gz = P + 7 * PGRP + prow * 512 + h * 128 + 4 * q;
            bf16* ry = WSP(bf16, WS_RETY) + trow * 512 + h * 128 + 4 * q; bf16* gy = WSP(bf16, WS_GDNY) + trow * 512 + h * 128 + 4 * q;
#pragma unroll
            for (int nt = 0; nt < 8; ++nt) { const u32x2 a = *(const u32x2*)(rg + 16 * nt), c = *(const u32x2*)(gz + 16 * nt);
                const float ga[4] = {bflo(a.x), bfhi(a.x), bflo(a.y), bfhi(a.y)}, gc4[4] = {bflo(c.x), bfhi(c.x), bflo(c.y), bfhi(c.y)};
                const f32x4 wr4 = *(const f32x4*)(F.ret_gn_w + h * 128 + 16 * nt + 4 * q), wg4 = *(const f32x4*)(F.gdn_norm_w + h * 128 + 16 * nt + 4 * q);
                float yr[4], yg[4];
#pragma unroll
                for (int e = 0; e < 4; ++e) { yr[e] = (orr[nt][e] - mean) * rs_r * wr4[e] * siluf_(ga[e]); yg[e] = og[nt][e] * rs_g * wg4[e] * siluf_(gc4[e]); }
                u32x2 o1, o2; o1.x = pk2(yr[0], yr[1]); o1.y = pk2(yr[2], yr[3]); o2.x = pk2(yg[0], yg[1]); o2.y = pk2(yg[2], yg[3]);
                *(u32x2*)(ry + 16 * nt) = o1; *(u32x2*)(gy + 16 * nt) = o2; }
        }
        LBAR();
    }
}

struct SchedMerge {
    const char *A0, *A1, *B0, *B1; int G, c;
    __device__ __forceinline__ bool next(int i, pg8::Unit& u) const {
        const int L = (i >> 1) * G + c; if (L >= 256) return false; const int term = i & 1;
        const int xcd = L % 8, off = L / 8; const int w = xcd * 32 + off;
        u.pm = w >> 2; u.pn = w & 3; u.e = term; u.base = 0;
        u.A = (term ? A1 : A0) + (size_t)u.pm * 256 * 512 * 2; u.B = (term ? B1 : B0) + (size_t)u.pn * 256 * 512 * 2; return true; }
    __device__ __forceinline__ int row_index(const pg8::Unit&, int r) const { return r; }
};
struct EpiMerge {
    const bf16* GATES; bf16* TMP; bf16* MERGED;
    __device__ __forceinline__ void operator()(const f32x4 (&acc)[2][2][4][2], const pg8::Unit& u, int wr, int wc, int fr, int fq) const {
#pragma unroll
        for (int ai = 0; ai < 2; ++ai) {
            u32x4 gv[4][2], pv[4][2];
#pragma unroll
            for (int m = 0; m < 4; ++m) { const size_t row = (size_t)u.pm * 256 + ai * 128 + wr * 64 + m * 16 + fr;
#pragma unroll
                for (int bj = 0; bj < 2; ++bj) { const int col = u.pn * 256 + bj * 128 + wc * 32 + 8 * fq;
                    gv[m][bj] = *(const u32x4*)(GATES + row * 2048 + u.e * 1024 + col);
                    if (u.e != 0) pv[m][bj] = *(const u32x4*)(TMP + row * DM + col); } }
#pragma unroll
            for (int m = 0; m < 4; ++m) { const size_t row = (size_t)u.pm * 256 + ai * 128 + wr * 64 + m * 16 + fr;
#pragma unroll
                for (int bj = 0; bj < 2; ++bj) { const int col = u.pn * 256 + bj * 128 + wc * 32 + 8 * fq;
                    float g[8]; unpack8(gv[m][bj], g);
                    float v[8] = {acc[ai][bj][m][0][0], acc[ai][bj][m][0][1], acc[ai][bj][m][0][2], acc[ai][bj][m][0][3], acc[ai][bj][m][1][0], acc[ai][bj][m][1][1], acc[ai][bj][m][1][2], acc[ai][bj][m][1][3]};
                    if (u.e == 0) {
#pragma unroll
                        for (int i = 0; i < 8; ++i) v[i] *= g[i];
                        *(u32x4*)(TMP + row * DM + col) = pack8(v);
                    } else { float p[8]; unpack8(pv[m][bj], p);
#pragma unroll
                        for (int i = 0; i < 8; ++i) v[i] = p[i] + v[i] * g[i];
                        *(u32x4*)(MERGED + row * DM + col) = pack8(v); } } }
        }
    }
};
struct SchedDense {
    const char *A, *B; int nM, nN, K, G, c;
    __device__ __forceinline__ bool next(int i, pg8::Unit& u) const {
        const int L = i * G + c; const int nwg = nM * nN; if (L >= nwg) return false;
        int w = L; if (nwg % 8 == 0) { const int xcd = L % 8, off = L / 8; w = xcd * (nwg / 8) + off; }
        u.pm = w / nN; u.pn = w % nN; u.e = 0; u.base = 0; u.A = A + (size_t)u.pm * 256 * K * 2; u.B = B + (size_t)u.pn * 256 * K * 2; return true; }
    __device__ __forceinline__ int row_index(const pg8::Unit&, int r) const { return r; }
};
struct EpiBf16Store { bf16* O; int ldc;
    __device__ __forceinline__ void operator()(const f32x4 (&acc)[2][2][4][2], const pg8::Unit& u, int wr, int wc, int fr, int fq) const {
#pragma unroll
        for (int ai = 0; ai < 2; ++ai)
#pragma unroll
            for (int m = 0; m < 4; ++m) { const size_t row = (size_t)u.pm * 256 + ai * 128 + wr * 64 + m * 16 + fr;
#pragma unroll
                for (int bj = 0; bj < 2; ++bj) { const int col = u.pn * 256 + bj * 128 + wc * 32 + 8 * fq; const f32x4 v0 = acc[ai][bj][m][0], v1 = acc[ai][bj][m][1];
                    u32x4 w; w.x = pg8::cvt_pk_bf16(v0[0], v0[1]); w.y = pg8::cvt_pk_bf16(v0[2], v0[3]); w.z = pg8::cvt_pk_bf16(v1[0], v1[1]); w.w = pg8::cvt_pk_bf16(v1[2], v1[3]);
                    *(u32x4*)(O + row * ldc + col) = w; } }
    }
};

__device__ __forceinline__ void load_row_bf16(const bf16* p, int lane, float (&v)[16]) { float a[8], b[8]; unpack8(*(const u32x4*)(p + 8 * lane), a); unpack8(*(const u32x4*)(p + 512 + 8 * lane), b);
#pragma unroll
    for (int i = 0; i < 8; ++i) { v[i] = a[i]; v[8 + i] = b[i]; } }
__device__ __forceinline__ void load_row_f32(const float* p, int lane, float (&v)[16]) {
#pragma unroll
    for (int q = 0; q < 4; ++q) { const f32x4 a = *(const f32x4*)(p + (q >> 1) * 512 + 8 * lane + 4 * (q & 1)); v[4 * q] = a.x; v[4 * q + 1] = a.y; v[4 * q + 2] = a.z; v[4 * q + 3] = a.w; } }
__device__ __forceinline__ void store_row_f32(float* p, int lane, const float (&v)[16]) {
#pragma unroll
    for (int q = 0; q < 4; ++q) *(f32x4*)(p + (q >> 1) * 512 + 8 * lane + 4 * (q & 1)) = (f32x4){v[4 * q], v[4 * q + 1], v[4 * q + 2], v[4 * q + 3]}; }
__device__ __forceinline__ void compute_x1(Frame& F, int t, float (&x1)[16]) {
    const int b = t / SEQ; const float* mod = WSP(float, WS_MOD) + b * 6144;
    const bf16* mop = WSP(bf16, WS_MO) + (size_t)t * DM;
    const u32x4 m0 = *(const u32x4*)(mop + 8 * F.lane), m1 = *(const u32x4*)(mop + 512 + 8 * F.lane);
    float ss = 0.f;
    { float a[8], c[8]; unpack8(m0, a); unpack8(m1, c);
#pragma unroll
      for (int i = 0; i < 8; ++i) ss += a[i] * a[i] + c[i] * c[i]; }
    const float rstd = 1.0f / sqrtf(wave_sum(ss) * (1.f / DM) + EPS);
#pragma unroll
    for (int hf = 0; hf < 2; ++hf) {
        const int c0 = hf * 512 + 8 * F.lane; float mo[8]; unpack8(hf ? m1 : m0, mo);
        const float* xp = F.x + (size_t)t * DM + c0; const float* wp = F.n_mix_post + c0; const float* gp = mod + 2 * DM + c0;
#pragma unroll
        for (int q = 0; q < 2; ++q) { const f32x4 xv = *(const f32x4*)(xp + 4 * q), wv = *(const f32x4*)(wp + 4 * q), g1 = *(const f32x4*)(gp + 4 * q);
#pragma unroll
            for (int e = 0; e < 4; ++e) x1[hf * 8 + 4 * q + e] = xv[e] + g1[e] * (mo[4 * q + e] * rstd * wv[e]); }
    }
}
__device__ __forceinline__ void route_token(Frame& F, int t, float logit, LAS unsigned* lcnt, LAS u32x2* stage, unsigned* cnt, int2* list) {
    logit = (logit == logit) ? logit : 0.f;
    const float score = 1.f / (1.f + expf(-logit)); const float biased = score + F.router_bias[F.lane];
    int rk = 0;
#pragma unroll
    for (int o = 0; o < 8; ++o) { const int src = (F.lane & ~7) | o; const float ov = __shfl(biased, src); rk += ((ov > biased) | ((ov == biased) & (src < F.lane))) ? 1 : 0; }
    float gs = rk < 2 ? biased : 0.f; gs += __shfl_xor(gs, 1); gs += __shfl_xor(gs, 2); gs += __shfl_xor(gs, 4);
    int grk = 0; const int myg = F.lane >> 3;
#pragma unroll
    for (int o = 0; o < 8; ++o) { const float ov = __shfl(gs, o * 8); grk += ((ov > gs) | ((ov == gs) & (o < myg))) ? 1 : 0; }
    const bool keep = grk < 4;
    const float cand = keep ? biased : -__builtin_inff();
    int erk = 0;
#pragma unroll
    for (int o = 0; o < 64; ++o) { const float ov = __builtin_bit_cast(float, __builtin_amdgcn_readlane(__builtin_bit_cast(int, cand), o)); erk += ((ov > cand) | ((ov == cand) & (o < F.lane))) ? 1 : 0; }
    const bool sel = keep && erk < TOPK;
    const float ssum = wave_sum(sel ? score : 0.f);
    if (sel) { const float w = score / ssum * 2.5f; const unsigned pos = __hip_atomic_fetch_add(lcnt + F.lane, 1u, __ATOMIC_RELAXED, __HIP_MEMORY_SCOPE_WORKGROUP);
        if (pos < 48u) stage[F.lane * 48 + pos] = (u32x2){(unsigned)(t * 8 + erk), __float_as_uint(w)};
        else { const unsigned gp = atomicAdd(cnt + 64 * F.lane, 1u); list[(size_t)F.lane * NT + gp] = make_int2(t * 8 + erk, __float_as_int(w)); } }
}
__device__ __forceinline__ void phase_route(Frame& F) {
    constexpr int HST = 2064;
    LAS unsigned char* hhi = F.lds;
    LAS unsigned char* hlo = F.lds + 16 * HST;
    LAS float* part = (LAS float*)(F.lds + 2 * 16 * HST);
    LAS u32x2* stage = (LAS u32x2*)(F.lds + 2 * 16 * HST + 32768);
    LAS unsigned* lcnt = (LAS unsigned*)(F.lds + MISC_OFF + 1024);
    unsigned* cnt = F.ctl + CW_CNT; int2* list = WSP(int2, WS_LIST);
    const int r = F.lane & 15, q = F.lane >> 4, kbase = F.wave * 128;
    bf16x8 wh[4][4]; u32x2 wl8[4][4];
#pragma unroll
    for (int ft = 0; ft < 4; ++ft) {
        asm volatile("" ::: "memory");
#pragma unroll
        for (int s = 0; s < 4; ++s) { float wv[8];
#pragma unroll
            for (int j = 0; j < 8; ++j) wv[j] = F.w_router[(size_t)(kbase + 32 * s + 8 * q + j) * NEXP + 16 * ft + r];
            unsigned hi[8];
#pragma unroll
            for (int j = 0; j < 8; ++j) hi[j] = f2bf(wv[j]);
            wh[ft][s] = __builtin_bit_cast(bf16x8, (u32x4){hi[0] | (hi[1] << 16), hi[2] | (hi[3] << 16), hi[4] | (hi[5] << 16), hi[6] | (hi[7] << 16)});
            float lf[8];
#pragma unroll
            for (int j = 0; j < 8; ++j) lf[j] = (wv[j] - bf2f(hi[j])) * 4096.0f;
            unsigned p0 = __builtin_amdgcn_cvt_pk_bf8_f32(lf[0], lf[1], 0u, false); p0 = __builtin_amdgcn_cvt_pk_bf8_f32(lf[2], lf[3], p0, true);
            unsigned p1 = __builtin_amdgcn_cvt_pk_bf8_f32(lf[4], lf[5], 0u, false); p1 = __builtin_amdgcn_cvt_pk_bf8_f32(lf[6], lf[7], p1, true);
            wl8[ft][s] = (u32x2){p0, p1}; } }
    for (int g64 = F.bid; g64 < NT / 64; g64 += F.G) {
        if (F.tid < 64) lcnt[F.tid] = 0u;
        __syncthreads();
#pragma unroll 1
        for (int grp = 0; grp < 4; ++grp) {
#pragma unroll 1
            for (int tw = 0; tw < 2; ++tw) {
                const int slot = 2 * F.wave + tw; const int t = g64 * 64 + grp * 16 + slot; const int b = t / SEQ; const float* mod = WSP(float, WS_MOD) + b * 6144;
                float x1[16]; compute_x1(F, t, x1);
                float ss = 0.f;
#pragma unroll
                for (int i = 0; i < 16; ++i) ss += x1[i] * x1[i];
                const float rstd = 1.0f / sqrtf(wave_sum(ss) * (1.f / DM) + EPS);
                bf16* d = WSP(bf16, WS_H2) + (size_t)t * DM;
#pragma unroll
                for (int hf = 0; hf < 2; ++hf) {
                    asm volatile("" ::: "memory");
                    const int c0 = hf * 512 + 8 * F.lane; float h2[8];
#pragma unroll
                    for (int qq = 0; qq < 2; ++qq) { const f32x4 wv = *(const f32x4*)(F.n_ffn_pre + c0 + 4 * qq), sh = *(const f32x4*)(mod + 3 * DM + c0 + 4 * qq), sc = *(const f32x4*)(mod + 4 * DM + c0 + 4 * qq);
#pragma unroll
                        for (int e = 0; e < 4; ++e) h2[4 * qq + e] = x1[hf * 8 + 4 * qq + e] * rstd * wv[e] * (1.f + sc[e]) + sh[e]; }
                    const u32x4 hp = pack8(h2); *(u32x4*)(d + c0) = hp;
                    float lo8[8]; { float hb[8]; unpack8(hp, hb);
#pragma unroll
                        for (int e = 0; e < 8; ++e) lo8[e] = h2[e] - hb[e]; }
                    *(LAS u32x4*)(hhi + slot * HST + c0 * 2) = hp; *(LAS u32x4*)(hlo + slot * HST + c0 * 2) = pack8(lo8);
                }
            }
            LBAR();
            {
                typedef float f32x2v __attribute__((ext_vector_type(2)));
                f32x4 acc[4], acc2[4];
#pragma unroll
                for (int ft = 0; ft < 4; ++ft) { acc[ft] = (f32x4){0.f, 0.f, 0.f, 0.f}; acc2[ft] = (f32x4){0.f, 0.f, 0.f, 0.f}; }
#pragma unroll
                for (int s = 0; s < 4; ++s) { const int off = r * HST + (kbase + 32 * s + 8 * q) * 2;
                    const bf16x8 bh = *(const LAS bf16x8*)(hhi + off), bl = *(const LAS bf16x8*)(hlo + off);
#pragma unroll
                    for (int ft = 0; ft < 4; ++ft) {
                        const f32x2v l0 = __builtin_amdgcn_cvt_pk_f32_bf8(wl8[ft][s].x, false), l1 = __builtin_amdgcn_cvt_pk_f32_bf8(wl8[ft][s].x, true), l2 = __builtin_amdgcn_cvt_pk_f32_bf8(wl8[ft][s].y, false), l3 = __builtin_amdgcn_cvt_pk_f32_bf8(wl8[ft][s].y, true);
                        const bf16x8 wlo = __builtin_bit_cast(bf16x8, (u32x4){pk2(l0.x, l0.y), pk2(l1.x, l1.y), pk2(l2.x, l2.y), pk2(l3.x, l3.y)});
                        acc[ft] = MFMA16(wh[ft][s], bh, acc[ft]); acc[ft] = MFMA16(wh[ft][s], bl, acc[ft]); acc2[ft] = MFMA16(wlo, bh, acc2[ft]); } }
#pragma unroll
                for (int ft = 0; ft < 4; ++ft)
#pragma unroll
                    for (int e = 0; e < 4; ++e) part[(F.wave * 64 + 16 * ft + 4 * q + e) * 16 + r] = acc[ft][e] + acc2[ft][e] * (1.0f / 4096.0f);
            }
            LBAR();
#pragma unroll 1
            for (int tw = 0; tw < 2; ++tw) { const int slot = 2 * F.wave + tw; float logit = 0.f;
#pragma unroll
                for (int w = 0; w < 8; ++w) logit += part[(w * 64 + F.lane) * 16 + slot];
                route_token(F, g64 * 64 + grp * 16 + slot, logit, lcnt, stage, cnt, list); }
        }
        __syncthreads();
        if (F.tid < 64) { const unsigned n = lcnt[F.tid] < 48u ? lcnt[F.tid] : 48u; lcnt[F.tid] = n; lcnt[64 + F.tid] = atomicAdd(cnt + 64 * F.tid, n); }
        __syncthreads();
        { const int e = F.tid >> 3; const unsigned n = lcnt[e], base = lcnt[64 + e];
          for (unsigned j = F.tid & 7; j < n; j += 8) { const u32x2 v = stage[e * 48 + j]; list[(size_t)e * NT + base + j] = make_int2((int)v.x, (int)v.y); } }
        __syncthreads();
    }
}

__device__ __forceinline__ void build_tile_prefix(Frame& F, LAS int* tp) {
    __syncthreads();
    if (F.tid == 0) { int s = 0; const unsigned* cnt = F.ctl + CW_CNT; for (int e = 0; e < 64; ++e) { const int ce = (int)__hip_atomic_load(cnt + 64 * e, __ATOMIC_RELAXED, __HIP_MEMORY_SCOPE_AGENT); tp[96 + e] = ce; tp[e] = s; s += (ce + 255) >> 8; } tp[64] = s; tp[65] = s + 64;
        const int x = F.bid & 7; int l = 0; for (int k = 0; k < 8; ++k) { tp[80 + k] = l; l += tp[x + 8 * k + 1] - tp[x + 8 * k]; } tp[88] = l; tp[89] = l + 8; }
    __syncthreads();
}
struct SchedMoe {
    const char* A; const char* B; const int2* list; const unsigned* cnt; const LAS int* tp; int npn, K, G, c; size_t bstride  ; int bcol0  ; bool gather;
    __device__ __forceinline__ bool next(int i, pg8::Unit& u) const {
        int e, pm;
        if ((G & 7) == 0) {
            const int x = c & 7, W = G >> 3, L = i * W + (c >> 3); const int nt = __builtin_amdgcn_readfirstlane(tp[89]); if (L >= nt * npn) return false;
            const int tl = L / npn; u.pn = L % npn; int k = 0;
            for (int q = 8; q >= 1; q >>= 1) if (k + q <= 8 && __builtin_amdgcn_readfirstlane(tp[80 + k + q]) <= tl) k += q;
            k = __builtin_amdgcn_readfirstlane(k); const int off = tl - __builtin_amdgcn_readfirstlane(tp[80 + k]);
            if (k < 8) { e = x + 8 * k; pm = off; } else { e = 64; pm = x + 8 * off; }
        } else {
            const int L = i * G + c; const int ntile = __builtin_amdgcn_readfirstlane(tp[65]); if (L >= ntile * npn) return false;
            const int tile = L / npn; u.pn = L % npn; e = 0;
            for (int q = 64; q >= 1; q >>= 1) if (e + q <= 64 && __builtin_amdgcn_readfirstlane(tp[e + q]) <= tile) e += q;
            e = __builtin_amdgcn_readfirstlane(e); pm = tile - __builtin_amdgcn_readfirstlane(tp[e]);
        }
        u.e = e; u.pm = pm; u.base = (e < 64 ? (__builtin_amdgcn_readfirstlane(tp[e < 64 ? e : 0]) + pm) * 256 : SLOT_SH + pm * 256);
        u.A = gather ? A : A + (size_t)u.base * K * 2; u.B = B + (size_t)e * bstride + (size_t)(bcol0 + u.pn * 256) * K * 2; return true; }
    __device__ __forceinline__ int row_index(const pg8::Unit& u, int r) const {
        if (u.e == 64) return u.pm * 256 + r;
        const unsigned tok = (unsigned)list[(size_t)u.e * NT + u.pm * 256 + r].x >> 3; return (int)(tok < (unsigned)NT ? tok : 0u); }
};
struct EpiUp { bf16* HMID;
    __device__ __forceinline__ void operator()(const f32x4 (&acc)[2][2][4][2], const pg8::Unit& u, int wr, int wc, int fr, int fq) const {
#pragma unroll
        for (int ai = 0; ai < 2; ++ai)
#pragma unroll
            for (int m = 0; m < 4; ++m) { const size_t slot = (size_t)u.base + ai * 128 + wr * 64 + m * 16 + fr;
#pragma unroll
                for (int bj = 0; bj < 2; ++bj) { const int hid = u.pn * 128 + bj * 64 + wc * 16 + fq * 4; const f32x4 g = acc[ai][bj][m][0], up = acc[ai][bj][m][1];
                    u32x2 w; w.x = pg8::cvt_pk_bf16(siluf_(g[0]) * up[0], siluf_(g[1]) * up[1]); w.y = pg8::cvt_pk_bf16(siluf_(g[2]) * up[2], siluf_(g[3]) * up[3]);
                    *(u32x2*)(HMID + slot * DEXP + hid) = w; } }
    }
};
constexpr float YB_SCALE = 64.0f, YB_INV = 1.0f / 64.0f;
__device__ __forceinline__ unsigned pk4_fp8(float a, float b, float c, float d) {
    a = fminf(fmaxf(a * YB_SCALE, -448.f), 448.f); b = fminf(fmaxf(b * YB_SCALE, -448.f), 448.f); c = fminf(fmaxf(c * YB_SCALE, -448.f), 448.f); d = fminf(fmaxf(d * YB_SCALE, -448.f), 448.f);
    unsigned p = __builtin_amdgcn_cvt_pk_fp8_f32(a, b, 0u, false); return __builtin_amdgcn_cvt_pk_fp8_f32(c, d, p, true); }
struct EpiDown { unsigned char* YB; float* OUT; const int2* list; const LAS int* tp;
    __device__ __forceinline__ void operator()(const f32x4 (&acc)[2][2][4][2], const pg8::Unit& u, int wr, int wc, int fr, int fq) const {
        if (u.e == 64) {
#pragma unroll
            for (int ai = 0; ai < 2; ++ai)
#pragma unroll
                for (int m = 0; m < 4; ++m) { const int idx = u.pm * 256 + ai * 128 + wr * 64 + m * 16 + fr; float* o = OUT + (size_t)idx * DM + u.pn * 256 + wc * 32 + 8 * fq;
#pragma unroll
                    for (int bj = 0; bj < 2; ++bj) { *(f32x4*)(o + bj * 128) = acc[ai][bj][m][0]; *(f32x4*)(o + bj * 128 + 4) = acc[ai][bj][m][1]; } }
        } else {
            const int n = __builtin_amdgcn_readfirstlane(tp[96 + u.e]); int2 dw[2][4];
#pragma unroll
            for (int ai = 0; ai < 2; ++ai)
#pragma unroll
                for (int m = 0; m < 4; ++m) { int idx = u.pm * 256 + ai * 128 + wr * 64 + m * 16 + fr; idx = idx < n ? idx : n - 1; dw[ai][m] = list[(size_t)u.e * NT + idx]; }
#pragma unroll
            for (int ai = 0; ai < 2; ++ai)
#pragma unroll
                for (int m = 0; m < 4; ++m) { const int idx = u.pm * 256 + ai * 128 + wr * 64 + m * 16 + fr;
                    if (idx < n) { const float w = __int_as_float(dw[ai][m].y); unsigned char* o = YB + (size_t)dw[ai][m].x * DM + u.pn * 256 + wc * 32 + 8 * fq;
#pragma unroll
                        for (int bj = 0; bj < 2; ++bj) { const f32x4 v0 = acc[ai][bj][m][0] * w, v1 = acc[ai][bj][m][1] * w;
                            u32x2 q; q.x = pk4_fp8(v0[0], v0[1], v0[2], v0[3]); q.y = pk4_fp8(v1[0], v1[1], v1[2], v1[3]);
                            *(u32x2*)(o + bj * 128) = q; } } }
        }
    }
};
__device__ __forceinline__ void phase_final(Frame& F) {
    typedef float f32x2v __attribute__((ext_vector_type(2)));
    const int gw = F.bid * NWAVES + F.wave, NGW = F.G * NWAVES; const unsigned char* YB = F.ws + WS_YB;
    for (int t = gw; t < NT; t += NGW) {
        const int b = t / SEQ; const float* mod = WSP(float, WS_MOD) + b * 6144;
        u32x2 ya[8], yb[8];
#pragma unroll
        for (int k = 0; k < 8; ++k) { const unsigned char* rp = YB + ((size_t)t * 8 + k) * DM; ya[k] = *(const u32x2*)(rp + 8 * F.lane); yb[k] = *(const u32x2*)(rp + 512 + 8 * F.lane); }
        float mv[16]; load_row_f32(F.out + (size_t)t * DM, F.lane, mv);
        float ra[16];
#pragma unroll
        for (int i = 0; i < 16; ++i) ra[i] = 0.f;
#pragma unroll
        for (int k = 0; k < 8; ++k) {
            const f32x2v a0 = __builtin_amdgcn_cvt_pk_f32_fp8(ya[k].x, false), a1 = __builtin_amdgcn_cvt_pk_f32_fp8(ya[k].x, true), a2 = __builtin_amdgcn_cvt_pk_f32_fp8(ya[k].y, false), a3 = __builtin_amdgcn_cvt_pk_f32_fp8(ya[k].y, true);
            const f32x2v c0 = __builtin_amdgcn_cvt_pk_f32_fp8(yb[k].x, false), c1 = __builtin_amdgcn_cvt_pk_f32_fp8(yb[k].x, true), c2 = __builtin_amdgcn_cvt_pk_f32_fp8(yb[k].y, false), c3 = __builtin_amdgcn_cvt_pk_f32_fp8(yb[k].y, true);
            ra[0] += a0.x; ra[1] += a0.y; ra[2] += a1.x; ra[3] += a1.y; ra[4] += a2.x; ra[5] += a2.y; ra[6] += a3.x; ra[7] += a3.y;
            ra[8] += c0.x; ra[9] += c0.y; ra[10] += c1.x; ra[11] += c1.y; ra[12] += c2.x; ra[13] += c2.y; ra[14] += c3.x; ra[15] += c3.y; }
        float ss = 0.f;
#pragma unroll
        for (int i = 0; i < 16; ++i) { mv[i] += ra[i] * YB_INV; ss += mv[i] * mv[i]; }
        const float rstd = 1.0f / sqrtf(wave_sum(ss) * (1.f / DM) + EPS);
        float x1[16]; compute_x1(F, t, x1);
        float wv[16], g2[16]; load_row_f32(F.n_ffn_post, F.lane, wv); load_row_f32(mod + 5 * DM, F.lane, g2);
        float o[16];
#pragma unroll
        for (int i = 0; i < 16; ++i) o[i] = x1[i] + g2[i] * (mv[i] * rstd * wv[i]);
        store_row_f32(F.out + (size_t)t * DM, F.lane, o);
    }
}

constexpr int N_PHASES = 16;
__global__ void __launch_bounds__(NTHR, 2) fwd(Args args) {
    extern __shared__ __attribute__((aligned(16))) unsigned char lds_raw[];
    Frame F; F.lds = (LAS unsigned char*)lds_raw; F.tid = threadIdx.x; F.lane = F.tid & 63; F.wave = __builtin_amdgcn_readfirstlane(F.tid >> 6); F.G = gridDim.x; F.bid = blockIdx.x;
    F.x = args.in[0]; F.c = args.in[1]; F.ctx = args.in[2]; F.c_ctx = args.in[3]; F.w_mod = args.in[4]; F.b_mod = args.in[5]; F.n_mix_pre = args.in[6]; F.n_mix_post = args.in[7];
    F.n_ffn_pre = args.in[8]; F.n_ffn_post = args.in[9]; F.w_in = args.in[10]; F.gdn_conv = args.in[11]; F.ret_log_decay = args.in[12]; F.gdn_a_log = args.in[13]; F.gdn_dt_bias = args.in[14];
    F.ret_gn_w = args.in[15]; F.gdn_norm_w = args.in[16]; F.w_ret_out = args.in[17]; F.w_gdn_out = args.in[18]; F.w_o = args.in[19]; F.w_router = args.in[20]; F.router_bias = args.in[21];
    F.w_gate = args.in[22]; F.w_up = args.in[23]; F.w_down = args.in[24]; F.w_sh_gate = args.in[25]; F.w_sh_up = args.in[26]; F.w_sh_down = args.in[27];
    F.out = args.out; F.ws = args.ws; F.ctl = (unsigned*)(args.ws + WS_CTL);
    volatile LAS unsigned* MISC = (volatile LAS unsigned*)(F.lds + MISC_OFF);
    if (F.tid < 64) MISC[F.tid] = 0u;
    __syncthreads();
#if MK_ONE_LAUNCH
    XcdBarrier bar = xcd_barrier_post(F.ctl + CW_BAR, MISC + 8);
#define SEAM() xcd_barrier(bar)
#else
#define SEAM() do {} while (0)
#endif
    const int lo = args.ph_lo, hi = args.ph_hi;
#ifndef PHM
#define PHM 0xffff
#endif
#ifndef DUP
#define DUP -1
#endif
#define IN(k) (((PHM >> (k)) & 1) && lo <= (k) && (k) < hi)
    LAS int* tp = (LAS int*)(F.lds + MISC_OFF + 256);
#ifndef PROBE_PH
#define PROBE_PH -1
#endif
#ifdef PROBE_A
#define PROBE_IA PROBE_A
#define PROBE_IB PROBE_B
#else
#define PROBE_IA (PROBE_PH % 100)
#define PROBE_IB ((PROBE_PH % 100) + 1)
#endif
    volatile LAS unsigned long long* tsl = (volatile LAS unsigned long long*)(F.lds + MISC_OFF + 4608);
#define STAMP(k) do { if (PROBE_PH >= 0 && F.bid == 0 && F.tid == 0 && !(PROBE_PH == 204 && (k) == 5)) tsl[k] = __builtin_amdgcn_s_memrealtime(); } while (0)

    STAMP(0);
    if (IN(0)) _Pragma("unroll") for (int rep_ = 0; rep_ < ((DUP == 0) ? 2 : 1); ++rep_) { phase_prologue(F); SEAM(); }
    STAMP(1);
    if (IN(1)) _Pragma("unroll") for (int rep_ = 0; rep_ < ((DUP == 1) ? 2 : 1); ++rep_) { phase_norm1(F);
        if (F.G >= 64 && F.bid < 32) { SchedCtx S{(const char*)WSP(bf16, WS_HX), (const char*)WSP(bf16, WS_WIN), F.bid >> 3, F.bid & 7}; EpiIn E{WSP(bf16, WS_P), (bf16*)F.out, WSP(float2, WS_ROPE)};
            pg8::gemm_phase<EpiIn, SchedCtx, false, SP2>(F.lds, DM, S, E); }
        SEAM(); }
    STAMP(2);
    if (IN(2)) _Pragma("unroll") for (int rep_ = 0; rep_ < ((DUP == 2) ? 2 : 1); ++rep_) {
        SchedIn S{(const char*)WSP(bf16, WS_HX), (const char*)WSP(bf16, WS_WIN), F.G, F.bid};
        EpiIn E{WSP(bf16, WS_P), (bf16*)F.out, WSP(float2, WS_ROPE)};
        pg8::gemm_phase<EpiIn, SchedIn, false, SP2>(F.lds, DM, S, E); SEAM();
    }
    STAMP(3);
    if (IN(3)) _Pragma("unroll") for (int rep_ = 0; rep_ < ((DUP == 3) ? 2 : 1); ++rep_) { phase_prep(F); SEAM(); }
    STAMP(4);
    if (IN(4)) _Pragma("unroll") for (int rep_ = 0; rep_ < ((DUP == 4) ? 2 : 1); ++rep_) { phase_scan(F); SEAM(); }
    STAMP(5);
    if (IN(5)) _Pragma("unroll") for (int rep_ = 0; rep_ < ((DUP == 5) ? 2 : 1); ++rep_) { phase_out(F); SEAM(); }
    STAMP(6);
    if (IN(6)) _Pragma("unroll") for (int rep_ = 0; rep_ < ((DUP == 6) ? 2 : 1); ++rep_) {
        SchedMerge S{(const char*)WSP(bf16, WS_RETY), (const char*)WSP(bf16, WS_GDNY), (const char*)WSP(bf16, WS_WRO), (const char*)WSP(bf16, WS_WGO), F.G, F.bid};
        EpiMerge E{(const bf16*)F.out, WSP(bf16, WS_TMP), WSP(bf16, WS_MERGED)};
        pg8::gemm_phase<EpiMerge, SchedMerge, false, SP2>(F.lds, 512, S, E);
        STAMP(15);
        if (rep_ == 0) { _Pragma("unroll") for (int r2_ = 0; r2_ < ((DUP == 16) ? 2 : 1); ++r2_) phase_moe_weights(F); }
        SEAM();
    }
    STAMP(7);
    if (IN(7)) _Pragma("unroll") for (int rep_ = 0; rep_ < ((DUP == 7) ? 2 : 1); ++rep_) {
        SchedDense S{(const char*)WSP(bf16, WS_MERGED), (const char*)WSP(bf16, WS_WO), 64, 4, DM, F.G, F.bid};
        EpiBf16Store E{WSP(bf16, WS_MO), DM};
        pg8::gemm_phase<EpiBf16Store, SchedDense, false, SP2>(F.lds, DM, S, E); SEAM();
    }
    STAMP(8);
    if (IN(8)) _Pragma("unroll") for (int rep_ = 0; rep_ < ((DUP == 8) ? 2 : 1); ++rep_) { if (rep_ == 1) { if (F.bid == 0 && F.tid < 64) F.ctl[CW_CNT + 64 * F.tid] = 0u; SEAM(); } phase_route(F); SEAM(); }
    STAMP(9);
    if (IN(9)) _Pragma("unroll") for (int rep_ = 0; rep_ < ((DUP == 9) ? 2 : 1); ++rep_) {
        build_tile_prefix(F, tp);
        SchedMoe S{(const char*)WSP(bf16, WS_H2), (const char*)WSP(bf16, WS_WGU), WSP(int2, WS_LIST), F.ctl + CW_CNT, tp, 2, DM, F.G, F.bid, (size_t)512 * DM * 2, 0, true};
        EpiUp E{WSP(bf16, WS_HMID)};
        pg8::gemm_phase<EpiUp, SchedMoe, true, SP2>(F.lds, DM, S, E); SEAM();
    }
    STAMP(10);
    if (IN(10)) _Pragma("unroll") for (int rep_ = 0; rep_ < ((DUP == 10) ? 2 : 1); ++rep_) {
        build_tile_prefix(F, tp);
        SchedMoe S{(const char*)WSP(bf16, WS_HMID), (const char*)WSP(bf16, WS_WD), WSP(int2, WS_LIST), F.ctl + CW_CNT, tp, 4, DEXP, F.G, F.bid, (size_t)DM * DEXP * 2, 0, false};
        EpiDown E{F.ws + WS_YB, F.out, WSP(int2, WS_LIST), tp};
        pg8::gemm_phase<EpiDown, SchedMoe, false, SP2>(F.lds, DEXP, S, E); SEAM();
    }
    STAMP(11);
    STAMP(12);
    STAMP(13);
    if (IN(13)) _Pragma("unroll") for (int rep_ = 0; rep_ < ((DUP == 13) ? 2 : 1); ++rep_) { phase_final(F); }
    STAMP(14);
    if (PROBE_PH >= 0 && F.bid == 0) { __syncthreads(); if (F.tid == 0) { const unsigned long long d = tsl[PROBE_IB] - tsl[PROBE_IA]; float a = 1.0f + 0.2f * floorf((float)d * 0.001f); a = a > 30.f ? 30.f : a;
#ifdef PROBE_BIG
            a = 20.0f + (float)d * 0.005f;
#endif
            asm volatile("s_waitcnt vmcnt(0)" ::: "memory"); F.out[0] += a; } }
#undef IN
}

extern "C" void kernel_launch(void* const* d_in, const int* in_sizes, int n_in, void* d_out, int out_size, void* d_ws, size_t ws_size, hipStream_t stream) {
    static int grid = 0;
    if (grid == 0) {
        if (n_in != 28 || in_sizes[0] != NT * DM || out_size != NT * DM || ws_size < WS_END) { fprintf(stderr, "kernel_launch: unexpected shapes / workspace (%d inputs, ws %zu)\n", n_in, ws_size); grid = -1; return; }
        int dev = 0, cus = 0;
        if (hipGetDevice(&dev) != hipSuccess || hipDeviceGetAttribute(&cus, hipDeviceAttributeMultiprocessorCount, dev) != hipSuccess) { grid = -1; return; }
        if (hipFuncSetAttribute((const void*)fwd, hipFuncAttributeMaxDynamicSharedMemorySize, LDS_BYTES) != hipSuccess) { fprintf(stderr, "kernel_launch: hipFuncSetAttribute failed\n"); grid = -1; return; }
        int per_cu = 0; (void)hipOccupancyMaxActiveBlocksPerMultiprocessor(&per_cu, (const void*)fwd, NTHR, LDS_BYTES); (void)hipGetLastError();
        if (per_cu < 1) fprintf(stderr, "kernel_launch: occupancy query says %d\n", per_cu);
        grid = cus;
    }
    if (grid < 0) return;
    (void)hipMemsetAsync((char*)d_ws + WS_CTL, 0, CTL_BYTES, stream);
    Args a{};
    for (int i = 0; i < 28; ++i) a.in[i] = (const float*)d_in[i];
    a.out = (float*)d_out; a.ws = (unsigned char*)d_ws;
#if MK_ONE_LAUNCH
    a.ph_lo = 0; a.ph_hi = N_PHASES;
    hipLaunchKernelGGL(fwd, dim3(grid), dim3(NTHR), LDS_BYTES, stream, a);
#else
    for (int p = 0; p < 14; ++p) { a.ph_lo = p; a.ph_hi = p + 1; hipLaunchKernelGGL(fwd, dim3(grid), dim3(NTHR), LDS_BYTES, stream, a); }
#endif
}
```

```cpp
#include <hip/hip_runtime.h>
#include <cstdio>
#include <cstdint>

#ifndef MK_ONE_LAUNCH
#define MK_ONE_LAUNCH 1
#endif
#ifndef MK_REF_GEMM
#define MK_REF_GEMM 0
#endif

constexpr int NB = 4, SEQ = 4096, DM = 1024, CTXL = 256, RPB = SEQ + CTXL  , NROW = NB * RPB  , NT = NB * SEQ  ;
constexpr int NH = 4, HD = 128, CH = 128, NCHUNK = RPB / CH  ;
constexpr int N_STATE = 2064, N_IN = 6160, NEXP = 64, TOPK = 8, DEXP = 256;
constexpr float EPS = 1e-6f;
constexpr int NPCOL = 4096;
constexpr int SLOT_SH = 147456;
constexpr int NSLOT = SLOT_SH + NT;

constexpr size_t MiB = 1u << 20;
constexpr size_t WS_CTL = 0, CTL_BYTES = 1 * MiB;
constexpr size_t WS_MOD = 1 * MiB;
constexpr size_t WS_ROPE = 2 * MiB;
constexpr size_t WS_LOGA = 4 * MiB;
constexpr size_t WS_BETA = 5 * MiB;
constexpr size_t WS_WRO = 6 * MiB, WS_WGO = 7 * MiB, WS_WO = 8 * MiB;
constexpr size_t WS_P = 10 * MiB;
constexpr size_t PGRP = (size_t)NROW * 512;
constexpr size_t WS_CH = 146 * MiB;
constexpr size_t WS_WIN = WS_CH;
constexpr size_t WS_HX = WS_CH + 12 * MiB;
constexpr size_t WS_GM = WS_CH;
constexpr size_t WS_GC = WS_CH + 34 * MiB;
constexpr size_t WS_GKV = WS_CH + 68 * MiB;
constexpr size_t WS_GQT = WS_CH + 102 * MiB;
constexpr size_t WS_OGDN = WS_CH + 134 * MiB;
constexpr size_t WS_ORET = WS_CH + 150 * MiB;
constexpr size_t WS_RETY = WS_P, WS_GDNY = WS_P + 17 * MiB;
constexpr size_t WS_H2 = 10 * MiB;
constexpr size_t WS_WGU = 73 * MiB;
constexpr size_t WS_YB = 10 * MiB;
constexpr size_t WS_WD = 138 * MiB;
constexpr size_t WS_HMID = 171 * MiB;
constexpr size_t WS_TMP = 171 * MiB, WS_MERGED = 203 * MiB;
constexpr size_t WS_MO = 251 * MiB;
constexpr size_t WS_LIST = 283 * MiB;
constexpr size_t WS_END = 312 * MiB;

constexpr int CW_BAR = 1024;
constexpr int CW_CNT = 8192;
constexpr int CW_FLAG = 12288;

#define GAS __attribute__((address_space(1)))
#define LAS __attribute__((address_space(3)))
typedef unsigned short bf16;
typedef float f32x4 __attribute__((ext_vector_type(4)));
typedef float f32x2 __attribute__((ext_vector_type(2)));
typedef short bf16x8 __attribute__((ext_vector_type(8)));
typedef unsigned u32x4 __attribute__((ext_vector_type(4)));
typedef unsigned u32x2 __attribute__((ext_vector_type(2)));
__device__ __forceinline__ unsigned f2bf(float f) { unsigned u = __builtin_bit_cast(unsigned, f); return (u + 0x7fffu + ((u >> 16) & 1u)) >> 16; }
__device__ __forceinline__ unsigned pk2(float lo, float hi) { return f2bf(lo) | (f2bf(hi) << 16); }
__device__ __forceinline__ float bf2f(unsigned b) { return __builtin_bit_cast(float, b << 16); }
__device__ __forceinline__ float bflo(unsigned w) { return __builtin_bit_cast(float, w << 16); }
__device__ __forceinline__ float bfhi(unsigned w) { return __builtin_bit_cast(float, w & 0xffff0000u); }
__device__ __forceinline__ float sigmoidf_(float x) { return 1.f / (1.f + __expf(-x)); }
__device__ __forceinline__ float siluf_(float x) { return x / (1.f + __expf(-x)); }
__device__ __forceinline__ float wave_sum(float v) {
#pragma unroll
    for (int o = 1; o < 64; o <<= 1) v += __shfl_xor(v, o);
    return v;
}
__device__ __forceinline__ float sum16(float v) {
#pragma unroll
    for (int o = 1; o < 16; o <<= 1) v += __shfl_xor(v, o);
    return v;
}
__device__ __forceinline__ void unpack8(const u32x4 w, float (&o)[8]) {
    o[0] = bflo(w.x); o[1] = bfhi(w.x); o[2] = bflo(w.y); o[3] = bfhi(w.y); o[4] = bflo(w.z); o[5] = bfhi(w.z); o[6] = bflo(w.w); o[7] = bfhi(w.w);
}
__device__ __forceinline__ u32x4 pack8(const float (&v)[8]) { u32x4 w; w.x = pk2(v[0], v[1]); w.y = pk2(v[2], v[3]); w.z = pk2(v[4], v[5]); w.w = pk2(v[6], v[7]); return w; }

namespace pg8 {
constexpr int BM = 256, BK = 64, HALF = 128, HTB = HALF * BK * 2, STAGE_BYTES = 8 * HTB;
__host__ __device__ __forceinline__ int lds_byte(int r, int c) { const int st = (r >> 4) * 2 + (c >> 5), rr = r & 15, cc = c & 31, ob = rr * 64 + cc * 2; return st * 1024 + (ob ^ (((ob >> 9) & 1) << 5)); }
__host__ __device__ __forceinline__ void stage_rc(int b, int& R, int& C) { const int st = b / 1024, sb = b % 1024, swz = sb ^ (((sb >> 9) & 1) << 5); R = (st >> 1) * 16 + swz / 64; C = (st & 1) * 32 + (swz % 64) / 2; }
__host__ __device__ __forceinline__ int perm32(int rho) { const int n = rho >> 4, i = rho & 15; return 8 * (i >> 2) + 4 * n + (i & 3); }
__device__ __forceinline__ unsigned cvt_pk_bf16(float lo, float hi) { unsigned r; asm volatile("v_cvt_pk_bf16_f32 %0, %1, %2" : "=v"(r) : "v"(lo), "v"(hi)); return r; }

struct Unit { const char* A; const char* B; int pm, pn, e, base; };

template <class Epi, class Sched, bool GATHER, bool SP2>
__device__ __forceinline__ void gemm_phase(LAS unsigned char* lds, const int K, const Sched& S, const Epi& E) {
#if MK_REF_GEMM
    {
        const int tid = threadIdx.x, wid = tid >> 6, lane = tid & 63, wr = wid >> 2, wc = wid & 3, fr = lane & 15, fq = lane >> 4;
        Unit cur;
        for (int ui = 0; S.next(ui, cur); ++ui) {
            f32x4 acc[2][2][4][2];
            for (int ai = 0; ai < 2; ++ai) for (int m = 0; m < 4; ++m) {
                const int r = 128 * ai + 64 * wr + 16 * m + fr;
                const bf16* arow = GATHER ? (const bf16*)cur.A + (size_t)S.row_index(cur, r) * K : (const bf16*)cur.A + (size_t)r * K;
                for (int bj = 0; bj < 2; ++bj) for (int n = 0; n < 2; ++n) {
                    f32x4 a4 = {0.f, 0.f, 0.f, 0.f};
                    for (int i = 0; i < 4; ++i) { const int c = 128 * bj + 32 * wc + 8 * fq + 4 * n + i; const bf16* brow = (const bf16*)cur.B + (size_t)c * K;
                        float s = 0.f; for (int k = 0; k < K; ++k) s += bf2f(arow[k]) * bf2f(brow[k]); a4[i] = s; }
                    acc[ai][bj][m][n] = a4; } }
            E(acc, cur, wr, wc, fr, fq);
        }
        return;
    }
#else
    const int tid = threadIdx.x, wid = __builtin_amdgcn_readfirstlane(tid >> 6), lane = tid & 63, wr = wid >> 2, wc = wid & 3, fr = lane & 15, fq = lane >> 4;
    const int nt = K / BK;
    unsigned voffA[2], voffB[2]; int gR = 0, gC = 0;
#pragma unroll
    for (int i = 0; i < 2; ++i) { int R, C; stage_rc(tid * 16 + i * 8192, R, C); const int Rb = (R & ~31) + perm32(R & 31);
        voffA[i] = (unsigned)(R * K + C) * 2u; voffB[i] = (unsigned)(Rb * K + C) * 2u; if (i == 0) { gR = R; gC = C; } }
    const size_t kstep = (size_t)(BK * 2);
    const size_t hstep = (size_t)HALF * K * 2;
    const unsigned ldsw = (unsigned)wid * 1024u;
    const int aoff = lds_byte(wr * 64 + fr, fq * 8), boff = lds_byte(wc * 32 + fr, fq * 8);
#define PG8_SA(b, h) (((b) * 2 + (h)) * HTB)
#define PG8_SB(b, h) ((4 + (b) * 2 + (h)) * HTB)
#define PG8_STAGE(bufoff, gbase, voff) do { _Pragma("unroll") for (int _i = 0; _i < 2; ++_i) \
        __builtin_amdgcn_global_load_lds((const unsigned*)((const char*)(gbase) + (voff)[_i]), (LAS unsigned*)(lds + (bufoff) + ldsw + _i * 8192), 16, 0, 0); } while (0)
#define PG8_STAGE_A(bufoff, gbase, h, G) do { if constexpr (GATHER) { PG8_STAGE(bufoff, gbase, (G)[h]); } else { PG8_STAGE(bufoff, (gbase) + (h) * hstep, voffA); } } while (0)
#define PG8_LDA(dst, b, h) do { _Pragma("unroll") for (int m = 0; m < 4; ++m) _Pragma("unroll") for (int k = 0; k < 2; ++k) dst[m][k] = *(const LAS bf16x8*)(lds + PG8_SA(b, h) + aoff + m * 2048 + k * 1024); } while (0)
#define PG8_LDB(dst, b, h) do { _Pragma("unroll") for (int n = 0; n < 2; ++n) _Pragma("unroll") for (int k = 0; k < 2; ++k) dst[n][k] = *(const LAS bf16x8*)(lds + PG8_SB(b, h) + boff + n * 2048 + k * 1024); } while (0)
#define PG8_MMA(ai, bj, At, Bt) do { __builtin_amdgcn_s_setprio(1); _Pragma("unroll") for (int m = 0; m < 4; ++m) _Pragma("unroll") for (int n = 0; n < 2; ++n) _Pragma("unroll") for (int k = 0; k < 2; ++k) \
        acc[ai][bj][m][n] = __builtin_amdgcn_mfma_f32_16x16x32_bf16(Bt[n][k], At[m][k], acc[ai][bj][m][n], 0, 0, 0); __builtin_amdgcn_s_setprio(0); } while (0)
#define PG8_WAIT_V(n) asm volatile("s_waitcnt vmcnt(" #n ")" ::: "memory")
#define PG8_WAIT_L(n) asm volatile("s_waitcnt lgkmcnt(" #n ")" ::: "memory")
#define PG8_BAR __builtin_amdgcn_s_barrier()
#define PG8_SCHED __builtin_amdgcn_sched_barrier(0)
    Unit cur, nxt; int ui = 0;
    if (!S.next(0, cur)) return;
    f32x4 acc[2][2][4][2];
#pragma unroll
    for (int a = 0; a < 2; ++a)
#pragma unroll
        for (int b = 0; b < 2; ++b)
#pragma unroll
            for (int m = 0; m < 4; ++m)
#pragma unroll
                for (int n = 0; n < 2; ++n) acc[a][b][m][n] = (f32x4){0.f, 0.f, 0.f, 0.f};
    bf16x8 At[4][2], B0[2][2], B1[2][2];
    const char* cA = cur.A; const char* cB = cur.B;
    unsigned cG[2][2] = {{0u, 0u}, {0u, 0u}}, nG[2][2] = {{0u, 0u}, {0u, 0u}};
    if constexpr (GATHER) {
#pragma unroll
        for (int h = 0; h < 2; ++h)
#pragma unroll
            for (int i = 0; i < 2; ++i) cG[h][i] = ((unsigned)S.row_index(cur, 128 * h + gR + 64 * i) * (unsigned)K + (unsigned)gC) * 2u;
    }
    if constexpr (SP2) {
        PG8_STAGE(PG8_SB(0, 0), cB, voffB); PG8_STAGE(PG8_SB(0, 1), cB + hstep, voffB); PG8_STAGE_A(PG8_SA(0, 0), cA, 0, cG); PG8_STAGE_A(PG8_SA(0, 1), cA, 1, cG);
        if (wr == 1) PG8_BAR;
        PG8_WAIT_V(2); PG8_BAR;
        PG8_STAGE(PG8_SB(1, 0), cB + kstep, voffB); PG8_STAGE_A(PG8_SA(1, 0), cA + kstep, 0, cG); PG8_STAGE(PG8_SB(1, 1), cB + hstep + kstep, voffB);
        PG8_WAIT_V(6); PG8_BAR;
    } else {
        PG8_STAGE(PG8_SB(0, 0), cB, voffB); PG8_STAGE_A(PG8_SA(0, 0), cA, 0, cG); PG8_STAGE(PG8_SB(0, 1), cB + hstep, voffB); PG8_STAGE_A(PG8_SA(0, 1), cA, 1, cG);
        if (wr == 1) PG8_BAR;
        PG8_WAIT_V(4); PG8_BAR;
        PG8_STAGE(PG8_SB(1, 0), cB + kstep, voffB); PG8_STAGE_A(PG8_SA(1, 0), cA + kstep, 0, cG); PG8_STAGE(PG8_SB(1, 1), cB + hstep + kstep, voffB);
        PG8_WAIT_V(6); PG8_BAR;
    }
    for (;;) {
        const bool has_next = S.next(ui + 1, nxt);
        const char* nA = has_next ? nxt.A : cA; const char* nB = has_next ? nxt.B : cB;
        for (int t = 0; t < nt; t += 2) {
            const bool last = (t == nt - 2);
            const char* a1 = cA + (size_t)(t + 1) * kstep;
            const char* a2 = last ? nA : cA + (size_t)(t + 2) * kstep; const char* b2 = last ? nB : cB + (size_t)(t + 2) * kstep;
            const char* a3 = a2 + kstep; const char* b3 = b2 + kstep;
            unsigned g2[2][2] = {{0u, 0u}, {0u, 0u}};
            if constexpr (GATHER) {
                if (last) {
                    if (has_next) {
#pragma unroll
                        for (int h = 0; h < 2; ++h)
#pragma unroll
                            for (int i = 0; i < 2; ++i) nG[h][i] = ((unsigned)S.row_index(nxt, 128 * h + gR + 64 * i) * (unsigned)K + (unsigned)gC) * 2u;
                    } else {
#pragma unroll
                        for (int h = 0; h < 2; ++h)
#pragma unroll
                            for (int i = 0; i < 2; ++i) nG[h][i] = cG[h][i];
                    }
                }
#pragma unroll
                for (int h = 0; h < 2; ++h)
#pragma unroll
                    for (int i = 0; i < 2; ++i) g2[h][i] = last ? nG[h][i] : cG[h][i];
            }
            if constexpr (SP2) {
            PG8_LDB(B0, 0, 0); PG8_LDB(B1, 0, 1); PG8_SCHED; PG8_LDA(At, 0, 0); PG8_STAGE_A(PG8_SA(1, 1), a1, 1, cG);
            PG8_WAIT_V(8); PG8_WAIT_L(0); PG8_BAR; PG8_MMA(0, 0, At, B0); PG8_MMA(0, 1, At, B1); PG8_BAR; PG8_SCHED;
            PG8_LDA(At, 0, 1); PG8_STAGE(PG8_SB(0, 0), b2, voffB); PG8_STAGE(PG8_SB(0, 1), b2 + hstep, voffB); PG8_STAGE_A(PG8_SA(0, 0), a2, 0, g2);
            PG8_WAIT_V(8); PG8_WAIT_L(0); PG8_BAR; PG8_MMA(1, 0, At, B0); PG8_MMA(1, 1, At, B1); PG8_BAR; PG8_SCHED;
            PG8_LDB(B0, 1, 0); PG8_LDB(B1, 1, 1); PG8_SCHED; PG8_LDA(At, 1, 0); PG8_STAGE_A(PG8_SA(0, 1), a2, 1, g2);
            PG8_WAIT_V(8); PG8_WAIT_L(0); PG8_BAR; PG8_MMA(0, 0, At, B0); PG8_MMA(0, 1, At, B1); PG8_BAR; PG8_SCHED;
            PG8_LDA(At, 1, 1); PG8_STAGE(PG8_SB(1, 0), b3, voffB); PG8_STAGE(PG8_SB(1, 1), b3 + hstep, voffB); PG8_STAGE_A(PG8_SA(1, 0), a3, 0, g2);
            PG8_WAIT_V(8); PG8_WAIT_L(0); PG8_BAR; PG8_MMA(1, 0, At, B0); PG8_MMA(1, 1, At, B1); PG8_BAR; PG8_SCHED;
            } else {
            PG8_LDB(B0, 0, 0); PG8_SCHED; PG8_LDA(At, 0, 0); PG8_STAGE_A(PG8_SA(1, 1), a1, 1, cG);
            PG8_WAIT_L(8); PG8_BAR; PG8_WAIT_L(0); PG8_MMA(0, 0, At, B0); PG8_BAR; PG8_SCHED;
            PG8_LDB(B1, 0, 1); PG8_STAGE(PG8_SB(0, 0), b2, voffB);
            PG8_BAR; PG8_WAIT_L(0); PG8_MMA(0, 1, At, B1); PG8_BAR;
            PG8_LDA(At, 0, 1); PG8_STAGE_A(PG8_SA(0, 0), a2, 0, g2);
            PG8_BAR; PG8_WAIT_L(0); PG8_MMA(1, 0, At, B0); PG8_BAR; PG8_SCHED;
            PG8_STAGE(PG8_SB(0, 1), b2 + hstep, voffB);
            PG8_WAIT_V(6); PG8_BAR; PG8_MMA(1, 1, At, B1); PG8_BAR;
            PG8_LDB(B0, 1, 0); PG8_SCHED; PG8_LDA(At, 1, 0); PG8_STAGE_A(PG8_SA(0, 1), a2, 1, g2);
            PG8_WAIT_L(8); PG8_BAR; PG8_WAIT_L(0); PG8_MMA(0, 0, At, B0); PG8_BAR; PG8_SCHED;
            PG8_LDB(B1, 1, 1); PG8_STAGE(PG8_SB(1, 0), b3, voffB);
            PG8_BAR; PG8_WAIT_L(0); PG8_MMA(0, 1, At, B1); PG8_BAR;
            PG8_LDA(At, 1, 1); PG8_STAGE_A(PG8_SA(1, 0), a3, 0, g2);
            PG8_BAR; PG8_WAIT_L(0); PG8_MMA(1, 0, At, B0); PG8_BAR; PG8_SCHED;
            PG8_STAGE(PG8_SB(1, 1), b3 + hstep, voffB);
            PG8_WAIT_V(6); PG8_BAR; PG8_MMA(1, 1, At, B1); PG8_BAR;
            }
        }
        if (wr == 0) PG8_BAR;
        { int tz = threadIdx.x; asm volatile("" : "+v"(tz)); const int wid_ = __builtin_amdgcn_readfirstlane(tz >> 6), lane_ = tz & 63;
          E(acc, cur, wid_ >> 2, wid_ & 3, lane_ & 15, lane_ >> 4); }
        if (!has_next) break;
#pragma unroll
        for (int a = 0; a < 2; ++a)
#pragma unroll
            for (int b = 0; b < 2; ++b)
#pragma unroll
                for (int m = 0; m < 4; ++m)
#pragma unroll
                    for (int n = 0; n < 2; ++n) acc[a][b][m][n] = (f32x4){0.f, 0.f, 0.f, 0.f};
        cur = nxt; cA = nA; cB = nB; ++ui;
        if constexpr (GATHER) {
#pragma unroll
            for (int h = 0; h < 2; ++h)
#pragma unroll
                for (int i = 0; i < 2; ++i) cG[h][i] = nG[h][i];
        }
        if (wr == 1) PG8_BAR;
    }
    PG8_WAIT_V(0);
    PG8_BAR;
#undef PG8_SA
#undef PG8_SB
#undef PG8_STAGE
#undef PG8_STAGE_A
#undef PG8_LDA
#undef PG8_LDB
#undef PG8_MMA
#undef PG8_WAIT_V
#undef PG8_WAIT_L
#undef PG8_BAR
#undef PG8_SCHED
#endif
}
}
constexpr bool SP2 = true;

#define XB_TMO      128
#define XB_XCNT(j)  (256  + 64 * (j))
#define XB_XSUB(j)  (1280 + 64 * (j))
#define XB_XGEN(j)  (2304 + 64 * (j))
#define XB_TOP      3328
#define XB_TOPGEN   3392
#define XCD_BAR_WORDS 3456
#define XB_SPIN_CAP (1u << 18)
__device__ __forceinline__ unsigned xb_ld(unsigned* p)              { return __hip_atomic_load(p, __ATOMIC_RELAXED, __HIP_MEMORY_SCOPE_AGENT); }
__device__ __forceinline__ unsigned xb_add(unsigned* p, unsigned v) { return __hip_atomic_fetch_add(p, v, __ATOMIC_RELAXED, __HIP_MEMORY_SCOPE_AGENT); }
__device__ __forceinline__ unsigned xb_xcc_id() { return (unsigned)__builtin_amdgcn_s_getreg((3 << 11) | 20) & 0xFu; }
#define XB_SPIN(cond, bar) do { unsigned _sp = 0; while (cond) { __builtin_amdgcn_s_sleep(1); \
    if ((++_sp & 255u) == 0u) { if (xb_ld(&(bar)[XB_TMO])) break; if (_sp > XB_SPIN_CAP) { atomicAdd(&(bar)[XB_TMO], 1u); break; } } } } while (0)
struct XcdBarrier { unsigned* bar; unsigned x; volatile LAS unsigned* st; };
__device__ __forceinline__ XcdBarrier xcd_barrier_post(unsigned* bar, volatile LAS unsigned* st) {
    XcdBarrier b; b.bar = bar; b.x = xb_xcc_id(); b.st = st;
    if (threadIdx.x == 0) (void)xb_add(&bar[XB_XCNT(b.x)], 1u);
    return b;
}
__device__ __forceinline__ void xcd_barrier_complete(unsigned* bar, unsigned x, unsigned& nloc, unsigned& nx) {
    const unsigned G = gridDim.x * gridDim.y * gridDim.z;
    unsigned sum, cnt, mine, sp = 0u;
    for (;;) {
        sum = 0u; cnt = 0u; mine = 0u;
#pragma unroll
        for (unsigned j = 0; j < 16; ++j) { const unsigned c = xb_ld(&bar[XB_XCNT(j)]); sum += c; cnt += (c > 0u) ? 1u : 0u; mine = (j == x) ? c : mine; }
        if (sum == G) break;
        __builtin_amdgcn_s_sleep(1);
        if ((++sp & 255u) == 0u) { if (xb_ld(&bar[XB_TMO])) break; if (sp > XB_SPIN_CAP) { atomicAdd(&bar[XB_TMO], 1u); break; } }
    }
    nloc = mine > 0u ? mine : 1u; nx = cnt > 0u ? cnt : 1u;
}
__device__ __forceinline__ void xcd_barrier(const XcdBarrier& b) {
    asm volatile("s_waitcnt vmcnt(0)" ::: "memory");
    __syncthreads();
    if (threadIdx.x == 0) {
        unsigned* bar = b.bar;
        __builtin_amdgcn_s_waitcnt(0);
        unsigned nloc = b.st[0], nx = b.st[1];
        if (nloc == 0u) { xcd_barrier_complete(bar, b.x, nloc, nx); b.st[0] = nloc; b.st[1] = nx; }
        const unsigned old = xb_add(&bar[XB_XSUB(b.x)], 1u);
        const unsigned gen = old / nloc;
        if (old + 1u == (gen + 1u) * nloc) {
            __builtin_amdgcn_fence(__ATOMIC_RELEASE, "agent");
            asm volatile("s_waitcnt vmcnt(0)" ::: "memory");
            const unsigned og = xb_add(&bar[XB_TOP], 1u);
            const unsigned tg = og / nx;
            if (og + 1u == (tg + 1u) * nx) xb_add(&bar[XB_TOPGEN], 1u);
            else XB_SPIN(xb_ld(&bar[XB_TOPGEN]) == tg, bar);
            __builtin_amdgcn_fence(__ATOMIC_ACQUIRE, "agent");
            xb_add(&bar[XB_XGEN(b.x)], 1u);
            asm volatile("s_waitcnt vmcnt(0)" ::: "memory");
        } else {
            XB_SPIN(xb_ld(&bar[XB_XGEN(b.x)]) == gen, bar);
            __builtin_amdgcn_fence(__ATOMIC_ACQUIRE, "agent");
            asm volatile("s_waitcnt vmcnt(0)" ::: "memory");
        }
    }
    __syncthreads();
}

constexpr int NWAVES = 8, NTHR = 512;
constexpr int RING_BYTES = 131072, MISC_OFF = 139264, LDS_BYTES = 147456;
struct Args {
    const float* in[28]; float* out; unsigned char* ws; int ph_lo, ph_hi;
};
struct Frame {
    LAS unsigned char* lds; int tid, lane, wave, G, bid;
    const float *x, *c, *ctx, *c_ctx, *w_mod, *b_mod, *n_mix_pre, *n_mix_post, *n_ffn_pre, *n_ffn_post, *w_in, *gdn_conv, *ret_log_decay, *gdn_a_log, *gdn_dt_bias,
        *ret_gn_w, *gdn_norm_w, *w_ret_out, *w_gdn_out, *w_o, *w_router, *router_bias, *w_gate, *w_up, *w_down, *w_sh_gate, *w_sh_up, *w_sh_down;
    float* out; unsigned char* ws; unsigned* ctl;
};
#define WSP(T, off) ((T*)(F.ws + (off)))

template <class CM>
__device__ __forceinline__ void transpose_item(const float* W, int ld, int K, bf16* WT, LAS float* scr, int kb, int nb, int lane, const CM& cm) {
    const int k0 = 64 * kb, n0 = 32 * nb; const int sc = cm(n0 + (lane & 31));
    float tv[32];
#pragma unroll
    for (int i = 0; i < 32; ++i) tv[i] = W[(size_t)(k0 + 2 * i + (lane >> 5)) * ld + sc];
#pragma unroll
    for (int i = 0; i < 32; ++i) scr[(2 * i + (lane >> 5)) * 33 + (lane & 31)] = tv[i];
    asm volatile("s_waitcnt lgkmcnt(0)" ::: "memory");
    const int c = lane & 7;
#pragma unroll
    for (int j = 0; j < 4; ++j) { const int n = (lane >> 3) + 8 * j; const LAS float* s = scr + (8 * c) * 33 + n;
        u32x4 o; o.x = pk2(s[0 * 33], s[1 * 33]); o.y = pk2(s[2 * 33], s[3 * 33]); o.z = pk2(s[4 * 33], s[5 * 33]); o.w = pk2(s[6 * 33], s[7 * 33]);
        *(u32x4*)(WT + (size_t)(n0 + n) * K + k0 + 8 * c) = o; }
    asm volatile("s_waitcnt lgkmcnt(0)" ::: "memory");
}
struct CmIdent { int off; __device__ __forceinline__ int operator()(int n) const { return n + off; } };
struct CmWin {
    __device__ __forceinline__ int operator()(int n) const {
        const int g = n >> 9; int src = n + (n >= 2048 ? 16 : 0);
        if (g == 0 || g == 4) { const int hb = n & ~127, cp = n & 127; const int wc = cp >> 5, fq = (cp >> 3) & 3, nn = (cp >> 2) & 1, i = cp & 3;
            const int d = 64 * nn + 16 * wc + 4 * fq + i; src = hb + d + (n >= 2048 ? 16 : 0); }
        return src; }
};
__device__ __forceinline__ void gu_decode(int cp, int& hid, int& isup) { const int pn = cp >> 8, r = cp & 255, bj = r >> 7, wc = (r >> 5) & 3, fq = (r >> 3) & 3, nn = (r >> 2) & 1, i = r & 3; hid = pn * 128 + bj * 64 + wc * 16 + fq * 4 + i; isup = nn; }

__device__ __forceinline__ void phase_prologue(Frame& F) {
    const int gw = F.bid * NWAVES + F.wave, NGW = F.G * NWAVES; const int gt = F.bid * NTHR + F.tid, NGT = F.G * NTHR;
    LAS float* scr = (LAS float*)(F.lds + F.wave * 16384);
    { float2* rt = WSP(float2, WS_ROPE);
      for (int idx = gt; idx < SEQ * 64; idx += NGT) { const int t = idx >> 6, j = idx & 63; const float pos = (float)(j < 32 ? (t >> 6) : (t & 63)); const int f = j & 31;
          const float inv = powf(10000.0f, -(float)f / 32.0f); const float ang = pos * inv; float sn, cs; sincosf(ang, &sn, &cs); rt[idx] = make_float2(cs, sn); } }
    {
        LAS float* red = (LAS float*)(F.lds);
        LAS float* sl = (LAS float*)(F.lds + 16384);
        if (F.bid < 96) { for (int i = F.tid; i < 5 * DM; i += NTHR) { const int r = i >> 10, k = i & 1023; sl[i] = siluf_(r < 4 ? F.c[r * DM + k] : F.c_ctx[k]); } __syncthreads(); }
        for (int it = F.bid; it < 96; it += F.G) {
            const int col = it * 64 + F.lane; float a[5] = {0.f, 0.f, 0.f, 0.f, 0.f};
            const int kb = F.wave * 128;
#pragma unroll 1
            for (int k0 = kb; k0 < kb + 128; k0 += 32) { float wv[32];
#pragma unroll
                for (int kk = 0; kk < 32; ++kk) wv[kk] = F.w_mod[(size_t)(k0 + kk) * 6144 + col];
#pragma unroll
                for (int kk = 0; kk < 32; ++kk) {
#pragma unroll
                    for (int r = 0; r < 5; ++r) a[r] += sl[r * DM + k0 + kk] * wv[kk]; } }
#pragma unroll
            for (int r = 0; r < 5; ++r) red[(F.wave * 5 + r) * 64 + F.lane] = a[r];
            __syncthreads();
            if (F.wave < 5) { float s = F.b_mod[col];
#pragma unroll
                for (int w = 0; w < 8; ++w) s += red[(w * 5 + F.wave) * 64 + F.lane];
                WSP(float, WS_MOD)[F.wave * 6144 + col] = s; }
            __syncthreads();
        }
    }
    {
        constexpr int I_IN = 16 * 192, I_RO = 8 * 32, I_O = 16 * 32; constexpr int NIT = I_IN + 2 * I_RO + I_O;
        for (int it = gw; it < NIT; it += NGW) { int r = it;
            if (r < I_IN) { transpose_item(F.w_in, N_IN, DM, WSP(bf16, WS_WIN), scr, r / 192, r % 192, F.lane, CmWin{}); continue; } r -= I_IN;
            if (r < I_RO) { transpose_item(F.w_ret_out, DM, 512, WSP(bf16, WS_WRO), scr, r / 32, r % 32, F.lane, CmIdent{0}); continue; } r -= I_RO;
            if (r < I_RO) { transpose_item(F.w_gdn_out, DM, 512, WSP(bf16, WS_WGO), scr, r / 32, r % 32, F.lane, CmIdent{0}); continue; } r -= I_RO;
            transpose_item(F.w_o, DM, DM, WSP(bf16, WS_WO), scr, r / 32, r % 32, F.lane, CmIdent{0}); }
    }
}

__device__ __forceinline__ void phase_moe_weights(Frame& F) {
    const int gw = F.bid * NWAVES + F.wave, NGW = F.G * NWAVES;
    LAS float* scr = (LAS float*)(F.lds + F.wave * 16384);
    constexpr int I_GU = 16 * 16  , I_D = 4 * 32;
    for (int it = gw; it < 65 * (I_GU + I_D); it += NGW) {
        const int e = it / (I_GU + I_D); int r = it % (I_GU + I_D);
        if (r < I_GU) {
            const int kb = r / 16, nb = r % 16;
            const int k0 = 64 * kb, n0 = 32 * nb; int hid, isup; gu_decode(n0 + (F.lane & 31), hid, isup);
            const float* Wg = e < 64 ? F.w_gate + (size_t)e * DM * DEXP : F.w_sh_gate; const float* Wu = e < 64 ? F.w_up + (size_t)e * DM * DEXP : F.w_sh_up;
            const float* W = isup ? Wu : Wg;
            float tv[32];
#pragma unroll
            for (int i = 0; i < 32; ++i) tv[i] = W[(size_t)(k0 + 2 * i + (F.lane >> 5)) * DEXP + hid];
#pragma unroll
            for (int i = 0; i < 32; ++i) scr[(2 * i + (F.lane >> 5)) * 33 + (F.lane & 31)] = tv[i];
            asm volatile("s_waitcnt lgkmcnt(0)" ::: "memory");
            const int c = F.lane & 7; bf16* WT = WSP(bf16, WS_WGU) + (size_t)e * 512 * DM;
#pragma unroll
            for (int j = 0; j < 4; ++j) { const int n = (F.lane >> 3) + 8 * j; const LAS float* s = scr + (8 * c) * 33 + n;
                u32x4 o; o.x = pk2(s[0 * 33], s[1 * 33]); o.y = pk2(s[2 * 33], s[3 * 33]); o.z = pk2(s[4 * 33], s[5 * 33]); o.w = pk2(s[6 * 33], s[7 * 33]);
                *(u32x4*)(WT + (size_t)(n0 + n) * DM + k0 + 8 * c) = o; }
            asm volatile("s_waitcnt lgkmcnt(0)" ::: "memory");
        } else { r -= I_GU;
            const float* W = e < 64 ? F.w_down + (size_t)e * DEXP * DM : F.w_sh_down;
            transpose_item(W, DM, DEXP, WSP(bf16, WS_WD) + (size_t)e * DM * DEXP, scr, r / 32, r % 32, F.lane, CmIdent{0}); }
    }
}

template <bool LAT> __device__ __forceinline__ int norm1_row_of(int i) { return LAT ? (i >> 12) * RPB + CTXL + (i & 4095) : i; }
template <bool LAT>
__device__ __forceinline__ void norm1_rows(Frame& F, LAS float* wl, int w0, int nw, int r_lo, int r_hi) {
    const float* mod = WSP(float, WS_MOD);
    int ri = r_lo + w0; if (ri >= r_hi) return;
    f32x4 vn[4];
    { const int row = norm1_row_of<LAT>(ri); const int b = row / RPB, pos = row % RPB; const float* src = pos < CTXL ? F.ctx + ((size_t)b * CTXL + pos) * DM : F.x + ((size_t)b * SEQ + (pos - CTXL)) * DM;
#pragma unroll
      for (int j = 0; j < 4; ++j) vn[j] = *(const f32x4*)(src + 4 * (F.lane + 64 * j)); }
    int pkey = -1; f32x4 pg[4], ps1[4], ps0[4];
    for (; ri < r_hi; ri += nw) {
        const int row = norm1_row_of<LAT>(ri); const int b = row / RPB, pos = row % RPB; const bool isctx = pos < CTXL;
        { const int key = isctx ? 4 : b;
          if (key != pkey) { pkey = key; const float* sh = mod + key * 6144; const float* sc = sh + DM;
#pragma unroll
              for (int j = 0; j < 4; ++j) { const int c0 = 4 * (F.lane + 64 * j); pg[j] = *(const f32x4*)(F.n_mix_pre + c0); ps1[j] = *(const f32x4*)(sc + c0) + 1.0f; ps0[j] = *(const f32x4*)(sh + c0); } } }
        f32x4 v[4]; float ss = 0.f;
#pragma unroll
        for (int j = 0; j < 4; ++j) { v[j] = vn[j]; ss += v[j].x * v[j].x + v[j].y * v[j].y + v[j].z * v[j].z + v[j].w * v[j].w; }
        { const int nri = ri + nw; if (nri < r_hi) { const int nr = norm1_row_of<LAT>(nri); const int nb = nr / RPB, np = nr % RPB; const float* src = np < CTXL ? F.ctx + ((size_t)nb * CTXL + np) * DM : F.x + ((size_t)nb * SEQ + (np - CTXL)) * DM;
#pragma unroll
            for (int j = 0; j < 4; ++j) vn[j] = *(const f32x4*)(src + 4 * (F.lane + 64 * j)); } }
        const float rstd = 1.0f / sqrtf(wave_sum(ss) * (1.f / DM) + EPS);
        float gd[16];
#pragma unroll
        for (int jj = 0; jj < 16; ++jj) gd[jj] = 0.f;
#pragma unroll
        for (int j = 0; j < 4; ++j) { const int c0 = 4 * (F.lane + 64 * j);
            const f32x4 g = pg[j], s1 = ps1[j], s0 = ps0[j];
            f32x4 h; h.x = v[j].x * rstd * g.x * s1.x + s0.x; h.y = v[j].y * rstd * g.y * s1.y + s0.y; h.z = v[j].z * rstd * g.z * s1.z + s0.z; h.w = v[j].w * rstd * g.w * s1.w + s0.w;
            u32x2 o; o.x = pk2(h.x, h.y); o.y = pk2(h.z, h.w);
            *(u32x2*)(WSP(bf16, WS_HX) + (size_t)row * DM + c0) = o;
#pragma unroll
            for (int jh = 0; jh < 2; ++jh) {
                asm volatile("" ::: "memory");
#pragma unroll
                for (int jj = 8 * jh; jj < 8 * jh + 8; ++jj) { const f32x4 w4 = *(const LAS f32x4*)(wl + jj * DM + c0); gd[jj] += (h.x * w4.x + h.y * w4.y) + (h.z * w4.z + h.w * w4.w); } } }
        float g8[8], g4[4], g2[2], mine;
        { const bool b0 = F.lane & 1, b1 = F.lane & 2, b2 = F.lane & 4, b3 = F.lane & 8;
#pragma unroll
          for (int i = 0; i < 8; ++i) { const float snd = b0 ? gd[2 * i] : gd[2 * i + 1], kp = b0 ? gd[2 * i + 1] : gd[2 * i]; g8[i] = kp + __shfl_xor(snd, 1); }
#pragma unroll
          for (int i = 0; i < 4; ++i) { const float snd = b1 ? g8[2 * i] : g8[2 * i + 1], kp = b1 ? g8[2 * i + 1] : g8[2 * i]; g4[i] = kp + __shfl_xor(snd, 2); }
#pragma unroll
          for (int i = 0; i < 2; ++i) { const float snd = b2 ? g4[2 * i] : g4[2 * i + 1], kp = b2 ? g4[2 * i + 1] : g4[2 * i]; g2[i] = kp + __shfl_xor(snd, 4); }
          { const float snd = b3 ? g2[0] : g2[1], kp = b3 ? g2[1] : g2[0]; mine = kp + __shfl_xor(snd, 8); }
          mine += __shfl_xor(mine, 16); mine += __shfl_xor(mine, 32); }
        if (F.lane < 16) { const int ab = F.lane >> 3, dir = (F.lane >> 2) & 1, h = F.lane & 3; const size_t o = ((size_t)(dir * NB + b) * NH + h) * RPB + pos;
            if (ab == 0) { const float z = mine + F.gdn_dt_bias[dir * 4 + h]; const float sp = z > 20.f ? z : log1pf(expf(z)); WSP(float, WS_LOGA)[o] = -expf(F.gdn_a_log[dir * 4 + h]) * sp; }
            else WSP(float, WS_BETA)[o] = 1.f / (1.f + expf(-mine)); }
    }
}
__device__ __forceinline__ void phase_norm1(Frame& F) {
    const int gw = F.bid * NWAVES + F.wave, NGW = F.G * NWAVES;
    LAS float* wl = (LAS float*)F.lds;
    for (int k = F.tid; k < DM; k += NTHR) { const float* wr = F.w_in + (size_t)k * N_IN + 2048;
#pragma unroll
        for (int jj = 0; jj < 4; ++jj) { const f32x4 w4 = *(const f32x4*)(wr + 4 * jj); wl[(4 * jj) * DM + k] = w4.x; wl[(4 * jj + 1) * DM + k] = w4.y; wl[(4 * jj + 2) * DM + k] = w4.z; wl[(4 * jj + 3) * DM + k] = w4.w; } }
    __syncthreads();
    if (F.G < 64) { norm1_rows<false>(F, wl, gw, NGW, 0, NROW); return; }
    if (F.bid < 32) {
        const int b = F.bid >> 3, sub = F.bid & 7; const int r0 = b * RPB + 32 * sub;
        norm1_rows<false>(F, wl, F.wave, NWAVES, r0, r0 + 32);
        asm volatile("s_waitcnt vmcnt(0)" ::: "memory");
        __syncthreads();
        if (F.tid == 0) {
            unsigned* flag = F.ctl + CW_FLAG + 64 * b;
            __builtin_amdgcn_fence(__ATOMIC_RELEASE, "agent"); asm volatile("s_waitcnt vmcnt(0)" ::: "memory");
            __hip_atomic_fetch_add(flag, 1u, __ATOMIC_RELAXED, __HIP_MEMORY_SCOPE_AGENT);
            unsigned sp = 0; while (__hip_atomic_load(flag, __ATOMIC_RELAXED, __HIP_MEMORY_SCOPE_AGENT) < 8u) { __builtin_amdgcn_s_sleep(1); if (++sp > (1u << 22)) break; }
            __builtin_amdgcn_fence(__ATOMIC_ACQUIRE, "agent"); asm volatile("s_waitcnt vmcnt(0)" ::: "memory");
        }
        __syncthreads();
    } else {
        norm1_rows<true>(F, wl, (F.bid - 32) * NWAVES + F.wave, (F.G - 32) * NWAVES, 0, NT);
    }
}

struct SchedIn {
    const char* A; const char* B; int G, c;
    __device__ __forceinline__ bool next(int i, pg8::Unit& u) const {
        const int L = i * G + c; if (L >= (G < 64 ? 1536 + 32 : 1536)) return false;
        int lt, pn;
        if (L < 1536) { int wgid = L; { const int q = 1536 / 8, xcd = wgid % 8, off = wgid / 8; wgid = xcd * q + off; }
            const int nig = 8 * 24, gid = wgid / nig, fm = gid * 8; lt = fm + ((wgid % nig) % 8); pn = (wgid % nig) / 8; u.pm = (lt >> 4) * 17 + 1 + (lt & 15); }
        else { const int q = L - 1536; u.pm = (q >> 3) * 17; pn = q & 7; }
        u.pn = pn; u.e = 0; u.base = 0; u.A = A + (size_t)u.pm * 256 * DM * 2; u.B = B + (size_t)pn * 256 * DM * 2; return true; }
    __device__ __forceinline__ int row_index(const pg8::Unit&, int r) const { return r; }
};
struct SchedCtx {
    const char* A; const char* B; int b, pn;
    __device__ __forceinline__ bool next(int i, pg8::Unit& u) const { if (i > 0) return false; u.pm = b * 17; u.pn = pn; u.e = 0; u.base = 0; u.A = A + (size_t)u.pm * 256 * DM * 2; u.B = B + (size_t)pn * 256 * DM * 2; return true; }
    __device__ __forceinline__ int row_index(const pg8::Unit&, int r) const { return r; }
};
struct EpiIn {
    bf16* P; bf16* GATES; const float2* rope;
    __device__ __forceinline__ void operator()(const f32x4 (&acc)[2][2][4][2], const pg8::Unit& u, int wr, int wc, int fr, int fq) const {
        const int g = u.pn >> 1;
        const int b = u.pm / 17, tl = u.pm % 17;
#pragma unroll
        for (int ai = 0; ai < 2; ++ai)
#pragma unroll
            for (int m = 0; m < 4; ++m) {
                const int rt = ai * 128 + wr * 64 + m * 16 + fr; const size_t prow = (size_t)u.pm * 256 + rt;
#pragma unroll
                for (int bj = 0; bj < 2; ++bj) {
                    f32x4 v0 = acc[ai][bj][m][0], v1 = acc[ai][bj][m][1];
                    const int ct = bj * 128 + wc * 32 + 8 * fq;
                    if (g == 0 || g == 4) {
                        const float s = (g == 0) ? 0.08838834764831845f : 1.0f; v0 = v0 * s; v1 = v1 * s;
                        const int j = 16 * wc + 4 * fq;
                        f32x4 o1 = v0, o2 = v1;
                        if (tl != 0) { const int t = (tl - 1) * 256 + rt; const float2* cs = rope + (size_t)t * 64 + j;
#pragma unroll
                            for (int i = 0; i < 4; ++i) { const float2 c2 = cs[i]; o1[i] = v0[i] * c2.x - v1[i] * c2.y; o2[i] = v0[i] * c2.y + v1[i] * c2.x; } }
                        bf16* dst = P + (size_t)g * PGRP + prow * 512 + (u.pn & 1) * 256 + bj * 128 + j;
                        u32x2 w1, w2; w1.x = pg8::cvt_pk_bf16(o1[0], o1[1]); w1.y = pg8::cvt_pk_bf16(o1[2], o1[3]); w2.x = pg8::cvt_pk_bf16(o2[0], o2[1]); w2.y = pg8::cvt_pk_bf16(o2[2], o2[3]);
                        *(u32x2*)dst = w1; *(u32x2*)(dst + 64) = w2;
                    } else if (g < 8) {
                        u32x4 w; w.x = pg8::cvt_pk_bf16(v0[0], v0[1]); w.y = pg8::cvt_pk_bf16(v0[2], v0[3]); w.z = pg8::cvt_pk_bf16(v1[0], v1[1]); w.w = pg8::cvt_pk_bf16(v1[2], v1[3]);
                        *(u32x4*)(P + (size_t)g * PGRP + prow * 512 + (u.pn & 1) * 256 + ct) = w;
                    } else {
                        const size_t lrow = (size_t)b * SEQ + (size_t)(tl - 1) * 256 + rt;
#pragma unroll
                        for (int i = 0; i < 4; ++i) { v0[i] = sigmoidf_(v0[i]); v1[i] = sigmoidf_(v1[i]); }
                        u32x4 w; w.x = pg8::cvt_pk_bf16(v0[0], v0[1]); w.y = pg8::cvt_pk_bf16(v0[2], v0[3]); w.z = pg8::cvt_pk_bf16(v1[0], v1[1]); w.w = pg8::cvt_pk_bf16(v1[2], v1[3]);
                        *(u32x4*)(GATES + lrow * 2048 + (u.pn - 16) * 256 + ct) = w;
                    }
                }
            }
    }
};

constexpr int IMGB = 34816, IMGS = 272;
typedef short s16x4 __attribute__((ext_vector_type(4)));
__device__ __forceinline__ unsigned offb(unsigned row, unsigned ch) { return 272u * row + 16u * ch; }
__device__ __forceinline__ unsigned offe(unsigned row, unsigned col) { return 272u * row + 2u * col; }
__device__ __forceinline__ bf16x8 frag_row(LAS unsigned char* img, int tile, int s, int lane) { return *(const LAS bf16x8*)(img + offb(16 * tile + (lane & 15), 4 * s + (lane >> 4))); }
__device__ __forceinline__ bf16x8 frag_tr(LAS unsigned char* img, int tile, int s, int lane) {
    const unsigned g = lane >> 4, qq = (lane & 15) >> 2, p = lane & 3;
    const s16x4 lo = __builtin_amdgcn_ds_read_tr16_b64_v4i16((LAS s16x4*)(img + offe(32 * s + 8 * g + qq, 16 * tile + 4 * p)));
    const s16x4 hi = __builtin_amdgcn_ds_read_tr16_b64_v4i16((LAS s16x4*)(img + offe(32 * s + 8 * g + 4 + qq, 16 * tile + 4 * p)));
    return (bf16x8){lo[0], lo[1], lo[2], lo[3], hi[0], hi[1], hi[2], hi[3]};
}
#define MFMA16(a, b, c) __builtin_amdgcn_mfma_f32_16x16x32_bf16(a, b, c, 0, 0, 0)
#define LBAR() do { asm volatile("s_waitcnt lgkmcnt(0)" ::: "memory"); __builtin_amdgcn_s_barrier(); asm volatile("" ::: "memory"); } while (0)
template <bool SWAP>
__device__ __forceinline__ void mm128(LAS unsigned char* ia, bool atr, LAS unsigned char* ib, bool btr, int wr, int wc, int lane, f32x4 (&acc)[2][4]) {
#pragma unroll
    for (int s = 0; s < 4; ++s) {
        bf16x8 fa[2], fb[4];
#pragma unroll
        for (int i = 0; i < 2; ++i) fa[i] = atr ? frag_tr(ia, 2 * wr + i, s, lane) : frag_row(ia, 2 * wr + i, s, lane);
#pragma unroll
        for (int j = 0; j < 4; ++j) fb[j] = btr ? frag_tr(ib, 4 * wc + j, s, lane) : frag_row(ib, 4 * wc + j, s, lane);
#pragma unroll
        for (int i = 0; i < 2; ++i)
#pragma unroll
            for (int j = 0; j < 4; ++j) acc[i][j] = SWAP ? MFMA16(fb[j], fa[i], acc[i][j]) : MFMA16(fa[i], fb[j], acc[i][j]);
    }
}
__device__ __forceinline__ void zero_acc(f32x4 (&acc)[2][4]) {
#pragma unroll
    for (int i = 0; i < 2; ++i)
#pragma unroll
        for (int j = 0; j < 4; ++j) acc[i][j] = (f32x4){0.f, 0.f, 0.f, 0.f};
}
__device__ __forceinline__ void st_img(LAS unsigned char* img, const f32x4 (&acc)[2][4], int wr, int wc, int lane) {
    const int r = lane & 15, q = lane >> 4;
#pragma unroll
    for (int i = 0; i < 2; ++i)
#pragma unroll
        for (int j = 0; j < 4; ++j) { u32x2 w; w.x = pk2(acc[i][j][0], acc[i][j][1]); w.y = pk2(acc[i][j][2], acc[i][j][3]);
            *(LAS u32x2*)(img + offe(32 * wr + 16 * i + r, 64 * wc + 16 * j + 4 * q)) = w; }
}
__device__ __forceinline__ void load_plain_img(LAS unsigned char* img, const bf16* src, int ld, int tid) {
#pragma unroll
    for (int i = 0; i < 4; ++i) { const int cidx = tid + 512 * i, row = cidx >> 4, ch = cidx & 15;
        *(LAS u32x4*)(img + offb(row, ch)) = *(const u32x4*)(src + (size_t)row * ld + 8 * ch); }
}
__device__ __forceinline__ void load_conv_img(LAS unsigned char* img, const bf16* src, const float* cw  , bool has_prev, bool has_next, int mode  , int wave, int lane) {
    asm volatile("" ::: "memory");
    const int ch = lane & 15; float w0[8], w1[8], w2[8];
#pragma unroll
    for (int i = 0; i < 8; ++i) { w0[i] = cw[8 * ch + i]; w1[i] = cw[1536 + 8 * ch + i]; w2[i] = cw[3072 + 8 * ch + i]; }
#pragma unroll
    for (int it = 0; it < 4; ++it) {
        const int row = 32 * it + 4 * wave + (lane >> 4); const u32x4 z4 = {0u, 0u, 0u, 0u};
        const u32x4 r0 = (row > 0 || has_prev) ? *(const u32x4*)(src + ((ptrdiff_t)row - 1) * 512 + 8 * ch) : z4;
        const u32x4 r1 = *(const u32x4*)(src + (size_t)row * 512 + 8 * ch);
        const u32x4 r2 = (row < 127 || has_next) ? *(const u32x4*)(src + (size_t)(row + 1) * 512 + 8 * ch) : z4;
        float a0[8], a1[8], a2[8], y[8]; unpack8(r0, a0); unpack8(r1, a1); unpack8(r2, a2); float ss = 0.f;
#pragma unroll
        for (int i = 0; i < 8; ++i) { y[i] = siluf_(w0[i] * a0[i] + w1[i] * a1[i] + w2[i] * a2[i]); ss += y[i] * y[i]; }
        if (mode != 1) { const float sc = (1.0f / sqrtf(sum16(ss) + EPS)) * (mode == 2 ? 0.08838834764831845f : 1.0f);
#pragma unroll
            for (int i = 0; i < 8; ++i) y[i] *= sc; }
        *(LAS u32x4*)(img + offb(row, ch)) = pack8(y);
    }
}
__device__ __forceinline__ void scale_rows_img(LAS unsigned char* dst, LAS unsigned char* src, const LAS float* rs, int tid) {
#pragma unroll
    for (int i = 0; i < 4; ++i) { const int cidx = tid + 512 * i, row = cidx >> 4, ch = cidx & 15; float v[8]; unpack8(*(const LAS u32x4*)(src + offb(row, ch)), v); const float sc = rs[row];
#pragma unroll
        for (int e = 0; e < 8; ++e) v[e] *= sc;
        *(LAS u32x4*)(dst + offb(row, ch)) = pack8(v); }
}
__device__ __forceinline__ void tri_inverse(LAS unsigned char* img, int w, int lane) {
    const int r = lane & 15, q = lane >> 4;
    {
        const int b0 = 16 * w; float x[16];
#pragma unroll
        for (int i = 0; i < 16; ++i) { float v = (i == r) ? 1.f : 0.f;
#pragma unroll
            for (int j = 0; j < i; ++j) v -= bf2f(*(const LAS unsigned short*)(img + offe(b0 + i, b0 + j))) * x[j];
            x[i] = v; }
        if (q == 0) {
#pragma unroll
            for (int i = 0; i < 16; ++i) *(LAS unsigned short*)(img + offe(b0 + i, b0 + r)) = (unsigned short)f2bf(x[i]); }
    }
    LBAR();
    if (w < 4) {
        const int c0 = 32 * w, r1 = c0 + 16;
        const u32x2 av = *(const LAS u32x2*)(img + offe(r1 + r, c0 + 4 * q));
        const bf16x8 fa = __builtin_bit_cast(bf16x8, (u32x4){av.x, av.y, 0u, 0u});
        const s16x4 tb = __builtin_amdgcn_ds_read_tr16_b64_v4i16((LAS s16x4*)(img + offe(c0 + 4 * q + (r >> 2), c0 + 4 * (r & 3))));
        const bf16x8 fb = (bf16x8){tb[0], tb[1], tb[2], tb[3], 0, 0, 0, 0};
        const f32x4 y = MFMA16(fa, fb, ((f32x4){0.f, 0.f, 0.f, 0.f}));
        const bf16x8 fy = __builtin_bit_cast(bf16x8, (u32x4){pk2(y[0], y[1]), pk2(y[2], y[3]), 0u, 0u});
        const u32x2 tv = *(const LAS u32x2*)(img + offe(r1 + r, r1 + 4 * q));
        const bf16x8 ft = __builtin_bit_cast(bf16x8, (u32x4){tv.x, tv.y, 0u, 0u});
        const f32x4 d = MFMA16(fy, ft, ((f32x4){0.f, 0.f, 0.f, 0.f}));
        u32x2 o; o.x = pk2(-d[0], -d[1]); o.y = pk2(-d[2], -d[3]);
        *(LAS u32x2*)(img + offe(r1 + r, c0 + 4 * q)) = o;
    }
    LBAR();
    {
        const int p = w >> 2, ti = (w >> 1) & 1, tj = w & 1, base = 64 * p, rb = base + 32;
        f32x4 y[2];
        const unsigned g = lane >> 4, qq = (lane & 15) >> 2, pp = lane & 3;
        const s16x4 lo = __builtin_amdgcn_ds_read_tr16_b64_v4i16((LAS s16x4*)(img + offe(base + 8 * g + qq, base + 16 * tj + 4 * pp)));
        const s16x4 hi = __builtin_amdgcn_ds_read_tr16_b64_v4i16((LAS s16x4*)(img + offe(base + 8 * g + 4 + qq, base + 16 * tj + 4 * pp)));
        const bf16x8 fb = (bf16x8){lo[0], lo[1], lo[2], lo[3], hi[0], hi[1], hi[2], hi[3]};
#pragma unroll
        for (int kt = 0; kt < 2; ++kt) { const bf16x8 fa = *(const LAS bf16x8*)(img + offb(rb + 16 * kt + r, (base >> 3) + q)); y[kt] = MFMA16(fa, fb, ((f32x4){0.f, 0.f, 0.f, 0.f})); }
        const bf16x8 fy = __builtin_bit_cast(bf16x8, (u32x4){pk2(y[0][0], y[0][1]), pk2(y[0][2], y[0][3]), pk2(y[1][0], y[1][1]), pk2(y[1][2], y[1][3])});
        const u32x2 t0 = *(const LAS u32x2*)(img + offe(rb + 16 * ti + r, rb + 4 * q)), t1 = *(const LAS u32x2*)(img + offe(rb + 16 * ti + r, rb + 16 + 4 * q));
        const bf16x8 ft = __builtin_bit_cast(bf16x8, (u32x4){t0.x, t0.y, t1.x, t1.y});
        const f32x4 d = MFMA16(fy, ft, ((f32x4){0.f, 0.f, 0.f, 0.f}));
        LBAR();
        u32x2 o; o.x = pk2(-d[0], -d[1]); o.y = pk2(-d[2], -d[3]);
        *(LAS u32x2*)(img + offe(rb + 16 * ti + r, base + 16 * tj + 4 * q)) = o;
    }
    LBAR();
    {
        const int tj = w >> 1, ti0 = 2 * (w & 1);
        f32x4 y[4];
#pragma unroll
        for (int kt = 0; kt < 4; ++kt) y[kt] = (f32x4){0.f, 0.f, 0.f, 0.f};
#pragma unroll
        for (int s = 0; s < 2; ++s) { const bf16x8 fb = frag_tr(img, tj, s, lane);
#pragma unroll
            for (int kt = 0; kt < 4; ++kt) y[kt] = MFMA16(frag_row(img, 4 + kt, s, lane), fb, y[kt]); }
        f32x4 d[2];
#pragma unroll
        for (int i = 0; i < 2; ++i) { d[i] = (f32x4){0.f, 0.f, 0.f, 0.f};
#pragma unroll
            for (int ks = 0; ks < 2; ++ks) {
                const bf16x8 fy = __builtin_bit_cast(bf16x8, (u32x4){pk2(y[2 * ks][0], y[2 * ks][1]), pk2(y[2 * ks][2], y[2 * ks][3]), pk2(y[2 * ks + 1][0], y[2 * ks + 1][1]), pk2(y[2 * ks + 1][2], y[2 * ks + 1][3])});
                const int row = 64 + 16 * (ti0 + i) + r;
                const u32x2 t0 = *(const LAS u32x2*)(img + offe(row, 64 + 32 * ks + 4 * q)), t1 = *(const LAS u32x2*)(img + offe(row, 64 + 32 * ks + 16 + 4 * q));
                d[i] = MFMA16(fy, __builtin_bit_cast(bf16x8, (u32x4){t0.x, t0.y, t1.x, t1.y}), d[i]); } }
        LBAR();
#pragma unroll
        for (int i = 0; i < 2; ++i) { u32x2 o; o.x = pk2(-d[i][0], -d[i][1]); o.y = pk2(-d[i][2], -d[i][3]);
            *(LAS u32x2*)(img + offe(64 + 16 * (ti0 + i) + r, 16 * tj + 4 * q)) = o; }
    }
    LBAR();
}

__device__ __forceinline__ void phase_prep(Frame& F) {
    LAS unsigned char* I0 = F.lds; LAS unsigned char* I1 = F.lds + IMGB; LAS unsigned char* I2 = F.lds + 2 * IMGB; LAS unsigned char* I3 = F.lds + 3 * IMGB;
    LAS float* sm = (LAS float*)(F.lds + MISC_OFF + 1024);
    LAS float* s_la = sm; LAS float* s_bet = sm + 128; LAS float* s_gc = sm + 256; LAS float* s_eg = sm + 384; LAS float* s_s2 = sm + 512; LAS float* s_t1 = sm + 640; LAS float* s_t2 = sm + 768;
#define LAUNDER() int tz_ = threadIdx.x; asm volatile("" : "+v"(tz_)); const int tid = tz_, lane = tz_ & 63, w = __builtin_amdgcn_readfirstlane(tz_ >> 6), wr = w >> 1, wc = w & 1, r = lane & 15, q = lane >> 4; (void)tid; (void)lane; (void)w; (void)wr; (void)wc; (void)r; (void)q
    const bf16* P = WSP(bf16, WS_P);
    for (int it = F.bid; it < 512 + 96; it += F.G) {
        int b, h, m, part = 3;
        if (it < 512) { b = it >> 7; h = (it >> 5) & 3; m = 2 + (it & 31); } else { const int c3 = it - 512; const int c = c3 / 3; part = c3 - 3 * c; b = c >> 3; h = (c >> 1) & 3; m = c & 1; }
        const bool isctx = m < 2; const int pos0 = 128 * m; const size_t row0 = (size_t)b * RPB + pos0; const size_t trow0 = (size_t)b * SEQ + (pos0 - CTXL);
        const bool hprev = isctx ? (m > 0) : (m > 2), hnext = isctx ? (m < 1) : (m < NCHUNK - 1);
        const size_t hoff = row0 * 512 + h * 128;
        f32x4 acc[2][4];
        if (part == 3 || part == 0) {
        const float lgf = F.ret_log_decay[h] * 1.4426950408889634f, lgb = F.ret_log_decay[4 + h] * 1.4426950408889634f;
        { LAUNDER();
        load_plain_img(I0, P + 0 * PGRP + hoff, 512, tid); load_plain_img(I1, P + 1 * PGRP + hoff, 512, tid);
        if (!isctx) load_plain_img(I2, P + 4 * PGRP + hoff, 512, tid);
        if (tid < 128) { s_t1[tid] = exp2f(lgf * (float)(127 - tid)); s_t2[tid] = exp2f(lgb * (float)tid); } }
        LBAR();
        if (!isctx) {
            { LAUNDER();
            zero_acc(acc); mm128<true>(I2, false, I0, false, wr, wc, lane, acc);
#pragma unroll
            for (int i = 0; i < 2; ++i)
#pragma unroll
                for (int j = 0; j < 4; ++j)
#pragma unroll
                    for (int e = 0; e < 4; ++e) { const int ii = 32 * wr + 16 * i + r, jj = 64 * wc + 16 * j + 4 * q + e; const int d = ii - jj;
                        const float wg = (d >= 0 ? exp2f(lgf * (float)d) : 0.f) + (d <= 0 ? exp2f(lgb * (float)(-d)) : 0.f); acc[i][j][e] *= wg; }
            st_img(I3, acc, wr, wc, lane); }
            LBAR();
            { LAUNDER();
            zero_acc(acc); mm128<true>(I3, false, I1, true, wr, wc, lane, acc);
            bf16* og = WSP(bf16, WS_ORET) + (trow0 + 32 * wr + r) * 512 + h * 128 + 64 * wc + 4 * q;
#pragma unroll
            for (int i = 0; i < 2; ++i)
#pragma unroll
                for (int j = 0; j < 4; ++j) { u32x2 o; o.x = pk2(acc[i][j][0], acc[i][j][1]); o.y = pk2(acc[i][j][2], acc[i][j][3]); *(u32x2*)(og + (size_t)(16 * i) * 512 + 16 * j) = o; } }
        }
#pragma unroll 1
        for (int dir = 0; dir < 2; ++dir) {
            LAS unsigned char* kw = dir ? I3 : I2;
            { LAUNDER(); scale_rows_img(kw, I0, dir ? s_t2 : s_t1, tid); }
            LBAR();
            LAUNDER();
            zero_acc(acc); mm128<false>(kw, true, I1, true, wr, wc, lane, acc);
            const int chain = (b * NH + h) * 2 + dir, n = dir ? (isctx ? 1 - m : 35 - m) : m;
            unsigned char* kv = F.ws + WS_GKV + ((size_t)chain * NCHUNK + n) * 32768;
#pragma unroll
            for (int i = 0; i < 2; ++i)
#pragma unroll
                for (int j = 0; j < 4; ++j) { const int mt = 2 * wr + i, nt = 4 * wc + j; u32x2 o; o.x = pk2(acc[i][j][0], acc[i][j][1]); o.y = pk2(acc[i][j][2], acc[i][j][3]);
                    *(u32x2*)(kv + ((size_t)((nt * 4 + (mt >> 1)) * 64 + (2 * (mt & 1) + (q >> 1)) * 16 + r)) * 16 + 8 * (q & 1)) = o; }
        }
        LBAR();
        }
#pragma unroll 1
        for (int dir = (part == 2 ? 1 : 0); dir < (part == 3 ? 2 : part == 0 ? 0 : part); ++dir) {
            const int chain = (b * NH + h) * 2 + dir, n = dir ? (isctx ? 1 - m : 35 - m) : m;
            { LAUNDER(); load_conv_img(I0, P + 2 * PGRP + hoff, F.gdn_conv + 512 + h * 128, hprev, hnext, 0, w, lane); }
            { LAUNDER(); load_conv_img(I1, P + 3 * PGRP + hoff, F.gdn_conv + 1024 + h * 128, hprev, hnext, 1, w, lane); }
            { LAUNDER(); if (tid < 128) { const size_t o = ((size_t)(dir * NB + b) * NH + h) * RPB + pos0 + tid; s_la[tid] = WSP(float, WS_LOGA)[o]; s_bet[tid] = WSP(float, WS_BETA)[o]; } }
            LBAR();
            { LAUNDER();
            if (w == 0) {
                const float a = s_la[2 * lane], c = s_la[2 * lane + 1]; const float pr = a + c; float inc = pr;
#pragma unroll
                for (int o = 1; o < 64; o <<= 1) { const float t = __shfl_up(inc, o); if (lane >= o) inc += t; }
                const float tot = __shfl(inc, 63); const float ex = inc - pr;
                float g0 = ex + a, g1 = ex + pr;
                if (dir) { g0 = tot - ex; g1 = tot - (ex + a); }
                s_gc[2 * lane] = g0; s_gc[2 * lane + 1] = g1; s_eg[2 * lane] = __expf(g0); s_eg[2 * lane + 1] = __expf(g1);
                s_s2[2 * lane] = __expf(tot - g0); s_s2[2 * lane + 1] = __expf(tot - g1);
                if (lane == 0) s_t1[0] = __expf(tot);
            } }
            LBAR();
            { LAUNDER();
            zero_acc(acc); mm128<true>(I0, false, I0, false, wr, wc, lane, acc);
#pragma unroll
            for (int i = 0; i < 2; ++i)
#pragma unroll
                for (int j = 0; j < 4; ++j) { const int ii = 32 * wr + 16 * i + r; const float gi = s_gc[ii], bi = s_bet[ii];
#pragma unroll
                    for (int e = 0; e < 4; ++e) { const int jj = 64 * wc + 16 * j + 4 * q + e;
                        const float f = dir ? s_bet[jj] * __expf(s_gc[jj] - gi) : bi * __expf(gi - s_gc[jj]); acc[i][j][e] = (ii > jj) ? acc[i][j][e] * f : 0.f; } }
            st_img(I2, acc, wr, wc, lane); }
            LBAR();
            { LAUNDER(); tri_inverse(I2, w, lane); }
            { LAUNDER();
#pragma unroll
            for (int i = 0; i < 4; ++i) { const int cidx = tid + 512 * i, row = cidx >> 4, ch = cidx & 15; float v[8], v2[8]; unpack8(*(const LAS u32x4*)(I2 + offb(row, ch)), v);
#pragma unroll
                for (int e = 0; e < 8; ++e) { const int k = dir ? row : 8 * ch + e; const float bb = s_bet[k]; v[e] *= bb; v2[e] = v[e] * s_eg[k]; }
                *(LAS u32x4*)(I2 + offb(row, ch)) = pack8(v); *(LAS u32x4*)(I3 + offb(row, ch)) = pack8(v2); } }
            LBAR();
            { LAUNDER();
            zero_acc(acc); mm128<true>(I3, dir != 0, I0, true, wr, wc, lane, acc);
            LBAR();
            st_img(I3, acc, wr, wc, lane); }
            { LAUNDER();
            zero_acc(acc); mm128<true>(I2, dir != 0, I1, true, wr, wc, lane, acc);
            LBAR();
            st_img(I2, acc, wr, wc, lane);
            scale_rows_img(I1, I0, s_s2, tid); }
            LBAR();
            {
                LAUNDER();
                const float dtot = s_t1[0];
                zero_acc(acc); mm128<false>(I1, true, I2, true, wr, wc, lane, acc);
                unsigned char* gc = F.ws + WS_GC + ((size_t)chain * NCHUNK + n) * 32768;
#pragma unroll
                for (int i = 0; i < 2; ++i)
#pragma unroll
                    for (int j = 0; j < 4; ++j) { const int mt = 2 * wr + i, nt = 4 * wc + j; u32x2 o; o.x = pk2(acc[i][j][0], acc[i][j][1]); o.y = pk2(acc[i][j][2], acc[i][j][3]);
                        *(u32x2*)(gc + ((size_t)((nt * 8 + mt) * 64 + lane)) * 8) = o; }
                }
                { LAUNDER(); const float dtot = s_t1[0];
                zero_acc(acc); mm128<true>(I1, true, I3, true, wr, wc, lane, acc);
                unsigned char* gm = F.ws + WS_GM + ((size_t)chain * NCHUNK + n) * 32768;
#pragma unroll
                for (int i = 0; i < 2; ++i)
#pragma unroll
                    for (int j = 0; j < 4; ++j) { const int mt = 2 * wr + i, ct = 4 * wc + j; const int rowi = 16 * mt + r; float v[4];
#pragma unroll
                        for (int e = 0; e < 4; ++e) v[e] = ((rowi == 16 * ct + 4 * q + e) ? dtot : 0.f) - acc[i][j][e];
                        u32x2 o; o.x = pk2(v[0], v[1]); o.y = pk2(v[2], v[3]);
                        *(u32x2*)(gm + ((size_t)((mt * 4 + (ct >> 1)) * 64 + q * 16 + r)) * 16 + 8 * (ct & 1)) = o; }
            }
            LBAR();
            if (!isctx) {
                { LAUNDER(); load_conv_img(I1, P + 6 * PGRP + hoff, F.gdn_conv + h * 128, hprev, hnext, 2, w, lane); }
                LBAR();
                { LAUNDER();
                zero_acc(acc); mm128<true>(I1, false, I0, false, wr, wc, lane, acc);
#pragma unroll
                for (int i = 0; i < 2; ++i) { const int ii = 32 * wr + 16 * i + r; const float gi = s_gc[ii];
#pragma unroll
                    for (int j = 0; j < 4; ++j)
#pragma unroll
                        for (int e = 0; e < 4; ++e) { const int jj = 64 * wc + 16 * j + 4 * q + e; const bool on = dir ? (jj >= ii) : (jj <= ii);
                            acc[i][j][e] = on ? acc[i][j][e] * __expf(gi - s_gc[jj]) : 0.f; } }
                LBAR();
                st_img(I0, acc, wr, wc, lane); }
                LBAR();
                { LAUNDER();
                zero_acc(acc); mm128<true>(I0, false, I2, true, wr, wc, lane, acc);
                { bf16* ogp = WSP(bf16, WS_OGDN) + (trow0 + 32 * wr + r) * 512 + h * 128 + 64 * wc + 4 * q;
#pragma unroll
                  for (int i = 0; i < 2; ++i)
#pragma unroll
                    for (int j = 0; j < 4; ++j) { bf16* pp = ogp + (size_t)(16 * i) * 512 + 16 * j; f32x4 v = acc[i][j];
                        if (dir) { const u32x2 pv = *(const u32x2*)pp; v[0] += bflo(pv.x); v[1] += bfhi(pv.x); v[2] += bflo(pv.y); v[3] += bfhi(pv.y); }
                        u32x2 o; o.x = pk2(v[0], v[1]); o.y = pk2(v[2], v[3]); *(u32x2*)pp = o; } } }
                { LAUNDER();
                zero_acc(acc); mm128<true>(I0, false, I3, true, wr, wc, lane, acc);
                unsigned char* qt = F.ws + WS_GQT + ((size_t)chain * 32 + (n - 2)) * 32768;
#pragma unroll
                for (int i = 0; i < 2; ++i) { const int ii = 32 * wr + 16 * i + r; const float egi = s_eg[ii];
#pragma unroll
                    for (int j = 0; j < 4; ++j) { const int mt = 2 * wr + i, ct = 4 * wc + j; const u32x2 qv = *(const LAS u32x2*)(I1 + offe(ii, 64 * wc + 16 * j + 4 * q));
                        u32x2 o; o.x = pk2(egi * bflo(qv.x) - acc[i][j][0], egi * bfhi(qv.x) - acc[i][j][1]); o.y = pk2(egi * bflo(qv.y) - acc[i][j][2], egi * bfhi(qv.y) - acc[i][j][3]);
                        *(u32x2*)(qt + ((size_t)((mt * 4 + (ct >> 1)) * 64 + q * 16 + r)) * 16 + 8 * (ct & 1)) = o; } } }
                LBAR();
            }
        }
    }
#undef LAUNDER
}

__device__ __forceinline__ void phase_scan(Frame& F) {
    const int lane = F.lane, w = F.wave, tid = F.tid;
    for (int it = F.bid; it < 256; it += F.G) {
        if (it < 128) {
            const int chain = (it & 7) * 4 + (it >> 5), dq = (it >> 3) & 3;
            const unsigned char* gm = F.ws + WS_GM + (size_t)chain * NCHUNK * 32768; unsigned char* gc = F.ws + WS_GC + (size_t)chain * NCHUNK * 32768;
            const unsigned char* gcs = gc + (size_t)(2 * dq) * 4096;
            if (w >= 4) {
                const int j = tid - 256; u32x4 sA[10], sB[10], sC[10], sD[10];
#define SCAN_LD(dst, n_) do { _Pragma("unroll") for (int i_ = 0; i_ < 8; ++i_) dst[i_] = *(const u32x4*)(gm + (size_t)(n_) * 32768 + (size_t)(j + 256 * i_) * 16); \
                              _Pragma("unroll") for (int i_ = 0; i_ < 2; ++i_) dst[8 + i_] = *(const u32x4*)(gcs + (size_t)(n_) * 32768 + (size_t)(j + 256 * i_) * 16); } while (0)
#define SCAN_ST(n_, src) do { LAS unsigned char* buf_ = F.lds + ((n_) % 3) * 40960; \
                              _Pragma("unroll") for (int i_ = 0; i_ < 8; ++i_) *(LAS u32x4*)(buf_ + (size_t)(j + 256 * i_) * 16) = src[i_]; \
                              _Pragma("unroll") for (int i_ = 0; i_ < 2; ++i_) *(LAS u32x4*)(buf_ + 32768 + (size_t)(j + 256 * i_) * 16) = src[8 + i_]; \
                              if ((n_) + 4 < NCHUNK) SCAN_LD(src, (n_) + 4); LBAR(); } while (0)
                SCAN_LD(sA, 0); SCAN_LD(sB, 1); SCAN_LD(sC, 2); SCAN_LD(sD, 3);
#pragma unroll 1
                for (int n = 0; n < 32; n += 4) { SCAN_ST(n, sA); SCAN_ST(n + 1, sB); SCAN_ST(n + 2, sC); SCAN_ST(n + 3, sD); }
                SCAN_ST(32, sA); SCAN_ST(33, sB);
#undef SCAN_LD
#undef SCAN_ST
            } else if (w < 2) {
                const int nt = 2 * dq + w;
                bf16x8 sf[4];
#pragma unroll
                for (int s = 0; s < 4; ++s) sf[s] = (bf16x8){0, 0, 0, 0, 0, 0, 0, 0};
#pragma unroll 1
                for (int n = 0; n < NCHUNK; ++n) {
                    LBAR();
                    const LAS unsigned char* buf = F.lds + (n % 3) * 40960; const LAS unsigned char* cb = buf + 32768 + w * 4096;
                    unsigned char* slot = gc + (size_t)n * 32768 + (size_t)nt * 4096; f32x4 acc[8];
#pragma unroll
                    for (int mt = 0; mt < 8; ++mt) { const u32x2 cv = *(const LAS u32x2*)(cb + (mt * 64 + lane) * 8); acc[mt] = (f32x4){bflo(cv.x), bfhi(cv.x), bflo(cv.y), bfhi(cv.y)}; }
#pragma unroll
                    for (int s = 0; s < 4; ++s)
#pragma unroll
                        for (int mt = 0; mt < 8; ++mt) acc[mt] = MFMA16(*(const LAS bf16x8*)(buf + ((mt * 4 + s) * 64 + lane) * 16), sf[s], acc[mt]);
#pragma unroll
                    for (int s = 0; s < 4; ++s) { const u32x4 pk = {pk2(acc[2 * s][0], acc[2 * s][1]), pk2(acc[2 * s][2], acc[2 * s][3]), pk2(acc[2 * s + 1][0], acc[2 * s + 1][1]), pk2(acc[2 * s + 1][2], acc[2 * s + 1][3])};
                        sf[s] = __builtin_bit_cast(bf16x8, pk); *(u32x4*)(slot + (size_t)(s * 64 + lane) * 16) = pk; }
                }
            } else {
#pragma unroll 1
                for (int n = 0; n < NCHUNK; ++n) LBAR();
            }
            LBAR();
#if defined(PROBE_PH) && PROBE_PH == 204
            if (F.bid == 0 && tid == 0) ((volatile LAS unsigned long long*)(F.lds + MISC_OFF + 4608))[5] = __builtin_amdgcn_s_memrealtime();
#endif
        } else {
            const int gidx = (it - 128) * NTHR + tid; const int chain = gidx >> 11, piece = gidx & 2047; const int h = (chain >> 1) & 3, dir = chain & 1;
            const float dec = expf(F.ret_log_decay[dir * 4 + h] * 128.f);
            unsigned char* kv = F.ws + WS_GKV + (size_t)chain * NCHUNK * 32768 + (size_t)piece * 16;
            float st[8];
#pragma unroll
            for (int e = 0; e < 8; ++e) st[e] = 0.f;
#pragma unroll 1
            for (int n0 = 0; n0 < NCHUNK; n0 += 17) { u32x4 v8[17];
#pragma unroll
                for (int j = 0; j < 17; ++j) v8[j] = *(const u32x4*)(kv + (size_t)(n0 + j) * 32768);
#pragma unroll
                for (int j = 0; j < 17; ++j) { float v[8]; unpack8(v8[j], v);
#pragma unroll
                    for (int e = 0; e < 8; ++e) st[e] = dec * st[e] + v[e];
                    *(u32x4*)(kv + (size_t)(n0 + j) * 32768) = pack8(st); } }
        }
    }
}

__device__ __forceinline__ void phase_out(Frame& F) {
    const bf16* P = WSP(bf16, WS_P);
    for (int it = F.bid; it < 512; it += F.G) {
        int tz_ = threadIdx.x; asm volatile("" : "+v"(tz_)); const int tid = tz_, lane = tz_ & 63, w = __builtin_amdgcn_readfirstlane(tz_ >> 6), r = lane & 15, q = lane >> 4;
        const int b = it >> 7, h = (it >> 5) & 3, m = 2 + (it & 31);
        const size_t prow = (size_t)b * RPB + 128 * m + 16 * w + r; const size_t trow = (size_t)b * SEQ + 128 * (m - 2) + 16 * w + r;
        const int il = 16 * w + r;
        bf16x8 fqg[2][4], fqr[4];
#pragma unroll
        for (int dir = 0; dir < 2; ++dir) { const int chain = (b * NH + h) * 2 + dir, n = dir ? 35 - m : m; const unsigned char* qt = F.ws + WS_GQT + ((size_t)chain * 32 + (n - 2)) * 32768;
#pragma unroll
            for (int s = 0; s < 4; ++s) fqg[dir][s] = *(const bf16x8*)(qt + (size_t)((w * 4 + s) * 64 + lane) * 16); }
        { const bf16* qp = P + 4 * PGRP + prow * 512 + h * 128;
#pragma unroll
          for (int s = 0; s < 4; ++s) fqr[s] = *(const bf16x8*)(qp + 32 * s + 8 * q); }
        u32x2 rog[8], ror[8];
        { const bf16* a = WSP(bf16, WS_OGDN) + trow * 512 + h * 128 + 4 * q; const bf16* c = WSP(bf16, WS_ORET) + trow * 512 + h * 128 + 4 * q;
#pragma unroll
          for (int nt = 0; nt < 8; ++nt) { rog[nt] = *(const u32x2*)(a + 16 * nt); ror[nt] = *(const u32x2*)(c + 16 * nt); } }
        {
            u32x4 v[4][4];
#pragma unroll
            for (int k = 0; k < 4; ++k) { const int dir = k & 1; const int chain = (b * NH + h) * 2 + dir, n = dir ? 35 - m : m;
                const unsigned char* sp = F.ws + (k < 2 ? WS_GC : WS_GKV) + ((size_t)chain * NCHUNK + (n - 1)) * 32768;
#pragma unroll
                for (int i = 0; i < 4; ++i) v[k][i] = *(const u32x4*)(sp + (size_t)(tid + 512 * i) * 16); }
#pragma unroll
            for (int k = 0; k < 4; ++k)
#pragma unroll
                for (int i = 0; i < 4; ++i) *(LAS u32x4*)(F.lds + k * 32768 + (tid + 512 * i) * 16) = v[k][i];
        }
        f32x4 og[8], orr[8];
#pragma unroll
        for (int nt = 0; nt < 8; ++nt) { og[nt] = (f32x4){bflo(rog[nt].x), bfhi(rog[nt].x), bflo(rog[nt].y), bfhi(rog[nt].y)}; orr[nt] = (f32x4){bflo(ror[nt].x), bfhi(ror[nt].x), bflo(ror[nt].y), bfhi(ror[nt].y)}; }
        LBAR();
#pragma unroll
        for (int dir = 0; dir < 2; ++dir) {
            {
                const LAS unsigned char* sp = F.lds + dir * 32768;
#pragma unroll
                for (int s = 0; s < 4; ++s)
#pragma unroll
                    for (int nt = 0; nt < 8; ++nt) og[nt] = MFMA16(*(const LAS bf16x8*)(sp + ((nt * 4 + s) * 64 + lane) * 16), fqg[dir][s], og[nt]);
            }
            {
                const LAS unsigned char* sp = F.lds + (2 + dir) * 32768;
                f32x4 t[8];
#pragma unroll
                for (int nt = 0; nt < 8; ++nt) t[nt] = (f32x4){0.f, 0.f, 0.f, 0.f};
#pragma unroll
                for (int s = 0; s < 4; ++s)
#pragma unroll
                    for (int nt = 0; nt < 8; ++nt) t[nt] = MFMA16(*(const LAS bf16x8*)(sp + ((nt * 4 + s) * 64 + lane) * 16), fqr[s], t[nt]);
                const float lg = F.ret_log_decay[dir * 4 + h]; const float dcy = expf(lg * (float)(dir ? 128 - il : il + 1));
#pragma unroll
                for (int nt = 0; nt < 8; ++nt) orr[nt] = orr[nt] + t[nt] * dcy;
            }
        }
        {
            float s1 = 0.f;
#pragma unroll
            for (int nt = 0; nt < 8; ++nt) s1 += (orr[nt][0] + orr[nt][1]) + (orr[nt][2] + orr[nt][3]);
            s1 += __shfl_xor(s1, 16); s1 += __shfl_xor(s1, 32); const float mean = s1 * (1.f / 128.f);
            float s2 = 0.f, s3 = 0.f;
#pragma unroll
            for (int nt = 0; nt < 8; ++nt)
#pragma unroll
                for (int e = 0; e < 4; ++e) { const float d = orr[nt][e] - mean; s2 += d * d; s3 += og[nt][e] * og[nt][e]; }
            s2 += __shfl_xor(s2, 16); s2 += __shfl_xor(s2, 32); s3 += __shfl_xor(s3, 16); s3 += __shfl_xor(s3, 32);
            const float rs_r = 1.0f / sqrtf(s2 * (1.f / 128.f) + EPS), rs_g = 1.0f / sqrtf(s3 * (1.f / 128.f) + EPS);
            const bf16* rg = P + 5 * PGRP + prow * 512 + h * 128 + 4 * q; const bf16* gz = P + 7 * PGRP + prow * 512 + h * 128 + 4 * q;
            bf16* ry = WSP(bf16, WS_RETY) + trow * 512 + h * 128 + 4 * q; bf16* gy = WSP(bf16, WS_GDNY) + trow * 512 + h * 128 + 4 * q;
#pragma unroll
            for (int nt = 0; nt < 8; ++nt) { const u32x2 a = *(const u32x2*)(rg + 16 * nt), c = *(const u32x2*)(gz + 16 * nt);
                const float ga[4] = {bflo(a.x), bfhi(a.x), bflo(a.y), bfhi(a.y)}, gc4[4] = {bflo(c.x), bfhi(c.x), bflo(c.y), bfhi(c.y)};
                const f32x4 wr4 = *(const f32x4*)(F.ret_gn_w + h * 128 + 16 * nt + 4 * q), wg4 = *(const f32x4*)(F.gdn_norm_w + h * 128 + 16 * nt + 4 * q);
                float yr[4], yg[4];
#pragma unroll
                for (int e = 0; e < 4; ++e) { yr[e] = (orr[nt][e] - mean) * rs_r * wr4[e] * siluf_(ga[e]); yg[e] = og[nt][e] * rs_g * wg4[e] * siluf_(gc4[e]); }
                u32x2 o1, o2; o1.x = pk2(yr[0], yr[1]); o1.y = pk2(yr[2], yr[3]); o2.x = pk2(yg[0], yg[1]); o2.y = pk2(yg[2], yg[3]);
                *(u32x2*)(ry + 16 * nt) = o1; *(u32x2*)(gy + 16 * nt) = o2; }
        }
        LBAR();
    }
}

struct SchedMerge {
    const char *A0, *A1, *B0, *B1; int G, c;
    __device__ __forceinline__ bool next(int i, pg8::Unit& u) const {
        const int L = (i >> 1) * G + c; if (L >= 256) return false; const int term = i & 1;
        const int xcd = L % 8, off = L / 8; const int w = xcd * 32 + off;
        u.pm = w >> 2; u.pn = w & 3; u.e = term; u.base = 0;
        u.A = (term ? A1 : A0) + (size_t)u.pm * 256 * 512 * 2; u.B = (term ? B1 : B0) + (size_t)u.pn * 256 * 512 * 2; return true; }
    __device__ __forceinline__ int row_index(const pg8::Unit&, int r) const { return r; }
};
struct EpiMerge {
    const bf16* GATES; bf16* TMP; bf16* MERGED;
    __device__ __forceinline__ void operator()(const f32x4 (&acc)[2][2][4][2], const pg8::Unit& u, int wr, int wc, int fr, int fq) const {
#pragma unroll
        for (int ai = 0; ai < 2; ++ai) {
            u32x4 gv[4][2], pv[4][2];
#pragma unroll
            for (int m = 0; m < 4; ++m) { const size_t row = (size_t)u.pm * 256 + ai * 128 + wr * 64 + m * 16 + fr;
#pragma unroll
                for (int bj = 0; bj < 2; ++bj) { const int col = u.pn * 256 + bj * 128 + wc * 32 + 8 * fq;
                    gv[m][bj] = *(const u32x4*)(GATES + row * 2048 + u.e * 1024 + col);
                    if (u.e != 0) pv[m][bj] = *(const u32x4*)(TMP + row * DM + col); } }
#pragma unroll
            for (int m = 0; m < 4; ++m) { const size_t row = (size_t)u.pm * 256 + ai * 128 + wr * 64 + m * 16 + fr;
#pragma unroll
                for (int bj = 0; bj < 2; ++bj) { const int col = u.pn * 256 + bj * 128 + wc * 32 + 8 * fq;
                    float g[8]; unpack8(gv[m][bj], g);
                    float v[8] = {acc[ai][bj][m][0][0], acc[ai][bj][m][0][1], acc[ai][bj][m][0][2], acc[ai][bj][m][0][3], acc[ai][bj][m][1][0], acc[ai][bj][m][1][1], acc[ai][bj][m][1][2], acc[ai][bj][m][1][3]};
                    if (u.e == 0) {
#pragma unroll
                        for (int i = 0; i < 8; ++i) v[i] *= g[i];
                        *(u32x4*)(TMP + row * DM + col) = pack8(v);
                    } else { float p[8]; unpack8(pv[m][bj], p);
#pragma unroll
                        for (int i = 0; i < 8; ++i) v[i] = p[i] + v[i] * g[i];
                        *(u32x4*)(MERGED + row * DM + col) = pack8(v); } } }
        }
    }
};
struct SchedDense {
    const char *A, *B; int nM, nN, K, G, c;
    __device__ __forceinline__ bool next(int i, pg8::Unit& u) const {
        const int L = i * G + c; const int nwg = nM * nN; if (L >= nwg) return false;
        int w = L; if (nwg % 8 == 0) { const int xcd = L % 8, off = L / 8; w = xcd * (nwg / 8) + off; }
        u.pm = w / nN; u.pn = w % nN; u.e = 0; u.base = 0; u.A = A + (size_t)u.pm * 256 * K * 2; u.B = B + (size_t)u.pn * 256 * K * 2; return true; }
    __device__ __forceinline__ int row_index(const pg8::Unit&, int r) const { return r; }
};
struct EpiBf16Store { bf16* O; int ldc;
    __device__ __forceinline__ void operator()(const f32x4 (&acc)[2][2][4][2], const pg8::Unit& u, int wr, int wc, int fr, int fq) const {
#pragma unroll
        for (int ai = 0; ai < 2; ++ai)
#pragma unroll
            for (int m = 0; m < 4; ++m) { const size_t row = (size_t)u.pm * 256 + ai * 128 + wr * 64 + m * 16 + fr;
#pragma unroll
                for (int bj = 0; bj < 2; ++bj) { const int col = u.pn * 256 + bj * 128 + wc * 32 + 8 * fq; const f32x4 v0 = acc[ai][bj][m][0], v1 = acc[ai][bj][m][1];
                    u32x4 w; w.x = pg8::cvt_pk_bf16(v0[0], v0[1]); w.y = pg8::cvt_pk_bf16(v0[2], v0[3]); w.z = pg8::cvt_pk_bf16(v1[0], v1[1]); w.w = pg8::cvt_pk_bf16(v1[2], v1[3]);
                    *(u32x4*)(O + row * ldc + col) = w; } }
    }
};

__device__ __forceinline__ void load_row_bf16(const bf16* p, int lane, float (&v)[16]) { float a[8], b[8]; unpack8(*(const u32x4*)(p + 8 * lane), a); unpack8(*(const u32x4*)(p + 512 + 8 * lane), b);
#pragma unroll
    for (int i = 0; i < 8; ++i) { v[i] = a[i]; v[8 + i] = b[i]; } }
__device__ __forceinline__ void load_row_f32(const float* p, int lane, float (&v)[16]) {
#pragma unroll
    for (int q = 0; q < 4; ++q) { const f32x4 a = *(const f32x4*)(p + (q >> 1) * 512 + 8 * lane + 4 * (q & 1)); v[4 * q] = a.x; v[4 * q + 1] = a.y; v[4 * q + 2] = a.z; v[4 * q + 3] = a.w; } }
__device__ __forceinline__ void store_row_f32(float* p, int lane, const float (&v)[16]) {
#pragma unroll
    for (int q = 0; q < 4; ++q) *(f32x4*)(p + (q >> 1) * 512 + 8 * lane + 4 * (q & 1)) = (f32x4){v[4 * q], v[4 * q + 1], v[4 * q + 2], v[4 * q + 3]}; }
__device__ __forceinline__ void compute_x1(Frame& F, int t, float (&x1)[16]) {
    const int b = t / SEQ; const float* mod = WSP(float, WS_MOD) + b * 6144;
    const bf16* mop = WSP(bf16, WS_MO) + (size_t)t * DM;
    const u32x4 m0 = *(const u32x4*)(mop + 8 * F.lane), m1 = *(const u32x4*)(mop + 512 + 8 * F.lane);
    float ss = 0.f;
    { float a[8], c[8]; unpack8(m0, a); unpack8(m1, c);
#pragma unroll
      for (int i = 0; i < 8; ++i) ss += a[i] * a[i] + c[i] * c[i]; }
    const float rstd = 1.0f / sqrtf(wave_sum(ss) * (1.f / DM) + EPS);
#pragma unroll
    for (int hf = 0; hf < 2; ++hf) {
        const int c0 = hf * 512 + 8 * F.lane; float mo[8]; unpack8(hf ? m1 : m0, mo);
        const float* xp = F.x + (size_t)t * DM + c0; const float* wp = F.n_mix_post + c0; const float* gp = mod + 2 * DM + c0;
#pragma unroll
        for (int q = 0; q < 2; ++q) { const f32x4 xv = *(const f32x4*)(xp + 4 * q), wv = *(const f32x4*)(wp + 4 * q), g1 = *(const f32x4*)(gp + 4 * q);
#pragma unroll
            for (int e = 0; e < 4; ++e) x1[hf * 8 + 4 * q + e] = xv[e] + g1[e] * (mo[4 * q + e] * rstd * wv[e]); }
    }
}
__device__ __forceinline__ void route_token(Frame& F, int t, float logit, LAS unsigned* lcnt, LAS u32x2* stage, unsigned* cnt, int2* list) {
    logit = (logit == logit) ? logit : 0.f;
    const float score = 1.f / (1.f + expf(-logit)); const float biased = score + F.router_bias[F.lane];
    int rk = 0;
#pragma unroll
    for (int o = 0; o < 8; ++o) { const int src = (F.lane & ~7) | o; const float ov = __shfl(biased, src); rk += ((ov > biased) | ((ov == biased) & (src < F.lane))) ? 1 : 0; }
    float gs = rk < 2 ? biased : 0.f; gs += __shfl_xor(gs, 1); gs += __shfl_xor(gs, 2); gs += __shfl_xor(gs, 4);
    int grk = 0; const int myg = F.lane >> 3;
#pragma unroll
    for (int o = 0; o < 8; ++o) { const float ov = __shfl(gs, o * 8); grk += ((ov > gs) | ((ov == gs) & (o < myg))) ? 1 : 0; }
    const bool keep = grk < 4;
    const float cand = keep ? biased : -__builtin_inff();
    int erk = 0;
#pragma unroll
    for (int o = 0; o < 64; ++o) { const float ov = __builtin_bit_cast(float, __builtin_amdgcn_readlane(__builtin_bit_cast(int, cand), o)); erk += ((ov > cand) | ((ov == cand) & (o < F.lane))) ? 1 : 0; }
    const bool sel = keep && erk < TOPK;
    const float ssum = wave_sum(sel ? score : 0.f);
    if (sel) { const float w = score / ssum * 2.5f; const unsigned pos = __hip_atomic_fetch_add(lcnt + F.lane, 1u, __ATOMIC_RELAXED, __HIP_MEMORY_SCOPE_WORKGROUP);
        if (pos < 48u) stage[F.lane * 48 + pos] = (u32x2){(unsigned)(t * 8 + erk), __float_as_uint(w)};
        else { const unsigned gp = atomicAdd(cnt + 64 * F.lane, 1u); list[(size_t)F.lane * NT + gp] = make_int2(t * 8 + erk, __float_as_int(w)); } }
}
__device__ __forceinline__ void phase_route(Frame& F) {
    constexpr int HST = 2064;
    LAS unsigned char* hhi = F.lds;
    LAS unsigned char* hlo = F.lds + 16 * HST;
    LAS float* part = (LAS float*)(F.lds + 2 * 16 * HST);
    LAS u32x2* stage = (LAS u32x2*)(F.lds + 2 * 16 * HST + 32768);
    LAS unsigned* lcnt = (LAS unsigned*)(F.lds + MISC_OFF + 1024);
    unsigned* cnt = F.ctl + CW_CNT; int2* list = WSP(int2, WS_LIST);
    const int r = F.lane & 15, q = F.lane >> 4, kbase = F.wave * 128;
    bf16x8 wh[4][4]; u32x2 wl8[4][4];
#pragma unroll
    for (int ft = 0; ft < 4; ++ft) {
        asm volatile("" ::: "memory");
#pragma unroll
        for (int s = 0; s < 4; ++s) { float wv[8];
#pragma unroll
            for (int j = 0; j < 8; ++j) wv[j] = F.w_router[(size_t)(kbase + 32 * s + 8 * q + j) * NEXP + 16 * ft + r];
            unsigned hi[8];
#pragma unroll
            for (int j = 0; j < 8; ++j) hi[j] = f2bf(wv[j]);
            wh[ft][s] = __builtin_bit_cast(bf16x8, (u32x4){hi[0] | (hi[1] << 16), hi[2] | (hi[3] << 16), hi[4] | (hi[5] << 16), hi[6] | (hi[7] << 16)});
            float lf[8];
#pragma unroll
            for (int j = 0; j < 8; ++j) lf[j] = (wv[j] - bf2f(hi[j])) * 4096.0f;
            unsigned p0 = __builtin_amdgcn_cvt_pk_bf8_f32(lf[0], lf[1], 0u, false); p0 = __builtin_amdgcn_cvt_pk_bf8_f32(lf[2], lf[3], p0, true);
            unsigned p1 = __builtin_amdgcn_cvt_pk_bf8_f32(lf[4], lf[5], 0u, false); p1 = __builtin_amdgcn_cvt_pk_bf8_f32(lf[6], lf[7], p1, true);
            wl8[ft][s] = (u32x2){p0, p1}; } }
    for (int g64 = F.bid; g64 < NT / 64; g64 += F.G) {
        if (F.tid < 64) lcnt[F.tid] = 0u;
        __syncthreads();
#pragma unroll 1
        for (int grp = 0; grp < 4; ++grp) {
#pragma unroll 1
            for (int tw = 0; tw < 2; ++tw) {
                const int slot = 2 * F.wave + tw; const int t = g64 * 64 + grp * 16 + slot; const int b = t / SEQ; const float* mod = WSP(float, WS_MOD) + b * 6144;
                float x1[16]; compute_x1(F, t, x1);
                float ss = 0.f;
#pragma unroll
                for (int i = 0; i < 16; ++i) ss += x1[i] * x1[i];
                const float rstd = 1.0f / sqrtf(wave_sum(ss) * (1.f / DM) + EPS);
                bf16* d = WSP(bf16, WS_H2) + (size_t)t * DM;
#pragma unroll
                for (int hf = 0; hf < 2; ++hf) {
                    asm volatile("" ::: "memory");
                    const int c0 = hf * 512 + 8 * F.lane; float h2[8];
#pragma unroll
                    for (int qq = 0; qq < 2; ++qq) { const f32x4 wv = *(const f32x4*)(F.n_ffn_pre + c0 + 4 * qq), sh = *(const f32x4*)(mod + 3 * DM + c0 + 4 * qq), sc = *(const f32x4*)(mod + 4 * DM + c0 + 4 * qq);
#pragma unroll
                        for (int e = 0; e < 4; ++e) h2[4 * qq + e] = x1[hf * 8 + 4 * qq + e] * rstd * wv[e] * (1.f + sc[e]) + sh[e]; }
                    const u32x4 hp = pack8(h2); *(u32x4*)(d + c0) = hp;
                    float lo8[8]; { float hb[8]; unpack8(hp, hb);
#pragma unroll
                        for (int e = 0; e < 8; ++e) lo8[e] = h2[e] - hb[e]; }
                    *(LAS u32x4*)(hhi + slot * HST + c0 * 2) = hp; *(LAS u32x4*)(hlo + slot * HST + c0 * 2) = pack8(lo8);
                }
            }
            LBAR();
            {
                typedef float f32x2v __attribute__((ext_vector_type(2)));
                f32x4 acc[4], acc2[4];
#pragma unroll
                for (int ft = 0; ft < 4; ++ft) { acc[ft] = (f32x4){0.f, 0.f, 0.f, 0.f}; acc2[ft] = (f32x4){0.f, 0.f, 0.f, 0.f}; }
#pragma unroll
                for (int s = 0; s < 4; ++s) { const int off = r * HST + (kbase + 32 * s + 8 * q) * 2;
                    const bf16x8 bh = *(const LAS bf16x8*)(hhi + off), bl = *(const LAS bf16x8*)(hlo + off);
#pragma unroll
                    for (int ft = 0; ft < 4; ++ft) {
                        const f32x2v l0 = __builtin_amdgcn_cvt_pk_f32_bf8(wl8[ft][s].x, false), l1 = __builtin_amdgcn_cvt_pk_f32_bf8(wl8[ft][s].x, true), l2 = __builtin_amdgcn_cvt_pk_f32_bf8(wl8[ft][s].y, false), l3 = __builtin_amdgcn_cvt_pk_f32_bf8(wl8[ft][s].y, true);
                        const bf16x8 wlo = __builtin_bit_cast(bf16x8, (u32x4){pk2(l0.x, l0.y), pk2(l1.x, l1.y), pk2(l2.x, l2.y), pk2(l3.x, l3.y)});
                        acc[ft] = MFMA16(wh[ft][s], bh, acc[ft]); acc[ft] = MFMA16(wh[ft][s], bl, acc[ft]); acc2[ft] = MFMA16(wlo, bh, acc2[ft]); } }
#pragma unroll
                for (int ft = 0; ft < 4; ++ft)
#pragma unroll
                    for (int e = 0; e < 4; ++e) part[(F.wave * 64 + 16 * ft + 4 * q + e) * 16 + r] = acc[ft][e] + acc2[ft][e] * (1.0f / 4096.0f);
            }
            LBAR();
#pragma unroll 1
            for (int tw = 0; tw < 2; ++tw) { const int slot = 2 * F.wave + tw; float logit = 0.f;
#pragma unroll
                for (int w = 0; w < 8; ++w) logit += part[(w * 64 + F.lane) * 16 + slot];
                route_token(F, g64 * 64 + grp * 16 + slot, logit, lcnt, stage, cnt, list); }
        }
        __syncthreads();
        if (F.tid < 64) { const unsigned n = lcnt[F.tid] < 48u ? lcnt[F.tid] : 48u; lcnt[F.tid] = n; lcnt[64 + F.tid] = atomicAdd(cnt + 64 * F.tid, n); }
        __syncthreads();
        { const int e = F.tid >> 3; const unsigned n = lcnt[e], base = lcnt[64 + e];
          for (unsigned j = F.tid & 7; j < n; j += 8) { const u32x2 v = stage[e * 48 + j]; list[(size_t)e * NT + base + j] = make_int2((int)v.x, (int)v.y); } }
        __syncthreads();
    }
}

__device__ __forceinline__ void build_tile_prefix(Frame& F, LAS int* tp) {
    __syncthreads();
    if (F.tid == 0) { int s = 0; const unsigned* cnt = F.ctl + CW_CNT; for (int e = 0; e < 64; ++e) { const int ce = (int)__hip_atomic_load(cnt + 64 * e, __ATOMIC_RELAXED, __HIP_MEMORY_SCOPE_AGENT); tp[96 + e] = ce; tp[e] = s; s += (ce + 255) >> 8; } tp[64] = s; tp[65] = s + 64;
        const int x = F.bid & 7; int l = 0; for (int k = 0; k < 8; ++k) { tp[80 + k] = l; l += tp[x + 8 * k + 1] - tp[x + 8 * k]; } tp[88] = l; tp[89] = l + 8; }
    __syncthreads();
}
struct SchedMoe {
    const char* A; const char* B; const int2* list; const unsigned* cnt; const LAS int* tp; int npn, K, G, c; size_t bstride  ; int bcol0  ; bool gather;
    __device__ __forceinline__ bool next(int i, pg8::Unit& u) const {
        int e, pm;
        if ((G & 7) == 0) {
            const int x = c & 7, W = G >> 3, L = i * W + (c >> 3); const int nt = __builtin_amdgcn_readfirstlane(tp[89]); if (L >= nt * npn) return false;
            const int tl = L / npn; u.pn = L % npn; int k = 0;
            for (int q = 8; q >= 1; q >>= 1) if (k + q <= 8 && __builtin_amdgcn_readfirstlane(tp[80 + k + q]) <= tl) k += q;
            k = __builtin_amdgcn_readfirstlane(k); const int off = tl - __builtin_amdgcn_readfirstlane(tp[80 + k]);
            if (k < 8) { e = x + 8 * k; pm = off; } else { e = 64; pm = x + 8 * off; }
        } else {
            const int L = i * G + c; const int ntile = __builtin_amdgcn_readfirstlane(tp[65]); if (L >= ntile * npn) return false;
            const int tile = L / npn; u.pn = L % npn; e = 0;
            for (int q = 64; q >= 1; q >>= 1) if (e + q <= 64 && __builtin_amdgcn_readfirstlane(tp[e + q]) <= tile) e += q;
            e = __builtin_amdgcn_readfirstlane(e); pm = tile - __builtin_amdgcn_readfirstlane(tp[e]);
        }
        u.e = e; u.pm = pm; u.base = (e < 64 ? (__builtin_amdgcn_readfirstlane(tp[e < 64 ? e : 0]) + pm) * 256 : SLOT_SH + pm * 256);
        u.A = gather ? A : A + (size_t)u.base * K * 2; u.B = B + (size_t)e * bstride + (size_t)(bcol0 + u.pn * 256) * K * 2; return true; }
    __device__ __forceinline__ int row_index(const pg8::Unit& u, int r) const {
        if (u.e == 64) return u.pm * 256 + r;
        const unsigned tok = (unsigned)list[(size_t)u.e * NT + u.pm * 256 + r].x >> 3; return (int)(tok < (unsigned)NT ? tok : 0u); }
};
struct EpiUp { bf16* HMID;
    __device__ __forceinline__ void operator()(const f32x4 (&acc)[2][2][4][2], const pg8::Unit& u, int wr, int wc, int fr, int fq) const {
#pragma unroll
        for (int ai = 0; ai < 2; ++ai)
#pragma unroll
            for (int m = 0; m < 4; ++m) { const size_t slot = (size_t)u.base + ai * 128 + wr * 64 + m * 16 + fr;
#pragma unroll
                for (int bj = 0; bj < 2; ++bj) { const int hid = u.pn * 128 + bj * 64 + wc * 16 + fq * 4; const f32x4 g = acc[ai][bj][m][0], up = acc[ai][bj][m][1];
                    u32x2 w; w.x = pg8::cvt_pk_bf16(siluf_(g[0]) * up[0], siluf_(g[1]) * up[1]); w.y = pg8::cvt_pk_bf16(siluf_(g[2]) * up[2], siluf_(g[3]) * up[3]);
                    *(u32x2*)(HMID + slot * DEXP + hid) = w; } }
    }
};
constexpr float YB_SCALE = 64.0f, YB_INV = 1.0f / 64.0f;
__device__ __forceinline__ unsigned pk4_fp8(float a, float b, float c, float d) {
    a = fminf(fmaxf(a * YB_SCALE, -448.f), 448.f); b = fminf(fmaxf(b * YB_SCALE, -448.f), 448.f); c = fminf(fmaxf(c * YB_SCALE, -448.f), 448.f); d = fminf(fmaxf(d * YB_SCALE, -448.f), 448.f);
    unsigned p = __builtin_amdgcn_cvt_pk_fp8_f32(a, b, 0u, false); return __builtin_amdgcn_cvt_pk_fp8_f32(c, d, p, true); }
struct EpiDown { unsigned char* YB; float* OUT; const int2* list; const LAS int* tp;
    __device__ __forceinline__ void operator()(const f32x4 (&acc)[2][2][4][2], const pg8::Unit& u, int wr, int wc, int fr, int fq) const {
        if (u.e == 64) {
#pragma unroll
            for (int ai = 0; ai < 2; ++ai)
#pragma unroll
                for (int m = 0; m < 4; ++m) { const int idx = u.pm * 256 + ai * 128 + wr * 64 + m * 16 + fr; float* o = OUT + (size_t)idx * DM + u.pn * 256 + wc * 32 + 8 * fq;
#pragma unroll
                    for (int bj = 0; bj < 2; ++bj) { *(f32x4*)(o + bj * 128) = acc[ai][bj][m][0]; *(f32x4*)(o + bj * 128 + 4) = acc[ai][bj][m][1]; } }
        } else {
            const int n = __builtin_amdgcn_readfirstlane(tp[96 + u.e]); int2 dw[2][4];
#pragma unroll
            for (int ai = 0; ai < 2; ++ai)
#pragma unroll
                for (int m = 0; m < 4; ++m) { int idx = u.pm * 256 + ai * 128 + wr * 64 + m * 16 + fr; idx = idx < n ? idx : n - 1; dw[ai][m] = list[(size_t)u.e * NT + idx]; }
#pragma unroll
            for (int ai = 0; ai < 2; ++ai)
#pragma unroll
                for (int m = 0; m < 4; ++m) { const int idx = u.pm * 256 + ai * 128 + wr * 64 + m * 16 + fr;
                    if (idx < n) { const float w = __int_as_float(dw[ai][m].y); unsigned char* o = YB + (size_t)dw[ai][m].x * DM + u.pn * 256 + wc * 32 + 8 * fq;
#pragma unroll
                        for (int bj = 0; bj < 2; ++bj) { const f32x4 v0 = acc[ai][bj][m][0] * w, v1 = acc[ai][bj][m][1] * w;
                            u32x2 q; q.x = pk4_fp8(v0[0], v0[1], v0[2], v0[3]); q.y = pk4_fp8(v1[0], v1[1], v1[2], v1[3]);
                            *(u32x2*)(o + bj * 128) = q; } } }
        }
    }
};
__device__ __forceinline__ void phase_final(Frame& F) {
    typedef float f32x2v __attribute__((ext_vector_type(2)));
    const int gw = F.bid * NWAVES + F.wave, NGW = F.G * NWAVES; const unsigned char* YB = F.ws + WS_YB;
    for (int t = gw; t < NT; t += NGW) {
        const int b = t / SEQ; const float* mod = WSP(float, WS_MOD) + b * 6144;
        u32x2 ya[8], yb[8];
#pragma unroll
        for (int k = 0; k < 8; ++k) { const unsigned char* rp = YB + ((size_t)t * 8 + k) * DM; ya[k] = *(const u32x2*)(rp + 8 * F.lane); yb[k] = *(const u32x2*)(rp + 512 + 8 * F.lane); }
        float mv[16]; load_row_f32(F.out + (size_t)t * DM, F.lane, mv);
        float ra[16];
#pragma unroll
        for (int i = 0; i < 16; ++i) ra[i] = 0.f;
#pragma unroll
        for (int k = 0; k < 8; ++k) {
            const f32x2v a0 = __builtin_amdgcn_cvt_pk_f32_fp8(ya[k].x, false), a1 = __builtin_amdgcn_cvt_pk_f32_fp8(ya[k].x, true), a2 = __builtin_amdgcn_cvt_pk_f32_fp8(ya[k].y, false), a3 = __builtin_amdgcn_cvt_pk_f32_fp8(ya[k].y, true);
            const f32x2v c0 = __builtin_amdgcn_cvt_pk_f32_fp8(yb[k].x, false), c1 = __builtin_amdgcn_cvt_pk_f32_fp8(yb[k].x, true), c2 = __builtin_amdgcn_cvt_pk_f32_fp8(yb[k].y, false), c3 = __builtin_amdgcn_cvt_pk_f32_fp8(yb[k].y, true);
            ra[0] += a0.x; ra[1] += a0.y; ra[2] += a1.x; ra[3] += a1.y; ra[4] += a2.x; ra[5] += a2.y; ra[6] += a3.x; ra[7] += a3.y;
            ra[8] += c0.x; ra[9] += c0.y; ra[10] += c1.x; ra[11] += c1.y; ra[12] += c2.x; ra[13] += c2.y; ra[14] += c3.x; ra[15] += c3.y; }
        float ss = 0.f;
#pragma unroll
        for (int i = 0; i < 16; ++i) { mv[i] += ra[i] * YB_INV; ss += mv[i] * mv[i]; }
        const float rstd = 1.0f / sqrtf(wave_sum(ss) * (1.f / DM) + EPS);
        float x1[16]; compute_x1(F, t, x1);
        float wv[16], g2[16]; load_row_f32(F.n_ffn_post, F.lane, wv); load_row_f32(mod + 5 * DM, F.lane, g2);
        float o[16];
#pragma unroll
        for (int i = 0; i < 16; ++i) o[i] = x1[i] + g2[i] * (mv[i] * rstd * wv[i]);
        store_row_f32(F.out + (size_t)t * DM, F.lane, o);
    }
}

constexpr int N_PHASES = 16;
__global__ void __launch_bounds__(NTHR, 2) fwd(Args args) {
    extern __shared__ __attribute__((aligned(16))) unsigned char lds_raw[];
    Frame F; F.lds = (LAS unsigned char*)lds_raw; F.tid = threadIdx.x; F.lane = F.tid & 63; F.wave = __builtin_amdgcn_readfirstlane(F.tid >> 6); F.G = gridDim.x; F.bid = blockIdx.x;
    F.x = args.in[0]; F.c = args.in[1]; F.ctx = args.in[2]; F.c_ctx = args.in[3]; F.w_mod = args.in[4]; F.b_mod = args.in[5]; F.n_mix_pre = args.in[6]; F.n_mix_post = args.in[7];
    F.n_ffn_pre = args.in[8]; F.n_ffn_post = args.in[9]; F.w_in = args.in[10]; F.gdn_conv = args.in[11]; F.ret_log_decay = args.in[12]; F.gdn_a_log = args.in[13]; F.gdn_dt_bias = args.in[14];
    F.ret_gn_w = args.in[15]; F.gdn_norm_w = args.in[16]; F.w_ret_out = args.in[17]; F.w_gdn_out = args.in[18]; F.w_o = args.in[19]; F.w_router = args.in[20]; F.router_bias = args.in[21];
    F.w_gate = args.in[22]; F.w_up = args.in[23]; F.w_down = args.in[24]; F.w_sh_gate = args.in[25]; F.w_sh_up = args.in[26]; F.w_sh_down = args.in[27];
    F.out = args.out; F.ws = args.ws; F.ctl = (unsigned*)(args.ws + WS_CTL);
    volatile LAS unsigned* MISC = (volatile LAS unsigned*)(F.lds + MISC_OFF);
    if (F.tid < 64) MISC[F.tid] = 0u;
    __syncthreads();
#if MK_ONE_LAUNCH
    XcdBarrier bar = xcd_barrier_post(F.ctl + CW_BAR, MISC + 8);
#define SEAM() xcd_barrier(bar)
#else
#define SEAM() do {} while (0)
#endif
    const int lo = args.ph_lo, hi = args.ph_hi;
#ifndef PHM
#define PHM 0xffff
#endif
#ifndef DUP
#define DUP -1
#endif
#define IN(k) (((PHM >> (k)) & 1) && lo <= (k) && (k) < hi)
    LAS int* tp = (LAS int*)(F.lds + MISC_OFF + 256);
#ifndef PROBE_PH
#define PROBE_PH -1
#endif
#ifdef PROBE_A
#define PROBE_IA PROBE_A
#define PROBE_IB PROBE_B
#else
#define PROBE_IA (PROBE_PH % 100)
#define PROBE_IB ((PROBE_PH % 100) + 1)
#endif
    volatile LAS unsigned long long* tsl = (volatile LAS unsigned long long*)(F.lds + MISC_OFF + 4608);
#define STAMP(k) do { if (PROBE_PH >= 0 && F.bid == 0 && F.tid == 0 && !(PROBE_PH == 204 && (k) == 5)) tsl[k] = __builtin_amdgcn_s_memrealtime(); } while (0)

    STAMP(0);
    if (IN(0)) _Pragma("unroll") for (int rep_ = 0; rep_ < ((DUP == 0) ? 2 : 1); ++rep_) { phase_prologue(F); SEAM(); }
    STAMP(1);
    if (IN(1)) _Pragma("unroll") for (int rep_ = 0; rep_ < ((DUP == 1) ? 2 : 1); ++rep_) { phase_norm1(F);
        if (F.G >= 64 && F.bid < 32) { SchedCtx S{(const char*)WSP(bf16, WS_HX), (const char*)WSP(bf16, WS_WIN), F.bid >> 3, F.bid & 7}; EpiIn E{WSP(bf16, WS_P), (bf16*)F.out, WSP(float2, WS_ROPE)};
            pg8::gemm_phase<EpiIn, SchedCtx, false, SP2>(F.lds, DM, S, E); }
        SEAM(); }
    STAMP(2);
    if (IN(2)) _Pragma("unroll") for (int rep_ = 0; rep_ < ((DUP == 2) ? 2 : 1); ++rep_) {
        SchedIn S{(const char*)WSP(bf16, WS_HX), (const char*)WSP(bf16, WS_WIN), F.G, F.bid};
        EpiIn E{WSP(bf16, WS_P), (bf16*)F.out, WSP(float2, WS_ROPE)};
        pg8::gemm_phase<EpiIn, SchedIn, false, SP2>(F.lds, DM, S, E); SEAM();
    }
    STAMP(3);
    if (IN(3)) _Pragma("unroll") for (int rep_ = 0; rep_ < ((DUP == 3) ? 2 : 1); ++rep_) { phase_prep(F); SEAM(); }
    STAMP(4);
    if (IN(4)) _Pragma("unroll") for (int rep_ = 0; rep_ < ((DUP == 4) ? 2 : 1); ++rep_) { phase_scan(F); SEAM(); }
    STAMP(5);
    if (IN(5)) _Pragma("unroll") for (int rep_ = 0; rep_ < ((DUP == 5) ? 2 : 1); ++rep_) { phase_out(F); SEAM(); }
    STAMP(6);
    if (IN(6)) _Pragma("unroll") for (int rep_ = 0; rep_ < ((DUP == 6) ? 2 : 1); ++rep_) {
        SchedMerge S{(const char*)WSP(bf16, WS_RETY), (const char*)WSP(bf16, WS_GDNY), (const char*)WSP(bf16, WS_WRO), (const char*)WSP(bf16, WS_WGO), F.G, F.bid};
        EpiMerge E{(const bf16*)F.out, WSP(bf16, WS_TMP), WSP(bf16, WS_MERGED)};
        pg8::gemm_phase<EpiMerge, SchedMerge, false, SP2>(F.lds, 512, S, E);
        STAMP(15);
        if (rep_ == 0) { _Pragma("unroll") for (int r2_ = 0; r2_ < ((DUP == 16) ? 2 : 1); ++r2_) phase_moe_weights(F); }
        SEAM();
    }
    STAMP(7);
    if (IN(7)) _Pragma("unroll") for (int rep_ = 0; rep_ < ((DUP == 7) ? 2 : 1); ++rep_) {
        SchedDense S{(const char*)WSP(bf16, WS_MERGED), (const char*)WSP(bf16, WS_WO), 64, 4, DM, F.G, F.bid};
        EpiBf16Store E{WSP(bf16, WS_MO), DM};
        pg8::gemm_phase<EpiBf16Store, SchedDense, false, SP2>(F.lds, DM, S, E); SEAM();
    }
    STAMP(8);
    if (IN(8)) _Pragma("unroll") for (int rep_ = 0; rep_ < ((DUP == 8) ? 2 : 1); ++rep_) { if (rep_ == 1) { if (F.bid == 0 && F.tid < 64) F.ctl[CW_CNT + 64 * F.tid] = 0u; SEAM(); } phase_route(F); SEAM(); }
    STAMP(9);
    if (IN(9)) _Pragma("unroll") for (int rep_ = 0; rep_ < ((DUP == 9) ? 2 : 1); ++rep_) {
        build_tile_prefix(F, tp);
        SchedMoe S{(const char*)WSP(bf16, WS_H2), (const char*)WSP(bf16, WS_WGU), WSP(int2, WS_LIST), F.ctl + CW_CNT, tp, 2, DM, F.G, F.bid, (size_t)512 * DM * 2, 0, true};
        EpiUp E{WSP(bf16, WS_HMID)};
        pg8::gemm_phase<EpiUp, SchedMoe, true, SP2>(F.lds, DM, S, E); SEAM();
    }
    STAMP(10);
    if (IN(10)) _Pragma("unroll") for (int rep_ = 0; rep_ < ((DUP == 10) ? 2 : 1); ++rep_) {
        build_tile_prefix(F, tp);
        SchedMoe S{(const char*)WSP(bf16, WS_HMID), (const char*)WSP(bf16, WS_WD), WSP(int2, WS_LIST), F.ctl + CW_CNT, tp, 4, DEXP, F.G, F.bid, (size_t)DM * DEXP * 2, 0, false};
        EpiDown E{F.ws + WS_YB, F.out, WSP(int2, WS_LIST), tp};
        pg8::gemm_phase<EpiDown, SchedMoe, false, SP2>(F.lds, DEXP, S, E); SEAM();
    }
    STAMP(11);
    STAMP(12);
    STAMP(13);
    if (IN(13)) _Pragma("unroll") for (int rep_ = 0; rep_ < ((DUP == 13) ? 2 : 1); ++rep_) { phase_final(F); }
    STAMP(14);
    if (PROBE_PH >= 0 && F.bid == 0) { __syncthreads(); if (F.tid == 0) { const unsigned long long d = tsl[PROBE_IB] - tsl[PROBE_IA]; float a = 1.0f + 0.2f * floorf((float)d * 0.001f); a = a > 30.f ? 30.f : a;
#ifdef PROBE_BIG
            a = 20.0f + (float)d * 0.005f;
#endif
            asm volatile("s_waitcnt vmcnt(0)" ::: "memory"); F.out[0] += a; } }
#undef IN
}

extern "C" void kernel_launch(void* const* d_in, const int* in_sizes, int n_in, void* d_out, int out_size, void* d_ws, size_t ws_size, hipStream_t stream) {
    static int grid = 0;
    if (grid == 0) {
        if (n_in != 28 || in_sizes[0] != NT * DM || out_size != NT * DM || ws_size < WS_END) { fprintf(stderr, "kernel_launch: unexpected shapes / workspace (%d inputs, ws %zu)\n", n_in, ws_size); grid = -1; return; }
        int dev = 0, cus = 0;
        if (hipGetDevice(&dev) != hipSuccess || hipDeviceGetAttribute(&cus, hipDeviceAttributeMultiprocessorCount, dev) != hipSuccess) { grid = -1; return; }
        if (hipFuncSetAttribute((const void*)fwd, hipFuncAttributeMaxDynamicSharedMemorySize, LDS_BYTES) != hipSuccess) { fprintf(stderr, "kernel_launch: hipFuncSetAttribute failed\n"); grid = -1; return; }
        int per_cu = 0; (void)hipOccupancyMaxActiveBlocksPerMultiprocessor(&per_cu, (const void*)fwd, NTHR, LDS_BYTES); (void)hipGetLastError();
        if (per_cu < 1) fprintf(stderr, "kernel_launch: occupancy query says %d\n", per_cu);
        grid = cus;
    }
    if (grid < 0) return;
    (void)hipMemsetAsync((char*)d_ws + WS_CTL, 0, CTL_BYTES, stream);
    Args a{};
    for (int i = 0; i < 28; ++i) a.in[i] = (const float*)d_in[i];
    a.out = (float*)d_out; a.ws = (unsigned char*)d_ws;
#if MK_ONE_LAUNCH
    a.ph_lo = 0; a.ph_hi = N_PHASES;
    hipLaunchKernelGGL(fwd, dim3(grid), dim3(NTHR), LDS_BYTES, stream, a);
#else
    for (int p = 0; p < 14; ++p) { a.ph_lo = p; a.ph_hi = p + 1; hipLaunchKernelGGL(fwd, dim3(grid), dim3(NTHR), LDS_BYTES, stream, a); }
#endif
}
```

```cpp
#include <hip/hip_runtime.h>
#include <cstdio>
#include <cstdint>

#ifndef MK_ONE_LAUNCH
#define MK_ONE_LAUNCH 1
#endif
#ifndef MK_REF_GEMM
#define MK_REF_GEMM 0
#endif

constexpr int NB = 4, SEQ = 4096, DM = 1024, CTXL = 256, RPB = SEQ + CTXL  , NROW = NB * RPB  , NT = NB * SEQ  ;
constexpr int NH = 4, HD = 128, CH = 128, NCHUNK = RPB / CH  ;
constexpr int N_STATE = 2064, N_IN = 6160, NEXP = 64, TOPK = 8, DEXP = 256;
constexpr float EPS = 1e-6f;
constexpr int NPCOL = 4096;
constexpr int SLOT_SH = 147456;
constexpr int NSLOT = SLOT_SH + NT;

constexpr size_t MiB = 1u << 20;
constexpr size_t WS_CTL = 0, CTL_BYTES = 64 * 1024;
constexpr size_t WS_MOD = 1 * MiB;
constexpr size_t WS_ROPE = 2 * MiB;
constexpr size_t WS_LOGA = 4 * MiB;
constexpr size_t WS_BETA = 5 * MiB;
constexpr size_t WS_WRO = 6 * MiB, WS_WGO = 7 * MiB, WS_WO = 8 * MiB;
constexpr size_t WS_P = 10 * MiB;
constexpr size_t PGRP = (size_t)NROW * 512;
constexpr size_t WS_CH = 146 * MiB;
constexpr size_t WS_WIN = WS_CH;
constexpr size_t WS_HX = WS_CH + 12 * MiB;
constexpr size_t WS_GM = WS_CH;
constexpr size_t WS_GC = WS_CH + 34 * MiB;
constexpr size_t WS_GKV = WS_CH + 68 * MiB;
constexpr size_t WS_GQT = WS_CH + 102 * MiB;
constexpr size_t WS_OGDN = WS_CH + 134 * MiB;
constexpr size_t WS_ORET = WS_CH + 150 * MiB;
constexpr size_t WS_RETY = WS_P, WS_GDNY = WS_P + 17 * MiB;
constexpr size_t WS_H2 = 10 * MiB;
constexpr size_t WS_WGU = 73 * MiB;
constexpr size_t WS_YB = 10 * MiB;
constexpr size_t WS_WD = 138 * MiB;
constexpr size_t WS_HMID = 171 * MiB;
constexpr size_t WS_TMP = 171 * MiB, WS_MERGED = 203 * MiB;
constexpr size_t WS_MO = 251 * MiB;
constexpr size_t WS_LIST = 283 * MiB;
constexpr size_t WS_END = 312 * MiB;

constexpr int CW_BAR = 1024;
constexpr int CW_CNT = 8192;
constexpr int CW_FLAG = 12288;

#define GAS __attribute__((address_space(1)))
#define LAS __attribute__((address_space(3)))
typedef unsigned short bf16;
typedef float f32x4 __attribute__((ext_vector_type(4)));
typedef float f32x2 __attribute__((ext_vector_type(2)));
typedef short bf16x8 __attribute__((ext_vector_type(8)));
typedef unsigned u32x4 __attribute__((ext_vector_type(4)));
typedef unsigned u32x2 __attribute__((ext_vector_type(2)));
__device__ __forceinline__ unsigned f2bf(float f) { unsigned u = __builtin_bit_cast(unsigned, f); return (u + 0x7fffu + ((u >> 16) & 1u)) >> 16; }
typedef __bf16 bf16x2_t __attribute__((ext_vector_type(2)));
__device__ __forceinline__ unsigned pk2(float lo, float hi) { const f32x2 v = {lo, hi}; return __builtin_bit_cast(unsigned, __builtin_convertvector(v, bf16x2_t)); }
__device__ __forceinline__ float bf2f(unsigned b) { return __builtin_bit_cast(float, b << 16); }
__device__ __forceinline__ float bflo(unsigned w) { return __builtin_bit_cast(float, w << 16); }
__device__ __forceinline__ float bfhi(unsigned w) { return __builtin_bit_cast(float, w & 0xffff0000u); }
__device__ __forceinline__ float sigmoidf_(float x) { return __builtin_amdgcn_rcpf(1.f + __expf(-x)); }
__device__ __forceinline__ float siluf_(float x) { return x * __builtin_amdgcn_rcpf(1.f + __expf(-x)); }
__device__ __forceinline__ float dpp_add(float v, const int ctrl_tag) { return v; }
#define DPP_ADD(v, ctrl) ((v) + __builtin_bit_cast(float, __builtin_amdgcn_update_dpp(0, __builtin_bit_cast(int, (v)), (ctrl), 0xf, 0xf, true)))
__device__ __forceinline__ float sum16(float v) {
    v = DPP_ADD(v, 0xB1);
    v = DPP_ADD(v, 0x4E);
    v = DPP_ADD(v, 0x141);
    v = DPP_ADD(v, 0x140);
    return v;
}
__device__ __forceinline__ float wave_sum(float v) {
    v = sum16(v);
    const float r0 = __builtin_bit_cast(float, __builtin_amdgcn_readlane(__builtin_bit_cast(int, v), 0)), r1 = __builtin_bit_cast(float, __builtin_amdgcn_readlane(__builtin_bit_cast(int, v), 16));
    const float r2 = __builtin_bit_cast(float, __builtin_amdgcn_readlane(__builtin_bit_cast(int, v), 32)), r3 = __builtin_bit_cast(float, __builtin_amdgcn_readlane(__builtin_bit_cast(int, v), 48));
    return (r0 + r1) + (r2 + r3);
}
__device__ __forceinline__ void unpack8(const u32x4 w, float (&o)[8]) {
    o[0] = bflo(w.x); o[1] = bfhi(w.x); o[2] = bflo(w.y); o[3] = bfhi(w.y); o[4] = bflo(w.z); o[5] = bfhi(w.z); o[6] = bflo(w.w); o[7] = bfhi(w.w);
}
__device__ __forceinline__ u32x4 pack8(const float (&v)[8]) { u32x4 w; w.x = pk2(v[0], v[1]); w.y = pk2(v[2], v[3]); w.z = pk2(v[4], v[5]); w.w = pk2(v[6], v[7]); return w; }

namespace pg8 {
constexpr int BM = 256, BK = 64, HALF = 128, HTB = HALF * BK * 2, STAGE_BYTES = 8 * HTB;
__host__ __device__ __forceinline__ int lds_byte(int r, int c) { const int st = (r >> 4) * 2 + (c >> 5), rr = r & 15, cc = c & 31, ob = rr * 64 + cc * 2; return st * 1024 + (ob ^ (((ob >> 9) & 1) << 5)); }
__host__ __device__ __forceinline__ void stage_rc(int b, int& R, int& C) { const int st = b / 1024, sb = b % 1024, swz = sb ^ (((sb >> 9) & 1) << 5); R = (st >> 1) * 16 + swz / 64; C = (st & 1) * 32 + (swz % 64) / 2; }
__host__ __device__ __forceinline__ int perm32(int rho) { const int n = rho >> 4, i = rho & 15; return 8 * (i >> 2) + 4 * n + (i & 3); }
__device__ __forceinline__ unsigned cvt_pk_bf16(float lo, float hi) { unsigned r; asm volatile("v_cvt_pk_bf16_f32 %0, %1, %2" : "=v"(r) : "v"(lo), "v"(hi)); return r; }

struct Unit { const char* A; const char* B; int pm, pn, e, base; };

template <class Epi, class Sched, bool GATHER, bool SP2>
__device__ __forceinline__ void gemm_phase(LAS unsigned char* lds, const int K, const Sched& S, const Epi& E) {
#if MK_REF_GEMM
    {
        const int tid = threadIdx.x, wid = tid >> 6, lane = tid & 63, wr = wid >> 2, wc = wid & 3, fr = lane & 15, fq = lane >> 4;
        Unit cur;
        for (int ui = 0; S.next(ui, cur); ++ui) {
            f32x4 acc[2][2][4][2];
            for (int ai = 0; ai < 2; ++ai) for (int m = 0; m < 4; ++m) {
                const int r = 128 * ai + 64 * wr + 16 * m + fr;
                const bf16* arow = GATHER ? (const bf16*)cur.A + (size_t)S.row_index(cur, r) * K : (const bf16*)cur.A + (size_t)r * K;
                for (int bj = 0; bj < 2; ++bj) for (int n = 0; n < 2; ++n) {
                    f32x4 a4 = {0.f, 0.f, 0.f, 0.f};
                    for (int i = 0; i < 4; ++i) { const int c = 128 * bj + 32 * wc + 8 * fq + 4 * n + i; const bf16* brow = (const bf16*)cur.B + (size_t)c * K;
                        float s = 0.f; for (int k = 0; k < K; ++k) s += bf2f(arow[k]) * bf2f(brow[k]); a4[i] = s; }
                    acc[ai][bj][m][n] = a4; } }
            E(acc, cur, wr, wc, fr, fq);
        }
        return;
    }
#else
    const int tid = threadIdx.x, wid = __builtin_amdgcn_readfirstlane(tid >> 6), lane = tid & 63, wr = wid >> 2, wc = wid & 3, fr = lane & 15, fq = lane >> 4;
    const int nt = K / BK;
    unsigned voffA[2], voffB[2]; int gR = 0, gC = 0;
#pragma unroll
    for (int i = 0; i < 2; ++i) { int R, C; stage_rc(tid * 16 + i * 8192, R, C); const int Rb = (R & ~31) + perm32(R & 31);
        voffA[i] = (unsigned)(R * K + C) * 2u; voffB[i] = (unsigned)(Rb * K + C) * 2u; if (i == 0) { gR = R; gC = C; } }
    const size_t kstep = (size_t)(BK * 2);
    const size_t hstep = (size_t)HALF * K * 2;
    const unsigned ldsw = (unsigned)wid * 1024u;
    const int aoff = lds_byte(wr * 64 + fr, fq * 8), boff = lds_byte(wc * 32 + fr, fq * 8);
#define PG8_SA(b, h) (((b) * 2 + (h)) * HTB)
#define PG8_SB(b, h) ((4 + (b) * 2 + (h)) * HTB)
#define PG8_STAGE(bufoff, gbase, voff) do { _Pragma("unroll") for (int _i = 0; _i < 2; ++_i) \
        __builtin_amdgcn_global_load_lds((const unsigned*)((const char*)(gbase) + (voff)[_i]), (LAS unsigned*)(lds + (bufoff) + ldsw + _i * 8192), 16, 0, 0); } while (0)
#define PG8_STAGE_A(bufoff, gbase, h, G) do { if constexpr (GATHER) { PG8_STAGE(bufoff, gbase, (G)[h]); } else { PG8_STAGE(bufoff, (gbase) + (h) * hstep, voffA); } } while (0)
#define PG8_LDA(dst, b, h) do { _Pragma("unroll") for (int m = 0; m < 4; ++m) _Pragma("unroll") for (int k = 0; k < 2; ++k) dst[m][k] = *(const LAS bf16x8*)(lds + PG8_SA(b, h) + aoff + m * 2048 + k * 1024); } while (0)
#define PG8_LDB(dst, b, h) do { _Pragma("unroll") for (int n = 0; n < 2; ++n) _Pragma("unroll") for (int k = 0; k < 2; ++k) dst[n][k] = *(const LAS bf16x8*)(lds + PG8_SB(b, h) + boff + n * 2048 + k * 1024); } while (0)
#define PG8_MMA(ai, bj, At, Bt) do { __builtin_amdgcn_s_setprio(1); _Pragma("unroll") for (int m = 0; m < 4; ++m) _Pragma("unroll") for (int n = 0; n < 2; ++n) _Pragma("unroll") for (int k = 0; k < 2; ++k) \
        acc[ai][bj][m][n] = __builtin_amdgcn_mfma_f32_16x16x32_bf16(Bt[n][k], At[m][k], acc[ai][bj][m][n], 0, 0, 0); __builtin_amdgcn_s_setprio(0); } while (0)
#define PG8_WAIT_V(n) asm volatile("s_waitcnt vmcnt(" #n ")" ::: "memory")
#define PG8_WAIT_L(n) asm volatile("s_waitcnt lgkmcnt(" #n ")" ::: "memory")
#define PG8_BAR __builtin_amdgcn_s_barrier()
#define PG8_SCHED __builtin_amdgcn_sched_barrier(0)
    Unit cur, nxt; int ui = 0;
    if (!S.next(0, cur)) return;
    f32x4 acc[2][2][4][2];
#pragma unroll
    for (int a = 0; a < 2; ++a)
#pragma unroll
        for (int b = 0; b < 2; ++b)
#pragma unroll
            for (int m = 0; m < 4; ++m)
#pragma unroll
                for (int n = 0; n < 2; ++n) acc[a][b][m][n] = (f32x4){0.f, 0.f, 0.f, 0.f};
    bf16x8 At[4][2], B0[2][2], B1[2][2];
    const char* cA = cur.A; const char* cB = cur.B;
    unsigned cG[2][2] = {{0u, 0u}, {0u, 0u}}, nG[2][2] = {{0u, 0u}, {0u, 0u}};
    if constexpr (GATHER) {
#pragma unroll
        for (int h = 0; h < 2; ++h)
#pragma unroll
            for (int i = 0; i < 2; ++i) cG[h][i] = ((unsigned)S.row_index(cur, 128 * h + gR + 64 * i) * (unsigned)K + (unsigned)gC) * 2u;
    }
    if constexpr (SP2) {
        PG8_STAGE(PG8_SB(0, 0), cB, voffB); PG8_STAGE(PG8_SB(0, 1), cB + hstep, voffB); PG8_STAGE_A(PG8_SA(0, 0), cA, 0, cG); PG8_STAGE_A(PG8_SA(0, 1), cA, 1, cG);
        if (wr == 1) PG8_BAR;
        PG8_WAIT_V(2); PG8_BAR;
        PG8_STAGE(PG8_SB(1, 0), cB + kstep, voffB); PG8_STAGE_A(PG8_SA(1, 0), cA + kstep, 0, cG); PG8_STAGE(PG8_SB(1, 1), cB + hstep + kstep, voffB);
        PG8_WAIT_V(6); PG8_BAR;
    } else {
        PG8_STAGE(PG8_SB(0, 0), cB, voffB); PG8_STAGE_A(PG8_SA(0, 0), cA, 0, cG); PG8_STAGE(PG8_SB(0, 1), cB + hstep, voffB); PG8_STAGE_A(PG8_SA(0, 1), cA, 1, cG);
        if (wr == 1) PG8_BAR;
        PG8_WAIT_V(4); PG8_BAR;
        PG8_STAGE(PG8_SB(1, 0), cB + kstep, voffB); PG8_STAGE_A(PG8_SA(1, 0), cA + kstep, 0, cG); PG8_STAGE(PG8_SB(1, 1), cB + hstep + kstep, voffB);
        PG8_WAIT_V(6); PG8_BAR;
    }
    for (;;) {
        const bool has_next = S.next(ui + 1, nxt);
        const char* nA = has_next ? nxt.A : cA; const char* nB = has_next ? nxt.B : cB;
        for (int t = 0; t < nt; t += 2) {
            const bool last = (t == nt - 2);
            const char* a1 = cA + (size_t)(t + 1) * kstep;
            const char* a2 = last ? nA : cA + (size_t)(t + 2) * kstep; const char* b2 = last ? nB : cB + (size_t)(t + 2) * kstep;
            const char* a3 = a2 + kstep; const char* b3 = b2 + kstep;
            unsigned g2[2][2] = {{0u, 0u}, {0u, 0u}};
            if constexpr (GATHER) {
                if (last) {
                    if (has_next) {
#pragma unroll
                        for (int h = 0; h < 2; ++h)
#pragma unroll
                            for (int i = 0; i < 2; ++i) nG[h][i] = ((unsigned)S.row_index(nxt, 128 * h + gR + 64 * i) * (unsigned)K + (unsigned)gC) * 2u;
                    } else {
#pragma unroll
                        for (int h = 0; h < 2; ++h)
#pragma unroll
                            for (int i = 0; i < 2; ++i) nG[h][i] = cG[h][i];
                    }
                }
#pragma unroll
                for (int h = 0; h < 2; ++h)
#pragma unroll
                    for (int i = 0; i < 2; ++i) g2[h][i] = last ? nG[h][i] : cG[h][i];
            }
            if constexpr (SP2) {
            PG8_LDB(B0, 0, 0); PG8_LDB(B1, 0, 1); PG8_SCHED; PG8_LDA(At, 0, 0); PG8_STAGE_A(PG8_SA(1, 1), a1, 1, cG);
            PG8_WAIT_V(8); PG8_WAIT_L(0); PG8_BAR; PG8_MMA(0, 0, At, B0); PG8_MMA(0, 1, At, B1); PG8_BAR; PG8_SCHED;
            PG8_LDA(At, 0, 1); PG8_STAGE(PG8_SB(0, 0), b2, voffB); PG8_STAGE(PG8_SB(0, 1), b2 + hstep, voffB); PG8_STAGE_A(PG8_SA(0, 0), a2, 0, g2);
            PG8_WAIT_V(8); PG8_WAIT_L(0); PG8_BAR; PG8_MMA(1, 0, At, B0); PG8_MMA(1, 1, At, B1); PG8_BAR; PG8_SCHED;
            PG8_LDB(B0, 1, 0); PG8_LDB(B1, 1, 1); PG8_SCHED; PG8_LDA(At, 1, 0); PG8_STAGE_A(PG8_SA(0, 1), a2, 1, g2);
            PG8_WAIT_V(8); PG8_WAIT_L(0); PG8_BAR; PG8_MMA(0, 0, At, B0); PG8_MMA(0, 1, At, B1); PG8_BAR; PG8_SCHED;
            PG8_LDA(At, 1, 1); PG8_STAGE(PG8_SB(1, 0), b3, voffB); PG8_STAGE(PG8_SB(1, 1), b3 + hstep, voffB); PG8_STAGE_A(PG8_SA(1, 0), a3, 0, g2);
            PG8_WAIT_V(8); PG8_WAIT_L(0); PG8_BAR; PG8_MMA(1, 0, At, B0); PG8_MMA(1, 1, At, B1); PG8_BAR; PG8_SCHED;
            } else {
            PG8_LDB(B0, 0, 0); PG8_SCHED; PG8_LDA(At, 0, 0); PG8_STAGE_A(PG8_SA(1, 1), a1, 1, cG);
            PG8_WAIT_L(8); PG8_BAR; PG8_WAIT_L(0); PG8_MMA(0, 0, At, B0); PG8_BAR; PG8_SCHED;
            PG8_LDB(B1, 0, 1); PG8_STAGE(PG8_SB(0, 0), b2, voffB);
            PG8_BAR; PG8_WAIT_L(0); PG8_MMA(0, 1, At, B1); PG8_BAR;
            PG8_LDA(At, 0, 1); PG8_STAGE_A(PG8_SA(0, 0), a2, 0, g2);
            PG8_BAR; PG8_WAIT_L(0); PG8_MMA(1, 0, At, B0); PG8_BAR; PG8_SCHED;
            PG8_STAGE(PG8_SB(0, 1), b2 + hstep, voffB);
            PG8_WAIT_V(6); PG8_BAR; PG8_MMA(1, 1, At, B1); PG8_BAR;
            PG8_LDB(B0, 1, 0); PG8_SCHED; PG8_LDA(At, 1, 0); PG8_STAGE_A(PG8_SA(0, 1), a2, 1, g2);
            PG8_WAIT_L(8); PG8_BAR; PG8_WAIT_L(0); PG8_MMA(0, 0, At, B0); PG8_BAR; PG8_SCHED;
            PG8_LDB(B1, 1, 1); PG8_STAGE(PG8_SB(1, 0), b3, voffB);
            PG8_BAR; PG8_WAIT_L(0); PG8_MMA(0, 1, At, B1); PG8_BAR;
            PG8_LDA(At, 1, 1); PG8_STAGE_A(PG8_SA(1, 0), a3, 0, g2);
            PG8_BAR; PG8_WAIT_L(0); PG8_MMA(1, 0, At, B0); PG8_BAR; PG8_SCHED;
            PG8_STAGE(PG8_SB(1, 1), b3 + hstep, voffB);
            PG8_WAIT_V(6); PG8_BAR; PG8_MMA(1, 1, At, B1); PG8_BAR;
            }
        }
        if (wr == 0) PG8_BAR;
        { int tz = threadIdx.x; asm volatile("" : "+v"(tz)); const int wid_ = __builtin_amdgcn_readfirstlane(tz >> 6), lane_ = tz & 63;
          E(acc, cur, wid_ >> 2, wid_ & 3, lane_ & 15, lane_ >> 4); }
        if (!has_next) break;
#pragma unroll
        for (int a = 0; a < 2; ++a)
#pragma unroll
            for (int b = 0; b < 2; ++b)
#pragma unroll
                for (int m = 0; m < 4; ++m)
#pragma unroll
                    for (int n = 0; n < 2; ++n) acc[a][b][m][n] = (f32x4){0.f, 0.f, 0.f, 0.f};
        cur = nxt; cA = nA; cB = nB; ++ui;
        if constexpr (GATHER) {
#pragma unroll
            for (int h = 0; h < 2; ++h)
#pragma unroll
                for (int i = 0; i < 2; ++i) cG[h][i] = nG[h][i];
        }
        if (wr == 1) PG8_BAR;
    }
    PG8_WAIT_V(0);
    PG8_BAR;
#undef PG8_SA
#undef PG8_SB
#undef PG8_STAGE
#undef PG8_STAGE_A
#undef PG8_LDA
#undef PG8_LDB
#undef PG8_MMA
#undef PG8_WAIT_V
#undef PG8_WAIT_L
#undef PG8_BAR
#undef PG8_SCHED
#endif
}
}
constexpr bool SP2 = true;

#define XB_TMO      128
#define XB_XCNT(j)  (256  + 64 * (j))
#define XB_XSUB(j)  (1280 + 64 * (j))
#define XB_XGEN(j)  (2304 + 64 * (j))
#define XB_TOP      3328
#define XB_TOPGEN   3392
#define XCD_BAR_WORDS 3456
#define XB_SPIN_CAP (1u << 18)
__device__ __forceinline__ unsigned xb_ld(unsigned* p)              { return __hip_atomic_load(p, __ATOMIC_RELAXED, __HIP_MEMORY_SCOPE_AGENT); }
__device__ __forceinline__ unsigned xb_add(unsigned* p, unsigned v) { return __hip_atomic_fetch_add(p, v, __ATOMIC_RELAXED, __HIP_MEMORY_SCOPE_AGENT); }
__device__ __forceinline__ unsigned xb_xcc_id() { return (unsigned)__builtin_amdgcn_s_getreg((3 << 11) | 20) & 0xFu; }
#define XB_SPIN(cond, bar) do { unsigned _sp = 0; while (cond) { __builtin_amdgcn_s_sleep(1); \
    if ((++_sp & 255u) == 0u) { if (xb_ld(&(bar)[XB_TMO])) break; if (_sp > XB_SPIN_CAP) { atomicAdd(&(bar)[XB_TMO], 1u); break; } } } } while (0)
struct XcdBarrier { unsigned* bar; unsigned x; volatile LAS unsigned* st; };
__device__ __forceinline__ XcdBarrier xcd_barrier_post(unsigned* bar, volatile LAS unsigned* st) {
    XcdBarrier b; b.bar = bar; b.x = xb_xcc_id(); b.st = st;
    if (threadIdx.x == 0) (void)xb_add(&bar[XB_XCNT(b.x)], 1u);
    return b;
}
__device__ __forceinline__ void xcd_barrier_complete(unsigned* bar, unsigned x, unsigned& nloc, unsigned& nx) {
    const unsigned G = gridDim.x * gridDim.y * gridDim.z;
    unsigned sum, cnt, mine, sp = 0u;
    for (;;) {
        sum = 0u; cnt = 0u; mine = 0u;
#pragma unroll
        for (unsigned j = 0; j < 16; ++j) { const unsigned c = xb_ld(&bar[XB_XCNT(j)]); sum += c; cnt += (c > 0u) ? 1u : 0u; mine = (j == x) ? c : mine; }
        if (sum == G) break;
        __builtin_amdgcn_s_sleep(1);
        if ((++sp & 255u) == 0u) { if (xb_ld(&bar[XB_TMO])) break; if (sp > XB_SPIN_CAP) { atomicAdd(&bar[XB_TMO], 1u); break; } }
    }
    nloc = mine > 0u ? mine : 1u; nx = cnt > 0u ? cnt : 1u;
}
__device__ __forceinline__ void xcd_barrier(const XcdBarrier& b) {
    asm volatile("s_waitcnt vmcnt(0)" ::: "memory");
    __syncthreads();
    if (threadIdx.x == 0) {
        unsigned* bar = b.bar;
        __builtin_amdgcn_s_waitcnt(0);
        unsigned nloc = b.st[0], nx = b.st[1];
        if (nloc == 0u) { xcd_barrier_complete(bar, b.x, nloc, nx); b.st[0] = nloc; b.st[1] = nx; }
        const unsigned old = xb_add(&bar[XB_XSUB(b.x)], 1u);
        const unsigned gen = old / nloc;
        if (old + 1u == (gen + 1u) * nloc) {
            __builtin_amdgcn_fence(__ATOMIC_RELEASE, "agent");
            asm volatile("s_waitcnt vmcnt(0)" ::: "memory");
            const unsigned og = xb_add(&bar[XB_TOP], 1u);
            const unsigned tg = og / nx;
            if (og + 1u == (tg + 1u) * nx) xb_add(&bar[XB_TOPGEN], 1u);
            else XB_SPIN(xb_ld(&bar[XB_TOPGEN]) == tg, bar);
            __builtin_amdgcn_fence(__ATOMIC_ACQUIRE, "agent");
            xb_add(&bar[XB_XGEN(b.x)], 1u);
            asm volatile("s_waitcnt vmcnt(0)" ::: "memory");
        } else {
            XB_SPIN(xb_ld(&bar[XB_XGEN(b.x)]) == gen, bar);
            __builtin_amdgcn_fence(__ATOMIC_ACQUIRE, "agent");
            asm volatile("s_waitcnt vmcnt(0)" ::: "memory");
        }
    }
    __syncthreads();
}

constexpr int NWAVES = 8, NTHR = 512;
constexpr int RING_BYTES = 131072, MISC_OFF = 139264, LDS_BYTES = 147456;
struct Args {
    const float* in[28]; float* out; unsigned char* ws; int ph_lo, ph_hi;
};
struct Frame {
    LAS unsigned char* lds; int tid, lane, wave, G, bid;
    const float *x, *c, *ctx, *c_ctx, *w_mod, *b_mod, *n_mix_pre, *n_mix_post, *n_ffn_pre, *n_ffn_post, *w_in, *gdn_conv, *ret_log_decay, *gdn_a_log, *gdn_dt_bias,
        *ret_gn_w, *gdn_norm_w, *w_ret_out, *w_gdn_out, *w_o, *w_router, *router_bias, *w_gate, *w_up, *w_down, *w_sh_gate, *w_sh_up, *w_sh_down;
    float* out; unsigned char* ws; unsigned* ctl;
};
#define WSP(T, off) ((T*)(F.ws + (off)))

template <class CM>
__device__ __forceinline__ void transpose_item(const float* W, int ld, int K, bf16* WT, LAS float* scr, int kb, int nb, int lane, const CM& cm) {
    const int k0 = 64 * kb, n0 = 32 * nb; const int sc = cm(n0 + (lane & 31));
    float tv[32];
#pragma unroll
    for (int i = 0; i < 32; ++i) tv[i] = W[(size_t)(k0 + 2 * i + (lane >> 5)) * ld + sc];
#pragma unroll
    for (int i = 0; i < 32; ++i) scr[(2 * i + (lane >> 5)) * 33 + (lane & 31)] = tv[i];
    asm volatile("s_waitcnt lgkmcnt(0)" ::: "memory");
    const int c = lane & 7;
#pragma unroll
    for (int j = 0; j < 4; ++j) { const int n = (lane >> 3) + 8 * j; const LAS float* s = scr + (8 * c) * 33 + n;
        u32x4 o; o.x = pk2(s[0 * 33], s[1 * 33]); o.y = pk2(s[2 * 33], s[3 * 33]); o.z = pk2(s[4 * 33], s[5 * 33]); o.w = pk2(s[6 * 33], s[7 * 33]);
        *(u32x4*)(WT + (size_t)(n0 + n) * K + k0 + 8 * c) = o; }
    asm volatile("s_waitcnt lgkmcnt(0)" ::: "memory");
}
struct CmIdent { int off; __device__ __forceinline__ int operator()(int n) const { return n + off; } };
struct CmWin {
    __device__ __forceinline__ int operator()(int n) const {
        const int g = n >> 9; int src = n + (n >= 2048 ? 16 : 0);
        if (g == 0 || g == 4) { const int hb = n & ~127, cp = n & 127; const int wc = cp >> 5, fq = (cp >> 3) & 3, nn = (cp >> 2) & 1, i = cp & 3;
            const int d = 64 * nn + 16 * wc + 4 * fq + i; src = hb + d + (n >= 2048 ? 16 : 0); }
        return src; }
};
__device__ __forceinline__ void gu_decode(int cp, int& hid, int& isup) { const int pn = cp >> 8, r = cp & 255, bj = r >> 7, wc = (r >> 5) & 3, fq = (r >> 3) & 3, nn = (r >> 2) & 1, i = r & 3; hid = pn * 128 + bj * 64 + wc * 16 + fq * 4 + i; isup = nn; }

__device__ __forceinline__ void phase_prologue(Frame& F) {
    const int gw = F.bid * NWAVES + F.wave, NGW = F.G * NWAVES; const int gt = F.bid * NTHR + F.tid, NGT = F.G * NTHR;
    LAS float* scr = (LAS float*)(F.lds + F.wave * 16384);
    { float2* rt = WSP(float2, WS_ROPE);
      for (int idx = gt; idx < SEQ * 64; idx += NGT) { const int t = idx >> 6, j = idx & 63; const float pos = (float)(j < 32 ? (t >> 6) : (t & 63)); const int f = j & 31;
          const float inv = powf(10000.0f, -(float)f / 32.0f); const float ang = pos * inv; float sn, cs; sincosf(ang, &sn, &cs); rt[idx] = make_float2(cs, sn); } }
    {
        LAS float* red = (LAS float*)(F.lds);
        LAS float* sl = (LAS float*)(F.lds + 16384);
        if (F.bid < 96) { for (int i = F.tid; i < 5 * DM; i += NTHR) { const int r = i >> 10, k = i & 1023; sl[i] = siluf_(r < 4 ? F.c[r * DM + k] : F.c_ctx[k]); } __syncthreads(); }
        for (int it = F.bid; it < 96; it += F.G) {
            const int col = it * 64 + F.lane; float a[5] = {0.f, 0.f, 0.f, 0.f, 0.f};
            const int kb = F.wave * 128;
#pragma unroll 1
            for (int k0 = kb; k0 < kb + 128; k0 += 32) { float wv[32];
#pragma unroll
                for (int kk = 0; kk < 32; ++kk) wv[kk] = F.w_mod[(size_t)(k0 + kk) * 6144 + col];
#pragma unroll
                for (int kk = 0; kk < 32; ++kk) {
#pragma unroll
                    for (int r = 0; r < 5; ++r) a[r] += sl[r * DM + k0 + kk] * wv[kk]; } }
#pragma unroll
            for (int r = 0; r < 5; ++r) red[(F.wave * 5 + r) * 64 + F.lane] = a[r];
            __syncthreads();
            if (F.wave < 5) { float s = F.b_mod[col];
#pragma unroll
                for (int w = 0; w < 8; ++w) s += red[(w * 5 + F.wave) * 64 + F.lane];
                WSP(float, WS_MOD)[F.wave * 6144 + col] = s; }
            __syncthreads();
        }
    }
    {
        constexpr int I_IN = 16 * 192, I_RO = 8 * 32, I_O = 16 * 32; constexpr int NIT = I_IN + 2 * I_RO + I_O;
        for (int it = gw; it < NIT; it += NGW) { int r = it;
            if (r < I_IN) { transpose_item(F.w_in, N_IN, DM, WSP(bf16, WS_WIN), scr, r / 192, r % 192, F.lane, CmWin{}); continue; } r -= I_IN;
            if (r < I_RO) { transpose_item(F.w_ret_out, DM, 512, WSP(bf16, WS_WRO), scr, r / 32, r % 32, F.lane, CmIdent{0}); continue; } r -= I_RO;
            if (r < I_RO) { transpose_item(F.w_gdn_out, DM, 512, WSP(bf16, WS_WGO), scr, r / 32, r % 32, F.lane, CmIdent{0}); continue; } r -= I_RO;
            transpose_item(F.w_o, DM, DM, WSP(bf16, WS_WO), scr, r / 32, r % 32, F.lane, CmIdent{0}); }
    }
}

__device__ __forceinline__ void phase_moe_weights(Frame& F) {
    const int gw = F.bid * NWAVES + F.wave, NGW = F.G * NWAVES;
    LAS float* scr = (LAS float*)(F.lds + F.wave * 16384);
    constexpr int I_GU = 16 * 16  , I_D = 4 * 32;
    for (int it = gw; it < 65 * (I_GU + I_D); it += NGW) {
        const int e = it / (I_GU + I_D); int r = it % (I_GU + I_D);
        if (r < I_GU) {
            const int kb = r / 16, nb = r % 16;
            const int k0 = 64 * kb, n0 = 32 * nb; int hid, isup; gu_decode(n0 + (F.lane & 31), hid, isup);
            const float* Wg = e < 64 ? F.w_gate + (size_t)e * DM * DEXP : F.w_sh_gate; const float* Wu = e < 64 ? F.w_up + (size_t)e * DM * DEXP : F.w_sh_up;
            const float* W = isup ? Wu : Wg;
            float tv[32];
#pragma unroll
            for (int i = 0; i < 32; ++i) tv[i] = W[(size_t)(k0 + 2 * i + (F.lane >> 5)) * DEXP + hid];
#pragma unroll
            for (int i = 0; i < 32; ++i) scr[(2 * i + (F.lane >> 5)) * 33 + (F.lane & 31)] = tv[i];
            asm volatile("s_waitcnt lgkmcnt(0)" ::: "memory");
            const int c = F.lane & 7; bf16* WT = WSP(bf16, WS_WGU) + (size_t)e * 512 * DM;
#pragma unroll
            for (int j = 0; j < 4; ++j) { const int n = (F.lane >> 3) + 8 * j; const LAS float* s = scr + (8 * c) * 33 + n;
                u32x4 o; o.x = pk2(s[0 * 33], s[1 * 33]); o.y = pk2(s[2 * 33], s[3 * 33]); o.z = pk2(s[4 * 33], s[5 * 33]); o.w = pk2(s[6 * 33], s[7 * 33]);
                *(u32x4*)(WT + (size_t)(n0 + n) * DM + k0 + 8 * c) = o; }
            asm volatile("s_waitcnt lgkmcnt(0)" ::: "memory");
        } else { r -= I_GU;
            const float* W = e < 64 ? F.w_down + (size_t)e * DEXP * DM : F.w_sh_down;
            transpose_item(W, DM, DEXP, WSP(bf16, WS_WD) + (size_t)e * DM * DEXP, scr, r / 32, r % 32, F.lane, CmIdent{0}); }
    }
}

template <bool LAT> __device__ __forceinline__ int norm1_row_of(int i) { return LAT ? (i >> 12) * RPB + CTXL + (i & 4095) : i; }
template <bool LAT>
__device__ __forceinline__ void norm1_rows(Frame& F, LAS float* wl, int w0, int nw, int r_lo, int r_hi) {
    const float* mod = WSP(float, WS_MOD);
    int ri = r_lo + w0; if (ri >= r_hi) return;
    f32x4 vn[4];
    { const int row = norm1_row_of<LAT>(ri); const int b = row / RPB, pos = row % RPB; const float* src = pos < CTXL ? F.ctx + ((size_t)b * CTXL + pos) * DM : F.x + ((size_t)b * SEQ + (pos - CTXL)) * DM;
#pragma unroll
      for (int j = 0; j < 4; ++j) vn[j] = *(const f32x4*)(src + 4 * (F.lane + 64 * j)); }
    int pkey = -1; f32x4 pg[4], ps1[4], ps0[4];
    for (; ri < r_hi; ri += nw) {
        const int row = norm1_row_of<LAT>(ri); const int b = row / RPB, pos = row % RPB; const bool isctx = pos < CTXL;
        { const int key = isctx ? 4 : b;
          if (key != pkey) { pkey = key; const float* sh = mod + key * 6144; const float* sc = sh + DM;
#pragma unroll
              for (int j = 0; j < 4; ++j) { const int c0 = 4 * (F.lane + 64 * j); pg[j] = *(const f32x4*)(F.n_mix_pre + c0); ps1[j] = *(const f32x4*)(sc + c0) + 1.0f; ps0[j] = *(const f32x4*)(sh + c0); } } }
        f32x4 v[4]; float ss = 0.f;
#pragma unroll
        for (int j = 0; j < 4; ++j) { v[j] = vn[j]; ss += v[j].x * v[j].x + v[j].y * v[j].y + v[j].z * v[j].z + v[j].w * v[j].w; }
        { const int nri = ri + nw; if (nri < r_hi) { const int nr = norm1_row_of<LAT>(nri); const int nb = nr / RPB, np = nr % RPB; const float* src = np < CTXL ? F.ctx + ((size_t)nb * CTXL + np) * DM : F.x + ((size_t)nb * SEQ + (np - CTXL)) * DM;
#pragma unroll
            for (int j = 0; j < 4; ++j) vn[j] = *(const f32x4*)(src + 4 * (F.lane + 64 * j)); } }
        const float rstd = 1.0f / sqrtf(wave_sum(ss) * (1.f / DM) + EPS);
        float gd[16];
#pragma unroll
        for (int jj = 0; jj < 16; ++jj) gd[jj] = 0.f;
#pragma unroll
        for (int j = 0; j < 4; ++j) { const int c0 = 4 * (F.lane + 64 * j);
            const f32x4 g = pg[j], s1 = ps1[j], s0 = ps0[j];
            f32x4 h; h.x = v[j].x * rstd * g.x * s1.x + s0.x; h.y = v[j].y * rstd * g.y * s1.y + s0.y; h.z = v[j].z * rstd * g.z * s1.z + s0.z; h.w = v[j].w * rstd * g.w * s1.w + s0.w;
            u32x2 o; o.x = pk2(h.x, h.y); o.y = pk2(h.z, h.w);
            *(u32x2*)(WSP(bf16, WS_HX) + (size_t)row * DM + c0) = o;
#pragma unroll
            for (int jh = 0; jh < 2; ++jh) {
                asm volatile("" ::: "memory");
#pragma unroll
                for (int jj = 8 * jh; jj < 8 * jh + 8; ++jj) { const f32x4 w4 = *(const LAS f32x4*)(wl + jj * DM + c0); gd[jj] += (h.x * w4.x + h.y * w4.y) + (h.z * w4.z + h.w * w4.w); } } }
        float g8[8], g4[4], g2[2], mine;
        { const bool b0 = F.lane & 1, b1 = F.lane & 2, b2 = F.lane & 4, b3 = F.lane & 8;
#pragma unroll
          for (int i = 0; i < 8; ++i) { const float snd = b0 ? gd[2 * i] : gd[2 * i + 1], kp = b0 ? gd[2 * i + 1] : gd[2 * i]; g8[i] = kp + __shfl_xor(snd, 1); }
#pragma unroll
          for (int i = 0; i < 4; ++i) { const float snd = b1 ? g8[2 * i] : g8[2 * i + 1], kp = b1 ? g8[2 * i + 1] : g8[2 * i]; g4[i] = kp + __shfl_xor(snd, 2); }
#pragma unroll
          for (int i = 0; i < 2; ++i) { const float snd = b2 ? g4[2 * i] : g4[2 * i + 1], kp = b2 ? g4[2 * i + 1] : g4[2 * i]; g2[i] = kp + __shfl_xor(snd, 4); }
          { const float snd = b3 ? g2[0] : g2[1], kp = b3 ? g2[1] : g2[0]; mine = kp + __shfl_xor(snd, 8); }
          mine += __shfl_xor(mine, 16); mine += __shfl_xor(mine, 32); }
        if (F.lane < 16) { const int ab = F.lane >> 3, dir = (F.lane >> 2) & 1, h = F.lane & 3; const size_t o = ((size_t)(dir * NB + b) * NH + h) * RPB + pos;
            if (ab == 0) { const float z = mine + F.gdn_dt_bias[dir * 4 + h]; const float sp = z > 20.f ? z : log1pf(expf(z)); WSP(float, WS_LOGA)[o] = -expf(F.gdn_a_log[dir * 4 + h]) * sp; }
            else WSP(float, WS_BETA)[o] = 1.f / (1.f + expf(-mine)); }
    }
}
__device__ __forceinline__ void phase_norm1(Frame& F) {
    const int gw = F.bid * NWAVES + F.wave, NGW = F.G * NWAVES;
    LAS float* wl = (LAS float*)F.lds;
    for (int k = F.tid; k < DM; k += NTHR) { const float* wr = F.w_in + (size_t)k * N_IN + 2048;
#pragma unroll
        for (int jj = 0; jj < 4; ++jj) { const f32x4 w4 = *(const f32x4*)(wr + 4 * jj); wl[(4 * jj) * DM + k] = w4.x; wl[(4 * jj + 1) * DM + k] = w4.y; wl[(4 * jj + 2) * DM + k] = w4.z; wl[(4 * jj + 3) * DM + k] = w4.w; } }
    __syncthreads();
    if (F.G < 64) { norm1_rows<false>(F, wl, gw, NGW, 0, NROW); return; }
    if (F.bid < 32) {
        const int b = F.bid >> 3, sub = F.bid & 7; const int r0 = b * RPB + 32 * sub;
        norm1_rows<false>(F, wl, F.wave, NWAVES, r0, r0 + 32);
        asm volatile("s_waitcnt vmcnt(0)" ::: "memory");
        __syncthreads();
        if (F.tid == 0) {
            unsigned* flag = F.ctl + CW_FLAG + 64 * b;
            __builtin_amdgcn_fence(__ATOMIC_RELEASE, "agent"); asm volatile("s_waitcnt vmcnt(0)" ::: "memory");
            __hip_atomic_fetch_add(flag, 1u, __ATOMIC_RELAXED, __HIP_MEMORY_SCOPE_AGENT);
            unsigned sp = 0; while (__hip_atomic_load(flag, __ATOMIC_RELAXED, __HIP_MEMORY_SCOPE_AGENT) < 8u) { __builtin_amdgcn_s_sleep(1); if (++sp > (1u << 22)) break; }
            __builtin_amdgcn_fence(__ATOMIC_ACQUIRE, "agent"); asm volatile("s_waitcnt vmcnt(0)" ::: "memory");
        }
        __syncthreads();
    } else {
        norm1_rows<true>(F, wl, (F.bid - 32) * NWAVES + F.wave, (F.G - 32) * NWAVES, 0, NT);
    }
}

struct SchedIn {
    const char* A; const char* B; int G, c;
    __device__ __forceinline__ bool next(int i, pg8::Unit& u) const {
        const int L = i * G + c; if (L >= (G < 64 ? 1536 + 32 : 1536)) return false;
        int lt, pn;
        if (L < 1536) { int wgid = L; { const int q = 1536 / 8, xcd = wgid % 8, off = wgid / 8; wgid = xcd * q + off; }
            const int nig = 8 * 24, gid = wgid / nig, fm = gid * 8; lt = fm + ((wgid % nig) % 8); pn = (wgid % nig) / 8; u.pm = (lt >> 4) * 17 + 1 + (lt & 15); }
        else { const int q = L - 1536; u.pm = (q >> 3) * 17; pn = q & 7; }
        u.pn = pn; u.e = 0; u.base = 0; u.A = A + (size_t)u.pm * 256 * DM * 2; u.B = B + (size_t)pn * 256 * DM * 2; return true; }
    __device__ __forceinline__ int row_index(const pg8::Unit&, int r) const { return r; }
};
struct SchedCtx {
    const char* A; const char* B; int b, pn;
    __device__ __forceinline__ bool next(int i, pg8::Unit& u) const { if (i > 0) return false; u.pm = b * 17; u.pn = pn; u.e = 0; u.base = 0; u.A = A + (size_t)u.pm * 256 * DM * 2; u.B = B + (size_t)pn * 256 * DM * 2; return true; }
    __device__ __forceinline__ int row_index(const pg8::Unit&, int r) const { return r; }
};
struct EpiIn {
    bf16* P; bf16* GATES; const float2* rope;
    __device__ __forceinline__ void operator()(const f32x4 (&acc)[2][2][4][2], const pg8::Unit& u, int wr, int wc, int fr, int fq) const {
        const int g = u.pn >> 1;
        const int b = u.pm / 17, tl = u.pm % 17;
#pragma unroll
        for (int ai = 0; ai < 2; ++ai)
#pragma unroll
            for (int m = 0; m < 4; ++m) {
                const int rt = ai * 128 + wr * 64 + m * 16 + fr; const size_t prow = (size_t)u.pm * 256 + rt;
#pragma unroll
                for (int bj = 0; bj < 2; ++bj) {
                    f32x4 v0 = acc[ai][bj][m][0], v1 = acc[ai][bj][m][1];
                    const int ct = bj * 128 + wc * 32 + 8 * fq;
                    if (g == 0 || g == 4) {
                        const float s = (g == 0) ? 0.08838834764831845f : 1.0f; v0 = v0 * s; v1 = v1 * s;
                        const int j = 16 * wc + 4 * fq;
                        f32x4 o1 = v0, o2 = v1;
                        if (tl != 0) { const int t = (tl - 1) * 256 + rt; const float2* cs = rope + (size_t)t * 64 + j;
#pragma unroll
                            for (int i = 0; i < 4; ++i) { const float2 c2 = cs[i]; o1[i] = v0[i] * c2.x - v1[i] * c2.y; o2[i] = v0[i] * c2.y + v1[i] * c2.x; } }
                        bf16* dst = P + (size_t)g * PGRP + prow * 512 + (u.pn & 1) * 256 + bj * 128 + j;
                        u32x2 w1, w2; w1.x = pk2(o1[0], o1[1]); w1.y = pk2(o1[2], o1[3]); w2.x = pk2(o2[0], o2[1]); w2.y = pk2(o2[2], o2[3]);
                        *(u32x2*)dst = w1; *(u32x2*)(dst + 64) = w2;
                    } else if (g < 8) {
                        u32x4 w; w.x = pk2(v0[0], v0[1]); w.y = pk2(v0[2], v0[3]); w.z = pk2(v1[0], v1[1]); w.w = pk2(v1[2], v1[3]);
                        *(u32x4*)(P + (size_t)g * PGRP + prow * 512 + (u.pn & 1) * 256 + ct) = w;
                    } else {
                        const size_t lrow = (size_t)b * SEQ + (size_t)(tl - 1) * 256 + rt;
#pragma unroll
                        for (int i = 0; i < 4; ++i) { v0[i] = sigmoidf_(v0[i]); v1[i] = sigmoidf_(v1[i]); }
                        u32x4 w; w.x = pk2(v0[0], v0[1]); w.y = pk2(v0[2], v0[3]); w.z = pk2(v1[0], v1[1]); w.w = pk2(v1[2], v1[3]);
                        *(u32x4*)(GATES + lrow * 2048 + (u.pn - 16) * 256 + ct) = w;
                    }
                }
            }
    }
};

constexpr int IMGB = 34816, IMGS = 272;
typedef short s16x4 __attribute__((ext_vector_type(4)));
__device__ __forceinline__ unsigned offb(unsigned row, unsigned ch) { return 272u * row + 16u * ch; }
__device__ __forceinline__ unsigned offe(unsigned row, unsigned col) { return 272u * row + 2u * col; }
__device__ __forceinline__ bf16x8 frag_row(LAS unsigned char* img, int tile, int s, int lane) { return *(const LAS bf16x8*)(img + offb(16 * tile + (lane & 15), 4 * s + (lane >> 4))); }
__device__ __forceinline__ bf16x8 frag_tr(LAS unsigned char* img, int tile, int s, int lane) {
    const unsigned g = lane >> 4, qq = (lane & 15) >> 2, p = lane & 3;
    const s16x4 lo = __builtin_amdgcn_ds_read_tr16_b64_v4i16((LAS s16x4*)(img + offe(32 * s + 8 * g + qq, 16 * tile + 4 * p)));
    const s16x4 hi = __builtin_amdgcn_ds_read_tr16_b64_v4i16((LAS s16x4*)(img + offe(32 * s + 8 * g + 4 + qq, 16 * tile + 4 * p)));
    return (bf16x8){lo[0], lo[1], lo[2], lo[3], hi[0], hi[1], hi[2], hi[3]};
}
#define MFMA16(a, b, c) __builtin_amdgcn_mfma_f32_16x16x32_bf16(a, b, c, 0, 0, 0)
#define LBAR() do { asm volatile("s_waitcnt lgkmcnt(0)" ::: "memory"); __builtin_amdgcn_s_barrier(); asm volatile("" ::: "memory"); } while (0)
template <bool SWAP>
__device__ __forceinline__ void mm128(LAS unsigned char* ia, bool atr, LAS unsigned char* ib, bool btr, int wr, int wc, int lane, f32x4 (&acc)[2][4]) {
#pragma unroll
    for (int s = 0; s < 4; ++s) {
        bf16x8 fa[2], fb[4];
#pragma unroll
        for (int i = 0; i < 2; ++i) fa[i] = atr ? frag_tr(ia, 2 * wr + i, s, lane) : frag_row(ia, 2 * wr + i, s, lane);
#pragma unroll
        for (int j = 0; j < 4; ++j) fb[j] = btr ? frag_tr(ib, 4 * wc + j, s, lane) : frag_row(ib, 4 * wc + j, s, lane);
#pragma unroll
        for (int i = 0; i < 2; ++i)
#pragma unroll
            for (int j = 0; j < 4; ++j) acc[i][j] = SWAP ? MFMA16(fb[j], fa[i], acc[i][j]) : MFMA16(fa[i], fb[j], acc[i][j]);
    }
}
__device__ __forceinline__ void zero_acc(f32x4 (&acc)[2][4]) {
#pragma unroll
    for (int i = 0; i < 2; ++i)
#pragma unroll
        for (int j = 0; j < 4; ++j) acc[i][j] = (f32x4){0.f, 0.f, 0.f, 0.f};
}
__device__ __forceinline__ void st_img(LAS unsigned char* img, const f32x4 (&acc)[2][4], int wr, int wc, int lane) {
    const int r = lane & 15, q = lane >> 4;
#pragma unroll
    for (int i = 0; i < 2; ++i)
#pragma unroll
        for (int j = 0; j < 4; ++j) { u32x2 w; w.x = pk2(acc[i][j][0], acc[i][j][1]); w.y = pk2(acc[i][j][2], acc[i][j][3]);
            *(LAS u32x2*)(img + offe(32 * wr + 16 * i + r, 64 * wc + 16 * j + 4 * q)) = w; }
}
__device__ __forceinline__ void load_plain_img(LAS unsigned char* img, const bf16* src, int ld, int tid) {
#pragma unroll
    for (int i = 0; i < 4; ++i) { const int cidx = tid + 512 * i, row = cidx >> 4, ch = cidx & 15;
        *(LAS u32x4*)(img + offb(row, ch)) = *(const u32x4*)(src + (size_t)row * ld + 8 * ch); }
}
__device__ __forceinline__ void load_conv_img(LAS unsigned char* img, const bf16* src, const float* cw  , bool has_prev, bool has_next, int mode  , int wave, int lane) {
    asm volatile("" ::: "memory");
    const int ch = lane & 15; float w0[8], w1[8], w2[8];
#pragma unroll
    for (int i = 0; i < 8; ++i) { w0[i] = cw[8 * ch + i]; w1[i] = cw[1536 + 8 * ch + i]; w2[i] = cw[3072 + 8 * ch + i]; }
#pragma unroll
    for (int it = 0; it < 4; ++it) {
        const int row = 32 * it + 4 * wave + (lane >> 4); const u32x4 z4 = {0u, 0u, 0u, 0u};
        const u32x4 r0 = (row > 0 || has_prev) ? *(const u32x4*)(src + ((ptrdiff_t)row - 1) * 512 + 8 * ch) : z4;
        const u32x4 r1 = *(const u32x4*)(src + (size_t)row * 512 + 8 * ch);
        const u32x4 r2 = (row < 127 || has_next) ? *(const u32x4*)(src + (size_t)(row + 1) * 512 + 8 * ch) : z4;
        float a0[8], a1[8], a2[8], y[8]; unpack8(r0, a0); unpack8(r1, a1); unpack8(r2, a2); float ss = 0.f;
#pragma unroll
        for (int i = 0; i < 8; ++i) { y[i] = siluf_(w0[i] * a0[i] + w1[i] * a1[i] + w2[i] * a2[i]); ss += y[i] * y[i]; }
        if (mode != 1) { const float sc = (1.0f / sqrtf(sum16(ss) + EPS)) * (mode == 2 ? 0.08838834764831845f : 1.0f);
#pragma unroll
            for (int i = 0; i < 8; ++i) y[i] *= sc; }
        *(LAS u32x4*)(img + offb(row, ch)) = pack8(y);
    }
}
__device__ __forceinline__ void load_conv_img2(LAS unsigned char* imgA, const bf16* srcA, const float* cwA, int ma, LAS unsigned char* imgB, const bf16* srcB, const float* cwB, int mb, bool has_prev, bool has_next, int wave, int lane) {
    asm volatile("" ::: "memory");
    const int ch = lane & 15; float wa0[8], wa1[8], wa2[8], wb0[8], wb1[8], wb2[8];
#pragma unroll
    for (int i = 0; i < 8; ++i) { wa0[i] = cwA[8 * ch + i]; wa1[i] = cwA[1536 + 8 * ch + i]; wa2[i] = cwA[3072 + 8 * ch + i]; wb0[i] = cwB[8 * ch + i]; wb1[i] = cwB[1536 + 8 * ch + i]; wb2[i] = cwB[3072 + 8 * ch + i]; }
#pragma unroll
    for (int it = 0; it < 4; ++it) {
        const int row = 32 * it + 4 * wave + (lane >> 4); const u32x4 z4 = {0u, 0u, 0u, 0u}; const bool hp = (row > 0 || has_prev), hn = (row < 127 || has_next);
        const u32x4 a0 = hp ? *(const u32x4*)(srcA + ((ptrdiff_t)row - 1) * 512 + 8 * ch) : z4, a1 = *(const u32x4*)(srcA + (size_t)row * 512 + 8 * ch), a2 = hn ? *(const u32x4*)(srcA + (size_t)(row + 1) * 512 + 8 * ch) : z4;
        const u32x4 b0 = hp ? *(const u32x4*)(srcB + ((ptrdiff_t)row - 1) * 512 + 8 * ch) : z4, b1 = *(const u32x4*)(srcB + (size_t)row * 512 + 8 * ch), b2 = hn ? *(const u32x4*)(srcB + (size_t)(row + 1) * 512 + 8 * ch) : z4;
        { float x0[8], x1[8], x2[8], y[8]; unpack8(a0, x0); unpack8(a1, x1); unpack8(a2, x2); float ss = 0.f;
#pragma unroll
          for (int i = 0; i < 8; ++i) { y[i] = siluf_(wa0[i] * x0[i] + wa1[i] * x1[i] + wa2[i] * x2[i]); ss += y[i] * y[i]; }
          if (ma != 1) { const float sc = (1.0f / sqrtf(sum16(ss) + EPS)) * (ma == 2 ? 0.08838834764831845f : 1.0f);
#pragma unroll
              for (int i = 0; i < 8; ++i) y[i] *= sc; }
          *(LAS u32x4*)(imgA + offb(row, ch)) = pack8(y); }
        { float x0[8], x1[8], x2[8], y[8]; unpack8(b0, x0); unpack8(b1, x1); unpack8(b2, x2); float ss = 0.f;
#pragma unroll
          for (int i = 0; i < 8; ++i) { y[i] = siluf_(wb0[i] * x0[i] + wb1[i] * x1[i] + wb2[i] * x2[i]); ss += y[i] * y[i]; }
          if (mb != 1) { const float sc = (1.0f / sqrtf(sum16(ss) + EPS)) * (mb == 2 ? 0.08838834764831845f : 1.0f);
#pragma unroll
              for (int i = 0; i < 8; ++i) y[i] *= sc; }
          *(LAS u32x4*)(imgB + offb(row, ch)) = pack8(y); }
    }
}
__device__ __forceinline__ void scale_rows_img(LAS unsigned char* dst, LAS unsigned char* src, const LAS float* rs, int tid) {
#pragma unroll
    for (int i = 0; i < 4; ++i) { const int cidx = tid + 512 * i, row = cidx >> 4, ch = cidx & 15; float v[8]; unpack8(*(const LAS u32x4*)(src + offb(row, ch)), v); const float sc = rs[row];
#pragma unroll
        for (int e = 0; e < 8; ++e) v[e] *= sc;
        *(LAS u32x4*)(dst + offb(row, ch)) = pack8(v); }
}
__device__ __forceinline__ void tri_inverse(LAS unsigned char* img, int w, int lane) {
    const int r = lane & 15, q = lane >> 4;
    {
        const int b0 = 16 * w; float x[16];
#pragma unroll
        for (int i = 0; i < 16; ++i) { float v = (i == r) ? 1.f : 0.f;
#pragma unroll
            for (int j = 0; j < i; ++j) v -= bf2f(*(const LAS unsigned short*)(img + offe(b0 + i, b0 + j))) * x[j];
            x[i] = v; }
        if (q == 0) {
#pragma unroll
            for (int i = 0; i < 16; ++i) *(LAS unsigned short*)(img + offe(b0 + i, b0 + r)) = (unsigned short)f2bf(x[i]); }
    }
    LBAR();
    if (w < 4) {
        const int c0 = 32 * w, r1 = c0 + 16;
        const u32x2 av = *(const LAS u32x2*)(img + offe(r1 + r, c0 + 4 * q));
        const bf16x8 fa = __builtin_bit_cast(bf16x8, (u32x4){av.x, av.y, 0u, 0u});
        const s16x4 tb = __builtin_amdgcn_ds_read_tr16_b64_v4i16((LAS s16x4*)(img + offe(c0 + 4 * q + (r >> 2), c0 + 4 * (r & 3))));
        const bf16x8 fb = (bf16x8){tb[0], tb[1], tb[2], tb[3], 0, 0, 0, 0};
        const f32x4 y = MFMA16(fa, fb, ((f32x4){0.f, 0.f, 0.f, 0.f}));
        const bf16x8 fy = __builtin_bit_cast(bf16x8, (u32x4){pk2(y[0], y[1]), pk2(y[2], y[3]), 0u, 0u});
        const u32x2 tv = *(const LAS u32x2*)(img + offe(r1 + r, r1 + 4 * q));
        const bf16x8 ft = __builtin_bit_cast(bf16x8, (u32x4){tv.x, tv.y, 0u, 0u});
        const f32x4 d = MFMA16(fy, ft, ((f32x4){0.f, 0.f, 0.f, 0.f}));
        u32x2 o; o.x = pk2(-d[0], -d[1]); o.y = pk2(-d[2], -d[3]);
        *(LAS u32x2*)(img + offe(r1 + r, c0 + 4 * q)) = o;
    }
    LBAR();
    {
        const int p = w >> 2, ti = (w >> 1) & 1, tj = w & 1, base = 64 * p, rb = base + 32;
        f32x4 y[2];
        const unsigned g = lane >> 4, qq = (lane & 15) >> 2, pp = lane & 3;
        const s16x4 lo = __builtin_amdgcn_ds_read_tr16_b64_v4i16((LAS s16x4*)(img + offe(base + 8 * g + qq, base + 16 * tj + 4 * pp)));
        const s16x4 hi = __builtin_amdgcn_ds_read_tr16_b64_v4i16((LAS s16x4*)(img + offe(base + 8 * g + 4 + qq, base + 16 * tj + 4 * pp)));
        const bf16x8 fb = (bf16x8){lo[0], lo[1], lo[2], lo[3], hi[0], hi[1], hi[2], hi[3]};
#pragma unroll
        for (int kt = 0; kt < 2; ++kt) { const bf16x8 fa = *(const LAS bf16x8*)(img + offb(rb + 16 * kt + r, (base >> 3) + q)); y[kt] = MFMA16(fa, fb, ((f32x4){0.f, 0.f, 0.f, 0.f})); }
        const bf16x8 fy = __builtin_bit_cast(bf16x8, (u32x4){pk2(y[0][0], y[0][1]), pk2(y[0][2], y[0][3]), pk2(y[1][0], y[1][1]), pk2(y[1][2], y[1][3])});
        const u32x2 t0 = *(const LAS u32x2*)(img + offe(rb + 16 * ti + r, rb + 4 * q)), t1 = *(const LAS u32x2*)(img + offe(rb + 16 * ti + r, rb + 16 + 4 * q));
        const bf16x8 ft = __builtin_bit_cast(bf16x8, (u32x4){t0.x, t0.y, t1.x, t1.y});
        const f32x4 d = MFMA16(fy, ft, ((f32x4){0.f, 0.f, 0.f, 0.f}));
        LBAR();
        u32x2 o; o.x = pk2(-d[0], -d[1]); o.y = pk2(-d[2], -d[3]);
        *(LAS u32x2*)(img + offe(rb + 16 * ti + r, base + 16 * tj + 4 * q)) = o;
    }
    LBAR();
    {
        const int tj = w >> 1, ti0 = 2 * (w & 1);
        f32x4 y[4];
#pragma unroll
        for (int kt = 0; kt < 4; ++kt) y[kt] = (f32x4){0.f, 0.f, 0.f, 0.f};
#pragma unroll
        for (int s = 0; s < 2; ++s) { const bf16x8 fb = frag_tr(img, tj, s, lane);
#pragma unroll
            for (int kt = 0; kt < 4; ++kt) y[kt] = MFMA16(frag_row(img, 4 + kt, s, lane), fb, y[kt]); }
        f32x4 d[2];
#pragma unroll
        for (int i = 0; i < 2; ++i) { d[i] = (f32x4){0.f, 0.f, 0.f, 0.f};
#pragma unroll
            for (int ks = 0; ks < 2; ++ks) {
                const bf16x8 fy = __builtin_bit_cast(bf16x8, (u32x4){pk2(y[2 * ks][0], y[2 * ks][1]), pk2(y[2 * ks][2], y[2 * ks][3]), pk2(y[2 * ks + 1][0], y[2 * ks + 1][1]), pk2(y[2 * ks + 1][2], y[2 * ks + 1][3])});
                const int row = 64 + 16 * (ti0 + i) + r;
                const u32x2 t0 = *(const LAS u32x2*)(img + offe(row, 64 + 32 * ks + 4 * q)), t1 = *(const LAS u32x2*)(img + offe(row, 64 + 32 * ks + 16 + 4 * q));
                d[i] = MFMA16(fy, __builtin_bit_cast(bf16x8, (u32x4){t0.x, t0.y, t1.x, t1.y}), d[i]); } }
        LBAR();
#pragma unroll
        for (int i = 0; i < 2; ++i) { u32x2 o; o.x = pk2(-d[i][0], -d[i][1]); o.y = pk2(-d[i][2], -d[i][3]);
            *(LAS u32x2*)(img + offe(64 + 16 * (ti0 + i) + r, 16 * tj + 4 * q)) = o; }
    }
    LBAR();
}

__device__ __forceinline__ void phase_prep(Frame& F) {
    LAS unsigned char* I0 = F.lds; LAS unsigned char* I1 = F.lds + IMGB; LAS unsigned char* I2 = F.lds + 2 * IMGB; LAS unsigned char* I3 = F.lds + 3 * IMGB;
    LAS float* sm = (LAS float*)(F.lds + MISC_OFF + 1024);
    LAS float* s_t1 = sm; LAS float* s_t2 = sm + 128; LAS float* sdir = sm + 256;
#define LAUNDER() int tz_ = threadIdx.x; asm volatile("" : "+v"(tz_)); const int tid = tz_, lane = tz_ & 63, w = __builtin_amdgcn_readfirstlane(tz_ >> 6), wr = w >> 1, wc = w & 1, r = lane & 15, q = lane >> 4; (void)tid; (void)lane; (void)w; (void)wr; (void)wc; (void)r; (void)q
    const bf16* P = WSP(bf16, WS_P);
    for (int it = F.bid; it < 512 + 96; it += F.G) {
        int b, h, m, part = 3;
        if (it < 512) { b = it >> 7; h = (it >> 5) & 3; m = 2 + (it & 31); } else { const int c3 = it - 512; const int c = c3 / 3; part = c3 - 3 * c; b = c >> 3; h = (c >> 1) & 3; m = c & 1; }
        const bool isctx = m < 2; const int pos0 = 128 * m; const size_t row0 = (size_t)b * RPB + pos0; const size_t trow0 = (size_t)b * SEQ + (pos0 - CTXL);
        const bool hprev = isctx ? (m > 0) : (m > 2), hnext = isctx ? (m < 1) : (m < NCHUNK - 1);
        const size_t hoff = row0 * 512 + h * 128;
        f32x4 acc[2][4];
        if (part == 3 || part == 0) {
        const float lgf = F.ret_log_decay[h] * 1.4426950408889634f, lgb = F.ret_log_decay[4 + h] * 1.4426950408889634f;
        { LAUNDER();
        load_plain_img(I0, P + 0 * PGRP + hoff, 512, tid); load_plain_img(I1, P + 1 * PGRP + hoff, 512, tid);
        if (!isctx) load_plain_img(I2, P + 4 * PGRP + hoff, 512, tid);
        if (tid < 128) { s_t1[tid] = exp2f(lgf * (float)(127 - tid)); s_t2[tid] = exp2f(lgb * (float)tid); } }
        LBAR();
        if (!isctx) {
            { LAUNDER();
            zero_acc(acc); mm128<true>(I2, false, I0, false, wr, wc, lane, acc);
#pragma unroll
            for (int i = 0; i < 2; ++i)
#pragma unroll
                for (int j = 0; j < 4; ++j)
#pragma unroll
                    for (int e = 0; e < 4; ++e) { const int ii = 32 * wr + 16 * i + r, jj = 64 * wc + 16 * j + 4 * q + e; const int d = ii - jj;
                        const float wg = (d >= 0 ? exp2f(lgf * (float)d) : 0.f) + (d <= 0 ? exp2f(lgb * (float)(-d)) : 0.f); acc[i][j][e] *= wg; }
            st_img(I3, acc, wr, wc, lane); }
            LBAR();
            { LAUNDER();
            zero_acc(acc); mm128<true>(I3, false, I1, true, wr, wc, lane, acc);
            bf16* og = WSP(bf16, WS_ORET) + (trow0 + 32 * wr + r) * 512 + h * 128 + 64 * wc + 4 * q;
#pragma unroll
            for (int i = 0; i < 2; ++i)
#pragma unroll
                for (int j = 0; j < 4; ++j) { u32x2 o; o.x = pk2(acc[i][j][0], acc[i][j][1]); o.y = pk2(acc[i][j][2], acc[i][j][3]); *(u32x2*)(og + (size_t)(16 * i) * 512 + 16 * j) = o; } }
        }
#pragma unroll 1
        for (int dir = 0; dir < 2; ++dir) {
            LAS unsigned char* kw = dir ? I3 : I2;
            { LAUNDER(); scale_rows_img(kw, I0, dir ? s_t2 : s_t1, tid); }
            LBAR();
            LAUNDER();
            zero_acc(acc); mm128<false>(kw, true, I1, true, wr, wc, lane, acc);
            const int chain = (b * NH + h) * 2 + dir, n = dir ? (isctx ? 1 - m : 35 - m) : m;
            unsigned char* kv = F.ws + WS_GKV + ((size_t)chain * NCHUNK + n) * 32768;
#pragma unroll
            for (int i = 0; i < 2; ++i)
#pragma unroll
                for (int j = 0; j < 4; ++j) { const int mt = 2 * wr + i, nt = 4 * wc + j; u32x2 o; o.x = pk2(acc[i][j][0], acc[i][j][1]); o.y = pk2(acc[i][j][2], acc[i][j][3]);
                    *(u32x2*)(kv + ((size_t)((nt * 4 + (mt >> 1)) * 64 + (2 * (mt & 1) + (q >> 1)) * 16 + r)) * 16 + 8 * (q & 1)) = o; }
        }
        LBAR();
        }
        if (part != 0) {
        const bool hasq = !isctx;
        f32x4 gacc[2][4], qk[2][4]; u32x2 qv[2][4];
        if (hasq) { LAUNDER(); load_conv_img2(I0, P + 2 * PGRP + hoff, F.gdn_conv + 512 + h * 128, 0, I1, P + 6 * PGRP + hoff, F.gdn_conv + h * 128, 2, hprev, hnext, w, lane); }
        else { LAUNDER(); load_conv_img(I0, P + 2 * PGRP + hoff, F.gdn_conv + 512 + h * 128, hprev, hnext, 0, w, lane); }
        { LAUNDER(); if (tid < 256) { const int d2 = tid >> 7, i2 = tid & 127; const size_t o = ((size_t)(d2 * NB + b) * NH + h) * RPB + pos0 + i2; sdir[d2 * 640 + i2] = WSP(float, WS_LOGA)[o]; sdir[d2 * 640 + 128 + i2] = WSP(float, WS_BETA)[o]; } }
        LBAR();
        { LAUNDER();
          if (w < 2) {
              LAS float* sd = sdir + w * 640;
              const float a = sd[2 * lane], c = sd[2 * lane + 1]; const float pr = a + c; float inc = pr;
#pragma unroll
              for (int o = 1; o < 64; o <<= 1) { const float t = __shfl_up(inc, o); if (lane >= o) inc += t; }
              const float tot = __shfl(inc, 63); const float ex = inc - pr;
              float g0 = ex + a, g1 = ex + pr;
              if (w) { g0 = tot - ex; g1 = tot - (ex + a); }
              sd[256 + 2 * lane] = g0; sd[256 + 2 * lane + 1] = g1; sd[384 + 2 * lane] = __expf(g0); sd[384 + 2 * lane + 1] = __expf(g1);
              sd[512 + 2 * lane] = __expf(tot - g0); sd[512 + 2 * lane + 1] = __expf(tot - g1);
              asm volatile("s_waitcnt lgkmcnt(0)" ::: "memory");
              if (lane == 0) sd[0] = __expf(tot);
          }
          zero_acc(gacc); mm128<true>(I0, false, I0, false, wr, wc, lane, gacc);
          if (hasq) { zero_acc(qk); mm128<true>(I1, false, I0, false, wr, wc, lane, qk);
#pragma unroll
              for (int i = 0; i < 2; ++i)
#pragma unroll
                  for (int j = 0; j < 4; ++j) qv[i][j] = *(const LAS u32x2*)(I1 + offe(32 * wr + 16 * i + r, 64 * wc + 16 * j + 4 * q)); } }
        LBAR();
#pragma unroll 1
        for (int dir = (part == 2 ? 1 : 0); dir < (part == 3 ? 2 : part); ++dir) {
            const int chain = (b * NH + h) * 2 + dir, n = dir ? (isctx ? 1 - m : 35 - m) : m;
            { LAUNDER(); load_conv_img(I1, P + 3 * PGRP + hoff, F.gdn_conv + 1024 + h * 128, hprev, hnext, 1, w, lane); }
            LAS float* s_bet = sdir + dir * 640 + 128; LAS float* s_gc = sdir + dir * 640 + 256; LAS float* s_eg = sdir + dir * 640 + 384; LAS float* s_s2 = sdir + dir * 640 + 512;
            LBAR();
            { LAUNDER();
#pragma unroll
            for (int i = 0; i < 2; ++i)
#pragma unroll
                for (int j = 0; j < 4; ++j) { const int ii = 32 * wr + 16 * i + r; const float gi = s_gc[ii], bi = s_bet[ii];
#pragma unroll
                    for (int e = 0; e < 4; ++e) { const int jj = 64 * wc + 16 * j + 4 * q + e;
                        const float f = dir ? s_bet[jj] * __expf(s_gc[jj] - gi) : bi * __expf(gi - s_gc[jj]); acc[i][j][e] = (ii > jj) ? gacc[i][j][e] * f : 0.f; } }
            st_img(I2, acc, wr, wc, lane); }
            LBAR();
            { LAUNDER(); tri_inverse(I2, w, lane); }
            { LAUNDER();
#pragma unroll
            for (int i = 0; i < 4; ++i) { const int cidx = tid + 512 * i, row = cidx >> 4, ch = cidx & 15; float v[8], v2[8]; unpack8(*(const LAS u32x4*)(I2 + offb(row, ch)), v);
#pragma unroll
                for (int e = 0; e < 8; ++e) { const int k = dir ? row : 8 * ch + e; const float bb = s_bet[k]; v[e] *= bb; v2[e] = v[e] * s_eg[k]; }
                *(LAS u32x4*)(I2 + offb(row, ch)) = pack8(v); *(LAS u32x4*)(I3 + offb(row, ch)) = pack8(v2); } }
            LBAR();
            { LAUNDER();
            zero_acc(acc); mm128<true>(I3, dir != 0, I0, true, wr, wc, lane, acc);
            LBAR();
            st_img(I3, acc, wr, wc, lane); }
            { LAUNDER();
            zero_acc(acc); mm128<true>(I2, dir != 0, I1, true, wr, wc, lane, acc);
            LBAR();
            st_img(I2, acc, wr, wc, lane);
            scale_rows_img(I1, I0, s_s2, tid); }
            LBAR();
            {
                LAUNDER();
                zero_acc(acc); mm128<false>(I1, true, I2, true, wr, wc, lane, acc);
                unsigned char* gc = F.ws + WS_GC + ((size_t)chain * NCHUNK + n) * 32768;
#pragma unroll
                for (int i = 0; i < 2; ++i)
#pragma unroll
                    for (int j = 0; j < 4; ++j) { const int mt = 2 * wr + i, nt = 4 * wc + j; u32x2 o; o.x = pk2(acc[i][j][0], acc[i][j][1]); o.y = pk2(acc[i][j][2], acc[i][j][3]);
                        *(u32x2*)(gc + ((size_t)((nt * 8 + mt) * 64 + lane)) * 8) = o; }
                }
                { LAUNDER(); const float dtot = sdir[dir * 640];
                zero_acc(acc); mm128<true>(I1, true, I3, true, wr, wc, lane, acc);
                unsigned char* gm = F.ws + WS_GM + ((size_t)chain * NCHUNK + n) * 32768;
#pragma unroll
                for (int i = 0; i < 2; ++i)
#pragma unroll
                    for (int j = 0; j < 4; ++j) { const int mt = 2 * wr + i, ct = 4 * wc + j; const int rowi = 16 * mt + r; float v[4];
#pragma unroll
                        for (int e = 0; e < 4; ++e) v[e] = ((rowi == 16 * ct + 4 * q + e) ? dtot : 0.f) - acc[i][j][e];
                        u32x2 o; o.x = pk2(v[0], v[1]); o.y = pk2(v[2], v[3]);
                        *(u32x2*)(gm + ((size_t)((mt * 4 + (ct >> 1)) * 64 + q * 16 + r)) * 16 + 8 * (ct & 1)) = o; }
            }
            LBAR();
            if (hasq) {
                { LAUNDER();
#pragma unroll
                for (int i = 0; i < 2; ++i) { const int ii = 32 * wr + 16 * i + r; const float gi = s_gc[ii];
#pragma unroll
                    for (int j = 0; j < 4; ++j)
#pragma unroll
                        for (int e = 0; e < 4; ++e) { const int jj = 64 * wc + 16 * j + 4 * q + e; const bool on = dir ? (jj >= ii) : (jj <= ii);
                            acc[i][j][e] = on ? qk[i][j][e] * __expf(gi - s_gc[jj]) : 0.f; } }
                st_img(I1, acc, wr, wc, lane); }
                LBAR();
                { LAUNDER();
                zero_acc(acc); mm128<true>(I1, false, I2, true, wr, wc, lane, acc);
                { bf16* ogp = WSP(bf16, WS_OGDN) + (trow0 + 32 * wr + r) * 512 + h * 128 + 64 * wc + 4 * q;
#pragma unroll
                  for (int i = 0; i < 2; ++i)
#pragma unroll
                    for (int j = 0; j < 4; ++j) { bf16* pp = ogp + (size_t)(16 * i) * 512 + 16 * j; f32x4 v = acc[i][j];
                        if (dir) { const u32x2 pv = *(const u32x2*)pp; v[0] += bflo(pv.x); v[1] += bfhi(pv.x); v[2] += bflo(pv.y); v[3] += bfhi(pv.y); }
                        u32x2 o; o.x = pk2(v[0], v[1]); o.y = pk2(v[2], v[3]); *(u32x2*)pp = o; } } }
                { LAUNDER();
                zero_acc(acc); mm128<true>(I1, false, I3, true, wr, wc, lane, acc);
                unsigned char* qt = F.ws + WS_GQT + ((size_t)chain * 32 + (n - 2)) * 32768;
#pragma unroll
                for (int i = 0; i < 2; ++i) { const int ii = 32 * wr + 16 * i + r; const float egi = s_eg[ii];
#pragma unroll
                    for (int j = 0; j < 4; ++j) { const int mt = 2 * wr + i, ct = 4 * wc + j; const u32x2 qq2 = qv[i][j];
                        u32x2 o; o.x = pk2(egi * bflo(qq2.x) - acc[i][j][0], egi * bfhi(qq2.x) - acc[i][j][1]); o.y = pk2(egi * bflo(qq2.y) - acc[i][j][2], egi * bfhi(qq2.y) - acc[i][j][3]);
                        *(u32x2*)(qt + ((size_t)((mt * 4 + (ct >> 1)) * 64 + q * 16 + r)) * 16 + 8 * (ct & 1)) = o; } } }
                LBAR();
            }
        }
        }
    }
#undef LAUNDER
}

__device__ __forceinline__ void phase_scan(Frame& F) {
    const int lane = F.lane, w = F.wave, tid = F.tid;
    for (int it = F.bid; it < 256; it += F.G) {
        if (it < 128) {
            const int chain = (it & 7) * 4 + (it >> 5), dq = (it >> 3) & 3;
            const unsigned char* gm = F.ws + WS_GM + (size_t)chain * NCHUNK * 32768; unsigned char* gc = F.ws + WS_GC + (size_t)chain * NCHUNK * 32768;
            const unsigned char* gcs = gc + (size_t)(2 * dq) * 4096;
            if (w >= 4) {
                const int j = tid - 256; u32x4 sA[10], sB[10], sC[10], sD[10];
#define SCAN_LD(dst, n_) do { _Pragma("unroll") for (int i_ = 0; i_ < 8; ++i_) dst[i_] = *(const u32x4*)(gm + (size_t)(n_) * 32768 + (size_t)(j + 256 * i_) * 16); \
                              _Pragma("unroll") for (int i_ = 0; i_ < 2; ++i_) dst[8 + i_] = *(const u32x4*)(gcs + (size_t)(n_) * 32768 + (size_t)(j + 256 * i_) * 16); } while (0)
#define SCAN_ST(n_, src) do { LAS unsigned char* buf_ = F.lds + ((n_) % 3) * 40960; \
                              _Pragma("unroll") for (int i_ = 0; i_ < 8; ++i_) *(LAS u32x4*)(buf_ + (size_t)(j + 256 * i_) * 16) = src[i_]; \
                              _Pragma("unroll") for (int i_ = 0; i_ < 2; ++i_) *(LAS u32x4*)(buf_ + 32768 + (size_t)(j + 256 * i_) * 16) = src[8 + i_]; \
                              if ((n_) + 4 < NCHUNK) SCAN_LD(src, (n_) + 4); LBAR(); } while (0)
                SCAN_LD(sA, 0); SCAN_LD(sB, 1); SCAN_LD(sC, 2); SCAN_LD(sD, 3);
#pragma unroll 1
                for (int n = 0; n < 32; n += 4) { SCAN_ST(n, sA); SCAN_ST(n + 1, sB); SCAN_ST(n + 2, sC); SCAN_ST(n + 3, sD); }
                SCAN_ST(32, sA); SCAN_ST(33, sB);
#undef SCAN_LD
#undef SCAN_ST
            } else if (w < 2) {
                const int nt = 2 * dq + w;
                bf16x8 sf[4];
#pragma unroll
                for (int s = 0; s < 4; ++s) sf[s] = (bf16x8){0, 0, 0, 0, 0, 0, 0, 0};
#pragma unroll 1
                for (int n = 0; n < NCHUNK; ++n) {
                    LBAR();
                    const LAS unsigned char* buf = F.lds + (n % 3) * 40960; const LAS unsigned char* cb = buf + 32768 + w * 4096;
                    unsigned char* slot = gc + (size_t)n * 32768 + (size_t)nt * 4096; f32x4 acc[8];
#pragma unroll
                    for (int mt = 0; mt < 8; ++mt) { const u32x2 cv = *(const LAS u32x2*)(cb + (mt * 64 + lane) * 8); acc[mt] = (f32x4){bflo(cv.x), bfhi(cv.x), bflo(cv.y), bfhi(cv.y)}; }
#pragma unroll
                    for (int s = 0; s < 4; ++s)
#pragma unroll
                        for (int mt = 0; mt < 8; ++mt) acc[mt] = MFMA16(*(const LAS bf16x8*)(buf + ((mt * 4 + s) * 64 + lane) * 16), sf[s], acc[mt]);
#pragma unroll
                    for (int s = 0; s < 4; ++s) { const u32x4 pk = {pk2(acc[2 * s][0], acc[2 * s][1]), pk2(acc[2 * s][2], acc[2 * s][3]), pk2(acc[2 * s + 1][0], acc[2 * s + 1][1]), pk2(acc[2 * s + 1][2], acc[2 * s + 1][3])};
                        sf[s] = __builtin_bit_cast(bf16x8, pk); *(u32x4*)(slot + (size_t)(s * 64 + lane) * 16) = pk; }
                }
            } else {
#pragma unroll 1
                for (int n = 0; n < NCHUNK; ++n) LBAR();
            }
            LBAR();
#if defined(PROBE_PH) && PROBE_PH == 204
            if (F.bid == 0 && tid == 0) ((volatile LAS unsigned long long*)(F.lds + MISC_OFF + 896))[5] = __builtin_amdgcn_s_memrealtime();
#endif
        } else {
            const int gidx = (it - 128) * NTHR + tid; const int chain = gidx >> 11, piece = gidx & 2047; const int h = (chain >> 1) & 3, dir = chain & 1;
            const float dec = expf(F.ret_log_decay[dir * 4 + h] * 128.f);
            unsigned char* kv = F.ws + WS_GKV + (size_t)chain * NCHUNK * 32768 + (size_t)piece * 16;
            float st[8];
#pragma unroll
            for (int e = 0; e < 8; ++e) st[e] = 0.f;
#pragma unroll 1
            for (int n0 = 0; n0 < NCHUNK; n0 += 17) { u32x4 v8[17];
#pragma unroll
                for (int j = 0; j < 17; ++j) v8[j] = *(const u32x4*)(kv + (size_t)(n0 + j) * 32768);
#pragma unroll
                for (int j = 0; j < 17; ++j) { float v[8]; unpack8(v8[j], v);
#pragma unroll
                    for (int e = 0; e < 8; ++e) st[e] = dec * st[e] + v[e];
                    *(u32x4*)(kv + (size_t)(n0 + j) * 32768) = pack8(st); } }
        }
    }
}

__device__ __forceinline__ void phase_out(Frame& F) {
    const bf16* P = WSP(bf16, WS_P);
    for (int it = F.bid; it < 512; it += F.G) {
        int tz_ = threadIdx.x; asm volatile("" : "+v"(tz_)); const int tid = tz_, lane = tz_ & 63, w = __builtin_amdgcn_readfirstlane(tz_ >> 6), r = lane & 15, q = lane >> 4;
        const int b = it >> 7, h = (it >> 5) & 3, m = 2 + (it & 31);
        const size_t prow = (size_t)b * RPB + 128 * m + 16 * w + r; const size_t trow = (size_t)b * SEQ + 128 * (m - 2) + 16 * w + r;
        const int il = 16 * w + r;
        bf16x8 fqg[2][4], fqr[4];
#pragma unroll
        for (int dir = 0; dir < 2; ++dir) { const int chain = (b * NH + h) * 2 + dir, n = dir ? 35 - m : m; const unsigned char* qt = F.ws + WS_GQT + ((size_t)chain * 32 + (n - 2)) * 32768;
#pragma unroll
            for (int s = 0; s < 4; ++s) fqg[dir][s] = *(const bf16x8*)(qt + (size_t)((w * 4 + s) * 64 + lane) * 16); }
        { const bf16* qp = P + 4 * PGRP + prow * 512 + h * 128;
#pragma unroll
          for (int s = 0; s < 4; ++s) fqr[s] = *(const bf16x8*)(qp + 32 * s + 8 * q); }
        u32x2 rog[8], ror[8];
        { const bf16* a = WSP(bf16, WS_OGDN) + trow * 512 + h * 128 + 4 * q; const bf16* c = WSP(bf16, WS_ORET) + trow * 512 + h * 128 + 4 * q;
#pragma unroll
          for (int nt = 0; nt < 8; ++nt) { rog[nt] = *(const u32x2*)(a + 16 * nt); ror[nt] = *(const u32x2*)(c + 16 * nt); } }
        {
            u32x4 v[4][4];
#pragma unroll
            for (int k = 0; k < 4; ++k) { const int dir = k & 1; const int chain = (b * NH + h) * 2 + dir, n = dir ? 35 - m : m;
                const unsigned char* sp = F.ws + (k < 2 ? WS_GC : WS_GKV) + ((size_t)chain * NCHUNK + (n - 1)) * 32768;
#pragma unroll
                for (int i = 0; i < 4; ++i) v[k][i] = *(const u32x4*)(sp + (size_t)(tid + 512 * i) * 16); }
#pragma unroll
            for (int k = 0; k < 4; ++k)
#pragma unroll
                for (int i = 0; i < 4; ++i) *(LAS u32x4*)(F.lds + k * 32768 + (tid + 512 * i) * 16) = v[k][i];
        }
        f32x4 og[8], orr[8];
#pragma unroll
        for (int nt = 0; nt < 8; ++nt) { og[nt] = (f32x4){bflo(rog[nt].x), bfhi(rog[nt].x), bflo(rog[nt].y), bfhi(rog[nt].y)}; orr[nt] = (f32x4){bflo(ror[nt].x), bfhi(ror[nt].x), bflo(ror[nt].y), bfhi(ror[nt].y)}; }
        LBAR();
#pragma unroll
        for (int dir = 0; dir < 2; ++dir) {
            {
                const LAS unsigned char* sp = F.lds + dir * 32768;
#pragma unroll
                for (int s = 0; s < 4; ++s)
#pragma unroll
                    for (int nt = 0; nt < 8; ++nt) og[nt] = MFMA16(*(const LAS bf16x8*)(sp + ((nt * 4 + s) * 64 + lane) * 16), fqg[dir][s], og[nt]);
            }
            {
                const LAS unsigned char* sp = F.lds + (2 + dir) * 32768;
                f32x4 t[8];
#pragma unroll
                for (int nt = 0; nt < 8; ++nt) t[nt] = (f32x4){0.f, 0.f, 0.f, 0.f};
#pragma unroll
                for (int s = 0; s < 4; ++s)
#pragma unroll
                    for (int nt = 0; nt < 8; ++nt) t[nt] = MFMA16(*(const LAS bf16x8*)(sp + ((nt * 4 + s) * 64 + lane) * 16), fqr[s], t[nt]);
                const float lg = F.ret_log_decay[dir * 4 + h]; const float dcy = expf(lg * (float)(dir ? 128 - il : il + 1));
#pragma unroll
                for (int nt = 0; nt < 8; ++nt) orr[nt] = orr[nt] + t[nt] * dcy;
            }
        }
        {
            float s1 = 0.f;
#pragma unroll
            for (int nt = 0; nt < 8; ++nt) s1 += (orr[nt][0] + orr[nt][1]) + (orr[nt][2] + orr[nt][3]);
            s1 += __shfl_xor(s1, 16); s1 += __shfl_xor(s1, 32); const float mean = s1 * (1.f / 128.f);
            float s2 = 0.f, s3 = 0.f;
#pragma unroll
            for (int nt = 0; nt < 8; ++nt)
#pragma unroll
                for (int e = 0; e < 4; ++e) { const float d = orr[nt][e] - mean; s2 += d * d; s3 += og[nt][e] * og[nt][e]; }
            s2 += __shfl_xor(s2, 16); s2 += __shfl_xor(s2, 32); s3 += __shfl_xor(s3, 16); s3 += __shfl_xor(s3, 32);
            const float rs_r = 1.0f / sqrtf(s2 * (1.f / 128.f) + EPS), rs_g = 1.0f / sqrtf(s3 * (1.f / 128.f) + EPS);
            const bf16* rg = P + 5 * PGRP + prow * 512 + h * 128 + 4 * q; const bf16* gz = P + 7 * PGRP + prow * 512 + h * 128 + 4 * q;
            bf16* ry = WSP(bf16, WS_RETY) + trow * 512 + h * 128 + 4 * q; bf16* gy = WSP(bf16, WS_GDNY) + trow * 512 + h * 128 + 4 * q;
#pragma unroll
            for (int nt = 0; nt < 8; ++nt) { const u32x2 a = *(const u32x2*)(rg + 16 * nt), c = *(const u32x2*)(gz + 16 * nt);
                const float ga[4] = {bflo(a.x), bfhi(a.x), bflo(a.y), bfhi(a.y)}, gc4[4] = {bflo(c.x), bfhi(c.x), bflo(c.y), bfhi(c.y)};
                const f32x4 wr4 = *(const f32x4*)(F.ret_gn_w + h * 128 + 16 * nt + 4 * q), wg4 = *(const f32x4*)(F.gdn_norm_w + h * 128 + 16 * nt + 4 * q);
                float yr[4], yg[4];
#pragma unroll
                for (int e = 0; e < 4; ++e) { yr[e] = (orr[nt][e] - mean) * rs_r * wr4[e] * siluf_(ga[e]); yg[e] = og[nt][e] * rs_g * wg4[e] * siluf_(gc4[e]); }
                u32x2 o1, o2; o1.x = pk2(yr[0], yr[1]); o1.y = pk2(yr[2], yr[3]); o2.x = pk2(yg[0], yg[1]); o2.y = pk2(yg[2], yg[3]);
                *(u32x2*)(ry + 16 * nt) = o1; *(u32x2*)(gy + 16 * nt) = o2; }
        }
        LBAR();
    }
}

struct SchedMerge {
    const char *A0, *A1, *B0, *B1; int G, c;
    __device__ __forceinline__ bool next(int i, pg8::Unit& u) const {
        const int L = (i >> 1) * G + c; if (L >= 256) return false; const int term = i & 1;
        const int xcd = L % 8, off = L / 8; const int w = xcd * 32 + off;
        u.pm = w >> 2; u.pn = w & 3; u.e = term; u.base = 0;
        u.A = (term ? A1 : A0) + (size_t)u.pm * 256 * 512 * 2; u.B = (term ? B1 : B0) + (size_t)u.pn * 256 * 512 * 2; return true; }
    __device__ __forceinline__ int row_index(const pg8::Unit&, int r) const { return r; }
};
struct EpiMerge {
    const bf16* GATES; bf16* TMP; bf16* MERGED;
    __device__ __forceinline__ void operator()(const f32x4 (&acc)[2][2][4][2], const pg8::Unit& u, int wr, int wc, int fr, int fq) const {
#pragma unroll
        for (int ai = 0; ai < 2; ++ai) {
            u32x4 gv[4][2], pv[4][2];
#pragma unroll
            for (int m = 0; m < 4; ++m) { const size_t row = (size_t)u.pm * 256 + ai * 128 + wr * 64 + m * 16 + fr;
#pragma unroll
                for (int bj = 0; bj < 2; ++bj) { const int col = u.pn * 256 + bj * 128 + wc * 32 + 8 * fq;
                    gv[m][bj] = *(const u32x4*)(GATES + row * 2048 + u.e * 1024 + col);
                    if (u.e != 0) pv[m][bj] = *(const u32x4*)(TMP + row * DM + col); } }
#pragma unroll
            for (int m = 0; m < 4; ++m) { const size_t row = (size_t)u.pm * 256 + ai * 128 + wr * 64 + m * 16 + fr;
#pragma unroll
                for (int bj = 0; bj < 2; ++bj) { const int col = u.pn * 256 + bj * 128 + wc * 32 + 8 * fq;
                    float g[8]; unpack8(gv[m][bj], g);
                    float v[8] = {acc[ai][bj][m][0][0], acc[ai][bj][m][0][1], acc[ai][bj][m][0][2], acc[ai][bj][m][0][3], acc[ai][bj][m][1][0], acc[ai][bj][m][1][1], acc[ai][bj][m][1][2], acc[ai][bj][m][1][3]};
                    if (u.e == 0) {
#pragma unroll
                        for (int i = 0; i < 8; ++i) v[i] *= g[i];
                        *(u32x4*)(TMP + row * DM + col) = pack8(v);
                    } else { float p[8]; unpack8(pv[m][bj], p);
#pragma unroll
                        for (int i = 0; i < 8; ++i) v[i] = p[i] + v[i] * g[i];
                        *(u32x4*)(MERGED + row * DM + col) = pack8(v); } } }
        }
    }
};
struct SchedDense {
    const char *A, *B; int nM, nN, K, G, c;
    __device__ __forceinline__ bool next(int i, pg8::Unit& u) const {
        const int L = i * G + c; const int nwg = nM * nN; if (L >= nwg) return false;
        int w = L; if (nwg % 8 == 0) { const int xcd = L % 8, off = L / 8; w = xcd * (nwg / 8) + off; }
        u.pm = w / nN; u.pn = w % nN; u.e = 0; u.base = 0; u.A = A + (size_t)u.pm * 256 * K * 2; u.B = B + (size_t)u.pn * 256 * K * 2; return true; }
    __device__ __forceinline__ int row_index(const pg8::Unit&, int r) const { return r; }
};
struct EpiBf16Store { bf16* O; int ldc;
    __device__ __forceinline__ void operator()(const f32x4 (&acc)[2][2][4][2], const pg8::Unit& u, int wr, int wc, int fr, int fq) const {
#pragma unroll
        for (int ai = 0; ai < 2; ++ai)
#pragma unroll
            for (int m = 0; m < 4; ++m) { const size_t row = (size_t)u.pm * 256 + ai * 128 + wr * 64 + m * 16 + fr;
#pragma unroll
                for (int bj = 0; bj < 2; ++bj) { const int col = u.pn * 256 + bj * 128 + wc * 32 + 8 * fq; const f32x4 v0 = acc[ai][bj][m][0], v1 = acc[ai][bj][m][1];
                    u32x4 w; w.x = pk2(v0[0], v0[1]); w.y = pk2(v0[2], v0[3]); w.z = pk2(v1[0], v1[1]); w.w = pk2(v1[2], v1[3]);
                    *(u32x4*)(O + row * ldc + col) = w; } }
    }
};

__device__ __forceinline__ void load_row_bf16(const bf16* p, int lane, float (&v)[16]) { float a[8], b[8]; unpack8(*(const u32x4*)(p + 8 * lane), a); unpack8(*(const u32x4*)(p + 512 + 8 * lane), b);
#pragma unroll
    for (int i = 0; i < 8; ++i) { v[i] = a[i]; v[8 + i] = b[i]; } }
__device__ __forceinline__ void load_row_f32(const float* p, int lane, float (&v)[16]) {
#pragma unroll
    for (int q = 0; q < 4; ++q) { const f32x4 a = *(const f32x4*)(p + (q >> 1) * 512 + 8 * lane + 4 * (q & 1)); v[4 * q] = a.x; v[4 * q + 1] = a.y; v[4 * q + 2] = a.z; v[4 * q + 3] = a.w; } }
__device__ __forceinline__ void store_row_f32(float* p, int lane, const float (&v)[16]) {
#pragma unroll
    for (int q = 0; q < 4; ++q) *(f32x4*)(p + (q >> 1) * 512 + 8 * lane + 4 * (q & 1)) = (f32x4){v[4 * q], v[4 * q + 1], v[4 * q + 2], v[4 * q + 3]}; }
__device__ __forceinline__ void compute_x1(Frame& F, int t, float (&x1)[16]) {
    const int b = t / SEQ; const float* mod = WSP(float, WS_MOD) + b * 6144;
    const bf16* mop = WSP(bf16, WS_MO) + (size_t)t * DM;
    const u32x4 m0 = *(const u32x4*)(mop + 8 * F.lane), m1 = *(const u32x4*)(mop + 512 + 8 * F.lane);
    float ss = 0.f;
    { float a[8], c[8]; unpack8(m0, a); unpack8(m1, c);
#pragma unroll
      for (int i = 0; i < 8; ++i) ss += a[i] * a[i] + c[i] * c[i]; }
    const float rstd = 1.0f / sqrtf(wave_sum(ss) * (1.f / DM) + EPS);
#pragma unroll
    for (int hf = 0; hf < 2; ++hf) {
        const int c0 = hf * 512 + 8 * F.lane; float mo[8]; unpack8(hf ? m1 : m0, mo);
        const float* xp = F.x + (size_t)t * DM + c0; const float* wp = F.n_mix_post + c0; const float* gp = mod + 2 * DM + c0;
#pragma unroll
        for (int q = 0; q < 2; ++q) { const f32x4 xv = *(const f32x4*)(xp + 4 * q), wv = *(const f32x4*)(wp + 4 * q), g1 = *(const f32x4*)(gp + 4 * q);
#pragma unroll
            for (int e = 0; e < 4; ++e) x1[hf * 8 + 4 * q + e] = xv[e] + g1[e] * (mo[4 * q + e] * rstd * wv[e]); }
    }
}
__device__ __forceinline__ void route_token(Frame& F, int t, float logit, LAS unsigned* lcnt, LAS u32x2* stage, unsigned* cnt, int2* list) {
    logit = (logit == logit) ? logit : 0.f;
    const float score = 1.f / (1.f + expf(-logit)); const float biased = score + F.router_bias[F.lane];
#define DPP_MAX(v, ctrl) fmaxf((v), __builtin_bit_cast(float, __builtin_amdgcn_update_dpp(0, __builtin_bit_cast(int, (v)), (ctrl), 0xf, 0xf, true)))
    float m1 = biased; m1 = DPP_MAX(m1, 0xB1); m1 = DPP_MAX(m1, 0x4E); m1 = DPP_MAX(m1, 0x141);
    const unsigned long long bm = __ballot(biased == m1); const unsigned gb = (unsigned)(bm >> (F.lane & ~7)) & 0xffu; const int first = __ffs((int)gb) - 1;
    float m2 = ((F.lane & 7) == first) ? -__builtin_inff() : biased; m2 = DPP_MAX(m2, 0xB1); m2 = DPP_MAX(m2, 0x4E); m2 = DPP_MAX(m2, 0x141);
#undef DPP_MAX
    const float gs = m1 + m2;
    int grk = 0; const int myg = F.lane >> 3;
#pragma unroll
    for (int o = 0; o < 8; ++o) { const float ov = __builtin_bit_cast(float, __builtin_amdgcn_readlane(__builtin_bit_cast(int, gs), o * 8)); grk += ((ov > gs) | ((ov == gs) & (o < myg))) ? 1 : 0; }
    const bool keep = grk < 4;
    const float cand = keep ? biased : -__builtin_inff();
    int erk = 0;
#pragma unroll
    for (int o = 0; o < 64; ++o) { const float ov = __builtin_bit_cast(float, __builtin_amdgcn_readlane(__builtin_bit_cast(int, cand), o)); erk += ((ov > cand) | ((ov == cand) & (o < F.lane))) ? 1 : 0; }
    const bool sel = keep && erk < TOPK;
    const float ssum = wave_sum(sel ? score : 0.f);
    if (sel) { const float w = score / ssum * 2.5f; const unsigned pos = __hip_atomic_fetch_add(lcnt + F.lane, 1u, __ATOMIC_RELAXED, __HIP_MEMORY_SCOPE_WORKGROUP);
        if (pos < 48u) stage[F.lane * 48 + pos] = (u32x2){(unsigned)(t * 8 + erk), __float_as_uint(w)};
        else { const unsigned gp = atomicAdd(cnt + 64 * F.lane, 1u); list[(size_t)F.lane * NT + gp] = make_int2(t * 8 + erk, __float_as_int(w)); } }
}
__device__ __forceinline__ void phase_route(Frame& F) {
    constexpr int HST = 2064;
    LAS unsigned char* hhi = F.lds;
    LAS unsigned char* hlo = F.lds + 16 * HST;
    LAS float* part = (LAS float*)(F.lds + 2 * 16 * HST);
    LAS u32x2* stage = (LAS u32x2*)(F.lds + 2 * 16 * HST + 32768);
    LAS unsigned* lcnt = (LAS unsigned*)(F.lds + MISC_OFF + 1024);
    unsigned* cnt = F.ctl + CW_CNT; int2* list = WSP(int2, WS_LIST);
    const int r = F.lane & 15, q = F.lane >> 4, kbase = F.wave * 128;
    bf16x8 wh[4][4]; u32x2 wl8[4][4];
#pragma unroll
    for (int ft = 0; ft < 4; ++ft) {
        asm volatile("" ::: "memory");
#pragma unroll
        for (int s = 0; s < 4; ++s) { float wv[8];
#pragma unroll
            for (int j = 0; j < 8; ++j) wv[j] = F.w_router[(size_t)(kbase + 32 * s + 8 * q + j) * NEXP + 16 * ft + r];
            unsigned hi[8];
#pragma unroll
            for (int j = 0; j < 8; ++j) hi[j] = f2bf(wv[j]);
            wh[ft][s] = __builtin_bit_cast(bf16x8, (u32x4){hi[0] | (hi[1] << 16), hi[2] | (hi[3] << 16), hi[4] | (hi[5] << 16), hi[6] | (hi[7] << 16)});
            float lf[8];
#pragma unroll
            for (int j = 0; j < 8; ++j) lf[j] = (wv[j] - bf2f(hi[j])) * 4096.0f;
            unsigned p0 = __builtin_amdgcn_cvt_pk_bf8_f32(lf[0], lf[1], 0u, false); p0 = __builtin_amdgcn_cvt_pk_bf8_f32(lf[2], lf[3], p0, true);
            unsigned p1 = __builtin_amdgcn_cvt_pk_bf8_f32(lf[4], lf[5], 0u, false); p1 = __builtin_amdgcn_cvt_pk_bf8_f32(lf[6], lf[7], p1, true);
            wl8[ft][s] = (u32x2){p0, p1}; } }
    for (int g64 = F.bid; g64 < NT / 64; g64 += F.G) {
        if (F.tid < 64) lcnt[F.tid] = 0u;
        __syncthreads();
#pragma unroll 1
        for (int grp = 0; grp < 4; ++grp) {
#pragma unroll 1
            for (int tw = 0; tw < 2; ++tw) {
                const int slot = 2 * F.wave + tw; const int t = g64 * 64 + grp * 16 + slot; const int b = t / SEQ; const float* mod = WSP(float, WS_MOD) + b * 6144;
                float x1[16]; compute_x1(F, t, x1);
                float ss = 0.f;
#pragma unroll
                for (int i = 0; i < 16; ++i) ss += x1[i] * x1[i];
                const float rstd = 1.0f / sqrtf(wave_sum(ss) * (1.f / DM) + EPS);
                bf16* d = WSP(bf16, WS_H2) + (size_t)t * DM;
#pragma unroll
                for (int hf = 0; hf < 2; ++hf) {
                    asm volatile("" ::: "memory");
                    const int c0 = hf * 512 + 8 * F.lane; float h2[8];
#pragma unroll
                    for (int qq = 0; qq < 2; ++qq) { const f32x4 wv = *(const f32x4*)(F.n_ffn_pre + c0 + 4 * qq), sh = *(const f32x4*)(mod + 3 * DM + c0 + 4 * qq), sc = *(const f32x4*)(mod + 4 * DM + c0 + 4 * qq);
#pragma unroll
                        for (int e = 0; e < 4; ++e) h2[4 * qq + e] = x1[hf * 8 + 4 * qq + e] * rstd * wv[e] * (1.f + sc[e]) + sh[e]; }
                    const u32x4 hp = pack8(h2); *(u32x4*)(d + c0) = hp;
                    float lo8[8]; { float hb[8]; unpack8(hp, hb);
#pragma unroll
                        for (int e = 0; e < 8; ++e) lo8[e] = h2[e] - hb[e]; }
                    *(LAS u32x4*)(hhi + slot * HST + c0 * 2) = hp; *(LAS u32x4*)(hlo + slot * HST + c0 * 2) = pack8(lo8);
                }
            }
            LBAR();
            {
                typedef float f32x2v __attribute__((ext_vector_type(2)));
                f32x4 acc[4], acc2[4];
#pragma unroll
                for (int ft = 0; ft < 4; ++ft) { acc[ft] = (f32x4){0.f, 0.f, 0.f, 0.f}; acc2[ft] = (f32x4){0.f, 0.f, 0.f, 0.f}; }
#pragma unroll
                for (int s = 0; s < 4; ++s) { const int off = r * HST + (kbase + 32 * s + 8 * q) * 2;
                    const bf16x8 bh = *(const LAS bf16x8*)(hhi + off), bl = *(const LAS bf16x8*)(hlo + off);
#pragma unroll
                    for (int ft = 0; ft < 4; ++ft) {
                        const f32x2v l0 = __builtin_amdgcn_cvt_pk_f32_bf8(wl8[ft][s].x, false), l1 = __builtin_amdgcn_cvt_pk_f32_bf8(wl8[ft][s].x, true), l2 = __builtin_amdgcn_cvt_pk_f32_bf8(wl8[ft][s].y, false), l3 = __builtin_amdgcn_cvt_pk_f32_bf8(wl8[ft][s].y, true);
                        const bf16x8 wlo = __builtin_bit_cast(bf16x8, (u32x4){pk2(l0.x, l0.y), pk2(l1.x, l1.y), pk2(l2.x, l2.y), pk2(l3.x, l3.y)});
                        acc[ft] = MFMA16(wh[ft][s], bh, acc[ft]); acc[ft] = MFMA16(wh[ft][s], bl, acc[ft]); acc2[ft] = MFMA16(wlo, bh, acc2[ft]); } }
#pragma unroll
                for (int ft = 0; ft < 4; ++ft)
#pragma unroll
                    for (int e = 0; e < 4; ++e) part[(F.wave * 64 + 16 * ft + 4 * q + e) * 16 + r] = acc[ft][e] + acc2[ft][e] * (1.0f / 4096.0f);
            }
            LBAR();
#pragma unroll 1
            for (int tw = 0; tw < 2; ++tw) { const int slot = 2 * F.wave + tw; float logit = 0.f;
#pragma unroll
                for (int w = 0; w < 8; ++w) logit += part[(w * 64 + F.lane) * 16 + slot];
                route_token(F, g64 * 64 + grp * 16 + slot, logit, lcnt, stage, cnt, list); }
        }
        __syncthreads();
        if (F.tid < 64) { const unsigned n = lcnt[F.tid] < 48u ? lcnt[F.tid] : 48u; lcnt[F.tid] = n; lcnt[64 + F.tid] = atomicAdd(cnt + 64 * F.tid, n); }
        __syncthreads();
        { const int e = F.tid >> 3; const unsigned n = lcnt[e], base = lcnt[64 + e];
          for (unsigned j = F.tid & 7; j < n; j += 8) { const u32x2 v = stage[e * 48 + j]; list[(size_t)e * NT + base + j] = make_int2((int)v.x, (int)v.y); } }
        __syncthreads();
    }
}

__device__ __forceinline__ void build_tile_prefix(Frame& F, LAS int* tp) {
    __syncthreads();
    if (F.tid == 0) { int s = 0; const unsigned* cnt = F.ctl + CW_CNT; for (int e = 0; e < 64; ++e) { const int ce = (int)__hip_atomic_load(cnt + 64 * e, __ATOMIC_RELAXED, __HIP_MEMORY_SCOPE_AGENT); tp[96 + e] = ce; tp[e] = s; s += (ce + 255) >> 8; } tp[64] = s; tp[65] = s + 64;
        const int x = F.bid & 7; int l = 0; for (int k = 0; k < 8; ++k) { tp[80 + k] = l; l += tp[x + 8 * k + 1] - tp[x + 8 * k]; } tp[88] = l; tp[89] = l + 8; }
    __syncthreads();
}
struct SchedMoe {
    const char* A; const char* B; const int2* list; const unsigned* cnt; const LAS int* tp; int npn, K, G, c; size_t bstride  ; int bcol0  ; bool gather;
    __device__ __forceinline__ bool next(int i, pg8::Unit& u) const {
        int e, pm;
        if ((G & 7) == 0) {
            const int x = c & 7, W = G >> 3, L = i * W + (c >> 3); const int nt = __builtin_amdgcn_readfirstlane(tp[89]); if (L >= nt * npn) return false;
            const int tl = L / npn; u.pn = L % npn; int k = 0;
            for (int q = 8; q >= 1; q >>= 1) if (k + q <= 8 && __builtin_amdgcn_readfirstlane(tp[80 + k + q]) <= tl) k += q;
            k = __builtin_amdgcn_readfirstlane(k); const int off = tl - __builtin_amdgcn_readfirstlane(tp[80 + k]);
            if (k < 8) { e = x + 8 * k; pm = off; } else { e = 64; pm = x + 8 * off; }
        } else {
            const int L = i * G + c; const int ntile = __builtin_amdgcn_readfirstlane(tp[65]); if (L >= ntile * npn) return false;
            const int tile = L / npn; u.pn = L % npn; e = 0;
            for (int q = 64; q >= 1; q >>= 1) if (e + q <= 64 && __builtin_amdgcn_readfirstlane(tp[e + q]) <= tile) e += q;
            e = __builtin_amdgcn_readfirstlane(e); pm = tile - __builtin_amdgcn_readfirstlane(tp[e]);
        }
        u.e = e; u.pm = pm; u.base = (e < 64 ? (__builtin_amdgcn_readfirstlane(tp[e < 64 ? e : 0]) + pm) * 256 : SLOT_SH + pm * 256);
        u.A = gather ? A : A + (size_t)u.base * K * 2; u.B = B + (size_t)e * bstride + (size_t)(bcol0 + u.pn * 256) * K * 2; return true; }
    __device__ __forceinline__ int row_index(const pg8::Unit& u, int r) const {
        if (u.e == 64) return u.pm * 256 + r;
        const unsigned tok = (unsigned)list[(size_t)u.e * NT + u.pm * 256 + r].x >> 3; return (int)(tok < (unsigned)NT ? tok : 0u); }
};
struct EpiUp { bf16* HMID;
    __device__ __forceinline__ void operator()(const f32x4 (&acc)[2][2][4][2], const pg8::Unit& u, int wr, int wc, int fr, int fq) const {
#pragma unroll
        for (int ai = 0; ai < 2; ++ai)
#pragma unroll
            for (int m = 0; m < 4; ++m) { const size_t slot = (size_t)u.base + ai * 128 + wr * 64 + m * 16 + fr;
#pragma unroll
                for (int bj = 0; bj < 2; ++bj) { const int hid = u.pn * 128 + bj * 64 + wc * 16 + fq * 4; const f32x4 g = acc[ai][bj][m][0], up = acc[ai][bj][m][1];
                    u32x2 w; w.x = pk2(siluf_(g[0]) * up[0], siluf_(g[1]) * up[1]); w.y = pk2(siluf_(g[2]) * up[2], siluf_(g[3]) * up[3]);
                    *(u32x2*)(HMID + slot * DEXP + hid) = w; } }
    }
};
constexpr float YB_SCALE = 64.0f, YB_INV = 1.0f / 64.0f;
__device__ __forceinline__ unsigned pk4_fp8(float a, float b, float c, float d) {
    a = fminf(fmaxf(a * YB_SCALE, -448.f), 448.f); b = fminf(fmaxf(b * YB_SCALE, -448.f), 448.f); c = fminf(fmaxf(c * YB_SCALE, -448.f), 448.f); d = fminf(fmaxf(d * YB_SCALE, -448.f), 448.f);
    unsigned p = __builtin_amdgcn_cvt_pk_fp8_f32(a, b, 0u, false); return __builtin_amdgcn_cvt_pk_fp8_f32(c, d, p, true); }
struct EpiDown { unsigned char* YB; float* OUT; const int2* list; const LAS int* tp;
    __device__ __forceinline__ void operator()(const f32x4 (&acc)[2][2][4][2], const pg8::Unit& u, int wr, int wc, int fr, int fq) const {
        if (u.e == 64) {
#pragma unroll
            for (int ai = 0; ai < 2; ++ai)
#pragma unroll
                for (int m = 0; m < 4; ++m) { const int idx = u.pm * 256 + ai * 128 + wr * 64 + m * 16 + fr; float* o = OUT + (size_t)idx * DM + u.pn * 256 + wc * 32 + 8 * fq;
#pragma unroll
                    for (int bj = 0; bj < 2; ++bj) { *(f32x4*)(o + bj * 128) = acc[ai][bj][m][0]; *(f32x4*)(o + bj * 128 + 4) = acc[ai][bj][m][1]; } }
        } else {
            const int n = __builtin_amdgcn_readfirstlane(tp[96 + u.e]); int2 dw[2][4];
#pragma unroll
            for (int ai = 0; ai < 2; ++ai)
#pragma unroll
                for (int m = 0; m < 4; ++m) { int idx = u.pm * 256 + ai * 128 + wr * 64 + m * 16 + fr; idx = idx < n ? idx : n - 1; dw[ai][m] = list[(size_t)u.e * NT + idx]; }
#pragma unroll
            for (int ai = 0; ai < 2; ++ai)
#pragma unroll
                for (int m = 0; m < 4; ++m) { const int idx = u.pm * 256 + ai * 128 + wr * 64 + m * 16 + fr;
                    if (idx < n) { const float w = __int_as_float(dw[ai][m].y); unsigned char* o = YB + (size_t)dw[ai][m].x * DM + u.pn * 256 + wc * 32 + 8 * fq;
#pragma unroll
                        for (int bj = 0; bj < 2; ++bj) { const f32x4 v0 = acc[ai][bj][m][0] * w, v1 = acc[ai][bj][m][1] * w;
                            u32x2 q; q.x = pk4_fp8(v0[0], v0[1], v0[2], v0[3]); q.y = pk4_fp8(v1[0], v1[1], v1[2], v1[3]);
                            *(u32x2*)(o + bj * 128) = q; } } }
        }
    }
};
__device__ __forceinline__ void phase_final(Frame& F) {
    typedef float f32x2v __attribute__((ext_vector_type(2)));
    const int gw = F.bid * NWAVES + F.wave, NGW = F.G * NWAVES; const unsigned char* YB = F.ws + WS_YB;
    for (int t = gw; t < NT; t += NGW) {
        const int b = t / SEQ; const float* mod = WSP(float, WS_MOD) + b * 6144;
        u32x2 ya[8], yb[8];
#pragma unroll
        for (int k = 0; k < 8; ++k) { const unsigned char* rp = YB + ((size_t)t * 8 + k) * DM; ya[k] = *(const u32x2*)(rp + 8 * F.lane); yb[k] = *(const u32x2*)(rp + 512 + 8 * F.lane); }
        float mv[16]; load_row_f32(F.out + (size_t)t * DM, F.lane, mv);
        float ra[16];
#pragma unroll
        for (int i = 0; i < 16; ++i) ra[i] = 0.f;
#pragma unroll
        for (int k = 0; k < 8; ++k) {
            const f32x2v a0 = __builtin_amdgcn_cvt_pk_f32_fp8(ya[k].x, false), a1 = __builtin_amdgcn_cvt_pk_f32_fp8(ya[k].x, true), a2 = __builtin_amdgcn_cvt_pk_f32_fp8(ya[k].y, false), a3 = __builtin_amdgcn_cvt_pk_f32_fp8(ya[k].y, true);
            const f32x2v c0 = __builtin_amdgcn_cvt_pk_f32_fp8(yb[k].x, false), c1 = __builtin_amdgcn_cvt_pk_f32_fp8(yb[k].x, true), c2 = __builtin_amdgcn_cvt_pk_f32_fp8(yb[k].y, false), c3 = __builtin_amdgcn_cvt_pk_f32_fp8(yb[k].y, true);
            ra[0] += a0.x; ra[1] += a0.y; ra[2] += a1.x; ra[3] += a1.y; ra[4] += a2.x; ra[5] += a2.y; ra[6] += a3.x; ra[7] += a3.y;
            ra[8] += c0.x; ra[9] += c0.y; ra[10] += c1.x; ra[11] += c1.y; ra[12] += c2.x; ra[13] += c2.y; ra[14] += c3.x; ra[15] += c3.y; }
        float ss = 0.f;
#pragma unroll
        for (int i = 0; i < 16; ++i) { mv[i] += ra[i] * YB_INV; ss += mv[i] * mv[i]; }
        const float rstd = 1.0f / sqrtf(wave_sum(ss) * (1.f / DM) + EPS);
        float x1[16]; compute_x1(F, t, x1);
        float wv[16], g2[16]; load_row_f32(F.n_ffn_post, F.lane, wv); load_row_f32(mod + 5 * DM, F.lane, g2);
        float o[16];
#pragma unroll
        for (int i = 0; i < 16; ++i) o[i] = x1[i] + g2[i] * (mv[i] * rstd * wv[i]);
        store_row_f32(F.out + (size_t)t * DM, F.lane, o);
    }
}

constexpr int N_PHASES = 16;
__global__ void __launch_bounds__(NTHR, 2) fwd(Args args) {
    extern __shared__ __attribute__((aligned(16))) unsigned char lds_raw[];
    Frame F; F.lds = (LAS unsigned char*)lds_raw; F.tid = threadIdx.x; F.lane = F.tid & 63; F.wave = __builtin_amdgcn_readfirstlane(F.tid >> 6); F.G = gridDim.x; F.bid = blockIdx.x;
    F.x = args.in[0]; F.c = args.in[1]; F.ctx = args.in[2]; F.c_ctx = args.in[3]; F.w_mod = args.in[4]; F.b_mod = args.in[5]; F.n_mix_pre = args.in[6]; F.n_mix_post = args.in[7];
    F.n_ffn_pre = args.in[8]; F.n_ffn_post = args.in[9]; F.w_in = args.in[10]; F.gdn_conv = args.in[11]; F.ret_log_decay = args.in[12]; F.gdn_a_log = args.in[13]; F.gdn_dt_bias = args.in[14];
    F.ret_gn_w = args.in[15]; F.gdn_norm_w = args.in[16]; F.w_ret_out = args.in[17]; F.w_gdn_out = args.in[18]; F.w_o = args.in[19]; F.w_router = args.in[20]; F.router_bias = args.in[21];
    F.w_gate = args.in[22]; F.w_up = args.in[23]; F.w_down = args.in[24]; F.w_sh_gate = args.in[25]; F.w_sh_up = args.in[26]; F.w_sh_down = args.in[27];
    F.out = args.out; F.ws = args.ws; F.ctl = (unsigned*)(args.ws + WS_CTL);
    volatile LAS unsigned* MISC = (volatile LAS unsigned*)(F.lds + MISC_OFF);
    if (F.tid < 64) MISC[F.tid] = 0u;
    __syncthreads();
#if MK_ONE_LAUNCH
    XcdBarrier bar = xcd_barrier_post(F.ctl + CW_BAR, MISC + 8);
#define SEAM() xcd_barrier(bar)
#else
#define SEAM() do {} while (0)
#endif
    const int lo = args.ph_lo, hi = args.ph_hi;
#ifndef PHM
#define PHM 0xffff
#endif
#ifndef DUP
#define DUP -1
#endif
#define IN(k) (((PHM >> (k)) & 1) && lo <= (k) && (k) < hi)
    LAS int* tp = (LAS int*)(F.lds + MISC_OFF + 256);
#ifndef PROBE_PH
#define PROBE_PH -1
#endif
#ifdef PROBE_A
#define PROBE_IA PROBE_A
#define PROBE_IB PROBE_B
#else
#define PROBE_IA (PROBE_PH % 100)
#define PROBE_IB ((PROBE_PH % 100) + 1)
#endif
    volatile LAS unsigned long long* tsl = (volatile LAS unsigned long long*)(F.lds + MISC_OFF + 896);
#define STAMP(k) do { if (PROBE_PH >= 0 && F.bid == 0 && F.tid == 0 && !(PROBE_PH == 204 && (k) == 5)) tsl[k] = __builtin_amdgcn_s_memrealtime(); } while (0)

    STAMP(0);
    if (IN(0)) _Pragma("unroll") for (int rep_ = 0; rep_ < ((DUP == 0) ? 2 : 1); ++rep_) { phase_prologue(F); SEAM(); }
    STAMP(1);
    if (IN(1)) _Pragma("unroll") for (int rep_ = 0; rep_ < ((DUP == 1) ? 2 : 1); ++rep_) { phase_norm1(F);
        if (F.G >= 64 && F.bid < 32) { SchedCtx S{(const char*)WSP(bf16, WS_HX), (const char*)WSP(bf16, WS_WIN), F.bid >> 3, F.bid & 7}; EpiIn E{WSP(bf16, WS_P), (bf16*)F.out, WSP(float2, WS_ROPE)};
            pg8::gemm_phase<EpiIn, SchedCtx, false, SP2>(F.lds, DM, S, E); }
        SEAM(); }
    STAMP(2);
    if (IN(2)) _Pragma("unroll") for (int rep_ = 0; rep_ < ((DUP == 2) ? 2 : 1); ++rep_) {
        SchedIn S{(const char*)WSP(bf16, WS_HX), (const char*)WSP(bf16, WS_WIN), F.G, F.bid};
        EpiIn E{WSP(bf16, WS_P), (bf16*)F.out, WSP(float2, WS_ROPE)};
        pg8::gemm_phase<EpiIn, SchedIn, false, SP2>(F.lds, DM, S, E); SEAM();
    }
    STAMP(3);
    if (IN(3)) _Pragma("unroll") for (int rep_ = 0; rep_ < ((DUP == 3) ? 2 : 1); ++rep_) { phase_prep(F); SEAM(); }
    STAMP(4);
    if (IN(4)) _Pragma("unroll") for (int rep_ = 0; rep_ < ((DUP == 4) ? 2 : 1); ++rep_) { phase_scan(F); SEAM(); }
    STAMP(5);
    if (IN(5)) _Pragma("unroll") for (int rep_ = 0; rep_ < ((DUP == 5) ? 2 : 1); ++rep_) { phase_out(F); SEAM(); }
    STAMP(6);
    if (IN(6)) _Pragma("unroll") for (int rep_ = 0; rep_ < ((DUP == 6) ? 2 : 1); ++rep_) {
        SchedMerge S{(const char*)WSP(bf16, WS_RETY), (const char*)WSP(bf16, WS_GDNY), (const char*)WSP(bf16, WS_WRO), (const char*)WSP(bf16, WS_WGO), F.G, F.bid};
        EpiMerge E{(const bf16*)F.out, WSP(bf16, WS_TMP), WSP(bf16, WS_MERGED)};
        pg8::gemm_phase<EpiMerge, SchedMerge, false, SP2>(F.lds, 512, S, E);
        STAMP(15);
        if (rep_ == 0) { _Pragma("unroll") for (int r2_ = 0; r2_ < ((DUP == 16) ? 2 : 1); ++r2_) phase_moe_weights(F); }
        SEAM();
    }
    STAMP(7);
    if (IN(7)) _Pragma("unroll") for (int rep_ = 0; rep_ < ((DUP == 7) ? 2 : 1); ++rep_) {
        SchedDense S{(const char*)WSP(bf16, WS_MERGED), (const char*)WSP(bf16, WS_WO), 64, 4, DM, F.G, F.bid};
        EpiBf16Store E{WSP(bf16, WS_MO), DM};
        pg8::gemm_phase<EpiBf16Store, SchedDense, false, SP2>(F.lds, DM, S, E); SEAM();
    }
    STAMP(8);
    if (IN(8)) _Pragma("unroll") for (int rep_ = 0; rep_ < ((DUP == 8) ? 2 : 1); ++rep_) { if (rep_ == 1) { if (F.bid == 0 && F.tid < 64) F.ctl[CW_CNT + 64 * F.tid] = 0u; SEAM(); } phase_route(F); SEAM(); }
    STAMP(9);
    if (IN(9)) _Pragma("unroll") for (int rep_ = 0; rep_ < ((DUP == 9) ? 2 : 1); ++rep_) {
        build_tile_prefix(F, tp);
        SchedMoe S{(const char*)WSP(bf16, WS_H2), (const char*)WSP(bf16, WS_WGU), WSP(int2, WS_LIST), F.ctl + CW_CNT, tp, 2, DM, F.G, F.bid, (size_t)512 * DM * 2, 0, true};
        EpiUp E{WSP(bf16, WS_HMID)};
        pg8::gemm_phase<EpiUp, SchedMoe, true, SP2>(F.lds, DM, S, E); SEAM();
    }
    STAMP(10);
    if (IN(10)) _Pragma("unroll") for (int rep_ = 0; rep_ < ((DUP == 10) ? 2 : 1); ++rep_) {
        build_tile_prefix(F, tp);
        SchedMoe S{(const char*)WSP(bf16, WS_HMID), (const char*)WSP(bf16, WS_WD), WSP(int2, WS_LIST), F.ctl + CW_CNT, tp, 4, DEXP, F.G, F.bid, (size_t)DM * DEXP * 2, 0, false};
        EpiDown E{F.ws + WS_YB, F.out, WSP(int2, WS_LIST), tp};
        pg8::gemm_phase<EpiDown, SchedMoe, false, SP2>(F.lds, DEXP, S, E); SEAM();
    }
    STAMP(11);
    STAMP(12);
    STAMP(13);
    if (IN(13)) _Pragma("unroll") for (int rep_ = 0; rep_ < ((DUP == 13) ? 2 : 1); ++rep_) { phase_final(F); }
    STAMP(14);
    if (PROBE_PH >= 0 && F.bid == 0) { __syncthreads(); if (F.tid == 0) { const unsigned long long d = tsl[PROBE_IB] - tsl[PROBE_IA]; float a = 1.0f + 0.2f * floorf((float)d * 0.001f); a = a > 30.f ? 30.f : a;
#ifdef PROBE_BIG
            a = 20.0f + (float)d * 0.005f;
#endif
            asm volatile("s_waitcnt vmcnt(0)" ::: "memory"); F.out[0] += a; } }
#undef IN
}

extern "C" void kernel_launch(void* const* d_in, const int* in_sizes, int n_in, void* d_out, int out_size, void* d_ws, size_t ws_size, hipStream_t stream) {
    static int grid = 0;
    if (grid == 0) {
        if (n_in != 28 || in_sizes[0] != NT * DM || out_size != NT * DM || ws_size < WS_END) { fprintf(stderr, "kernel_launch: unexpected shapes / workspace (%d inputs, ws %zu)\n", n_in, ws_size); grid = -1; return; }
        int dev = 0, cus = 0;
        if (hipGetDevice(&dev) != hipSuccess || hipDeviceGetAttribute(&cus, hipDeviceAttributeMultiprocessorCount, dev) != hipSuccess) { grid = -1; return; }
        if (hipFuncSetAttribute((const void*)fwd, hipFuncAttributeMaxDynamicSharedMemorySize, LDS_BYTES) != hipSuccess) { fprintf(stderr, "kernel_launch: hipFuncSetAttribute failed\n"); grid = -1; return; }
        int per_cu = 0; (void)hipOccupancyMaxActiveBlocksPerMultiprocessor(&per_cu, (const void*)fwd, NTHR, LDS_BYTES); (void)hipGetLastError();
        if (per_cu < 1) fprintf(stderr, "kernel_launch: occupancy query says %d\n", per_cu);
        grid = cus;
    }
    if (grid < 0) return;
    (void)hipMemsetAsync((char*)d_ws + WS_CTL, 0, CTL_BYTES, stream);
    Args a{};
    for (int i = 0; i < 28; ++i) a.in[i] = (const float*)d_in[i];
    a.out = (float*)d_out; a.ws = (unsigned char*)d_ws;
#if MK_ONE_LAUNCH
    a.ph_lo = 0; a.ph_hi = N_PHASES;
    hipLaunchKernelGGL(fwd, dim3(grid), dim3(NTHR), LDS_BYTES, stream, a);
#else
    for (int p = 0; p < 14; ++p) { a.ph_lo = p; a.ph_hi = p + 1; hipLaunchKernelGGL(fwd, dim3(grid), dim3(NTHR), LDS_BYTES, stream, a); }
#endif
}
```

```cpp
#include <hip/hip_runtime.h>
#include <cstdio>
#include <cstdint>

#ifndef MK_ONE_LAUNCH
#define MK_ONE_LAUNCH 1
#endif
#ifndef MK_REF_GEMM
#define MK_REF_GEMM 0
#endif

constexpr int NB = 4, SEQ = 4096, DM = 1024, CTXL = 256, RPB = SEQ + CTXL  , NROW = NB * RPB  , NT = NB * SEQ  ;
constexpr int NH = 4, HD = 128, CH = 128, NCHUNK = RPB / CH  ;
constexpr int N_STATE = 2064, N_IN = 6160, NEXP = 64, TOPK = 8, DEXP = 256;
constexpr float EPS = 1e-6f;
constexpr int NPCOL = 4096;
constexpr int SLOT_SH = 147456;
constexpr int NSLOT = SLOT_SH + NT;

constexpr size_t MiB = 1u << 20;
constexpr size_t WS_CTL = 0, CTL_BYTES = 64 * 1024;
constexpr size_t WS_MOD = 1 * MiB;
constexpr size_t WS_ROPE = 2 * MiB;
constexpr size_t WS_LOGA = 4 * MiB;
constexpr size_t WS_BETA = 5 * MiB;
constexpr size_t WS_WRO = 6 * MiB, WS_WGO = 7 * MiB, WS_WO = 8 * MiB;
constexpr size_t WS_P = 10 * MiB;
constexpr size_t PGRP = (size_t)NROW * 512;
constexpr size_t WS_CH = 146 * MiB;
constexpr size_t WS_WIN = WS_CH;
constexpr size_t WS_HX = WS_CH + 12 * MiB;
constexpr size_t WS_GM = WS_CH;
constexpr size_t WS_GC = WS_CH + 34 * MiB;
constexpr size_t WS_GKV = WS_CH + 68 * MiB;
constexpr size_t WS_GQT = WS_CH + 102 * MiB;
constexpr size_t WS_OGDN = WS_CH + 134 * MiB;
constexpr size_t WS_ORET = WS_CH + 150 * MiB;
constexpr size_t WS_RETY = WS_P, WS_GDNY = WS_P + 17 * MiB;
constexpr size_t WS_H2 = 10 * MiB;
constexpr size_t WS_WGU = 73 * MiB;
constexpr size_t WS_YB = 10 * MiB;
constexpr size_t WS_WD = 138 * MiB;
constexpr size_t WS_HMID = 171 * MiB;
constexpr size_t WS_TMP = 171 * MiB, WS_MERGED = 203 * MiB;
constexpr size_t WS_MO = 251 * MiB;
constexpr size_t WS_LIST = 283 * MiB;
constexpr size_t WS_END = 312 * MiB;

constexpr int CW_BAR = 1024;
constexpr int CW_CNT = 8192;
constexpr int CW_FLAG = 12288;

#define GAS __attribute__((address_space(1)))
#define LAS __attribute__((address_space(3)))
typedef unsigned short bf16;
typedef float f32x4 __attribute__((ext_vector_type(4)));
typedef float f32x2 __attribute__((ext_vector_type(2)));
typedef short bf16x8 __attribute__((ext_vector_type(8)));
typedef unsigned u32x4 __attribute__((ext_vector_type(4)));
typedef unsigned u32x2 __attribute__((ext_vector_type(2)));
__device__ __forceinline__ unsigned f2bf(float f) { unsigned u = __builtin_bit_cast(unsigned, f); return (u + 0x7fffu + ((u >> 16) & 1u)) >> 16; }
typedef __bf16 bf16x2_t __attribute__((ext_vector_type(2)));
__device__ __forceinline__ unsigned pk2(float lo, float hi) { const f32x2 v = {lo, hi}; return __builtin_bit_cast(unsigned, __builtin_convertvector(v, bf16x2_t)); }
__device__ __forceinline__ float bf2f(unsigned b) { return __builtin_bit_cast(float, b << 16); }
__device__ __forceinline__ float bflo(unsigned w) { return __builtin_bit_cast(float, w << 16); }
__device__ __forceinline__ float bfhi(unsigned w) { return __builtin_bit_cast(float, w & 0xffff0000u); }
__device__ __forceinline__ float sigmoidf_(float x) { return __builtin_amdgcn_rcpf(1.f + __expf(-x)); }
__device__ __forceinline__ float siluf_(float x) { return x * __builtin_amdgcn_rcpf(1.f + __expf(-x)); }
__device__ __forceinline__ float dpp_add(float v, const int ctrl_tag) { return v; }
#define DPP_ADD(v, ctrl) ((v) + __builtin_bit_cast(float, __builtin_amdgcn_update_dpp(0, __builtin_bit_cast(int, (v)), (ctrl), 0xf, 0xf, true)))
__device__ __forceinline__ float sum16(float v) {
    v = DPP_ADD(v, 0xB1);
    v = DPP_ADD(v, 0x4E);
    v = DPP_ADD(v, 0x141);
    v = DPP_ADD(v, 0x140);
    return v;
}
__device__ __forceinline__ float wave_sum(float v) {
    v = sum16(v);
    const float r0 = __builtin_bit_cast(float, __builtin_amdgcn_readlane(__builtin_bit_cast(int, v), 0)), r1 = __builtin_bit_cast(float, __builtin_amdgcn_readlane(__builtin_bit_cast(int, v), 16));
    const float r2 = __builtin_bit_cast(float, __builtin_amdgcn_readlane(__builtin_bit_cast(int, v), 32)), r3 = __builtin_bit_cast(float, __builtin_amdgcn_readlane(__builtin_bit_cast(int, v), 48));
    return (r0 + r1) + (r2 + r3);
}
__device__ __forceinline__ void unpack8(const u32x4 w, float (&o)[8]) {
    o[0] = bflo(w.x); o[1] = bfhi(w.x); o[2] = bflo(w.y); o[3] = bfhi(w.y); o[4] = bflo(w.z); o[5] = bfhi(w.z); o[6] = bflo(w.w); o[7] = bfhi(w.w);
}
__device__ __forceinline__ u32x4 pack8(const float (&v)[8]) { u32x4 w; w.x = pk2(v[0], v[1]); w.y = pk2(v[2], v[3]); w.z = pk2(v[4], v[5]); w.w = pk2(v[6], v[7]); return w; }

namespace pg8 {
constexpr int BM = 256, BK = 64, HALF = 128, HTB = HALF * BK * 2, STAGE_BYTES = 8 * HTB;
__host__ __device__ __forceinline__ int lds_byte(int r, int c) { const int st = (r >> 4) * 2 + (c >> 5), rr = r & 15, cc = c & 31, ob = rr * 64 + cc * 2; return st * 1024 + (ob ^ (((ob >> 9) & 1) << 5)); }
__host__ __device__ __forceinline__ void stage_rc(int b, int& R, int& C) { const int st = b / 1024, sb = b % 1024, swz = sb ^ (((sb >> 9) & 1) << 5); R = (st >> 1) * 16 + swz / 64; C = (st & 1) * 32 + (swz % 64) / 2; }
__host__ __device__ __forceinline__ int perm32(int rho) { const int n = rho >> 4, i = rho & 15; return 8 * (i >> 2) + 4 * n + (i & 3); }
__device__ __forceinline__ unsigned cvt_pk_bf16(float lo, float hi) { unsigned r; asm volatile("v_cvt_pk_bf16_f32 %0, %1, %2" : "=v"(r) : "v"(lo), "v"(hi)); return r; }

struct Unit { const char* A; const char* B; int pm, pn, e, base; };

template <class Epi, class Sched, bool GATHER, bool SP2>
__device__ __forceinline__ void gemm_phase(LAS unsigned char* lds, const int K, const Sched& S, const Epi& E) {
#if MK_REF_GEMM
    {
        const int tid = threadIdx.x, wid = tid >> 6, lane = tid & 63, wr = wid >> 2, wc = wid & 3, fr = lane & 15, fq = lane >> 4;
        Unit cur;
        for (int ui = 0; S.next(ui, cur); ++ui) {
            f32x4 acc[2][2][4][2];
            for (int ai = 0; ai < 2; ++ai) for (int m = 0; m < 4; ++m) {
                const int r = 128 * ai + 64 * wr + 16 * m + fr;
                const bf16* arow = GATHER ? (const bf16*)cur.A + (size_t)S.row_index(cur, r) * K : (const bf16*)cur.A + (size_t)r * K;
                for (int bj = 0; bj < 2; ++bj) for (int n = 0; n < 2; ++n) {
                    f32x4 a4 = {0.f, 0.f, 0.f, 0.f};
                    for (int i = 0; i < 4; ++i) { const int c = 128 * bj + 32 * wc + 8 * fq + 4 * n + i; const bf16* brow = (const bf16*)cur.B + (size_t)c * K;
                        float s = 0.f; for (int k = 0; k < K; ++k) s += bf2f(arow[k]) * bf2f(brow[k]); a4[i] = s; }
                    acc[ai][bj][m][n] = a4; } }
            E(acc, cur, wr, wc, fr, fq);
        }
        return;
    }
#else
    const int tid = threadIdx.x, wid = __builtin_amdgcn_readfirstlane(tid >> 6), lane = tid & 63, wr = wid >> 2, wc = wid & 3, fr = lane & 15, fq = lane >> 4;
    const int nt = K / BK;
    unsigned voffA[2], voffB[2]; int gR = 0, gC = 0;
#pragma unroll
    for (int i = 0; i < 2; ++i) { int R, C; stage_rc(tid * 16 + i * 8192, R, C); const int Rb = (R & ~31) + perm32(R & 31);
        voffA[i] = (unsigned)(R * K + C) * 2u; voffB[i] = (unsigned)(Rb * K + C) * 2u; if (i == 0) { gR = R; gC = C; } }
    const size_t kstep = (size_t)(BK * 2);
    const size_t hstep = (size_t)HALF * K * 2;
    const unsigned ldsw = (unsigned)wid * 1024u;
    const int aoff = lds_byte(wr * 64 + fr, fq * 8), boff = lds_byte(wc * 32 + fr, fq * 8);
#define PG8_SA(b, h) (((b) * 2 + (h)) * HTB)
#define PG8_SB(b, h) ((4 + (b) * 2 + (h)) * HTB)
#define PG8_STAGE(bufoff, gbase, voff) do { _Pragma("unroll") for (int _i = 0; _i < 2; ++_i) \
        __builtin_amdgcn_global_load_lds((const unsigned*)((const char*)(gbase) + (voff)[_i]), (LAS unsigned*)(lds + (bufoff) + ldsw + _i * 8192), 16, 0, 0); } while (0)
#define PG8_STAGE_A(bufoff, gbase, h, G) do { if constexpr (GATHER) { PG8_STAGE(bufoff, gbase, (G)[h]); } else { PG8_STAGE(bufoff, (gbase) + (h) * hstep, voffA); } } while (0)
#define PG8_LDA(dst, b, h) do { _Pragma("unroll") for (int m = 0; m < 4; ++m) _Pragma("unroll") for (int k = 0; k < 2; ++k) dst[m][k] = *(const LAS bf16x8*)(lds + PG8_SA(b, h) + aoff + m * 2048 + k * 1024); } while (0)
#define PG8_LDB(dst, b, h) do { _Pragma("unroll") for (int n = 0; n < 2; ++n) _Pragma("unroll") for (int k = 0; k < 2; ++k) dst[n][k] = *(const LAS bf16x8*)(lds + PG8_SB(b, h) + boff + n * 2048 + k * 1024); } while (0)
#define PG8_MMA(ai, bj, At, Bt) do { __builtin_amdgcn_s_setprio(1); _Pragma("unroll") for (int m = 0; m < 4; ++m) _Pragma("unroll") for (int n = 0; n < 2; ++n) _Pragma("unroll") for (int k = 0; k < 2; ++k) \
        acc[ai][bj][m][n] = __builtin_amdgcn_mfma_f32_16x16x32_bf16(Bt[n][k], At[m][k], acc[ai][bj][m][n], 0, 0, 0); __builtin_amdgcn_s_setprio(0); } while (0)
#define PG8_WAIT_V(n) asm volatile("s_waitcnt vmcnt(" #n ")" ::: "memory")
#define PG8_WAIT_L(n) asm volatile("s_waitcnt lgkmcnt(" #n ")" ::: "memory")
#define PG8_BAR __builtin_amdgcn_s_barrier()
#define PG8_SCHED __builtin_amdgcn_sched_barrier(0)
    Unit cur, nxt; int ui = 0;
    if (!S.next(0, cur)) return;
    f32x4 acc[2][2][4][2];
#pragma unroll
    for (int a = 0; a < 2; ++a)
#pragma unroll
        for (int b = 0; b < 2; ++b)
#pragma unroll
            for (int m = 0; m < 4; ++m)
#pragma unroll
                for (int n = 0; n < 2; ++n) acc[a][b][m][n] = (f32x4){0.f, 0.f, 0.f, 0.f};
    bf16x8 At[4][2], B0[2][2], B1[2][2];
    const char* cA = cur.A; const char* cB = cur.B;
    unsigned cG[2][2] = {{0u, 0u}, {0u, 0u}}, nG[2][2] = {{0u, 0u}, {0u, 0u}};
    if constexpr (GATHER) {
#pragma unroll
        for (int h = 0; h < 2; ++h)
#pragma unroll
            for (int i = 0; i < 2; ++i) cG[h][i] = ((unsigned)S.row_index(cur, 128 * h + gR + 64 * i) * (unsigned)K + (unsigned)gC) * 2u;
    }
    if constexpr (SP2) {
        PG8_STAGE(PG8_SB(0, 0), cB, voffB); PG8_STAGE(PG8_SB(0, 1), cB + hstep, voffB); PG8_STAGE_A(PG8_SA(0, 0), cA, 0, cG); PG8_STAGE_A(PG8_SA(0, 1), cA, 1, cG);
        if (wr == 1) PG8_BAR;
        PG8_WAIT_V(2); PG8_BAR;
        PG8_STAGE(PG8_SB(1, 0), cB + kstep, voffB); PG8_STAGE_A(PG8_SA(1, 0), cA + kstep, 0, cG); PG8_STAGE(PG8_SB(1, 1), cB + hstep + kstep, voffB);
        PG8_WAIT_V(6); PG8_BAR;
    } else {
        PG8_STAGE(PG8_SB(0, 0), cB, voffB); PG8_STAGE_A(PG8_SA(0, 0), cA, 0, cG); PG8_STAGE(PG8_SB(0, 1), cB + hstep, voffB); PG8_STAGE_A(PG8_SA(0, 1), cA, 1, cG);
        if (wr == 1) PG8_BAR;
        PG8_WAIT_V(4); PG8_BAR;
        PG8_STAGE(PG8_SB(1, 0), cB + kstep, voffB); PG8_STAGE_A(PG8_SA(1, 0), cA + kstep, 0, cG); PG8_STAGE(PG8_SB(1, 1), cB + hstep + kstep, voffB);
        PG8_WAIT_V(6); PG8_BAR;
    }
    for (;;) {
        const bool has_next = S.next(ui + 1, nxt);
        const char* nA = has_next ? nxt.A : cA; const char* nB = has_next ? nxt.B : cB;
        for (int t = 0; t < nt; t += 2) {
            const bool last = (t == nt - 2);
            const char* a1 = cA + (size_t)(t + 1) * kstep;
            const char* a2 = last ? nA : cA + (size_t)(t + 2) * kstep; const char* b2 = last ? nB : cB + (size_t)(t + 2) * kstep;
            const char* a3 = a2 + kstep; const char* b3 = b2 + kstep;
            unsigned g2[2][2] = {{0u, 0u}, {0u, 0u}};
            if constexpr (GATHER) {
                if (last) {
                    if (has_next) {
#pragma unroll
                        for (int h = 0; h < 2; ++h)
#pragma unroll
                            for (int i = 0; i < 2; ++i) nG[h][i] = ((unsigned)S.row_index(nxt, 128 * h + gR + 64 * i) * (unsigned)K + (unsigned)gC) * 2u;
                    } else {
#pragma unroll
                        for (int h = 0; h < 2; ++h)
#pragma unroll
                            for (int i = 0; i < 2; ++i) nG[h][i] = cG[h][i];
                    }
                }
#pragma unroll
                for (int h = 0; h < 2; ++h)
#pragma unroll
                    for (int i = 0; i < 2; ++i) g2[h][i] = last ? nG[h][i] : cG[h][i];
            }
            if constexpr (SP2) {
            PG8_LDB(B0, 0, 0); PG8_LDB(B1, 0, 1); PG8_SCHED; PG8_LDA(At, 0, 0); PG8_STAGE_A(PG8_SA(1, 1), a1, 1, cG);
            PG8_WAIT_V(8); PG8_WAIT_L(0); PG8_BAR; PG8_MMA(0, 0, At, B0); PG8_MMA(0, 1, At, B1); PG8_BAR; PG8_SCHED;
            PG8_LDA(At, 0, 1); PG8_STAGE(PG8_SB(0, 0), b2, voffB); PG8_STAGE(PG8_SB(0, 1), b2 + hstep, voffB); PG8_STAGE_A(PG8_SA(0, 0), a2, 0, g2);
            PG8_WAIT_V(8); PG8_WAIT_L(0); PG8_BAR; PG8_MMA(1, 0, At, B0); PG8_MMA(1, 1, At, B1); PG8_BAR; PG8_SCHED;
            PG8_LDB(B0, 1, 0); PG8_LDB(B1, 1, 1); PG8_SCHED; PG8_LDA(At, 1, 0); PG8_STAGE_A(PG8_SA(0, 1), a2, 1, g2);
            PG8_WAIT_V(8); PG8_WAIT_L(0); PG8_BAR; PG8_MMA(0, 0, At, B0); PG8_MMA(0, 1, At, B1); PG8_BAR; PG8_SCHED;
            PG8_LDA(At, 1, 1); PG8_STAGE(PG8_SB(1, 0), b3, voffB); PG8_STAGE(PG8_SB(1, 1), b3 + hstep, voffB); PG8_STAGE_A(PG8_SA(1, 0), a3, 0, g2);
            PG8_WAIT_V(8); PG8_WAIT_L(0); PG8_BAR; PG8_MMA(1, 0, At, B0); PG8_MMA(1, 1, At, B1); PG8_BAR; PG8_SCHED;
            } else {
            PG8_LDB(B0, 0, 0); PG8_SCHED; PG8_LDA(At, 0, 0); PG8_STAGE_A(PG8_SA(1, 1), a1, 1, cG);
            PG8_WAIT_L(8); PG8_BAR; PG8_WAIT_L(0); PG8_MMA(0, 0, At, B0); PG8_BAR; PG8_SCHED;
            PG8_LDB(B1, 0, 1); PG8_STAGE(PG8_SB(0, 0), b2, voffB);
            PG8_BAR; PG8_WAIT_L(0); PG8_MMA(0, 1, At, B1); PG8_BAR;
            PG8_LDA(At, 0, 1); PG8_STAGE_A(PG8_SA(0, 0), a2, 0, g2);
            PG8_BAR; PG8_WAIT_L(0); PG8_MMA(1, 0, At, B0); PG8_BAR; PG8_SCHED;
            PG8_STAGE(PG8_SB(0, 1), b2 + hstep, voffB);
            PG8_WAIT_V(6); PG8_BAR; PG8_MMA(1, 1, At, B1); PG8_BAR;
            PG8_LDB(B0, 1, 0); PG8_SCHED; PG8_LDA(At, 1, 0); PG8_STAGE_A(PG8_SA(0, 1), a2, 1, g2);
            PG8_WAIT_L(8); PG8_BAR; PG8_WAIT_L(0); PG8_MMA(0, 0, At, B0); PG8_BAR; PG8_SCHED;
            PG8_LDB(B1, 1, 1); PG8_STAGE(PG8_SB(1, 0), b3, voffB);
            PG8_BAR; PG8_WAIT_L(0); PG8_MMA(0, 1, At, B1); PG8_BAR;
            PG8_LDA(At, 1, 1); PG8_STAGE_A(PG8_SA(1, 0), a3, 0, g2);
            PG8_BAR; PG8_WAIT_L(0); PG8_MMA(1, 0, At, B0); PG8_BAR; PG8_SCHED;
            PG8_STAGE(PG8_SB(1, 1), b3 + hstep, voffB);
            PG8_WAIT_V(6); PG8_BAR; PG8_MMA(1, 1, At, B1); PG8_BAR;
            }
        }
        if (wr == 0) PG8_BAR;
        { int tz = threadIdx.x; asm volatile("" : "+v"(tz)); const int wid_ = __builtin_amdgcn_readfirstlane(tz >> 6), lane_ = tz & 63;
          E(acc, cur, wid_ >> 2, wid_ & 3, lane_ & 15, lane_ >> 4); }
        if (!has_next) break;
#pragma unroll
        for (int a = 0; a < 2; ++a)
#pragma unroll
            for (int b = 0; b < 2; ++b)
#pragma unroll
                for (int m = 0; m < 4; ++m)
#pragma unroll
                    for (int n = 0; n < 2; ++n) acc[a][b][m][n] = (f32x4){0.f, 0.f, 0.f, 0.f};
        cur = nxt; cA = nA; cB = nB; ++ui;
        if constexpr (GATHER) {
#pragma unroll
            for (int h = 0; h < 2; ++h)
#pragma unroll
                for (int i = 0; i < 2; ++i) cG[h][i] = nG[h][i];
        }
        if (wr == 1) PG8_BAR;
    }
    PG8_WAIT_V(0);
    PG8_BAR;
#undef PG8_SA
#undef PG8_SB
#undef PG8_STAGE
#undef PG8_STAGE_A
#undef PG8_LDA
#undef PG8_LDB
#undef PG8_MMA
#undef PG8_WAIT_V
#undef PG8_WAIT_L
#undef PG8_BAR
#undef PG8_SCHED
#endif
}
}
constexpr bool SP2 = true;

#define XB_TMO      128
#define XB_XCNT(j)  (256  + 64 * (j))
#define XB_XSUB(j)  (1280 + 64 * (j))
#define XB_XGEN(j)  (2304 + 64 * (j))
#define XB_TOP      3328
#define XB_TOPGEN   3392
#define XCD_BAR_WORDS 3456
#define XB_SPIN_CAP (1u << 18)
__device__ __forceinline__ unsigned xb_ld(unsigned* p)              { return __hip_atomic_load(p, __ATOMIC_RELAXED, __HIP_MEMORY_SCOPE_AGENT); }
__device__ __forceinline__ unsigned xb_add(unsigned* p, unsigned v) { return __hip_atomic_fetch_add(p, v, __ATOMIC_RELAXED, __HIP_MEMORY_SCOPE_AGENT); }
__device__ __forceinline__ unsigned xb_xcc_id() { return (unsigned)__builtin_amdgcn_s_getreg((3 << 11) | 20) & 0xFu; }
#define XB_SPIN(cond, bar) do { unsigned _sp = 0; while (cond) { __builtin_amdgcn_s_sleep(1); \
    if ((++_sp & 255u) == 0u) { if (xb_ld(&(bar)[XB_TMO])) break; if (_sp > XB_SPIN_CAP) { atomicAdd(&(bar)[XB_TMO], 1u); break; } } } } while (0)
struct XcdBarrier { unsigned* bar; unsigned x; volatile LAS unsigned* st; };
__device__ __forceinline__ XcdBarrier xcd_barrier_post(unsigned* bar, volatile LAS unsigned* st) {
    XcdBarrier b; b.bar = bar; b.x = xb_xcc_id(); b.st = st;
    if (threadIdx.x == 0) (void)xb_add(&bar[XB_XCNT(b.x)], 1u);
    return b;
}
__device__ __forceinline__ void xcd_barrier_complete(unsigned* bar, unsigned x, unsigned& nloc, unsigned& nx) {
    const unsigned G = gridDim.x * gridDim.y * gridDim.z;
    unsigned sum, cnt, mine, sp = 0u;
    for (;;) {
        sum = 0u; cnt = 0u; mine = 0u;
#pragma unroll
        for (unsigned j = 0; j < 16; ++j) { const unsigned c = xb_ld(&bar[XB_XCNT(j)]); sum += c; cnt += (c > 0u) ? 1u : 0u; mine = (j == x) ? c : mine; }
        if (sum == G) break;
        __builtin_amdgcn_s_sleep(1);
        if ((++sp & 255u) == 0u) { if (xb_ld(&bar[XB_TMO])) break; if (sp > XB_SPIN_CAP) { atomicAdd(&bar[XB_TMO], 1u); break; } }
    }
    nloc = mine > 0u ? mine : 1u; nx = cnt > 0u ? cnt : 1u;
}
__device__ __forceinline__ void xcd_barrier(const XcdBarrier& b) {
    asm volatile("s_waitcnt vmcnt(0)" ::: "memory");
    __syncthreads();
    if (threadIdx.x == 0) {
        unsigned* bar = b.bar;
        __builtin_amdgcn_s_waitcnt(0);
        unsigned nloc = b.st[0], nx = b.st[1];
        if (nloc == 0u) { xcd_barrier_complete(bar, b.x, nloc, nx); b.st[0] = nloc; b.st[1] = nx; }
        const unsigned old = xb_add(&bar[XB_XSUB(b.x)], 1u);
        const unsigned gen = old / nloc;
        if (old + 1u == (gen + 1u) * nloc) {
            __builtin_amdgcn_fence(__ATOMIC_RELEASE, "agent");
            asm volatile("s_waitcnt vmcnt(0)" ::: "memory");
            const unsigned og = xb_add(&bar[XB_TOP], 1u);
            const unsigned tg = og / nx;
            if (og + 1u == (tg + 1u) * nx) xb_add(&bar[XB_TOPGEN], 1u);
            else XB_SPIN(xb_ld(&bar[XB_TOPGEN]) == tg, bar);
            __builtin_amdgcn_fence(__ATOMIC_ACQUIRE, "agent");
            xb_add(&bar[XB_XGEN(b.x)], 1u);
            asm volatile("s_waitcnt vmcnt(0)" ::: "memory");
        } else {
            XB_SPIN(xb_ld(&bar[XB_XGEN(b.x)]) == gen, bar);
            __builtin_amdgcn_fence(__ATOMIC_ACQUIRE, "agent");
            asm volatile("s_waitcnt vmcnt(0)" ::: "memory");
        }
    }
    __syncthreads();
}

constexpr int NWAVES = 8, NTHR = 512;
constexpr int RING_BYTES = 131072, MISC_OFF = 139264, LDS_BYTES = 147456;
struct Args {
    const float* in[28]; float* out; unsigned char* ws; int ph_lo, ph_hi;
};
struct Frame {
    LAS unsigned char* lds; int tid, lane, wave, G, bid;
    const float *x, *c, *ctx, *c_ctx, *w_mod, *b_mod, *n_mix_pre, *n_mix_post, *n_ffn_pre, *n_ffn_post, *w_in, *gdn_conv, *ret_log_decay, *gdn_a_log, *gdn_dt_bias,
        *ret_gn_w, *gdn_norm_w, *w_ret_out, *w_gdn_out, *w_o, *w_router, *router_bias, *w_gate, *w_up, *w_down, *w_sh_gate, *w_sh_up, *w_sh_down;
    float* out; unsigned char* ws; unsigned* ctl;
};
#define WSP(T, off) ((T*)(F.ws + (off)))

template <class CM>
__device__ __forceinline__ void transpose_item(const float* W, int ld, int K, bf16* WT, LAS float* scr, int kb, int nb, int lane, const CM& cm) {
    const int k0 = 64 * kb, n0 = 32 * nb; const int sc = cm(n0 + (lane & 31));
    float tv[32];
#pragma unroll
    for (int i = 0; i < 32; ++i) tv[i] = W[(size_t)(k0 + 2 * i + (lane >> 5)) * ld + sc];
#pragma unroll
    for (int i = 0; i < 32; ++i) scr[(2 * i + (lane >> 5)) * 33 + (lane & 31)] = tv[i];
    asm volatile("s_waitcnt lgkmcnt(0)" ::: "memory");
    const int c = lane & 7;
#pragma unroll
    for (int j = 0; j < 4; ++j) { const int n = (lane >> 3) + 8 * j; const LAS float* s = scr + (8 * c) * 33 + n;
        u32x4 o; o.x = pk2(s[0 * 33], s[1 * 33]); o.y = pk2(s[2 * 33], s[3 * 33]); o.z = pk2(s[4 * 33], s[5 * 33]); o.w = pk2(s[6 * 33], s[7 * 33]);
        *(u32x4*)(WT + (size_t)(n0 + n) * K + k0 + 8 * c) = o; }
    asm volatile("s_waitcnt lgkmcnt(0)" ::: "memory");
}
struct CmIdent { int off; __device__ __forceinline__ int operator()(int n) const { return n + off; } };
struct CmWin {
    __device__ __forceinline__ int operator()(int n) const {
        const int g = n >> 9; int src = n + (n >= 2048 ? 16 : 0);
        if (g == 0 || g == 4) { const int hb = n & ~127, cp = n & 127; const int wc = cp >> 5, fq = (cp >> 3) & 3, nn = (cp >> 2) & 1, i = cp & 3;
            const int d = 64 * nn + 16 * wc + 4 * fq + i; src = hb + d + (n >= 2048 ? 16 : 0); }
        return src; }
};
__device__ __forceinline__ void gu_decode(int cp, int& hid, int& isup) { const int pn = cp >> 8, r = cp & 255, bj = r >> 7, wc = (r >> 5) & 3, fq = (r >> 3) & 3, nn = (r >> 2) & 1, i = r & 3; hid = pn * 128 + bj * 64 + wc * 16 + fq * 4 + i; isup = nn; }

__device__ __forceinline__ void phase_prologue(Frame& F) {
    const int gw = F.bid * NWAVES + F.wave, NGW = F.G * NWAVES; const int gt = F.bid * NTHR + F.tid, NGT = F.G * NTHR;
    LAS float* scr = (LAS float*)(F.lds + F.wave * 16384);
    { float2* rt = WSP(float2, WS_ROPE);
      for (int idx = gt; idx < SEQ * 64; idx += NGT) { const int t = idx >> 6, j = idx & 63; const float pos = (float)(j < 32 ? (t >> 6) : (t & 63)); const int f = j & 31;
          const float inv = powf(10000.0f, -(float)f / 32.0f); const float ang = pos * inv; float sn, cs; sincosf(ang, &sn, &cs); rt[idx] = make_float2(cs, sn); } }
    {
        LAS float* red = (LAS float*)(F.lds);
        LAS float* sl = (LAS float*)(F.lds + 16384);
        if (F.bid < 96) { for (int i = F.tid; i < 5 * DM; i += NTHR) { const int r = i >> 10, k = i & 1023; sl[i] = siluf_(r < 4 ? F.c[r * DM + k] : F.c_ctx[k]); } __syncthreads(); }
        for (int it = F.bid; it < 96; it += F.G) {
            const int col = it * 64 + F.lane; float a[5] = {0.f, 0.f, 0.f, 0.f, 0.f};
            const int kb = F.wave * 128;
#pragma unroll 1
            for (int k0 = kb; k0 < kb + 128; k0 += 32) { float wv[32];
#pragma unroll
                for (int kk = 0; kk < 32; ++kk) wv[kk] = F.w_mod[(size_t)(k0 + kk) * 6144 + col];
#pragma unroll
                for (int kk = 0; kk < 32; ++kk) {
#pragma unroll
                    for (int r = 0; r < 5; ++r) a[r] += sl[r * DM + k0 + kk] * wv[kk]; } }
#pragma unroll
            for (int r = 0; r < 5; ++r) red[(F.wave * 5 + r) * 64 + F.lane] = a[r];
            __syncthreads();
            if (F.wave < 5) { float s = F.b_mod[col];
#pragma unroll
                for (int w = 0; w < 8; ++w) s += red[(w * 5 + F.wave) * 64 + F.lane];
                WSP(float, WS_MOD)[F.wave * 6144 + col] = s; }
            __syncthreads();
        }
    }
    {
        constexpr int I_IN = 16 * 192, I_RO = 8 * 32, I_O = 16 * 32; constexpr int NIT = I_IN + 2 * I_RO + I_O;
        for (int it = gw; it < NIT; it += NGW) { int r = it;
            if (r < I_IN) { transpose_item(F.w_in, N_IN, DM, WSP(bf16, WS_WIN), scr, r / 192, r % 192, F.lane, CmWin{}); continue; } r -= I_IN;
            if (r < I_RO) { transpose_item(F.w_ret_out, DM, 512, WSP(bf16, WS_WRO), scr, r / 32, r % 32, F.lane, CmIdent{0}); continue; } r -= I_RO;
            if (r < I_RO) { transpose_item(F.w_gdn_out, DM, 512, WSP(bf16, WS_WGO), scr, r / 32, r % 32, F.lane, CmIdent{0}); continue; } r -= I_RO;
            transpose_item(F.w_o, DM, DM, WSP(bf16, WS_WO), scr, r / 32, r % 32, F.lane, CmIdent{0}); }
    }
}

__device__ __forceinline__ void phase_moe_weights(Frame& F) {
    const int gw = F.bid * NWAVES + F.wave, NGW = F.G * NWAVES;
    LAS float* scr = (LAS float*)(F.lds + F.wave * 16384);
    constexpr int I_GU = 16 * 16  , I_D = 4 * 32;
    for (int it = gw; it < 65 * (I_GU + I_D); it += NGW) {
        const int e = it / (I_GU + I_D); int r = it % (I_GU + I_D);
        if (r < I_GU) {
            const int kb = r / 16, nb = r % 16;
            const int k0 = 64 * kb, n0 = 32 * nb; int hid, isup; gu_decode(n0 + (F.lane & 31), hid, isup);
            const float* Wg = e < 64 ? F.w_gate + (size_t)e * DM * DEXP : F.w_sh_gate; const float* Wu = e < 64 ? F.w_up + (size_t)e * DM * DEXP : F.w_sh_up;
            const float* W = isup ? Wu : Wg;
            float tv[32];
#pragma unroll
            for (int i = 0; i < 32; ++i) tv[i] = W[(size_t)(k0 + 2 * i + (F.lane >> 5)) * DEXP + hid];
#pragma unroll
            for (int i = 0; i < 32; ++i) scr[(2 * i + (F.lane >> 5)) * 33 + (F.lane & 31)] = tv[i];
            asm volatile("s_waitcnt lgkmcnt(0)" ::: "memory");
            const int c = F.lane & 7; bf16* WT = WSP(bf16, WS_WGU) + (size_t)e * 512 * DM;
#pragma unroll
            for (int j = 0; j < 4; ++j) { const int n = (F.lane >> 3) + 8 * j; const LAS float* s = scr + (8 * c) * 33 + n;
                u32x4 o; o.x = pk2(s[0 * 33], s[1 * 33]); o.y = pk2(s[2 * 33], s[3 * 33]); o.z = pk2(s[4 * 33], s[5 * 33]); o.w = pk2(s[6 * 33], s[7 * 33]);
                *(u32x4*)(WT + (size_t)(n0 + n) * DM + k0 + 8 * c) = o; }
            asm volatile("s_waitcnt lgkmcnt(0)" ::: "memory");
        } else { r -= I_GU;
            const float* W = e < 64 ? F.w_down + (size_t)e * DEXP * DM : F.w_sh_down;
            transpose_item(W, DM, DEXP, WSP(bf16, WS_WD) + (size_t)e * DM * DEXP, scr, r / 32, r % 32, F.lane, CmIdent{0}); }
    }
}

template <bool LAT> __device__ __forceinline__ int norm1_row_of(int i) { return LAT ? (i >> 12) * RPB + CTXL + (i & 4095) : i; }
template <bool LAT>
__device__ __forceinline__ void norm1_rows(Frame& F, LAS float* wl, int w0, int nw, int r_lo, int r_hi) {
    const float* mod = WSP(float, WS_MOD);
    int ri = r_lo + w0; if (ri >= r_hi) return;
    f32x4 vn[4];
    { const int row = norm1_row_of<LAT>(ri); const int b = row / RPB, pos = row % RPB; const float* src = pos < CTXL ? F.ctx + ((size_t)b * CTXL + pos) * DM : F.x + ((size_t)b * SEQ + (pos - CTXL)) * DM;
#pragma unroll
      for (int j = 0; j < 4; ++j) vn[j] = *(const f32x4*)(src + 4 * (F.lane + 64 * j)); }
    int pkey = -1; f32x4 pg[4], ps1[4], ps0[4];
    for (; ri < r_hi; ri += nw) {
        const int row = norm1_row_of<LAT>(ri); const int b = row / RPB, pos = row % RPB; const bool isctx = pos < CTXL;
        { const int key = isctx ? 4 : b;
          if (key != pkey) { pkey = key; const float* sh = mod + key * 6144; const float* sc = sh + DM;
#pragma unroll
              for (int j = 0; j < 4; ++j) { const int c0 = 4 * (F.lane + 64 * j); pg[j] = *(const f32x4*)(F.n_mix_pre + c0); ps1[j] = *(const f32x4*)(sc + c0) + 1.0f; ps0[j] = *(const f32x4*)(sh + c0); } } }
        f32x4 v[4]; float ss = 0.f;
#pragma unroll
        for (int j = 0; j < 4; ++j) { v[j] = vn[j]; ss += v[j].x * v[j].x + v[j].y * v[j].y + v[j].z * v[j].z + v[j].w * v[j].w; }
        { const int nri = ri + nw; if (nri < r_hi) { const int nr = norm1_row_of<LAT>(nri); const int nb = nr / RPB, np = nr % RPB; const float* src = np < CTXL ? F.ctx + ((size_t)nb * CTXL + np) * DM : F.x + ((size_t)nb * SEQ + (np - CTXL)) * DM;
#pragma unroll
            for (int j = 0; j < 4; ++j) vn[j] = *(const f32x4*)(src + 4 * (F.lane + 64 * j)); } }
        const float rstd = 1.0f / sqrtf(wave_sum(ss) * (1.f / DM) + EPS);
        f32x2 gp2[8];
#pragma unroll
        for (int p = 0; p < 8; ++p) gp2[p] = (f32x2){0.f, 0.f};
#pragma unroll
        for (int j = 0; j < 4; ++j) { const int c0 = 4 * (F.lane + 64 * j);
            const f32x4 g = pg[j], s1 = ps1[j], s0 = ps0[j];
            f32x4 h; h.x = v[j].x * rstd * g.x * s1.x + s0.x; h.y = v[j].y * rstd * g.y * s1.y + s0.y; h.z = v[j].z * rstd * g.z * s1.z + s0.z; h.w = v[j].w * rstd * g.w * s1.w + s0.w;
            u32x2 o; o.x = pk2(h.x, h.y); o.y = pk2(h.z, h.w);
            *(u32x2*)(WSP(bf16, WS_HX) + (size_t)row * DM + c0) = o;
#pragma unroll
            for (int ph = 0; ph < 2; ++ph) {
                asm volatile("" ::: "memory");
#pragma unroll
                for (int p = 4 * ph; p < 4 * ph + 4; ++p) { const LAS float* wp = wl + (p * DM + c0) * 2; const f32x4 wa = *(const LAS f32x4*)wp, wb = *(const LAS f32x4*)(wp + 4);
                    gp2[p] += (f32x2){wa.x, wa.y} * h.x; gp2[p] += (f32x2){wa.z, wa.w} * h.y; gp2[p] += (f32x2){wb.x, wb.y} * h.z; gp2[p] += (f32x2){wb.z, wb.w} * h.w; } } }
        float gd[16];
#pragma unroll
        for (int p = 0; p < 8; ++p) { gd[2 * p] = gp2[p].x; gd[2 * p + 1] = gp2[p].y; }
        float g8[8], g4[4], g2[2], mine;
        { const bool b0 = F.lane & 1, b1 = F.lane & 2, b2 = F.lane & 4, b3 = F.lane & 8;
#pragma unroll
          for (int i = 0; i < 8; ++i) { const float snd = b0 ? gd[2 * i] : gd[2 * i + 1], kp = b0 ? gd[2 * i + 1] : gd[2 * i]; g8[i] = kp + __shfl_xor(snd, 1); }
#pragma unroll
          for (int i = 0; i < 4; ++i) { const float snd = b1 ? g8[2 * i] : g8[2 * i + 1], kp = b1 ? g8[2 * i + 1] : g8[2 * i]; g4[i] = kp + __shfl_xor(snd, 2); }
#pragma unroll
          for (int i = 0; i < 2; ++i) { const float snd = b2 ? g4[2 * i] : g4[2 * i + 1], kp = b2 ? g4[2 * i + 1] : g4[2 * i]; g2[i] = kp + __shfl_xor(snd, 4); }
          { const float snd = b3 ? g2[0] : g2[1], kp = b3 ? g2[1] : g2[0]; mine = kp + __shfl_xor(snd, 8); }
          mine += __shfl_xor(mine, 16); mine += __shfl_xor(mine, 32); }
        if (F.lane < 16) { const int ab = F.lane >> 3, dir = (F.lane >> 2) & 1, h = F.lane & 3; const size_t o = ((size_t)(dir * NB + b) * NH + h) * RPB + pos;
            if (ab == 0) { const float z = mine + F.gdn_dt_bias[dir * 4 + h]; const float sp = z > 20.f ? z : log1pf(expf(z)); WSP(float, WS_LOGA)[o] = -expf(F.gdn_a_log[dir * 4 + h]) * sp; }
            else WSP(float, WS_BETA)[o] = 1.f / (1.f + expf(-mine)); }
    }
}
__device__ __forceinline__ void phase_norm1(Frame& F) {
    const int gw = F.bid * NWAVES + F.wave, NGW = F.G * NWAVES;
    LAS float* wl = (LAS float*)F.lds;
    for (int k = F.tid; k < DM; k += NTHR) { const float* wr = F.w_in + (size_t)k * N_IN + 2048;
#pragma unroll
        for (int jj = 0; jj < 4; ++jj) { const f32x4 w4 = *(const f32x4*)(wr + 4 * jj);
            *(LAS f32x2*)(wl + ((2 * jj) * DM + k) * 2) = (f32x2){w4.x, w4.y}; *(LAS f32x2*)(wl + ((2 * jj + 1) * DM + k) * 2) = (f32x2){w4.z, w4.w}; } }
    __syncthreads();
    if (F.G < 64) { norm1_rows<false>(F, wl, gw, NGW, 0, NROW); return; }
    if (F.bid < 32) {
        const int b = F.bid >> 3, sub = F.bid & 7; const int r0 = b * RPB + 32 * sub;
        norm1_rows<false>(F, wl, F.wave, NWAVES, r0, r0 + 32);
        asm volatile("s_waitcnt vmcnt(0)" ::: "memory");
        __syncthreads();
        if (F.tid == 0) {
            unsigned* flag = F.ctl + CW_FLAG + 64 * b;
            __builtin_amdgcn_fence(__ATOMIC_RELEASE, "agent"); asm volatile("s_waitcnt vmcnt(0)" ::: "memory");
            __hip_atomic_fetch_add(flag, 1u, __ATOMIC_RELAXED, __HIP_MEMORY_SCOPE_AGENT);
            unsigned sp = 0; while (__hip_atomic_load(flag, __ATOMIC_RELAXED, __HIP_MEMORY_SCOPE_AGENT) < 8u) { __builtin_amdgcn_s_sleep(1); if (++sp > (1u << 22)) break; }
            __builtin_amdgcn_fence(__ATOMIC_ACQUIRE, "agent"); asm volatile("s_waitcnt vmcnt(0)" ::: "memory");
        }
        __syncthreads();
    } else {
        norm1_rows<true>(F, wl, (F.bid - 32) * NWAVES + F.wave, (F.G - 32) * NWAVES, 0, NT);
    }
}

struct SchedIn {
    const char* A; const char* B; int G, c;
    __device__ __forceinline__ bool next(int i, pg8::Unit& u) const {
        const int L = i * G + c; if (L >= (G < 64 ? 1536 + 32 : 1536)) return false;
        int lt, pn;
        if (L < 1536) { int wgid = L; { const int q = 1536 / 8, xcd = wgid % 8, off = wgid / 8; wgid = xcd * q + off; }
            const int nig = 8 * 24, gid = wgid / nig, fm = gid * 8; lt = fm + ((wgid % nig) % 8); pn = (wgid % nig) / 8; u.pm = (lt >> 4) * 17 + 1 + (lt & 15); }
        else { const int q = L - 1536; u.pm = (q >> 3) * 17; pn = q & 7; }
        u.pn = pn; u.e = 0; u.base = 0; u.A = A + (size_t)u.pm * 256 * DM * 2; u.B = B + (size_t)pn * 256 * DM * 2; return true; }
    __device__ __forceinline__ int row_index(const pg8::Unit&, int r) const { return r; }
};
struct SchedCtx {
    const char* A; const char* B; int b, pn;
    __device__ __forceinline__ bool next(int i, pg8::Unit& u) const { if (i > 0) return false; u.pm = b * 17; u.pn = pn; u.e = 0; u.base = 0; u.A = A + (size_t)u.pm * 256 * DM * 2; u.B = B + (size_t)pn * 256 * DM * 2; return true; }
    __device__ __forceinline__ int row_index(const pg8::Unit&, int r) const { return r; }
};
struct EpiIn {
    bf16* P; bf16* GATES; const float2* rope;
    __device__ __forceinline__ void operator()(const f32x4 (&acc)[2][2][4][2], const pg8::Unit& u, int wr, int wc, int fr, int fq) const {
        const int g = u.pn >> 1;
        const int b = u.pm / 17, tl = u.pm % 17;
#pragma unroll
        for (int ai = 0; ai < 2; ++ai)
#pragma unroll
            for (int m = 0; m < 4; ++m) {
                const int rt = ai * 128 + wr * 64 + m * 16 + fr; const size_t prow = (size_t)u.pm * 256 + rt;
#pragma unroll
                for (int bj = 0; bj < 2; ++bj) {
                    f32x4 v0 = acc[ai][bj][m][0], v1 = acc[ai][bj][m][1];
                    const int ct = bj * 128 + wc * 32 + 8 * fq;
                    if (g == 0 || g == 4) {
                        const float s = (g == 0) ? 0.08838834764831845f : 1.0f; v0 = v0 * s; v1 = v1 * s;
                        const int j = 16 * wc + 4 * fq;
                        f32x4 o1 = v0, o2 = v1;
                        if (tl != 0) { const int t = (tl - 1) * 256 + rt; const float2* cs = rope + (size_t)t * 64 + j;
#pragma unroll
                            for (int i = 0; i < 4; ++i) { const float2 c2 = cs[i]; o1[i] = v0[i] * c2.x - v1[i] * c2.y; o2[i] = v0[i] * c2.y + v1[i] * c2.x; } }
                        bf16* dst = P + (size_t)g * PGRP + prow * 512 + (u.pn & 1) * 256 + bj * 128 + j;
                        u32x2 w1, w2; w1.x = pk2(o1[0], o1[1]); w1.y = pk2(o1[2], o1[3]); w2.x = pk2(o2[0], o2[1]); w2.y = pk2(o2[2], o2[3]);
                        *(u32x2*)dst = w1; *(u32x2*)(dst + 64) = w2;
                    } else if (g < 8) {
                        u32x4 w; w.x = pk2(v0[0], v0[1]); w.y = pk2(v0[2], v0[3]); w.z = pk2(v1[0], v1[1]); w.w = pk2(v1[2], v1[3]);
                        *(u32x4*)(P + (size_t)g * PGRP + prow * 512 + (u.pn & 1) * 256 + ct) = w;
                    } else {
                        const size_t lrow = (size_t)b * SEQ + (size_t)(tl - 1) * 256 + rt;
#pragma unroll
                        for (int i = 0; i < 4; ++i) { v0[i] = sigmoidf_(v0[i]); v1[i] = sigmoidf_(v1[i]); }
                        u32x4 w; w.x = pk2(v0[0], v0[1]); w.y = pk2(v0[2], v0[3]); w.z = pk2(v1[0], v1[1]); w.w = pk2(v1[2], v1[3]);
                        *(u32x4*)(GATES + lrow * 2048 + (u.pn - 16) * 256 + ct) = w;
                    }
                }
            }
    }
};

constexpr int IMGB = 34816, IMGS = 272;
typedef short s16x4 __attribute__((ext_vector_type(4)));
__device__ __forceinline__ unsigned offb(unsigned row, unsigned ch) { return 272u * row + 16u * ch; }
__device__ __forceinline__ unsigned offe(unsigned row, unsigned col) { return 272u * row + 2u * col; }
__device__ __forceinline__ bf16x8 frag_row(LAS unsigned char* img, int tile, int s, int lane) { return *(const LAS bf16x8*)(img + offb(16 * tile + (lane & 15), 4 * s + (lane >> 4))); }
__device__ __forceinline__ bf16x8 frag_tr(LAS unsigned char* img, int tile, int s, int lane) {
    const unsigned g = lane >> 4, qq = (lane & 15) >> 2, p = lane & 3;
    const s16x4 lo = __builtin_amdgcn_ds_read_tr16_b64_v4i16((LAS s16x4*)(img + offe(32 * s + 8 * g + qq, 16 * tile + 4 * p)));
    const s16x4 hi = __builtin_amdgcn_ds_read_tr16_b64_v4i16((LAS s16x4*)(img + offe(32 * s + 8 * g + 4 + qq, 16 * tile + 4 * p)));
    return (bf16x8){lo[0], lo[1], lo[2], lo[3], hi[0], hi[1], hi[2], hi[3]};
}
#define MFMA16(a, b, c) __builtin_amdgcn_mfma_f32_16x16x32_bf16(a, b, c, 0, 0, 0)
#define LBAR() do { asm volatile("s_waitcnt lgkmcnt(0)" ::: "memory"); __builtin_amdgcn_s_barrier(); asm volatile("" ::: "memory"); } while (0)
template <bool SWAP>
__device__ __forceinline__ void mm128(LAS unsigned char* ia, bool atr, LAS unsigned char* ib, bool btr, int wr, int wc, int lane, f32x4 (&acc)[2][4]) {
#pragma unroll
    for (int s = 0; s < 4; ++s) {
        bf16x8 fa[2], fb[4];
#pragma unroll
        for (int i = 0; i < 2; ++i) fa[i] = atr ? frag_tr(ia, 2 * wr + i, s, lane) : frag_row(ia, 2 * wr + i, s, lane);
#pragma unroll
        for (int j = 0; j < 4; ++j) fb[j] = btr ? frag_tr(ib, 4 * wc + j, s, lane) : frag_row(ib, 4 * wc + j, s, lane);
#pragma unroll
        for (int i = 0; i < 2; ++i)
#pragma unroll
            for (int j = 0; j < 4; ++j) acc[i][j] = SWAP ? MFMA16(fb[j], fa[i], acc[i][j]) : MFMA16(fa[i], fb[j], acc[i][j]);
    }
}
__device__ __forceinline__ void zero_acc(f32x4 (&acc)[2][4]) {
#pragma unroll
    for (int i = 0; i < 2; ++i)
#pragma unroll
        for (int j = 0; j < 4; ++j) acc[i][j] = (f32x4){0.f, 0.f, 0.f, 0.f};
}
__device__ __forceinline__ void st_img(LAS unsigned char* img, const f32x4 (&acc)[2][4], int wr, int wc, int lane) {
    const int r = lane & 15, q = lane >> 4;
#pragma unroll
    for (int i = 0; i < 2; ++i)
#pragma unroll
        for (int j = 0; j < 4; ++j) { u32x2 w; w.x = pk2(acc[i][j][0], acc[i][j][1]); w.y = pk2(acc[i][j][2], acc[i][j][3]);
            *(LAS u32x2*)(img + offe(32 * wr + 16 * i + r, 64 * wc + 16 * j + 4 * q)) = w; }
}
__device__ __forceinline__ void load_plain_img(LAS unsigned char* img, const bf16* src, int ld, int tid) {
#pragma unroll
    for (int i = 0; i < 4; ++i) { const int cidx = tid + 512 * i, row = cidx >> 4, ch = cidx & 15;
        *(LAS u32x4*)(img + offb(row, ch)) = *(const u32x4*)(src + (size_t)row * ld + 8 * ch); }
}
__device__ __forceinline__ void load_conv_img(LAS unsigned char* img, const bf16* src, const float* cw  , bool has_prev, bool has_next, int mode  , int wave, int lane) {
    asm volatile("" ::: "memory");
    const int ch = lane & 15; float w0[8], w1[8], w2[8];
#pragma unroll
    for (int i = 0; i < 8; ++i) { w0[i] = cw[8 * ch + i]; w1[i] = cw[1536 + 8 * ch + i]; w2[i] = cw[3072 + 8 * ch + i]; }
#pragma unroll
    for (int it = 0; it < 4; ++it) {
        const int row = 32 * it + 4 * wave + (lane >> 4); const u32x4 z4 = {0u, 0u, 0u, 0u};
        const u32x4 r0 = (row > 0 || has_prev) ? *(const u32x4*)(src + ((ptrdiff_t)row - 1) * 512 + 8 * ch) : z4;
        const u32x4 r1 = *(const u32x4*)(src + (size_t)row * 512 + 8 * ch);
        const u32x4 r2 = (row < 127 || has_next) ? *(const u32x4*)(src + (size_t)(row + 1) * 512 + 8 * ch) : z4;
        float a0[8], a1[8], a2[8], y[8]; unpack8(r0, a0); unpack8(r1, a1); unpack8(r2, a2); float ss = 0.f;
#pragma unroll
        for (int i = 0; i < 8; ++i) { y[i] = siluf_(w0[i] * a0[i] + w1[i] * a1[i] + w2[i] * a2[i]); ss += y[i] * y[i]; }
        if (mode != 1) { const float sc = (1.0f / sqrtf(sum16(ss) + EPS)) * (mode == 2 ? 0.08838834764831845f : 1.0f);
#pragma unroll
            for (int i = 0; i < 8; ++i) y[i] *= sc; }
        *(LAS u32x4*)(img + offb(row, ch)) = pack8(y);
    }
}
__device__ __forceinline__ void load_conv_img2(LAS unsigned char* imgA, const bf16* srcA, const float* cwA, int ma, LAS unsigned char* imgB, const bf16* srcB, const float* cwB, int mb, bool has_prev, bool has_next, int wave, int lane) {
    asm volatile("" ::: "memory");
    const int ch = lane & 15; float wa0[8], wa1[8], wa2[8], wb0[8], wb1[8], wb2[8];
#pragma unroll
    for (int i = 0; i < 8; ++i) { wa0[i] = cwA[8 * ch + i]; wa1[i] = cwA[1536 + 8 * ch + i]; wa2[i] = cwA[3072 + 8 * ch + i]; wb0[i] = cwB[8 * ch + i]; wb1[i] = cwB[1536 + 8 * ch + i]; wb2[i] = cwB[3072 + 8 * ch + i]; }
#pragma unroll
    for (int it = 0; it < 4; ++it) {
        const int row = 32 * it + 4 * wave + (lane >> 4); const u32x4 z4 = {0u, 0u, 0u, 0u}; const bool hp = (row > 0 || has_prev), hn = (row < 127 || has_next);
        const u32x4 a0 = hp ? *(const u32x4*)(srcA + ((ptrdiff_t)row - 1) * 512 + 8 * ch) : z4, a1 = *(const u32x4*)(srcA + (size_t)row * 512 + 8 * ch), a2 = hn ? *(const u32x4*)(srcA + (size_t)(row + 1) * 512 + 8 * ch) : z4;
        const u32x4 b0 = hp ? *(const u32x4*)(srcB + ((ptrdiff_t)row - 1) * 512 + 8 * ch) : z4, b1 = *(const u32x4*)(srcB + (size_t)row * 512 + 8 * ch), b2 = hn ? *(const u32x4*)(srcB + (size_t)(row + 1) * 512 + 8 * ch) : z4;
        { float x0[8], x1[8], x2[8], y[8]; unpack8(a0, x0); unpack8(a1, x1); unpack8(a2, x2); float ss = 0.f;
#pragma unroll
          for (int i = 0; i < 8; ++i) { y[i] = siluf_(wa0[i] * x0[i] + wa1[i] * x1[i] + wa2[i] * x2[i]); ss += y[i] * y[i]; }
          if (ma != 1) { const float sc = (1.0f / sqrtf(sum16(ss) + EPS)) * (ma == 2 ? 0.08838834764831845f : 1.0f);
#pragma unroll
              for (int i = 0; i < 8; ++i) y[i] *= sc; }
          *(LAS u32x4*)(imgA + offb(row, ch)) = pack8(y); }
        { float x0[8], x1[8], x2[8], y[8]; unpack8(b0, x0); unpack8(b1, x1); unpack8(b2, x2); float ss = 0.f;
#pragma unroll
          for (int i = 0; i < 8; ++i) { y[i] = siluf_(wb0[i] * x0[i] + wb1[i] * x1[i] + wb2[i] * x2[i]); ss += y[i] * y[i]; }
          if (mb != 1) { const float sc = (1.0f / sqrtf(sum16(ss) + EPS)) * (mb == 2 ? 0.08838834764831845f : 1.0f);
#pragma unroll
              for (int i = 0; i < 8; ++i) y[i] *= sc; }
          *(LAS u32x4*)(imgB + offb(row, ch)) = pack8(y); }
    }
}
__device__ __forceinline__ void scale_rows_img(LAS unsigned char* dst, LAS unsigned char* src, const LAS float* rs, int tid) {
#pragma unroll
    for (int i = 0; i < 4; ++i) { const int cidx = tid + 512 * i, row = cidx >> 4, ch = cidx & 15; float v[8]; unpack8(*(const LAS u32x4*)(src + offb(row, ch)), v); const float sc = rs[row];
#pragma unroll
        for (int e = 0; e < 8; ++e) v[e] *= sc;
        *(LAS u32x4*)(dst + offb(row, ch)) = pack8(v); }
}
__device__ __forceinline__ void tri_inverse(LAS unsigned char* img, int w, int lane) {
    const int r = lane & 15, q = lane >> 4;
    {
        const int b0 = 16 * w; float x[16];
#pragma unroll
        for (int i = 0; i < 16; ++i) { float v = (i == r) ? 1.f : 0.f;
#pragma unroll
            for (int j = 0; j < i; ++j) v -= bf2f(*(const LAS unsigned short*)(img + offe(b0 + i, b0 + j))) * x[j];
            x[i] = v; }
        if (q == 0) {
#pragma unroll
            for (int i = 0; i < 16; ++i) *(LAS unsigned short*)(img + offe(b0 + i, b0 + r)) = (unsigned short)f2bf(x[i]); }
    }
    LBAR();
    if (w < 4) {
        const int c0 = 32 * w, r1 = c0 + 16;
        const u32x2 av = *(const LAS u32x2*)(img + offe(r1 + r, c0 + 4 * q));
        const bf16x8 fa = __builtin_bit_cast(bf16x8, (u32x4){av.x, av.y, 0u, 0u});
        const s16x4 tb = __builtin_amdgcn_ds_read_tr16_b64_v4i16((LAS s16x4*)(img + offe(c0 + 4 * q + (r >> 2), c0 + 4 * (r & 3))));
        const bf16x8 fb = (bf16x8){tb[0], tb[1], tb[2], tb[3], 0, 0, 0, 0};
        const f32x4 y = MFMA16(fa, fb, ((f32x4){0.f, 0.f, 0.f, 0.f}));
        const bf16x8 fy = __builtin_bit_cast(bf16x8, (u32x4){pk2(y[0], y[1]), pk2(y[2], y[3]), 0u, 0u});
        const u32x2 tv = *(const LAS u32x2*)(img + offe(r1 + r, r1 + 4 * q));
        const bf16x8 ft = __builtin_bit_cast(bf16x8, (u32x4){tv.x, tv.y, 0u, 0u});
        const f32x4 d = MFMA16(fy, ft, ((f32x4){0.f, 0.f, 0.f, 0.f}));
        u32x2 o; o.x = pk2(-d[0], -d[1]); o.y = pk2(-d[2], -d[3]);
        *(LAS u32x2*)(img + offe(r1 + r, c0 + 4 * q)) = o;
    }
    LBAR();
    {
        const int p = w >> 2, ti = (w >> 1) & 1, tj = w & 1, base = 64 * p, rb = base + 32;
        f32x4 y[2];
        const unsigned g = lane >> 4, qq = (lane & 15) >> 2, pp = lane & 3;
        const s16x4 lo = __builtin_amdgcn_ds_read_tr16_b64_v4i16((LAS s16x4*)(img + offe(base + 8 * g + qq, base + 16 * tj + 4 * pp)));
        const s16x4 hi = __builtin_amdgcn_ds_read_tr16_b64_v4i16((LAS s16x4*)(img + offe(base + 8 * g + 4 + qq, base + 16 * tj + 4 * pp)));
        const bf16x8 fb = (bf16x8){lo[0], lo[1], lo[2], lo[3], hi[0], hi[1], hi[2], hi[3]};
#pragma unroll
        for (int kt = 0; kt < 2; ++kt) { const bf16x8 fa = *(const LAS bf16x8*)(img + offb(rb + 16 * kt + r, (base >> 3) + q)); y[kt] = MFMA16(fa, fb, ((f32x4){0.f, 0.f, 0.f, 0.f})); }
        const bf16x8 fy = __builtin_bit_cast(bf16x8, (u32x4){pk2(y[0][0], y[0][1]), pk2(y[0][2], y[0][3]), pk2(y[1][0], y[1][1]), pk2(y[1][2], y[1][3])});
        const u32x2 t0 = *(const LAS u32x2*)(img + offe(rb + 16 * ti + r, rb + 4 * q)), t1 = *(const LAS u32x2*)(img + offe(rb + 16 * ti + r, rb + 16 + 4 * q));
        const bf16x8 ft = __builtin_bit_cast(bf16x8, (u32x4){t0.x, t0.y, t1.x, t1.y});
        const f32x4 d = MFMA16(fy, ft, ((f32x4){0.f, 0.f, 0.f, 0.f}));
        LBAR();
        u32x2 o; o.x = pk2(-d[0], -d[1]); o.y = pk2(-d[2], -d[3]);
        *(LAS u32x2*)(img + offe(rb + 16 * ti + r, base + 16 * tj + 4 * q)) = o;
    }
    LBAR();
    {
        const int tj = w >> 1, ti0 = 2 * (w & 1);
        f32x4 y[4];
#pragma unroll
        for (int kt = 0; kt < 4; ++kt) y[kt] = (f32x4){0.f, 0.f, 0.f, 0.f};
#pragma unroll
        for (int s = 0; s < 2; ++s) { const bf16x8 fb = frag_tr(img, tj, s, lane);
#pragma unroll
            for (int kt = 0; kt < 4; ++kt) y[kt] = MFMA16(frag_row(img, 4 + kt, s, lane), fb, y[kt]); }
        f32x4 d[2];
#pragma unroll
        for (int i = 0; i < 2; ++i) { d[i] = (f32x4){0.f, 0.f, 0.f, 0.f};
#pragma unroll
            for (int ks = 0; ks < 2; ++ks) {
                const bf16x8 fy = __builtin_bit_cast(bf16x8, (u32x4){pk2(y[2 * ks][0], y[2 * ks][1]), pk2(y[2 * ks][2], y[2 * ks][3]), pk2(y[2 * ks + 1][0], y[2 * ks + 1][1]), pk2(y[2 * ks + 1][2], y[2 * ks + 1][3])});
                const int row = 64 + 16 * (ti0 + i) + r;
                const u32x2 t0 = *(const LAS u32x2*)(img + offe(row, 64 + 32 * ks + 4 * q)), t1 = *(const LAS u32x2*)(img + offe(row, 64 + 32 * ks + 16 + 4 * q));
                d[i] = MFMA16(fy, __builtin_bit_cast(bf16x8, (u32x4){t0.x, t0.y, t1.x, t1.y}), d[i]); } }
        LBAR();
#pragma unroll
        for (int i = 0; i < 2; ++i) { u32x2 o; o.x = pk2(-d[i][0], -d[i][1]); o.y = pk2(-d[i][2], -d[i][3]);
            *(LAS u32x2*)(img + offe(64 + 16 * (ti0 + i) + r, 16 * tj + 4 * q)) = o; }
    }
    LBAR();
}

__device__ __forceinline__ void phase_prep(Frame& F) {
    LAS unsigned char* I0 = F.lds; LAS unsigned char* I1 = F.lds + IMGB; LAS unsigned char* I2 = F.lds + 2 * IMGB; LAS unsigned char* I3 = F.lds + 3 * IMGB;
    LAS float* sm = (LAS float*)(F.lds + MISC_OFF + 1024);
    LAS float* s_t1 = sm; LAS float* s_t2 = sm + 128; LAS float* sdir = sm + 256;
#define LAUNDER() int tz_ = threadIdx.x; asm volatile("" : "+v"(tz_)); const int tid = tz_, lane = tz_ & 63, w = __builtin_amdgcn_readfirstlane(tz_ >> 6), wr = w >> 1, wc = w & 1, r = lane & 15, q = lane >> 4; (void)tid; (void)lane; (void)w; (void)wr; (void)wc; (void)r; (void)q
    const bf16* P = WSP(bf16, WS_P);
    for (int it = F.bid; it < 512 + 96; it += F.G) {
        int b, h, m, part = 3;
        if (it < 512) { b = it >> 7; h = (it >> 5) & 3; m = 2 + (it & 31); } else { const int c3 = it - 512; const int c = c3 / 3; part = c3 - 3 * c; b = c >> 3; h = (c >> 1) & 3; m = c & 1; }
        const bool isctx = m < 2; const int pos0 = 128 * m; const size_t row0 = (size_t)b * RPB + pos0; const size_t trow0 = (size_t)b * SEQ + (pos0 - CTXL);
        const bool hprev = isctx ? (m > 0) : (m > 2), hnext = isctx ? (m < 1) : (m < NCHUNK - 1);
        const size_t hoff = row0 * 512 + h * 128;
        f32x4 acc[2][4];
        if (part == 3 || part == 0) {
        const float lgf = F.ret_log_decay[h] * 1.4426950408889634f, lgb = F.ret_log_decay[4 + h] * 1.4426950408889634f;
        { LAUNDER();
        load_plain_img(I0, P + 0 * PGRP + hoff, 512, tid); load_plain_img(I1, P + 1 * PGRP + hoff, 512, tid);
        if (!isctx) load_plain_img(I2, P + 4 * PGRP + hoff, 512, tid);
        if (tid < 128) { s_t1[tid] = exp2f(lgf * (float)(127 - tid)); s_t2[tid] = exp2f(lgb * (float)tid); } }
        LBAR();
        if (!isctx) {
            { LAUNDER();
            zero_acc(acc); mm128<true>(I2, false, I0, false, wr, wc, lane, acc);
#pragma unroll
            for (int i = 0; i < 2; ++i)
#pragma unroll
                for (int j = 0; j < 4; ++j)
#pragma unroll
                    for (int e = 0; e < 4; ++e) { const int ii = 32 * wr + 16 * i + r, jj = 64 * wc + 16 * j + 4 * q + e; const int d = ii - jj;
                        const float wg = (d >= 0 ? exp2f(lgf * (float)d) : 0.f) + (d <= 0 ? exp2f(lgb * (float)(-d)) : 0.f); acc[i][j][e] *= wg; }
            st_img(I3, acc, wr, wc, lane); }
            LBAR();
            { LAUNDER();
            zero_acc(acc); mm128<true>(I3, false, I1, true, wr, wc, lane, acc);
            bf16* og = WSP(bf16, WS_ORET) + (trow0 + 32 * wr + r) * 512 + h * 128 + 64 * wc + 4 * q;
#pragma unroll
            for (int i = 0; i < 2; ++i)
#pragma unroll
                for (int j = 0; j < 4; ++j) { u32x2 o; o.x = pk2(acc[i][j][0], acc[i][j][1]); o.y = pk2(acc[i][j][2], acc[i][j][3]); *(u32x2*)(og + (size_t)(16 * i) * 512 + 16 * j) = o; } }
        }
#pragma unroll 1
        for (int dir = 0; dir < 2; ++dir) {
            LAS unsigned char* kw = dir ? I3 : I2;
            { LAUNDER(); scale_rows_img(kw, I0, dir ? s_t2 : s_t1, tid); }
            LBAR();
            LAUNDER();
            zero_acc(acc); mm128<false>(kw, true, I1, true, wr, wc, lane, acc);
            const int chain = (b * NH + h) * 2 + dir, n = dir ? (isctx ? 1 - m : 35 - m) : m;
            unsigned char* kv = F.ws + WS_GKV + ((size_t)chain * NCHUNK + n) * 32768;
#pragma unroll
            for (int i = 0; i < 2; ++i)
#pragma unroll
                for (int j = 0; j < 4; ++j) { const int mt = 2 * wr + i, nt = 4 * wc + j; u32x2 o; o.x = pk2(acc[i][j][0], acc[i][j][1]); o.y = pk2(acc[i][j][2], acc[i][j][3]);
                    *(u32x2*)(kv + ((size_t)((nt * 4 + (mt >> 1)) * 64 + (2 * (mt & 1) + (q >> 1)) * 16 + r)) * 16 + 8 * (q & 1)) = o; }
        }
        LBAR();
        }
        if (part != 0) {
        const bool hasq = !isctx;
        f32x4 gacc[2][4], qk[2][4]; u32x2 qv[2][4];
        if (hasq) { LAUNDER(); load_conv_img2(I0, P + 2 * PGRP + hoff, F.gdn_conv + 512 + h * 128, 0, I1, P + 6 * PGRP + hoff, F.gdn_conv + h * 128, 2, hprev, hnext, w, lane); }
        else { LAUNDER(); load_conv_img(I0, P + 2 * PGRP + hoff, F.gdn_conv + 512 + h * 128, hprev, hnext, 0, w, lane); }
        { LAUNDER(); if (tid < 256) { const int d2 = tid >> 7, i2 = tid & 127; const size_t o = ((size_t)(d2 * NB + b) * NH + h) * RPB + pos0 + i2; sdir[d2 * 640 + i2] = WSP(float, WS_LOGA)[o]; sdir[d2 * 640 + 128 + i2] = WSP(float, WS_BETA)[o]; } }
        LBAR();
        { LAUNDER();
          if (w < 2) {
              LAS float* sd = sdir + w * 640;
              const float a = sd[2 * lane], c = sd[2 * lane + 1]; const float pr = a + c; float inc = pr;
#pragma unroll
              for (int o = 1; o < 64; o <<= 1) { const float t = __shfl_up(inc, o); if (lane >= o) inc += t; }
              const float tot = __shfl(inc, 63); const float ex = inc - pr;
              float g0 = ex + a, g1 = ex + pr;
              if (w) { g0 = tot - ex; g1 = tot - (ex + a); }
              sd[256 + 2 * lane] = g0; sd[256 + 2 * lane + 1] = g1; sd[384 + 2 * lane] = __expf(g0); sd[384 + 2 * lane + 1] = __expf(g1);
              sd[512 + 2 * lane] = __expf(tot - g0); sd[512 + 2 * lane + 1] = __expf(tot - g1);
              asm volatile("s_waitcnt lgkmcnt(0)" ::: "memory");
              if (lane == 0) sd[0] = __expf(tot);
          }
          zero_acc(gacc); mm128<true>(I0, false, I0, false, wr, wc, lane, gacc);
          if (hasq) { zero_acc(qk); mm128<true>(I1, false, I0, false, wr, wc, lane, qk);
#pragma unroll
              for (int i = 0; i < 2; ++i)
#pragma unroll
                  for (int j = 0; j < 4; ++j) qv[i][j] = *(const LAS u32x2*)(I1 + offe(32 * wr + 16 * i + r, 64 * wc + 16 * j + 4 * q)); } }
        LBAR();
#pragma unroll 1
        for (int dir = (part == 2 ? 1 : 0); dir < (part == 3 ? 2 : part); ++dir) {
            const int chain = (b * NH + h) * 2 + dir, n = dir ? (isctx ? 1 - m : 35 - m) : m;
            { LAUNDER(); load_conv_img(I1, P + 3 * PGRP + hoff, F.gdn_conv + 1024 + h * 128, hprev, hnext, 1, w, lane); }
            LAS float* s_bet = sdir + dir * 640 + 128; LAS float* s_gc = sdir + dir * 640 + 256; LAS float* s_eg = sdir + dir * 640 + 384; LAS float* s_s2 = sdir + dir * 640 + 512;
            LBAR();
            { LAUNDER();
#pragma unroll
            for (int i = 0; i < 2; ++i)
#pragma unroll
                for (int j = 0; j < 4; ++j) { const int ii = 32 * wr + 16 * i + r; const float gi = s_gc[ii], bi = s_bet[ii];
#pragma unroll
                    for (int e = 0; e < 4; ++e) { const int jj = 64 * wc + 16 * j + 4 * q + e;
                        const float f = dir ? s_bet[jj] * __expf(s_gc[jj] - gi) : bi * __expf(gi - s_gc[jj]); acc[i][j][e] = (ii > jj) ? gacc[i][j][e] * f : 0.f; } }
            st_img(I2, acc, wr, wc, lane); }
            LBAR();
            { LAUNDER(); tri_inverse(I2, w, lane); }
            { LAUNDER();
#pragma unroll
            for (int i = 0; i < 4; ++i) { const int cidx = tid + 512 * i, row = cidx >> 4, ch = cidx & 15; float v[8], v2[8]; unpack8(*(const LAS u32x4*)(I2 + offb(row, ch)), v);
#pragma unroll
                for (int e = 0; e < 8; ++e) { const int k = dir ? row : 8 * ch + e; const float bb = s_bet[k]; v[e] *= bb; v2[e] = v[e] * s_eg[k]; }
                *(LAS u32x4*)(I2 + offb(row, ch)) = pack8(v); *(LAS u32x4*)(I3 + offb(row, ch)) = pack8(v2); } }
            LBAR();
            { LAUNDER();
            zero_acc(acc); mm128<true>(I3, dir != 0, I0, true, wr, wc, lane, acc);
            LBAR();
            st_img(I3, acc, wr, wc, lane); }
            { LAUNDER();
            zero_acc(acc); mm128<true>(I2, dir != 0, I1, true, wr, wc, lane, acc);
            LBAR();
            st_img(I2, acc, wr, wc, lane);
            scale_rows_img(I1, I0, s_s2, tid); }
            LBAR();
            {
                LAUNDER();
                zero_acc(acc); mm128<false>(I1, true, I2, true, wr, wc, lane, acc);
                unsigned char* gc = F.ws + WS_GC + ((size_t)chain * NCHUNK + n) * 32768;
#pragma unroll
                for (int i = 0; i < 2; ++i)
#pragma unroll
                    for (int j = 0; j < 4; ++j) { const int mt = 2 * wr + i, nt = 4 * wc + j; u32x2 o; o.x = pk2(acc[i][j][0], acc[i][j][1]); o.y = pk2(acc[i][j][2], acc[i][j][3]);
                        *(u32x2*)(gc + ((size_t)((nt * 8 + mt) * 64 + lane)) * 8) = o; }
                }
                { LAUNDER(); const float dtot = sdir[dir * 640];
                zero_acc(acc); mm128<true>(I1, true, I3, true, wr, wc, lane, acc);
                unsigned char* gm = F.ws + WS_GM + ((size_t)chain * NCHUNK + n) * 32768;
#pragma unroll
                for (int i = 0; i < 2; ++i)
#pragma unroll
                    for (int j = 0; j < 4; ++j) { const int mt = 2 * wr + i, ct = 4 * wc + j; const int rowi = 16 * mt + r; float v[4];
#pragma unroll
                        for (int e = 0; e < 4; ++e) v[e] = ((rowi == 16 * ct + 4 * q + e) ? dtot : 0.f) - acc[i][j][e];
                        u32x2 o; o.x = pk2(v[0], v[1]); o.y = pk2(v[2], v[3]);
                        *(u32x2*)(gm + ((size_t)((mt * 4 + (ct >> 1)) * 64 + q * 16 + r)) * 16 + 8 * (ct & 1)) = o; }
            }
            LBAR();
            if (hasq) {
                { LAUNDER();
#pragma unroll
                for (int i = 0; i < 2; ++i) { const int ii = 32 * wr + 16 * i + r; const float gi = s_gc[ii];
#pragma unroll
                    for (int j = 0; j < 4; ++j)
#pragma unroll
                        for (int e = 0; e < 4; ++e) { const int jj = 64 * wc + 16 * j + 4 * q + e; const bool on = dir ? (jj >= ii) : (jj <= ii);
                            acc[i][j][e] = on ? qk[i][j][e] * __expf(gi - s_gc[jj]) : 0.f; } }
                st_img(I1, acc, wr, wc, lane); }
                LBAR();
                { LAUNDER();
                zero_acc(acc); mm128<true>(I1, false, I2, true, wr, wc, lane, acc);
                { bf16* ogp = WSP(bf16, WS_OGDN) + (trow0 + 32 * wr + r) * 512 + h * 128 + 64 * wc + 4 * q;
#pragma unroll
                  for (int i = 0; i < 2; ++i)
#pragma unroll
                    for (int j = 0; j < 4; ++j) { bf16* pp = ogp + (size_t)(16 * i) * 512 + 16 * j; f32x4 v = acc[i][j];
                        if (dir) { const u32x2 pv = *(const u32x2*)pp; v[0] += bflo(pv.x); v[1] += bfhi(pv.x); v[2] += bflo(pv.y); v[3] += bfhi(pv.y); }
                        u32x2 o; o.x = pk2(v[0], v[1]); o.y = pk2(v[2], v[3]); *(u32x2*)pp = o; } } }
                { LAUNDER();
                zero_acc(acc); mm128<true>(I1, false, I3, true, wr, wc, lane, acc);
                unsigned char* qt = F.ws + WS_GQT + ((size_t)chain * 32 + (n - 2)) * 32768;
#pragma unroll
                for (int i = 0; i < 2; ++i) { const int ii = 32 * wr + 16 * i + r; const float egi = s_eg[ii];
#pragma unroll
                    for (int j = 0; j < 4; ++j) { const int mt = 2 * wr + i, ct = 4 * wc + j; const u32x2 qq2 = qv[i][j];
                        u32x2 o; o.x = pk2(egi * bflo(qq2.x) - acc[i][j][0], egi * bfhi(qq2.x) - acc[i][j][1]); o.y = pk2(egi * bflo(qq2.y) - acc[i][j][2], egi * bfhi(qq2.y) - acc[i][j][3]);
                        *(u32x2*)(qt + ((size_t)((mt * 4 + (ct >> 1)) * 64 + q * 16 + r)) * 16 + 8 * (ct & 1)) = o; } } }
                LBAR();
            }
        }
        }
    }
#undef LAUNDER
}

__device__ __forceinline__ void phase_scan(Frame& F) {
    const int lane = F.lane, w = F.wave, tid = F.tid;
    for (int it = F.bid; it < 256; it += F.G) {
        if (it < 128) {
            const int chain = (it & 7) * 4 + (it >> 5), dq = (it >> 3) & 3;
            const unsigned char* gm = F.ws + WS_GM + (size_t)chain * NCHUNK * 32768; unsigned char* gc = F.ws + WS_GC + (size_t)chain * NCHUNK * 32768;
            const unsigned char* gcs = gc + (size_t)(2 * dq) * 4096;
            if (w >= 4) {
                const int j = tid - 256; u32x4 sA[10], sB[10], sC[10], sD[10];
#define SCAN_LD(dst, n_) do { _Pragma("unroll") for (int i_ = 0; i_ < 8; ++i_) dst[i_] = *(const u32x4*)(gm + (size_t)(n_) * 32768 + (size_t)(j + 256 * i_) * 16); \
                              _Pragma("unroll") for (int i_ = 0; i_ < 2; ++i_) dst[8 + i_] = *(const u32x4*)(gcs + (size_t)(n_) * 32768 + (size_t)(j + 256 * i_) * 16); } while (0)
#define SCAN_ST(n_, src) do { LAS unsigned char* buf_ = F.lds + ((n_) % 3) * 40960; \
                              _Pragma("unroll") for (int i_ = 0; i_ < 8; ++i_) *(LAS u32x4*)(buf_ + (size_t)(j + 256 * i_) * 16) = src[i_]; \
                              _Pragma("unroll") for (int i_ = 0; i_ < 2; ++i_) *(LAS u32x4*)(buf_ + 32768 + (size_t)(j + 256 * i_) * 16) = src[8 + i_]; \
                              if ((n_) + 4 < NCHUNK) SCAN_LD(src, (n_) + 4); LBAR(); } while (0)
                SCAN_LD(sA, 0); SCAN_LD(sB, 1); SCAN_LD(sC, 2); SCAN_LD(sD, 3);
#pragma unroll 1
                for (int n = 0; n < 32; n += 4) { SCAN_ST(n, sA); SCAN_ST(n + 1, sB); SCAN_ST(n + 2, sC); SCAN_ST(n + 3, sD); }
                SCAN_ST(32, sA); SCAN_ST(33, sB);
#undef SCAN_LD
#undef SCAN_ST
            } else if (w < 2) {
                const int nt = 2 * dq + w;
                bf16x8 sf[4];
#pragma unroll
                for (int s = 0; s < 4; ++s) sf[s] = (bf16x8){0, 0, 0, 0, 0, 0, 0, 0};
#pragma unroll 1
                for (int n = 0; n < NCHUNK; ++n) {
                    LBAR();
                    const LAS unsigned char* buf = F.lds + (n % 3) * 40960; const LAS unsigned char* cb = buf + 32768 + w * 4096;
                    unsigned char* slot = gc + (size_t)n * 32768 + (size_t)nt * 4096; f32x4 acc[8];
#pragma unroll
                    for (int mt = 0; mt < 8; ++mt) { const u32x2 cv = *(const LAS u32x2*)(cb + (mt * 64 + lane) * 8); acc[mt] = (f32x4){bflo(cv.x), bfhi(cv.x), bflo(cv.y), bfhi(cv.y)}; }
#pragma unroll
                    for (int s = 0; s < 4; ++s)
#pragma unroll
                        for (int mt = 0; mt < 8; ++mt) acc[mt] = MFMA16(*(const LAS bf16x8*)(buf + ((mt * 4 + s) * 64 + lane) * 16), sf[s], acc[mt]);
#pragma unroll
                    for (int s = 0; s < 4; ++s) { const u32x4 pk = {pk2(acc[2 * s][0], acc[2 * s][1]), pk2(acc[2 * s][2], acc[2 * s][3]), pk2(acc[2 * s + 1][0], acc[2 * s + 1][1]), pk2(acc[2 * s + 1][2], acc[2 * s + 1][3])};
                        sf[s] = __builtin_bit_cast(bf16x8, pk); *(u32x4*)(slot + (size_t)(s * 64 + lane) * 16) = pk; }
                }
            } else {
#pragma unroll 1
                for (int n = 0; n < NCHUNK; ++n) LBAR();
            }
            LBAR();
#if defined(PROBE_PH) && PROBE_PH == 204
            if (F.bid == 0 && tid == 0) ((volatile LAS unsigned long long*)(F.lds + MISC_OFF + 896))[5] = __builtin_amdgcn_s_memrealtime();
#endif
        } else {
            const int gidx = (it - 128) * NTHR + tid; const int chain = gidx >> 11, piece = gidx & 2047; const int h = (chain >> 1) & 3, dir = chain & 1;
            const float dec = expf(F.ret_log_decay[dir * 4 + h] * 128.f);
            unsigned char* kv = F.ws + WS_GKV + (size_t)chain * NCHUNK * 32768 + (size_t)piece * 16;
            float st[8];
#pragma unroll
            for (int e = 0; e < 8; ++e) st[e] = 0.f;
#pragma unroll 1
            for (int n0 = 0; n0 < NCHUNK; n0 += 17) { u32x4 v8[17];
#pragma unroll
                for (int j = 0; j < 17; ++j) v8[j] = *(const u32x4*)(kv + (size_t)(n0 + j) * 32768);
#pragma unroll
                for (int j = 0; j < 17; ++j) { float v[8]; unpack8(v8[j], v);
#pragma unroll
                    for (int e = 0; e < 8; ++e) st[e] = dec * st[e] + v[e];
                    *(u32x4*)(kv + (size_t)(n0 + j) * 32768) = pack8(st); } }
        }
    }
}

__device__ __forceinline__ void phase_out(Frame& F) {
    const bf16* P = WSP(bf16, WS_P);
    for (int it = F.bid; it < 512; it += F.G) {
        int tz_ = threadIdx.x; asm volatile("" : "+v"(tz_)); const int tid = tz_, lane = tz_ & 63, w = __builtin_amdgcn_readfirstlane(tz_ >> 6), r = lane & 15, q = lane >> 4;
        const int b = it >> 7, h = (it >> 5) & 3, m = 2 + (it & 31);
        const size_t prow = (size_t)b * RPB + 128 * m + 16 * w + r; const size_t trow = (size_t)b * SEQ + 128 * (m - 2) + 16 * w + r;
        const int il = 16 * w + r;
        bf16x8 fqg[2][4], fqr[4];
#pragma unroll
        for (int dir = 0; dir < 2; ++dir) { const int chain = (b * NH + h) * 2 + dir, n = dir ? 35 - m : m; const unsigned char* qt = F.ws + WS_GQT + ((size_t)chain * 32 + (n - 2)) * 32768;
#pragma unroll
            for (int s = 0; s < 4; ++s) fqg[dir][s] = *(const bf16x8*)(qt + (size_t)((w * 4 + s) * 64 + lane) * 16); }
        { const bf16* qp = P + 4 * PGRP + prow * 512 + h * 128;
#pragma unroll
          for (int s = 0; s < 4; ++s) fqr[s] = *(const bf16x8*)(qp + 32 * s + 8 * q); }
        u32x2 rog[8], ror[8];
        { const bf16* a = WSP(bf16, WS_OGDN) + trow * 512 + h * 128 + 4 * q; const bf16* c = WSP(bf16, WS_ORET) + trow * 512 + h * 128 + 4 * q;
#pragma unroll
          for (int nt = 0; nt < 8; ++nt) { rog[nt] = *(const u32x2*)(a + 16 * nt); ror[nt] = *(const u32x2*)(c + 16 * nt); } }
        {
            u32x4 v[4][4];
#pragma unroll
            for (int k = 0; k < 4; ++k) { const int dir = k & 1; const int chain = (b * NH + h) * 2 + dir, n = dir ? 35 - m : m;
                const unsigned char* sp = F.ws + (k < 2 ? WS_GC : WS_GKV) + ((size_t)chain * NCHUNK + (n - 1)) * 32768;
#pragma unroll
                for (int i = 0; i < 4; ++i) v[k][i] = *(const u32x4*)(sp + (size_t)(tid + 512 * i) * 16); }
#pragma unroll
            for (int k = 0; k < 4; ++k)
#pragma unroll
                for (int i = 0; i < 4; ++i) *(LAS u32x4*)(F.lds + k * 32768 + (tid + 512 * i) * 16) = v[k][i];
        }
        f32x4 og[8], orr[8];
#pragma unroll
        for (int nt = 0; nt < 8; ++nt) { og[nt] = (f32x4){bflo(rog[nt].x), bfhi(rog[nt].x), bflo(rog[nt].y), bfhi(rog[nt].y)}; orr[nt] = (f32x4){bflo(ror[nt].x), bfhi(ror[nt].x), bflo(ror[nt].y), bfhi(ror[nt].y)}; }
        LBAR();
#pragma unroll
        for (int dir = 0; dir < 2; ++dir) {
            {
                const LAS unsigned char* sp = F.lds + dir * 32768;
#pragma unroll
                for (int s = 0; s < 4; ++s)
#pragma unroll
                    for (int nt = 0; nt < 8; ++nt) og[nt] = MFMA16(*(const LAS bf16x8*)(sp + ((nt * 4 + s) * 64 + lane) * 16), fqg[dir][s], og[nt]);
            }
            {
                const LAS unsigned char* sp = F.lds + (2 + dir) * 32768;
                f32x4 t[8];
#pragma unroll
                for (int nt = 0; nt < 8; ++nt) t[nt] = (f32x4){0.f, 0.f, 0.f, 0.f};
#pragma unroll
                for (int s = 0; s < 4; ++s)
#pragma unroll
                    for (int nt = 0; nt < 8; ++nt) t[nt] = MFMA16(*(const LAS bf16x8*)(sp + ((nt * 4 + s) * 64 + lane) * 16), fqr[s], t[nt]);
                const float lg = F.ret_log_decay[dir * 4 + h]; const float dcy = expf(lg * (float)(dir ? 128 - il : il + 1));
#pragma unroll
                for (int nt = 0; nt < 8; ++nt) orr[nt] = orr[nt] + t[nt] * dcy;
            }
        }
        {
            float s1 = 0.f;
#pragma unroll
            for (int nt = 0; nt < 8; ++nt) s1 += (orr[nt][0] + orr[nt][1]) + (orr[nt][2] + orr[nt][3]);
            s1 += __shfl_xor(s1, 16); s1 += __shfl_xor(s1, 32); const float mean = s1 * (1.f / 128.f);
            float s2 = 0.f, s3 = 0.f;
#pragma unroll
            for (int nt = 0; nt < 8; ++nt)
#pragma unroll
                for (int e = 0; e < 4; ++e) { const float d = orr[nt][e] - mean; s2 += d * d; s3 += og[nt][e] * og[nt][e]; }
            s2 += __shfl_xor(s2, 16); s2 += __shfl_xor(s2, 32); s3 += __shfl_xor(s3, 16); s3 += __shfl_xor(s3, 32);
            const float rs_r = 1.0f / sqrtf(s2 * (1.f / 128.f) + EPS), rs_g = 1.0f / sqrtf(s3 * (1.f / 128.f) + EPS);
            const bf16* rg = P + 5 * PGRP + prow * 512 + h * 128 + 4 * q; const bf16* gz = P + 7 * PGRP + prow * 512 + h * 128 + 4 * q;
            bf16* ry = WSP(bf16, WS_RETY) + trow * 512 + h * 128 + 4 * q; bf16* gy = WSP(bf16, WS_GDNY) + trow * 512 + h * 128 + 4 * q;
#pragma unroll
            for (int nt = 0; nt < 8; ++nt) { const u32x2 a = *(const u32x2*)(rg + 16 * nt), c = *(const u32x2*)(gz + 16 * nt);
                const float ga[4] = {bflo(a.x), bfhi(a.x), bflo(a.y), bfhi(a.y)}, gc4[4] = {bflo(c.x), bfhi(c.x), bflo(c.y), bfhi(c.y)};
                const f32x4 wr4 = *(const f32x4*)(F.ret_gn_w + h * 128 + 16 * nt + 4 * q), wg4 = *(const f32x4*)(F.gdn_norm_w + h * 128 + 16 * nt + 4 * q);
                float yr[4], yg[4];
#pragma unroll
                for (int e = 0; e < 4; ++e) { yr[e] = (orr[nt][e] - mean) * rs_r * wr4[e] * siluf_(ga[e]); yg[e] = og[nt][e] * rs_g * wg4[e] * siluf_(gc4[e]); }
                u32x2 o1, o2; o1.x = pk2(yr[0], yr[1]); o1.y = pk2(yr[2], yr[3]); o2.x = pk2(yg[0], yg[1]); o2.y = pk2(yg[2], yg[3]);
                *(u32x2*)(ry + 16 * nt) = o1; *(u32x2*)(gy + 16 * nt) = o2; }
        }
        LBAR();
    }
}

struct SchedMerge {
    const char *A0, *A1, *B0, *B1; int G, c;
    __device__ __forceinline__ bool next(int i, pg8::Unit& u) const {
        const int L = (i >> 1) * G + c; if (L >= 256) return false; const int term = i & 1;
        const int xcd = L % 8, off = L / 8; const int w = xcd * 32 + off;
        u.pm = w >> 2; u.pn = w & 3; u.e = term; u.base = 0;
        u.A = (term ? A1 : A0) + (size_t)u.pm * 256 * 512 * 2; u.B = (term ? B1 : B0) + (size_t)u.pn * 256 * 512 * 2; return true; }
    __device__ __forceinline__ int row_index(const pg8::Unit&, int r) const { return r; }
};
struct EpiMerge {
    const bf16* GATES; bf16* TMP; bf16* MERGED;
    __device__ __forceinline__ void operator()(const f32x4 (&acc)[2][2][4][2], const pg8::Unit& u, int wr, int wc, int fr, int fq) const {
#pragma unroll
        for (int ai = 0; ai < 2; ++ai) {
            u32x4 gv[4][2], pv[4][2];
#pragma unroll
            for (int m = 0; m < 4; ++m) { const size_t row = (size_t)u.pm * 256 + ai * 128 + wr * 64 + m * 16 + fr;
#pragma unroll
                for (int bj = 0; bj < 2; ++bj) { const int col = u.pn * 256 + bj * 128 + wc * 32 + 8 * fq;
                    gv[m][bj] = *(const u32x4*)(GATES + row * 2048 + u.e * 1024 + col);
                    if (u.e != 0) pv[m][bj] = *(const u32x4*)(TMP + row * DM + col); } }
#pragma unroll
            for (int m = 0; m < 4; ++m) { const size_t row = (size_t)u.pm * 256 + ai * 128 + wr * 64 + m * 16 + fr;
#pragma unroll
                for (int bj = 0; bj < 2; ++bj) { const int col = u.pn * 256 + bj * 128 + wc * 32 + 8 * fq;
                    float g[8]; unpack8(gv[m][bj], g);
                    float v[8] = {acc[ai][bj][m][0][0], acc[ai][bj][m][0][1], acc[ai][bj][m][0][2], acc[ai][bj][m][0][3], acc[ai][bj][m][1][0], acc[ai][bj][m][1][1], acc[ai][bj][m][1][2], acc[ai][bj][m][1][3]};
                    if (u.e == 0) {
#pragma unroll
                        for (int i = 0; i < 8; ++i) v[i] *= g[i];
                        *(u32x4*)(TMP + row * DM + col) = pack8(v);
                    } else { float p[8]; unpack8(pv[m][bj], p);
#pragma unroll
                        for (int i = 0; i < 8; ++i) v[i] = p[i] + v[i] * g[i];
                        *(u32x4*)(MERGED + row * DM + col) = pack8(v); } } }
        }
    }
};
struct SchedDense {
    const char *A, *B; int nM, nN, K, G, c;
    __device__ __forceinline__ bool next(int i, pg8::Unit& u) const {
        const int L = i * G + c; const int nwg = nM * nN; if (L >= nwg) return false;
        int w = L; if (nwg % 8 == 0) { const int xcd = L % 8, off = L / 8; w = xcd * (nwg / 8) + off; }
        u.pm = w / nN; u.pn = w % nN; u.e = 0; u.base = 0; u.A = A + (size_t)u.pm * 256 * K * 2; u.B = B + (size_t)u.pn * 256 * K * 2; return true; }
    __device__ __forceinline__ int row_index(const pg8::Unit&, int r) const { return r; }
};
struct EpiBf16Store { bf16* O; int ldc;
    __device__ __forceinline__ void operator()(const f32x4 (&acc)[2][2][4][2], const pg8::Unit& u, int wr, int wc, int fr, int fq) const {
#pragma unroll
        for (int ai = 0; ai < 2; ++ai)
#pragma unroll
            for (int m = 0; m < 4; ++m) { const size_t row = (size_t)u.pm * 256 + ai * 128 + wr * 64 + m * 16 + fr;
#pragma unroll
                for (int bj = 0; bj < 2; ++bj) { const int col = u.pn * 256 + bj * 128 + wc * 32 + 8 * fq; const f32x4 v0 = acc[ai][bj][m][0], v1 = acc[ai][bj][m][1];
                    u32x4 w; w.x = pk2(v0[0], v0[1]); w.y = pk2(v0[2], v0[3]); w.z = pk2(v1[0], v1[1]); w.w = pk2(v1[2], v1[3]);
                    *(u32x4*)(O + row * ldc + col) = w; } }
    }
};

__device__ __forceinline__ void load_row_bf16(const bf16* p, int lane, float (&v)[16]) { float a[8], b[8]; unpack8(*(const u32x4*)(p + 8 * lane), a); unpack8(*(const u32x4*)(p + 512 + 8 * lane), b);
#pragma unroll
    for (int i = 0; i < 8; ++i) { v[i] = a[i]; v[8 + i] = b[i]; } }
__device__ __forceinline__ void load_row_f32(const float* p, int lane, float (&v)[16]) {
#pragma unroll
    for (int q = 0; q < 4; ++q) { const f32x4 a = *(const f32x4*)(p + (q >> 1) * 512 + 8 * lane + 4 * (q & 1)); v[4 * q] = a.x; v[4 * q + 1] = a.y; v[4 * q + 2] = a.z; v[4 * q + 3] = a.w; } }
__device__ __forceinline__ void store_row_f32(float* p, int lane, const float (&v)[16]) {
#pragma unroll
    for (int q = 0; q < 4; ++q) *(f32x4*)(p + (q >> 1) * 512 + 8 * lane + 4 * (q & 1)) = (f32x4){v[4 * q], v[4 * q + 1], v[4 * q + 2], v[4 * q + 3]}; }
__device__ __forceinline__ void compute_x1(Frame& F, int t, float (&x1)[16]) {
    const int b = t / SEQ; const float* mod = WSP(float, WS_MOD) + b * 6144;
    const bf16* mop = WSP(bf16, WS_MO) + (size_t)t * DM;
    const u32x4 m0 = *(const u32x4*)(mop + 8 * F.lane), m1 = *(const u32x4*)(mop + 512 + 8 * F.lane);
    float ss = 0.f;
    { float a[8], c[8]; unpack8(m0, a); unpack8(m1, c);
#pragma unroll
      for (int i = 0; i < 8; ++i) ss += a[i] * a[i] + c[i] * c[i]; }
    const float rstd = 1.0f / sqrtf(wave_sum(ss) * (1.f / DM) + EPS);
#pragma unroll
    for (int hf = 0; hf < 2; ++hf) {
        const int c0 = hf * 512 + 8 * F.lane; float mo[8]; unpack8(hf ? m1 : m0, mo);
        const float* xp = F.x + (size_t)t * DM + c0; const float* wp = F.n_mix_post + c0; const float* gp = mod + 2 * DM + c0;
#pragma unroll
        for (int q = 0; q < 2; ++q) { const f32x4 xv = *(const f32x4*)(xp + 4 * q), wv = *(const f32x4*)(wp + 4 * q), g1 = *(const f32x4*)(gp + 4 * q);
#pragma unroll
            for (int e = 0; e < 4; ++e) x1[hf * 8 + 4 * q + e] = xv[e] + g1[e] * (mo[4 * q + e] * rstd * wv[e]); }
    }
}
__device__ __forceinline__ void route_token(Frame& F, int t, float logit, LAS unsigned* lcnt, LAS u32x2* stage, unsigned* cnt, int2* list) {
    logit = (logit == logit) ? logit : 0.f;
    const float score = 1.f / (1.f + expf(-logit)); const float biased = score + F.router_bias[F.lane];
#define DPP_MAX(v, ctrl) fmaxf((v), __builtin_bit_cast(float, __builtin_amdgcn_update_dpp(0, __builtin_bit_cast(int, (v)), (ctrl), 0xf, 0xf, true)))
    float m1 = biased; m1 = DPP_MAX(m1, 0xB1); m1 = DPP_MAX(m1, 0x4E); m1 = DPP_MAX(m1, 0x141);
    const unsigned long long bm = __ballot(biased == m1); const unsigned gb = (unsigned)(bm >> (F.lane & ~7)) & 0xffu; const int first = __ffs((int)gb) - 1;
    float m2 = ((F.lane & 7) == first) ? -__builtin_inff() : biased; m2 = DPP_MAX(m2, 0xB1); m2 = DPP_MAX(m2, 0x4E); m2 = DPP_MAX(m2, 0x141);
#undef DPP_MAX
    const float gs = m1 + m2;
    int grk = 0; const int myg = F.lane >> 3;
#pragma unroll
    for (int o = 0; o < 8; ++o) { const float ov = __builtin_bit_cast(float, __builtin_amdgcn_readlane(__builtin_bit_cast(int, gs), o * 8)); grk += ((ov > gs) | ((ov == gs) & (o < myg))) ? 1 : 0; }
    const bool keep = grk < 4;
    const float cand = keep ? biased : -__builtin_inff();
    int erk = 0;
#pragma unroll
    for (int o = 0; o < 64; ++o) { const float ov = __builtin_bit_cast(float, __builtin_amdgcn_readlane(__builtin_bit_cast(int, cand), o)); erk += ((ov > cand) | ((ov == cand) & (o < F.lane))) ? 1 : 0; }
    const bool sel = keep && erk < TOPK;
    const float ssum = wave_sum(sel ? score : 0.f);
    if (sel) { const float w = score / ssum * 2.5f; const unsigned pos = __hip_atomic_fetch_add(lcnt + F.lane, 1u, __ATOMIC_RELAXED, __HIP_MEMORY_SCOPE_WORKGROUP);
        if (pos < 48u) stage[F.lane * 48 + pos] = (u32x2){(unsigned)(t * 8 + erk), __float_as_uint(w)};
        else { const unsigned gp = atomicAdd(cnt + 64 * F.lane, 1u); list[(size_t)F.lane * NT + gp] = make_int2(t * 8 + erk, __float_as_int(w)); } }
}
__device__ __forceinline__ void phase_route(Frame& F) {
    constexpr int HST = 2064;
    LAS unsigned char* hhi = F.lds;
    LAS unsigned char* hlo = F.lds + 16 * HST;
    LAS float* part = (LAS float*)(F.lds + 2 * 16 * HST);
    LAS u32x2* stage = (LAS u32x2*)(F.lds + 2 * 16 * HST + 32768);
    LAS unsigned* lcnt = (LAS unsigned*)(F.lds + MISC_OFF + 1024);
    unsigned* cnt = F.ctl + CW_CNT; int2* list = WSP(int2, WS_LIST);
    const int r = F.lane & 15, q = F.lane >> 4, kbase = F.wave * 128;
    bf16x8 wh[4][4]; u32x2 wl8[4][4];
#pragma unroll
    for (int ft = 0; ft < 4; ++ft) {
        asm volatile("" ::: "memory");
#pragma unroll
        for (int s = 0; s < 4; ++s) { float wv[8];
#pragma unroll
            for (int j = 0; j < 8; ++j) wv[j] = F.w_router[(size_t)(kbase + 32 * s + 8 * q + j) * NEXP + 16 * ft + r];
            unsigned hi[8];
#pragma unroll
            for (int j = 0; j < 8; ++j) hi[j] = f2bf(wv[j]);
            wh[ft][s] = __builtin_bit_cast(bf16x8, (u32x4){hi[0] | (hi[1] << 16), hi[2] | (hi[3] << 16), hi[4] | (hi[5] << 16), hi[6] | (hi[7] << 16)});
            float lf[8];
#pragma unroll
            for (int j = 0; j < 8; ++j) lf[j] = (wv[j] - bf2f(hi[j])) * 4096.0f;
            unsigned p0 = __builtin_amdgcn_cvt_pk_bf8_f32(lf[0], lf[1], 0u, false); p0 = __builtin_amdgcn_cvt_pk_bf8_f32(lf[2], lf[3], p0, true);
            unsigned p1 = __builtin_amdgcn_cvt_pk_bf8_f32(lf[4], lf[5], 0u, false); p1 = __builtin_amdgcn_cvt_pk_bf8_f32(lf[6], lf[7], p1, true);
            wl8[ft][s] = (u32x2){p0, p1}; } }
    for (int g64 = F.bid; g64 < NT / 64; g64 += F.G) {
        if (F.tid < 64) lcnt[F.tid] = 0u;
        __syncthreads();
#pragma unroll 1
        for (int grp = 0; grp < 4; ++grp) {
#pragma unroll
            for (int tw = 0; tw < 2; ++tw) {
                const int slot = 2 * F.wave + tw; const int t = g64 * 64 + grp * 16 + slot; const int b = t / SEQ; const float* mod = WSP(float, WS_MOD) + b * 6144;
                float x1[16]; compute_x1(F, t, x1);
                float ss = 0.f;
#pragma unroll
                for (int i = 0; i < 16; ++i) ss += x1[i] * x1[i];
                const float rstd = 1.0f / sqrtf(wave_sum(ss) * (1.f / DM) + EPS);
                bf16* d = WSP(bf16, WS_H2) + (size_t)t * DM;
#pragma unroll
                for (int hf = 0; hf < 2; ++hf) {
                    asm volatile("" ::: "memory");
                    const int c0 = hf * 512 + 8 * F.lane; float h2[8];
#pragma unroll
                    for (int qq = 0; qq < 2; ++qq) { const f32x4 wv = *(const f32x4*)(F.n_ffn_pre + c0 + 4 * qq), sh = *(const f32x4*)(mod + 3 * DM + c0 + 4 * qq), sc = *(const f32x4*)(mod + 4 * DM + c0 + 4 * qq);
#pragma unroll
                        for (int e = 0; e < 4; ++e) h2[4 * qq + e] = x1[hf * 8 + 4 * qq + e] * rstd * wv[e] * (1.f + sc[e]) + sh[e]; }
                    const u32x4 hp = pack8(h2); *(u32x4*)(d + c0) = hp;
                    float lo8[8]; { float hb[8]; unpack8(hp, hb);
#pragma unroll
                        for (int e = 0; e < 8; ++e) lo8[e] = h2[e] - hb[e]; }
                    *(LAS u32x4*)(hhi + slot * HST + c0 * 2) = hp; *(LAS u32x4*)(hlo + slot * HST + c0 * 2) = pack8(lo8);
                }
            }
            LBAR();
            {
                typedef float f32x2v __attribute__((ext_vector_type(2)));
                f32x4 acc[4], acc2[4];
#pragma unroll
                for (int ft = 0; ft < 4; ++ft) { acc[ft] = (f32x4){0.f, 0.f, 0.f, 0.f}; acc2[ft] = (f32x4){0.f, 0.f, 0.f, 0.f}; }
#pragma unroll
                for (int s = 0; s < 4; ++s) { const int off = r * HST + (kbase + 32 * s + 8 * q) * 2;
                    const bf16x8 bh = *(const LAS bf16x8*)(hhi + off), bl = *(const LAS bf16x8*)(hlo + off);
#pragma unroll
                    for (int ft = 0; ft < 4; ++ft) {
                        const f32x2v l0 = __builtin_amdgcn_cvt_pk_f32_bf8(wl8[ft][s].x, false), l1 = __builtin_amdgcn_cvt_pk_f32_bf8(wl8[ft][s].x, true), l2 = __builtin_amdgcn_cvt_pk_f32_bf8(wl8[ft][s].y, false), l3 = __builtin_amdgcn_cvt_pk_f32_bf8(wl8[ft][s].y, true);
                        const bf16x8 wlo = __builtin_bit_cast(bf16x8, (u32x4){pk2(l0.x, l0.y), pk2(l1.x, l1.y), pk2(l2.x, l2.y), pk2(l3.x, l3.y)});
                        acc[ft] = MFMA16(wh[ft][s], bh, acc[ft]); acc[ft] = MFMA16(wh[ft][s], bl, acc[ft]); acc2[ft] = MFMA16(wlo, bh, acc2[ft]); } }
#pragma unroll
                for (int ft = 0; ft < 4; ++ft)
#pragma unroll
                    for (int e = 0; e < 4; ++e) part[(F.wave * 64 + 16 * ft + 4 * q + e) * 16 + r] = acc[ft][e] + acc2[ft][e] * (1.0f / 4096.0f);
            }
            LBAR();
#pragma unroll 1
            for (int tw = 0; tw < 2; ++tw) { const int slot = 2 * F.wave + tw; float logit = 0.f;
#pragma unroll
                for (int w = 0; w < 8; ++w) logit += part[(w * 64 + F.lane) * 16 + slot];
                route_token(F, g64 * 64 + grp * 16 + slot, logit, lcnt, stage, cnt, list); }
        }
        __syncthreads();
        if (F.tid < 64) { const unsigned n = lcnt[F.tid] < 48u ? lcnt[F.tid] : 48u; lcnt[F.tid] = n; lcnt[64 + F.tid] = atomicAdd(cnt + 64 * F.tid, n); }
        __syncthreads();
        { const int e = F.tid >> 3; const unsigned n = lcnt[e], base = lcnt[64 + e];
          for (unsigned j = F.tid & 7; j < n; j += 8) { const u32x2 v = stage[e * 48 + j]; list[(size_t)e * NT + base + j] = make_int2((int)v.x, (int)v.y); } }
        __syncthreads();
    }
}

__device__ __forceinline__ void build_tile_prefix(Frame& F, LAS int* tp) {
    __syncthreads();
    if (F.tid == 0) { int s = 0; const unsigned* cnt = F.ctl + CW_CNT; for (int e = 0; e < 64; ++e) { const int ce = (int)__hip_atomic_load(cnt + 64 * e, __ATOMIC_RELAXED, __HIP_MEMORY_SCOPE_AGENT); tp[96 + e] = ce; tp[e] = s; s += (ce + 255) >> 8; } tp[64] = s; tp[65] = s + 64;
        const int x = F.bid & 7; int l = 0; for (int k = 0; k < 8; ++k) { tp[80 + k] = l; l += tp[x + 8 * k + 1] - tp[x + 8 * k]; } tp[88] = l; tp[89] = l + 8; }
    __syncthreads();
}
struct SchedMoe {
    const char* A; const char* B; const int2* list; const unsigned* cnt; const LAS int* tp; int npn, K, G, c; size_t bstride  ; int bcol0  ; bool gather;
    __device__ __forceinline__ bool next(int i, pg8::Unit& u) const {
        int e, pm;
        if ((G & 7) == 0) {
            const int x = c & 7, W = G >> 3, L = i * W + (c >> 3); const int nt = __builtin_amdgcn_readfirstlane(tp[89]); if (L >= nt * npn) return false;
            const int tl = L / npn; u.pn = L % npn; int k = 0;
            for (int q = 8; q >= 1; q >>= 1) if (k + q <= 8 && __builtin_amdgcn_readfirstlane(tp[80 + k + q]) <= tl) k += q;
            k = __builtin_amdgcn_readfirstlane(k); const int off = tl - __builtin_amdgcn_readfirstlane(tp[80 + k]);
            if (k < 8) { e = x + 8 * k; pm = off; } else { e = 64; pm = x + 8 * off; }
        } else {
            const int L = i * G + c; const int ntile = __builtin_amdgcn_readfirstlane(tp[65]); if (L >= ntile * npn) return false;
            const int tile = L / npn; u.pn = L % npn; e = 0;
            for (int q = 64; q >= 1; q >>= 1) if (e + q <= 64 && __builtin_amdgcn_readfirstlane(tp[e + q]) <= tile) e += q;
            e = __builtin_amdgcn_readfirstlane(e); pm = tile - __builtin_amdgcn_readfirstlane(tp[e]);
        }
        u.e = e; u.pm = pm; u.base = (e < 64 ? (__builtin_amdgcn_readfirstlane(tp[e < 64 ? e : 0]) + pm) * 256 : SLOT_SH + pm * 256);
        u.A = gather ? A : A + (size_t)u.base * K * 2; u.B = B + (size_t)e * bstride + (size_t)(bcol0 + u.pn * 256) * K * 2; return true; }
    __device__ __forceinline__ int row_index(const pg8::Unit& u, int r) const {
        if (u.e == 64) return u.pm * 256 + r;
        const unsigned tok = (unsigned)list[(size_t)u.e * NT + u.pm * 256 + r].x >> 3; return (int)(tok < (unsigned)NT ? tok : 0u); }
};
struct EpiUp { bf16* HMID;
    __device__ __forceinline__ void operator()(const f32x4 (&acc)[2][2][4][2], const pg8::Unit& u, int wr, int wc, int fr, int fq) const {
#pragma unroll
        for (int ai = 0; ai < 2; ++ai)
#pragma unroll
            for (int m = 0; m < 4; ++m) { const size_t slot = (size_t)u.base + ai * 128 + wr * 64 + m * 16 + fr;
#pragma unroll
                for (int bj = 0; bj < 2; ++bj) { const int hid = u.pn * 128 + bj * 64 + wc * 16 + fq * 4; const f32x4 g = acc[ai][bj][m][0], up = acc[ai][bj][m][1];
                    u32x2 w; w.x = pk2(siluf_(g[0]) * up[0], siluf_(g[1]) * up[1]); w.y = pk2(siluf_(g[2]) * up[2], siluf_(g[3]) * up[3]);
                    *(u32x2*)(HMID + slot * DEXP + hid) = w; } }
    }
};
constexpr float YB_SCALE = 64.0f, YB_INV = 1.0f / 64.0f;
__device__ __forceinline__ unsigned pk4_fp8(float a, float b, float c, float d) {
    a = fminf(fmaxf(a * YB_SCALE, -448.f), 448.f); b = fminf(fmaxf(b * YB_SCALE, -448.f), 448.f); c = fminf(fmaxf(c * YB_SCALE, -448.f), 448.f); d = fminf(fmaxf(d * YB_SCALE, -448.f), 448.f);
    unsigned p = __builtin_amdgcn_cvt_pk_fp8_f32(a, b, 0u, false); return __builtin_amdgcn_cvt_pk_fp8_f32(c, d, p, true); }
struct EpiDown { unsigned char* YB; float* OUT; const int2* list; const LAS int* tp;
    __device__ __forceinline__ void operator()(const f32x4 (&acc)[2][2][4][2], const pg8::Unit& u, int wr, int wc, int fr, int fq) const {
        if (u.e == 64) {
#pragma unroll
            for (int ai = 0; ai < 2; ++ai)
#pragma unroll
                for (int m = 0; m < 4; ++m) { const int idx = u.pm * 256 + ai * 128 + wr * 64 + m * 16 + fr; float* o = OUT + (size_t)idx * DM + u.pn * 256 + wc * 32 + 8 * fq;
#pragma unroll
                    for (int bj = 0; bj < 2; ++bj) { *(f32x4*)(o + bj * 128) = acc[ai][bj][m][0]; *(f32x4*)(o + bj * 128 + 4) = acc[ai][bj][m][1]; } }
        } else {
            const int n = __builtin_amdgcn_readfirstlane(tp[96 + u.e]); int2 dw[2][4];
#pragma unroll
            for (int ai = 0; ai < 2; ++ai)
#pragma unroll
                for (int m = 0; m < 4; ++m) { int idx = u.pm * 256 + ai * 128 + wr * 64 + m * 16 + fr; idx = idx < n ? idx : n - 1; dw[ai][m] = list[(size_t)u.e * NT + idx]; }
#pragma unroll
            for (int ai = 0; ai < 2; ++ai)
#pragma unroll
                for (int m = 0; m < 4; ++m) { const int idx = u.pm * 256 + ai * 128 + wr * 64 + m * 16 + fr;
                    if (idx < n) { const float w = __int_as_float(dw[ai][m].y); unsigned char* o = YB + (size_t)dw[ai][m].x * DM + u.pn * 256 + wc * 32 + 8 * fq;
#pragma unroll
                        for (int bj = 0; bj < 2; ++bj) { const f32x4 v0 = acc[ai][bj][m][0] * w, v1 = acc[ai][bj][m][1] * w;
                            u32x2 q; q.x = pk4_fp8(v0[0], v0[1], v0[2], v0[3]); q.y = pk4_fp8(v1[0], v1[1], v1[2], v1[3]);
                            *(u32x2*)(o + bj * 128) = q; } } }
        }
    }
};
__device__ __forceinline__ void phase_final(Frame& F) {
    typedef float f32x2v __attribute__((ext_vector_type(2)));
    const int gw = F.bid * NWAVES + F.wave, NGW = F.G * NWAVES; const unsigned char* YB = F.ws + WS_YB;
    for (int t = gw; t < NT; t += NGW) {
        const int b = t / SEQ; const float* mod = WSP(float, WS_MOD) + b * 6144;
        u32x2 ya[8], yb[8];
#pragma unroll
        for (int k = 0; k < 8; ++k) { const unsigned char* rp = YB + ((size_t)t * 8 + k) * DM; ya[k] = *(const u32x2*)(rp + 8 * F.lane); yb[k] = *(const u32x2*)(rp + 512 + 8 * F.lane); }
        float mv[16]; load_row_f32(F.out + (size_t)t * DM, F.lane, mv);
        float ra[16];
#pragma unroll
        for (int i = 0; i < 16; ++i) ra[i] = 0.f;
#pragma unroll
        for (int k = 0; k < 8; ++k) {
            const f32x2v a0 = __builtin_amdgcn_cvt_pk_f32_fp8(ya[k].x, false), a1 = __builtin_amdgcn_cvt_pk_f32_fp8(ya[k].x, true), a2 = __builtin_amdgcn_cvt_pk_f32_fp8(ya[k].y, false), a3 = __builtin_amdgcn_cvt_pk_f32_fp8(ya[k].y, true);
            const f32x2v c0 = __builtin_amdgcn_cvt_pk_f32_fp8(yb[k].x, false), c1 = __builtin_amdgcn_cvt_pk_f32_fp8(yb[k].x, true), c2 = __builtin_amdgcn_cvt_pk_f32_fp8(yb[k].y, false), c3 = __builtin_amdgcn_cvt_pk_f32_fp8(yb[k].y, true);
            ra[0] += a0.x; ra[1] += a0.y; ra[2] += a1.x; ra[3] += a1.y; ra[4] += a2.x; ra[5] += a2.y; ra[6] += a3.x; ra[7] += a3.y;
            ra[8] += c0.x; ra[9] += c0.y; ra[10] += c1.x; ra[11] += c1.y; ra[12] += c2.x; ra[13] += c2.y; ra[14] += c3.x; ra[15] += c3.y; }
        float ss = 0.f;
#pragma unroll
        for (int i = 0; i < 16; ++i) { mv[i] += ra[i] * YB_INV; ss += mv[i] * mv[i]; }
        const float rstd = 1.0f / sqrtf(wave_sum(ss) * (1.f / DM) + EPS);
        float x1[16]; compute_x1(F, t, x1);
        float wv[16], g2[16]; load_row_f32(F.n_ffn_post, F.lane, wv); load_row_f32(mod + 5 * DM, F.lane, g2);
        float o[16];
#pragma unroll
        for (int i = 0; i < 16; ++i) o[i] = x1[i] + g2[i] * (mv[i] * rstd * wv[i]);
        store_row_f32(F.out + (size_t)t * DM, F.lane, o);
    }
}

constexpr int N_PHASES = 16;
__global__ void __launch_bounds__(NTHR, 2) fwd(Args args) {
    extern __shared__ __attribute__((aligned(16))) unsigned char lds_raw[];
    Frame F; F.lds = (LAS unsigned char*)lds_raw; F.tid = threadIdx.x; F.lane = F.tid & 63; F.wave = __builtin_amdgcn_readfirstlane(F.tid >> 6); F.G = gridDim.x; F.bid = blockIdx.x;
    F.x = args.in[0]; F.c = args.in[1]; F.ctx = args.in[2]; F.c_ctx = args.in[3]; F.w_mod = args.in[4]; F.b_mod = args.in[5]; F.n_mix_pre = args.in[6]; F.n_mix_post = args.in[7];
    F.n_ffn_pre = args.in[8]; F.n_ffn_post = args.in[9]; F.w_in = args.in[10]; F.gdn_conv = args.in[11]; F.ret_log_decay = args.in[12]; F.gdn_a_log = args.in[13]; F.gdn_dt_bias = args.in[14];
    F.ret_gn_w = args.in[15]; F.gdn_norm_w = args.in[16]; F.w_ret_out = args.in[17]; F.w_gdn_out = args.in[18]; F.w_o = args.in[19]; F.w_router = args.in[20]; F.router_bias = args.in[21];
    F.w_gate = args.in[22]; F.w_up = args.in[23]; F.w_down = args.in[24]; F.w_sh_gate = args.in[25]; F.w_sh_up = args.in[26]; F.w_sh_down = args.in[27];
    F.out = args.out; F.ws = args.ws; F.ctl = (unsigned*)(args.ws + WS_CTL);
    volatile LAS unsigned* MISC = (volatile LAS unsigned*)(F.lds + MISC_OFF);
    if (F.tid < 64) MISC[F.tid] = 0u;
    __syncthreads();
#if MK_ONE_LAUNCH
    XcdBarrier bar = xcd_barrier_post(F.ctl + CW_BAR, MISC + 8);
#define SEAM() xcd_barrier(bar)
#else
#define SEAM() do {} while (0)
#endif
    const int lo = args.ph_lo, hi = args.ph_hi;
#ifndef PHM
#define PHM 0xffff
#endif
#ifndef DUP
#define DUP -1
#endif
#define IN(k) (((PHM >> (k)) & 1) && lo <= (k) && (k) < hi)
    LAS int* tp = (LAS int*)(F.lds + MISC_OFF + 256);
#ifndef PROBE_PH
#define PROBE_PH -1
#endif
#ifdef PROBE_A
#define PROBE_IA PROBE_A
#define PROBE_IB PROBE_B
#else
#define PROBE_IA (PROBE_PH % 100)
#define PROBE_IB ((PROBE_PH % 100) + 1)
#endif
    volatile LAS unsigned long long* tsl = (volatile LAS unsigned long long*)(F.lds + MISC_OFF + 896);
#define STAMP(k) do { if (PROBE_PH >= 0 && F.bid == 0 && F.tid == 0 && !(PROBE_PH == 204 && (k) == 5)) tsl[k] = __builtin_amdgcn_s_memrealtime(); } while (0)

    STAMP(0);
    if (IN(0)) _Pragma("unroll") for (int rep_ = 0; rep_ < ((DUP == 0) ? 2 : 1); ++rep_) { phase_prologue(F); SEAM(); }
    STAMP(1);
    if (IN(1)) _Pragma("unroll") for (int rep_ = 0; rep_ < ((DUP == 1) ? 2 : 1); ++rep_) { phase_norm1(F);
        if (F.G >= 64 && F.bid < 32) { SchedCtx S{(const char*)WSP(bf16, WS_HX), (const char*)WSP(bf16, WS_WIN), F.bid >> 3, F.bid & 7}; EpiIn E{WSP(bf16, WS_P), (bf16*)F.out, WSP(float2, WS_ROPE)};
            pg8::gemm_phase<EpiIn, SchedCtx, false, SP2>(F.lds, DM, S, E); }
        SEAM(); }
    STAMP(2);
    if (IN(2)) _Pragma("unroll") for (int rep_ = 0; rep_ < ((DUP == 2) ? 2 : 1); ++rep_) {
        SchedIn S{(const char*)WSP(bf16, WS_HX), (const char*)WSP(bf16, WS_WIN), F.G, F.bid};
        EpiIn E{WSP(bf16, WS_P), (bf16*)F.out, WSP(float2, WS_ROPE)};
        pg8::gemm_phase<EpiIn, SchedIn, false, SP2>(F.lds, DM, S, E); SEAM();
    }
    STAMP(3);
    if (IN(3)) _Pragma("unroll") for (int rep_ = 0; rep_ < ((DUP == 3) ? 2 : 1); ++rep_) { phase_prep(F); SEAM(); }
    STAMP(4);
    if (IN(4)) _Pragma("unroll") for (int rep_ = 0; rep_ < ((DUP == 4) ? 2 : 1); ++rep_) { phase_scan(F); SEAM(); }
    STAMP(5);
    if (IN(5)) _Pragma("unroll") for (int rep_ = 0; rep_ < ((DUP == 5) ? 2 : 1); ++rep_) { phase_out(F); SEAM(); }
    STAMP(6);
    if (IN(6)) _Pragma("unroll") for (int rep_ = 0; rep_ < ((DUP == 6) ? 2 : 1); ++rep_) {
        SchedMerge S{(const char*)WSP(bf16, WS_RETY), (const char*)WSP(bf16, WS_GDNY), (const char*)WSP(bf16, WS_WRO), (const char*)WSP(bf16, WS_WGO), F.G, F.bid};
        EpiMerge E{(const bf16*)F.out, WSP(bf16, WS_TMP), WSP(bf16, WS_MERGED)};
        pg8::gemm_phase<EpiMerge, SchedMerge, false, SP2>(F.lds, 512, S, E);
        STAMP(15);
        if (rep_ == 0) { _Pragma("unroll") for (int r2_ = 0; r2_ < ((DUP == 16) ? 2 : 1); ++r2_) phase_moe_weights(F); }
        SEAM();
    }
    STAMP(7);
    if (IN(7)) _Pragma("unroll") for (int rep_ = 0; rep_ < ((DUP == 7) ? 2 : 1); ++rep_) {
        SchedDense S{(const char*)WSP(bf16, WS_MERGED), (const char*)WSP(bf16, WS_WO), 64, 4, DM, F.G, F.bid};
        EpiBf16Store E{WSP(bf16, WS_MO), DM};
        pg8::gemm_phase<EpiBf16Store, SchedDense, false, SP2>(F.lds, DM, S, E); SEAM();
    }
    STAMP(8);
    if (IN(8)) _Pragma("unroll") for (int rep_ = 0; rep_ < ((DUP == 8) ? 2 : 1); ++rep_) { if (rep_ == 1) { if (F.bid == 0 && F.tid < 64) F.ctl[CW_CNT + 64 * F.tid] = 0u; SEAM(); } phase_route(F); SEAM(); }
    STAMP(9);
    if (IN(9)) _Pragma("unroll") for (int rep_ = 0; rep_ < ((DUP == 9) ? 2 : 1); ++rep_) {
        build_tile_prefix(F, tp);
        SchedMoe S{(const char*)WSP(bf16, WS_H2), (const char*)WSP(bf16, WS_WGU), WSP(int2, WS_LIST), F.ctl + CW_CNT, tp, 2, DM, F.G, F.bid, (size_t)512 * DM * 2, 0, true};
        EpiUp E{WSP(bf16, WS_HMID)};
        pg8::gemm_phase<EpiUp, SchedMoe, true, SP2>(F.lds, DM, S, E); SEAM();
    }
    STAMP(10);
    if (IN(10)) _Pragma("unroll") for (int rep_ = 0; rep_ < ((DUP == 10) ? 2 : 1); ++rep_) {
        build_tile_prefix(F, tp);
        SchedMoe S{(const char*)WSP(bf16, WS_HMID), (const char*)WSP(bf16, WS_WD), WSP(int2, WS_LIST), F.ctl + CW_CNT, tp, 4, DEXP, F.G, F.bid, (size_t)DM * DEXP * 2, 0, false};
        EpiDown E{F.ws + WS_YB, F.out, WSP(int2, WS_LIST), tp};
        pg8::gemm_phase<EpiDown, SchedMoe, false, SP2>(F.lds, DEXP, S, E); SEAM();
    }
    STAMP(11);
    STAMP(12);
    STAMP(13);
    if (IN(13)) _Pragma("unroll") for (int rep_ = 0; rep_ < ((DUP == 13) ? 2 : 1); ++rep_) { phase_final(F); }
    STAMP(14);
    if (PROBE_PH >= 0 && F.bid == 0) { __syncthreads(); if (F.tid == 0) { const unsigned long long d = tsl[PROBE_IB] - tsl[PROBE_IA]; float a = 1.0f + 0.2f * floorf((float)d * 0.001f); a = a > 30.f ? 30.f : a;
#ifdef PROBE_BIG
            a = 20.0f + (float)d * 0.005f;
#endif
            asm volatile("s_waitcnt vmcnt(0)" ::: "memory"); F.out[0] += a; } }
#undef IN
}

extern "C" void kernel_launch(void* const* d_in, const int* in_sizes, int n_in, void* d_out, int out_size, void* d_ws, size_t ws_size, hipStream_t stream) {
    static int grid = 0;
    if (grid == 0) {
        if (n_in != 28 || in_sizes[0] != NT * DM || out_size != NT * DM || ws_size < WS_END) { fprintf(stderr, "kernel_launch: unexpected shapes / workspace (%d inputs, ws %zu)\n", n_in, ws_size); grid = -1; return; }
        int dev = 0, cus = 0;
        if (hipGetDevice(&dev) != hipSuccess || hipDeviceGetAttribute(&cus, hipDeviceAttributeMultiprocessorCount, dev) != hipSuccess) { grid = -1; return; }
        if (hipFuncSetAttribute((const void*)fwd, hipFuncAttributeMaxDynamicSharedMemorySize, LDS_BYTES) != hipSuccess) { fprintf(stderr, "kernel_launch: hipFuncSetAttribute failed\n"); grid = -1; return; }
        int per_cu = 0; (void)hipOccupancyMaxActiveBlocksPerMultiprocessor(&per_cu, (const void*)fwd, NTHR, LDS_BYTES); (void)hipGetLastError();
        if (per_cu < 1) fprintf(stderr, "kernel_launch: occupancy query says %d\n", per_cu);
        grid = cus;
    }
    if (grid < 0) return;
    (void)hipMemsetAsync((char*)d_ws + WS_CTL, 0, CTL_BYTES, stream);
    Args a{};
    for (int i = 0; i < 28; ++i) a.in[i] = (const float*)d_in[i];
    a.out = (float*)d_out; a.ws = (unsigned char*)d_ws;
#if MK_ONE_LAUNCH
    a.ph_lo = 0; a.ph_hi = N_PHASES;
    hipLaunchKernelGGL(fwd, dim3(grid), dim3(NTHR), LDS_BYTES, stream, a);
#else
    for (int p = 0; p < 14; ++p) { a.ph_lo = p; a.ph_hi = p + 1; hipLaunchKernelGGL(fwd, dim3(grid), dim3(NTHR), LDS_BYTES, stream, a); }
#endif
}
```

```cpp
#include <hip/hip_runtime.h>
#include <cstdio>
#include <cstdint>

#ifndef MK_ONE_LAUNCH
#define MK_ONE_LAUNCH 1
#endif
#ifndef MK_REF_GEMM
#define MK_REF_GEMM 0
#endif

constexpr int NB = 4, SEQ = 4096, DM = 1024, CTXL = 256, RPB = SEQ + CTXL  , NROW = NB * RPB  , NT = NB * SEQ  ;
constexpr int NH = 4, HD = 128, CH = 128, NCHUNK = RPB / CH  ;
constexpr int N_STATE = 2064, N_IN = 6160, NEXP = 64, TOPK = 8, DEXP = 256;
constexpr float EPS = 1e-6f;
constexpr int NPCOL = 4096;
constexpr int SLOT_SH = 147456;
constexpr int NSLOT = SLOT_SH + NT;

constexpr size_t MiB = 1u << 20;
constexpr size_t WS_CTL = 0, CTL_BYTES = 64 * 1024;
constexpr size_t WS_MOD = 1 * MiB;
constexpr size_t WS_ROPE = 2 * MiB;
constexpr size_t WS_LOGA = 4 * MiB;
constexpr size_t WS_BETA = 5 * MiB;
constexpr size_t WS_WRO = 6 * MiB, WS_WGO = 7 * MiB, WS_WO = 8 * MiB;
constexpr size_t WS_P = 10 * MiB;
constexpr size_t PGRP = (size_t)NROW * 512;
constexpr size_t WS_CH = 146 * MiB;
constexpr size_t WS_WIN = WS_CH;
constexpr size_t WS_HX = WS_CH + 12 * MiB;
constexpr size_t WS_GM = WS_CH;
constexpr size_t WS_GC = WS_CH + 34 * MiB;
constexpr size_t WS_GKV = WS_CH + 68 * MiB;
constexpr size_t WS_GQT = WS_CH + 102 * MiB;
constexpr size_t WS_OGDN = WS_CH + 134 * MiB;
constexpr size_t WS_ORET = WS_CH + 150 * MiB;
constexpr size_t WS_RETY = WS_P, WS_GDNY = WS_P + 17 * MiB;
constexpr size_t WS_H2 = 10 * MiB;
constexpr size_t WS_WGU = 73 * MiB;
constexpr size_t WS_YB = 10 * MiB;
constexpr size_t WS_WD = 138 * MiB;
constexpr size_t WS_HMID = 171 * MiB;
constexpr size_t WS_TMP = 171 * MiB, WS_MERGED = 203 * MiB;
constexpr size_t WS_MO = 251 * MiB;
constexpr size_t WS_LIST = 283 * MiB;
constexpr size_t WS_END = 312 * MiB;

constexpr int CW_BAR = 1024;
constexpr int CW_CNT = 8192;
constexpr int CW_FLAG = 12288;

#define GAS __attribute__((address_space(1)))
#define LAS __attribute__((address_space(3)))
typedef unsigned short bf16;
typedef float f32x4 __attribute__((ext_vector_type(4)));
typedef float f32x2 __attribute__((ext_vector_type(2)));
typedef short bf16x8 __attribute__((ext_vector_type(8)));
typedef unsigned u32x4 __attribute__((ext_vector_type(4)));
typedef unsigned u32x2 __attribute__((ext_vector_type(2)));
__device__ __forceinline__ unsigned f2bf(float f) { unsigned u = __builtin_bit_cast(unsigned, f); return (u + 0x7fffu + ((u >> 16) & 1u)) >> 16; }
typedef __bf16 bf16x2_t __attribute__((ext_vector_type(2)));
__device__ __forceinline__ unsigned pk2(float lo, float hi) { const f32x2 v = {lo, hi}; return __builtin_bit_cast(unsigned, __builtin_convertvector(v, bf16x2_t)); }
__device__ __forceinline__ float bf2f(unsigned b) { return __builtin_bit_cast(float, b << 16); }
__device__ __forceinline__ float bflo(unsigned w) { return __builtin_bit_cast(float, w << 16); }
__device__ __forceinline__ float bfhi(unsigned w) { return __builtin_bit_cast(float, w & 0xffff0000u); }
__device__ __forceinline__ float sigmoidf_(float x) { return __builtin_amdgcn_rcpf(1.f + __expf(-x)); }
__device__ __forceinline__ float siluf_(float x) { return x * __builtin_amdgcn_rcpf(1.f + __expf(-x)); }
__device__ __forceinline__ float dpp_add(float v, const int ctrl_tag) { return v; }
#define DPP_ADD(v, ctrl) ((v) + __builtin_bit_cast(float, __builtin_amdgcn_update_dpp(0, __builtin_bit_cast(int, (v)), (ctrl), 0xf, 0xf, true)))
__device__ __forceinline__ float sum16(float v) {
    v = DPP_ADD(v, 0xB1);
    v = DPP_ADD(v, 0x4E);
    v = DPP_ADD(v, 0x141);
    v = DPP_ADD(v, 0x140);
    return v;
}
__device__ __forceinline__ float wave_sum(float v) {
    v = sum16(v);
    const float r0 = __builtin_bit_cast(float, __builtin_amdgcn_readlane(__builtin_bit_cast(int, v), 0)), r1 = __builtin_bit_cast(float, __builtin_amdgcn_readlane(__builtin_bit_cast(int, v), 16));
    const float r2 = __builtin_bit_cast(float, __builtin_amdgcn_readlane(__builtin_bit_cast(int, v), 32)), r3 = __builtin_bit_cast(float, __builtin_amdgcn_readlane(__builtin_bit_cast(int, v), 48));
    return (r0 + r1) + (r2 + r3);
}
__device__ __forceinline__ void unpack8(const u32x4 w, float (&o)[8]) {
    o[0] = bflo(w.x); o[1] = bfhi(w.x); o[2] = bflo(w.y); o[3] = bfhi(w.y); o[4] = bflo(w.z); o[5] = bfhi(w.z); o[6] = bflo(w.w); o[7] = bfhi(w.w);
}
__device__ __forceinline__ u32x4 pack8(const float (&v)[8]) { u32x4 w; w.x = pk2(v[0], v[1]); w.y = pk2(v[2], v[3]); w.z = pk2(v[4], v[5]); w.w = pk2(v[6], v[7]); return w; }

namespace pg8 {
constexpr int BM = 256, BK = 64, HALF = 128, HTB = HALF * BK * 2, STAGE_BYTES = 8 * HTB;
__host__ __device__ __forceinline__ int lds_byte(int r, int c) { const int st = (r >> 4) * 2 + (c >> 5), rr = r & 15, cc = c & 31, ob = rr * 64 + cc * 2; return st * 1024 + (ob ^ (((ob >> 9) & 1) << 5)); }
__host__ __device__ __forceinline__ void stage_rc(int b, int& R, int& C) { const int st = b / 1024, sb = b % 1024, swz = sb ^ (((sb >> 9) & 1) << 5); R = (st >> 1) * 16 + swz / 64; C = (st & 1) * 32 + (swz % 64) / 2; }
__host__ __device__ __forceinline__ int perm32(int rho) { const int n = rho >> 4, i = rho & 15; return 8 * (i >> 2) + 4 * n + (i & 3); }
__device__ __forceinline__ unsigned cvt_pk_bf16(float lo, float hi) { unsigned r; asm volatile("v_cvt_pk_bf16_f32 %0, %1, %2" : "=v"(r) : "v"(lo), "v"(hi)); return r; }

struct Unit { const char* A; const char* B; int pm, pn, e, base, ord; };

template <class Epi, class Sched, bool GATHER, bool SP2>
__device__ __forceinline__ void gemm_phase(LAS unsigned char* lds, const int K, const Sched& S, const Epi& E) {
#if MK_REF_GEMM
    {
        const int tid = threadIdx.x, wid = tid >> 6, lane = tid & 63, wr = wid >> 2, wc = wid & 3, fr = lane & 15, fq = lane >> 4;
        Unit cur;
        for (int ui = 0; S.next(ui, cur); ++ui) {
            f32x4 acc[2][2][4][2];
            for (int ai = 0; ai < 2; ++ai) for (int m = 0; m < 4; ++m) {
                const int r = 128 * ai + 64 * wr + 16 * m + fr;
                const bf16* arow = GATHER ? (const bf16*)cur.A + (size_t)S.row_index(cur, r) * K : (const bf16*)cur.A + (size_t)r * K;
                for (int bj = 0; bj < 2; ++bj) for (int n = 0; n < 2; ++n) {
                    f32x4 a4 = {0.f, 0.f, 0.f, 0.f};
                    for (int i = 0; i < 4; ++i) { const int c = 128 * bj + 32 * wc + 8 * fq + 4 * n + i; const bf16* brow = (const bf16*)cur.B + (size_t)c * K;
                        float s = 0.f; for (int k = 0; k < K; ++k) s += bf2f(arow[k]) * bf2f(brow[k]); a4[i] = s; }
                    acc[ai][bj][m][n] = a4; } }
            E(acc, cur, wr, wc, fr, fq);
        }
        return;
    }
#else
    const int tid = threadIdx.x, wid = __builtin_amdgcn_readfirstlane(tid >> 6), lane = tid & 63, wr = wid >> 2, wc = wid & 3, fr = lane & 15, fq = lane >> 4;
    const int nt = K / BK;
    unsigned voffA[2], voffB[2]; int gR = 0, gC = 0;
#pragma unroll
    for (int i = 0; i < 2; ++i) { int R, C; stage_rc(tid * 16 + i * 8192, R, C); const int Rb = (R & ~31) + perm32(R & 31);
        voffA[i] = (unsigned)(R * K + C) * 2u; voffB[i] = (unsigned)(Rb * K + C) * 2u; if (i == 0) { gR = R; gC = C; } }
    const size_t kstep = (size_t)(BK * 2);
    const size_t hstep = (size_t)HALF * K * 2;
    const unsigned ldsw = (unsigned)wid * 1024u;
    const int aoff = lds_byte(wr * 64 + fr, fq * 8), boff = lds_byte(wc * 32 + fr, fq * 8);
#define PG8_SA(b, h) (((b) * 2 + (h)) * HTB)
#define PG8_SB(b, h) ((4 + (b) * 2 + (h)) * HTB)
#define PG8_STAGE(bufoff, gbase, voff) do { _Pragma("unroll") for (int _i = 0; _i < 2; ++_i) \
        __builtin_amdgcn_global_load_lds((const unsigned*)((const char*)(gbase) + (voff)[_i]), (LAS unsigned*)(lds + (bufoff) + ldsw + _i * 8192), 16, 0, 0); } while (0)
#define PG8_STAGE_A(bufoff, gbase, h, G) do { if constexpr (GATHER) { PG8_STAGE(bufoff, gbase, (G)[h]); } else { PG8_STAGE(bufoff, (gbase) + (h) * hstep, voffA); } } while (0)
#define PG8_LDA(dst, b, h) do { _Pragma("unroll") for (int m = 0; m < 4; ++m) _Pragma("unroll") for (int k = 0; k < 2; ++k) dst[m][k] = *(const LAS bf16x8*)(lds + PG8_SA(b, h) + aoff + m * 2048 + k * 1024); } while (0)
#define PG8_LDB(dst, b, h) do { _Pragma("unroll") for (int n = 0; n < 2; ++n) _Pragma("unroll") for (int k = 0; k < 2; ++k) dst[n][k] = *(const LAS bf16x8*)(lds + PG8_SB(b, h) + boff + n * 2048 + k * 1024); } while (0)
#define PG8_MMA(ai, bj, At, Bt) do { __builtin_amdgcn_s_setprio(1); _Pragma("unroll") for (int m = 0; m < 4; ++m) _Pragma("unroll") for (int n = 0; n < 2; ++n) _Pragma("unroll") for (int k = 0; k < 2; ++k) \
        acc[ai][bj][m][n] = __builtin_amdgcn_mfma_f32_16x16x32_bf16(Bt[n][k], At[m][k], acc[ai][bj][m][n], 0, 0, 0); __builtin_amdgcn_s_setprio(0); } while (0)
#define PG8_WAIT_V(n) asm volatile("s_waitcnt vmcnt(" #n ")" ::: "memory")
#define PG8_WAIT_L(n) asm volatile("s_waitcnt lgkmcnt(" #n ")" ::: "memory")
#define PG8_BAR __builtin_amdgcn_s_barrier()
#define PG8_SCHED __builtin_amdgcn_sched_barrier(0)
    Unit cur, nxt; int ui = 0;
    if (!S.next(0, cur)) return;
    f32x4 acc[2][2][4][2];
#pragma unroll
    for (int a = 0; a < 2; ++a)
#pragma unroll
        for (int b = 0; b < 2; ++b)
#pragma unroll
            for (int m = 0; m < 4; ++m)
#pragma unroll
                for (int n = 0; n < 2; ++n) acc[a][b][m][n] = (f32x4){0.f, 0.f, 0.f, 0.f};
    bf16x8 At[4][2], B0[2][2], B1[2][2];
    const char* cA = cur.A; const char* cB = cur.B;
    unsigned cG[2][2] = {{0u, 0u}, {0u, 0u}}, nG[2][2] = {{0u, 0u}, {0u, 0u}};
    if constexpr (GATHER) {
#pragma unroll
        for (int h = 0; h < 2; ++h)
#pragma unroll
            for (int i = 0; i < 2; ++i) cG[h][i] = ((unsigned)S.row_index(cur, 128 * h + gR + 64 * i) * (unsigned)K + (unsigned)gC) * 2u;
    }
    if constexpr (SP2) {
        PG8_STAGE(PG8_SB(0, 0), cB, voffB); PG8_STAGE(PG8_SB(0, 1), cB + hstep, voffB); PG8_STAGE_A(PG8_SA(0, 0), cA, 0, cG); PG8_STAGE_A(PG8_SA(0, 1), cA, 1, cG);
        if (wr == 1) PG8_BAR;
        PG8_WAIT_V(2); PG8_BAR;
        PG8_STAGE(PG8_SB(1, 0), cB + kstep, voffB); PG8_STAGE_A(PG8_SA(1, 0), cA + kstep, 0, cG); PG8_STAGE(PG8_SB(1, 1), cB + hstep + kstep, voffB);
        PG8_WAIT_V(6); PG8_BAR;
    } else {
        PG8_STAGE(PG8_SB(0, 0), cB, voffB); PG8_STAGE_A(PG8_SA(0, 0), cA, 0, cG); PG8_STAGE(PG8_SB(0, 1), cB + hstep, voffB); PG8_STAGE_A(PG8_SA(0, 1), cA, 1, cG);
        if (wr == 1) PG8_BAR;
        PG8_WAIT_V(4); PG8_BAR;
        PG8_STAGE(PG8_SB(1, 0), cB + kstep, voffB); PG8_STAGE_A(PG8_SA(1, 0), cA + kstep, 0, cG); PG8_STAGE(PG8_SB(1, 1), cB + hstep + kstep, voffB);
        PG8_WAIT_V(6); PG8_BAR;
    }
    for (;;) {
        const bool has_next = S.next(ui + 1, nxt);
        const char* nA = has_next ? nxt.A : cA; const char* nB = has_next ? nxt.B : cB;
        for (int t = 0; t < nt; t += 2) {
            const bool last = (t == nt - 2);
            const char* a1 = cA + (size_t)(t + 1) * kstep;
            const char* a2 = last ? nA : cA + (size_t)(t + 2) * kstep; const char* b2 = last ? nB : cB + (size_t)(t + 2) * kstep;
            const char* a3 = a2 + kstep; const char* b3 = b2 + kstep;
            unsigned g2[2][2] = {{0u, 0u}, {0u, 0u}};
            if constexpr (GATHER) {
                if (last) {
                    if (has_next) {
#pragma unroll
                        for (int h = 0; h < 2; ++h)
#pragma unroll
                            for (int i = 0; i < 2; ++i) nG[h][i] = ((unsigned)S.row_index(nxt, 128 * h + gR + 64 * i) * (unsigned)K + (unsigned)gC) * 2u;
                    } else {
#pragma unroll
                        for (int h = 0; h < 2; ++h)
#pragma unroll
                            for (int i = 0; i < 2; ++i) nG[h][i] = cG[h][i];
                    }
                }
#pragma unroll
                for (int h = 0; h < 2; ++h)
#pragma unroll
                    for (int i = 0; i < 2; ++i) g2[h][i] = last ? nG[h][i] : cG[h][i];
            }
            if constexpr (SP2) {
            PG8_LDB(B0, 0, 0); PG8_LDB(B1, 0, 1); PG8_SCHED; PG8_LDA(At, 0, 0); PG8_STAGE_A(PG8_SA(1, 1), a1, 1, cG);
            PG8_WAIT_V(8); PG8_WAIT_L(0); PG8_BAR; PG8_MMA(0, 0, At, B0); PG8_MMA(0, 1, At, B1); PG8_BAR; PG8_SCHED;
            PG8_LDA(At, 0, 1); PG8_STAGE(PG8_SB(0, 0), b2, voffB); PG8_STAGE(PG8_SB(0, 1), b2 + hstep, voffB); PG8_STAGE_A(PG8_SA(0, 0), a2, 0, g2);
            PG8_WAIT_V(8); PG8_WAIT_L(0); PG8_BAR; PG8_MMA(1, 0, At, B0); PG8_MMA(1, 1, At, B1); PG8_BAR; PG8_SCHED;
            PG8_LDB(B0, 1, 0); PG8_LDB(B1, 1, 1); PG8_SCHED; PG8_LDA(At, 1, 0); PG8_STAGE_A(PG8_SA(0, 1), a2, 1, g2);
            PG8_WAIT_V(8); PG8_WAIT_L(0); PG8_BAR; PG8_MMA(0, 0, At, B0); PG8_MMA(0, 1, At, B1); PG8_BAR; PG8_SCHED;
            PG8_LDA(At, 1, 1); PG8_STAGE(PG8_SB(1, 0), b3, voffB); PG8_STAGE(PG8_SB(1, 1), b3 + hstep, voffB); PG8_STAGE_A(PG8_SA(1, 0), a3, 0, g2);
            PG8_WAIT_V(8); PG8_WAIT_L(0); PG8_BAR; PG8_MMA(1, 0, At, B0); PG8_MMA(1, 1, At, B1); PG8_BAR; PG8_SCHED;
            } else {
            PG8_LDB(B0, 0, 0); PG8_SCHED; PG8_LDA(At, 0, 0); PG8_STAGE_A(PG8_SA(1, 1), a1, 1, cG);
            PG8_WAIT_L(8); PG8_BAR; PG8_WAIT_L(0); PG8_MMA(0, 0, At, B0); PG8_BAR; PG8_SCHED;
            PG8_LDB(B1, 0, 1); PG8_STAGE(PG8_SB(0, 0), b2, voffB);
            PG8_BAR; PG8_WAIT_L(0); PG8_MMA(0, 1, At, B1); PG8_BAR;
            PG8_LDA(At, 0, 1); PG8_STAGE_A(PG8_SA(0, 0), a2, 0, g2);
            PG8_BAR; PG8_WAIT_L(0); PG8_MMA(1, 0, At, B0); PG8_BAR; PG8_SCHED;
            PG8_STAGE(PG8_SB(0, 1), b2 + hstep, voffB);
            PG8_WAIT_V(6); PG8_BAR; PG8_MMA(1, 1, At, B1); PG8_BAR;
            PG8_LDB(B0, 1, 0); PG8_SCHED; PG8_LDA(At, 1, 0); PG8_STAGE_A(PG8_SA(0, 1), a2, 1, g2);
            PG8_WAIT_L(8); PG8_BAR; PG8_WAIT_L(0); PG8_MMA(0, 0, At, B0); PG8_BAR; PG8_SCHED;
            PG8_LDB(B1, 1, 1); PG8_STAGE(PG8_SB(1, 0), b3, voffB);
            PG8_BAR; PG8_WAIT_L(0); PG8_MMA(0, 1, At, B1); PG8_BAR;
            PG8_LDA(At, 1, 1); PG8_STAGE_A(PG8_SA(1, 0), a3, 0, g2);
            PG8_BAR; PG8_WAIT_L(0); PG8_MMA(1, 0, At, B0); PG8_BAR; PG8_SCHED;
            PG8_STAGE(PG8_SB(1, 1), b3 + hstep, voffB);
            PG8_WAIT_V(6); PG8_BAR; PG8_MMA(1, 1, At, B1); PG8_BAR;
            }
        }
        if (wr == 0) PG8_BAR;
        { int tz = threadIdx.x; asm volatile("" : "+v"(tz)); const int wid_ = __builtin_amdgcn_readfirstlane(tz >> 6), lane_ = tz & 63;
          E(acc, cur, wid_ >> 2, wid_ & 3, lane_ & 15, lane_ >> 4); }
        if (!has_next) break;
#pragma unroll
        for (int a = 0; a < 2; ++a)
#pragma unroll
            for (int b = 0; b < 2; ++b)
#pragma unroll
                for (int m = 0; m < 4; ++m)
#pragma unroll
                    for (int n = 0; n < 2; ++n) acc[a][b][m][n] = (f32x4){0.f, 0.f, 0.f, 0.f};
        cur = nxt; cA = nA; cB = nB; ++ui;
        if constexpr (GATHER) {
#pragma unroll
            for (int h = 0; h < 2; ++h)
#pragma unroll
                for (int i = 0; i < 2; ++i) cG[h][i] = nG[h][i];
        }
        if (wr == 1) PG8_BAR;
    }
    PG8_WAIT_V(0);
    PG8_BAR;
#undef PG8_SA
#undef PG8_SB
#undef PG8_STAGE
#undef PG8_STAGE_A
#undef PG8_LDA
#undef PG8_LDB
#undef PG8_MMA
#undef PG8_WAIT_V
#undef PG8_WAIT_L
#undef PG8_BAR
#undef PG8_SCHED
#endif
}
}
constexpr bool SP2 = true;

#define XB_TMO      128
#define XB_XCNT(j)  (256  + 64 * (j))
#define XB_XSUB(j)  (1280 + 64 * (j))
#define XB_XGEN(j)  (2304 + 64 * (j))
#define XB_TOP      3328
#define XB_TOPGEN   3392
#define XCD_BAR_WORDS 3456
#define XB_SPIN_CAP (1u << 18)
__device__ __forceinline__ unsigned xb_ld(unsigned* p)              { return __hip_atomic_load(p, __ATOMIC_RELAXED, __HIP_MEMORY_SCOPE_AGENT); }
__device__ __forceinline__ unsigned xb_add(unsigned* p, unsigned v) { return __hip_atomic_fetch_add(p, v, __ATOMIC_RELAXED, __HIP_MEMORY_SCOPE_AGENT); }
__device__ __forceinline__ unsigned xb_xcc_id() { return (unsigned)__builtin_amdgcn_s_getreg((3 << 11) | 20) & 0xFu; }
#define XB_SPIN(cond, bar) do { unsigned _sp = 0; while (cond) { __builtin_amdgcn_s_sleep(1); \
    if ((++_sp & 255u) == 0u) { if (xb_ld(&(bar)[XB_TMO])) break; if (_sp > XB_SPIN_CAP) { atomicAdd(&(bar)[XB_TMO], 1u); break; } } } } while (0)
struct XcdBarrier { unsigned* bar; unsigned x; volatile LAS unsigned* st; };
__device__ __forceinline__ XcdBarrier xcd_barrier_post(unsigned* bar, volatile LAS unsigned* st) {
    XcdBarrier b; b.bar = bar; b.x = xb_xcc_id(); b.st = st;
    if (threadIdx.x == 0) (void)xb_add(&bar[XB_XCNT(b.x)], 1u);
    return b;
}
__device__ __forceinline__ void xcd_barrier_complete(unsigned* bar, unsigned x, unsigned& nloc, unsigned& nx) {
    const unsigned G = gridDim.x * gridDim.y * gridDim.z;
    unsigned sum, cnt, mine, sp = 0u;
    for (;;) {
        sum = 0u; cnt = 0u; mine = 0u;
#pragma unroll
        for (unsigned j = 0; j < 16; ++j) { const unsigned c = xb_ld(&bar[XB_XCNT(j)]); sum += c; cnt += (c > 0u) ? 1u : 0u; mine = (j == x) ? c : mine; }
        if (sum == G) break;
        __builtin_amdgcn_s_sleep(1);
        if ((++sp & 255u) == 0u) { if (xb_ld(&bar[XB_TMO])) break; if (sp > XB_SPIN_CAP) { atomicAdd(&bar[XB_TMO], 1u); break; } }
    }
    nloc = mine > 0u ? mine : 1u; nx = cnt > 0u ? cnt : 1u;
}
__device__ __forceinline__ void xcd_barrier(const XcdBarrier& b) {
    asm volatile("s_waitcnt vmcnt(0)" ::: "memory");
    __syncthreads();
    if (threadIdx.x == 0) {
        unsigned* bar = b.bar;
        __builtin_amdgcn_s_waitcnt(0);
        unsigned nloc = b.st[0], nx = b.st[1];
        if (nloc == 0u) { xcd_barrier_complete(bar, b.x, nloc, nx); b.st[0] = nloc; b.st[1] = nx; }
        const unsigned old = xb_add(&bar[XB_XSUB(b.x)], 1u);
        const unsigned gen = old / nloc;
        if (old + 1u == (gen + 1u) * nloc) {
            __builtin_amdgcn_fence(__ATOMIC_RELEASE, "agent");
            asm volatile("s_waitcnt vmcnt(0)" ::: "memory");
            const unsigned og = xb_add(&bar[XB_TOP], 1u);
            const unsigned tg = og / nx;
            if (og + 1u == (tg + 1u) * nx) xb_add(&bar[XB_TOPGEN], 1u);
            else XB_SPIN(xb_ld(&bar[XB_TOPGEN]) == tg, bar);
            __builtin_amdgcn_fence(__ATOMIC_ACQUIRE, "agent");
            xb_add(&bar[XB_XGEN(b.x)], 1u);
            asm volatile("s_waitcnt vmcnt(0)" ::: "memory");
        } else {
            XB_SPIN(xb_ld(&bar[XB_XGEN(b.x)]) == gen, bar);
            __builtin_amdgcn_fence(__ATOMIC_ACQUIRE, "agent");
            asm volatile("s_waitcnt vmcnt(0)" ::: "memory");
        }
    }
    __syncthreads();
}

constexpr int NWAVES = 8, NTHR = 512;
constexpr int RING_BYTES = 131072, MISC_OFF = 139264, LDS_BYTES = 147456;
struct Args {
    const float* in[28]; float* out; unsigned char* ws; int ph_lo, ph_hi;
};
struct Frame {
    LAS unsigned char* lds; int tid, lane, wave, G, bid;
    const float *x, *c, *ctx, *c_ctx, *w_mod, *b_mod, *n_mix_pre, *n_mix_post, *n_ffn_pre, *n_ffn_post, *w_in, *gdn_conv, *ret_log_decay, *gdn_a_log, *gdn_dt_bias,
        *ret_gn_w, *gdn_norm_w, *w_ret_out, *w_gdn_out, *w_o, *w_router, *router_bias, *w_gate, *w_up, *w_down, *w_sh_gate, *w_sh_up, *w_sh_down;
    float* out; unsigned char* ws; unsigned* ctl;
};
#define WSP(T, off) ((T*)(F.ws + (off)))

template <class CM>
__device__ __forceinline__ void transpose_item(const float* W, int ld, int K, bf16* WT, LAS float* scr, int kb, int nb, int lane, const CM& cm) {
    const int k0 = 64 * kb, n0 = 32 * nb; const int sc = cm(n0 + (lane & 31));
    float tv[32];
#pragma unroll
    for (int i = 0; i < 32; ++i) tv[i] = W[(size_t)(k0 + 2 * i + (lane >> 5)) * ld + sc];
#pragma unroll
    for (int i = 0; i < 32; ++i) scr[(2 * i + (lane >> 5)) * 33 + (lane & 31)] = tv[i];
    asm volatile("s_waitcnt lgkmcnt(0)" ::: "memory");
    const int c = lane & 7;
#pragma unroll
    for (int j = 0; j < 4; ++j) { const int n = (lane >> 3) + 8 * j; const LAS float* s = scr + (8 * c) * 33 + n;
        u32x4 o; o.x = pk2(s[0 * 33], s[1 * 33]); o.y = pk2(s[2 * 33], s[3 * 33]); o.z = pk2(s[4 * 33], s[5 * 33]); o.w = pk2(s[6 * 33], s[7 * 33]);
        *(u32x4*)(WT + (size_t)(n0 + n) * K + k0 + 8 * c) = o; }
    asm volatile("s_waitcnt lgkmcnt(0)" ::: "memory");
}
struct CmIdent { int off; __device__ __forceinline__ int operator()(int n) const { return n + off; } };
struct CmWin {
    __device__ __forceinline__ int operator()(int n) const {
        const int g = n >> 9; int src = n + (n >= 2048 ? 16 : 0);
        if (g == 0 || g == 4) { const int hb = n & ~127, cp = n & 127; const int wc = cp >> 5, fq = (cp >> 3) & 3, nn = (cp >> 2) & 1, i = cp & 3;
            const int d = 64 * nn + 16 * wc + 4 * fq + i; src = hb + d + (n >= 2048 ? 16 : 0); }
        return src; }
};
__device__ __forceinline__ void gu_decode(int cp, int& hid, int& isup) { const int pn = cp >> 8, r = cp & 255, bj = r >> 7, wc = (r >> 5) & 3, fq = (r >> 3) & 3, nn = (r >> 2) & 1, i = r & 3; hid = pn * 128 + bj * 64 + wc * 16 + fq * 4 + i; isup = nn; }

__device__ __forceinline__ void phase_prologue(Frame& F) {
    const int gw = F.bid * NWAVES + F.wave, NGW = F.G * NWAVES; const int gt = F.bid * NTHR + F.tid, NGT = F.G * NTHR;
    LAS float* scr = (LAS float*)(F.lds + F.wave * 16384);
    { float2* rt = WSP(float2, WS_ROPE);
      for (int idx = gt; idx < SEQ * 64; idx += NGT) { const int t = idx >> 6, j = idx & 63; const float pos = (float)(j < 32 ? (t >> 6) : (t & 63)); const int f = j & 31;
          const float inv = powf(10000.0f, -(float)f / 32.0f); const float ang = pos * inv; float sn, cs; sincosf(ang, &sn, &cs); rt[idx] = make_float2(cs, sn); } }
    {
        LAS float* red = (LAS float*)(F.lds);
        LAS float* sl = (LAS float*)(F.lds + 16384);
        if (F.bid < 96) { for (int i = F.tid; i < 5 * DM; i += NTHR) { const int r = i >> 10, k = i & 1023; sl[i] = siluf_(r < 4 ? F.c[r * DM + k] : F.c_ctx[k]); } __syncthreads(); }
        for (int it = F.bid; it < 96; it += F.G) {
            const int col = it * 64 + F.lane; float a[5] = {0.f, 0.f, 0.f, 0.f, 0.f};
            const int kb = F.wave * 128;
#pragma unroll 1
            for (int k0 = kb; k0 < kb + 128; k0 += 32) { float wv[32];
#pragma unroll
                for (int kk = 0; kk < 32; ++kk) wv[kk] = F.w_mod[(size_t)(k0 + kk) * 6144 + col];
#pragma unroll
                for (int kk = 0; kk < 32; ++kk) {
#pragma unroll
                    for (int r = 0; r < 5; ++r) a[r] += sl[r * DM + k0 + kk] * wv[kk]; } }
#pragma unroll
            for (int r = 0; r < 5; ++r) red[(F.wave * 5 + r) * 64 + F.lane] = a[r];
            __syncthreads();
            if (F.wave < 5) { float s = F.b_mod[col];
#pragma unroll
                for (int w = 0; w < 8; ++w) s += red[(w * 5 + F.wave) * 64 + F.lane];
                WSP(float, WS_MOD)[F.wave * 6144 + col] = s; }
            __syncthreads();
        }
    }
    {
        constexpr int I_IN = 16 * 192, I_RO = 8 * 32, I_O = 16 * 32; constexpr int NIT = I_IN + 2 * I_RO + I_O;
        for (int it = gw; it < NIT; it += NGW) { int r = it;
            if (r < I_IN) { transpose_item(F.w_in, N_IN, DM, WSP(bf16, WS_WIN), scr, r / 192, r % 192, F.lane, CmWin{}); continue; } r -= I_IN;
            if (r < I_RO) { transpose_item(F.w_ret_out, DM, 512, WSP(bf16, WS_WRO), scr, r / 32, r % 32, F.lane, CmIdent{0}); continue; } r -= I_RO;
            if (r < I_RO) { transpose_item(F.w_gdn_out, DM, 512, WSP(bf16, WS_WGO), scr, r / 32, r % 32, F.lane, CmIdent{0}); continue; } r -= I_RO;
            transpose_item(F.w_o, DM, DM, WSP(bf16, WS_WO), scr, r / 32, r % 32, F.lane, CmIdent{0}); }
    }
}

__device__ __forceinline__ void phase_moe_weights(Frame& F) {
    const int gw = F.bid * NWAVES + F.wave, NGW = F.G * NWAVES;
    LAS float* scr = (LAS float*)(F.lds + F.wave * 16384);
    constexpr int I_GU = 16 * 16  , I_D = 4 * 32;
    for (int it = gw; it < 65 * (I_GU + I_D); it += NGW) {
        const int e = it / (I_GU + I_D); int r = it % (I_GU + I_D);
        if (r < I_GU) {
            const int kb = r / 16, nb = r % 16;
            const int k0 = 64 * kb, n0 = 32 * nb; int hid, isup; gu_decode(n0 + (F.lane & 31), hid, isup);
            const float* Wg = e < 64 ? F.w_gate + (size_t)e * DM * DEXP : F.w_sh_gate; const float* Wu = e < 64 ? F.w_up + (size_t)e * DM * DEXP : F.w_sh_up;
            const float* W = isup ? Wu : Wg;
            float tv[32];
#pragma unroll
            for (int i = 0; i < 32; ++i) tv[i] = W[(size_t)(k0 + 2 * i + (F.lane >> 5)) * DEXP + hid];
#pragma unroll
            for (int i = 0; i < 32; ++i) scr[(2 * i + (F.lane >> 5)) * 33 + (F.lane & 31)] = tv[i];
            asm volatile("s_waitcnt lgkmcnt(0)" ::: "memory");
            const int c = F.lane & 7; bf16* WT = WSP(bf16, WS_WGU) + (size_t)e * 512 * DM;
#pragma unroll
            for (int j = 0; j < 4; ++j) { const int n = (F.lane >> 3) + 8 * j; const LAS float* s = scr + (8 * c) * 33 + n;
                u32x4 o; o.x = pk2(s[0 * 33], s[1 * 33]); o.y = pk2(s[2 * 33], s[3 * 33]); o.z = pk2(s[4 * 33], s[5 * 33]); o.w = pk2(s[6 * 33], s[7 * 33]);
                *(u32x4*)(WT + (size_t)(n0 + n) * DM + k0 + 8 * c) = o; }
            asm volatile("s_waitcnt lgkmcnt(0)" ::: "memory");
        } else { r -= I_GU;
            const float* W = e < 64 ? F.w_down + (size_t)e * DEXP * DM : F.w_sh_down;
            transpose_item(W, DM, DEXP, WSP(bf16, WS_WD) + (size_t)e * DM * DEXP, scr, r / 32, r % 32, F.lane, CmIdent{0}); }
    }
}

template <bool LAT> __device__ __forceinline__ int norm1_row_of(int i) { return LAT ? (i >> 12) * RPB + CTXL + (i & 4095) : i; }
template <bool LAT>
__device__ __forceinline__ void norm1_rows(Frame& F, LAS float* wl, int w0, int nw, int r_lo, int r_hi) {
    const float* mod = WSP(float, WS_MOD);
    int ri = r_lo + w0; if (ri >= r_hi) return;
    f32x4 vn[4];
    { const int row = norm1_row_of<LAT>(ri); const int b = row / RPB, pos = row % RPB; const float* src = pos < CTXL ? F.ctx + ((size_t)b * CTXL + pos) * DM : F.x + ((size_t)b * SEQ + (pos - CTXL)) * DM;
#pragma unroll
      for (int j = 0; j < 4; ++j) vn[j] = *(const f32x4*)(src + 4 * (F.lane + 64 * j)); }
    int pkey = -1; f32x4 pg[4], ps1[4], ps0[4];
    for (; ri < r_hi; ri += nw) {
        const int row = norm1_row_of<LAT>(ri); const int b = row / RPB, pos = row % RPB; const bool isctx = pos < CTXL;
        { const int key = isctx ? 4 : b;
          if (key != pkey) { pkey = key; const float* sh = mod + key * 6144; const float* sc = sh + DM;
#pragma unroll
              for (int j = 0; j < 4; ++j) { const int c0 = 4 * (F.lane + 64 * j); pg[j] = *(const f32x4*)(F.n_mix_pre + c0); ps1[j] = *(const f32x4*)(sc + c0) + 1.0f; ps0[j] = *(const f32x4*)(sh + c0); } } }
        f32x4 v[4]; float ss = 0.f;
#pragma unroll
        for (int j = 0; j < 4; ++j) { v[j] = vn[j]; ss += v[j].x * v[j].x + v[j].y * v[j].y + v[j].z * v[j].z + v[j].w * v[j].w; }
        { const int nri = ri + nw; if (nri < r_hi) { const int nr = norm1_row_of<LAT>(nri); const int nb = nr / RPB, np = nr % RPB; const float* src = np < CTXL ? F.ctx + ((size_t)nb * CTXL + np) * DM : F.x + ((size_t)nb * SEQ + (np - CTXL)) * DM;
#pragma unroll
            for (int j = 0; j < 4; ++j) vn[j] = *(const f32x4*)(src + 4 * (F.lane + 64 * j)); } }
        const float rstd = 1.0f / sqrtf(wave_sum(ss) * (1.f / DM) + EPS);
        f32x2 gp2[8];
#pragma unroll
        for (int p = 0; p < 8; ++p) gp2[p] = (f32x2){0.f, 0.f};
#pragma unroll
        for (int j = 0; j < 4; ++j) { const int c0 = 4 * (F.lane + 64 * j);
            const f32x4 g = pg[j], s1 = ps1[j], s0 = ps0[j];
            f32x4 h; h.x = v[j].x * rstd * g.x * s1.x + s0.x; h.y = v[j].y * rstd * g.y * s1.y + s0.y; h.z = v[j].z * rstd * g.z * s1.z + s0.z; h.w = v[j].w * rstd * g.w * s1.w + s0.w;
            u32x2 o; o.x = pk2(h.x, h.y); o.y = pk2(h.z, h.w);
            *(u32x2*)(WSP(bf16, WS_HX) + (size_t)row * DM + c0) = o;
#pragma unroll
            for (int ph = 0; ph < 2; ++ph) {
                asm volatile("" ::: "memory");
#pragma unroll
                for (int p = 4 * ph; p < 4 * ph + 4; ++p) { const LAS float* wp = wl + (p * DM + c0) * 2; const f32x4 wa = *(const LAS f32x4*)wp, wb = *(const LAS f32x4*)(wp + 4);
                    gp2[p] += (f32x2){wa.x, wa.y} * h.x; gp2[p] += (f32x2){wa.z, wa.w} * h.y; gp2[p] += (f32x2){wb.x, wb.y} * h.z; gp2[p] += (f32x2){wb.z, wb.w} * h.w; } } }
        float gd[16];
#pragma unroll
        for (int p = 0; p < 8; ++p) { gd[2 * p] = gp2[p].x; gd[2 * p + 1] = gp2[p].y; }
        float g8[8], g4[4], g2[2], mine;
        { const bool b0 = F.lane & 1, b1 = F.lane & 2, b2 = F.lane & 4, b3 = F.lane & 8;
#pragma unroll
          for (int i = 0; i < 8; ++i) { const float snd = b0 ? gd[2 * i] : gd[2 * i + 1], kp = b0 ? gd[2 * i + 1] : gd[2 * i]; g8[i] = kp + __shfl_xor(snd, 1); }
#pragma unroll
          for (int i = 0; i < 4; ++i) { const float snd = b1 ? g8[2 * i] : g8[2 * i + 1], kp = b1 ? g8[2 * i + 1] : g8[2 * i]; g4[i] = kp + __shfl_xor(snd, 2); }
#pragma unroll
          for (int i = 0; i < 2; ++i) { const float snd = b2 ? g4[2 * i] : g4[2 * i + 1], kp = b2 ? g4[2 * i + 1] : g4[2 * i]; g2[i] = kp + __shfl_xor(snd, 4); }
          { const float snd = b3 ? g2[0] : g2[1], kp = b3 ? g2[1] : g2[0]; mine = kp + __shfl_xor(snd, 8); }
          mine += __shfl_xor(mine, 16); mine += __shfl_xor(mine, 32); }
        if (F.lane < 16) { const int ab = F.lane >> 3, dir = (F.lane >> 2) & 1, h = F.lane & 3; const size_t o = ((size_t)(dir * NB + b) * NH + h) * RPB + pos;
            if (ab == 0) { const float z = mine + F.gdn_dt_bias[dir * 4 + h]; const float sp = z > 20.f ? z : log1pf(expf(z)); WSP(float, WS_LOGA)[o] = -expf(F.gdn_a_log[dir * 4 + h]) * sp; }
            else WSP(float, WS_BETA)[o] = 1.f / (1.f + expf(-mine)); }
    }
}
__device__ __forceinline__ void phase_norm1(Frame& F) {
    const int gw = F.bid * NWAVES + F.wave, NGW = F.G * NWAVES;
    LAS float* wl = (LAS float*)F.lds;
    for (int k = F.tid; k < DM; k += NTHR) { const float* wr = F.w_in + (size_t)k * N_IN + 2048;
#pragma unroll
        for (int jj = 0; jj < 4; ++jj) { const f32x4 w4 = *(const f32x4*)(wr + 4 * jj);
            *(LAS f32x2*)(wl + ((2 * jj) * DM + k) * 2) = (f32x2){w4.x, w4.y}; *(LAS f32x2*)(wl + ((2 * jj + 1) * DM + k) * 2) = (f32x2){w4.z, w4.w}; } }
    __syncthreads();
    if (F.G < 64) { norm1_rows<false>(F, wl, gw, NGW, 0, NROW); return; }
    if (F.bid < 32) {
        const int b = F.bid >> 3, sub = F.bid & 7; const int r0 = b * RPB + 32 * sub;
        norm1_rows<false>(F, wl, F.wave, NWAVES, r0, r0 + 32);
        asm volatile("s_waitcnt vmcnt(0)" ::: "memory");
        __syncthreads();
        if (F.tid == 0) {
            unsigned* flag = F.ctl + CW_FLAG + 64 * b;
            __builtin_amdgcn_fence(__ATOMIC_RELEASE, "agent"); asm volatile("s_waitcnt vmcnt(0)" ::: "memory");
            __hip_atomic_fetch_add(flag, 1u, __ATOMIC_RELAXED, __HIP_MEMORY_SCOPE_AGENT);
            unsigned sp = 0; while (__hip_atomic_load(flag, __ATOMIC_RELAXED, __HIP_MEMORY_SCOPE_AGENT) < 8u) { __builtin_amdgcn_s_sleep(1); if (++sp > (1u << 22)) break; }
            __builtin_amdgcn_fence(__ATOMIC_ACQUIRE, "agent"); asm volatile("s_waitcnt vmcnt(0)" ::: "memory");
        }
        __syncthreads();
    } else {
        norm1_rows<true>(F, wl, (F.bid - 32) * NWAVES + F.wave, (F.G - 32) * NWAVES, 0, NT);
    }
}

struct SchedIn {
    const char* A; const char* B; int G, c;
    __device__ __forceinline__ bool next(int i, pg8::Unit& u) const {
        const int L = i * G + c; if (L >= (G < 64 ? 1536 + 32 : 1536)) return false;
        int lt, pn;
        if (L < 1536) { int wgid = L; { const int q = 1536 / 8, xcd = wgid % 8, off = wgid / 8; wgid = xcd * q + off; }
            const int nig = 8 * 24, gid = wgid / nig, fm = gid * 8; lt = fm + ((wgid % nig) % 8); pn = (wgid % nig) / 8; u.pm = (lt >> 4) * 17 + 1 + (lt & 15); }
        else { const int q = L - 1536; u.pm = (q >> 3) * 17; pn = q & 7; }
        u.pn = pn; u.e = 0; u.base = 0; u.A = A + (size_t)u.pm * 256 * DM * 2; u.B = B + (size_t)pn * 256 * DM * 2; return true; }
    __device__ __forceinline__ int row_index(const pg8::Unit&, int r) const { return r; }
};
struct SchedCtx {
    const char* A; const char* B; int b, pn;
    __device__ __forceinline__ bool next(int i, pg8::Unit& u) const { if (i > 0) return false; u.pm = b * 17; u.pn = pn; u.e = 0; u.base = 0; u.A = A + (size_t)u.pm * 256 * DM * 2; u.B = B + (size_t)pn * 256 * DM * 2; return true; }
    __device__ __forceinline__ int row_index(const pg8::Unit&, int r) const { return r; }
};
struct EpiIn {
    bf16* P; bf16* GATES; const float2* rope;
    __device__ __forceinline__ void operator()(const f32x4 (&acc)[2][2][4][2], const pg8::Unit& u, int wr, int wc, int fr, int fq) const {
        const int g = u.pn >> 1;
        const int b = u.pm / 17, tl = u.pm % 17;
#pragma unroll
        for (int ai = 0; ai < 2; ++ai)
#pragma unroll
            for (int m = 0; m < 4; ++m) {
                const int rt = ai * 128 + wr * 64 + m * 16 + fr; const size_t prow = (size_t)u.pm * 256 + rt;
#pragma unroll
                for (int bj = 0; bj < 2; ++bj) {
                    f32x4 v0 = acc[ai][bj][m][0], v1 = acc[ai][bj][m][1];
                    const int ct = bj * 128 + wc * 32 + 8 * fq;
                    if (g == 0 || g == 4) {
                        const float s = (g == 0) ? 0.08838834764831845f : 1.0f; v0 = v0 * s; v1 = v1 * s;
                        const int j = 16 * wc + 4 * fq;
                        f32x4 o1 = v0, o2 = v1;
                        if (tl != 0) { const int t = (tl - 1) * 256 + rt; const float2* cs = rope + (size_t)t * 64 + j;
#pragma unroll
                            for (int i = 0; i < 4; ++i) { const float2 c2 = cs[i]; o1[i] = v0[i] * c2.x - v1[i] * c2.y; o2[i] = v0[i] * c2.y + v1[i] * c2.x; } }
                        bf16* dst = P + (size_t)g * PGRP + prow * 512 + (u.pn & 1) * 256 + bj * 128 + j;
                        u32x2 w1, w2; w1.x = pk2(o1[0], o1[1]); w1.y = pk2(o1[2], o1[3]); w2.x = pk2(o2[0], o2[1]); w2.y = pk2(o2[2], o2[3]);
                        *(u32x2*)dst = w1; *(u32x2*)(dst + 64) = w2;
                    } else if (g < 8) {
                        u32x4 w; w.x = pk2(v0[0], v0[1]); w.y = pk2(v0[2], v0[3]); w.z = pk2(v1[0], v1[1]); w.w = pk2(v1[2], v1[3]);
                        *(u32x4*)(P + (size_t)g * PGRP + prow * 512 + (u.pn & 1) * 256 + ct) = w;
                    } else {
                        const size_t lrow = (size_t)b * SEQ + (size_t)(tl - 1) * 256 + rt;
#pragma unroll
                        for (int i = 0; i < 4; ++i) { v0[i] = sigmoidf_(v0[i]); v1[i] = sigmoidf_(v1[i]); }
                        u32x4 w; w.x = pk2(v0[0], v0[1]); w.y = pk2(v0[2], v0[3]); w.z = pk2(v1[0], v1[1]); w.w = pk2(v1[2], v1[3]);
                        *(u32x4*)(GATES + lrow * 2048 + (u.pn - 16) * 256 + ct) = w;
                    }
                }
            }
    }
};

constexpr int IMGB = 34816, IMGS = 272;
typedef short s16x4 __attribute__((ext_vector_type(4)));
__device__ __forceinline__ unsigned offb(unsigned row, unsigned ch) { return 272u * row + 16u * ch; }
__device__ __forceinline__ unsigned offe(unsigned row, unsigned col) { return 272u * row + 2u * col; }
__device__ __forceinline__ bf16x8 frag_row(LAS unsigned char* img, int tile, int s, int lane) { return *(const LAS bf16x8*)(img + offb(16 * tile + (lane & 15), 4 * s + (lane >> 4))); }
__device__ __forceinline__ bf16x8 frag_tr(LAS unsigned char* img, int tile, int s, int lane) {
    const unsigned g = lane >> 4, qq = (lane & 15) >> 2, p = lane & 3;
    const s16x4 lo = __builtin_amdgcn_ds_read_tr16_b64_v4i16((LAS s16x4*)(img + offe(32 * s + 8 * g + qq, 16 * tile + 4 * p)));
    const s16x4 hi = __builtin_amdgcn_ds_read_tr16_b64_v4i16((LAS s16x4*)(img + offe(32 * s + 8 * g + 4 + qq, 16 * tile + 4 * p)));
    return (bf16x8){lo[0], lo[1], lo[2], lo[3], hi[0], hi[1], hi[2], hi[3]};
}
#define MFMA16(a, b, c) __builtin_amdgcn_mfma_f32_16x16x32_bf16(a, b, c, 0, 0, 0)
#define LBAR() do { asm volatile("s_waitcnt lgkmcnt(0)" ::: "memory"); __builtin_amdgcn_s_barrier(); asm volatile("" ::: "memory"); } while (0)
template <bool SWAP>
__device__ __forceinline__ void mm128(LAS unsigned char* ia, bool atr, LAS unsigned char* ib, bool btr, int wr, int wc, int lane, f32x4 (&acc)[2][4]) {
#pragma unroll
    for (int s = 0; s < 4; ++s) {
        bf16x8 fa[2], fb[4];
#pragma unroll
        for (int i = 0; i < 2; ++i) fa[i] = atr ? frag_tr(ia, 2 * wr + i, s, lane) : frag_row(ia, 2 * wr + i, s, lane);
#pragma unroll
        for (int j = 0; j < 4; ++j) fb[j] = btr ? frag_tr(ib, 4 * wc + j, s, lane) : frag_row(ib, 4 * wc + j, s, lane);
#pragma unroll
        for (int i = 0; i < 2; ++i)
#pragma unroll
            for (int j = 0; j < 4; ++j) acc[i][j] = SWAP ? MFMA16(fb[j], fa[i], acc[i][j]) : MFMA16(fa[i], fb[j], acc[i][j]);
    }
}
__device__ __forceinline__ void zero_acc(f32x4 (&acc)[2][4]) {
#pragma unroll
    for (int i = 0; i < 2; ++i)
#pragma unroll
        for (int j = 0; j < 4; ++j) acc[i][j] = (f32x4){0.f, 0.f, 0.f, 0.f};
}
__device__ __forceinline__ void st_img(LAS unsigned char* img, const f32x4 (&acc)[2][4], int wr, int wc, int lane) {
    const int r = lane & 15, q = lane >> 4;
#pragma unroll
    for (int i = 0; i < 2; ++i)
#pragma unroll
        for (int j = 0; j < 4; ++j) { u32x2 w; w.x = pk2(acc[i][j][0], acc[i][j][1]); w.y = pk2(acc[i][j][2], acc[i][j][3]);
            *(LAS u32x2*)(img + offe(32 * wr + 16 * i + r, 64 * wc + 16 * j + 4 * q)) = w; }
}
__device__ __forceinline__ void load_plain_img(LAS unsigned char* img, const bf16* src, int ld, int tid) {
#pragma unroll
    for (int i = 0; i < 4; ++i) { const int cidx = tid + 512 * i, row = cidx >> 4, ch = cidx & 15;
        *(LAS u32x4*)(img + offb(row, ch)) = *(const u32x4*)(src + (size_t)row * ld + 8 * ch); }
}
__device__ __forceinline__ void load_conv_img(LAS unsigned char* img, const bf16* src, const float* cw  , bool has_prev, bool has_next, int mode  , int wave, int lane) {
    asm volatile("" ::: "memory");
    const int ch = lane & 15; float w0[8], w1[8], w2[8];
#pragma unroll
    for (int i = 0; i < 8; ++i) { w0[i] = cw[8 * ch + i]; w1[i] = cw[1536 + 8 * ch + i]; w2[i] = cw[3072 + 8 * ch + i]; }
#pragma unroll
    for (int it = 0; it < 4; ++it) {
        const int row = 32 * it + 4 * wave + (lane >> 4); const u32x4 z4 = {0u, 0u, 0u, 0u};
        const u32x4 r0 = (row > 0 || has_prev) ? *(const u32x4*)(src + ((ptrdiff_t)row - 1) * 512 + 8 * ch) : z4;
        const u32x4 r1 = *(const u32x4*)(src + (size_t)row * 512 + 8 * ch);
        const u32x4 r2 = (row < 127 || has_next) ? *(const u32x4*)(src + (size_t)(row + 1) * 512 + 8 * ch) : z4;
        float a0[8], a1[8], a2[8], y[8]; unpack8(r0, a0); unpack8(r1, a1); unpack8(r2, a2); float ss = 0.f;
#pragma unroll
        for (int i = 0; i < 8; ++i) { y[i] = siluf_(w0[i] * a0[i] + w1[i] * a1[i] + w2[i] * a2[i]); ss += y[i] * y[i]; }
        if (mode != 1) { const float sc = (1.0f / sqrtf(sum16(ss) + EPS)) * (mode == 2 ? 0.08838834764831845f : 1.0f);
#pragma unroll
            for (int i = 0; i < 8; ++i) y[i] *= sc; }
        *(LAS u32x4*)(img + offb(row, ch)) = pack8(y);
    }
}
__device__ __forceinline__ void load_conv_img2(LAS unsigned char* imgA, const bf16* srcA, const float* cwA, int ma, LAS unsigned char* imgB, const bf16* srcB, const float* cwB, int mb, bool has_prev, bool has_next, int wave, int lane) {
    asm volatile("" ::: "memory");
    const int ch = lane & 15; float wa0[8], wa1[8], wa2[8], wb0[8], wb1[8], wb2[8];
#pragma unroll
    for (int i = 0; i < 8; ++i) { wa0[i] = cwA[8 * ch + i]; wa1[i] = cwA[1536 + 8 * ch + i]; wa2[i] = cwA[3072 + 8 * ch + i]; wb0[i] = cwB[8 * ch + i]; wb1[i] = cwB[1536 + 8 * ch + i]; wb2[i] = cwB[3072 + 8 * ch + i]; }
#pragma unroll
    for (int it = 0; it < 4; ++it) {
        const int row = 32 * it + 4 * wave + (lane >> 4); const u32x4 z4 = {0u, 0u, 0u, 0u}; const bool hp = (row > 0 || has_prev), hn = (row < 127 || has_next);
        const u32x4 a0 = hp ? *(const u32x4*)(srcA + ((ptrdiff_t)row - 1) * 512 + 8 * ch) : z4, a1 = *(const u32x4*)(srcA + (size_t)row * 512 + 8 * ch), a2 = hn ? *(const u32x4*)(srcA + (size_t)(row + 1) * 512 + 8 * ch) : z4;
        const u32x4 b0 = hp ? *(const u32x4*)(srcB + ((ptrdiff_t)row - 1) * 512 + 8 * ch) : z4, b1 = *(const u32x4*)(srcB + (size_t)row * 512 + 8 * ch), b2 = hn ? *(const u32x4*)(srcB + (size_t)(row + 1) * 512 + 8 * ch) : z4;
        { float x0[8], x1[8], x2[8], y[8]; unpack8(a0, x0); unpack8(a1, x1); unpack8(a2, x2); float ss = 0.f;
#pragma unroll
          for (int i = 0; i < 8; ++i) { y[i] = siluf_(wa0[i] * x0[i] + wa1[i] * x1[i] + wa2[i] * x2[i]); ss += y[i] * y[i]; }
          if (ma != 1) { const float sc = (1.0f / sqrtf(sum16(ss) + EPS)) * (ma == 2 ? 0.08838834764831845f : 1.0f);
#pragma unroll
              for (int i = 0; i < 8; ++i) y[i] *= sc; }
          *(LAS u32x4*)(imgA + offb(row, ch)) = pack8(y); }
        { float x0[8], x1[8], x2[8], y[8]; unpack8(b0, x0); unpack8(b1, x1); unpack8(b2, x2); float ss = 0.f;
#pragma unroll
          for (int i = 0; i < 8; ++i) { y[i] = siluf_(wb0[i] * x0[i] + wb1[i] * x1[i] + wb2[i] * x2[i]); ss += y[i] * y[i]; }
          if (mb != 1) { const float sc = (1.0f / sqrtf(sum16(ss) + EPS)) * (mb == 2 ? 0.08838834764831845f : 1.0f);
#pragma unroll
              for (int i = 0; i < 8; ++i) y[i] *= sc; }
          *(LAS u32x4*)(imgB + offb(row, ch)) = pack8(y); }
    }
}
__device__ __forceinline__ void scale_rows_img(LAS unsigned char* dst, LAS unsigned char* src, const LAS float* rs, int tid) {
#pragma unroll
    for (int i = 0; i < 4; ++i) { const int cidx = tid + 512 * i, row = cidx >> 4, ch = cidx & 15; float v[8]; unpack8(*(const LAS u32x4*)(src + offb(row, ch)), v); const float sc = rs[row];
#pragma unroll
        for (int e = 0; e < 8; ++e) v[e] *= sc;
        *(LAS u32x4*)(dst + offb(row, ch)) = pack8(v); }
}
__device__ __forceinline__ void tri_inverse(LAS unsigned char* img, int w, int lane) {
    const int r = lane & 15, q = lane >> 4;
    {
        const int b0 = 16 * w; float x[16];
#pragma unroll
        for (int i = 0; i < 16; ++i) { float v = (i == r) ? 1.f : 0.f;
#pragma unroll
            for (int j = 0; j < i; ++j) v -= bf2f(*(const LAS unsigned short*)(img + offe(b0 + i, b0 + j))) * x[j];
            x[i] = v; }
        if (q == 0) {
#pragma unroll
            for (int i = 0; i < 16; ++i) *(LAS unsigned short*)(img + offe(b0 + i, b0 + r)) = (unsigned short)f2bf(x[i]); }
    }
    LBAR();
    if (w < 4) {
        const int c0 = 32 * w, r1 = c0 + 16;
        const u32x2 av = *(const LAS u32x2*)(img + offe(r1 + r, c0 + 4 * q));
        const bf16x8 fa = __builtin_bit_cast(bf16x8, (u32x4){av.x, av.y, 0u, 0u});
        const s16x4 tb = __builtin_amdgcn_ds_read_tr16_b64_v4i16((LAS s16x4*)(img + offe(c0 + 4 * q + (r >> 2), c0 + 4 * (r & 3))));
        const bf16x8 fb = (bf16x8){tb[0], tb[1], tb[2], tb[3], 0, 0, 0, 0};
        const f32x4 y = MFMA16(fa, fb, ((f32x4){0.f, 0.f, 0.f, 0.f}));
        const bf16x8 fy = __builtin_bit_cast(bf16x8, (u32x4){pk2(y[0], y[1]), pk2(y[2], y[3]), 0u, 0u});
        const u32x2 tv = *(const LAS u32x2*)(img + offe(r1 + r, r1 + 4 * q));
        const bf16x8 ft = __builtin_bit_cast(bf16x8, (u32x4){tv.x, tv.y, 0u, 0u});
        const f32x4 d = MFMA16(fy, ft, ((f32x4){0.f, 0.f, 0.f, 0.f}));
        u32x2 o; o.x = pk2(-d[0], -d[1]); o.y = pk2(-d[2], -d[3]);
        *(LAS u32x2*)(img + offe(r1 + r, c0 + 4 * q)) = o;
    }
    LBAR();
    {
        const int p = w >> 2, ti = (w >> 1) & 1, tj = w & 1, base = 64 * p, rb = base + 32;
        f32x4 y[2];
        const unsigned g = lane >> 4, qq = (lane & 15) >> 2, pp = lane & 3;
        const s16x4 lo = __builtin_amdgcn_ds_read_tr16_b64_v4i16((LAS s16x4*)(img + offe(base + 8 * g + qq, base + 16 * tj + 4 * pp)));
        const s16x4 hi = __builtin_amdgcn_ds_read_tr16_b64_v4i16((LAS s16x4*)(img + offe(base + 8 * g + 4 + qq, base + 16 * tj + 4 * pp)));
        const bf16x8 fb = (bf16x8){lo[0], lo[1], lo[2], lo[3], hi[0], hi[1], hi[2], hi[3]};
#pragma unroll
        for (int kt = 0; kt < 2; ++kt) { const bf16x8 fa = *(const LAS bf16x8*)(img + offb(rb + 16 * kt + r, (base >> 3) + q)); y[kt] = MFMA16(fa, fb, ((f32x4){0.f, 0.f, 0.f, 0.f})); }
        const bf16x8 fy = __builtin_bit_cast(bf16x8, (u32x4){pk2(y[0][0], y[0][1]), pk2(y[0][2], y[0][3]), pk2(y[1][0], y[1][1]), pk2(y[1][2], y[1][3])});
        const u32x2 t0 = *(const LAS u32x2*)(img + offe(rb + 16 * ti + r, rb + 4 * q)), t1 = *(const LAS u32x2*)(img + offe(rb + 16 * ti + r, rb + 16 + 4 * q));
        const bf16x8 ft = __builtin_bit_cast(bf16x8, (u32x4){t0.x, t0.y, t1.x, t1.y});
        const f32x4 d = MFMA16(fy, ft, ((f32x4){0.f, 0.f, 0.f, 0.f}));
        LBAR();
        u32x2 o; o.x = pk2(-d[0], -d[1]); o.y = pk2(-d[2], -d[3]);
        *(LAS u32x2*)(img + offe(rb + 16 * ti + r, base + 16 * tj + 4 * q)) = o;
    }
    LBAR();
    {
        const int tj = w >> 1, ti0 = 2 * (w & 1);
        f32x4 y[4];
#pragma unroll
        for (int kt = 0; kt < 4; ++kt) y[kt] = (f32x4){0.f, 0.f, 0.f, 0.f};
#pragma unroll
        for (int s = 0; s < 2; ++s) { const bf16x8 fb = frag_tr(img, tj, s, lane);
#pragma unroll
            for (int kt = 0; kt < 4; ++kt) y[kt] = MFMA16(frag_row(img, 4 + kt, s, lane), fb, y[kt]); }
        f32x4 d[2];
#pragma unroll
        for (int i = 0; i < 2; ++i) { d[i] = (f32x4){0.f, 0.f, 0.f, 0.f};
#pragma unroll
            for (int ks = 0; ks < 2; ++ks) {
                const bf16x8 fy = __builtin_bit_cast(bf16x8, (u32x4){pk2(y[2 * ks][0], y[2 * ks][1]), pk2(y[2 * ks][2], y[2 * ks][3]), pk2(y[2 * ks + 1][0], y[2 * ks + 1][1]), pk2(y[2 * ks + 1][2], y[2 * ks + 1][3])});
                const int row = 64 + 16 * (ti0 + i) + r;
                const u32x2 t0 = *(const LAS u32x2*)(img + offe(row, 64 + 32 * ks + 4 * q)), t1 = *(const LAS u32x2*)(img + offe(row, 64 + 32 * ks + 16 + 4 * q));
                d[i] = MFMA16(fy, __builtin_bit_cast(bf16x8, (u32x4){t0.x, t0.y, t1.x, t1.y}), d[i]); } }
        LBAR();
#pragma unroll
        for (int i = 0; i < 2; ++i) { u32x2 o; o.x = pk2(-d[i][0], -d[i][1]); o.y = pk2(-d[i][2], -d[i][3]);
            *(LAS u32x2*)(img + offe(64 + 16 * (ti0 + i) + r, 16 * tj + 4 * q)) = o; }
    }
    LBAR();
}

__device__ __forceinline__ void phase_prep(Frame& F) {
    LAS unsigned char* I0 = F.lds; LAS unsigned char* I1 = F.lds + IMGB; LAS unsigned char* I2 = F.lds + 2 * IMGB; LAS unsigned char* I3 = F.lds + 3 * IMGB;
    LAS float* sm = (LAS float*)(F.lds + MISC_OFF + 1024);
    LAS float* s_t1 = sm; LAS float* s_t2 = sm + 128; LAS float* sdir = sm + 256;
#define LAUNDER() int tz_ = threadIdx.x; asm volatile("" : "+v"(tz_)); const int tid = tz_, lane = tz_ & 63, w = __builtin_amdgcn_readfirstlane(tz_ >> 6), wr = w >> 1, wc = w & 1, r = lane & 15, q = lane >> 4; (void)tid; (void)lane; (void)w; (void)wr; (void)wc; (void)r; (void)q
    const bf16* P = WSP(bf16, WS_P);
    for (int it = F.bid; it < 512 + 96; it += F.G) {
        int b, h, m, part = 3;
        if (it < 512) { b = it >> 7; h = (it >> 5) & 3; m = 2 + (it & 31); } else { const int c3 = it - 512; const int c = c3 / 3; part = c3 - 3 * c; b = c >> 3; h = (c >> 1) & 3; m = c & 1; }
        const bool isctx = m < 2; const int pos0 = 128 * m; const size_t row0 = (size_t)b * RPB + pos0; const size_t trow0 = (size_t)b * SEQ + (pos0 - CTXL);
        const bool hprev = isctx ? (m > 0) : (m > 2), hnext = isctx ? (m < 1) : (m < NCHUNK - 1);
        const size_t hoff = row0 * 512 + h * 128;
        f32x4 acc[2][4];
        if (part == 3 || part == 0) {
        const float lgf = F.ret_log_decay[h] * 1.4426950408889634f, lgb = F.ret_log_decay[4 + h] * 1.4426950408889634f;
        { LAUNDER();
        load_plain_img(I0, P + 0 * PGRP + hoff, 512, tid); load_plain_img(I1, P + 1 * PGRP + hoff, 512, tid);
        if (!isctx) load_plain_img(I2, P + 4 * PGRP + hoff, 512, tid);
        if (tid < 128) { s_t1[tid] = exp2f(lgf * (float)(127 - tid)); s_t2[tid] = exp2f(lgb * (float)tid); } }
        LBAR();
        if (!isctx) {
            { LAUNDER();
            zero_acc(acc); mm128<true>(I2, false, I0, false, wr, wc, lane, acc);
#pragma unroll
            for (int i = 0; i < 2; ++i)
#pragma unroll
                for (int j = 0; j < 4; ++j)
#pragma unroll
                    for (int e = 0; e < 4; ++e) { const int ii = 32 * wr + 16 * i + r, jj = 64 * wc + 16 * j + 4 * q + e; const int d = ii - jj;
                        const float wg = (d >= 0 ? exp2f(lgf * (float)d) : 0.f) + (d <= 0 ? exp2f(lgb * (float)(-d)) : 0.f); acc[i][j][e] *= wg; }
            st_img(I3, acc, wr, wc, lane); }
            LBAR();
            { LAUNDER();
            zero_acc(acc); mm128<true>(I3, false, I1, true, wr, wc, lane, acc);
            bf16* og = WSP(bf16, WS_ORET) + (trow0 + 32 * wr + r) * 512 + h * 128 + 64 * wc + 4 * q;
#pragma unroll
            for (int i = 0; i < 2; ++i)
#pragma unroll
                for (int j = 0; j < 4; ++j) { u32x2 o; o.x = pk2(acc[i][j][0], acc[i][j][1]); o.y = pk2(acc[i][j][2], acc[i][j][3]); *(u32x2*)(og + (size_t)(16 * i) * 512 + 16 * j) = o; } }
        }
#pragma unroll 1
        for (int dir = 0; dir < 2; ++dir) {
            LAS unsigned char* kw = dir ? I3 : I2;
            { LAUNDER(); scale_rows_img(kw, I0, dir ? s_t2 : s_t1, tid); }
            LBAR();
            LAUNDER();
            zero_acc(acc); mm128<false>(kw, true, I1, true, wr, wc, lane, acc);
            const int chain = (b * NH + h) * 2 + dir, n = dir ? (isctx ? 1 - m : 35 - m) : m;
            unsigned char* kv = F.ws + WS_GKV + ((size_t)chain * NCHUNK + n) * 32768;
#pragma unroll
            for (int i = 0; i < 2; ++i)
#pragma unroll
                for (int j = 0; j < 4; ++j) { const int mt = 2 * wr + i, nt = 4 * wc + j; u32x2 o; o.x = pk2(acc[i][j][0], acc[i][j][1]); o.y = pk2(acc[i][j][2], acc[i][j][3]);
                    *(u32x2*)(kv + ((size_t)((nt * 4 + (mt >> 1)) * 64 + (2 * (mt & 1) + (q >> 1)) * 16 + r)) * 16 + 8 * (q & 1)) = o; }
        }
        LBAR();
        }
        if (part != 0) {
        const bool hasq = !isctx;
        f32x4 gacc[2][4], qk[2][4]; u32x2 qv[2][4];
        if (hasq) { LAUNDER(); load_conv_img2(I0, P + 2 * PGRP + hoff, F.gdn_conv + 512 + h * 128, 0, I1, P + 6 * PGRP + hoff, F.gdn_conv + h * 128, 2, hprev, hnext, w, lane); }
        else { LAUNDER(); load_conv_img(I0, P + 2 * PGRP + hoff, F.gdn_conv + 512 + h * 128, hprev, hnext, 0, w, lane); }
        { LAUNDER(); if (tid < 256) { const int d2 = tid >> 7, i2 = tid & 127; const size_t o = ((size_t)(d2 * NB + b) * NH + h) * RPB + pos0 + i2; sdir[d2 * 640 + i2] = WSP(float, WS_LOGA)[o]; sdir[d2 * 640 + 128 + i2] = WSP(float, WS_BETA)[o]; } }
        LBAR();
        { LAUNDER();
          if (w < 2) {
              LAS float* sd = sdir + w * 640;
              const float a = sd[2 * lane], c = sd[2 * lane + 1]; const float pr = a + c; float inc = pr;
#pragma unroll
              for (int o = 1; o < 64; o <<= 1) { const float t = __shfl_up(inc, o); if (lane >= o) inc += t; }
              const float tot = __shfl(inc, 63); const float ex = inc - pr;
              float g0 = ex + a, g1 = ex + pr;
              if (w) { g0 = tot - ex; g1 = tot - (ex + a); }
              sd[256 + 2 * lane] = g0; sd[256 + 2 * lane + 1] = g1; sd[384 + 2 * lane] = __expf(g0); sd[384 + 2 * lane + 1] = __expf(g1);
              sd[512 + 2 * lane] = __expf(tot - g0); sd[512 + 2 * lane + 1] = __expf(tot - g1);
              asm volatile("s_waitcnt lgkmcnt(0)" ::: "memory");
              if (lane == 0) sd[0] = __expf(tot);
          }
          zero_acc(gacc); mm128<true>(I0, false, I0, false, wr, wc, lane, gacc);
          if (hasq) { zero_acc(qk); mm128<true>(I1, false, I0, false, wr, wc, lane, qk);
#pragma unroll
              for (int i = 0; i < 2; ++i)
#pragma unroll
                  for (int j = 0; j < 4; ++j) qv[i][j] = *(const LAS u32x2*)(I1 + offe(32 * wr + 16 * i + r, 64 * wc + 16 * j + 4 * q)); } }
        LBAR();
#pragma unroll 1
        for (int dir = (part == 2 ? 1 : 0); dir < (part == 3 ? 2 : part); ++dir) {
            const int chain = (b * NH + h) * 2 + dir, n = dir ? (isctx ? 1 - m : 35 - m) : m;
            { LAUNDER(); load_conv_img(I1, P + 3 * PGRP + hoff, F.gdn_conv + 1024 + h * 128, hprev, hnext, 1, w, lane); }
            LAS float* s_bet = sdir + dir * 640 + 128; LAS float* s_gc = sdir + dir * 640 + 256; LAS float* s_eg = sdir + dir * 640 + 384; LAS float* s_s2 = sdir + dir * 640 + 512;
            LBAR();
            { LAUNDER();
#pragma unroll
            for (int i = 0; i < 2; ++i)
#pragma unroll
                for (int j = 0; j < 4; ++j) { const int ii = 32 * wr + 16 * i + r; const float gi = s_gc[ii], bi = s_bet[ii];
#pragma unroll
                    for (int e = 0; e < 4; ++e) { const int jj = 64 * wc + 16 * j + 4 * q + e;
                        const float f = dir ? s_bet[jj] * __expf(s_gc[jj] - gi) : bi * __expf(gi - s_gc[jj]); acc[i][j][e] = (ii > jj) ? gacc[i][j][e] * f : 0.f; } }
            st_img(I2, acc, wr, wc, lane); }
            LBAR();
            { LAUNDER(); tri_inverse(I2, w, lane); }
            { LAUNDER();
#pragma unroll
            for (int i = 0; i < 4; ++i) { const int cidx = tid + 512 * i, row = cidx >> 4, ch = cidx & 15; float v[8], v2[8]; unpack8(*(const LAS u32x4*)(I2 + offb(row, ch)), v);
#pragma unroll
                for (int e = 0; e < 8; ++e) { const int k = dir ? row : 8 * ch + e; const float bb = s_bet[k]; v[e] *= bb; v2[e] = v[e] * s_eg[k]; }
                *(LAS u32x4*)(I2 + offb(row, ch)) = pack8(v); *(LAS u32x4*)(I3 + offb(row, ch)) = pack8(v2); } }
            LBAR();
            { LAUNDER();
            zero_acc(acc); mm128<true>(I3, dir != 0, I0, true, wr, wc, lane, acc);
            LBAR();
            st_img(I3, acc, wr, wc, lane); }
            { LAUNDER();
            zero_acc(acc); mm128<true>(I2, dir != 0, I1, true, wr, wc, lane, acc);
            LBAR();
            st_img(I2, acc, wr, wc, lane);
            scale_rows_img(I1, I0, s_s2, tid); }
            LBAR();
            {
                LAUNDER();
                zero_acc(acc); mm128<false>(I1, true, I2, true, wr, wc, lane, acc);
                unsigned char* gc = F.ws + WS_GC + ((size_t)chain * NCHUNK + n) * 32768;
#pragma unroll
                for (int i = 0; i < 2; ++i)
#pragma unroll
                    for (int j = 0; j < 4; ++j) { const int mt = 2 * wr + i, nt = 4 * wc + j; u32x2 o; o.x = pk2(acc[i][j][0], acc[i][j][1]); o.y = pk2(acc[i][j][2], acc[i][j][3]);
                        *(u32x2*)(gc + ((size_t)((nt * 8 + mt) * 64 + lane)) * 8) = o; }
                }
                { LAUNDER(); const float dtot = sdir[dir * 640];
                zero_acc(acc); mm128<true>(I1, true, I3, true, wr, wc, lane, acc);
                unsigned char* gm = F.ws + WS_GM + ((size_t)chain * NCHUNK + n) * 32768;
#pragma unroll
                for (int i = 0; i < 2; ++i)
#pragma unroll
                    for (int j = 0; j < 4; ++j) { const int mt = 2 * wr + i, ct = 4 * wc + j; const int rowi = 16 * mt + r; float v[4];
#pragma unroll
                        for (int e = 0; e < 4; ++e) v[e] = ((rowi == 16 * ct + 4 * q + e) ? dtot : 0.f) - acc[i][j][e];
                        u32x2 o; o.x = pk2(v[0], v[1]); o.y = pk2(v[2], v[3]);
                        *(u32x2*)(gm + ((size_t)((mt * 4 + (ct >> 1)) * 64 + q * 16 + r)) * 16 + 8 * (ct & 1)) = o; }
            }
            LBAR();
            if (hasq) {
                { LAUNDER();
#pragma unroll
                for (int i = 0; i < 2; ++i) { const int ii = 32 * wr + 16 * i + r; const float gi = s_gc[ii];
#pragma unroll
                    for (int j = 0; j < 4; ++j)
#pragma unroll
                        for (int e = 0; e < 4; ++e) { const int jj = 64 * wc + 16 * j + 4 * q + e; const bool on = dir ? (jj >= ii) : (jj <= ii);
                            acc[i][j][e] = on ? qk[i][j][e] * __expf(gi - s_gc[jj]) : 0.f; } }
                st_img(I1, acc, wr, wc, lane); }
                LBAR();
                { LAUNDER();
                zero_acc(acc); mm128<true>(I1, false, I2, true, wr, wc, lane, acc);
                { bf16* ogp = WSP(bf16, WS_OGDN) + (trow0 + 32 * wr + r) * 512 + h * 128 + 64 * wc + 4 * q;
#pragma unroll
                  for (int i = 0; i < 2; ++i)
#pragma unroll
                    for (int j = 0; j < 4; ++j) { bf16* pp = ogp + (size_t)(16 * i) * 512 + 16 * j; f32x4 v = acc[i][j];
                        if (dir) { const u32x2 pv = *(const u32x2*)pp; v[0] += bflo(pv.x); v[1] += bfhi(pv.x); v[2] += bflo(pv.y); v[3] += bfhi(pv.y); }
                        u32x2 o; o.x = pk2(v[0], v[1]); o.y = pk2(v[2], v[3]); *(u32x2*)pp = o; } } }
                { LAUNDER();
                zero_acc(acc); mm128<true>(I1, false, I3, true, wr, wc, lane, acc);
                unsigned char* qt = F.ws + WS_GQT + ((size_t)chain * 32 + (n - 2)) * 32768;
#pragma unroll
                for (int i = 0; i < 2; ++i) { const int ii = 32 * wr + 16 * i + r; const float egi = s_eg[ii];
#pragma unroll
                    for (int j = 0; j < 4; ++j) { const int mt = 2 * wr + i, ct = 4 * wc + j; const u32x2 qq2 = qv[i][j];
                        u32x2 o; o.x = pk2(egi * bflo(qq2.x) - acc[i][j][0], egi * bfhi(qq2.x) - acc[i][j][1]); o.y = pk2(egi * bflo(qq2.y) - acc[i][j][2], egi * bfhi(qq2.y) - acc[i][j][3]);
                        *(u32x2*)(qt + ((size_t)((mt * 4 + (ct >> 1)) * 64 + q * 16 + r)) * 16 + 8 * (ct & 1)) = o; } } }
                LBAR();
            }
        }
        }
    }
#undef LAUNDER
}

__device__ __forceinline__ void phase_scan(Frame& F) {
    const int lane = F.lane, w = F.wave, tid = F.tid;
    for (int it = F.bid; it < 256; it += F.G) {
        if (it < 128) {
            const int chain = (it & 7) * 4 + (it >> 5), dq = (it >> 3) & 3;
            const unsigned char* gm = F.ws + WS_GM + (size_t)chain * NCHUNK * 32768; unsigned char* gc = F.ws + WS_GC + (size_t)chain * NCHUNK * 32768;
            const unsigned char* gcs = gc + (size_t)(2 * dq) * 4096;
            if (w >= 4) {
                const int j = tid - 256; u32x4 sA[10], sB[10], sC[10], sD[10];
#define SCAN_LD(dst, n_) do { _Pragma("unroll") for (int i_ = 0; i_ < 8; ++i_) dst[i_] = *(const u32x4*)(gm + (size_t)(n_) * 32768 + (size_t)(j + 256 * i_) * 16); \
                              _Pragma("unroll") for (int i_ = 0; i_ < 2; ++i_) dst[8 + i_] = *(const u32x4*)(gcs + (size_t)(n_) * 32768 + (size_t)(j + 256 * i_) * 16); } while (0)
#define SCAN_ST(n_, src) do { LAS unsigned char* buf_ = F.lds + ((n_) % 3) * 40960; \
                              _Pragma("unroll") for (int i_ = 0; i_ < 8; ++i_) *(LAS u32x4*)(buf_ + (size_t)(j + 256 * i_) * 16) = src[i_]; \
                              _Pragma("unroll") for (int i_ = 0; i_ < 2; ++i_) *(LAS u32x4*)(buf_ + 32768 + (size_t)(j + 256 * i_) * 16) = src[8 + i_]; \
                              if ((n_) + 4 < NCHUNK) SCAN_LD(src, (n_) + 4); LBAR(); } while (0)
                SCAN_LD(sA, 0); SCAN_LD(sB, 1); SCAN_LD(sC, 2); SCAN_LD(sD, 3);
#pragma unroll 1
                for (int n = 0; n < 32; n += 4) { SCAN_ST(n, sA); SCAN_ST(n + 1, sB); SCAN_ST(n + 2, sC); SCAN_ST(n + 3, sD); }
                SCAN_ST(32, sA); SCAN_ST(33, sB);
#undef SCAN_LD
#undef SCAN_ST
            } else if (w < 2) {
                const int nt = 2 * dq + w;
                bf16x8 sf[4];
#pragma unroll
                for (int s = 0; s < 4; ++s) sf[s] = (bf16x8){0, 0, 0, 0, 0, 0, 0, 0};
#pragma unroll 1
                for (int n = 0; n < NCHUNK; ++n) {
                    LBAR();
                    const LAS unsigned char* buf = F.lds + (n % 3) * 40960; const LAS unsigned char* cb = buf + 32768 + w * 4096;
                    unsigned char* slot = gc + (size_t)n * 32768 + (size_t)nt * 4096; f32x4 acc[8];
#pragma unroll
                    for (int mt = 0; mt < 8; ++mt) { const u32x2 cv = *(const LAS u32x2*)(cb + (mt * 64 + lane) * 8); acc[mt] = (f32x4){bflo(cv.x), bfhi(cv.x), bflo(cv.y), bfhi(cv.y)}; }
#pragma unroll
                    for (int s = 0; s < 4; ++s)
#pragma unroll
                        for (int mt = 0; mt < 8; ++mt) acc[mt] = MFMA16(*(const LAS bf16x8*)(buf + ((mt * 4 + s) * 64 + lane) * 16), sf[s], acc[mt]);
#pragma unroll
                    for (int s = 0; s < 4; ++s) { const u32x4 pk = {pk2(acc[2 * s][0], acc[2 * s][1]), pk2(acc[2 * s][2], acc[2 * s][3]), pk2(acc[2 * s + 1][0], acc[2 * s + 1][1]), pk2(acc[2 * s + 1][2], acc[2 * s + 1][3])};
                        sf[s] = __builtin_bit_cast(bf16x8, pk); *(u32x4*)(slot + (size_t)(s * 64 + lane) * 16) = pk; }
                }
            } else {
#pragma unroll 1
                for (int n = 0; n < NCHUNK; ++n) LBAR();
            }
            LBAR();
#if defined(PROBE_PH) && PROBE_PH == 204
            if (F.bid == 0 && tid == 0) ((volatile LAS unsigned long long*)(F.lds + MISC_OFF + 896))[5] = __builtin_amdgcn_s_memrealtime();
#endif
        } else {
            const int gidx = (it - 128) * NTHR + tid; const int chain = gidx >> 11, piece = gidx & 2047; const int h = (chain >> 1) & 3, dir = chain & 1;
            const float dec = expf(F.ret_log_decay[dir * 4 + h] * 128.f);
            unsigned char* kv = F.ws + WS_GKV + (size_t)chain * NCHUNK * 32768 + (size_t)piece * 16;
            float st[8];
#pragma unroll
            for (int e = 0; e < 8; ++e) st[e] = 0.f;
#pragma unroll 1
            for (int n0 = 0; n0 < NCHUNK; n0 += 17) { u32x4 v8[17];
#pragma unroll
                for (int j = 0; j < 17; ++j) v8[j] = *(const u32x4*)(kv + (size_t)(n0 + j) * 32768);
#pragma unroll
                for (int j = 0; j < 17; ++j) { float v[8]; unpack8(v8[j], v);
#pragma unroll
                    for (int e = 0; e < 8; ++e) st[e] = dec * st[e] + v[e];
                    *(u32x4*)(kv + (size_t)(n0 + j) * 32768) = pack8(st); } }
        }
    }
}

__device__ __forceinline__ void phase_out(Frame& F) {
    const bf16* P = WSP(bf16, WS_P);
    for (int it = F.bid; it < 512; it += F.G) {
        int tz_ = threadIdx.x; asm volatile("" : "+v"(tz_)); const int tid = tz_, lane = tz_ & 63, w = __builtin_amdgcn_readfirstlane(tz_ >> 6), r = lane & 15, q = lane >> 4;
        const int b = it >> 7, h = (it >> 5) & 3, m = 2 + (it & 31);
        const size_t prow = (size_t)b * RPB + 128 * m + 16 * w + r; const size_t trow = (size_t)b * SEQ + 128 * (m - 2) + 16 * w + r;
        const int il = 16 * w + r;
        bf16x8 fqg[2][4], fqr[4];
#pragma unroll
        for (int dir = 0; dir < 2; ++dir) { const int chain = (b * NH + h) * 2 + dir, n = dir ? 35 - m : m; const unsigned char* qt = F.ws + WS_GQT + ((size_t)chain * 32 + (n - 2)) * 32768;
#pragma unroll
            for (int s = 0; s < 4; ++s) fqg[dir][s] = *(const bf16x8*)(qt + (size_t)((w * 4 + s) * 64 + lane) * 16); }
        { const bf16* qp = P + 4 * PGRP + prow * 512 + h * 128;
#pragma unroll
          for (int s = 0; s < 4; ++s) fqr[s] = *(const bf16x8*)(qp + 32 * s + 8 * q); }
        u32x2 rog[8], ror[8];
        { const bf16* a = WSP(bf16, WS_OGDN) + trow * 512 + h * 128 + 4 * q; const bf16* c = WSP(bf16, WS_ORET) + trow * 512 + h * 128 + 4 * q;
#pragma unroll
          for (int nt = 0; nt < 8; ++nt) { rog[nt] = *(const u32x2*)(a + 16 * nt); ror[nt] = *(const u32x2*)(c + 16 * nt); } }
        {
            u32x4 v[4][4];
#pragma unroll
            for (int k = 0; k < 4; ++k) { const int dir = k & 1; const int chain = (b * NH + h) * 2 + dir, n = dir ? 35 - m : m;
                const unsigned char* sp = F.ws + (k < 2 ? WS_GC : WS_GKV) + ((size_t)chain * NCHUNK + (n - 1)) * 32768;
#pragma unroll
                for (int i = 0; i < 4; ++i) v[k][i] = *(const u32x4*)(sp + (size_t)(tid + 512 * i) * 16); }
#pragma unroll
            for (int k = 0; k < 4; ++k)
#pragma unroll
                for (int i = 0; i < 4; ++i) *(LAS u32x4*)(F.lds + k * 32768 + (tid + 512 * i) * 16) = v[k][i];
        }
        f32x4 og[8], orr[8];
#pragma unroll
        for (int nt = 0; nt < 8; ++nt) { og[nt] = (f32x4){bflo(rog[nt].x), bfhi(rog[nt].x), bflo(rog[nt].y), bfhi(rog[nt].y)}; orr[nt] = (f32x4){bflo(ror[nt].x), bfhi(ror[nt].x), bflo(ror[nt].y), bfhi(ror[nt].y)}; }
        LBAR();
#pragma unroll
        for (int dir = 0; dir < 2; ++dir) {
            {
                const LAS unsigned char* sp = F.lds + dir * 32768;
#pragma unroll
                for (int s = 0; s < 4; ++s)
#pragma unroll
                    for (int nt = 0; nt < 8; ++nt) og[nt] = MFMA16(*(const LAS bf16x8*)(sp + ((nt * 4 + s) * 64 + lane) * 16), fqg[dir][s], og[nt]);
            }
            {
                const LAS unsigned char* sp = F.lds + (2 + dir) * 32768;
                f32x4 t[8];
#pragma unroll
                for (int nt = 0; nt < 8; ++nt) t[nt] = (f32x4){0.f, 0.f, 0.f, 0.f};
#pragma unroll
                for (int s = 0; s < 4; ++s)
#pragma unroll
                    for (int nt = 0; nt < 8; ++nt) t[nt] = MFMA16(*(const LAS bf16x8*)(sp + ((nt * 4 + s) * 64 + lane) * 16), fqr[s], t[nt]);
                const float lg = F.ret_log_decay[dir * 4 + h]; const float dcy = expf(lg * (float)(dir ? 128 - il : il + 1));
#pragma unroll
                for (int nt = 0; nt < 8; ++nt) orr[nt] = orr[nt] + t[nt] * dcy;
            }
        }
        {
            float s1 = 0.f;
#pragma unroll
            for (int nt = 0; nt < 8; ++nt) s1 += (orr[nt][0] + orr[nt][1]) + (orr[nt][2] + orr[nt][3]);
            s1 += __shfl_xor(s1, 16); s1 += __shfl_xor(s1, 32); const float mean = s1 * (1.f / 128.f);
            float s2 = 0.f, s3 = 0.f;
#pragma unroll
            for (int nt = 0; nt < 8; ++nt)
#pragma unroll
                for (int e = 0; e < 4; ++e) { const float d = orr[nt][e] - mean; s2 += d * d; s3 += og[nt][e] * og[nt][e]; }
            s2 += __shfl_xor(s2, 16); s2 += __shfl_xor(s2, 32); s3 += __shfl_xor(s3, 16); s3 += __shfl_xor(s3, 32);
            const float rs_r = 1.0f / sqrtf(s2 * (1.f / 128.f) + EPS), rs_g = 1.0f / sqrtf(s3 * (1.f / 128.f) + EPS);
            const bf16* rg = P + 5 * PGRP + prow * 512 + h * 128 + 4 * q; const bf16* gz = P + 7 * PGRP + prow * 512 + h * 128 + 4 * q;
            bf16* ry = WSP(bf16, WS_RETY) + trow * 512 + h * 128 + 4 * q; bf16* gy = WSP(bf16, WS_GDNY) + trow * 512 + h * 128 + 4 * q;
#pragma unroll
            for (int nt = 0; nt < 8; ++nt) { const u32x2 a = *(const u32x2*)(rg + 16 * nt), c = *(const u32x2*)(gz + 16 * nt);
                const float ga[4] = {bflo(a.x), bfhi(a.x), bflo(a.y), bfhi(a.y)}, gc4[4] = {bflo(c.x), bfhi(c.x), bflo(c.y), bfhi(c.y)};
                const f32x4 wr4 = *(const f32x4*)(F.ret_gn_w + h * 128 + 16 * nt + 4 * q), wg4 = *(const f32x4*)(F.gdn_norm_w + h * 128 + 16 * nt + 4 * q);
                float yr[4], yg[4];
#pragma unroll
                for (int e = 0; e < 4; ++e) { yr[e] = (orr[nt][e] - mean) * rs_r * wr4[e] * siluf_(ga[e]); yg[e] = og[nt][e] * rs_g * wg4[e] * siluf_(gc4[e]); }
                u32x2 o1, o2; o1.x = pk2(yr[0], yr[1]); o1.y = pk2(yr[2], yr[3]); o2.x = pk2(yg[0], yg[1]); o2.y = pk2(yg[2], yg[3]);
                *(u32x2*)(ry + 16 * nt) = o1; *(u32x2*)(gy + 16 * nt) = o2; }
        }
        LBAR();
    }
}

struct SchedMerge {
    const char *A0, *A1, *B0, *B1; int G, c;
    __device__ __forceinline__ bool next(int i, pg8::Unit& u) const {
        const int L = (i >> 1) * G + c; if (L >= 256) return false; const int term = i & 1;
        const int xcd = L % 8, off = L / 8; const int w = xcd * 32 + off;
        u.pm = w >> 2; u.pn = w & 3; u.e = term; u.base = 0;
        u.A = (term ? A1 : A0) + (size_t)u.pm * 256 * 512 * 2; u.B = (term ? B1 : B0) + (size_t)u.pn * 256 * 512 * 2; return true; }
    __device__ __forceinline__ int row_index(const pg8::Unit&, int r) const { return r; }
};
struct EpiMerge {
    const bf16* GATES; bf16* TMP; bf16* MERGED;
    __device__ __forceinline__ void operator()(const f32x4 (&acc)[2][2][4][2], const pg8::Unit& u, int wr, int wc, int fr, int fq) const {
#pragma unroll
        for (int ai = 0; ai < 2; ++ai) {
            u32x4 gv[4][2], pv[4][2];
#pragma unroll
            for (int m = 0; m < 4; ++m) { const size_t row = (size_t)u.pm * 256 + ai * 128 + wr * 64 + m * 16 + fr;
#pragma unroll
                for (int bj = 0; bj < 2; ++bj) { const int col = u.pn * 256 + bj * 128 + wc * 32 + 8 * fq;
                    gv[m][bj] = *(const u32x4*)(GATES + row * 2048 + u.e * 1024 + col);
                    if (u.e != 0) pv[m][bj] = *(const u32x4*)(TMP + row * DM + col); } }
#pragma unroll
            for (int m = 0; m < 4; ++m) { const size_t row = (size_t)u.pm * 256 + ai * 128 + wr * 64 + m * 16 + fr;
#pragma unroll
                for (int bj = 0; bj < 2; ++bj) { const int col = u.pn * 256 + bj * 128 + wc * 32 + 8 * fq;
                    float g[8]; unpack8(gv[m][bj], g);
                    float v[8] = {acc[ai][bj][m][0][0], acc[ai][bj][m][0][1], acc[ai][bj][m][0][2], acc[ai][bj][m][0][3], acc[ai][bj][m][1][0], acc[ai][bj][m][1][1], acc[ai][bj][m][1][2], acc[ai][bj][m][1][3]};
                    if (u.e == 0) {
#pragma unroll
                        for (int i = 0; i < 8; ++i) v[i] *= g[i];
                        *(u32x4*)(TMP + row * DM + col) = pack8(v);
                    } else { float p[8]; unpack8(pv[m][bj], p);
#pragma unroll
                        for (int i = 0; i < 8; ++i) v[i] = p[i] + v[i] * g[i];
                        *(u32x4*)(MERGED + row * DM + col) = pack8(v); } } }
        }
    }
};
struct SchedDense {
    const char *A, *B; int nM, nN, K, G, c;
    __device__ __forceinline__ bool next(int i, pg8::Unit& u) const {
        const int L = i * G + c; const int nwg = nM * nN; if (L >= nwg) return false;
        int w = L; if (nwg % 8 == 0) { const int xcd = L % 8, off = L / 8; w = xcd * (nwg / 8) + off; }
        u.pm = w / nN; u.pn = w % nN; u.e = 0; u.base = 0; u.A = A + (size_t)u.pm * 256 * K * 2; u.B = B + (size_t)u.pn * 256 * K * 2; return true; }
    __device__ __forceinline__ int row_index(const pg8::Unit&, int r) const { return r; }
};
struct EpiBf16Store { bf16* O; int ldc;
    __device__ __forceinline__ void operator()(const f32x4 (&acc)[2][2][4][2], const pg8::Unit& u, int wr, int wc, int fr, int fq) const {
#pragma unroll
        for (int ai = 0; ai < 2; ++ai)
#pragma unroll
            for (int m = 0; m < 4; ++m) { const size_t row = (size_t)u.pm * 256 + ai * 128 + wr * 64 + m * 16 + fr;
#pragma unroll
                for (int bj = 0; bj < 2; ++bj) { const int col = u.pn * 256 + bj * 128 + wc * 32 + 8 * fq; const f32x4 v0 = acc[ai][bj][m][0], v1 = acc[ai][bj][m][1];
                    u32x4 w; w.x = pk2(v0[0], v0[1]); w.y = pk2(v0[2], v0[3]); w.z = pk2(v1[0], v1[1]); w.w = pk2(v1[2], v1[3]);
                    *(u32x4*)(O + row * ldc + col) = w; } }
    }
};

__device__ __forceinline__ void load_row_bf16(const bf16* p, int lane, float (&v)[16]) { float a[8], b[8]; unpack8(*(const u32x4*)(p + 8 * lane), a); unpack8(*(const u32x4*)(p + 512 + 8 * lane), b);
#pragma unroll
    for (int i = 0; i < 8; ++i) { v[i] = a[i]; v[8 + i] = b[i]; } }
__device__ __forceinline__ void load_row_f32(const float* p, int lane, float (&v)[16]) {
#pragma unroll
    for (int q = 0; q < 4; ++q) { const f32x4 a = *(const f32x4*)(p + (q >> 1) * 512 + 8 * lane + 4 * (q & 1)); v[4 * q] = a.x; v[4 * q + 1] = a.y; v[4 * q + 2] = a.z; v[4 * q + 3] = a.w; } }
__device__ __forceinline__ void store_row_f32(float* p, int lane, const float (&v)[16]) {
#pragma unroll
    for (int q = 0; q < 4; ++q) *(f32x4*)(p + (q >> 1) * 512 + 8 * lane + 4 * (q & 1)) = (f32x4){v[4 * q], v[4 * q + 1], v[4 * q + 2], v[4 * q + 3]}; }
__device__ __forceinline__ void compute_x1(Frame& F, int t, float (&x1)[16]) {
    const int b = t / SEQ; const float* mod = WSP(float, WS_MOD) + b * 6144;
    const bf16* mop = WSP(bf16, WS_MO) + (size_t)t * DM;
    const u32x4 m0 = *(const u32x4*)(mop + 8 * F.lane), m1 = *(const u32x4*)(mop + 512 + 8 * F.lane);
    float ss = 0.f;
    { float a[8], c[8]; unpack8(m0, a); unpack8(m1, c);
#pragma unroll
      for (int i = 0; i < 8; ++i) ss += a[i] * a[i] + c[i] * c[i]; }
    const float rstd = 1.0f / sqrtf(wave_sum(ss) * (1.f / DM) + EPS);
#pragma unroll
    for (int hf = 0; hf < 2; ++hf) {
        const int c0 = hf * 512 + 8 * F.lane; float mo[8]; unpack8(hf ? m1 : m0, mo);
        const float* xp = F.x + (size_t)t * DM + c0; const float* wp = F.n_mix_post + c0; const float* gp = mod + 2 * DM + c0;
#pragma unroll
        for (int q = 0; q < 2; ++q) { const f32x4 xv = *(const f32x4*)(xp + 4 * q), wv = *(const f32x4*)(wp + 4 * q), g1 = *(const f32x4*)(gp + 4 * q);
#pragma unroll
            for (int e = 0; e < 4; ++e) x1[hf * 8 + 4 * q + e] = xv[e] + g1[e] * (mo[4 * q + e] * rstd * wv[e]); }
    }
}
__device__ __forceinline__ void route_token(Frame& F, int t, float logit, LAS unsigned* lcnt, LAS u32x2* stage, unsigned* cnt, int2* list) {
    logit = (logit == logit) ? logit : 0.f;
    const float score = 1.f / (1.f + expf(-logit)); const float biased = score + F.router_bias[F.lane];
#define DPP_MAX(v, ctrl) fmaxf((v), __builtin_bit_cast(float, __builtin_amdgcn_update_dpp(0, __builtin_bit_cast(int, (v)), (ctrl), 0xf, 0xf, true)))
    float m1 = biased; m1 = DPP_MAX(m1, 0xB1); m1 = DPP_MAX(m1, 0x4E); m1 = DPP_MAX(m1, 0x141);
    const unsigned long long bm = __ballot(biased == m1); const unsigned gb = (unsigned)(bm >> (F.lane & ~7)) & 0xffu; const int first = __ffs((int)gb) - 1;
    float m2 = ((F.lane & 7) == first) ? -__builtin_inff() : biased; m2 = DPP_MAX(m2, 0xB1); m2 = DPP_MAX(m2, 0x4E); m2 = DPP_MAX(m2, 0x141);
#undef DPP_MAX
    const float gs = m1 + m2;
    int grk = 0; const int myg = F.lane >> 3;
#pragma unroll
    for (int o = 0; o < 8; ++o) { const float ov = __builtin_bit_cast(float, __builtin_amdgcn_readlane(__builtin_bit_cast(int, gs), o * 8)); grk += ((ov > gs) | ((ov == gs) & (o < myg))) ? 1 : 0; }
    const bool keep = grk < 4;
    const float cand = keep ? biased : -__builtin_inff();
    int erk = 0;
#pragma unroll
    for (int o = 0; o < 64; ++o) { const float ov = __builtin_bit_cast(float, __builtin_amdgcn_readlane(__builtin_bit_cast(int, cand), o)); erk += ((ov > cand) | ((ov == cand) & (o < F.lane))) ? 1 : 0; }
    const bool sel = keep && erk < TOPK;
    const float ssum = wave_sum(sel ? score : 0.f);
    if (sel) { const float w = score / ssum * 2.5f; const unsigned pos = __hip_atomic_fetch_add(lcnt + F.lane, 1u, __ATOMIC_RELAXED, __HIP_MEMORY_SCOPE_WORKGROUP);
        if (pos < 48u) stage[F.lane * 48 + pos] = (u32x2){(unsigned)(t * 8 + erk), __float_as_uint(w)};
        else { const unsigned gp = atomicAdd(cnt + 64 * F.lane, 1u); list[(size_t)F.lane * NT + gp] = make_int2(t * 8 + erk, __float_as_int(w)); } }
}
__device__ __forceinline__ void phase_route(Frame& F) {
    constexpr int HST = 2064;
    LAS unsigned char* hhi = F.lds;
    LAS unsigned char* hlo = F.lds + 16 * HST;
    LAS float* part = (LAS float*)(F.lds + 2 * 16 * HST);
    LAS u32x2* stage = (LAS u32x2*)(F.lds + 2 * 16 * HST + 32768);
    LAS unsigned* lcnt = (LAS unsigned*)(F.lds + MISC_OFF + 1024);
    unsigned* cnt = F.ctl + CW_CNT; int2* list = WSP(int2, WS_LIST);
    const int r = F.lane & 15, q = F.lane >> 4, kbase = F.wave * 128;
    bf16x8 wh[4][4]; u32x2 wl8[4][4];
#pragma unroll
    for (int ft = 0; ft < 4; ++ft) {
        asm volatile("" ::: "memory");
#pragma unroll
        for (int s = 0; s < 4; ++s) { float wv[8];
#pragma unroll
            for (int j = 0; j < 8; ++j) wv[j] = F.w_router[(size_t)(kbase + 32 * s + 8 * q + j) * NEXP + 16 * ft + r];
            unsigned hi[8];
#pragma unroll
            for (int j = 0; j < 8; ++j) hi[j] = f2bf(wv[j]);
            wh[ft][s] = __builtin_bit_cast(bf16x8, (u32x4){hi[0] | (hi[1] << 16), hi[2] | (hi[3] << 16), hi[4] | (hi[5] << 16), hi[6] | (hi[7] << 16)});
            float lf[8];
#pragma unroll
            for (int j = 0; j < 8; ++j) lf[j] = (wv[j] - bf2f(hi[j])) * 4096.0f;
            unsigned p0 = __builtin_amdgcn_cvt_pk_bf8_f32(lf[0], lf[1], 0u, false); p0 = __builtin_amdgcn_cvt_pk_bf8_f32(lf[2], lf[3], p0, true);
            unsigned p1 = __builtin_amdgcn_cvt_pk_bf8_f32(lf[4], lf[5], 0u, false); p1 = __builtin_amdgcn_cvt_pk_bf8_f32(lf[6], lf[7], p1, true);
            wl8[ft][s] = (u32x2){p0, p1}; } }
    for (int g64 = F.bid; g64 < NT / 64; g64 += F.G) {
        if (F.tid < 64) lcnt[F.tid] = 0u;
        __syncthreads();
#pragma unroll 1
        for (int grp = 0; grp < 4; ++grp) {
#pragma unroll
            for (int tw = 0; tw < 2; ++tw) {
                const int slot = 2 * F.wave + tw; const int t = g64 * 64 + grp * 16 + slot; const int b = t / SEQ; const float* mod = WSP(float, WS_MOD) + b * 6144;
                float x1[16]; compute_x1(F, t, x1);
                float ss = 0.f;
#pragma unroll
                for (int i = 0; i < 16; ++i) ss += x1[i] * x1[i];
                const float rstd = 1.0f / sqrtf(wave_sum(ss) * (1.f / DM) + EPS);
                bf16* d = WSP(bf16, WS_H2) + (size_t)t * DM;
#pragma unroll
                for (int hf = 0; hf < 2; ++hf) {
                    asm volatile("" ::: "memory");
                    const int c0 = hf * 512 + 8 * F.lane; float h2[8];
#pragma unroll
                    for (int qq = 0; qq < 2; ++qq) { const f32x4 wv = *(const f32x4*)(F.n_ffn_pre + c0 + 4 * qq), sh = *(const f32x4*)(mod + 3 * DM + c0 + 4 * qq), sc = *(const f32x4*)(mod + 4 * DM + c0 + 4 * qq);
#pragma unroll
                        for (int e = 0; e < 4; ++e) h2[4 * qq + e] = x1[hf * 8 + 4 * qq + e] * rstd * wv[e] * (1.f + sc[e]) + sh[e]; }
                    const u32x4 hp = pack8(h2); *(u32x4*)(d + c0) = hp;
                    float lo8[8]; { float hb[8]; unpack8(hp, hb);
#pragma unroll
                        for (int e = 0; e < 8; ++e) lo8[e] = h2[e] - hb[e]; }
                    *(LAS u32x4*)(hhi + slot * HST + c0 * 2) = hp; *(LAS u32x4*)(hlo + slot * HST + c0 * 2) = pack8(lo8);
                }
            }
            LBAR();
            {
                typedef float f32x2v __attribute__((ext_vector_type(2)));
                f32x4 acc[4], acc2[4];
#pragma unroll
                for (int ft = 0; ft < 4; ++ft) { acc[ft] = (f32x4){0.f, 0.f, 0.f, 0.f}; acc2[ft] = (f32x4){0.f, 0.f, 0.f, 0.f}; }
#pragma unroll
                for (int s = 0; s < 4; ++s) { const int off = r * HST + (kbase + 32 * s + 8 * q) * 2;
                    const bf16x8 bh = *(const LAS bf16x8*)(hhi + off), bl = *(const LAS bf16x8*)(hlo + off);
#pragma unroll
                    for (int ft = 0; ft < 4; ++ft) {
                        const f32x2v l0 = __builtin_amdgcn_cvt_pk_f32_bf8(wl8[ft][s].x, false), l1 = __builtin_amdgcn_cvt_pk_f32_bf8(wl8[ft][s].x, true), l2 = __builtin_amdgcn_cvt_pk_f32_bf8(wl8[ft][s].y, false), l3 = __builtin_amdgcn_cvt_pk_f32_bf8(wl8[ft][s].y, true);
                        const bf16x8 wlo = __builtin_bit_cast(bf16x8, (u32x4){pk2(l0.x, l0.y), pk2(l1.x, l1.y), pk2(l2.x, l2.y), pk2(l3.x, l3.y)});
                        acc[ft] = MFMA16(wh[ft][s], bh, acc[ft]); acc[ft] = MFMA16(wh[ft][s], bl, acc[ft]); acc2[ft] = MFMA16(wlo, bh, acc2[ft]); } }
#pragma unroll
                for (int ft = 0; ft < 4; ++ft)
#pragma unroll
                    for (int e = 0; e < 4; ++e) part[(F.wave * 64 + 16 * ft + 4 * q + e) * 16 + r] = acc[ft][e] + acc2[ft][e] * (1.0f / 4096.0f);
            }
            LBAR();
#pragma unroll 1
            for (int tw = 0; tw < 2; ++tw) { const int slot = 2 * F.wave + tw; float logit = 0.f;
#pragma unroll
                for (int w = 0; w < 8; ++w) logit += part[(w * 64 + F.lane) * 16 + slot];
                route_token(F, g64 * 64 + grp * 16 + slot, logit, lcnt, stage, cnt, list); }
        }
        __syncthreads();
        if (F.tid < 64) { const unsigned n = lcnt[F.tid] < 48u ? lcnt[F.tid] : 48u; lcnt[F.tid] = n; lcnt[64 + F.tid] = atomicAdd(cnt + 64 * F.tid, n); }
        __syncthreads();
        { const int e = F.tid >> 3; const unsigned n = lcnt[e], base = lcnt[64 + e];
          for (unsigned j = F.tid & 7; j < n; j += 8) { const u32x2 v = stage[e * 48 + j]; list[(size_t)e * NT + base + j] = make_int2((int)v.x, (int)v.y); } }
        __syncthreads();
    }
}

__device__ __forceinline__ void build_tile_prefix(Frame& F, LAS int* tp) {
    __syncthreads();
    if (F.tid == 0) { int s = 0; const unsigned* cnt = F.ctl + CW_CNT; for (int e = 0; e < 64; ++e) { const int ce = (int)__hip_atomic_load(cnt + 64 * e, __ATOMIC_RELAXED, __HIP_MEMORY_SCOPE_AGENT); tp[96 + e] = ce; tp[e] = s; s += (ce + 255) >> 8; } tp[64] = s; tp[65] = s + 64;
        const int x = F.bid & 7; int l = 0; for (int k = 0; k < 8; ++k) { tp[80 + k] = l; l += tp[x + 8 * k + 1] - tp[x + 8 * k]; } tp[88] = l; tp[89] = l + 8; }
    __syncthreads();
}
struct SchedMoe {
    const char* A; const char* B; const int2* list; const unsigned* cnt; const LAS int* tp; int npn, K, G, c; size_t bstride  ; int bcol0  ; bool gather; const LAS int* rtab  ;
    __device__ __forceinline__ bool next(int i, pg8::Unit& u) const {
        int e, pm;
        if ((G & 7) == 0) {
            const int x = c & 7, W = G >> 3, L = i * W + (c >> 3); const int nt = __builtin_amdgcn_readfirstlane(tp[89]); if (L >= nt * npn) return false;
            const int tl = L / npn; u.pn = L % npn; int k = 0;
            for (int q = 8; q >= 1; q >>= 1) if (k + q <= 8 && __builtin_amdgcn_readfirstlane(tp[80 + k + q]) <= tl) k += q;
            k = __builtin_amdgcn_readfirstlane(k); const int off = tl - __builtin_amdgcn_readfirstlane(tp[80 + k]);
            if (k < 8) { e = x + 8 * k; pm = off; } else { e = 64; pm = x + 8 * off; }
        } else {
            const int L = i * G + c; const int ntile = __builtin_amdgcn_readfirstlane(tp[65]); if (L >= ntile * npn) return false;
            const int tile = L / npn; u.pn = L % npn; e = 0;
            for (int q = 64; q >= 1; q >>= 1) if (e + q <= 64 && __builtin_amdgcn_readfirstlane(tp[e + q]) <= tile) e += q;
            e = __builtin_amdgcn_readfirstlane(e); pm = tile - __builtin_amdgcn_readfirstlane(tp[e]);
        }
        u.ord = i; u.e = e; u.pm = pm; u.base = (e < 64 ? (__builtin_amdgcn_readfirstlane(tp[e < 64 ? e : 0]) + pm) * 256 : SLOT_SH + pm * 256);
        u.A = gather ? A : A + (size_t)u.base * K * 2; u.B = B + (size_t)e * bstride + (size_t)(bcol0 + u.pn * 256) * K * 2; return true; }
    __device__ __forceinline__ int row_index(const pg8::Unit& u, int r) const {
        if (rtab) return rtab[u.ord * 256 + r];
        if (u.e == 64) return u.pm * 256 + r;
        const unsigned tok = (unsigned)list[(size_t)u.e * NT + u.pm * 256 + r].x >> 3; return (int)(tok < (unsigned)NT ? tok : 0u); }
};
struct EpiUp { bf16* HMID;
    __device__ __forceinline__ void operator()(const f32x4 (&acc)[2][2][4][2], const pg8::Unit& u, int wr, int wc, int fr, int fq) const {
#pragma unroll
        for (int ai = 0; ai < 2; ++ai)
#pragma unroll
            for (int m = 0; m < 4; ++m) { const size_t slot = (size_t)u.base + ai * 128 + wr * 64 + m * 16 + fr;
#pragma unroll
                for (int bj = 0; bj < 2; ++bj) { const int hid = u.pn * 128 + bj * 64 + wc * 16 + fq * 4; const f32x4 g = acc[ai][bj][m][0], up = acc[ai][bj][m][1];
                    u32x2 w; w.x = pk2(siluf_(g[0]) * up[0], siluf_(g[1]) * up[1]); w.y = pk2(siluf_(g[2]) * up[2], siluf_(g[3]) * up[3]);
                    *(u32x2*)(HMID + slot * DEXP + hid) = w; } }
    }
};
constexpr float YB_SCALE = 64.0f, YB_INV = 1.0f / 64.0f;
__device__ __forceinline__ unsigned pk4_fp8(float a, float b, float c, float d) {
    a = fminf(fmaxf(a * YB_SCALE, -448.f), 448.f); b = fminf(fmaxf(b * YB_SCALE, -448.f), 448.f); c = fminf(fmaxf(c * YB_SCALE, -448.f), 448.f); d = fminf(fmaxf(d * YB_SCALE, -448.f), 448.f);
    unsigned p = __builtin_amdgcn_cvt_pk_fp8_f32(a, b, 0u, false); return __builtin_amdgcn_cvt_pk_fp8_f32(c, d, p, true); }
struct EpiDown { unsigned char* YB; float* OUT; const int2* list; const LAS int* tp;
    __device__ __forceinline__ void operator()(const f32x4 (&acc)[2][2][4][2], const pg8::Unit& u, int wr, int wc, int fr, int fq) const {
        if (u.e == 64) {
#pragma unroll
            for (int ai = 0; ai < 2; ++ai)
#pragma unroll
                for (int m = 0; m < 4; ++m) { const int idx = u.pm * 256 + ai * 128 + wr * 64 + m * 16 + fr; float* o = OUT + (size_t)idx * DM + u.pn * 256 + wc * 32 + 8 * fq;
#pragma unroll
                    for (int bj = 0; bj < 2; ++bj) { *(f32x4*)(o + bj * 128) = acc[ai][bj][m][0]; *(f32x4*)(o + bj * 128 + 4) = acc[ai][bj][m][1]; } }
        } else {
            const int n = __builtin_amdgcn_readfirstlane(tp[96 + u.e]); int2 dw[2][4];
#pragma unroll
            for (int ai = 0; ai < 2; ++ai)
#pragma unroll
                for (int m = 0; m < 4; ++m) { int idx = u.pm * 256 + ai * 128 + wr * 64 + m * 16 + fr; idx = idx < n ? idx : n - 1; dw[ai][m] = list[(size_t)u.e * NT + idx]; }
#pragma unroll
            for (int ai = 0; ai < 2; ++ai)
#pragma unroll
                for (int m = 0; m < 4; ++m) { const int idx = u.pm * 256 + ai * 128 + wr * 64 + m * 16 + fr;
                    if (idx < n) { const float w = __int_as_float(dw[ai][m].y); unsigned char* o = YB + (size_t)dw[ai][m].x * DM + u.pn * 256 + wc * 32 + 8 * fq;
#pragma unroll
                        for (int bj = 0; bj < 2; ++bj) { const f32x4 v0 = acc[ai][bj][m][0] * w, v1 = acc[ai][bj][m][1] * w;
                            u32x2 q; q.x = pk4_fp8(v0[0], v0[1], v0[2], v0[3]); q.y = pk4_fp8(v1[0], v1[1], v1[2], v1[3]);
                            *(u32x2*)(o + bj * 128) = q; } } }
        }
    }
};
__device__ __forceinline__ void phase_final(Frame& F) {
    typedef float f32x2v __attribute__((ext_vector_type(2)));
    const int gw = F.bid * NWAVES + F.wave, NGW = F.G * NWAVES; const unsigned char* YB = F.ws + WS_YB;
    for (int t = gw; t < NT; t += NGW) {
        const int b = t / SEQ; const float* mod = WSP(float, WS_MOD) + b * 6144;
        u32x2 ya[8], yb[8];
#pragma unroll
        for (int k = 0; k < 8; ++k) { const unsigned char* rp = YB + ((size_t)t * 8 + k) * DM; ya[k] = *(const u32x2*)(rp + 8 * F.lane); yb[k] = *(const u32x2*)(rp + 512 + 8 * F.lane); }
        float mv[16]; load_row_f32(F.out + (size_t)t * DM, F.lane, mv);
        float ra[16];
#pragma unroll
        for (int i = 0; i < 16; ++i) ra[i] = 0.f;
#pragma unroll
        for (int k = 0; k < 8; ++k) {
            const f32x2v a0 = __builtin_amdgcn_cvt_pk_f32_fp8(ya[k].x, false), a1 = __builtin_amdgcn_cvt_pk_f32_fp8(ya[k].x, true), a2 = __builtin_amdgcn_cvt_pk_f32_fp8(ya[k].y, false), a3 = __builtin_amdgcn_cvt_pk_f32_fp8(ya[k].y, true);
            const f32x2v c0 = __builtin_amdgcn_cvt_pk_f32_fp8(yb[k].x, false), c1 = __builtin_amdgcn_cvt_pk_f32_fp8(yb[k].x, true), c2 = __builtin_amdgcn_cvt_pk_f32_fp8(yb[k].y, false), c3 = __builtin_amdgcn_cvt_pk_f32_fp8(yb[k].y, true);
            ra[0] += a0.x; ra[1] += a0.y; ra[2] += a1.x; ra[3] += a1.y; ra[4] += a2.x; ra[5] += a2.y; ra[6] += a3.x; ra[7] += a3.y;
            ra[8] += c0.x; ra[9] += c0.y; ra[10] += c1.x; ra[11] += c1.y; ra[12] += c2.x; ra[13] += c2.y; ra[14] += c3.x; ra[15] += c3.y; }
        float ss = 0.f;
#pragma unroll
        for (int i = 0; i < 16; ++i) { mv[i] += ra[i] * YB_INV; ss += mv[i] * mv[i]; }
        const float rstd = 1.0f / sqrtf(wave_sum(ss) * (1.f / DM) + EPS);
        float x1[16]; compute_x1(F, t, x1);
        float wv[16], g2[16]; load_row_f32(F.n_ffn_post, F.lane, wv); load_row_f32(mod + 5 * DM, F.lane, g2);
        float o[16];
#pragma unroll
        for (int i = 0; i < 16; ++i) o[i] = x1[i] + g2[i] * (mv[i] * rstd * wv[i]);
        store_row_f32(F.out + (size_t)t * DM, F.lane, o);
    }
}

constexpr int N_PHASES = 16;
__global__ void __launch_bounds__(NTHR, 2) fwd(Args args) {
    extern __shared__ __attribute__((aligned(16))) unsigned char lds_raw[];
    Frame F; F.lds = (LAS unsigned char*)lds_raw; F.tid = threadIdx.x; F.lane = F.tid & 63; F.wave = __builtin_amdgcn_readfirstlane(F.tid >> 6); F.G = gridDim.x; F.bid = blockIdx.x;
    F.x = args.in[0]; F.c = args.in[1]; F.ctx = args.in[2]; F.c_ctx = args.in[3]; F.w_mod = args.in[4]; F.b_mod = args.in[5]; F.n_mix_pre = args.in[6]; F.n_mix_post = args.in[7];
    F.n_ffn_pre = args.in[8]; F.n_ffn_post = args.in[9]; F.w_in = args.in[10]; F.gdn_conv = args.in[11]; F.ret_log_decay = args.in[12]; F.gdn_a_log = args.in[13]; F.gdn_dt_bias = args.in[14];
    F.ret_gn_w = args.in[15]; F.gdn_norm_w = args.in[16]; F.w_ret_out = args.in[17]; F.w_gdn_out = args.in[18]; F.w_o = args.in[19]; F.w_router = args.in[20]; F.router_bias = args.in[21];
    F.w_gate = args.in[22]; F.w_up = args.in[23]; F.w_down = args.in[24]; F.w_sh_gate = args.in[25]; F.w_sh_up = args.in[26]; F.w_sh_down = args.in[27];
    F.out = args.out; F.ws = args.ws; F.ctl = (unsigned*)(args.ws + WS_CTL);
    volatile LAS unsigned* MISC = (volatile LAS unsigned*)(F.lds + MISC_OFF);
    if (F.tid < 64) MISC[F.tid] = 0u;
    __syncthreads();
#if MK_ONE_LAUNCH
    XcdBarrier bar = xcd_barrier_post(F.ctl + CW_BAR, MISC + 8);
#define SEAM() xcd_barrier(bar)
#else
#define SEAM() do {} while (0)
#endif
    const int lo = args.ph_lo, hi = args.ph_hi;
#ifndef PHM
#define PHM 0xffff
#endif
#ifndef DUP
#define DUP -1
#endif
#define IN(k) (((PHM >> (k)) & 1) && lo <= (k) && (k) < hi)
    LAS int* tp = (LAS int*)(F.lds + MISC_OFF + 256);
#ifndef PROBE_PH
#define PROBE_PH -1
#endif
#ifdef PROBE_A
#define PROBE_IA PROBE_A
#define PROBE_IB PROBE_B
#else
#define PROBE_IA (PROBE_PH % 100)
#define PROBE_IB ((PROBE_PH % 100) + 1)
#endif
    volatile LAS unsigned long long* tsl = (volatile LAS unsigned long long*)(F.lds + MISC_OFF + 896);
#define STAMP(k) do { if (PROBE_PH >= 0 && F.bid == 0 && F.tid == 0 && !(PROBE_PH == 204 && (k) == 5)) tsl[k] = __builtin_amdgcn_s_memrealtime(); } while (0)

    STAMP(0);
    if (IN(0)) _Pragma("unroll") for (int rep_ = 0; rep_ < ((DUP == 0) ? 2 : 1); ++rep_) { phase_prologue(F); SEAM(); }
    STAMP(1);
    if (IN(1)) _Pragma("unroll") for (int rep_ = 0; rep_ < ((DUP == 1) ? 2 : 1); ++rep_) { phase_norm1(F);
        if (F.G >= 64 && F.bid < 32) { SchedCtx S{(const char*)WSP(bf16, WS_HX), (const char*)WSP(bf16, WS_WIN), F.bid >> 3, F.bid & 7}; EpiIn E{WSP(bf16, WS_P), (bf16*)F.out, WSP(float2, WS_ROPE)};
            pg8::gemm_phase<EpiIn, SchedCtx, false, SP2>(F.lds, DM, S, E); }
        SEAM(); }
    STAMP(2);
    if (IN(2)) _Pragma("unroll") for (int rep_ = 0; rep_ < ((DUP == 2) ? 2 : 1); ++rep_) {
        SchedIn S{(const char*)WSP(bf16, WS_HX), (const char*)WSP(bf16, WS_WIN), F.G, F.bid};
        EpiIn E{WSP(bf16, WS_P), (bf16*)F.out, WSP(float2, WS_ROPE)};
        pg8::gemm_phase<EpiIn, SchedIn, false, SP2>(F.lds, DM, S, E); SEAM();
    }
    STAMP(3);
    if (IN(3)) _Pragma("unroll") for (int rep_ = 0; rep_ < ((DUP == 3) ? 2 : 1); ++rep_) { phase_prep(F); SEAM(); }
    STAMP(4);
    if (IN(4)) _Pragma("unroll") for (int rep_ = 0; rep_ < ((DUP == 4) ? 2 : 1); ++rep_) { phase_scan(F); SEAM(); }
    STAMP(5);
    if (IN(5)) _Pragma("unroll") for (int rep_ = 0; rep_ < ((DUP == 5) ? 2 : 1); ++rep_) { phase_out(F); SEAM(); }
    STAMP(6);
    if (IN(6)) _Pragma("unroll") for (int rep_ = 0; rep_ < ((DUP == 6) ? 2 : 1); ++rep_) {
        SchedMerge S{(const char*)WSP(bf16, WS_RETY), (const char*)WSP(bf16, WS_GDNY), (const char*)WSP(bf16, WS_WRO), (const char*)WSP(bf16, WS_WGO), F.G, F.bid};
        EpiMerge E{(const bf16*)F.out, WSP(bf16, WS_TMP), WSP(bf16, WS_MERGED)};
        pg8::gemm_phase<EpiMerge, SchedMerge, false, SP2>(F.lds, 512, S, E);
        STAMP(15);
        if (rep_ == 0) { _Pragma("unroll") for (int r2_ = 0; r2_ < ((DUP == 16) ? 2 : 1); ++r2_) phase_moe_weights(F); }
        SEAM();
    }
    STAMP(7);
    if (IN(7)) _Pragma("unroll") for (int rep_ = 0; rep_ < ((DUP == 7) ? 2 : 1); ++rep_) {
        SchedDense S{(const char*)WSP(bf16, WS_MERGED), (const char*)WSP(bf16, WS_WO), 64, 4, DM, F.G, F.bid};
        EpiBf16Store E{WSP(bf16, WS_MO), DM};
        pg8::gemm_phase<EpiBf16Store, SchedDense, false, SP2>(F.lds, DM, S, E); SEAM();
    }
    STAMP(8);
    if (IN(8)) _Pragma("unroll") for (int rep_ = 0; rep_ < ((DUP == 8) ? 2 : 1); ++rep_) { if (rep_ == 1) { if (F.bid == 0 && F.tid < 64) F.ctl[CW_CNT + 64 * F.tid] = 0u; SEAM(); } phase_route(F); SEAM(); }
    STAMP(9);
    if (IN(9)) _Pragma("unroll") for (int rep_ = 0; rep_ < ((DUP == 9) ? 2 : 1); ++rep_) {
        build_tile_prefix(F, tp);
        LAS int* rtab = (LAS int*)(F.lds + MISC_OFF + 1024);
        SchedMoe S0{(const char*)WSP(bf16, WS_H2), (const char*)WSP(bf16, WS_WGU), WSP(int2, WS_LIST), F.ctl + CW_CNT, tp, 2, DM, F.G, F.bid, (size_t)512 * DM * 2, 0, true, nullptr};
        bool fits = true;
        { pg8::Unit u; int ui = 0; for (; S0.next(ui, u); ++ui) { if (ui >= 7) { fits = false; break; } if (F.tid < 256) rtab[ui * 256 + F.tid] = S0.row_index(u, F.tid); } }
        __syncthreads();
        SchedMoe S{(const char*)WSP(bf16, WS_H2), (const char*)WSP(bf16, WS_WGU), WSP(int2, WS_LIST), F.ctl + CW_CNT, tp, 2, DM, F.G, F.bid, (size_t)512 * DM * 2, 0, true, fits ? rtab : nullptr};
        EpiUp E{WSP(bf16, WS_HMID)};
        pg8::gemm_phase<EpiUp, SchedMoe, true, SP2>(F.lds, DM, S, E); SEAM();
    }
    STAMP(10);
    if (IN(10)) _Pragma("unroll") for (int rep_ = 0; rep_ < ((DUP == 10) ? 2 : 1); ++rep_) {
        build_tile_prefix(F, tp);
        SchedMoe S{(const char*)WSP(bf16, WS_HMID), (const char*)WSP(bf16, WS_WD), WSP(int2, WS_LIST), F.ctl + CW_CNT, tp, 4, DEXP, F.G, F.bid, (size_t)DM * DEXP * 2, 0, false, nullptr};
        EpiDown E{F.ws + WS_YB, F.out, WSP(int2, WS_LIST), tp};
        pg8::gemm_phase<EpiDown, SchedMoe, false, SP2>(F.lds, DEXP, S, E); SEAM();
    }
    STAMP(11);
    STAMP(12);
    STAMP(13);
    if (IN(13)) _Pragma("unroll") for (int rep_ = 0; rep_ < ((DUP == 13) ? 2 : 1); ++rep_) { phase_final(F); }
    STAMP(14);
    if (PROBE_PH >= 0 && F.bid == 0) { __syncthreads(); if (F.tid == 0) { const unsigned long long d = tsl[PROBE_IB] - tsl[PROBE_IA]; float a = 1.0f + 0.2f * floorf((float)d * 0.001f); a = a > 30.f ? 30.f : a;
#ifdef PROBE_BIG
            a = 20.0f + (float)d * 0.005f;
#endif
            asm volatile("s_waitcnt vmcnt(0)" ::: "memory"); F.out[0] += a; } }
#undef IN
}

extern "C" void kernel_launch(void* const* d_in, const int* in_sizes, int n_in, void* d_out, int out_size, void* d_ws, size_t ws_size, hipStream_t stream) {
    static int grid = 0;
    if (grid == 0) {
        if (n_in != 28 || in_sizes[0] != NT * DM || out_size != NT * DM || ws_size < WS_END) { fprintf(stderr, "kernel_launch: unexpected shapes / workspace (%d inputs, ws %zu)\n", n_in, ws_size); grid = -1; return; }
        int dev = 0, cus = 0;
        if (hipGetDevice(&dev) != hipSuccess || hipDeviceGetAttribute(&cus, hipDeviceAttributeMultiprocessorCount, dev) != hipSuccess) { grid = -1; return; }
        if (hipFuncSetAttribute((const void*)fwd, hipFuncAttributeMaxDynamicSharedMemorySize, LDS_BYTES) != hipSuccess) { fprintf(stderr, "kernel_launch: hipFuncSetAttribute failed\n"); grid = -1; return; }
        int per_cu = 0; (void)hipOccupancyMaxActiveBlocksPerMultiprocessor(&per_cu, (const void*)fwd, NTHR, LDS_BYTES); (void)hipGetLastError();
        if (per_cu < 1) fprintf(stderr, "kernel_launch: occupancy query says %d\n", per_cu);
        grid = cus;
    }
    if (grid < 0) return;
    (void)hipMemsetAsync((char*)d_ws + WS_CTL, 0, CTL_BYTES, stream);
    Args a{};
    for (int i = 0; i < 28; ++i) a.in[i] = (const float*)d_in[i];
    a.out = (float*)d_out; a.ws = (unsigned char*)d_ws;
#if MK_ONE_LAUNCH
    a.ph_lo = 0; a.ph_hi = N_PHASES;
    hipLaunchKernelGGL(fwd, dim3(grid), dim3(NTHR), LDS_BYTES, stream, a);
#else
    for (int p = 0; p < 14; ++p) { a.ph_lo = p; a.ph_hi = p + 1; hipLaunchKernelGGL(fwd, dim3(grid), dim3(NTHR), LDS_BYTES, stream, a); }
#endif
}
```

```cpp
#include <hip/hip_runtime.h>
#include <cstdio>
#include <cstdint>

#ifndef MK_ONE_LAUNCH
#define MK_ONE_LAUNCH 1
#endif
#ifndef MK_REF_GEMM
#define MK_REF_GEMM 0
#endif

constexpr int NB = 4, SEQ = 4096, DM = 1024, CTXL = 256, RPB = SEQ + CTXL  , NROW = NB * RPB  , NT = NB * SEQ  ;
constexpr int NH = 4, HD = 128, CH = 128, NCHUNK = RPB / CH  ;
constexpr int N_STATE = 2064, N_IN = 6160, NEXP = 64, TOPK = 8, DEXP = 256;
constexpr float EPS = 1e-6f;
constexpr int NPCOL = 4096;
constexpr int SLOT_SH = 147456;
constexpr int NSLOT = SLOT_SH + NT;

constexpr size_t MiB = 1u << 20;
constexpr size_t WS_CTL = 0, CTL_BYTES = 64 * 1024;
constexpr size_t WS_MOD = 1 * MiB;
constexpr size_t WS_ROPE = 2 * MiB;
constexpr size_t WS_LOGA = 4 * MiB;
constexpr size_t WS_BETA = 5 * MiB;
constexpr size_t WS_WRO = 6 * MiB, WS_WGO = 7 * MiB, WS_WO = 8 * MiB;
constexpr size_t WS_P = 10 * MiB;
constexpr size_t PGRP = (size_t)NROW * 512;
constexpr size_t WS_CH = 146 * MiB;
constexpr size_t WS_WIN = WS_CH;
constexpr size_t WS_HX = WS_CH + 12 * MiB;
constexpr size_t WS_GM = WS_CH;
constexpr size_t WS_GC = WS_CH + 34 * MiB;
constexpr size_t WS_GKV = WS_CH + 68 * MiB;
constexpr size_t WS_GQT = WS_CH + 102 * MiB;
constexpr size_t WS_OGDN = WS_CH + 134 * MiB;
constexpr size_t WS_ORET = WS_CH + 150 * MiB;
constexpr size_t WS_RETY = WS_P, WS_GDNY = WS_P + 17 * MiB;
constexpr size_t WS_H2 = 10 * MiB;
constexpr size_t WS_WGU = 77 * MiB;
constexpr size_t WS_WD = 44 * MiB;
constexpr int YB_SPLIT = 4352 * 8;
constexpr size_t WS_YB_A = 10 * MiB, WS_YB_B = 77 * MiB - (size_t)YB_SPLIT * 1024;
__device__ __forceinline__ size_t yb_off(int dst) { return (dst < YB_SPLIT ? WS_YB_A : WS_YB_B) + (size_t)dst * 1024; }
constexpr size_t WS_HMID = 171 * MiB;
constexpr size_t WS_TMP = 171 * MiB, WS_MERGED = 203 * MiB;
constexpr size_t WS_MO = 251 * MiB;
constexpr size_t WS_LIST = 283 * MiB;
constexpr size_t WS_END = 312 * MiB;

constexpr int CW_BAR = 1024;
constexpr int CW_CNT = 8192;
constexpr int CW_FLAG = 12288;

#define GAS __attribute__((address_space(1)))
#define LAS __attribute__((address_space(3)))
typedef unsigned short bf16;
typedef float f32x4 __attribute__((ext_vector_type(4)));
typedef float f32x2 __attribute__((ext_vector_type(2)));
typedef short bf16x8 __attribute__((ext_vector_type(8)));
typedef unsigned u32x4 __attribute__((ext_vector_type(4)));
typedef unsigned u32x2 __attribute__((ext_vector_type(2)));
__device__ __forceinline__ unsigned f2bf(float f) { unsigned u = __builtin_bit_cast(unsigned, f); return (u + 0x7fffu + ((u >> 16) & 1u)) >> 16; }
typedef __bf16 bf16x2_t __attribute__((ext_vector_type(2)));
__device__ __forceinline__ unsigned pk2(float lo, float hi) { const f32x2 v = {lo, hi}; return __builtin_bit_cast(unsigned, __builtin_convertvector(v, bf16x2_t)); }
__device__ __forceinline__ float bf2f(unsigned b) { return __builtin_bit_cast(float, b << 16); }
__device__ __forceinline__ float bflo(unsigned w) { return __builtin_bit_cast(float, w << 16); }
__device__ __forceinline__ float bfhi(unsigned w) { return __builtin_bit_cast(float, w & 0xffff0000u); }
__device__ __forceinline__ float sigmoidf_(float x) { return __builtin_amdgcn_rcpf(1.f + __expf(-x)); }
__device__ __forceinline__ float siluf_(float x) { return x * __builtin_amdgcn_rcpf(1.f + __expf(-x)); }
__device__ __forceinline__ float dpp_add(float v, const int ctrl_tag) { return v; }
#define DPP_ADD(v, ctrl) ((v) + __builtin_bit_cast(float, __builtin_amdgcn_update_dpp(0, __builtin_bit_cast(int, (v)), (ctrl), 0xf, 0xf, true)))
__device__ __forceinline__ float sum16(float v) {
    v = DPP_ADD(v, 0xB1);
    v = DPP_ADD(v, 0x4E);
    v = DPP_ADD(v, 0x141);
    v = DPP_ADD(v, 0x140);
    return v;
}
__device__ __forceinline__ float wave_sum(float v) {
    v = sum16(v);
    const float r0 = __builtin_bit_cast(float, __builtin_amdgcn_readlane(__builtin_bit_cast(int, v), 0)), r1 = __builtin_bit_cast(float, __builtin_amdgcn_readlane(__builtin_bit_cast(int, v), 16));
    const float r2 = __builtin_bit_cast(float, __builtin_amdgcn_readlane(__builtin_bit_cast(int, v), 32)), r3 = __builtin_bit_cast(float, __builtin_amdgcn_readlane(__builtin_bit_cast(int, v), 48));
    return (r0 + r1) + (r2 + r3);
}
__device__ __forceinline__ void unpack8(const u32x4 w, float (&o)[8]) {
    o[0] = bflo(w.x); o[1] = bfhi(w.x); o[2] = bflo(w.y); o[3] = bfhi(w.y); o[4] = bflo(w.z); o[5] = bfhi(w.z); o[6] = bflo(w.w); o[7] = bfhi(w.w);
}
__device__ __forceinline__ u32x4 pack8(const float (&v)[8]) { u32x4 w; w.x = pk2(v[0], v[1]); w.y = pk2(v[2], v[3]); w.z = pk2(v[4], v[5]); w.w = pk2(v[6], v[7]); return w; }

__device__ __forceinline__ u32x4 widen16(const u32x2 a, const u32x2 b) {
    const auto r0 = __builtin_amdgcn_permlane16_swap(a.x, b.x, false, false);
    const auto r1 = __builtin_amdgcn_permlane16_swap(a.y, b.y, false, false);
    return (u32x4){r0[0], r1[0], r0[1], r1[1]};
}

namespace pg8 {
constexpr int BM = 256, BK = 64, HALF = 128, HTB = HALF * BK * 2, STAGE_BYTES = 8 * HTB;
__host__ __device__ __forceinline__ int lds_byte(int r, int c) { const int st = (r >> 4) * 2 + (c >> 5), rr = r & 15, cc = c & 31, ob = rr * 64 + cc * 2; return st * 1024 + (ob ^ (((ob >> 9) & 1) << 5)); }
__host__ __device__ __forceinline__ void stage_rc(int b, int& R, int& C) { const int st = b / 1024, sb = b % 1024, swz = sb ^ (((sb >> 9) & 1) << 5); R = (st >> 1) * 16 + swz / 64; C = (st & 1) * 32 + (swz % 64) / 2; }
__host__ __device__ __forceinline__ int perm32(int rho) { const int n = rho >> 4, i = rho & 15; return 8 * (i >> 2) + 4 * n + (i & 3); }
__device__ __forceinline__ unsigned cvt_pk_bf16(float lo, float hi) { unsigned r; asm volatile("v_cvt_pk_bf16_f32 %0, %1, %2" : "=v"(r) : "v"(lo), "v"(hi)); return r; }

struct Unit { const char* A; const char* B; int pm, pn, e, base, ord, cnt  ; };

template <class Epi, class Sched, bool GATHER, bool SP2>
__device__ __forceinline__ void gemm_phase(LAS unsigned char* lds, const int K, const Sched& S, const Epi& E) {
#if MK_REF_GEMM
    {
        const int tid = threadIdx.x, wid = tid >> 6, lane = tid & 63, wr = wid >> 2, wc = wid & 3, fr = lane & 15, fq = lane >> 4;
        Unit cur;
        for (int ui = 0; S.next(ui, cur); ++ui) {
            f32x4 acc[2][2][4][2];
            for (int ai = 0; ai < 2; ++ai) for (int m = 0; m < 4; ++m) {
                const int r = 128 * ai + 64 * wr + 16 * m + fr;
                const bf16* arow = GATHER ? (const bf16*)cur.A + (size_t)S.row_index(cur, r) * K : (const bf16*)cur.A + (size_t)r * K;
                for (int bj = 0; bj < 2; ++bj) for (int n = 0; n < 2; ++n) {
                    f32x4 a4 = {0.f, 0.f, 0.f, 0.f};
                    for (int i = 0; i < 4; ++i) { const int c = 128 * bj + 32 * wc + 8 * fq + 4 * n + i; const bf16* brow = (const bf16*)cur.B + (size_t)c * K;
                        float s = 0.f; for (int k = 0; k < K; ++k) s += bf2f(arow[k]) * bf2f(brow[k]); a4[i] = s; }
                    acc[ai][bj][m][n] = a4; } }
            E(acc, cur, wr, wc, fr, fq);
        }
        return;
    }
#else
    const int tid = threadIdx.x, wid = __builtin_amdgcn_readfirstlane(tid >> 6), lane = tid & 63, wr = wid >> 2, wc = wid & 3, fr = lane & 15, fq = lane >> 4;
    const int nt = K / BK;
    unsigned voffA[2], voffB[2]; int gR = 0, gC = 0;
#pragma unroll
    for (int i = 0; i < 2; ++i) { int R, C; stage_rc(tid * 16 + i * 8192, R, C); const int Rb = (R & ~31) + perm32(R & 31);
        voffA[i] = (unsigned)(R * K + C) * 2u; voffB[i] = (unsigned)(Rb * K + C) * 2u; if (i == 0) { gR = R; gC = C; } }
    const size_t kstep = (size_t)(BK * 2);
    const size_t hstep = (size_t)HALF * K * 2;
    const unsigned ldsw = (unsigned)wid * 1024u;
    const int aoff = lds_byte(wr * 64 + fr, fq * 8), boff = lds_byte(wc * 32 + fr, fq * 8);
#define PG8_SA(b, h) (((b) * 2 + (h)) * HTB)
#define PG8_SB(b, h) ((4 + (b) * 2 + (h)) * HTB)
#define PG8_STAGE(bufoff, gbase, voff) do { _Pragma("unroll") for (int _i = 0; _i < 2; ++_i) \
        __builtin_amdgcn_global_load_lds((const unsigned*)((const char*)(gbase) + (voff)[_i]), (LAS unsigned*)(lds + (bufoff) + ldsw + _i * 8192), 16, 0, 0); } while (0)
#define PG8_STAGE_A(bufoff, gbase, h, G) do { if constexpr (GATHER) { PG8_STAGE(bufoff, gbase, (G)[h]); } else { PG8_STAGE(bufoff, (gbase) + (h) * hstep, voffA); } } while (0)
#define PG8_LDA(dst, b, h) do { _Pragma("unroll") for (int m = 0; m < 4; ++m) _Pragma("unroll") for (int k = 0; k < 2; ++k) dst[m][k] = *(const LAS bf16x8*)(lds + PG8_SA(b, h) + aoff + m * 2048 + k * 1024); } while (0)
#define PG8_LDB(dst, b, h) do { _Pragma("unroll") for (int n = 0; n < 2; ++n) _Pragma("unroll") for (int k = 0; k < 2; ++k) dst[n][k] = *(const LAS bf16x8*)(lds + PG8_SB(b, h) + boff + n * 2048 + k * 1024); } while (0)
#define PG8_MMA(ai, bj, At, Bt) do { __builtin_amdgcn_s_setprio(1); _Pragma("unroll") for (int m = 0; m < 4; ++m) _Pragma("unroll") for (int n = 0; n < 2; ++n) _Pragma("unroll") for (int k = 0; k < 2; ++k) \
        acc[ai][bj][m][n] = __builtin_amdgcn_mfma_f32_16x16x32_bf16(Bt[n][k], At[m][k], acc[ai][bj][m][n], 0, 0, 0); __builtin_amdgcn_s_setprio(0); } while (0)
#define PG8_WAIT_V(n) asm volatile("s_waitcnt vmcnt(" #n ")" ::: "memory")
#define PG8_WAIT_L(n) asm volatile("s_waitcnt lgkmcnt(" #n ")" ::: "memory")
#define PG8_BAR __builtin_amdgcn_s_barrier()
#define PG8_SCHED __builtin_amdgcn_sched_barrier(0)
    Unit cur, nxt; int ui = 0;
    if (!S.next(0, cur)) return;
    f32x4 acc[2][2][4][2];
#pragma unroll
    for (int a = 0; a < 2; ++a)
#pragma unroll
        for (int b = 0; b < 2; ++b)
#pragma unroll
            for (int m = 0; m < 4; ++m)
#pragma unroll
                for (int n = 0; n < 2; ++n) acc[a][b][m][n] = (f32x4){0.f, 0.f, 0.f, 0.f};
    bf16x8 At[4][2], B0[2][2], B1[2][2];
    const char* cA = cur.A; const char* cB = cur.B;
    unsigned cG[2][2] = {{0u, 0u}, {0u, 0u}}, nG[2][2] = {{0u, 0u}, {0u, 0u}};
    if constexpr (GATHER) {
#pragma unroll
        for (int h = 0; h < 2; ++h)
#pragma unroll
            for (int i = 0; i < 2; ++i) cG[h][i] = ((unsigned)S.row_index(cur, 128 * h + gR + 64 * i) * (unsigned)K + (unsigned)gC) * 2u;
    }
    if constexpr (SP2) {
        PG8_STAGE(PG8_SB(0, 0), cB, voffB); PG8_STAGE(PG8_SB(0, 1), cB + hstep, voffB); PG8_STAGE_A(PG8_SA(0, 0), cA, 0, cG); PG8_STAGE_A(PG8_SA(0, 1), cA, 1, cG);
        if (wr == 1) PG8_BAR;
        PG8_WAIT_V(2); PG8_BAR;
        PG8_STAGE(PG8_SB(1, 0), cB + kstep, voffB); PG8_STAGE_A(PG8_SA(1, 0), cA + kstep, 0, cG); PG8_STAGE(PG8_SB(1, 1), cB + hstep + kstep, voffB);
        PG8_WAIT_V(6); PG8_BAR;
    } else {
        PG8_STAGE(PG8_SB(0, 0), cB, voffB); PG8_STAGE_A(PG8_SA(0, 0), cA, 0, cG); PG8_STAGE(PG8_SB(0, 1), cB + hstep, voffB); PG8_STAGE_A(PG8_SA(0, 1), cA, 1, cG);
        if (wr == 1) PG8_BAR;
        PG8_WAIT_V(4); PG8_BAR;
        PG8_STAGE(PG8_SB(1, 0), cB + kstep, voffB); PG8_STAGE_A(PG8_SA(1, 0), cA + kstep, 0, cG); PG8_STAGE(PG8_SB(1, 1), cB + hstep + kstep, voffB);
        PG8_WAIT_V(6); PG8_BAR;
    }
    for (;;) {
        const bool has_next = S.next(ui + 1, nxt);
        const char* nA = has_next ? nxt.A : cA; const char* nB = has_next ? nxt.B : cB;
        for (int t = 0; t < nt; t += 2) {
            const bool last = (t == nt - 2);
            const char* a1 = cA + (size_t)(t + 1) * kstep;
            const char* a2 = last ? nA : cA + (size_t)(t + 2) * kstep; const char* b2 = last ? nB : cB + (size_t)(t + 2) * kstep;
            const char* a3 = a2 + kstep; const char* b3 = b2 + kstep;
            unsigned g2[2][2] = {{0u, 0u}, {0u, 0u}};
            if constexpr (GATHER) {
                if (last) {
                    if (has_next) {
#pragma unroll
                        for (int h = 0; h < 2; ++h)
#pragma unroll
                            for (int i = 0; i < 2; ++i) nG[h][i] = ((unsigned)S.row_index(nxt, 128 * h + gR + 64 * i) * (unsigned)K + (unsigned)gC) * 2u;
                    } else {
#pragma unroll
                        for (int h = 0; h < 2; ++h)
#pragma unroll
                            for (int i = 0; i < 2; ++i) nG[h][i] = cG[h][i];
                    }
                }
#pragma unroll
                for (int h = 0; h < 2; ++h)
#pragma unroll
                    for (int i = 0; i < 2; ++i) g2[h][i] = last ? nG[h][i] : cG[h][i];
            }
            if constexpr (SP2) {
            PG8_LDB(B0, 0, 0); PG8_LDB(B1, 0, 1); PG8_SCHED; PG8_LDA(At, 0, 0); PG8_STAGE_A(PG8_SA(1, 1), a1, 1, cG);
            PG8_WAIT_V(8); PG8_WAIT_L(0); PG8_BAR; PG8_MMA(0, 0, At, B0); PG8_MMA(0, 1, At, B1); PG8_BAR; PG8_SCHED;
            PG8_LDA(At, 0, 1); PG8_STAGE(PG8_SB(0, 0), b2, voffB); PG8_STAGE(PG8_SB(0, 1), b2 + hstep, voffB); PG8_STAGE_A(PG8_SA(0, 0), a2, 0, g2);
            PG8_WAIT_V(8); PG8_WAIT_L(0); PG8_BAR; PG8_MMA(1, 0, At, B0); PG8_MMA(1, 1, At, B1); PG8_BAR; PG8_SCHED;
            PG8_LDB(B0, 1, 0); PG8_LDB(B1, 1, 1); PG8_SCHED; PG8_LDA(At, 1, 0); PG8_STAGE_A(PG8_SA(0, 1), a2, 1, g2);
            PG8_WAIT_V(8); PG8_WAIT_L(0); PG8_BAR; PG8_MMA(0, 0, At, B0); PG8_MMA(0, 1, At, B1); PG8_BAR; PG8_SCHED;
            PG8_LDA(At, 1, 1); PG8_STAGE(PG8_SB(1, 0), b3, voffB); PG8_STAGE(PG8_SB(1, 1), b3 + hstep, voffB); PG8_STAGE_A(PG8_SA(1, 0), a3, 0, g2);
            PG8_WAIT_V(8); PG8_WAIT_L(0); PG8_BAR; PG8_MMA(1, 0, At, B0); PG8_MMA(1, 1, At, B1); PG8_BAR; PG8_SCHED;
            } else {
            PG8_LDB(B0, 0, 0); PG8_SCHED; PG8_LDA(At, 0, 0); PG8_STAGE_A(PG8_SA(1, 1), a1, 1, cG);
            PG8_WAIT_L(8); PG8_BAR; PG8_WAIT_L(0); PG8_MMA(0, 0, At, B0); PG8_BAR; PG8_SCHED;
            PG8_LDB(B1, 0, 1); PG8_STAGE(PG8_SB(0, 0), b2, voffB);
            PG8_BAR; PG8_WAIT_L(0); PG8_MMA(0, 1, At, B1); PG8_BAR;
            PG8_LDA(At, 0, 1); PG8_STAGE_A(PG8_SA(0, 0), a2, 0, g2);
            PG8_BAR; PG8_WAIT_L(0); PG8_MMA(1, 0, At, B0); PG8_BAR; PG8_SCHED;
            PG8_STAGE(PG8_SB(0, 1), b2 + hstep, voffB);
            PG8_WAIT_V(6); PG8_BAR; PG8_MMA(1, 1, At, B1); PG8_BAR;
            PG8_LDB(B0, 1, 0); PG8_SCHED; PG8_LDA(At, 1, 0); PG8_STAGE_A(PG8_SA(0, 1), a2, 1, g2);
            PG8_WAIT_L(8); PG8_BAR; PG8_WAIT_L(0); PG8_MMA(0, 0, At, B0); PG8_BAR; PG8_SCHED;
            PG8_LDB(B1, 1, 1); PG8_STAGE(PG8_SB(1, 0), b3, voffB);
            PG8_BAR; PG8_WAIT_L(0); PG8_MMA(0, 1, At, B1); PG8_BAR;
            PG8_LDA(At, 1, 1); PG8_STAGE_A(PG8_SA(1, 0), a3, 0, g2);
            PG8_BAR; PG8_WAIT_L(0); PG8_MMA(1, 0, At, B0); PG8_BAR; PG8_SCHED;
            PG8_STAGE(PG8_SB(1, 1), b3 + hstep, voffB);
            PG8_WAIT_V(6); PG8_BAR; PG8_MMA(1, 1, At, B1); PG8_BAR;
            }
        }
        if (wr == 0) PG8_BAR;
        { int tz = threadIdx.x; asm volatile("" : "+v"(tz)); const int wid_ = __builtin_amdgcn_readfirstlane(tz >> 6), lane_ = tz & 63;
          E(acc, cur, wid_ >> 2, wid_ & 3, lane_ & 15, lane_ >> 4); }
        if (!has_next) break;
#pragma unroll
        for (int a = 0; a < 2; ++a)
#pragma unroll
            for (int b = 0; b < 2; ++b)
#pragma unroll
                for (int m = 0; m < 4; ++m)
#pragma unroll
                    for (int n = 0; n < 2; ++n) acc[a][b][m][n] = (f32x4){0.f, 0.f, 0.f, 0.f};
        cur = nxt; cA = nA; cB = nB; ++ui;
        if constexpr (GATHER) {
#pragma unroll
            for (int h = 0; h < 2; ++h)
#pragma unroll
                for (int i = 0; i < 2; ++i) cG[h][i] = nG[h][i];
        }
        if (wr == 1) PG8_BAR;
    }
    PG8_WAIT_V(0);
    PG8_BAR;
#undef PG8_SA
#undef PG8_SB
#undef PG8_STAGE
#undef PG8_STAGE_A
#undef PG8_LDA
#undef PG8_LDB
#undef PG8_MMA
#undef PG8_WAIT_V
#undef PG8_WAIT_L
#undef PG8_BAR
#undef PG8_SCHED
#endif
}
}
constexpr bool SP2 = true;

#define XB_TMO      128
#define XB_XCNT(j)  (256  + 64 * (j))
#define XB_XSUB(j)  (1280 + 64 * (j))
#define XB_XGEN(j)  (2304 + 64 * (j))
#define XB_TOP      3328
#define XB_TOPGEN   3392
#define XCD_BAR_WORDS 3456
#define XB_SPIN_CAP (1u << 18)
__device__ __forceinline__ unsigned xb_ld(unsigned* p)              { return __hip_atomic_load(p, __ATOMIC_RELAXED, __HIP_MEMORY_SCOPE_AGENT); }
__device__ __forceinline__ unsigned xb_add(unsigned* p, unsigned v) { return __hip_atomic_fetch_add(p, v, __ATOMIC_RELAXED, __HIP_MEMORY_SCOPE_AGENT); }
__device__ __forceinline__ unsigned xb_xcc_id() { return (unsigned)__builtin_amdgcn_s_getreg((3 << 11) | 20) & 0xFu; }
#define XB_SPIN(cond, bar) do { unsigned _sp = 0; while (cond) { __builtin_amdgcn_s_sleep(1); \
    if ((++_sp & 255u) == 0u) { if (xb_ld(&(bar)[XB_TMO])) break; if (_sp > XB_SPIN_CAP) { atomicAdd(&(bar)[XB_TMO], 1u); break; } } } } while (0)
struct XcdBarrier { unsigned* bar; unsigned x; volatile LAS unsigned* st; };
__device__ __forceinline__ XcdBarrier xcd_barrier_post(unsigned* bar, volatile LAS unsigned* st) {
    XcdBarrier b; b.bar = bar; b.x = xb_xcc_id(); b.st = st;
    if (threadIdx.x == 0) (void)xb_add(&bar[XB_XCNT(b.x)], 1u);
    return b;
}
__device__ __forceinline__ void xcd_barrier_complete(unsigned* bar, unsigned x, unsigned& nloc, unsigned& nx) {
    const unsigned G = gridDim.x * gridDim.y * gridDim.z;
    unsigned sum, cnt, mine, sp = 0u;
    for (;;) {
        sum = 0u; cnt = 0u; mine = 0u;
#pragma unroll
        for (unsigned j = 0; j < 16; ++j) { const unsigned c = xb_ld(&bar[XB_XCNT(j)]); sum += c; cnt += (c > 0u) ? 1u : 0u; mine = (j == x) ? c : mine; }
        if (sum == G) break;
        __builtin_amdgcn_s_sleep(1);
        if ((++sp & 255u) == 0u) { if (xb_ld(&bar[XB_TMO])) break; if (sp > XB_SPIN_CAP) { atomicAdd(&bar[XB_TMO], 1u); break; } }
    }
    nloc = mine > 0u ? mine : 1u; nx = cnt > 0u ? cnt : 1u;
}
__device__ __forceinline__ void xcd_barrier(const XcdBarrier& b) {
    asm volatile("s_waitcnt vmcnt(0)" ::: "memory");
    __syncthreads();
    if (threadIdx.x == 0) {
        unsigned* bar = b.bar;
        __builtin_amdgcn_s_waitcnt(0);
        unsigned nloc = b.st[0], nx = b.st[1];
        if (nloc == 0u) { xcd_barrier_complete(bar, b.x, nloc, nx); b.st[0] = nloc; b.st[1] = nx; }
        const unsigned old = xb_add(&bar[XB_XSUB(b.x)], 1u);
        const unsigned gen = old / nloc;
        if (old + 1u == (gen + 1u) * nloc) {
            __builtin_amdgcn_fence(__ATOMIC_RELEASE, "agent");
            asm volatile("s_waitcnt vmcnt(0)" ::: "memory");
            const unsigned og = xb_add(&bar[XB_TOP], 1u);
            const unsigned tg = og / nx;
            if (og + 1u == (tg + 1u) * nx) xb_add(&bar[XB_TOPGEN], 1u);
            else XB_SPIN(xb_ld(&bar[XB_TOPGEN]) == tg, bar);
            __builtin_amdgcn_fence(__ATOMIC_ACQUIRE, "agent");
            xb_add(&bar[XB_XGEN(b.x)], 1u);
            asm volatile("s_waitcnt vmcnt(0)" ::: "memory");
        } else {
            XB_SPIN(xb_ld(&bar[XB_XGEN(b.x)]) == gen, bar);
            __builtin_amdgcn_fence(__ATOMIC_ACQUIRE, "agent");
            asm volatile("s_waitcnt vmcnt(0)" ::: "memory");
        }
    }
    __syncthreads();
}

constexpr int NWAVES = 8, NTHR = 512;
constexpr int RING_BYTES = 131072, MISC_OFF = 139264, LDS_BYTES = 147456;
struct Args {
    const float* in[28]; float* out; unsigned char* ws; int ph_lo, ph_hi;
};
struct Frame {
    LAS unsigned char* lds; int tid, lane, wave, G, bid;
    const float *x, *c, *ctx, *c_ctx, *w_mod, *b_mod, *n_mix_pre, *n_mix_post, *n_ffn_pre, *n_ffn_post, *w_in, *gdn_conv, *ret_log_decay, *gdn_a_log, *gdn_dt_bias,
        *ret_gn_w, *gdn_norm_w, *w_ret_out, *w_gdn_out, *w_o, *w_router, *router_bias, *w_gate, *w_up, *w_down, *w_sh_gate, *w_sh_up, *w_sh_down;
    float* out; unsigned char* ws; unsigned* ctl;
};
#define WSP(T, off) ((T*)(F.ws + (off)))

template <class CM, bool NT = false>
__device__ __forceinline__ void transpose_item(const float* W, int ld, int K, bf16* WT, LAS float* scr, int kb, int nb, int lane, const CM& cm) {
    const int k0 = 64 * kb, n0 = 32 * nb; const int kr = lane >> 3, seg = lane & 7;
    const float* src = W + (size_t)(k0 + kr) * ld + cm.src(n0 + 4 * seg);
    f32x4 tv[8];
#pragma unroll
    for (int i = 0; i < 8; ++i) { const f32x4* p_ = (const f32x4*)(src + (size_t)(8 * i) * ld); tv[i] = NT ? __builtin_nontemporal_load(p_) : *p_; }
#pragma unroll
    for (int i = 0; i < 8; ++i) { LAS float* w_ = scr + (8 * i + kr) * 33 + 4 * seg; w_[0] = tv[i].x; w_[1] = tv[i].y; w_[2] = tv[i].z; w_[3] = tv[i].w; }
    asm volatile("s_waitcnt lgkmcnt(0)" ::: "memory");
    const int c = lane & 7;
#pragma unroll
    for (int j = 0; j < 4; ++j) { const int n = (lane >> 3) + 8 * j; const LAS float* s = scr + (8 * c) * 33 + n;
        u32x4 o; o.x = pk2(s[0 * 33], s[1 * 33]); o.y = pk2(s[2 * 33], s[3 * 33]); o.z = pk2(s[4 * 33], s[5 * 33]); o.w = pk2(s[6 * 33], s[7 * 33]);
        u32x4* q_ = (u32x4*)(WT + (size_t)cm.dst(n0 + n) * K + k0 + 8 * c); if (NT) __builtin_nontemporal_store(o, q_); else *q_ = o; }
    asm volatile("s_waitcnt lgkmcnt(0)" ::: "memory");
}
struct CmIdent { int off; __device__ __forceinline__ int src(int n) const { return n + off; } __device__ __forceinline__ int dst(int n) const { return n; } };
struct CmWin {
    __device__ __forceinline__ int src(int n) const { return n + (n >= 2048 ? 16 : 0); }
    __device__ __forceinline__ int dst(int n) const {
        const int g = n >> 9; int r = n;
        if (g == 0 || g == 4) { const int hb = n & ~127, d = n & 127; const int nn = d >> 6, wc = (d >> 4) & 3, fq = (d >> 2) & 3, i = d & 3; r = hb + 32 * wc + 8 * fq + 4 * nn + i; }
        return r; }
};
__device__ __forceinline__ void gu_decode(int cp, int& hid, int& isup) { const int pn = cp >> 8, r = cp & 255, bj = r >> 7, wc = (r >> 5) & 3, fq = (r >> 3) & 3, nn = (r >> 2) & 1, i = r & 3; hid = pn * 128 + bj * 64 + wc * 16 + fq * 4 + i; isup = nn; }

__device__ __forceinline__ void phase_prologue(Frame& F) {
    const int gw = F.bid * NWAVES + F.wave, NGW = F.G * NWAVES; const int gt = F.bid * NTHR + F.tid, NGT = F.G * NTHR;
    LAS float* scr = (LAS float*)(F.lds + F.wave * 16384);
    { float2* rt = WSP(float2, WS_ROPE);
      for (int idx = gt; idx < SEQ * 64; idx += NGT) { const int t = idx >> 6, j = idx & 63; const float pos = (float)(j < 32 ? (t >> 6) : (t & 63)); const int f = j & 31;
          const float inv = powf(10000.0f, -(float)f / 32.0f); const float ang = pos * inv; float sn, cs; sincosf(ang, &sn, &cs); rt[idx] = make_float2(cs, sn); } }
    {
        LAS float* red = (LAS float*)(F.lds);
        LAS float* sl = (LAS float*)(F.lds + 16384);
        bool sl_ready = false;
        for (int it = F.bid; it < 256 || !sl_ready; it += F.G) {
            const bool has = it < 256;
            const int sub = F.lane / 24, cl = F.lane - 24 * sub; const bool act = sub < 2;
            const int col = (has ? it : 0) * 24 + (act ? cl : 0); float a[5] = {0.f, 0.f, 0.f, 0.f, 0.f};
            const int kb = (F.wave * 2 + (sub & 1)) * 64;
            float wv[64];
#pragma unroll
            for (int kk = 0; kk < 64; ++kk) wv[kk] = F.w_mod[(size_t)(kb + kk) * 6144 + col];
            if (!sl_ready) { sl_ready = true;
                for (int i = F.tid; i < 5 * DM; i += NTHR) { const int r = i >> 10, k = i & 1023; sl[i] = siluf_(r < 4 ? F.c[r * DM + k] : F.c_ctx[k]); }
                __syncthreads(); }
            if (!has) break;
#pragma unroll
            for (int kk = 0; kk < 64; ++kk) {
#pragma unroll
                for (int r = 0; r < 5; ++r) a[r] += sl[r * DM + kb + kk] * wv[kk]; }
            if (act) {
#pragma unroll
                for (int r = 0; r < 5; ++r) red[((F.wave * 2 + sub) * 5 + r) * 24 + cl] = a[r]; }
            __syncthreads();
            if (F.tid < 120) { const int r = F.tid / 24, c = F.tid - 24 * r; float s = F.b_mod[it * 24 + c];
#pragma unroll
                for (int p2 = 0; p2 < 16; ++p2) s += red[(p2 * 5 + r) * 24 + c];
                WSP(float, WS_MOD)[r * 6144 + it * 24 + c] = s; }
            __syncthreads();
        }
    }
    {
        constexpr int I_IN = 16 * 192, I_RO = 8 * 32, I_O = 16 * 32; constexpr int NIT = I_IN + 2 * I_RO + I_O;
        for (int it = gw; it < NIT; it += NGW) { int r = it;
            if (r < I_IN) { transpose_item(F.w_in, N_IN, DM, WSP(bf16, WS_WIN), scr, r / 192, r % 192, F.lane, CmWin{}); continue; } r -= I_IN;
            if (r < I_RO) { transpose_item(F.w_ret_out, DM, 512, WSP(bf16, WS_WRO), scr, r / 32, r % 32, F.lane, CmIdent{0}); continue; } r -= I_RO;
            if (r < I_RO) { transpose_item(F.w_gdn_out, DM, 512, WSP(bf16, WS_WGO), scr, r / 32, r % 32, F.lane, CmIdent{0}); continue; } r -= I_RO;
            transpose_item(F.w_o, DM, DM, WSP(bf16, WS_WO), scr, r / 32, r % 32, F.lane, CmIdent{0}); }
    }
}

struct CvItem { const float* src; int ld; bf16* dst; int K; int nq; };
__device__ __forceinline__ CvItem moe_item(Frame& F, int it, int per, int lane_) {
    constexpr int I_GU = 16 * 16;
    const int e = it / per; int r = it % per; CvItem d; const int kr = lane_ >> 3, seg = lane_ & 7;
    if (r < I_GU) {
        const int kb = r / 16, nb = r % 16;
        const int k0 = 64 * kb, n0 = 32 * nb; d.nq = 8 * (seg & 3) + 4 * (seg >> 2); int hid, isup; gu_decode(n0 + d.nq, hid, isup);
        const float* Wg = e < 64 ? F.w_gate + (size_t)e * DM * DEXP : F.w_sh_gate; const float* Wu = e < 64 ? F.w_up + (size_t)e * DM * DEXP : F.w_sh_up;
        d.src = (isup ? Wu : Wg) + (size_t)(k0 + kr) * DEXP + hid; d.ld = DEXP; d.dst = WSP(bf16, WS_WGU) + (size_t)e * 512 * DM + (size_t)n0 * DM + k0; d.K = DM;
    } else { r -= I_GU; const int kb = r / 32, nb = r % 32; const int k0 = 64 * kb, n0 = 32 * nb; d.nq = 4 * seg;
        const float* W = e < 64 ? F.w_down + (size_t)e * DEXP * DM : F.w_sh_down;
        d.src = W + (size_t)(k0 + kr) * DM + n0 + d.nq; d.ld = DM; d.dst = WSP(bf16, WS_WD) + (size_t)e * DM * DEXP + (size_t)n0 * DEXP + k0; d.K = DEXP; }
    return d;
}
__device__ __forceinline__ void cv_finish(const f32x4 (&tv)[8], const CvItem& d, LAS float* scr, int lane_) {
#pragma unroll
    for (int i = 0; i < 8; ++i) { LAS float* w = scr + (8 * i + (lane_ >> 3)) * 33 + d.nq; w[0] = tv[i].x; w[1] = tv[i].y; w[2] = tv[i].z; w[3] = tv[i].w; }
    asm volatile("s_waitcnt lgkmcnt(0)" ::: "memory");
    const int c = lane_ & 7;
#pragma unroll
    for (int j = 0; j < 4; ++j) { const int n = (lane_ >> 3) + 8 * j; const LAS float* s = scr + (8 * c) * 33 + n;
        u32x4 o; o.x = pk2(s[0 * 33], s[1 * 33]); o.y = pk2(s[2 * 33], s[3 * 33]); o.z = pk2(s[4 * 33], s[5 * 33]); o.w = pk2(s[6 * 33], s[7 * 33]);
        *(u32x4*)(d.dst + (size_t)n * d.K + 8 * c) = o; }
}
__device__ __forceinline__ void phase_moe_weights(Frame& F, const bool with_down) {
    int tz = threadIdx.x; asm volatile("" : "+v"(tz));
    const int lane_ = tz & 63, wave_ = __builtin_amdgcn_readfirstlane(tz >> 6);
    LAS float* scr = (LAS float*)(F.lds + wave_ * 16896);
    constexpr int I_GU = 16 * 16  , I_D = 4 * 32;
    const int per = with_down ? I_GU + I_D : I_GU; const int total = 65 * per;
    const int cb = (total + F.G - 1) / F.G, lo_ = F.bid * cb, hi_ = lo_ + cb < total ? lo_ + cb : total;
    for (int it = lo_ + wave_; it < hi_; it += 2 * NWAVES) {
        const bool two = it + NWAVES < hi_;
        const CvItem d0 = moe_item(F, it, per, lane_), d1 = moe_item(F, two ? it + NWAVES : it, per, lane_);
        f32x4 t0[8], t1[8];
#pragma unroll
        for (int i = 0; i < 8; ++i) t0[i] = *(const f32x4*)(d0.src + (size_t)(8 * i) * d0.ld);
        if (two) {
#pragma unroll
            for (int i = 0; i < 8; ++i) t1[i] = *(const f32x4*)(d1.src + (size_t)(8 * i) * d1.ld); }
        cv_finish(t0, d0, scr, lane_);
        if (two) cv_finish(t1, d1, scr + 64 * 33, lane_);
        asm volatile("s_waitcnt lgkmcnt(0)" ::: "memory");
    }
}

__device__ __forceinline__ void phase_moe_wd(Frame& F, int bid0) {
    int tz = threadIdx.x; asm volatile("" : "+v"(tz));
    const int lane_ = tz & 63, wave_ = __builtin_amdgcn_readfirstlane(tz >> 6);
    LAS float* scr = (LAS float*)(F.lds + wave_ * 16384);
    const int nb_ = F.G - bid0, cb = (65 * 128 + nb_ - 1) / nb_, lo_ = (F.bid - bid0) * cb, hi_ = lo_ + cb < 65 * 128 ? lo_ + cb : 65 * 128;
    for (int it = lo_ + wave_; it < hi_; it += NWAVES) { const int e = it >> 7, r = it & 127;
        const float* W = e < 64 ? F.w_down + (size_t)e * DEXP * DM : F.w_sh_down;
        transpose_item<CmIdent, true>(W, DM, DEXP, WSP(bf16, WS_WD) + (size_t)e * DM * DEXP, scr, r / 32, r % 32, lane_, CmIdent{0}); }
}
template <bool LAT> __device__ __forceinline__ int norm1_row_of(int i) { return LAT ? (i >> 12) * RPB + CTXL + (i & 4095) : i; }
template <bool LAT>
__device__ __forceinline__ void norm1_rows(Frame& F, LAS float* wl, int w0, int nw, int r_lo, int r_hi) {
    const float* mod = WSP(float, WS_MOD);
    int ri = r_lo + w0; if (ri >= r_hi) return;
    f32x4 vn[4];
    { const int row = norm1_row_of<LAT>(ri); const int b = row / RPB, pos = row % RPB; const float* src = pos < CTXL ? F.ctx + ((size_t)b * CTXL + pos) * DM : F.x + ((size_t)b * SEQ + (pos - CTXL)) * DM;
#pragma unroll
      for (int j = 0; j < 4; ++j) vn[j] = *(const f32x4*)(src + 4 * (F.lane + 64 * j)); }
    int pkey = -1; f32x4 pg[4], ps1[4], ps0[4];
    for (; ri < r_hi; ri += nw) {
        const int row = norm1_row_of<LAT>(ri); const int b = row / RPB, pos = row % RPB; const bool isctx = pos < CTXL;
        { const int key = isctx ? 4 : b;
          if (key != pkey) { pkey = key; const float* sh = mod + key * 6144; const float* sc = sh + DM;
#pragma unroll
              for (int j = 0; j < 4; ++j) { const int c0 = 4 * (F.lane + 64 * j); pg[j] = *(const f32x4*)(F.n_mix_pre + c0); ps1[j] = *(const f32x4*)(sc + c0) + 1.0f; ps0[j] = *(const f32x4*)(sh + c0); } } }
        f32x4 v[4]; float ss = 0.f;
#pragma unroll
        for (int j = 0; j < 4; ++j) { v[j] = vn[j]; ss += v[j].x * v[j].x + v[j].y * v[j].y + v[j].z * v[j].z + v[j].w * v[j].w; }
        { const int nri = ri + nw; if (nri < r_hi) { const int nr = norm1_row_of<LAT>(nri); const int nb = nr / RPB, np = nr % RPB; const float* src = np < CTXL ? F.ctx + ((size_t)nb * CTXL + np) * DM : F.x + ((size_t)nb * SEQ + (np - CTXL)) * DM;
#pragma unroll
            for (int j = 0; j < 4; ++j) vn[j] = *(const f32x4*)(src + 4 * (F.lane + 64 * j)); } }
        const float rstd = 1.0f / sqrtf(wave_sum(ss) * (1.f / DM) + EPS);
        f32x2 gp2[8];
#pragma unroll
        for (int p = 0; p < 8; ++p) gp2[p] = (f32x2){0.f, 0.f};
#pragma unroll
        for (int j = 0; j < 4; ++j) { const int c0 = 4 * (F.lane + 64 * j);
            const f32x4 g = pg[j], s1 = ps1[j], s0 = ps0[j];
            f32x4 h; h.x = v[j].x * rstd * g.x * s1.x + s0.x; h.y = v[j].y * rstd * g.y * s1.y + s0.y; h.z = v[j].z * rstd * g.z * s1.z + s0.z; h.w = v[j].w * rstd * g.w * s1.w + s0.w;
            u32x2 o; o.x = pk2(h.x, h.y); o.y = pk2(h.z, h.w);
            *(u32x2*)(WSP(bf16, WS_HX) + (size_t)row * DM + c0) = o;
#pragma unroll
            for (int ph = 0; ph < 2; ++ph) {
                asm volatile("" ::: "memory");
#pragma unroll
                for (int p = 4 * ph; p < 4 * ph + 4; ++p) { const LAS float* wp = wl + (p * DM + c0) * 2; const f32x4 wa = *(const LAS f32x4*)wp, wb = *(const LAS f32x4*)(wp + 4);
                    gp2[p] += (f32x2){wa.x, wa.y} * h.x; gp2[p] += (f32x2){wa.z, wa.w} * h.y; gp2[p] += (f32x2){wb.x, wb.y} * h.z; gp2[p] += (f32x2){wb.z, wb.w} * h.w; } } }
        float gd[16];
#pragma unroll
        for (int p = 0; p < 8; ++p) { gd[2 * p] = gp2[p].x; gd[2 * p + 1] = gp2[p].y; }
        float g8[8], g4[4], g2[2], mine;
        { const bool b0 = F.lane & 1, b1 = F.lane & 2, b2 = F.lane & 4, b3 = F.lane & 8;
#pragma unroll
          for (int i = 0; i < 8; ++i) { const float snd = b0 ? gd[2 * i] : gd[2 * i + 1], kp = b0 ? gd[2 * i + 1] : gd[2 * i]; g8[i] = kp + __shfl_xor(snd, 1); }
#pragma unroll
          for (int i = 0; i < 4; ++i) { const float snd = b1 ? g8[2 * i] : g8[2 * i + 1], kp = b1 ? g8[2 * i + 1] : g8[2 * i]; g4[i] = kp + __shfl_xor(snd, 2); }
#pragma unroll
          for (int i = 0; i < 2; ++i) { const float snd = b2 ? g4[2 * i] : g4[2 * i + 1], kp = b2 ? g4[2 * i + 1] : g4[2 * i]; g2[i] = kp + __shfl_xor(snd, 4); }
          { const float snd = b3 ? g2[0] : g2[1], kp = b3 ? g2[1] : g2[0]; mine = kp + __shfl_xor(snd, 8); }
          mine += __shfl_xor(mine, 16); mine += __shfl_xor(mine, 32); }
        if (F.lane < 16) { const int ab = F.lane >> 3, dir = (F.lane >> 2) & 1, h = F.lane & 3; const size_t o = ((size_t)(dir * NB + b) * NH + h) * RPB + pos;
            if (ab == 0) { const float z = mine + F.gdn_dt_bias[dir * 4 + h]; const float sp = z > 20.f ? z : log1pf(expf(z)); WSP(float, WS_LOGA)[o] = -expf(F.gdn_a_log[dir * 4 + h]) * sp; }
            else WSP(float, WS_BETA)[o] = 1.f / (1.f + expf(-mine)); }
    }
}
__device__ __forceinline__ void phase_norm1(Frame& F) {
    const int gw = F.bid * NWAVES + F.wave, NGW = F.G * NWAVES;
    LAS float* wl = (LAS float*)F.lds;
    for (int k = F.tid; k < DM; k += NTHR) { const float* wr = F.w_in + (size_t)k * N_IN + 2048;
#pragma unroll
        for (int jj = 0; jj < 4; ++jj) { const f32x4 w4 = *(const f32x4*)(wr + 4 * jj);
            *(LAS f32x2*)(wl + ((2 * jj) * DM + k) * 2) = (f32x2){w4.x, w4.y}; *(LAS f32x2*)(wl + ((2 * jj + 1) * DM + k) * 2) = (f32x2){w4.z, w4.w}; } }
    __syncthreads();
    if (F.G < 64) { norm1_rows<false>(F, wl, gw, NGW, 0, NROW); return; }
    if (F.bid < 32) {
        const int b = F.bid >> 3, sub = F.bid & 7; const int r0 = b * RPB + 32 * sub;
        norm1_rows<false>(F, wl, F.wave, NWAVES, r0, r0 + 32);
        asm volatile("s_waitcnt vmcnt(0)" ::: "memory");
        __syncthreads();
        if (F.tid == 0) {
            unsigned* flag = F.ctl + CW_FLAG + 64 * b;
            __builtin_amdgcn_fence(__ATOMIC_RELEASE, "agent"); asm volatile("s_waitcnt vmcnt(0)" ::: "memory");
            __hip_atomic_fetch_add(flag, 1u, __ATOMIC_RELAXED, __HIP_MEMORY_SCOPE_AGENT);
            unsigned sp = 0; while (__hip_atomic_load(flag, __ATOMIC_RELAXED, __HIP_MEMORY_SCOPE_AGENT) < 8u) { __builtin_amdgcn_s_sleep(1); if (++sp > (1u << 22)) break; }
            __builtin_amdgcn_fence(__ATOMIC_ACQUIRE, "agent"); asm volatile("s_waitcnt vmcnt(0)" ::: "memory");
        }
        __syncthreads();
    } else {
        norm1_rows<true>(F, wl, (F.bid - 32) * NWAVES + F.wave, (F.G - 32) * NWAVES, 0, NT);
    }
}

struct SchedIn {
    const char* A; const char* B; int G, c;
    __device__ __forceinline__ bool next(int i, pg8::Unit& u) const {
        const int L = i * G + c; if (L >= (G < 64 ? 1536 + 32 : 1536)) return false;
        int lt, pn;
        if (L < 1536) { int wgid = L; { const int q = 1536 / 8, xcd = wgid % 8, off = wgid / 8; wgid = xcd * q + off; }
            const int nig = 8 * 24, gid = wgid / nig, fm = gid * 8; lt = fm + ((wgid % nig) % 8); pn = (wgid % nig) / 8; u.pm = (lt >> 4) * 17 + 1 + (lt & 15); }
        else { const int q = L - 1536; u.pm = (q >> 3) * 17; pn = q & 7; }
        u.pn = pn; u.e = 0; u.base = 0; u.A = A + (size_t)u.pm * 256 * DM * 2; u.B = B + (size_t)pn * 256 * DM * 2; return true; }
    __device__ __forceinline__ int row_index(const pg8::Unit&, int r) const { return r; }
};
struct SchedCtx {
    const char* A; const char* B; int b, pn;
    __device__ __forceinline__ bool next(int i, pg8::Unit& u) const { if (i > 0) return false; u.pm = b * 17; u.pn = pn; u.e = 0; u.base = 0; u.A = A + (size_t)u.pm * 256 * DM * 2; u.B = B + (size_t)pn * 256 * DM * 2; return true; }
    __device__ __forceinline__ int row_index(const pg8::Unit&, int r) const { return r; }
};
struct EpiIn {
    bf16* P; bf16* GATES; const float2* rope;
    __device__ __forceinline__ void operator()(const f32x4 (&acc)[2][2][4][2], const pg8::Unit& u, int wr, int wc, int fr, int fq) const {
        const int g = u.pn >> 1;
        const int b = u.pm / 17, tl = u.pm % 17;
        if (g == 0 || g == 4) {
            const float sc_ = (g == 0) ? 0.08838834764831845f : 1.0f;
#pragma unroll
            for (int ai = 0; ai < 2; ++ai)
#pragma unroll
                for (int mp = 0; mp < 2; ++mp)
#pragma unroll
                    for (int bj = 0; bj < 2; ++bj) { u32x2 w1[2], w2[2];
#pragma unroll
                        for (int h = 0; h < 2; ++h) { const int rt = ai * 128 + wr * 64 + (2 * mp + h) * 16 + fr;
                            const f32x4 v0 = acc[ai][bj][2 * mp + h][0] * sc_, v1 = acc[ai][bj][2 * mp + h][1] * sc_; f32x4 o1 = v0, o2 = v1;
                            if (tl != 0) { const int t = (tl - 1) * 256 + rt; const float2* cs = rope + (size_t)t * 64 + 16 * wc + 4 * fq;
#pragma unroll
                                for (int i = 0; i < 4; ++i) { const float2 c2 = cs[i]; o1[i] = v0[i] * c2.x - v1[i] * c2.y; o2[i] = v0[i] * c2.y + v1[i] * c2.x; } }
                            w1[h].x = pk2(o1[0], o1[1]); w1[h].y = pk2(o1[2], o1[3]); w2[h].x = pk2(o2[0], o2[1]); w2[h].y = pk2(o2[2], o2[3]); }
                        const size_t prow = (size_t)u.pm * 256 + ai * 128 + wr * 64 + (2 * mp + (fq & 1)) * 16 + fr;
                        bf16* dst = P + (size_t)g * PGRP + prow * 512 + (u.pn & 1) * 256 + bj * 128 + 16 * wc + 4 * (fq & 2);
                        *(u32x4*)dst = widen16(w1[0], w1[1]); *(u32x4*)(dst + 64) = widen16(w2[0], w2[1]); }
            return;
        }
#pragma unroll
        for (int ai = 0; ai < 2; ++ai)
#pragma unroll
            for (int m = 0; m < 4; ++m) {
                const int rt = ai * 128 + wr * 64 + m * 16 + fr; const size_t prow = (size_t)u.pm * 256 + rt;
#pragma unroll
                for (int bj = 0; bj < 2; ++bj) {
                    f32x4 v0 = acc[ai][bj][m][0], v1 = acc[ai][bj][m][1];
                    const int ct = bj * 128 + wc * 32 + 8 * fq;
                    if (g == 0 || g == 4) {
                        const float s = (g == 0) ? 0.08838834764831845f : 1.0f; v0 = v0 * s; v1 = v1 * s;
                        const int j = 16 * wc + 4 * fq;
                        f32x4 o1 = v0, o2 = v1;
                        if (tl != 0) { const int t = (tl - 1) * 256 + rt; const float2* cs = rope + (size_t)t * 64 + j;
#pragma unroll
                            for (int i = 0; i < 4; ++i) { const float2 c2 = cs[i]; o1[i] = v0[i] * c2.x - v1[i] * c2.y; o2[i] = v0[i] * c2.y + v1[i] * c2.x; } }
                        bf16* dst = P + (size_t)g * PGRP + prow * 512 + (u.pn & 1) * 256 + bj * 128 + j;
                        u32x2 w1, w2; w1.x = pk2(o1[0], o1[1]); w1.y = pk2(o1[2], o1[3]); w2.x = pk2(o2[0], o2[1]); w2.y = pk2(o2[2], o2[3]);
                        *(u32x2*)dst = w1; *(u32x2*)(dst + 64) = w2;
                    } else if (g < 8) {
                        u32x4 w; w.x = pk2(v0[0], v0[1]); w.y = pk2(v0[2], v0[3]); w.z = pk2(v1[0], v1[1]); w.w = pk2(v1[2], v1[3]);
                        *(u32x4*)(P + (size_t)g * PGRP + prow * 512 + (u.pn & 1) * 256 + ct) = w;
                    } else {
                        const size_t lrow = (size_t)b * SEQ + (size_t)(tl - 1) * 256 + rt;
#pragma unroll
                        for (int i = 0; i < 4; ++i) { v0[i] = sigmoidf_(v0[i]); v1[i] = sigmoidf_(v1[i]); }
                        u32x4 w; w.x = pk2(v0[0], v0[1]); w.y = pk2(v0[2], v0[3]); w.z = pk2(v1[0], v1[1]); w.w = pk2(v1[2], v1[3]);
                        *(u32x4*)(GATES + lrow * 2048 + (u.pn - 16) * 256 + ct) = w;
                    }
                }
            }
    }
};

constexpr int IMGB = 34816, IMGS = 272;
typedef short s16x4 __attribute__((ext_vector_type(4)));
__device__ __forceinline__ unsigned offb(unsigned row, unsigned ch) { return 272u * row + 16u * ch; }
__device__ __forceinline__ unsigned offe(unsigned row, unsigned col) { return 272u * row + 2u * col; }
__device__ __forceinline__ bf16x8 frag_row(LAS unsigned char* img, int tile, int s, int lane) { return *(const LAS bf16x8*)(img + offb(16 * tile + (lane & 15), 4 * s + (lane >> 4))); }
__device__ __forceinline__ bf16x8 frag_tr(LAS unsigned char* img, int tile, int s, int lane) {
    const unsigned g = lane >> 4, qq = (lane & 15) >> 2, p = lane & 3;
    const s16x4 lo = __builtin_amdgcn_ds_read_tr16_b64_v4i16((LAS s16x4*)(img + offe(32 * s + 8 * g + qq, 16 * tile + 4 * p)));
    const s16x4 hi = __builtin_amdgcn_ds_read_tr16_b64_v4i16((LAS s16x4*)(img + offe(32 * s + 8 * g + 4 + qq, 16 * tile + 4 * p)));
    return (bf16x8){lo[0], lo[1], lo[2], lo[3], hi[0], hi[1], hi[2], hi[3]};
}
#define MFMA16(a, b, c) __builtin_amdgcn_mfma_f32_16x16x32_bf16(a, b, c, 0, 0, 0)
#define LBAR() do { asm volatile("s_waitcnt lgkmcnt(0)" ::: "memory"); __builtin_amdgcn_s_barrier(); asm volatile("" ::: "memory"); } while (0)
template <bool SWAP>
__device__ __forceinline__ void mm128(LAS unsigned char* ia, bool atr, LAS unsigned char* ib, bool btr, int wr, int wc, int lane, f32x4 (&acc)[2][4]) {
#pragma unroll
    for (int s = 0; s < 4; ++s) {
        bf16x8 fa[2], fb[4];
#pragma unroll
        for (int i = 0; i < 2; ++i) fa[i] = atr ? frag_tr(ia, 2 * wr + i, s, lane) : frag_row(ia, 2 * wr + i, s, lane);
#pragma unroll
        for (int j = 0; j < 4; ++j) fb[j] = btr ? frag_tr(ib, 4 * wc + j, s, lane) : frag_row(ib, 4 * wc + j, s, lane);
#pragma unroll
        for (int i = 0; i < 2; ++i)
#pragma unroll
            for (int j = 0; j < 4; ++j) acc[i][j] = SWAP ? MFMA16(fb[j], fa[i], acc[i][j]) : MFMA16(fa[i], fb[j], acc[i][j]);
    }
}
__device__ __forceinline__ void zero_acc(f32x4 (&acc)[2][4]) {
#pragma unroll
    for (int i = 0; i < 2; ++i)
#pragma unroll
        for (int j = 0; j < 4; ++j) acc[i][j] = (f32x4){0.f, 0.f, 0.f, 0.f};
}
__device__ __forceinline__ void st_img(LAS unsigned char* img, const f32x4 (&acc)[2][4], int wr, int wc, int lane) {
    const int r = lane & 15, q = lane >> 4;
#pragma unroll
    for (int i = 0; i < 2; ++i)
#pragma unroll
        for (int j = 0; j < 4; ++j) { u32x2 w; w.x = pk2(acc[i][j][0], acc[i][j][1]); w.y = pk2(acc[i][j][2], acc[i][j][3]);
            *(LAS u32x2*)(img + offe(32 * wr + 16 * i + r, 64 * wc + 16 * j + 4 * q)) = w; }
}
__device__ __forceinline__ void load_plain_img(LAS unsigned char* img, const bf16* src, int ld, int tid) {
#pragma unroll
    for (int i = 0; i < 4; ++i) { const int cidx = tid + 512 * i, row = cidx >> 4, ch = cidx & 15;
        *(LAS u32x4*)(img + offb(row, ch)) = *(const u32x4*)(src + (size_t)row * ld + 8 * ch); }
}
__device__ __forceinline__ void load_conv_img(LAS unsigned char* img, const bf16* src, const float* cw  , bool has_prev, bool has_next, int mode  , int wave, int lane) {
    asm volatile("" ::: "memory");
    const int ch = lane & 15; float w0[8], w1[8], w2[8];
#pragma unroll
    for (int i = 0; i < 8; ++i) { w0[i] = cw[8 * ch + i]; w1[i] = cw[1536 + 8 * ch + i]; w2[i] = cw[3072 + 8 * ch + i]; }
#pragma unroll
    for (int it = 0; it < 4; ++it) {
        const int row = 32 * it + 4 * wave + (lane >> 4); const u32x4 z4 = {0u, 0u, 0u, 0u};
        const u32x4 r0 = (row > 0 || has_prev) ? *(const u32x4*)(src + ((ptrdiff_t)row - 1) * 512 + 8 * ch) : z4;
        const u32x4 r1 = *(const u32x4*)(src + (size_t)row * 512 + 8 * ch);
        const u32x4 r2 = (row < 127 || has_next) ? *(const u32x4*)(src + (size_t)(row + 1) * 512 + 8 * ch) : z4;
        float a0[8], a1[8], a2[8], y[8]; unpack8(r0, a0); unpack8(r1, a1); unpack8(r2, a2); float ss = 0.f;
#pragma unroll
        for (int i = 0; i < 8; ++i) { y[i] = siluf_(w0[i] * a0[i] + w1[i] * a1[i] + w2[i] * a2[i]); ss += y[i] * y[i]; }
        if (mode != 1) { const float sc = (1.0f / sqrtf(sum16(ss) + EPS)) * (mode == 2 ? 0.08838834764831845f : 1.0f);
#pragma unroll
            for (int i = 0; i < 8; ++i) y[i] *= sc; }
        *(LAS u32x4*)(img + offb(row, ch)) = pack8(y);
    }
}
__device__ __forceinline__ void load_conv_img_keep(u32x4 (&keep)[4], LAS unsigned char* img, const bf16* src, const float* cw  , bool has_prev, bool has_next, int mode  , int wave, int lane) {
    asm volatile("" ::: "memory");
    const int ch = lane & 15; float w0[8], w1[8], w2[8];
#pragma unroll
    for (int i = 0; i < 8; ++i) { w0[i] = cw[8 * ch + i]; w1[i] = cw[1536 + 8 * ch + i]; w2[i] = cw[3072 + 8 * ch + i]; }
#pragma unroll
    for (int it = 0; it < 4; ++it) {
        const int row = 32 * it + 4 * wave + (lane >> 4); const u32x4 z4 = {0u, 0u, 0u, 0u};
        const u32x4 r0 = (row > 0 || has_prev) ? *(const u32x4*)(src + ((ptrdiff_t)row - 1) * 512 + 8 * ch) : z4;
        const u32x4 r1 = *(const u32x4*)(src + (size_t)row * 512 + 8 * ch);
        const u32x4 r2 = (row < 127 || has_next) ? *(const u32x4*)(src + (size_t)(row + 1) * 512 + 8 * ch) : z4;
        float a0[8], a1[8], a2[8], y[8]; unpack8(r0, a0); unpack8(r1, a1); unpack8(r2, a2); float ss = 0.f;
#pragma unroll
        for (int i = 0; i < 8; ++i) { y[i] = siluf_(w0[i] * a0[i] + w1[i] * a1[i] + w2[i] * a2[i]); ss += y[i] * y[i]; }
        if (mode != 1) { const float sc = (1.0f / sqrtf(sum16(ss) + EPS)) * (mode == 2 ? 0.08838834764831845f : 1.0f);
#pragma unroll
            for (int i = 0; i < 8; ++i) y[i] *= sc; }
        keep[it] = pack8(y); *(LAS u32x4*)(img + offb(row, ch)) = keep[it];
    }
}
__device__ __forceinline__ void conv_v_keep(u32x4 (&keep)[4], const bf16* src, const float* cw, bool has_prev, bool has_next, int wave, int lane) {
    const int ch = lane & 15; float w0[8], w1[8], w2[8];
#pragma unroll
    for (int i = 0; i < 8; ++i) { w0[i] = cw[8 * ch + i]; w1[i] = cw[1536 + 8 * ch + i]; w2[i] = cw[3072 + 8 * ch + i]; }
    u32x4 r0[4], r1[4], r2[4]; const u32x4 z4 = {0u, 0u, 0u, 0u};
#pragma unroll
    for (int it = 0; it < 4; ++it) { const int row = 32 * it + 4 * wave + (lane >> 4);
        r0[it] = (row > 0 || has_prev) ? *(const u32x4*)(src + ((ptrdiff_t)row - 1) * 512 + 8 * ch) : z4;
        r1[it] = *(const u32x4*)(src + (size_t)row * 512 + 8 * ch);
        r2[it] = (row < 127 || has_next) ? *(const u32x4*)(src + (size_t)(row + 1) * 512 + 8 * ch) : z4; }
#pragma unroll
    for (int it = 0; it < 4; ++it) { float a0[8], a1[8], a2[8], y[8]; unpack8(r0[it], a0); unpack8(r1[it], a1); unpack8(r2[it], a2);
#pragma unroll
        for (int i = 0; i < 8; ++i) y[i] = siluf_(w0[i] * a0[i] + w1[i] * a1[i] + w2[i] * a2[i]);
        keep[it] = pack8(y); }
}
__device__ __forceinline__ void load_conv_img2(LAS unsigned char* imgA, const bf16* srcA, const float* cwA, int ma, LAS unsigned char* imgB, const bf16* srcB, const float* cwB, int mb, bool has_prev, bool has_next, int wave, int lane) {
    asm volatile("" ::: "memory");
    const int ch = lane & 15; float wa0[8], wa1[8], wa2[8], wb0[8], wb1[8], wb2[8];
#pragma unroll
    for (int i = 0; i < 8; ++i) { wa0[i] = cwA[8 * ch + i]; wa1[i] = cwA[1536 + 8 * ch + i]; wa2[i] = cwA[3072 + 8 * ch + i]; wb0[i] = cwB[8 * ch + i]; wb1[i] = cwB[1536 + 8 * ch + i]; wb2[i] = cwB[3072 + 8 * ch + i]; }
#pragma unroll
    for (int it = 0; it < 4; ++it) {
        const int row = 32 * it + 4 * wave + (lane >> 4); const u32x4 z4 = {0u, 0u, 0u, 0u}; const bool hp = (row > 0 || has_prev), hn = (row < 127 || has_next);
        const u32x4 a0 = hp ? *(const u32x4*)(srcA + ((ptrdiff_t)row - 1) * 512 + 8 * ch) : z4, a1 = *(const u32x4*)(srcA + (size_t)row * 512 + 8 * ch), a2 = hn ? *(const u32x4*)(srcA + (size_t)(row + 1) * 512 + 8 * ch) : z4;
        const u32x4 b0 = hp ? *(const u32x4*)(srcB + ((ptrdiff_t)row - 1) * 512 + 8 * ch) : z4, b1 = *(const u32x4*)(srcB + (size_t)row * 512 + 8 * ch), b2 = hn ? *(const u32x4*)(srcB + (size_t)(row + 1) * 512 + 8 * ch) : z4;
        { float x0[8], x1[8], x2[8], y[8]; unpack8(a0, x0); unpack8(a1, x1); unpack8(a2, x2); float ss = 0.f;
#pragma unroll
          for (int i = 0; i < 8; ++i) { y[i] = siluf_(wa0[i] * x0[i] + wa1[i] * x1[i] + wa2[i] * x2[i]); ss += y[i] * y[i]; }
          if (ma != 1) { const float sc = (1.0f / sqrtf(sum16(ss) + EPS)) * (ma == 2 ? 0.08838834764831845f : 1.0f);
#pragma unroll
              for (int i = 0; i < 8; ++i) y[i] *= sc; }
          *(LAS u32x4*)(imgA + offb(row, ch)) = pack8(y); }
        { float x0[8], x1[8], x2[8], y[8]; unpack8(b0, x0); unpack8(b1, x1); unpack8(b2, x2); float ss = 0.f;
#pragma unroll
          for (int i = 0; i < 8; ++i) { y[i] = siluf_(wb0[i] * x0[i] + wb1[i] * x1[i] + wb2[i] * x2[i]); ss += y[i] * y[i]; }
          if (mb != 1) { const float sc = (1.0f / sqrtf(sum16(ss) + EPS)) * (mb == 2 ? 0.08838834764831845f : 1.0f);
#pragma unroll
              for (int i = 0; i < 8; ++i) y[i] *= sc; }
          *(LAS u32x4*)(imgB + offb(row, ch)) = pack8(y); }
    }
}
__device__ __forceinline__ void scale_rows_img(LAS unsigned char* dst, LAS unsigned char* src, const LAS float* rs, int tid) {
#pragma unroll
    for (int i = 0; i < 4; ++i) { const int cidx = tid + 512 * i, row = cidx >> 4, ch = cidx & 15; float v[8]; unpack8(*(const LAS u32x4*)(src + offb(row, ch)), v); const float sc = rs[row];
#pragma unroll
        for (int e = 0; e < 8; ++e) v[e] *= sc;
        *(LAS u32x4*)(dst + offb(row, ch)) = pack8(v); }
}
__device__ __forceinline__ void tri_inverse(LAS unsigned char* img, int w, int lane) {
    const int r = lane & 15, q = lane >> 4;
    {
        const int b0 = 16 * w; float x[16];
#pragma unroll
        for (int i = 0; i < 16; ++i) { float v = (i == r) ? 1.f : 0.f;
#pragma unroll
            for (int j = 0; j < i; ++j) v -= bf2f(*(const LAS unsigned short*)(img + offe(b0 + i, b0 + j))) * x[j];
            x[i] = v; }
        if (q == 0) {
#pragma unroll
            for (int i = 0; i < 16; ++i) *(LAS unsigned short*)(img + offe(b0 + i, b0 + r)) = (unsigned short)f2bf(x[i]); }
    }
    LBAR();
    if (w < 4) {
        const int c0 = 32 * w, r1 = c0 + 16;
        const u32x2 av = *(const LAS u32x2*)(img + offe(r1 + r, c0 + 4 * q));
        const bf16x8 fa = __builtin_bit_cast(bf16x8, (u32x4){av.x, av.y, 0u, 0u});
        const s16x4 tb = __builtin_amdgcn_ds_read_tr16_b64_v4i16((LAS s16x4*)(img + offe(c0 + 4 * q + (r >> 2), c0 + 4 * (r & 3))));
        const bf16x8 fb = (bf16x8){tb[0], tb[1], tb[2], tb[3], 0, 0, 0, 0};
        const f32x4 y = MFMA16(fa, fb, ((f32x4){0.f, 0.f, 0.f, 0.f}));
        const bf16x8 fy = __builtin_bit_cast(bf16x8, (u32x4){pk2(y[0], y[1]), pk2(y[2], y[3]), 0u, 0u});
        const u32x2 tv = *(const LAS u32x2*)(img + offe(r1 + r, r1 + 4 * q));
        const bf16x8 ft = __builtin_bit_cast(bf16x8, (u32x4){tv.x, tv.y, 0u, 0u});
        const f32x4 d = MFMA16(fy, ft, ((f32x4){0.f, 0.f, 0.f, 0.f}));
        u32x2 o; o.x = pk2(-d[0], -d[1]); o.y = pk2(-d[2], -d[3]);
        *(LAS u32x2*)(img + offe(r1 + r, c0 + 4 * q)) = o;
    }
    LBAR();
    {
        const int p = w >> 2, ti = (w >> 1) & 1, tj = w & 1, base = 64 * p, rb = base + 32;
        f32x4 y[2];
        const unsigned g = lane >> 4, qq = (lane & 15) >> 2, pp = lane & 3;
        const s16x4 lo = __builtin_amdgcn_ds_read_tr16_b64_v4i16((LAS s16x4*)(img + offe(base + 8 * g + qq, base + 16 * tj + 4 * pp)));
        const s16x4 hi = __builtin_amdgcn_ds_read_tr16_b64_v4i16((LAS s16x4*)(img + offe(base + 8 * g + 4 + qq, base + 16 * tj + 4 * pp)));
        const bf16x8 fb = (bf16x8){lo[0], lo[1], lo[2], lo[3], hi[0], hi[1], hi[2], hi[3]};
#pragma unroll
        for (int kt = 0; kt < 2; ++kt) { const bf16x8 fa = *(const LAS bf16x8*)(img + offb(rb + 16 * kt + r, (base >> 3) + q)); y[kt] = MFMA16(fa, fb, ((f32x4){0.f, 0.f, 0.f, 0.f})); }
        const bf16x8 fy = __builtin_bit_cast(bf16x8, (u32x4){pk2(y[0][0], y[0][1]), pk2(y[0][2], y[0][3]), pk2(y[1][0], y[1][1]), pk2(y[1][2], y[1][3])});
        const u32x2 t0 = *(const LAS u32x2*)(img + offe(rb + 16 * ti + r, rb + 4 * q)), t1 = *(const LAS u32x2*)(img + offe(rb + 16 * ti + r, rb + 16 + 4 * q));
        const bf16x8 ft = __builtin_bit_cast(bf16x8, (u32x4){t0.x, t0.y, t1.x, t1.y});
        const f32x4 d = MFMA16(fy, ft, ((f32x4){0.f, 0.f, 0.f, 0.f}));
        LBAR();
        u32x2 o; o.x = pk2(-d[0], -d[1]); o.y = pk2(-d[2], -d[3]);
        *(LAS u32x2*)(img + offe(rb + 16 * ti + r, base + 16 * tj + 4 * q)) = o;
    }
    LBAR();
    {
        const int tj = w >> 1, ti0 = 2 * (w & 1);
        f32x4 y[4];
#pragma unroll
        for (int kt = 0; kt < 4; ++kt) y[kt] = (f32x4){0.f, 0.f, 0.f, 0.f};
#pragma unroll
        for (int s = 0; s < 2; ++s) { const bf16x8 fb = frag_tr(img, tj, s, lane);
#pragma unroll
            for (int kt = 0; kt < 4; ++kt) y[kt] = MFMA16(frag_row(img, 4 + kt, s, lane), fb, y[kt]); }
        f32x4 d[2];
#pragma unroll
        for (int i = 0; i < 2; ++i) { d[i] = (f32x4){0.f, 0.f, 0.f, 0.f};
#pragma unroll
            for (int ks = 0; ks < 2; ++ks) {
                const bf16x8 fy = __builtin_bit_cast(bf16x8, (u32x4){pk2(y[2 * ks][0], y[2 * ks][1]), pk2(y[2 * ks][2], y[2 * ks][3]), pk2(y[2 * ks + 1][0], y[2 * ks + 1][1]), pk2(y[2 * ks + 1][2], y[2 * ks + 1][3])});
                const int row = 64 + 16 * (ti0 + i) + r;
                const u32x2 t0 = *(const LAS u32x2*)(img + offe(row, 64 + 32 * ks + 4 * q)), t1 = *(const LAS u32x2*)(img + offe(row, 64 + 32 * ks + 16 + 4 * q));
                d[i] = MFMA16(fy, __builtin_bit_cast(bf16x8, (u32x4){t0.x, t0.y, t1.x, t1.y}), d[i]); } }
        LBAR();
#pragma unroll
        for (int i = 0; i < 2; ++i) { u32x2 o; o.x = pk2(-d[i][0], -d[i][1]); o.y = pk2(-d[i][2], -d[i][3]);
            *(LAS u32x2*)(img + offe(64 + 16 * (ti0 + i) + r, 16 * tj + 4 * q)) = o; }
    }
    LBAR();
}

__device__ __forceinline__ void phase_prep(Frame& F) {
    LAS unsigned char* I0 = F.lds; LAS unsigned char* I1 = F.lds + IMGB; LAS unsigned char* I2 = F.lds + 2 * IMGB; LAS unsigned char* I3 = F.lds + 3 * IMGB;
    LAS float* sm = (LAS float*)(F.lds + MISC_OFF + 1024);
    LAS float* s_t1 = sm; LAS float* s_t2 = sm + 128; LAS float* sdir = sm + 256;
#define LAUNDER() int tz_ = threadIdx.x; asm volatile("" : "+v"(tz_)); const int tid = tz_, lane = tz_ & 63, w = __builtin_amdgcn_readfirstlane(tz_ >> 6), wr = w >> 1, wc = w & 1, r = lane & 15, q = lane >> 4; (void)tid; (void)lane; (void)w; (void)wr; (void)wc; (void)r; (void)q
    const bf16* P = WSP(bf16, WS_P);
    const bool rebal = F.G == 256;
    for (int it = F.bid; it < (rebal ? 512 + 96 + 128 : 512 + 96); it += F.G) {
        int b, h, m, part = 3;
        if (it < 512) { b = it >> 7; h = (it >> 5) & 3; m = 2 + (it & 31);
            if (rebal) { const int bb = it & 255; if (bb < 96 && (bb % 3) != 0) part = 4; } }
        else if (it < 608) { const int c3 = it - 512; const int c = c3 / 3; part = c3 - 3 * c; b = c >> 3; h = (c >> 1) & 3; m = c & 1; }
        else { const int j = it - 608, e = j >> 1, bb = 3 * (e >> 1) + 1 + (e & 1), L = bb + 256 * (j & 1); b = L >> 7; h = (L >> 5) & 3; m = 2 + (L & 31); part = 0; }
        const bool isctx = m < 2; const int pos0 = 128 * m; const size_t row0 = (size_t)b * RPB + pos0; const size_t trow0 = (size_t)b * SEQ + (pos0 - CTXL);
        const bool hprev = isctx ? (m > 0) : (m > 2), hnext = isctx ? (m < 1) : (m < NCHUNK - 1);
        const size_t hoff = row0 * 512 + h * 128;
        f32x4 acc[2][4];
        if (part == 3 || part == 0) {
        const float lgf = F.ret_log_decay[h] * 1.4426950408889634f, lgb = F.ret_log_decay[4 + h] * 1.4426950408889634f;
        { LAUNDER();
        load_plain_img(I0, P + 0 * PGRP + hoff, 512, tid); load_plain_img(I1, P + 1 * PGRP + hoff, 512, tid);
        if (!isctx) load_plain_img(I2, P + 4 * PGRP + hoff, 512, tid);
        if (tid < 128) { s_t1[tid] = exp2f(lgf * (float)(127 - tid)); s_t2[tid] = exp2f(lgb * (float)tid); } }
        LBAR();
        if (!isctx) {
            { LAUNDER();
            zero_acc(acc); mm128<true>(I2, false, I0, false, wr, wc, lane, acc);
#pragma unroll
            for (int i = 0; i < 2; ++i)
#pragma unroll
                for (int j = 0; j < 4; ++j)
#pragma unroll
                    for (int e = 0; e < 4; ++e) { const int ii = 32 * wr + 16 * i + r, jj = 64 * wc + 16 * j + 4 * q + e; const int d = ii - jj;
                        const float wg = (d >= 0 ? exp2f(lgf * (float)d) : 0.f) + (d <= 0 ? exp2f(lgb * (float)(-d)) : 0.f); acc[i][j][e] *= wg; }
            st_img(I3, acc, wr, wc, lane); }
            LBAR();
            { LAUNDER();
            zero_acc(acc); mm128<true>(I3, false, I1, true, wr, wc, lane, acc);
            bf16* og = WSP(bf16, WS_ORET) + (trow0 + 32 * wr + r) * 512 + h * 128 + 64 * wc + 4 * q;
#pragma unroll
            for (int i = 0; i < 2; ++i)
#pragma unroll
                for (int jp = 0; jp < 2; ++jp) { u32x2 oa, ob; oa.x = pk2(acc[i][2 * jp][0], acc[i][2 * jp][1]); oa.y = pk2(acc[i][2 * jp][2], acc[i][2 * jp][3]); ob.x = pk2(acc[i][2 * jp + 1][0], acc[i][2 * jp + 1][1]); ob.y = pk2(acc[i][2 * jp + 1][2], acc[i][2 * jp + 1][3]);
                    *(u32x4*)(og + (size_t)(16 * i) * 512 + 16 * (2 * jp + (q & 1)) - 4 * (q & 1)) = widen16(oa, ob); } }
        }
#pragma unroll 1
        for (int dir = 0; dir < 2; ++dir) {
            LAS unsigned char* kw = dir ? I3 : I2;
            { LAUNDER(); scale_rows_img(kw, I0, dir ? s_t2 : s_t1, tid); }
            LBAR();
            LAUNDER();
            zero_acc(acc); mm128<false>(kw, true, I1, true, wr, wc, lane, acc);
            const int chain = (b * NH + h) * 2 + dir, n = dir ? (isctx ? 1 - m : 35 - m) : m;
            unsigned char* kv = F.ws + WS_GKV + ((size_t)chain * NCHUNK + n) * 32768;
#pragma unroll
            for (int i = 0; i < 2; ++i)
#pragma unroll
                for (int jp = 0; jp < 2; ++jp) { const int mt = 2 * wr + i, nts = 4 * wc + 2 * jp + (q & 1); u32x2 oa, ob;
                    oa.x = pk2(acc[i][2 * jp][0], acc[i][2 * jp][1]); oa.y = pk2(acc[i][2 * jp][2], acc[i][2 * jp][3]); ob.x = pk2(acc[i][2 * jp + 1][0], acc[i][2 * jp + 1][1]); ob.y = pk2(acc[i][2 * jp + 1][2], acc[i][2 * jp + 1][3]);
                    *(u32x4*)(kv + ((size_t)((nts * 4 + (mt >> 1)) * 64 + (2 * (mt & 1) + (q >> 1)) * 16 + r)) * 16) = widen16(oa, ob); }
        }
        LBAR();
        }
        if (part != 0) {
        const bool hasq = !isctx;
        f32x4 gacc[2][4], qk[2][4]; u32x2 qv[2][4];
        u32x4 vkeep[4];
        { LAUNDER(); conv_v_keep(vkeep, P + 3 * PGRP + hoff, F.gdn_conv + 1024 + h * 128, hprev, hnext, w, lane); }
        float la_ = 0.f, be_ = 0.f;
        { LAUNDER(); if (tid < 256) { const int d2 = tid >> 7, i2 = tid & 127; const size_t o = ((size_t)(d2 * NB + b) * NH + h) * RPB + pos0 + i2; la_ = WSP(float, WS_LOGA)[o]; be_ = WSP(float, WS_BETA)[o]; } }
        if (hasq) { LAUNDER(); load_conv_img2(I0, P + 2 * PGRP + hoff, F.gdn_conv + 512 + h * 128, 0, I1, P + 6 * PGRP + hoff, F.gdn_conv + h * 128, 2, hprev, hnext, w, lane); }
        else { LAUNDER(); load_conv_img(I0, P + 2 * PGRP + hoff, F.gdn_conv + 512 + h * 128, hprev, hnext, 0, w, lane); }
        { LAUNDER(); if (tid < 256) { const int d2 = tid >> 7, i2 = tid & 127; sdir[d2 * 640 + i2] = la_; sdir[d2 * 640 + 128 + i2] = be_; } }
        LBAR();
        { LAUNDER();
          if (w < 2) {
              LAS float* sd = sdir + w * 640;
              const float a = sd[2 * lane], c = sd[2 * lane + 1]; const float pr = a + c; float inc = pr;
#pragma unroll
              for (int o = 1; o < 64; o <<= 1) { const float t = __shfl_up(inc, o); if (lane >= o) inc += t; }
              const float tot = __shfl(inc, 63); const float ex = inc - pr;
              float g0 = ex + a, g1 = ex + pr;
              if (w) { g0 = tot - ex; g1 = tot - (ex + a); }
              sd[256 + 2 * lane] = g0; sd[256 + 2 * lane + 1] = g1; sd[384 + 2 * lane] = __expf(g0); sd[384 + 2 * lane + 1] = __expf(g1);
              sd[512 + 2 * lane] = __expf(tot - g0); sd[512 + 2 * lane + 1] = __expf(tot - g1);
              asm volatile("s_waitcnt lgkmcnt(0)" ::: "memory");
              if (lane == 0) sd[0] = __expf(tot);
          }
          zero_acc(gacc); mm128<true>(I0, false, I0, false, wr, wc, lane, gacc);
          if (hasq) { zero_acc(qk); mm128<true>(I1, false, I0, false, wr, wc, lane, qk);
#pragma unroll
              for (int i = 0; i < 2; ++i)
#pragma unroll
                  for (int j = 0; j < 4; ++j) qv[i][j] = *(const LAS u32x2*)(I1 + offe(32 * wr + 16 * i + r, 64 * wc + 16 * j + 4 * q)); } }
        LBAR();
        u32x2 okeep[2][4] = {{{0u, 0u}, {0u, 0u}, {0u, 0u}, {0u, 0u}}, {{0u, 0u}, {0u, 0u}, {0u, 0u}, {0u, 0u}}};
#pragma unroll 1
        for (int dir = (part == 2 ? 1 : 0); dir < (part >= 3 ? 2 : part); ++dir) {
            const int chain = (b * NH + h) * 2 + dir, n = dir ? (isctx ? 1 - m : 35 - m) : m;
            { LAUNDER();
#pragma unroll
              for (int it4 = 0; it4 < 4; ++it4) *(LAS u32x4*)(I1 + offb(32 * it4 + 4 * w + (lane >> 4), lane & 15)) = vkeep[it4]; }
            LAS float* s_bet = sdir + dir * 640 + 128; LAS float* s_gc = sdir + dir * 640 + 256; LAS float* s_eg = sdir + dir * 640 + 384; LAS float* s_s2 = sdir + dir * 640 + 512;
            LBAR();
            { LAUNDER();
#pragma unroll
            for (int i = 0; i < 2; ++i)
#pragma unroll
                for (int j = 0; j < 4; ++j) { const int ii = 32 * wr + 16 * i + r; const float gi = s_gc[ii], bi = s_bet[ii];
#pragma unroll
                    for (int e = 0; e < 4; ++e) { const int jj = 64 * wc + 16 * j + 4 * q + e;
                        const float f = dir ? s_bet[jj] * __expf(s_gc[jj] - gi) : bi * __expf(gi - s_gc[jj]); acc[i][j][e] = (ii > jj) ? gacc[i][j][e] * f : 0.f; } }
            st_img(I2, acc, wr, wc, lane); }
            LBAR();
            { LAUNDER(); tri_inverse(I2, w, lane); }
            { LAUNDER();
#pragma unroll
            for (int i = 0; i < 4; ++i) { const int cidx = tid + 512 * i, row = cidx >> 4, ch = cidx & 15; float v[8], v2[8]; unpack8(*(const LAS u32x4*)(I2 + offb(row, ch)), v);
#pragma unroll
                for (int e = 0; e < 8; ++e) { const int k = dir ? row : 8 * ch + e; const float bb = s_bet[k]; v[e] *= bb; v2[e] = v[e] * s_eg[k]; }
                *(LAS u32x4*)(I2 + offb(row, ch)) = pack8(v); *(LAS u32x4*)(I3 + offb(row, ch)) = pack8(v2); } }
            LBAR();
            { LAUNDER();
            zero_acc(acc); mm128<true>(I3, dir != 0, I0, true, wr, wc, lane, acc);
            LBAR();
            st_img(I3, acc, wr, wc, lane); }
            { LAUNDER();
            zero_acc(acc); mm128<true>(I2, dir != 0, I1, true, wr, wc, lane, acc);
            LBAR();
            st_img(I2, acc, wr, wc, lane);
            scale_rows_img(I1, I0, s_s2, tid); }
            LBAR();
            {
                LAUNDER();
                zero_acc(acc); mm128<false>(I1, true, I2, true, wr, wc, lane, acc);
                unsigned char* gc = F.ws + WS_GC + ((size_t)chain * NCHUNK + n) * 32768;
#pragma unroll
                for (int i = 0; i < 2; ++i)
#pragma unroll
                    for (int j = 0; j < 4; ++j) { const int mt = 2 * wr + i, nt = 4 * wc + j; u32x2 o; o.x = pk2(acc[i][j][0], acc[i][j][1]); o.y = pk2(acc[i][j][2], acc[i][j][3]);
                        *(u32x2*)(gc + ((size_t)((nt * 8 + mt) * 64 + lane)) * 8) = o; }
                }
                { LAUNDER(); const float dtot = sdir[dir * 640];
                zero_acc(acc); mm128<true>(I1, true, I3, true, wr, wc, lane, acc);
                unsigned char* gm = F.ws + WS_GM + ((size_t)chain * NCHUNK + n) * 32768;
#pragma unroll
                for (int i = 0; i < 2; ++i)
#pragma unroll
                    for (int jp = 0; jp < 2; ++jp) { const int mt = 2 * wr + i; const int rowi = 16 * mt + r; u32x2 o[2];
#pragma unroll
                        for (int hh = 0; hh < 2; ++hh) { const int ct = 4 * wc + 2 * jp + hh; float v[4];
#pragma unroll
                            for (int e = 0; e < 4; ++e) v[e] = ((rowi == 16 * ct + 4 * q + e) ? dtot : 0.f) - acc[i][2 * jp + hh][e];
                            o[hh].x = pk2(v[0], v[1]); o[hh].y = pk2(v[2], v[3]); }
                        *(u32x4*)(gm + ((size_t)((mt * 4 + 2 * wc + jp) * 64 + q * 16 + r)) * 16) = (u32x4){o[0].x, o[0].y, o[1].x, o[1].y}; }
            }
            LBAR();
            if (hasq) {
                { LAUNDER();
#pragma unroll
                for (int i = 0; i < 2; ++i) { const int ii = 32 * wr + 16 * i + r; const float gi = s_gc[ii];
#pragma unroll
                    for (int j = 0; j < 4; ++j)
#pragma unroll
                        for (int e = 0; e < 4; ++e) { const int jj = 64 * wc + 16 * j + 4 * q + e; const bool on = dir ? (jj >= ii) : (jj <= ii);
                            acc[i][j][e] = on ? qk[i][j][e] * __expf(gi - s_gc[jj]) : 0.f; } }
                st_img(I1, acc, wr, wc, lane); }
                LBAR();
                { LAUNDER();
                zero_acc(acc); mm128<true>(I1, false, I2, true, wr, wc, lane, acc);
                { bf16* ogp = WSP(bf16, WS_OGDN) + (trow0 + 32 * wr + r) * 512 + h * 128 + 64 * wc + 4 * q;
#pragma unroll
                  for (int i = 0; i < 2; ++i)
#pragma unroll
                    for (int jp = 0; jp < 2; ++jp) { u32x2 o[2];
#pragma unroll
                        for (int hh = 0; hh < 2; ++hh) { f32x4 v = acc[i][2 * jp + hh];
                            if (dir) { const u32x2 pv = okeep[i][2 * jp + hh]; v[0] += bflo(pv.x); v[1] += bfhi(pv.x); v[2] += bflo(pv.y); v[3] += bfhi(pv.y); }
                            o[hh].x = pk2(v[0], v[1]); o[hh].y = pk2(v[2], v[3]); if (!dir) okeep[i][2 * jp + hh] = o[hh]; }
                        if (dir) *(u32x4*)(ogp + (size_t)(16 * i) * 512 + 16 * (2 * jp + (q & 1)) - 4 * (q & 1)) = widen16(o[0], o[1]); } } }
                { LAUNDER();
                zero_acc(acc); mm128<true>(I1, false, I3, true, wr, wc, lane, acc);
                unsigned char* qt = F.ws + WS_GQT + ((size_t)chain * 32 + (n - 2)) * 32768;
#pragma unroll
                for (int i = 0; i < 2; ++i) { const int ii = 32 * wr + 16 * i + r; const float egi = s_eg[ii];
#pragma unroll
                    for (int jp = 0; jp < 2; ++jp) { const int mt = 2 * wr + i; u32x2 o[2];
#pragma unroll
                        for (int hh = 0; hh < 2; ++hh) { const int j = 2 * jp + hh; const u32x2 qq2 = qv[i][j];
                            o[hh].x = pk2(egi * bflo(qq2.x) - acc[i][j][0], egi * bfhi(qq2.x) - acc[i][j][1]); o[hh].y = pk2(egi * bflo(qq2.y) - acc[i][j][2], egi * bfhi(qq2.y) - acc[i][j][3]); }
                        *(u32x4*)(qt + ((size_t)((mt * 4 + 2 * wc + jp) * 64 + q * 16 + r)) * 16) = (u32x4){o[0].x, o[0].y, o[1].x, o[1].y}; } } }
                LBAR();
            }
        }
        }
    }
#undef LAUNDER
}

__device__ __forceinline__ void phase_scan(Frame& F) {
    const int lane = F.lane, w = F.wave, tid = F.tid;
    for (int it = F.bid; it < 256; it += F.G) {
        if (it < 128) {
            const int chain = (it & 7) * 4 + (it >> 5), dq = (it >> 3) & 3;
            const unsigned char* gm = F.ws + WS_GM + (size_t)chain * NCHUNK * 32768; unsigned char* gc = F.ws + WS_GC + (size_t)chain * NCHUNK * 32768;
            const unsigned char* gcs = gc + (size_t)(2 * dq) * 4096;
            if (w >= 4) {
                const int j = tid - 256; u32x4 sA[10], sB[10], sC[10], sD[10], sE[10];
#define SCAN_LD(dst, n_) do { _Pragma("unroll") for (int i_ = 0; i_ < 8; ++i_) dst[i_] = *(const u32x4*)(gm + (size_t)(n_) * 32768 + (size_t)(j + 256 * i_) * 16); \
                              _Pragma("unroll") for (int i_ = 0; i_ < 2; ++i_) dst[8 + i_] = *(const u32x4*)(gcs + (size_t)(n_) * 32768 + (size_t)(j + 256 * i_) * 16); } while (0)
#define SCAN_ST(n_, src) do { LAS unsigned char* buf_ = F.lds + ((n_) % 3) * 40960; \
                              _Pragma("unroll") for (int i_ = 0; i_ < 8; ++i_) *(LAS u32x4*)(buf_ + (size_t)(j + 256 * i_) * 16) = src[i_]; \
                              _Pragma("unroll") for (int i_ = 0; i_ < 2; ++i_) *(LAS u32x4*)(buf_ + 32768 + (size_t)(j + 256 * i_) * 16) = src[8 + i_]; \
                              if ((n_) + 5 < NCHUNK) SCAN_LD(src, (n_) + 5); LBAR(); } while (0)
                SCAN_LD(sA, 0); SCAN_LD(sB, 1); SCAN_LD(sC, 2); SCAN_LD(sD, 3); SCAN_LD(sE, 4);
#pragma unroll 1
                for (int n = 0; n < 30; n += 5) { SCAN_ST(n, sA); SCAN_ST(n + 1, sB); SCAN_ST(n + 2, sC); SCAN_ST(n + 3, sD); SCAN_ST(n + 4, sE); }
                SCAN_ST(30, sA); SCAN_ST(31, sB); SCAN_ST(32, sC); SCAN_ST(33, sD);
#undef SCAN_LD
#undef SCAN_ST
            } else if (w < 2) {
                const int nt = 2 * dq + w;
                bf16x8 sf[4];
#pragma unroll
                for (int s = 0; s < 4; ++s) sf[s] = (bf16x8){0, 0, 0, 0, 0, 0, 0, 0};
#pragma unroll 1
                for (int n = 0; n < NCHUNK; ++n) {
                    LBAR();
                    const LAS unsigned char* buf = F.lds + (n % 3) * 40960; const LAS unsigned char* cb = buf + 32768 + w * 4096;
                    unsigned char* slot = gc + (size_t)n * 32768 + (size_t)nt * 4096; f32x4 acc[8];
#pragma unroll
                    for (int mt = 0; mt < 8; ++mt) { const u32x2 cv = *(const LAS u32x2*)(cb + (mt * 64 + lane) * 8); acc[mt] = (f32x4){bflo(cv.x), bfhi(cv.x), bflo(cv.y), bfhi(cv.y)}; }
#pragma unroll
                    for (int s = 0; s < 4; ++s)
#pragma unroll
                        for (int mt = 0; mt < 8; ++mt) acc[mt] = MFMA16(*(const LAS bf16x8*)(buf + ((mt * 4 + s) * 64 + lane) * 16), sf[s], acc[mt]);
#pragma unroll
                    for (int s = 0; s < 4; ++s) { const u32x4 pk = {pk2(acc[2 * s][0], acc[2 * s][1]), pk2(acc[2 * s][2], acc[2 * s][3]), pk2(acc[2 * s + 1][0], acc[2 * s + 1][1]), pk2(acc[2 * s + 1][2], acc[2 * s + 1][3])};
                        sf[s] = __builtin_bit_cast(bf16x8, pk); *(u32x4*)(slot + (size_t)(s * 64 + lane) * 16) = pk; }
                }
            } else {
#pragma unroll 1
                for (int n = 0; n < NCHUNK; ++n) LBAR();
            }
            LBAR();
#if defined(PROBE_PH) && PROBE_PH == 204
            if (F.bid == 0 && tid == 0) ((volatile LAS unsigned long long*)(F.lds + MISC_OFF + 896))[5] = __builtin_amdgcn_s_memrealtime();
#endif
        } else {
            const int gidx = (it - 128) * NTHR + tid; const int chain = gidx >> 11, piece = gidx & 2047; const int h = (chain >> 1) & 3, dir = chain & 1;
            const float dec = expf(F.ret_log_decay[dir * 4 + h] * 128.f);
            unsigned char* kv = F.ws + WS_GKV + (size_t)chain * NCHUNK * 32768 + (size_t)piece * 16;
            float st[8];
#pragma unroll
            for (int e = 0; e < 8; ++e) st[e] = 0.f;
#pragma unroll 1
            for (int n0 = 0; n0 < NCHUNK; n0 += 17) { u32x4 v8[17];
#pragma unroll
                for (int j = 0; j < 17; ++j) v8[j] = *(const u32x4*)(kv + (size_t)(n0 + j) * 32768);
#pragma unroll
                for (int j = 0; j < 17; ++j) { float v[8]; unpack8(v8[j], v);
#pragma unroll
                    for (int e = 0; e < 8; ++e) st[e] = dec * st[e] + v[e];
                    *(u32x4*)(kv + (size_t)(n0 + j) * 32768) = pack8(st); } }
        }
    }
}

__device__ __forceinline__ void phase_out(Frame& F) {
    const bf16* P = WSP(bf16, WS_P);
    for (int it = F.bid; it < 512; it += F.G) {
        int tz_ = threadIdx.x; asm volatile("" : "+v"(tz_)); const int tid = tz_, lane = tz_ & 63, w = __builtin_amdgcn_readfirstlane(tz_ >> 6), r = lane & 15, q = lane >> 4;
        const int b = it >> 7, h = (it >> 5) & 3, m = 2 + (it & 31);
        const size_t prow = (size_t)b * RPB + 128 * m + 16 * w + r; const size_t trow = (size_t)b * SEQ + 128 * (m - 2) + 16 * w + r;
        const int il = 16 * w + r;
        bf16x8 fqg[2][4], fqr[4];
#pragma unroll
        for (int dir = 0; dir < 2; ++dir) { const int chain = (b * NH + h) * 2 + dir, n = dir ? 35 - m : m; const unsigned char* qt = F.ws + WS_GQT + ((size_t)chain * 32 + (n - 2)) * 32768;
#pragma unroll
            for (int s = 0; s < 4; ++s) fqg[dir][s] = *(const bf16x8*)(qt + (size_t)((w * 4 + s) * 64 + lane) * 16); }
        { const bf16* qp = P + 4 * PGRP + prow * 512 + h * 128;
#pragma unroll
          for (int s = 0; s < 4; ++s) fqr[s] = *(const bf16x8*)(qp + 32 * s + 8 * q); }
        u32x2 rog[8], ror[8];
        { const bf16* a = WSP(bf16, WS_OGDN) + trow * 512 + h * 128 + 4 * q; const bf16* c = WSP(bf16, WS_ORET) + trow * 512 + h * 128 + 4 * q;
#pragma unroll
          for (int nt = 0; nt < 8; ++nt) { rog[nt] = *(const u32x2*)(a + 16 * nt); ror[nt] = *(const u32x2*)(c + 16 * nt); } }
        {
            u32x4 v[4][4];
#pragma unroll
            for (int k = 0; k < 4; ++k) { const int dir = k & 1; const int chain = (b * NH + h) * 2 + dir, n = dir ? 35 - m : m;
                const unsigned char* sp = F.ws + (k < 2 ? WS_GC : WS_GKV) + ((size_t)chain * NCHUNK + (n - 1)) * 32768;
#pragma unroll
                for (int i = 0; i < 4; ++i) v[k][i] = *(const u32x4*)(sp + (size_t)(tid + 512 * i) * 16); }
#pragma unroll
            for (int k = 0; k < 4; ++k)
#pragma unroll
                for (int i = 0; i < 4; ++i) *(LAS u32x4*)(F.lds + k * 32768 + (tid + 512 * i) * 16) = v[k][i];
        }
        f32x4 og[8], orr[8];
#pragma unroll
        for (int nt = 0; nt < 8; ++nt) { og[nt] = (f32x4){bflo(rog[nt].x), bfhi(rog[nt].x), bflo(rog[nt].y), bfhi(rog[nt].y)}; orr[nt] = (f32x4){bflo(ror[nt].x), bfhi(ror[nt].x), bflo(ror[nt].y), bfhi(ror[nt].y)}; }
        LBAR();
#pragma unroll
        for (int dir = 0; dir < 2; ++dir) {
            {
                const LAS unsigned char* sp = F.lds + dir * 32768;
#pragma unroll
                for (int s = 0; s < 4; ++s)
#pragma unroll
                    for (int nt = 0; nt < 8; ++nt) og[nt] = MFMA16(*(const LAS bf16x8*)(sp + ((nt * 4 + s) * 64 + lane) * 16), fqg[dir][s], og[nt]);
            }
            {
                const LAS unsigned char* sp = F.lds + (2 + dir) * 32768;
                f32x4 t[8];
#pragma unroll
                for (int nt = 0; nt < 8; ++nt) t[nt] = (f32x4){0.f, 0.f, 0.f, 0.f};
#pragma unroll
                for (int s = 0; s < 4; ++s)
#pragma unroll
                    for (int nt = 0; nt < 8; ++nt) t[nt] = MFMA16(*(const LAS bf16x8*)(sp + ((nt * 4 + s) * 64 + lane) * 16), fqr[s], t[nt]);
                const float lg = F.ret_log_decay[dir * 4 + h]; const float dcy = expf(lg * (float)(dir ? 128 - il : il + 1));
#pragma unroll
                for (int nt = 0; nt < 8; ++nt) orr[nt] = orr[nt] + t[nt] * dcy;
            }
        }
        {
            float s1 = 0.f;
#pragma unroll
            for (int nt = 0; nt < 8; ++nt) s1 += (orr[nt][0] + orr[nt][1]) + (orr[nt][2] + orr[nt][3]);
            s1 += __shfl_xor(s1, 16); s1 += __shfl_xor(s1, 32); const float mean = s1 * (1.f / 128.f);
            float s2 = 0.f, s3 = 0.f;
#pragma unroll
            for (int nt = 0; nt < 8; ++nt)
#pragma unroll
                for (int e = 0; e < 4; ++e) { const float d = orr[nt][e] - mean; s2 += d * d; s3 += og[nt][e] * og[nt][e]; }
            s2 += __shfl_xor(s2, 16); s2 += __shfl_xor(s2, 32); s3 += __shfl_xor(s3, 16); s3 += __shfl_xor(s3, 32);
            const float rs_r = 1.0f / sqrtf(s2 * (1.f / 128.f) + EPS), rs_g = 1.0f / sqrtf(s3 * (1.f / 128.f) + EPS);
            const bf16* rg = P + 5 * PGRP + prow * 512 + h * 128 + 4 * q; const bf16* gz = P + 7 * PGRP + prow * 512 + h * 128 + 4 * q;
            bf16* ry = WSP(bf16, WS_RETY) + trow * 512 + h * 128 + 4 * q; bf16* gy = WSP(bf16, WS_GDNY) + trow * 512 + h * 128 + 4 * q; u32x2 po1 = {0u, 0u}, po2 = {0u, 0u};
#pragma unroll
            for (int nt = 0; nt < 8; ++nt) { const u32x2 a = *(const u32x2*)(rg + 16 * nt), c = *(const u32x2*)(gz + 16 * nt);
                const float ga[4] = {bflo(a.x), bfhi(a.x), bflo(a.y), bfhi(a.y)}, gc4[4] = {bflo(c.x), bfhi(c.x), bflo(c.y), bfhi(c.y)};
                const f32x4 wr4 = *(const f32x4*)(F.ret_gn_w + h * 128 + 16 * nt + 4 * q), wg4 = *(const f32x4*)(F.gdn_norm_w + h * 128 + 16 * nt + 4 * q);
                float yr[4], yg[4];
#pragma unroll
                for (int e = 0; e < 4; ++e) { yr[e] = (orr[nt][e] - mean) * rs_r * wr4[e] * siluf_(ga[e]); yg[e] = og[nt][e] * rs_g * wg4[e] * siluf_(gc4[e]); }
                u32x2 o1, o2; o1.x = pk2(yr[0], yr[1]); o1.y = pk2(yr[2], yr[3]); o2.x = pk2(yg[0], yg[1]); o2.y = pk2(yg[2], yg[3]);
                if ((nt & 1) == 0) { po1 = o1; po2 = o2; }
                else {
                    const int cofs = 16 * (nt - 1 + (q & 1)) - 4 * (q & 1);
                    *(u32x4*)(ry + cofs) = widen16(po1, o1); *(u32x4*)(gy + cofs) = widen16(po2, o2); } }
        }
        LBAR();
    }
}

struct SchedMerge {
    const char *A0, *A1, *B0, *B1; int G, c;
    __device__ __forceinline__ bool next(int i, pg8::Unit& u) const {
        const int L = (i >> 1) * G + c; if (L >= 256) return false; const int term = i & 1;
        const int xcd = L % 8, off = L / 8; const int w = xcd * 32 + off;
        u.pm = w >> 2; u.pn = w & 3; u.e = term; u.base = 0;
        u.A = (term ? A1 : A0) + (size_t)u.pm * 256 * 512 * 2; u.B = (term ? B1 : B0) + (size_t)u.pn * 256 * 512 * 2; return true; }
    __device__ __forceinline__ int row_index(const pg8::Unit&, int r) const { return r; }
};
struct EpiMerge {
    const bf16* GATES; bf16* TMP; bf16* MERGED;
    __device__ __forceinline__ void operator()(const f32x4 (&acc)[2][2][4][2], const pg8::Unit& u, int wr, int wc, int fr, int fq) const {
        if (u.e == 0) {
#pragma unroll
            for (int ai = 0; ai < 2; ++ai)
#pragma unroll
                for (int m = 0; m < 4; ++m) { const unsigned row = (unsigned)u.pm * 256u + ai * 128 + wr * 64 + m * 16 + fr;
#pragma unroll
                    for (int bj = 0; bj < 2; ++bj) { const unsigned col = u.pn * 256 + bj * 128 + wc * 32 + 8 * fq;
                        const float v[8] = {acc[ai][bj][m][0][0], acc[ai][bj][m][0][1], acc[ai][bj][m][0][2], acc[ai][bj][m][0][3], acc[ai][bj][m][1][0], acc[ai][bj][m][1][1], acc[ai][bj][m][1][2], acc[ai][bj][m][1][3]};
                        *(u32x4*)((char*)TMP + (row * (unsigned)DM + col) * 2u) = pack8(v); } }
            return;
        }
#pragma unroll
        for (int ai = 0; ai < 2; ++ai) {
            u32x4 g0v[4][2], g1v[4][2], pv[4][2];
#pragma unroll
            for (int m = 0; m < 4; ++m) { const unsigned row = (unsigned)u.pm * 256u + ai * 128 + wr * 64 + m * 16 + fr;
#pragma unroll
                for (int bj = 0; bj < 2; ++bj) { const unsigned col = u.pn * 256 + bj * 128 + wc * 32 + 8 * fq;
                    const unsigned go = (row * 2048u + col) * 2u, to = (row * (unsigned)DM + col) * 2u;
                    g0v[m][bj] = *(const u32x4*)((const char*)GATES + go); g1v[m][bj] = *(const u32x4*)((const char*)GATES + go + 2048u);
                    pv[m][bj] = *(const u32x4*)((const char*)TMP + to); } }
#pragma unroll
            for (int m = 0; m < 4; ++m) { const unsigned row = (unsigned)u.pm * 256u + ai * 128 + wr * 64 + m * 16 + fr;
#pragma unroll
                for (int bj = 0; bj < 2; ++bj) { const unsigned col = u.pn * 256 + bj * 128 + wc * 32 + 8 * fq;
                    float g0[8], g1[8], p[8]; unpack8(g0v[m][bj], g0); unpack8(g1v[m][bj], g1); unpack8(pv[m][bj], p);
                    float v[8] = {acc[ai][bj][m][0][0], acc[ai][bj][m][0][1], acc[ai][bj][m][0][2], acc[ai][bj][m][0][3], acc[ai][bj][m][1][0], acc[ai][bj][m][1][1], acc[ai][bj][m][1][2], acc[ai][bj][m][1][3]};
#pragma unroll
                    for (int i = 0; i < 8; ++i) v[i] = p[i] * g0[i] + v[i] * g1[i];
                    *(u32x4*)((char*)MERGED + (row * (unsigned)DM + col) * 2u) = pack8(v); } }
        }
    }
};
struct SchedDense {
    const char *A, *B; int nM, nN, K, G, c;
    __device__ __forceinline__ bool next(int i, pg8::Unit& u) const {
        const int L = i * G + c; const int nwg = nM * nN; if (L >= nwg) return false;
        int w = L; if (nwg % 8 == 0) { const int xcd = L % 8, off = L / 8; w = xcd * (nwg / 8) + off; }
        u.pm = w / nN; u.pn = w % nN; u.e = 0; u.base = 0; u.A = A + (size_t)u.pm * 256 * K * 2; u.B = B + (size_t)u.pn * 256 * K * 2; return true; }
    __device__ __forceinline__ int row_index(const pg8::Unit&, int r) const { return r; }
};
struct EpiBf16Store { bf16* O; int ldc;
    __device__ __forceinline__ void operator()(const f32x4 (&acc)[2][2][4][2], const pg8::Unit& u, int wr, int wc, int fr, int fq) const {
#pragma unroll
        for (int ai = 0; ai < 2; ++ai)
#pragma unroll
            for (int m = 0; m < 4; ++m) { const size_t row = (size_t)u.pm * 256 + ai * 128 + wr * 64 + m * 16 + fr;
#pragma unroll
                for (int bj = 0; bj < 2; ++bj) { const int col = u.pn * 256 + bj * 128 + wc * 32 + 8 * fq; const f32x4 v0 = acc[ai][bj][m][0], v1 = acc[ai][bj][m][1];
                    u32x4 w; w.x = pk2(v0[0], v0[1]); w.y = pk2(v0[2], v0[3]); w.z = pk2(v1[0], v1[1]); w.w = pk2(v1[2], v1[3]);
                    *(u32x4*)(O + row * ldc + col) = w; } }
    }
};

__device__ __forceinline__ void load_row_bf16(const bf16* p, int lane, float (&v)[16]) { float a[8], b[8]; unpack8(*(const u32x4*)(p + 8 * lane), a); unpack8(*(const u32x4*)(p + 512 + 8 * lane), b);
#pragma unroll
    for (int i = 0; i < 8; ++i) { v[i] = a[i]; v[8 + i] = b[i]; } }
__device__ __forceinline__ void load_row_f32(const float* p, int lane, float (&v)[16]) {
#pragma unroll
    for (int q = 0; q < 4; ++q) { const f32x4 a = *(const f32x4*)(p + (q >> 1) * 512 + 8 * lane + 4 * (q & 1)); v[4 * q] = a.x; v[4 * q + 1] = a.y; v[4 * q + 2] = a.z; v[4 * q + 3] = a.w; } }
__device__ __forceinline__ void store_row_f32(float* p, int lane, const float (&v)[16]) {
#pragma unroll
    for (int q = 0; q < 4; ++q) *(f32x4*)(p + (q >> 1) * 512 + 8 * lane + 4 * (q & 1)) = (f32x4){v[4 * q], v[4 * q + 1], v[4 * q + 2], v[4 * q + 3]}; }
__device__ __forceinline__ void compute_x1(Frame& F, int t, float (&x1)[16]) {
    const int b = t / SEQ; const float* mod = WSP(float, WS_MOD) + b * 6144;
    const bf16* mop = WSP(bf16, WS_MO) + (size_t)t * DM;
    const u32x4 m0 = *(const u32x4*)(mop + 8 * F.lane), m1 = *(const u32x4*)(mop + 512 + 8 * F.lane);
    float ss = 0.f;
    { float a[8], c[8]; unpack8(m0, a); unpack8(m1, c);
#pragma unroll
      for (int i = 0; i < 8; ++i) ss += a[i] * a[i] + c[i] * c[i]; }
    const float rstd = 1.0f / sqrtf(wave_sum(ss) * (1.f / DM) + EPS);
#pragma unroll
    for (int hf = 0; hf < 2; ++hf) {
        const int c0 = hf * 512 + 8 * F.lane; float mo[8]; unpack8(hf ? m1 : m0, mo);
        const float* xp = F.x + (size_t)t * DM + c0; const float* wp = F.n_mix_post + c0; const float* gp = mod + 2 * DM + c0;
#pragma unroll
        for (int q = 0; q < 2; ++q) { const f32x4 xv = *(const f32x4*)(xp + 4 * q), wv = *(const f32x4*)(wp + 4 * q), g1 = *(const f32x4*)(gp + 4 * q);
#pragma unroll
            for (int e = 0; e < 4; ++e) x1[hf * 8 + 4 * q + e] = xv[e] + g1[e] * (mo[4 * q + e] * rstd * wv[e]); }
    }
}
__device__ __forceinline__ void route_token(Frame& F, int t, float logit, const float bias, LAS unsigned* lcnt, LAS u32x2* stage, unsigned* cnt, int2* list) {
    logit = (logit == logit) ? logit : 0.f;
    const float score = 1.f / (1.f + expf(-logit)); const float biased = score + bias;
#define DPP_MAX(v, ctrl) fmaxf((v), __builtin_bit_cast(float, __builtin_amdgcn_update_dpp(0, __builtin_bit_cast(int, (v)), (ctrl), 0xf, 0xf, true)))
    float m1 = biased; m1 = DPP_MAX(m1, 0xB1); m1 = DPP_MAX(m1, 0x4E); m1 = DPP_MAX(m1, 0x141);
    const unsigned long long bm = __ballot(biased == m1); const unsigned gb = (unsigned)(bm >> (F.lane & ~7)) & 0xffu; const int first = __ffs((int)gb) - 1;
    float m2 = ((F.lane & 7) == first) ? -__builtin_inff() : biased; m2 = DPP_MAX(m2, 0xB1); m2 = DPP_MAX(m2, 0x4E); m2 = DPP_MAX(m2, 0x141);
#undef DPP_MAX
    const float gs = m1 + m2;
    int grk = 0; const int myg = F.lane >> 3;
#pragma unroll
    for (int o = 0; o < 8; ++o) { const float ov = __builtin_bit_cast(float, __builtin_amdgcn_readlane(__builtin_bit_cast(int, gs), o * 8)); grk += ((ov > gs) | ((ov == gs) & (o < myg))) ? 1 : 0; }
    const bool keep = grk < 4;
    const float cand = keep ? biased : -__builtin_inff();
    int erk = 0; bool sel = false; float cv = cand;
#define DPP_MAXF(v, ctrl) fmaxf((v), __builtin_bit_cast(float, __builtin_amdgcn_update_dpp(0, __builtin_bit_cast(int, (v)), (ctrl), 0xf, 0xf, true)))
#pragma unroll
    for (int k = 0; k < TOPK; ++k) {
        float mx = cv; mx = DPP_MAXF(mx, 0xB1); mx = DPP_MAXF(mx, 0x4E); mx = DPP_MAXF(mx, 0x141); mx = DPP_MAXF(mx, 0x140);
        const float r0 = __builtin_bit_cast(float, __builtin_amdgcn_readlane(__builtin_bit_cast(int, mx), 0)), r1 = __builtin_bit_cast(float, __builtin_amdgcn_readlane(__builtin_bit_cast(int, mx), 16));
        const float r2 = __builtin_bit_cast(float, __builtin_amdgcn_readlane(__builtin_bit_cast(int, mx), 32)), r3 = __builtin_bit_cast(float, __builtin_amdgcn_readlane(__builtin_bit_cast(int, mx), 48));
        const float mm = fmaxf(fmaxf(r0, r1), fmaxf(r2, r3));
        const unsigned long long bmx = __ballot(cv == mm); const int lw = __ffsll((long long)bmx) - 1;
        if (F.lane == lw) { sel = true; erk = k; cv = -__builtin_inff(); } }
#undef DPP_MAXF
    sel = sel && keep;
    const float ssum = wave_sum(sel ? score : 0.f);
    if (sel) { const float w = score / ssum * 2.5f; const unsigned pos = __hip_atomic_fetch_add(lcnt + F.lane, 1u, __ATOMIC_RELAXED, __HIP_MEMORY_SCOPE_WORKGROUP);
        if (pos < 48u) stage[F.lane * 48 + pos] = (u32x2){(unsigned)(t * 8 + erk), __float_as_uint(w)};
        else { const unsigned gp = atomicAdd(cnt + 64 * F.lane, 1u); list[(size_t)F.lane * NT + gp] = make_int2(t * 8 + erk, __float_as_int(w)); } }
}
__device__ __forceinline__ void phase_route(Frame& F) {
    constexpr int HST = 2064;
    LAS unsigned char* hhi = F.lds;
    LAS unsigned char* hlo = F.lds + 16 * HST;
    LAS float* part = (LAS float*)(F.lds + 2 * 16 * HST);
    LAS u32x2* stage = (LAS u32x2*)(F.lds + 2 * 16 * HST + 32768);
    LAS unsigned* lcnt = (LAS unsigned*)(F.lds + MISC_OFF + 1024);
    unsigned* cnt = F.ctl + CW_CNT; int2* list = WSP(int2, WS_LIST);
    const int r = F.lane & 15, q = F.lane >> 4, kbase = F.wave * 128;
    bf16x8 wh[4][4]; u32x2 wl8[4][4];
#pragma unroll
    for (int ft = 0; ft < 4; ++ft) {
        asm volatile("" ::: "memory");
#pragma unroll
        for (int s = 0; s < 4; ++s) { float wv[8];
#pragma unroll
            for (int j = 0; j < 8; ++j) wv[j] = F.w_router[(size_t)(kbase + 32 * s + 8 * q + j) * NEXP + 16 * ft + r];
            unsigned hi[8];
#pragma unroll
            for (int j = 0; j < 8; ++j) hi[j] = f2bf(wv[j]);
            wh[ft][s] = __builtin_bit_cast(bf16x8, (u32x4){hi[0] | (hi[1] << 16), hi[2] | (hi[3] << 16), hi[4] | (hi[5] << 16), hi[6] | (hi[7] << 16)});
            float lf[8];
#pragma unroll
            for (int j = 0; j < 8; ++j) lf[j] = (wv[j] - bf2f(hi[j])) * 4096.0f;
            unsigned p0 = __builtin_amdgcn_cvt_pk_bf8_f32(lf[0], lf[1], 0u, false); p0 = __builtin_amdgcn_cvt_pk_bf8_f32(lf[2], lf[3], p0, true);
            unsigned p1 = __builtin_amdgcn_cvt_pk_bf8_f32(lf[4], lf[5], 0u, false); p1 = __builtin_amdgcn_cvt_pk_bf8_f32(lf[6], lf[7], p1, true);
            wl8[ft][s] = (u32x2){p0, p1}; } }
    const float rbias = F.router_bias[F.lane];
    LAS float* prm = (LAS float*)(F.lds + 2 * 16 * HST + 32768 + 24576);
    for (int g64 = F.bid; g64 < NT / 64; g64 += F.G) {
        if (F.tid < 64) lcnt[F.tid] = 0u;
        { const float* mod = WSP(float, WS_MOD) + ((g64 * 64) / SEQ) * 6144;
          for (int i = F.tid; i < DM; i += NTHR) { prm[i] = mod[2 * DM + i] * F.n_mix_post[i]; prm[DM + i] = F.n_ffn_pre[i] * (1.f + mod[4 * DM + i]); prm[2 * DM + i] = mod[3 * DM + i]; } }
        __syncthreads();
        u32x4 pmo[2][2]; f32x4 pxr[2][4];
#define ROUTE_ISSUE(grp_) do { _Pragma("unroll") for (int tw_ = 0; tw_ < 2; ++tw_) { const int t_ = g64 * 64 + (grp_) * 16 + 2 * F.wave + tw_; \
            const bf16* mop_ = WSP(bf16, WS_MO) + (size_t)t_ * DM; pmo[tw_][0] = *(const u32x4*)(mop_ + 8 * F.lane); pmo[tw_][1] = *(const u32x4*)(mop_ + 512 + 8 * F.lane); \
            const float* xp_ = F.x + (size_t)t_ * DM; _Pragma("unroll") for (int q_ = 0; q_ < 4; ++q_) pxr[tw_][q_] = *(const f32x4*)(xp_ + (q_ >> 1) * 512 + 8 * F.lane + 4 * (q_ & 1)); } } while (0)
        ROUTE_ISSUE(0);
#pragma unroll 1
        for (int grp = 0; grp < 4; ++grp) {
#pragma unroll
            for (int tw = 0; tw < 2; ++tw) {
                const int slot = 2 * F.wave + tw; const int t = g64 * 64 + grp * 16 + slot;
                float x1[16];
                {
                  const u32x4 m0 = pmo[tw][0], m1 = pmo[tw][1];
                  f32x4 xv[4];
#pragma unroll
                  for (int q4 = 0; q4 < 4; ++q4) xv[q4] = pxr[tw][q4];
                  float ma[8], mc[8]; unpack8(m0, ma); unpack8(m1, mc); float s2 = 0.f;
#pragma unroll
                  for (int i = 0; i < 8; ++i) s2 += ma[i] * ma[i] + mc[i] * mc[i];
                  const float rs = 1.0f / sqrtf(wave_sum(s2) * (1.f / DM) + EPS);
#pragma unroll
                  for (int q4 = 0; q4 < 4; ++q4) { const f32x4 a1 = *(const LAS f32x4*)(prm + (q4 >> 1) * 512 + 8 * F.lane + 4 * (q4 & 1));
#pragma unroll
                      for (int e = 0; e < 4; ++e) x1[4 * q4 + e] = xv[q4][e] + a1[e] * (((q4 >> 1) ? mc : ma)[4 * (q4 & 1) + e] * rs); } }
                float ss = 0.f;
#pragma unroll
                for (int i = 0; i < 16; ++i) ss += x1[i] * x1[i];
                const float rstd = 1.0f / sqrtf(wave_sum(ss) * (1.f / DM) + EPS);
                bf16* d = WSP(bf16, WS_H2) + (size_t)t * DM;
#pragma unroll
                for (int hf = 0; hf < 2; ++hf) {
                    const int c0 = hf * 512 + 8 * F.lane; float h2[8];
#pragma unroll
                    for (int qq = 0; qq < 2; ++qq) { const f32x4 b1 = *(const LAS f32x4*)(prm + DM + c0 + 4 * qq), sh = *(const LAS f32x4*)(prm + 2 * DM + c0 + 4 * qq);
#pragma unroll
                        for (int e = 0; e < 4; ++e) h2[4 * qq + e] = x1[hf * 8 + 4 * qq + e] * rstd * b1[e] + sh[e]; }
                    const u32x4 hp = pack8(h2); *(u32x4*)(d + c0) = hp;
                    float lo8[8]; { float hb[8]; unpack8(hp, hb);
#pragma unroll
                        for (int e = 0; e < 8; ++e) lo8[e] = h2[e] - hb[e]; }
                    *(LAS u32x4*)(hhi + slot * HST + c0 * 2) = hp; *(LAS u32x4*)(hlo + slot * HST + c0 * 2) = pack8(lo8);
                }
            }
            if (grp < 3) ROUTE_ISSUE(grp + 1);
            LBAR();
            {
                typedef float f32x2v __attribute__((ext_vector_type(2)));
                f32x4 acc[4], acc2[4];
#pragma unroll
                for (int ft = 0; ft < 4; ++ft) { acc[ft] = (f32x4){0.f, 0.f, 0.f, 0.f}; acc2[ft] = (f32x4){0.f, 0.f, 0.f, 0.f}; }
#pragma unroll
                for (int s = 0; s < 4; ++s) { const int off = r * HST + (kbase + 32 * s + 8 * q) * 2;
                    const bf16x8 bh = *(const LAS bf16x8*)(hhi + off), bl = *(const LAS bf16x8*)(hlo + off);
#pragma unroll
                    for (int ft = 0; ft < 4; ++ft) {
                        const f32x2v l0 = __builtin_amdgcn_cvt_pk_f32_bf8(wl8[ft][s].x, false), l1 = __builtin_amdgcn_cvt_pk_f32_bf8(wl8[ft][s].x, true), l2 = __builtin_amdgcn_cvt_pk_f32_bf8(wl8[ft][s].y, false), l3 = __builtin_amdgcn_cvt_pk_f32_bf8(wl8[ft][s].y, true);
                        const bf16x8 wlo = __builtin_bit_cast(bf16x8, (u32x4){pk2(l0.x, l0.y), pk2(l1.x, l1.y), pk2(l2.x, l2.y), pk2(l3.x, l3.y)});
                        acc[ft] = MFMA16(wh[ft][s], bh, acc[ft]); acc[ft] = MFMA16(wh[ft][s], bl, acc[ft]); acc2[ft] = MFMA16(wlo, bh, acc2[ft]); } }
#pragma unroll
                for (int ft = 0; ft < 4; ++ft)
#pragma unroll
                    for (int e = 0; e < 4; ++e) part[(F.wave * 64 + 16 * ft + 4 * q + e) * 16 + r] = acc[ft][e] + acc2[ft][e] * (1.0f / 4096.0f);
            }
            LBAR();
#pragma unroll 1
            for (int tw = 0; tw < 2; ++tw) { const int slot = 2 * F.wave + tw; float logit = 0.f;
#pragma unroll
                for (int w = 0; w < 8; ++w) logit += part[(w * 64 + F.lane) * 16 + slot];
                route_token(F, g64 * 64 + grp * 16 + slot, logit, rbias, lcnt, stage, cnt, list); }
        }
        __syncthreads();
        { int tz = threadIdx.x; asm volatile("" : "+v"(tz));
          if (tz < 64) { const unsigned n = lcnt[tz] < 48u ? lcnt[tz] : 48u; lcnt[tz] = n; lcnt[64 + tz] = atomicAdd(F.ctl + CW_CNT + 64 * tz, n); } }
        __syncthreads();
        { const int e = F.tid >> 3; const unsigned n = lcnt[e], base = lcnt[64 + e];
          for (unsigned j = F.tid & 7; j < n; j += 8) { const u32x2 v = stage[e * 48 + j]; list[(size_t)e * NT + base + j] = make_int2((int)v.x, (int)v.y); } }
        __syncthreads();
    }
}

__device__ __forceinline__ void build_tile_prefix(Frame& F, LAS int* tp) {
    __syncthreads();
    if (F.tid < 64) {
        const int lane = F.tid, x = F.bid & 7;
        const int ce = (int)__hip_atomic_load(F.ctl + CW_CNT + 64 * lane, __ATOMIC_RELAXED, __HIP_MEMORY_SCOPE_AGENT); const int tl = (ce + 255) >> 8;
        int s = tl;
#pragma unroll
        for (int d = 1; d < 64; d <<= 1) { const int o = __shfl_up(s, d); if (lane >= d) s += o; }
        tp[96 + lane] = ce; tp[lane] = s - tl; if (lane == 63) { tp[64] = s; tp[65] = s + 64; }
        int rx = tl; rx += __shfl_xor(rx, 8); rx += __shfl_xor(rx, 16); rx += __shfl_xor(rx, 32);
        int lo = 0, hi = 1024;
#pragma unroll 1
        while (lo < hi) { const int T = (lo + hi) >> 1; int f = T > rx ? T - rx : 0; f += __shfl_xor(f, 1); f += __shfl_xor(f, 2); f += __shfl_xor(f, 4); if (f >= 64) hi = T; else lo = T + 1; }
        int sx = lo > rx ? lo - rx : 0; int f = sx; f += __shfl_xor(f, 1); f += __shfl_xor(f, 2); f += __shfl_xor(f, 4);
        { const unsigned m8 = (unsigned)(__ballot(sx > 0) >> (lane & ~7)) & 0xffu; const int before = __popc(m8 & ((1u << (lane & 7)) - 1u)); if (sx > 0 && before < f - 64) sx -= 1; }
        int ps = sx;
#pragma unroll
        for (int d = 1; d < 8; d <<= 1) { const int o = __shfl_up(ps, d); if ((lane & 7) >= d) ps += o; }
        const int sx_mine = __shfl(sx, x), s0_mine = __shfl(ps - sx, x);
        const int tk = __shfl(tl, x + 8 * (lane & 7)); int pk = tk;
#pragma unroll
        for (int d = 1; d < 8; d <<= 1) { const int o = __shfl_up(pk, d); if ((lane & 7) >= d) pk += o; }
        if (lane < 8) tp[80 + lane] = pk - tk;
        if (lane == 7) { tp[88] = pk; tp[89] = pk + sx_mine; tp[90] = s0_mine; }
    }
    __syncthreads();
}
struct SchedMoe {
    const char* A; const char* B; const int2* list; const unsigned* cnt; const LAS int* tp; int npn, K, G, c; size_t bstride  ; int bcol0  ; bool gather; const LAS int* rtab  ; const LAS unsigned* utab = nullptr  ;
    __device__ __forceinline__ bool next(int i, pg8::Unit& u) const {
        int e, pm;
        if (utab && i < 32) {
            const unsigned v = (unsigned)__builtin_amdgcn_readfirstlane((int)utab[i]); if (v == 0xffffffffu) return false;
            e = (int)(v & 0xffu); u.pn = (int)((v >> 8) & 0xffu); pm = (int)(v >> 16);
            u.ord = i; u.e = e; u.pm = pm; u.base = __builtin_amdgcn_readfirstlane((int)utab[32 + i]); u.cnt = __builtin_amdgcn_readfirstlane((int)utab[64 + i]);
            u.A = gather ? A : A + (size_t)u.base * K * 2; u.B = B + (size_t)e * bstride + (size_t)(bcol0 + u.pn * 256) * K * 2; return true;
        } else if ((G & 7) == 0) {
            const int x = c & 7, W = G >> 3, L = i * W + (c >> 3); const int nt = __builtin_amdgcn_readfirstlane(tp[89]); if (L >= nt * npn) return false;
            const int tl = L / npn; u.pn = L % npn; int k = 0;
            for (int q = 8; q >= 1; q >>= 1) if (k + q <= 8 && __builtin_amdgcn_readfirstlane(tp[80 + k + q]) <= tl) k += q;
            k = __builtin_amdgcn_readfirstlane(k); const int off = tl - __builtin_amdgcn_readfirstlane(tp[80 + k]);
            if (k < 8) { e = x + 8 * k; pm = off; } else { e = 64; pm = __builtin_amdgcn_readfirstlane(tp[90]) + off; }
        } else {
            const int L = i * G + c; const int ntile = __builtin_amdgcn_readfirstlane(tp[65]); if (L >= ntile * npn) return false;
            const int tile = L / npn; u.pn = L % npn; e = 0;
            for (int q = 64; q >= 1; q >>= 1) if (e + q <= 64 && __builtin_amdgcn_readfirstlane(tp[e + q]) <= tile) e += q;
            e = __builtin_amdgcn_readfirstlane(e); pm = tile - __builtin_amdgcn_readfirstlane(tp[e]);
        }
        u.cnt = __builtin_amdgcn_readfirstlane(tp[96 + (e < 64 ? e : 0)]);
        u.ord = i; u.e = e; u.pm = pm; u.base = (e < 64 ? (__builtin_amdgcn_readfirstlane(tp[e < 64 ? e : 0]) + pm) * 256 : SLOT_SH + pm * 256);
        u.A = gather ? A : A + (size_t)u.base * K * 2; u.B = B + (size_t)e * bstride + (size_t)(bcol0 + u.pn * 256) * K * 2; return true; }
    __device__ __forceinline__ unsigned pack_base(unsigned v) const { if (v == 0xffffffffu) return 0u; const int e = (int)(v & 0xffu), pm = (int)(v >> 16); return (unsigned)(e < 64 ? (tp[e] + pm) * 256 : SLOT_SH + pm * 256); }
    __device__ __forceinline__ unsigned pack_unit(int i) const {
        const int x = c & 7, W = G >> 3, L = i * W + (c >> 3); const int nt = tp[89]; if (L >= nt * npn) return 0xffffffffu;
        const int tl = L / npn, pn_ = L % npn; int k = 0;
        for (int q = 8; q >= 1; q >>= 1) if (k + q <= 8 && tp[80 + k + q] <= tl) k += q;
        const int off = tl - tp[80 + k]; const int e = k < 8 ? x + 8 * k : 64, pm = k < 8 ? off : tp[90] + off;
        return (unsigned)e | ((unsigned)pn_ << 8) | ((unsigned)pm << 16); }
    __device__ __forceinline__ int row_index(const pg8::Unit& u, int r) const {
        if (rtab) return rtab[u.ord * 256 + r];
        if (u.e == 64) return u.pm * 256 + r;
        const unsigned tok = (unsigned)list[(size_t)u.e * NT + u.pm * 256 + r].x >> 3; return (int)(tok < (unsigned)NT ? tok : 0u); }
};
struct EpiUp { bf16* HMID;
    __device__ __forceinline__ void operator()(const f32x4 (&acc)[2][2][4][2], const pg8::Unit& u, int wr, int wc, int fr, int fq) const {
#pragma unroll
        for (int ai = 0; ai < 2; ++ai)
#pragma unroll
            for (int mp = 0; mp < 2; ++mp) { const size_t slot = (size_t)u.base + ai * 128 + wr * 64 + (2 * mp + (fq & 1)) * 16 + fr;
#pragma unroll
                for (int bj = 0; bj < 2; ++bj) { const int hid = u.pn * 128 + bj * 64 + wc * 16 + (fq & 2) * 4; u32x2 w[2];
#pragma unroll
                    for (int h = 0; h < 2; ++h) { const f32x4 g = acc[ai][bj][2 * mp + h][0], up = acc[ai][bj][2 * mp + h][1];
                        w[h].x = pk2(siluf_(g[0]) * up[0], siluf_(g[1]) * up[1]); w[h].y = pk2(siluf_(g[2]) * up[2], siluf_(g[3]) * up[3]); }
                    *(u32x4*)(HMID + slot * DEXP + hid) = widen16(w[0], w[1]); } }
    }
};
constexpr float YB_SCALE = 64.0f, YB_INV = 1.0f / 64.0f;
__device__ __forceinline__ unsigned pk4_fp8(float a, float b, float c, float d) {
    a = fminf(fmaxf(a * YB_SCALE, -448.f), 448.f); b = fminf(fmaxf(b * YB_SCALE, -448.f), 448.f); c = fminf(fmaxf(c * YB_SCALE, -448.f), 448.f); d = fminf(fmaxf(d * YB_SCALE, -448.f), 448.f);
    unsigned p = __builtin_amdgcn_cvt_pk_fp8_f32(a, b, 0u, false); return __builtin_amdgcn_cvt_pk_fp8_f32(c, d, p, true); }
__device__ __forceinline__ unsigned pk4_fp8s(float a, float b, float c, float d) {
    a = __builtin_amdgcn_fmed3f(a, -448.f, 448.f); b = __builtin_amdgcn_fmed3f(b, -448.f, 448.f); c = __builtin_amdgcn_fmed3f(c, -448.f, 448.f); d = __builtin_amdgcn_fmed3f(d, -448.f, 448.f);
    unsigned p = __builtin_amdgcn_cvt_pk_fp8_f32(a, b, 0u, false); return __builtin_amdgcn_cvt_pk_fp8_f32(c, d, p, true); }
struct EpiDown { unsigned char* YB; float* OUT; const int2* list; const LAS int* tp;
    __device__ __forceinline__ void operator()(const f32x4 (&acc)[2][2][4][2], const pg8::Unit& u, int wr, int wc, int fr, int fq) const {
        if (u.e == 64) {
#pragma unroll
            for (int ai = 0; ai < 2; ++ai)
#pragma unroll
                for (int m = 0; m < 4; ++m) { const int idx = u.pm * 256 + ai * 128 + wr * 64 + m * 16 + fr; bf16* o = (bf16*)(OUT + (size_t)idx * DM) + u.pn * 256 + wc * 32 + 8 * fq;
#pragma unroll
                    for (int bj = 0; bj < 2; ++bj) { const f32x4 v0 = acc[ai][bj][m][0], v1 = acc[ai][bj][m][1]; const float v[8] = {v0[0], v0[1], v0[2], v0[3], v1[0], v1[1], v1[2], v1[3]}; *(u32x4*)(o + bj * 128) = pack8(v); } }
        } else {
            const int n = u.cnt; int2 dw[2][4];
#pragma unroll
            for (int ai = 0; ai < 2; ++ai)
#pragma unroll
                for (int m = 0; m < 4; ++m) { int idx = u.pm * 256 + ai * 128 + wr * 64 + m * 16 + fr; idx = idx < n ? idx : n - 1; dw[ai][m] = list[(size_t)u.e * NT + idx]; }
#pragma unroll
            for (int ai = 0; ai < 2; ++ai)
#pragma unroll
                for (int mp = 0; mp < 2; ++mp) {
                    const int2 d0 = dw[ai][2 * mp], d1 = dw[ai][2 * mp + 1]; const int2 ds = (fq & 1) ? d1 : d0;
                    const int idx = u.pm * 256 + ai * 128 + wr * 64 + (2 * mp + (fq & 1)) * 16 + fr;
                    const float w0 = __int_as_float(d0.y) * YB_SCALE, w1 = __int_as_float(d1.y) * YB_SCALE;
                    unsigned char* o = YB + yb_off(ds.x) + u.pn * 256 + wc * 32 + 8 * (fq & 2);
#pragma unroll
                    for (int bj = 0; bj < 2; ++bj) { u32x2 q[2];
                        { const f32x4 v0 = acc[ai][bj][2 * mp][0] * w0, v1 = acc[ai][bj][2 * mp][1] * w0; q[0].x = pk4_fp8s(v0[0], v0[1], v0[2], v0[3]); q[0].y = pk4_fp8s(v1[0], v1[1], v1[2], v1[3]); }
                        { const f32x4 v0 = acc[ai][bj][2 * mp + 1][0] * w1, v1 = acc[ai][bj][2 * mp + 1][1] * w1; q[1].x = pk4_fp8s(v0[0], v0[1], v0[2], v0[3]); q[1].y = pk4_fp8s(v1[0], v1[1], v1[2], v1[3]); }
                        const u32x4 q4 = widen16(q[0], q[1]);
                        if (idx < n) *(u32x4*)(o + bj * 128) = q4; } }
        }
    }
};
__device__ __forceinline__ void phase_final(Frame& F) {
    typedef float f32x2v __attribute__((ext_vector_type(2)));
    const int gw = F.bid * NWAVES + F.wave, NGW = F.G * NWAVES; const unsigned char* YB = F.ws;
    for (int t = gw; t < NT; t += NGW) {
        const int b = t / SEQ; const float* mod = WSP(float, WS_MOD) + b * 6144;
        u32x2 ya[8], yb[8];
#pragma unroll
        for (int k = 0; k < 8; ++k) { const unsigned char* rp = YB + yb_off(t * 8 + k); ya[k] = *(const u32x2*)(rp + 8 * F.lane); yb[k] = *(const u32x2*)(rp + 512 + 8 * F.lane); }
        float mv[16];
        { const bf16* sp = (const bf16*)(F.out + (size_t)t * DM); const u32x4 s0 = *(const u32x4*)(sp + 8 * F.lane), s1 = *(const u32x4*)(sp + 512 + 8 * F.lane); float lo8[8], hi8[8]; unpack8(s0, lo8); unpack8(s1, hi8);
#pragma unroll
          for (int i = 0; i < 8; ++i) { mv[i] = lo8[i]; mv[8 + i] = hi8[i]; } }
        float ra[16];
#pragma unroll
        for (int i = 0; i < 16; ++i) ra[i] = 0.f;
#pragma unroll
        for (int k = 0; k < 8; ++k) {
            const f32x2v a0 = __builtin_amdgcn_cvt_pk_f32_fp8(ya[k].x, false), a1 = __builtin_amdgcn_cvt_pk_f32_fp8(ya[k].x, true), a2 = __builtin_amdgcn_cvt_pk_f32_fp8(ya[k].y, false), a3 = __builtin_amdgcn_cvt_pk_f32_fp8(ya[k].y, true);
            const f32x2v c0 = __builtin_amdgcn_cvt_pk_f32_fp8(yb[k].x, false), c1 = __builtin_amdgcn_cvt_pk_f32_fp8(yb[k].x, true), c2 = __builtin_amdgcn_cvt_pk_f32_fp8(yb[k].y, false), c3 = __builtin_amdgcn_cvt_pk_f32_fp8(yb[k].y, true);
            ra[0] += a0.x; ra[1] += a0.y; ra[2] += a1.x; ra[3] += a1.y; ra[4] += a2.x; ra[5] += a2.y; ra[6] += a3.x; ra[7] += a3.y;
            ra[8] += c0.x; ra[9] += c0.y; ra[10] += c1.x; ra[11] += c1.y; ra[12] += c2.x; ra[13] += c2.y; ra[14] += c3.x; ra[15] += c3.y; }
        float ss = 0.f;
#pragma unroll
        for (int i = 0; i < 16; ++i) { mv[i] += ra[i] * YB_INV; ss += mv[i] * mv[i]; }
        const float rstd = 1.0f / sqrtf(wave_sum(ss) * (1.f / DM) + EPS);
        float x1[16]; compute_x1(F, t, x1);
        float wv[16], g2[16]; load_row_f32(F.n_ffn_post, F.lane, wv); load_row_f32(mod + 5 * DM, F.lane, g2);
        float o[16];
#pragma unroll
        for (int i = 0; i < 16; ++i) o[i] = x1[i] + g2[i] * (mv[i] * rstd * wv[i]);
        store_row_f32(F.out + (size_t)t * DM, F.lane, o);
    }
}

constexpr int N_PHASES = 16;
__global__ void __launch_bounds__(NTHR, 2) fwd(Args args) {
    extern __shared__ __attribute__((aligned(16))) unsigned char lds_raw[];
    Frame F; F.lds = (LAS unsigned char*)lds_raw; F.tid = threadIdx.x; F.lane = F.tid & 63; F.wave = __builtin_amdgcn_readfirstlane(F.tid >> 6); F.G = gridDim.x; F.bid = blockIdx.x;
    F.x = args.in[0]; F.c = args.in[1]; F.ctx = args.in[2]; F.c_ctx = args.in[3]; F.w_mod = args.in[4]; F.b_mod = args.in[5]; F.n_mix_pre = args.in[6]; F.n_mix_post = args.in[7];
    F.n_ffn_pre = args.in[8]; F.n_ffn_post = args.in[9]; F.w_in = args.in[10]; F.gdn_conv = args.in[11]; F.ret_log_decay = args.in[12]; F.gdn_a_log = args.in[13]; F.gdn_dt_bias = args.in[14];
    F.ret_gn_w = args.in[15]; F.gdn_norm_w = args.in[16]; F.w_ret_out = args.in[17]; F.w_gdn_out = args.in[18]; F.w_o = args.in[19]; F.w_router = args.in[20]; F.router_bias = args.in[21];
    F.w_gate = args.in[22]; F.w_up = args.in[23]; F.w_down = args.in[24]; F.w_sh_gate = args.in[25]; F.w_sh_up = args.in[26]; F.w_sh_down = args.in[27];
    F.out = args.out; F.ws = args.ws; F.ctl = (unsigned*)(args.ws + WS_CTL);
    volatile LAS unsigned* MISC = (volatile LAS unsigned*)(F.lds + MISC_OFF);
    if (F.tid < 64) MISC[F.tid] = 0u;
    __syncthreads();
#if MK_ONE_LAUNCH
    XcdBarrier bar = xcd_barrier_post(F.ctl + CW_BAR, MISC + 8);
#define SEAM() xcd_barrier(bar)
#else
#define SEAM() do {} while (0)
#endif
    const int lo = args.ph_lo, hi = args.ph_hi;
#ifndef PHM
#define PHM 0xffff
#endif
#ifndef DUP
#define DUP -1
#endif
#define IN(k) (((PHM >> (k)) & 1) && lo <= (k) && (k) < hi)
    const bool WD_EARLY = MK_ONE_LAUNCH && F.G >= 192;
    LAS int* tp = (LAS int*)(F.lds + MISC_OFF + 256);
#ifndef PROBE_PH
#define PROBE_PH -1
#endif
#ifdef PROBE_A
#define PROBE_IA PROBE_A
#define PROBE_IB PROBE_B
#else
#define PROBE_IA (PROBE_PH % 100)
#define PROBE_IB ((PROBE_PH % 100) + 1)
#endif
    volatile LAS unsigned long long* tsl = (volatile LAS unsigned long long*)(F.lds + MISC_OFF + 896);
#define STAMP(k) do { if (PROBE_PH >= 0 && F.bid == 0 && F.tid == 0 && !(PROBE_PH == 204 && (k) == 5)) tsl[k] = __builtin_amdgcn_s_memrealtime(); } while (0)

    STAMP(0);
    if (IN(0)) _Pragma("unroll") for (int rep_ = 0; rep_ < ((DUP == 0) ? 2 : 1); ++rep_) { phase_prologue(F); SEAM(); }
    STAMP(1);
    if (IN(1)) _Pragma("unroll") for (int rep_ = 0; rep_ < ((DUP == 1) ? 2 : 1); ++rep_) { phase_norm1(F);
        if (F.G >= 64 && F.bid < 32) { SchedCtx S{(const char*)WSP(bf16, WS_HX), (const char*)WSP(bf16, WS_WIN), F.bid >> 3, F.bid & 7}; EpiIn E{WSP(bf16, WS_P), (bf16*)F.out, WSP(float2, WS_ROPE)};
            pg8::gemm_phase<EpiIn, SchedCtx, false, SP2>(F.lds, DM, S, E); }
        SEAM(); }
    STAMP(2);
    if (IN(2)) _Pragma("unroll") for (int rep_ = 0; rep_ < ((DUP == 2) ? 2 : 1); ++rep_) {
        SchedIn S{(const char*)WSP(bf16, WS_HX), (const char*)WSP(bf16, WS_WIN), F.G, F.bid};
        EpiIn E{WSP(bf16, WS_P), (bf16*)F.out, WSP(float2, WS_ROPE)};
        pg8::gemm_phase<EpiIn, SchedIn, false, SP2>(F.lds, DM, S, E); SEAM();
    }
    STAMP(3);
    if (IN(3)) _Pragma("unroll") for (int rep_ = 0; rep_ < ((DUP == 3) ? 2 : 1); ++rep_) { phase_prep(F); SEAM(); }
    STAMP(4);
    if (IN(4)) _Pragma("unroll") for (int rep_ = 0; rep_ < ((DUP == 4) ? 2 : 1); ++rep_) { phase_scan(F); if (WD_EARLY && F.bid >= 128 && rep_ == 0) { __syncthreads(); phase_moe_wd(F, 128); } SEAM(); }
    STAMP(5);
    if (IN(5)) _Pragma("unroll") for (int rep_ = 0; rep_ < ((DUP == 5) ? 2 : 1); ++rep_) { phase_out(F); SEAM(); }
    STAMP(6);
    if (IN(6)) _Pragma("unroll") for (int rep_ = 0; rep_ < ((DUP == 6) ? 2 : 1); ++rep_) {
        SchedMerge S{(const char*)WSP(bf16, WS_RETY), (const char*)WSP(bf16, WS_GDNY), (const char*)WSP(bf16, WS_WRO), (const char*)WSP(bf16, WS_WGO), F.G, F.bid};
        EpiMerge E{(const bf16*)F.out, WSP(bf16, WS_TMP), WSP(bf16, WS_MERGED)};
        pg8::gemm_phase<EpiMerge, SchedMerge, false, SP2>(F.lds, 512, S, E);
        STAMP(15);
        SEAM();
    }
    STAMP(7);
    if (IN(7)) _Pragma("unroll") for (int rep_ = 0; rep_ < ((DUP == 7) ? 2 : 1); ++rep_) {
        SchedDense S{(const char*)WSP(bf16, WS_MERGED), (const char*)WSP(bf16, WS_WO), 64, 4, DM, F.G, F.bid};
        EpiBf16Store E{WSP(bf16, WS_MO), DM};
        pg8::gemm_phase<EpiBf16Store, SchedDense, false, SP2>(F.lds, DM, S, E); SEAM();
    }
    STAMP(8);
    if (IN(8)) _Pragma("unroll") for (int rep_ = 0; rep_ < ((DUP == 8) ? 2 : 1); ++rep_) { if (rep_ == 1) { if (F.bid == 0 && F.tid < 64) F.ctl[CW_CNT + 64 * F.tid] = 0u; SEAM(); }
        const bool conv_first = ((F.bid >> 3) & 1) != 0;
        if (conv_first && rep_ == 0) { phase_moe_weights(F, !WD_EARLY); __syncthreads(); }
        phase_route(F);
        if (!conv_first && rep_ == 0) { __syncthreads(); phase_moe_weights(F, !WD_EARLY); }
        SEAM(); }
    STAMP(9);
    if (IN(9)) _Pragma("unroll") for (int rep_ = 0; rep_ < ((DUP == 9) ? 2 : 1); ++rep_) {
        build_tile_prefix(F, tp);
        LAS unsigned* utab = (LAS unsigned*)(F.lds + RING_BYTES);
        const bool useu = (F.G & 7) == 0;
        if (useu && F.tid < 32) { SchedMoe Sx{nullptr, nullptr, nullptr, F.ctl + CW_CNT, tp, 2, DM, F.G, F.bid, 0, 0, true, nullptr}; { const unsigned v_ = Sx.pack_unit(F.tid); utab[F.tid] = v_; utab[32 + F.tid] = Sx.pack_base(v_); utab[64 + F.tid] = (v_ != 0xffffffffu && (v_ & 0xffu) < 64u) ? (unsigned)tp[96 + (v_ & 0xffu)] : 0u; } }
        __syncthreads();
        LAS int* rtab = (LAS int*)(F.lds + MISC_OFF + 1024);
        SchedMoe S0{(const char*)WSP(bf16, WS_H2), (const char*)WSP(bf16, WS_WGU), WSP(int2, WS_LIST), F.ctl + CW_CNT, tp, 2, DM, F.G, F.bid, (size_t)512 * DM * 2, 0, true, nullptr, useu ? utab : nullptr};
        bool fits = true;
        { pg8::Unit u; int ui = 0; for (; S0.next(ui, u); ++ui) { if (ui >= 7) { fits = false; break; } if (F.tid < 256) rtab[ui * 256 + F.tid] = S0.row_index(u, F.tid); } }
        __syncthreads();
        SchedMoe S{(const char*)WSP(bf16, WS_H2), (const char*)WSP(bf16, WS_WGU), WSP(int2, WS_LIST), F.ctl + CW_CNT, tp, 2, DM, F.G, F.bid, (size_t)512 * DM * 2, 0, true, fits ? rtab : nullptr, useu ? utab : nullptr};
        EpiUp E{WSP(bf16, WS_HMID)};
        pg8::gemm_phase<EpiUp, SchedMoe, true, SP2>(F.lds, DM, S, E); SEAM();
    }
    STAMP(10);
    if (IN(10)) _Pragma("unroll") for (int rep_ = 0; rep_ < ((DUP == 10) ? 2 : 1); ++rep_) {
        if (!IN(9)) build_tile_prefix(F, tp);
        LAS unsigned* utab = (LAS unsigned*)(F.lds + RING_BYTES); const bool useu = (F.G & 7) == 0;
        if (useu && F.tid < 32) { SchedMoe Sx{nullptr, nullptr, nullptr, F.ctl + CW_CNT, tp, 4, DEXP, F.G, F.bid, 0, 0, false, nullptr}; { const unsigned v_ = Sx.pack_unit(F.tid); utab[F.tid] = v_; utab[32 + F.tid] = Sx.pack_base(v_); utab[64 + F.tid] = (v_ != 0xffffffffu && (v_ & 0xffu) < 64u) ? (unsigned)tp[96 + (v_ & 0xffu)] : 0u; } }
        __syncthreads();
        SchedMoe S{(const char*)WSP(bf16, WS_HMID), (const char*)WSP(bf16, WS_WD), WSP(int2, WS_LIST), F.ctl + CW_CNT, tp, 4, DEXP, F.G, F.bid, (size_t)DM * DEXP * 2, 0, false, nullptr, useu ? utab : nullptr};
        EpiDown E{F.ws, F.out, WSP(int2, WS_LIST), tp};
        pg8::gemm_phase<EpiDown, SchedMoe, false, SP2>(F.lds, DEXP, S, E); SEAM();
    }
    STAMP(11);
    STAMP(12);
    STAMP(13);
    if (IN(13)) _Pragma("unroll") for (int rep_ = 0; rep_ < ((DUP == 13) ? 2 : 1); ++rep_) { phase_final(F); }
    STAMP(14);
    if (PROBE_PH >= 0 && F.bid == 0) { __syncthreads(); if (F.tid == 0) { const unsigned long long d = tsl[PROBE_IB] - tsl[PROBE_IA]; float a = 1.0f + 0.2f * floorf((float)d * 0.001f); a = a > 30.f ? 30.f : a;
#ifdef PROBE_BIG
            a = 20.0f + (float)d * 0.005f;
#endif
            asm volatile("s_waitcnt vmcnt(0)" ::: "memory"); F.out[0] += a; } }
#undef IN
}

extern "C" void kernel_launch(void* const* d_in, const int* in_sizes, int n_in, void* d_out, int out_size, void* d_ws, size_t ws_size, hipStream_t stream) {
    static int grid = 0;
    if (grid == 0) {
        if (n_in != 28 || in_sizes[0] != NT * DM || out_size != NT * DM || ws_size < WS_END) { fprintf(stderr, "kernel_launch: unexpected shapes / workspace (%d inputs, ws %zu)\n", n_in, ws_size); grid = -1; return; }
        int dev = 0, cus = 0;
        if (hipGetDevice(&dev) != hipSuccess || hipDeviceGetAttribute(&cus, hipDeviceAttributeMultiprocessorCount, dev) != hipSuccess) { grid = -1; return; }
        if (hipFuncSetAttribute((const void*)fwd, hipFuncAttributeMaxDynamicSharedMemorySize, LDS_BYTES) != hipSuccess) { fprintf(stderr, "kernel_launch: hipFuncSetAttribute failed\n"); grid = -1; return; }
        int per_cu = 0; (void)hipOccupancyMaxActiveBlocksPerMultiprocessor(&per_cu, (const void*)fwd, NTHR, LDS_BYTES); (void)hipGetLastError();
        if (per_cu < 1) fprintf(stderr, "kernel_launch: occupancy query says %d\n", per_cu);
        grid = cus;
    }
    if (grid < 0) return;
    (void)hipMemsetAsync((char*)d_ws + WS_CTL, 0, CTL_BYTES, stream);
    Args a{};
    for (int i = 0; i < 28; ++i) a.in[i] = (const float*)d_in[i];
    a.out = (float*)d_out; a.ws = (unsigned char*)d_ws;
#if MK_ONE_LAUNCH
    a.ph_lo = 0; a.ph_hi = N_PHASES;
    hipLaunchKernelGGL(fwd, dim3(grid), dim3(NTHR), LDS_BYTES, stream, a);
#else
    for (int p = 0; p < 14; ++p) { a.ph_lo = p; a.ph_hi = p + 1; hipLaunchKernelGGL(fwd, dim3(grid), dim3(NTHR), LDS_BYTES, stream, a); }
#endif
}
```
